# Optimizing an MI355X kernel written in HIP

```python
import math
import jax, jax.numpy as jnp
from jax import lax
import numpy as np

D_MODEL = 1024
BATCH = 8
SEQ = 2048
DEPTH = 2

GRID_W = 64
CTX_LEN = 256
F32 = jnp.float32
RMS_EPS = 1e-6
HEAD_DIM = 64
ATTN_HEADS = 8
ATTN_KV_HEADS = 2
Q_BLOCK = 128
ROPE_THETA = 10000.0
SSD_HEADS = 8
SSD_HEAD_DIM = 64
SSD_GROUPS = 2
SSD_STATE = 64
SSD_CONV = 3
SSD_CHUNK = 128
S5_GROUPS = 24
S5_GROUP_DIM = 16
S5_STATE = 64
SC_WIDTH = 384
SC_CONV = 3
N_EXPERTS = 16
EXPERT_FF = 1024
EC_CAPACITY = 2
N_BRANCHES = 4

ATTN_Q_DIM = ATTN_HEADS * HEAD_DIM
ATTN_KV_DIM = ATTN_KV_HEADS * HEAD_DIM
SSD_INNER = SSD_HEADS * SSD_HEAD_DIM
SSD_BC_DIM = SSD_GROUPS * SSD_STATE
SSD_CONV_DIM = SSD_INNER + 2 * SSD_BC_DIM
S5_WIDTH = S5_GROUPS * S5_GROUP_DIM
IN_SPLITS = (ATTN_Q_DIM, ATTN_KV_DIM, ATTN_KV_DIM, SSD_INNER, SSD_CONV_DIM, SSD_HEADS,
             S5_WIDTH, SC_WIDTH, SC_WIDTH, SC_WIDTH, N_BRANCHES * D_MODEL)
N_IN = sum(IN_SPLITS)

kernel_name = "hybrid_parallel_dit_block"


def rmsnorm(x, g):
    xf = x.astype(F32)
    y = xf * lax.rsqrt(jnp.mean(xf * xf, axis=-1, keepdims=True) + RMS_EPS)
    return (y * g.astype(F32)).astype(x.dtype)


def modulate(h, shift, scale):
    return h * (1.0 + scale) + shift


def split_cols(z, sizes):
    return jnp.split(z, np.cumsum(sizes)[:-1].tolist(), axis=-1)


def dwconv_centred(x, w):
    k = w.shape[0]
    pad = k // 2
    T = x.shape[1]
    xp = jnp.pad(x, ((0, 0), (pad, pad), (0, 0)))
    return sum(w[i] * xp[:, i:i + T] for i in range(k))


def axial_angles(T):
    rows = T // GRID_W
    row = jnp.repeat(jnp.arange(rows, dtype=F32), GRID_W)
    col = jnp.tile(jnp.arange(GRID_W, dtype=F32), rows)
    half = HEAD_DIM // 2
    inv = ROPE_THETA ** (-jnp.arange(0, half, 2, dtype=F32) / half)
    return row[:, None] * inv, col[:, None] * inv


def rope_1d(x, ang):
    x1, x2 = jnp.split(x, 2, axis=-1)
    cos = jnp.cos(ang)[None, :, None, :].astype(x.dtype)
    sin = jnp.sin(ang)[None, :, None, :].astype(x.dtype)
    return jnp.concatenate([x1 * cos - x2 * sin, x2 * cos + x1 * sin], axis=-1)


def axial_rope(x, row_ang, col_ang):
    half = HEAD_DIM // 2
    return jnp.concatenate([rope_1d(x[..., :half], row_ang), rope_1d(x[..., half:], col_ang)], axis=-1)


def gqa_attend(q, k, v):
    b, T, H, d = q.shape
    G = k.shape[2]
    qg = q.reshape(b, T, G, H // G, d)
    s = jnp.einsum('btgrd,bsgd->bgrts', qg, k).astype(F32) * (d ** -0.5)
    p = jax.nn.softmax(s, axis=-1).astype(v.dtype)
    o = jnp.einsum('bgrts,bsgd->btgrd', p, v)
    return o.reshape(b, T, H * d)


def attention_mixer(q_l, k_l, v_l, q_c, k_c, v_c, q_norm_g, k_norm_g, ctx_out):
    b, T = q_l.shape[:2]

    def heads(t, h):
        return t.reshape(t.shape[0], t.shape[1], h, HEAD_DIM)

    row_ang, col_ang = axial_angles(T)
    ql = axial_rope(rmsnorm(heads(q_l, ATTN_HEADS), q_norm_g), row_ang, col_ang)
    kl = axial_rope(rmsnorm(heads(k_l, ATTN_KV_HEADS), k_norm_g), row_ang, col_ang)
    vl = heads(v_l, ATTN_KV_HEADS)
    kc = rmsnorm(heads(k_c, ATTN_KV_HEADS), k_norm_g)
    vc = heads(v_c, ATTN_KV_HEADS)
    k_all = jnp.concatenate([kc, kl], axis=1)
    v_all = jnp.concatenate([vc, vl], axis=1)
    nb = T // Q_BLOCK
    qb = jnp.moveaxis(ql.reshape(b, nb, Q_BLOCK, ATTN_HEADS, HEAD_DIM), 1, 0)
    ob = lax.map(lambda qq: gqa_attend(qq, k_all, v_all), qb)
    y_l = jnp.moveaxis(ob, 0, 1).reshape(b, T, ATTN_Q_DIM)
    if not ctx_out:
        return y_l, None
    y_c = gqa_attend(rmsnorm(heads(q_c, ATTN_HEADS), q_norm_g), kc, vc)
    return y_l, y_c


def segsum(a):
    T = a.shape[-1]
    x = jnp.broadcast_to(a[..., :, None], a.shape + (T,))
    x = jnp.where(jnp.tril(jnp.ones((T, T), bool), -1), x, 0.0)
    cs = jnp.cumsum(x, axis=-2)
    return jnp.where(jnp.tril(jnp.ones((T, T), bool)), cs, -jnp.inf)


def ssd_scan(x, dt, a, bm, cm, h0):
    b, T, H, P = x.shape
    N = bm.shape[-1]
    l = SSD_CHUNK
    nc = T // l
    xd = (x.astype(F32) * dt[..., None]).reshape(b, nc, l, H, P)
    bc = bm.astype(F32).reshape(b, nc, l, H, N)
    cc = cm.astype(F32).reshape(b, nc, l, H, N)
    adt = jnp.moveaxis((dt * a).reshape(b, nc, l, H), -1, 1)
    a_cs = jnp.cumsum(adt, axis=-1)
    scores = jnp.einsum('bclhn,bcshn->bhcls', cc, bc) * jnp.exp(segsum(adt))
    y_diag = jnp.einsum('bhcls,bcshp->bclhp', scores, xd)
    decay_to_end = jnp.exp(a_cs[..., -1:] - a_cs)
    chunk_states = jnp.einsum('bclhn,bhcl,bclhp->bchpn', bc, decay_to_end, xd)
    states = jnp.concatenate([h0[:, None].astype(F32), chunk_states], axis=1)
    decay_chunk = jnp.exp(segsum(jnp.pad(a_cs[..., -1], ((0, 0), (0, 0), (1, 0)))))
    states = jnp.einsum('bhzc,bchpn->bzhpn', decay_chunk, states)
    y_off = jnp.einsum('bclhn,bchpn,bhcl->bclhp', cc, states[:, :-1], jnp.exp(a_cs))
    return (y_diag + y_off).reshape(b, T, H, P), states[:, -1]


def ssd_split(xbc):
    xs, bs, cs = split_cols(xbc, (SSD_INNER, SSD_BC_DIM, SSD_BC_DIM))
    b, T = xs.shape[:2]
    rep = SSD_HEADS // SSD_GROUPS
    xs = xs.reshape(b, T, SSD_HEADS, SSD_HEAD_DIM)
    bs = jnp.repeat(bs.reshape(b, T, SSD_GROUPS, SSD_STATE), rep, axis=2)
    cs = jnp.repeat(cs.reshape(b, T, SSD_GROUPS, SSD_STATE), rep, axis=2)
    return xs, bs, cs


def ssd_direction(x, dt, bm, cm, a, h0, rev):
    if rev:
        x, dt, bm, cm = (jnp.flip(t, axis=1) for t in (x, dt, bm, cm))
    y, h = ssd_scan(x, dt, a, bm, cm, h0)
    return (jnp.flip(y, axis=1) if rev else y), h


def ssd_mixer(z_l, xbc_l, dt_l, z_c, xbc_c, dt_c, conv_w, conv_b, dt_bias, a_log, d_skip, norm_g, ctx_out):
    xl, bl, cl = ssd_split(jax.nn.silu(dwconv_centred(xbc_l, conv_w) + conv_b))
    xc, bc, cc = ssd_split(jax.nn.silu(dwconv_centred(xbc_c, conv_w) + conv_b))
    h0 = jnp.zeros((xl.shape[0], SSD_HEADS, SSD_HEAD_DIM, SSD_STATE), F32)
    y_l = d_skip.astype(F32)[:, None] * xl.astype(F32)
    y_c = d_skip.astype(F32)[:, None] * xc.astype(F32)
    for d in range(2):
        a = -jnp.exp(a_log[d].astype(F32))
        dtl = jax.nn.softplus((dt_l + dt_bias[d]).astype(F32))
        dtc = jax.nn.softplus((dt_c + dt_bias[d]).astype(F32))
        yc_d, hc = ssd_direction(xc, dtc, bc, cc, a, h0, d == 1)
        yl_d, _ = ssd_direction(xl, dtl, bl, cl, a, hc, d == 1)
        y_l = y_l + yl_d
        y_c = y_c + yc_d

    def finish(y, z):
        y = y.reshape(z.shape).astype(z.dtype) * jax.nn.silu(z)
        return rmsnorm(y, norm_g)

    return finish(y_l, z_l), (finish(y_c, z_c) if ctx_out else None)


def s5_discretise(lam_re, lam_im, log_step, b_re, b_im):
    step = jnp.exp(log_step.astype(F32))[:, None]
    lr, li = lam_re.astype(F32), lam_im.astype(F32)
    mag = jnp.exp(lr * step)
    ab_re, ab_im = mag * jnp.cos(li * step), mag * jnp.sin(li * step)
    den = lr * lr + li * li
    nr, ni = ab_re - 1.0, ab_im
    coef_re = (nr * lr + ni * li) / den
    coef_im = (ni * lr - nr * li) / den
    br, bi = b_re.astype(F32), b_im.astype(F32)
    bb_re = coef_re[..., None] * br - coef_im[..., None] * bi
    bb_im = coef_re[..., None] * bi + coef_im[..., None] * br
    return ab_re, ab_im, bb_re, bb_im


def complex_linear_scan(ab_re, ab_im, bu_re, bu_im, h0_re, h0_im):
    a_re = jnp.broadcast_to(ab_re, bu_re.shape)
    a_im = jnp.broadcast_to(ab_im, bu_re.shape)

    def combine(e1, e2):
        a1r, a1i, b1r, b1i = e1
        a2r, a2i, b2r, b2i = e2
        return (a2r * a1r - a2i * a1i, a2r * a1i + a2i * a1r,
                a2r * b1r - a2i * b1i + b2r, a2r * b1i + a2i * b1r + b2i)

    pr, pi, hr, hi = lax.associative_scan(combine, (a_re, a_im, bu_re, bu_im), axis=1)
    h0r, h0i = h0_re[:, None], h0_im[:, None]
    return hr + pr * h0r - pi * h0i, hi + pr * h0i + pi * h0r


def s5_drive(u, bb):
    return jnp.einsum('btgi,gpi->btgp', u.astype(F32), bb)


def s5_readout(u, s_re, s_im, c_re, c_im, d_skip, w_glu, b_glu):
    b, T = u.shape[:2]
    y = (jnp.einsum('btgp,gip->btgi', s_re, c_re.astype(F32))
         - jnp.einsum('btgp,gip->btgi', s_im, c_im.astype(F32))
         + d_skip.reshape(S5_GROUPS, S5_GROUP_DIM).astype(F32) * u.astype(F32))
    y = jax.nn.gelu(y.reshape(b, T, S5_WIDTH)).astype(u.dtype)
    return y * jax.nn.sigmoid(y @ w_glu + b_glu)


def s5_mixer(u_l, u_c, lam_re, lam_im, log_step, b_re, b_im, c_re, c_im, d_skip, w_glu, b_glu, ctx_out):
    def groups(u):
        return u.reshape(u.shape[0], u.shape[1], S5_GROUPS, S5_GROUP_DIM)

    ul, uc = groups(u_l), groups(u_c)
    zero = jnp.zeros((ul.shape[0], S5_GROUPS, S5_STATE), F32)
    sl_re = sl_im = sc_re = sc_im = 0.0
    for d in range(2):
        ab_re, ab_im, bb_re, bb_im = s5_discretise(lam_re[d], lam_im[d], log_step[d], b_re, b_im)
        uc_d = jnp.flip(uc, axis=1) if d else uc
        ul_d = jnp.flip(ul, axis=1) if d else ul
        hc_re, hc_im = complex_linear_scan(ab_re, ab_im, s5_drive(uc_d, bb_re), s5_drive(uc_d, bb_im), zero, zero)
        hl_re, hl_im = complex_linear_scan(ab_re, ab_im, s5_drive(ul_d, bb_re), s5_drive(ul_d, bb_im),
                                           hc_re[:, -1], hc_im[:, -1])
        if d:
            hc_re, hc_im, hl_re, hl_im = (jnp.flip(t, axis=1) for t in (hc_re, hc_im, hl_re, hl_im))
        sl_re, sl_im = sl_re + hl_re, sl_im + hl_im
        sc_re, sc_im = sc_re + hc_re, sc_im + hc_im
    y_l = s5_readout(ul, sl_re, sl_im, c_re, c_im, d_skip, w_glu, b_glu)
    y_c = s5_readout(uc, sc_re, sc_im, c_re, c_im, d_skip, w_glu, b_glu) if ctx_out else None
    return y_l, y_c


def shortconv_mixer(bg, cg, hh, conv_w):
    return bg * dwconv_centred(cg * hh, conv_w)


def hybrid_mixer(h_l, h_c, p, ctx_out):
    proj_l = h_l @ p['w_in']
    proj_c = h_c @ p['w_in']
    q_l, k_l, v_l, z_l, xbc_l, dt_l, u_l, sb_l, sg_l, sh_l, g_l = split_cols(proj_l, IN_SPLITS)
    q_c, k_c, v_c, z_c, xbc_c, dt_c, u_c, sb_c, sg_c, sh_c, g_c = split_cols(proj_c, IN_SPLITS)
    ya_l, ya_c = attention_mixer(q_l, k_l, v_l, q_c, k_c, v_c, p['q_norm_g'], p['k_norm_g'], ctx_out)
    yb_l, yb_c = ssd_mixer(z_l, xbc_l, dt_l, z_c, xbc_c, dt_c, p['ssd_conv_w'], p['ssd_conv_b'],
                           p['ssd_dt_bias'], p['ssd_a_log'], p['ssd_d'], p['ssd_norm_g'], ctx_out)
    yc_l, yc_c = s5_mixer(u_l, u_c, p['s5_lambda_re'], p['s5_lambda_im'], p['s5_log_step'],
                          p['s5_b_re'], p['s5_b_im'], p['s5_c_re'], p['s5_c_im'], p['s5_d'],
                          p['s5_w_glu'], p['s5_b_glu'], ctx_out)
    yd_l = shortconv_mixer(sb_l, sg_l, sh_l, p['sc_conv_w'])

    def merge(ya, yb, yc, yd, g):
        gates = jnp.split(jax.nn.sigmoid(g), N_BRANCHES, axis=-1)
        merged = (gates[0] * (ya @ p['w_br_attn']) + gates[1] * (yb @ p['w_br_ssd'])
                  + gates[2] * (yc @ p['w_br_s5']) + gates[3] * (yd @ p['w_br_sc']))
        return merged @ p['w_out']

    y_l = merge(ya_l, yb_l, yc_l, yd_l, g_l)
    if not ctx_out:
        return y_l, None
    yd_c = shortconv_mixer(sb_c, sg_c, sh_c, p['sc_conv_w'])
    return y_l, merge(ya_c, yb_c, yc_c, yd_c, g_c)


def expert_choice_ffn(h, w_router, w_gate, w_up, w_down):
    b, T, _ = h.shape
    cap = EC_CAPACITY * T // N_EXPERTS
    aff = jax.nn.softmax((h @ w_router).astype(F32), axis=-1)
    gval, idx = lax.top_k(jnp.swapaxes(aff, 1, 2), cap)
    bidx = jnp.arange(b)[:, None, None]
    xg = h[bidx, idx]
    hid = jax.nn.silu(jnp.einsum('becd,edf->becf', xg, w_gate)) * jnp.einsum('becd,edf->becf', xg, w_up)
    ye = jnp.einsum('becf,efd->becd', hid, w_down) * gval[..., None].astype(h.dtype)
    return jnp.zeros_like(h).at[bidx, idx].add(ye)


def setup_inputs(seed: int = 0) -> dict:
    key = jax.random.key(seed)
    ks = iter(jax.random.split(key, 48))

    def nrm(shape, scale=1.0):
        return scale * jax.random.normal(next(ks), shape, F32)

    def unif(shape, lo, hi):
        return jax.random.uniform(next(ks), shape, F32, lo, hi)

    L, D = DEPTH, D_MODEL
    dt0 = jnp.exp(unif((L, 2, SSD_HEADS), math.log(1e-3), math.log(1e-1)))
    return {
        'x': nrm((BATCH, SEQ, D)),
        'c': nrm((BATCH, D)),
        'ctx': nrm((BATCH, CTX_LEN, D)),
        'c_ctx': nrm((D,)),
        'w_mod': nrm((L, D, 6 * D), 0.5 * D ** -0.5),
        'b_mod': nrm((L, 6 * D), 0.01),
        'norm_mix_g': 1.0 + nrm((L, D), 0.01),
        'norm_ffn_g': 1.0 + nrm((L, D), 0.01),
        'w_in': nrm((L, D, N_IN), D ** -0.5),
        'q_norm_g': 1.0 + nrm((L, HEAD_DIM), 0.01),
        'k_norm_g': 1.0 + nrm((L, HEAD_DIM), 0.01),
        'ssd_conv_w': nrm((L, SSD_CONV, SSD_CONV_DIM), SSD_CONV ** -0.5),
        'ssd_conv_b': nrm((L, SSD_CONV_DIM), 0.01),
        'ssd_dt_bias': dt0 + jnp.log(-jnp.expm1(-dt0)),
        'ssd_a_log': jnp.log(unif((L, 2, SSD_HEADS), 1.0, 16.0)),
        'ssd_d': 1.0 + nrm((L, SSD_HEADS), 0.01),
        'ssd_norm_g': 1.0 + nrm((L, SSD_INNER), 0.01),
        's5_lambda_re': -0.5 + nrm((L, 2, S5_GROUPS, S5_STATE), 0.01),
        's5_lambda_im': jnp.pi * jnp.arange(S5_STATE, dtype=F32) + nrm((L, 2, S5_GROUPS, S5_STATE), 0.01),
        's5_log_step': unif((L, 2, S5_GROUPS), math.log(1e-3), math.log(1e-1)),
        's5_b_re': nrm((L, S5_GROUPS, S5_STATE, S5_GROUP_DIM), S5_GROUP_DIM ** -0.5),
        's5_b_im': nrm((L, S5_GROUPS, S5_STATE, S5_GROUP_DIM), S5_GROUP_DIM ** -0.5),
        's5_c_re': nrm((L, S5_GROUPS, S5_GROUP_DIM, S5_STATE), S5_STATE ** -0.5),
        's5_c_im': nrm((L, S5_GROUPS, S5_GROUP_DIM, S5_STATE), S5_STATE ** -0.5),
        's5_d': nrm((L, S5_WIDTH)),
        's5_w_glu': nrm((L, S5_WIDTH, S5_WIDTH), S5_WIDTH ** -0.5),
        's5_b_glu': nrm((L, S5_WIDTH), 0.01),
        'sc_conv_w': nrm((L, SC_CONV, SC_WIDTH), SC_CONV ** -0.5),
        'w_br_attn': nrm((L, ATTN_Q_DIM, D), ATTN_Q_DIM ** -0.5),
        'w_br_ssd': nrm((L, SSD_INNER, D), SSD_INNER ** -0.5),
        'w_br_s5': nrm((L, S5_WIDTH, D), S5_WIDTH ** -0.5),
        'w_br_sc': nrm((L, SC_WIDTH, D), SC_WIDTH ** -0.5),
        'w_out': nrm((L, D, D), D ** -0.5),
        'w_router': nrm((L, D, N_EXPERTS), D ** -0.5),
        'w_exp_gate': nrm((L, N_EXPERTS, D, EXPERT_FF), D ** -0.5),
        'w_exp_up': nrm((L, N_EXPERTS, D, EXPERT_FF), D ** -0.5),
        'w_exp_down': nrm((L, N_EXPERTS, EXPERT_FF, D), EXPERT_FF ** -0.5),
        'final_norm_g': 1.0 + nrm((D,), 0.01),
    }


def reference(x, c, ctx, c_ctx, w_mod, b_mod, norm_mix_g, norm_ffn_g, w_in, q_norm_g, k_norm_g,
              ssd_conv_w, ssd_conv_b, ssd_dt_bias, ssd_a_log, ssd_d, ssd_norm_g,
              s5_lambda_re, s5_lambda_im, s5_log_step, s5_b_re, s5_b_im, s5_c_re, s5_c_im,
              s5_d, s5_w_glu, s5_b_glu, sc_conv_w, w_br_attn, w_br_ssd, w_br_s5, w_br_sc, w_out,
              w_router, w_exp_gate, w_exp_up, w_exp_down, final_norm_g):
    silu_c = jax.nn.silu(c)
    silu_cc = jax.nn.silu(c_ctx)
    for i in range(DEPTH):
        ctx_out = i < DEPTH - 1
        p = {
            'w_in': w_in[i], 'q_norm_g': q_norm_g[i], 'k_norm_g': k_norm_g[i],
            'ssd_conv_w': ssd_conv_w[i], 'ssd_conv_b': ssd_conv_b[i], 'ssd_dt_bias': ssd_dt_bias[i],
            'ssd_a_log': ssd_a_log[i], 'ssd_d': ssd_d[i], 'ssd_norm_g': ssd_norm_g[i],
            's5_lambda_re': s5_lambda_re[i], 's5_lambda_im': s5_lambda_im[i], 's5_log_step': s5_log_step[i],
            's5_b_re': s5_b_re[i], 's5_b_im': s5_b_im[i], 's5_c_re': s5_c_re[i], 's5_c_im': s5_c_im[i],
            's5_d': s5_d[i], 's5_w_glu': s5_w_glu[i], 's5_b_glu': s5_b_glu[i], 'sc_conv_w': sc_conv_w[i],
            'w_br_attn': w_br_attn[i], 'w_br_ssd': w_br_ssd[i], 'w_br_s5': w_br_s5[i], 'w_br_sc': w_br_sc[i],
            'w_out': w_out[i],
        }
        mod_l = jnp.split((silu_c @ w_mod[i] + b_mod[i])[:, None, :], 6, axis=-1)
        mod_c = jnp.split(silu_cc @ w_mod[i] + b_mod[i], 6, axis=-1)
        h_l = modulate(rmsnorm(x, norm_mix_g[i]), mod_l[0], mod_l[1])
        h_c = modulate(rmsnorm(ctx, norm_mix_g[i]), mod_c[0], mod_c[1])
        y_l, y_c = hybrid_mixer(h_l, h_c, p, ctx_out)
        x = x + mod_l[2] * y_l
        x = x + mod_l[5] * expert_choice_ffn(modulate(rmsnorm(x, norm_ffn_g[i]), mod_l[3], mod_l[4]),
                                             w_router[i], w_exp_gate[i], w_exp_up[i], w_exp_down[i])
        if ctx_out:
            ctx = ctx + mod_c[2] * y_c
            ctx = ctx + mod_c[5] * expert_choice_ffn(modulate(rmsnorm(ctx, norm_ffn_g[i]), mod_c[3], mod_c[4]),
                                                     w_router[i], w_exp_gate[i], w_exp_up[i], w_exp_down[i])
    return rmsnorm(x, final_norm_g)
```

```cpp
#include <hip/hip_runtime.h>
#include <hip/hip_bf16.h>
#include <cstdio>
#include <cstdint>
#include <cmath>

#define DI __device__ __forceinline__
#define GAS __attribute__((address_space(1)))
#define LAS __attribute__((address_space(3)))
typedef unsigned short bf16_t;
typedef short bf16x8 __attribute__((ext_vector_type(8)));
typedef short s16x4 __attribute__((ext_vector_type(4)));
typedef float f32x2 __attribute__((ext_vector_type(2)));
typedef float f32x4 __attribute__((ext_vector_type(4)));
typedef float f32x16 __attribute__((ext_vector_type(16)));
typedef unsigned u32x2 __attribute__((ext_vector_type(2)));
typedef unsigned u32x4 __attribute__((ext_vector_type(4)));
typedef GAS unsigned gu32;

constexpr int DM = 1024, NB = 8, SEQ = 2048, CTXL = 256, PB = 2304, MROWS = NB * PB;
constexpr int NIN = 7688, NE = 16, EFF = 1024;
constexpr int C_Q = 0, C_K = 512, C_V = 640, C_Z = 768, C_XBC = 1280, C_DT = 2048, C_U = 2056, C_SB = 2440, C_SG = 2824, C_SH = 3208, C_G = 3592;
constexpr int PA_W = 3840, PG_W = 4096, NPROJ = PA_W + PG_W;
constexpr int EROWS = 2304;
constexpr float RMS_EPS = 1e-6f;
constexpr float ATT_C2 = 0.125f * 1.4426950408889634f;

constexpr size_t MiB = 1u << 20;
constexpr size_t WS_CTL = 0, CTL_ZERO_BYTES = 1 * MiB;
constexpr size_t WS_MOD = 1 * MiB;
constexpr size_t WS_ROPE = WS_MOD + 512 * 1024;
constexpr size_t WS_AFF = 2 * MiB;
constexpr size_t WS_INV = WS_AFF + 1280 * 1024;
constexpr size_t WS_DT = WS_INV + 1280 * 1024;
constexpr size_t WS_SRC = WS_DT + 1280 * 1024;
constexpr size_t WS_GV = WS_SRC + 256 * 1024;
constexpr size_t WS_SSQ = WS_GV + 256 * 1024;
constexpr size_t WS_TOT = WS_SSQ + 256 * 1024;
constexpr size_t WS_X = 8 * MiB;
constexpr size_t WS_W = 80 * MiB;
constexpr size_t W_WIN = WS_W;
constexpr size_t W_BRA = W_WIN + (size_t)NPROJ * 1024 * 2;
constexpr size_t W_BRB = W_BRA + 1024 * 512 * 2;
constexpr size_t W_BRC = W_BRB + 1024 * 512 * 2;
constexpr size_t W_BRD = W_BRC + 1024 * 384 * 2;
constexpr size_t W_OUT = W_BRD + 1024 * 384 * 2;
constexpr size_t W_GLU = W_OUT + 1024 * 1024 * 2;
constexpr size_t W_TQ = W_GLU + 512 * 384 * 2;
constexpr size_t W_P = W_TQ + (size_t)24 * 512 * 768 * 2;
constexpr size_t W_END = W_P + (size_t)24 * 256 * 512 * 2;
constexpr size_t WS_H = 126 * MiB;
constexpr size_t WS_YA = WS_H, WS_YB = WS_H + 18 * MiB;
constexpr size_t WS_PA = 162 * MiB;
constexpr size_t WS_MRG = WS_PA, WS_MRGB = WS_PA + 72 * MiB, WS_XG = WS_PA;
constexpr size_t WS_PG = 297 * MiB;
constexpr size_t WS_HID = WS_PG, WS_YE = WS_PG + 72 * MiB;
constexpr size_t WS_R5 = 441 * MiB;
constexpr size_t WS_QN = WS_R5;
constexpr size_t WS_KN = WS_R5 + 18 * MiB;
constexpr size_t WS_HIN = WS_R5;
constexpr size_t WS_XBC = WS_R5 + 23 * MiB;
constexpr size_t WS_AU = WS_R5 + 50 * MiB;
constexpr size_t WS_S = WS_R5 + 71 * MiB;
constexpr size_t WS_YG = WS_S, WS_YC = WS_S + 14 * MiB;
constexpr size_t WS_S5S = WS_R5 + 107 * MiB;
constexpr size_t WS_YD = WS_R5 + 121 * MiB;
constexpr size_t WS_WGU = WS_R5;
constexpr size_t WS_WD = WS_R5 + 64 * MiB;
constexpr size_t WS_END = 576 * MiB;
static_assert(W_END <= WS_H, "small weights fit");
static_assert(WS_AU + (size_t)24 * 576 * 768 * 2 <= WS_S && WS_XBC + (size_t)MROWS * 768 * 2 <= WS_AU && WS_S + (size_t)8 * 18 * 16 * 4096 * 4 <= WS_S5S, "R5 map");
static_assert(WS_S5S + (size_t)24 * 576 * 256 * 4 <= WS_YD && WS_YD + (size_t)MROWS * 384 * 2 <= WS_END && WS_WD + (size_t)32 * MiB <= WS_END, "R5 map 2");
static_assert(WS_TOT + 16384 <= WS_X && WS_ROPE + 2048 * 64 * 4 <= WS_AFF, "misc map");

constexpr int CW_BAR = 4096;

constexpr int NWAVES = 8;
constexpr int LDS_SCRATCH = 151552;
constexpr int LDSCTL_OFF = LDS_SCRATCH;
constexpr int LDS_BYTES = 155648;

#define LDS_WAIT() asm volatile("s_waitcnt lgkmcnt(0)" ::: "memory")
#define VM_WAIT() asm volatile("s_waitcnt vmcnt(0)" ::: "memory")
DI int fresh_tid() { int t = threadIdx.x; asm volatile("" : "+v"(t)); return t; }
DI unsigned f2bf(float f) { unsigned u = __builtin_bit_cast(unsigned, f); return (u + 0x7fffu + ((u >> 16) & 1u)) >> 16; }
DI unsigned pk2(float lo, float hi) { return f2bf(lo) | (f2bf(hi) << 16); }
DI float bflo(unsigned w) { return __builtin_bit_cast(float, w << 16); }
DI float bfhi(unsigned w) { return __builtin_bit_cast(float, w & 0xffff0000u); }
DI float bf2f(bf16_t h) { return __builtin_bit_cast(float, (unsigned)h << 16); }
DI float silu_f(float x) { return x / (1.f + __expf(-x)); }
DI float sigmoid_f(float x) { return 1.f / (1.f + __expf(-x)); }
DI float softplus_f(float x) { return fmaxf(x, 0.f) + log1pf(__expf(-fabsf(x))); }
DI float gelu_tanh_f(float x) { const float u = 0.7978845608028654f * (x + 0.044715f * x * x * x); const float t = 1.f - 2.f / (__expf(2.f * u) + 1.f); return 0.5f * x * (1.f + t); }
DI float wave_sum(float v) {
#pragma unroll
    for (int o = 1; o < 64; o <<= 1) v += __shfl_xor(v, o);
    return v;
}
DI void unpack8(const u32x4 w, float (&f)[8]) {
    f[0] = bflo(w.x); f[1] = bfhi(w.x); f[2] = bflo(w.y); f[3] = bfhi(w.y); f[4] = bflo(w.z); f[5] = bfhi(w.z); f[6] = bflo(w.w); f[7] = bfhi(w.w);
}
DI u32x4 pack8(const float (&f)[8]) { u32x4 w; w.x = pk2(f[0], f[1]); w.y = pk2(f[2], f[3]); w.z = pk2(f[4], f[5]); w.w = pk2(f[6], f[7]); return w; }

#define XB_TMO      128
#define XB_XCNT(j)  (256  + 64 * (j))
#define XB_XSUB(j)  (1280 + 64 * (j))
#define XB_XGEN(j)  (2304 + 64 * (j))
#define XB_TOP      3328
#define XB_TOPGEN   3392
#define XCD_BAR_WORDS 3456
#define XB_SPIN_CAP (1u << 20)
DI unsigned xb_ld(unsigned* p)              { return __hip_atomic_load(p, __ATOMIC_RELAXED, __HIP_MEMORY_SCOPE_AGENT); }
DI unsigned xb_add(unsigned* p, unsigned v) { return __hip_atomic_fetch_add(p, v, __ATOMIC_RELAXED, __HIP_MEMORY_SCOPE_AGENT); }
DI unsigned xb_xcc_id() { return (unsigned)__builtin_amdgcn_s_getreg((3 << 11) | 20) & 0xFu; }
#define XB_SPIN(cond, bar) do { unsigned _sp = 0; while (cond) { __builtin_amdgcn_s_sleep(1); \
    if ((++_sp & 255u) == 0u) { if (xb_ld(&(bar)[XB_TMO])) break; if (_sp > XB_SPIN_CAP) { atomicAdd(&(bar)[XB_TMO], 1u); break; } } } } while (0)
struct XcdBarrier { unsigned* bar; unsigned x; volatile LAS unsigned* st; };
DI XcdBarrier xcd_barrier_post(unsigned* bar, volatile LAS unsigned* st) {
    XcdBarrier b; b.bar = bar; b.x = xb_xcc_id(); b.st = st;
    if (threadIdx.x == 0) (void)xb_add(&bar[XB_XCNT(b.x)], 1u);
    return b;
}
DI void xcd_barrier_complete(unsigned* bar, unsigned x, unsigned& nloc, unsigned& nx) {
    const unsigned G = gridDim.x * gridDim.y * gridDim.z;
    unsigned sum, cnt, mine, sp = 0u;
    for (;;) {
        sum = 0u; cnt = 0u; mine = 0u;
#pragma unroll
        for (unsigned j = 0; j < 16; ++j) { const unsigned c = xb_ld(&bar[XB_XCNT(j)]); sum += c; cnt += (c > 0u) ? 1u : 0u; mine = (j == x) ? c : mine; }
        if (sum == G) break;
        __builtin_amdgcn_s_sleep(1);
        if ((++sp & 255u) == 0u) { if (xb_ld(&bar[XB_TMO])) break; if (sp > XB_SPIN_CAP) { atomicAdd(&bar[XB_TMO], 1u); break; } }
    }
    nloc = mine > 0u ? mine : 1u; nx = cnt > 0u ? cnt : 1u;
}
DI void xcd_barrier(const XcdBarrier& b) {
    asm volatile("s_waitcnt vmcnt(0)" ::: "memory");
    __syncthreads();
    if (threadIdx.x == 0) {
        unsigned* bar = b.bar;
        __builtin_amdgcn_s_waitcnt(0);
        unsigned nloc = b.st[0], nx = b.st[1];
        if (nloc == 0u) { xcd_barrier_complete(bar, b.x, nloc, nx); b.st[0] = nloc; b.st[1] = nx; }
        const unsigned old = xb_add(&bar[XB_XSUB(b.x)], 1u);
        const unsigned gen = old / nloc;
        if (old + 1u == (gen + 1u) * nloc) {
            __builtin_amdgcn_fence(__ATOMIC_RELEASE, "agent");
            asm volatile("s_waitcnt vmcnt(0)" ::: "memory");
            const unsigned og = xb_add(&bar[XB_TOP], 1u);
            const unsigned tg = og / nx;
            if (og + 1u == (tg + 1u) * nx) xb_add(&bar[XB_TOPGEN], 1u);
            else XB_SPIN(xb_ld(&bar[XB_TOPGEN]) == tg, bar);
            __builtin_amdgcn_fence(__ATOMIC_ACQUIRE, "agent");
            xb_add(&bar[XB_XGEN(b.x)], 1u);
            asm volatile("s_waitcnt vmcnt(0)" ::: "memory");
        } else {
            XB_SPIN(xb_ld(&bar[XB_XGEN(b.x)]) == gen, bar);
            __builtin_amdgcn_fence(__ATOMIC_ACQUIRE, "agent");
            asm volatile("s_waitcnt vmcnt(0)" ::: "memory");
        }
    }
    __syncthreads();
}

namespace pg8 {
constexpr int BM = 256, BK = 64, HALF = 128, HTB = HALF * BK * 2, STAGE_BYTES = 8 * HTB, NXCD = 8, WGM = 8;
__host__ __device__ __forceinline__ int lds_byte(int r, int c) { const int st = (r >> 4) * 2 + (c >> 5), rr = r & 15, cc = c & 31, ob = rr * 64 + cc * 2; return st * 1024 + (ob ^ (((ob >> 9) & 1) << 5)); }
__host__ __device__ __forceinline__ void stage_rc(int b, int& R, int& C) { const int st = b / 1024, sb = b % 1024, swz = sb ^ (((sb >> 9) & 1) << 5); R = (st >> 1) * 16 + swz / 64; C = (st & 1) * 32 + (swz % 64) / 2; }
__host__ __device__ __forceinline__ int perm32(int rho) { const int n = rho >> 4, i = rho & 15; return 8 * (i >> 2) + 4 * n + (i & 3); }

struct Unit { int arow, brow, pm, pn; };
struct Gemm { const bf16_t* A; const bf16_t* Bt; int lda, ldb, K; };

template <class Epi, class Sched, bool ALIGN_EPI = true>
DI void gemm_phase(LAS unsigned char* lds, const Gemm g, const Sched& S, const Epi& E) {
    const int tid = fresh_tid(), wid = __builtin_amdgcn_readfirstlane(tid >> 6), lane = tid & 63, wr = wid >> 2, wc = wid & 3, fr = lane & 15, fq = lane >> 4;
    const int K = g.K, nt = K / BK;
    unsigned voffA[2], voffB[2];
#pragma unroll
    for (int i = 0; i < 2; ++i) { int R, C; stage_rc(tid * 16 + i * 8192, R, C); const int Rb = Epi::PERM ? ((R & ~31) + perm32(R & 31)) : R;
        voffA[i] = (unsigned)(R * g.lda + C) * 2u; voffB[i] = (unsigned)(Rb * g.ldb + C) * 2u; }
    const size_t kstep = (size_t)(BK * 2);
    const size_t hA = (size_t)HALF * g.lda * 2, hB = (size_t)HALF * g.ldb * 2;
    const unsigned ldsw = (unsigned)wid * 1024u;
    const int aoff = lds_byte(wr * 64 + fr, fq * 8), boff = lds_byte(wc * 32 + fr, fq * 8);
#define PG8_SA(b, h) (((b) * 2 + (h)) * HTB)
#define PG8_SB(b, h) ((4 + (b) * 2 + (h)) * HTB)
#define PG8_STAGE(bufoff, gbase, voff) do { _Pragma("unroll") for (int _i = 0; _i < 2; ++_i) \
        __builtin_amdgcn_global_load_lds((const unsigned*)((const char*)(gbase) + (voff)[_i]), (LAS unsigned*)(lds + (bufoff) + ldsw + _i * 8192), 16, 0, 0); } while (0)
#define PG8_LDA(dst, b, h) do { _Pragma("unroll") for (int m = 0; m < 4; ++m) _Pragma("unroll") for (int k = 0; k < 2; ++k) dst[m][k] = *(const LAS bf16x8*)(lds + PG8_SA(b, h) + aoff + m * 2048 + k * 1024); } while (0)
#define PG8_LDB(dst, b, h) do { _Pragma("unroll") for (int n = 0; n < 2; ++n) _Pragma("unroll") for (int k = 0; k < 2; ++k) dst[n][k] = *(const LAS bf16x8*)(lds + PG8_SB(b, h) + boff + n * 2048 + k * 1024); } while (0)
#define PG8_MMA(ai, bj, At, Bt) do { __builtin_amdgcn_s_setprio(1); _Pragma("unroll") for (int m = 0; m < 4; ++m) _Pragma("unroll") for (int n = 0; n < 2; ++n) _Pragma("unroll") for (int k = 0; k < 2; ++k) \
        acc[ai][bj][m][n] = __builtin_amdgcn_mfma_f32_16x16x32_bf16(Bt[n][k], At[m][k], acc[ai][bj][m][n], 0, 0, 0); __builtin_amdgcn_s_setprio(0); } while (0)
#define PG8_WAIT_V(n) asm volatile("s_waitcnt vmcnt(" #n ")" ::: "memory")
#define PG8_WAIT_L(n) asm volatile("s_waitcnt lgkmcnt(" #n ")" ::: "memory")
#define PG8_BAR __builtin_amdgcn_s_barrier()
#define PG8_SCHED __builtin_amdgcn_sched_barrier(0)
    int ui = 0;
    Unit cur = S.next(0);
    if (cur.arow < 0) return;
    f32x4 acc[2][2][4][2];
#pragma unroll
    for (int a = 0; a < 2; ++a)
#pragma unroll
        for (int b = 0; b < 2; ++b)
#pragma unroll
            for (int m = 0; m < 4; ++m)
#pragma unroll
                for (int n = 0; n < 2; ++n) acc[a][b][m][n] = (f32x4){0.f, 0.f, 0.f, 0.f};
    bf16x8 At[4][2], B0[2][2], B1[2][2];
    const char* cA = (const char*)g.A + (size_t)cur.arow * g.lda * 2; const char* cB = (const char*)g.Bt + (size_t)cur.brow * g.ldb * 2;
    PG8_STAGE(PG8_SB(0, 0), cB, voffB); PG8_STAGE(PG8_SB(0, 1), cB + hB, voffB); PG8_STAGE(PG8_SA(0, 0), cA, voffA); PG8_STAGE(PG8_SA(0, 1), cA + hA, voffA);
    if (wr == 1) PG8_BAR;
    PG8_WAIT_V(2); PG8_BAR;
    PG8_STAGE(PG8_SB(1, 0), cB + kstep, voffB); PG8_STAGE(PG8_SA(1, 0), cA + kstep, voffA); PG8_STAGE(PG8_SB(1, 1), cB + hB + kstep, voffB);
    PG8_WAIT_V(6); PG8_BAR;
    for (;;) {
        const Unit nxt = S.next(ui + 1);
        const bool has_next = nxt.arow >= 0;
        const char* nA = has_next ? (const char*)g.A + (size_t)nxt.arow * g.lda * 2 : cA; const char* nB = has_next ? (const char*)g.Bt + (size_t)nxt.brow * g.ldb * 2 : cB;
#pragma unroll 1
        for (int t = 0; t < nt; t += 2) {
            const bool last = (t == nt - 2);
            const char* a1 = cA + (size_t)(t + 1) * kstep;
            const char* a2 = last ? nA : cA + (size_t)(t + 2) * kstep; const char* b2 = last ? nB : cB + (size_t)(t + 2) * kstep;
            const char* a3 = a2 + kstep; const char* b3 = b2 + kstep;
            PG8_LDB(B0, 0, 0); PG8_LDB(B1, 0, 1); PG8_SCHED; PG8_LDA(At, 0, 0); PG8_STAGE(PG8_SA(1, 1), a1 + hA, voffA);
            PG8_WAIT_V(8); PG8_WAIT_L(0); PG8_BAR; PG8_MMA(0, 0, At, B0); PG8_MMA(0, 1, At, B1); PG8_BAR; PG8_SCHED;
            PG8_LDA(At, 0, 1); PG8_STAGE(PG8_SB(0, 0), b2, voffB); PG8_STAGE(PG8_SB(0, 1), b2 + hB, voffB); PG8_STAGE(PG8_SA(0, 0), a2, voffA);
            PG8_WAIT_V(8); PG8_WAIT_L(0); PG8_BAR; PG8_MMA(1, 0, At, B0); PG8_MMA(1, 1, At, B1); PG8_BAR; PG8_SCHED;
            PG8_LDB(B0, 1, 0); PG8_LDB(B1, 1, 1); PG8_SCHED; PG8_LDA(At, 1, 0); PG8_STAGE(PG8_SA(0, 1), a2 + hA, voffA);
            PG8_WAIT_V(8); PG8_WAIT_L(0); PG8_BAR; PG8_MMA(0, 0, At, B0); PG8_MMA(0, 1, At, B1); PG8_BAR; PG8_SCHED;
            PG8_LDA(At, 1, 1); PG8_STAGE(PG8_SB(1, 0), b3, voffB); PG8_STAGE(PG8_SB(1, 1), b3 + hB, voffB); PG8_STAGE(PG8_SA(1, 0), a3, voffA);
            PG8_WAIT_V(8); PG8_WAIT_L(0); PG8_BAR; PG8_MMA(1, 0, At, B0); PG8_MMA(1, 1, At, B1); PG8_BAR; PG8_SCHED;
        }
        if constexpr (ALIGN_EPI) { if (wr == 0) PG8_BAR; }
        E(acc, cur, wr, wc, fr, fq);
        if (!has_next) break;
#pragma unroll
        for (int a = 0; a < 2; ++a)
#pragma unroll
            for (int b = 0; b < 2; ++b)
#pragma unroll
                for (int m = 0; m < 4; ++m)
#pragma unroll
                    for (int n = 0; n < 2; ++n) acc[a][b][m][n] = (f32x4){0.f, 0.f, 0.f, 0.f};
        cur = nxt; cA = nA; cB = nB; ++ui;
        if constexpr (ALIGN_EPI) { if (wr == 1) PG8_BAR; }
    }
    PG8_WAIT_V(0);
    if constexpr (!ALIGN_EPI) { if (wr == 0) PG8_BAR; }
    PG8_BAR;
#undef PG8_SA
#undef PG8_SB
#undef PG8_STAGE
#undef PG8_LDA
#undef PG8_LDB
#undef PG8_MMA
#undef PG8_WAIT_V
#undef PG8_WAIT_L
#undef PG8_BAR
#undef PG8_SCHED
}
}

using pg8::Unit;

struct EpiProj {
    static constexpr bool PERM = true;
    bf16_t* O0; int ld0; int split_pn; bf16_t* O1; int ld1;
    DI void operator()(const f32x4 (&acc)[2][2][4][2], const Unit& u, int wr, int wc, int fr, int fq) const {
        bf16_t* base; int ld, ct;
        if (u.pn < split_pn) { base = O0; ld = ld0; ct = u.pn * 256; } else { base = O1; ld = ld1; ct = (u.pn - split_pn) * 256; }
        const int row0 = u.arow + wr * 64 + fr, col0 = ct + wc * 32 + 8 * fq;
#pragma unroll
        for (int ai = 0; ai < 2; ++ai)
#pragma unroll
            for (int m = 0; m < 4; ++m) { bf16_t* rowp = base + (size_t)(row0 + ai * 128 + m * 16) * ld + col0;
#pragma unroll
                for (int bj = 0; bj < 2; ++bj) { const f32x4 v0 = acc[ai][bj][m][0], v1 = acc[ai][bj][m][1];
                    u32x4 w; w.x = pk2(v0[0], v0[1]); w.y = pk2(v0[2], v0[3]); w.z = pk2(v1[0], v1[1]); w.w = pk2(v1[2], v1[3]);
                    *(u32x4*)(rowp + bj * 128) = w; } }
    }
};

struct EpiMerge {
    static constexpr bool PERM = true;
    const bf16_t* G; float* MRG; bf16_t* MRGB; const float* ssq; int mode;
    DI void operator()(const f32x4 (&acc)[2][2][4][2], const Unit& u, int wr, int wc, int fr, int fq) const {
        const int row0 = u.arow + wr * 64 + fr, col0 = u.pn * 256 + wc * 32 + 8 * fq;
#pragma unroll
        for (int ai = 0; ai < 2; ++ai)
#pragma unroll
            for (int m = 0; m < 4; ++m) { const int row = row0 + ai * 128 + m * 16;
                float rs = 1.f; if (ssq) rs = 1.0f / sqrtf((ssq[2 * row] + ssq[2 * row + 1]) * (1.f / 512.f) + RMS_EPS);
#pragma unroll
                for (int bj = 0; bj < 2; ++bj) { const size_t off = (size_t)row * 1024 + col0 + bj * 128;
                    const u32x4 gw = *(const u32x4*)(G + (size_t)row * PG_W + col0 + bj * 128);
                    float gf[8]; unpack8(gw, gf);
                    f32x4 v0 = acc[ai][bj][m][0], v1 = acc[ai][bj][m][1];
#pragma unroll
                    for (int k = 0; k < 4; ++k) { v0[k] *= rs * sigmoid_f(gf[k]); v1[k] *= rs * sigmoid_f(gf[4 + k]); }
                    if (mode != 0) { v0 += *(const f32x4*)(MRG + off); v1 += *(const f32x4*)(MRG + off + 4); }
                    if (mode != 2) { *(f32x4*)(MRG + off) = v0; *(f32x4*)(MRG + off + 4) = v1; }
                    else { u32x4 w; w.x = pk2(v0[0], v0[1]); w.y = pk2(v0[2], v0[3]); w.z = pk2(v1[0], v1[1]); w.w = pk2(v1[2], v1[3]); *(u32x4*)(MRGB + off) = w; } __builtin_amdgcn_sched_barrier(0); } }
    }
};

struct EpiWout {
    static constexpr bool PERM = true;
    float* X; const float* modl;
    DI void operator()(const f32x4 (&acc)[2][2][4][2], const Unit& u, int wr, int wc, int fr, int fq) const {
        const int tile = u.arow / 256, b = tile / 9, jj = tile % 9, mrow = (jj == 0) ? 8 : b;
        const int row0 = u.arow + wr * 64 + fr, col0 = u.pn * 256 + wc * 32 + 8 * fq;
        const float* mg = modl + (size_t)mrow * 6144 + 2 * 1024;
#pragma unroll
        for (int bj = 0; bj < 2; ++bj) { const int col = col0 + bj * 128;
            const f32x4 g0 = *(const f32x4*)(mg + col), g1 = *(const f32x4*)(mg + col + 4);
#pragma unroll
            for (int ai = 0; ai < 2; ++ai)
#pragma unroll
                for (int m = 0; m < 4; ++m) { float* p = X + (size_t)(row0 + ai * 128 + m * 16) * 1024 + col;
                    f32x4 x0 = *(const f32x4*)p, x1 = *(const f32x4*)(p + 4);
                    x0 += g0 * acc[ai][bj][m][0]; x1 += g1 * acc[ai][bj][m][1];
                    *(f32x4*)p = x0; *(f32x4*)(p + 4) = x1; __builtin_amdgcn_sched_barrier(0); } }
    }
};

struct EpiGlu {
    static constexpr bool PERM = true;
    const bf16_t* YG; bf16_t* YC; const float* bglu;
    DI void operator()(const f32x4 (&acc)[2][2][4][2], const Unit& u, int wr, int wc, int fr, int fq) const {
        const int row0 = u.arow + wr * 64 + fr, col0 = u.pn * 256 + wc * 32 + 8 * fq;
#pragma unroll
        for (int bj = 0; bj < 2; ++bj) { const int col = col0 + bj * 128; if (u.pn == 1 && bj == 1) continue;
            const f32x4 b0 = *(const f32x4*)(bglu + col), b1 = *(const f32x4*)(bglu + col + 4);
#pragma unroll
            for (int ai = 0; ai < 2; ++ai)
#pragma unroll
                for (int m = 0; m < 4; ++m) { const size_t off = (size_t)(row0 + ai * 128 + m * 16) * 384 + col;
                    float y[8]; unpack8(*(const u32x4*)(YG + off), y);
                    const f32x4 a0 = acc[ai][bj][m][0] + b0, a1 = acc[ai][bj][m][1] + b1;
                    float o[8];
#pragma unroll
                    for (int k = 0; k < 4; ++k) { o[k] = y[k] * sigmoid_f(a0[k]); o[4 + k] = y[4 + k] * sigmoid_f(a1[k]); }
                    *(u32x4*)(YC + off) = pack8(o); __builtin_amdgcn_sched_barrier(0); } }
    }
};

struct EpiS5S {
    static constexpr bool PERM = true;
    float* S;
    DI void operator()(const f32x4 (&acc)[2][2][4][2], const Unit& u, int wr, int wc, int fr, int fq) const {
        const int m0 = u.pn * 256 + wr * 64 + fr, col0 = wc * 32 + 8 * fq;
#pragma unroll
        for (int ai = 0; ai < 2; ++ai)
#pragma unroll
            for (int m = 0; m < 4; ++m) { const int mm = m0 + ai * 128 + m * 16; if (u.pn == 2 && (ai == 1 || wr == 1)) continue;
                float* p = S + ((size_t)u.pm * 576 + mm) * 256 + col0;
#pragma unroll
                for (int bj = 0; bj < 2; ++bj) { *(f32x4*)(p + bj * 128) = acc[ai][bj][m][0]; *(f32x4*)(p + bj * 128 + 4) = acc[ai][bj][m][1]; } }
    }
};

struct EpiS5Y {
    static constexpr bool PERM = true;
    const bf16_t* AU; bf16_t* YG; const float* dsk;
    DI void operator()(const f32x4 (&acc)[2][2][4][2], const Unit& u, int wr, int wc, int fr, int fq) const {
        const int g = u.pm / 3, j = u.pm % 3;
        const int m0 = j * 256 + wr * 64 + fr, n0 = u.pn * 256 + wc * 32 + 8 * fq;
#pragma unroll
        for (int bj = 0; bj < 2; ++bj) { const int n = n0 + bj * 128, i = n >> 4, a0 = n & 15;
            const f32x4 d0 = *(const f32x4*)(dsk + g * 16 + a0), d1 = *(const f32x4*)(dsk + g * 16 + a0 + 4);
#pragma unroll
            for (int ai = 0; ai < 2; ++ai)
#pragma unroll
                for (int m = 0; m < 4; ++m) { const int mm = m0 + ai * 128 + m * 16; if (j == 2 && (ai == 1 || wr == 1)) continue;
                    float uu[8]; unpack8(*(const u32x4*)(AU + ((size_t)g * 576 + mm) * 768 + n), uu);
                    const f32x4 v0 = acc[ai][bj][m][0], v1 = acc[ai][bj][m][1];
                    float o[8];
#pragma unroll
                    for (int k = 0; k < 4; ++k) { o[k] = gelu_tanh_f(v0[k] + d0[k] * uu[k]); o[4 + k] = gelu_tanh_f(v1[k] + d1[k] * uu[4 + k]); }
                    *(u32x4*)(YG + (size_t)(mm * 32 + i) * 384 + g * 16 + a0) = pack8(o); __builtin_amdgcn_sched_barrier(0); } }
    }
};

struct EpiUp {
    static constexpr bool PERM = true;
    bf16_t* HID;
    DI void operator()(const f32x4 (&acc)[2][2][4][2], const Unit& u, int wr, int wc, int fr, int fq) const {
        const int row0 = u.arow + wr * 64 + fr, col0 = u.pn * 128 + wc * 32 + 8 * fq;
#pragma unroll
        for (int ai = 0; ai < 2; ++ai)
#pragma unroll
            for (int m = 0; m < 4; ++m) { const f32x4 g0 = acc[ai][0][m][0], g1 = acc[ai][0][m][1], u0 = acc[ai][1][m][0], u1 = acc[ai][1][m][1];
                float o[8];
#pragma unroll
                for (int k = 0; k < 4; ++k) { o[k] = silu_f(g0[k]) * u0[k]; o[4 + k] = silu_f(g1[k]) * u1[k]; }
                *(u32x4*)(HID + (size_t)(row0 + ai * 128 + m * 16) * 1024 + col0) = pack8(o); }
    }
};

struct EpiDown {
    static constexpr bool PERM = true;
    bf16_t* YE; const float* GV;
    DI void operator()(const f32x4 (&acc)[2][2][4][2], const Unit& u, int wr, int wc, int fr, int fq) const {
        const int row0 = u.arow + wr * 64 + fr, col0 = u.pn * 256 + wc * 32 + 8 * fq;
#pragma unroll
        for (int ai = 0; ai < 2; ++ai)
#pragma unroll
            for (int m = 0; m < 4; ++m) { const int row = row0 + ai * 128 + m * 16; const float gv = GV[row];
#pragma unroll
                for (int bj = 0; bj < 2; ++bj) { const f32x4 v0 = acc[ai][bj][m][0] * gv, v1 = acc[ai][bj][m][1] * gv;
                    u32x4 w; w.x = pk2(v0[0], v0[1]); w.y = pk2(v0[2], v0[3]); w.z = pk2(v1[0], v1[1]); w.w = pk2(v1[2], v1[3]);
                    *(u32x4*)(YE + (size_t)row * 1024 + col0 + bj * 128) = w; } }
    }
};

DI Unit mk_unit(int arow, int brow, int pm, int pn) { Unit u; u.arow = arow; u.brow = brow; u.pm = pm; u.pn = pn; return u; }
struct RowSkipOrder {
    int nN, G, c, skipctx, keep_lo, keep_hi, nmain, total;
    DI void init(int N, int G_, int c_, int skipctx_, int keep_lo_, int keep_hi_) { nN = N / 256; G = G_; c = c_; skipctx = skipctx_; keep_lo = keep_lo_; keep_hi = keep_hi_;
        nmain = (skipctx ? 64 : 72) * nN; total = nmain + (skipctx ? 8 * (keep_hi - keep_lo) : 0); }
    DI Unit next(int i) const {
        const int L0 = i * G + c; if (L0 >= total) return mk_unit(-1, 0, 0, 0);
        const int q = total / 8, r = total % 8, xcd = L0 % 8, off = L0 / 8;
        const int L = (xcd < r ? xcd * (q + 1) : r * (q + 1) + (xcd - r) * q) + off;
        const int nig = 8 * nN, gid = L / nig, rr = L % nig, lt = gid * 8 + (rr % 8);
        const int pm_main = skipctx ? ((lt / 8) * 9 + 1 + (lt % 8)) : lt, pn_main = rr / 8;
        const int Lc = L - nmain, pm_ctx = (Lc % 8) * 9, pn_ctx = keep_lo + Lc / 8;
        const bool main = L < nmain;
        const int pm = main ? pm_main : pm_ctx, pn = main ? pn_main : pn_ctx;
        return mk_unit(pm * 256, pn * 256, pm, pn);
    }
};
struct OrderS5S { int G, c; DI Unit next(int i) const { const int L = i * G + c; if (L >= 72) return mk_unit(-1, 0, 0, 0); const int g = L / 3, j = L % 3; return mk_unit(g * 576 + j * 256, g * 256, g, j); } };
struct OrderS5Y { int G, c; DI Unit next(int i) const { const int L = i * G + c; if (L >= 144) return mk_unit(-1, 0, 0, 0); const int g = L / 6, r = L % 6, j = r >> 1, nh = r & 1;
    return mk_unit(g * 576 + j * 256, g * 512 + nh * 256, g * 3 + j, nh); } };
struct OrderUp { int G, c, nJ; DI Unit next(int i) const { const int L = i * G + c; if (L >= 16 * nJ * 8) return mk_unit(-1, 0, 0, 0); const int n = L & 7, t = L >> 3, jt = t % nJ, e = t / nJ;
    return mk_unit(e * EROWS + jt * 256, e * 2048 + n * 256, e, n); } };
struct OrderDown { int G, c, nJ; DI Unit next(int i) const { const int L = i * G + c; if (L >= 16 * nJ * 4) return mk_unit(-1, 0, 0, 0); const int n = L & 3, t = L >> 2, jt = t % nJ, e = t / nJ;
    return mk_unit(e * EROWS + jt * 256, e * 1024 + n * 256, e, n); } };

struct Frame {
    LAS unsigned char* lds;
    int tid, lane, wave, G, vcu, gw, NGW;
};

template <class DstRow>
DI void tr_item(const float* W, int ldw, int nvalid, int nstore, int K, bf16_t* WT, int k0, int n0, const DstRow& drow, const float* kscale, LAS float* scr, int lane) {
#pragma unroll 8
    for (int i = 0; i < 32; ++i) { const int kk = 2 * i + (lane >> 5), n = n0 + (lane & 31);
        float v = (n < nvalid) ? W[(size_t)(k0 + kk) * ldw + n] : 0.f;
        if (kscale) v *= kscale[k0 + kk];
        scr[kk * 33 + (lane & 31)] = v; }
    LDS_WAIT(); asm volatile("" ::: "memory");
    const int c = lane & 7;
#pragma unroll
    for (int j = 0; j < 4; ++j) { const int n = (lane >> 3) + 8 * j; const LAS float* s = scr + (8 * c) * 33 + n;
        u32x4 o; o.x = pk2(s[0 * 33], s[1 * 33]); o.y = pk2(s[2 * 33], s[3 * 33]); o.z = pk2(s[4 * 33], s[5 * 33]); o.w = pk2(s[6 * 33], s[7 * 33]);
        if (n0 + n < nstore) *(u32x4*)(WT + (size_t)drow(n0 + n) * K + k0 + 8 * c) = o; }
    LDS_WAIT(); asm volatile("" ::: "memory");
}
struct DrIdent { int off; DI int operator()(int n) const { return off + n; } };
struct DrWin { DI int operator()(int n) const { return n < C_G ? n : n + (PA_W - C_G); } };
struct DrGU { int base; DI int operator()(int f) const { return base + (f >> 7) * 256 + (f & 127); } };

struct LayerIn {
    const float *w_in, *q_norm_g, *k_norm_g, *ssd_conv_w, *ssd_conv_b, *ssd_dt_bias, *ssd_a_log, *ssd_d, *ssd_norm_g;
    const float *s5_lre, *s5_lim, *s5_lstep, *s5_bre, *s5_bim, *s5_cre, *s5_cim, *s5_d, *s5_wglu, *s5_bglu, *sc_conv_w;
    const float *w_br_attn, *w_br_ssd, *w_br_s5, *w_br_sc, *w_out, *w_router, *w_gate, *w_up, *w_down, *norm_mix_g, *norm_ffn_g;
};

DI void prep_small_weights(const Frame& F, const LayerIn& P, unsigned char* ws) {
    LAS float* scr = (LAS float*)(F.lds + F.wave * 16384);
    bf16_t* WIN = (bf16_t*)(ws + W_WIN);
    constexpr int I_WIN = 16 * 241, I_PAD = 62, I_BA = 8 * 32, I_BB = 8 * 32, I_BC = 6 * 32, I_BD = 6 * 32, I_OUT = 16 * 32, I_GLU = 6 * 16;
    constexpr int NIT = I_WIN + I_PAD + I_BA + I_BB + I_BC + I_BD + I_OUT + I_GLU;
    for (int it = F.gw; it < NIT; it += F.NGW) {
        int r = it;
        if (r < I_WIN) { const int kb = r / 241, nb = r % 241; tr_item(P.w_in, NIN, NIN, NIN, 1024, WIN, kb * 64, nb * 32, DrWin{}, nullptr, scr, F.lane); continue; } r -= I_WIN;
        if (r < I_PAD) {
#pragma unroll
            for (int j = 0; j < 8; ++j) { const int idx = j * 64 + F.lane, row = C_G + r * 4 + (idx >> 7), ch = idx & 127; *(u32x4*)(WIN + (size_t)row * 1024 + ch * 8) = (u32x4){0u, 0u, 0u, 0u}; }
            continue; } r -= I_PAD;
        if (r < I_BA) { tr_item(P.w_br_attn, 1024, 1024, 1024, 512, (bf16_t*)(ws + W_BRA), (r / 32) * 64, (r % 32) * 32, DrIdent{0}, nullptr, scr, F.lane); continue; } r -= I_BA;
        if (r < I_BB) { tr_item(P.w_br_ssd, 1024, 1024, 1024, 512, (bf16_t*)(ws + W_BRB), (r / 32) * 64, (r % 32) * 32, DrIdent{0}, P.ssd_norm_g, scr, F.lane); continue; } r -= I_BB;
        if (r < I_BC) { tr_item(P.w_br_s5, 1024, 1024, 1024, 384, (bf16_t*)(ws + W_BRC), (r / 32) * 64, (r % 32) * 32, DrIdent{0}, nullptr, scr, F.lane); continue; } r -= I_BC;
        if (r < I_BD) { tr_item(P.w_br_sc, 1024, 1024, 1024, 384, (bf16_t*)(ws + W_BRD), (r / 32) * 64, (r % 32) * 32, DrIdent{0}, nullptr, scr, F.lane); continue; } r -= I_BD;
        if (r < I_OUT) { tr_item(P.w_out, 1024, 1024, 1024, 1024, (bf16_t*)(ws + W_OUT), (r / 32) * 64, (r % 32) * 32, DrIdent{0}, nullptr, scr, F.lane); continue; } r -= I_OUT;
        tr_item(P.s5_wglu, 384, 384, 512, 384, (bf16_t*)(ws + W_GLU), (r / 16) * 64, (r % 16) * 32, DrIdent{0}, nullptr, scr, F.lane);
    }
}
DI void prep_expert_weights(const Frame& F, const LayerIn& P, unsigned char* ws) {
    LAS float* scr = (LAS float*)(F.lds + F.wave * 16384);
    constexpr int PER = 16 * 32, NIT = 3 * 16 * PER;
    for (int it = F.gw; it < NIT; it += F.NGW) {
        const int which = it / (16 * PER), r = it % (16 * PER), e = r / PER, q = r % PER, k0 = (q / 32) * 64, n0 = (q % 32) * 32;
        if (which == 0) tr_item(P.w_gate + (size_t)e * 1024 * 1024, 1024, 1024, 1024, 1024, (bf16_t*)(ws + WS_WGU), k0, n0, DrGU{e * 2048}, nullptr, scr, F.lane);
        else if (which == 1) tr_item(P.w_up + (size_t)e * 1024 * 1024, 1024, 1024, 1024, 1024, (bf16_t*)(ws + WS_WGU), k0, n0, DrGU{e * 2048 + 128}, nullptr, scr, F.lane);
        else tr_item(P.w_down + (size_t)e * 1024 * 1024, 1024, 1024, 1024, 1024, (bf16_t*)(ws + WS_WD), k0, n0, DrIdent{e * 1024}, nullptr, scr, F.lane);
    }
}

DI void prep_mod(const Frame& F, const float* c, const float* c_ctx, const float* w_mod, const float* b_mod, float* MOD) {
    LAS float* red = (LAS float*)F.lds;
    for (int it = blockIdx.x; it < 2 * 96; it += F.G) {
        const int l = it / 96, cb = it % 96, n = cb * 64 + F.lane;
        const float* W = w_mod + (size_t)l * 1024 * 6144;
        float acc[9];
#pragma unroll
        for (int r = 0; r < 9; ++r) acc[r] = 0.f;
        const int kbeg = F.wave * 128;
#pragma unroll 4
        for (int kk = 0; kk < 128; ++kk) { const int k = kbeg + kk; const float w = W[(size_t)k * 6144 + n];
#pragma unroll
            for (int r = 0; r < 9; ++r) { const float cv = (r < 8) ? c[r * 1024 + k] : c_ctx[k]; acc[r] += silu_f(cv) * w; } }
#pragma unroll
        for (int r = 0; r < 9; ++r) red[(F.wave * 9 + r) * 64 + F.lane] = acc[r];
        __syncthreads();
        for (int o = F.tid; o < 9 * 64; o += 512) { const int r = o >> 6, ln = o & 63; float s = 0.f;
#pragma unroll
            for (int w = 0; w < 8; ++w) s += red[(w * 9 + r) * 64 + ln];
            MOD[((size_t)l * 9 + r) * 6144 + cb * 64 + ln] = s + b_mod[l * 6144 + cb * 64 + ln]; }
        __syncthreads();
    }
}
DI void prep_rope(const Frame& F, float* ROPE) {
    for (int idx = blockIdx.x * 512 + F.tid; idx < 2048 * 32; idx += F.G * 512) {
        const int t = idx >> 5, j = idx & 31, i = j & 15;
        const float inv = powf(10000.f, -(float)(2 * i) / 32.f);
        const float pos = (j < 16) ? (float)(t >> 6) : (float)(t & 63);
        const float a = pos * inv;
        ROPE[t * 64 + j] = cosf(a); ROPE[t * 64 + 32 + j] = sinf(a);
    }
}

DI void prep_s5(const Frame& F, const LayerIn& P, unsigned char* ws) {
    LAS float* pw = (LAS float*)F.lds;
    LAS float* bb = pw + 8448;
    LAS float* Kt = bb + 4096;
    for (int g = blockIdx.x; g < 24; g += F.G) {
        if (F.tid < 128) { const int d = F.tid >> 6, p = F.tid & 63;
            const float step = __expf(P.s5_lstep[d * 24 + g]);
            const float lr = P.s5_lre[(d * 24 + g) * 64 + p], li = P.s5_lim[(d * 24 + g) * 64 + p];
            const float th = li * step, sh = sinf(0.5f * th);
            const float mag = expf(lr * step), abr = mag * cosf(th), abi = mag * sinf(th);
            const float nr = expm1f(lr * step) - 2.f * mag * sh * sh, ni = abi;
            const float den = lr * lr + li * li;
            const float cr = (nr * lr + ni * li) / den, ci = (ni * lr - nr * li) / den;
            (void)abr;
            for (int j = 0; j < 16; ++j) { const float br = P.s5_bre[((size_t)g * 64 + p) * 16 + j], bi = P.s5_bim[((size_t)g * 64 + p) * 16 + j];
                bb[((d * 64 + p) * 16 + j) * 2 + 0] = cr * br - ci * bi; bb[((d * 64 + p) * 16 + j) * 2 + 1] = cr * bi + ci * br; }
            for (int tau = 0; tau <= 32; ++tau) { const float m = expf(lr * step * (float)tau), a = th * (float)tau;
                pw[((d * 64 + p) * 33 + tau) * 2 + 0] = m * cosf(a); pw[((d * 64 + p) * 33 + tau) * 2 + 1] = m * sinf(a); } }
        __syncthreads();
        for (int o = F.tid; o < 2 * 32 * 256; o += 512) { const int d = o >> 13, tau = (o >> 8) & 31, a = (o >> 4) & 15, b = o & 15; float s = 0.f;
            for (int p = 0; p < 64; ++p) { const float cre = P.s5_cre[((size_t)g * 16 + a) * 64 + p], cim = P.s5_cim[((size_t)g * 16 + a) * 64 + p];
                const float lr_ = pw[((d * 64 + p) * 33 + tau) * 2], li_ = pw[((d * 64 + p) * 33 + tau) * 2 + 1];
                const float br = bb[((d * 64 + p) * 16 + b) * 2], bi = bb[((d * 64 + p) * 16 + b) * 2 + 1];
                const float wr_ = lr_ * br - li_ * bi, wi_ = lr_ * bi + li_ * br;
                s += cre * wr_ - cim * wi_; }
            Kt[o] = s; }
        __syncthreads();
        bf16_t* TQ = (bf16_t*)(ws + W_TQ) + (size_t)g * 512 * 768;
        for (int o = F.tid; o < 512 * 96; o += 512) { const int row = o / 96, ch = o % 96, i = row >> 4, a = row & 15; float v[8];
            if (ch < 64) { const int j = ch >> 1, b0 = (ch & 1) * 8;
#pragma unroll
                for (int k = 0; k < 8; ++k) { float s = 0.f;
                    if (j <= i) s += Kt[((0 * 32 + (i - j)) * 16 + a) * 16 + b0 + k];
                    if (j >= i) s += Kt[((1 * 32 + (j - i)) * 16 + a) * 16 + b0 + k];
                    v[k] = s; } }
            else { const int cc = (ch - 64) * 8, d = cc >> 7, ri = (cc >> 6) & 1, p0 = cc & 63; const int tau = d == 0 ? (i + 1) : (32 - i);
#pragma unroll
                for (int k = 0; k < 8; ++k) { const int p = p0 + k;
                    const float cre = P.s5_cre[((size_t)g * 16 + a) * 64 + p], cim = P.s5_cim[((size_t)g * 16 + a) * 64 + p];
                    const float ar = pw[((d * 64 + p) * 33 + tau) * 2], ai = pw[((d * 64 + p) * 33 + tau) * 2 + 1];
                    v[k] = ri == 0 ? (cre * ar - cim * ai) : -(cre * ai + cim * ar); } }
            *(u32x4*)(TQ + (size_t)row * 768 + ch * 8) = pack8(v); }
        bf16_t* PP = (bf16_t*)(ws + W_P) + (size_t)g * 256 * 512;
        for (int o = F.tid; o < 256 * 64; o += 512) { const int row = o >> 6, ch = o & 63, d = row >> 7, ri = (row >> 6) & 1, p = row & 63, j = ch >> 1, b0 = (ch & 1) * 8;
            const int tau = d == 0 ? (31 - j) : j;
            const float ar = pw[((d * 64 + p) * 33 + tau) * 2], ai = pw[((d * 64 + p) * 33 + tau) * 2 + 1]; float v[8];
#pragma unroll
            for (int k = 0; k < 8; ++k) { const float br = bb[((d * 64 + p) * 16 + b0 + k) * 2], bi = bb[((d * 64 + p) * 16 + b0 + k) * 2 + 1];
                v[k] = ri == 0 ? (ar * br - ai * bi) : (ar * bi + ai * br); }
            *(u32x4*)(PP + (size_t)row * 512 + ch * 8) = pack8(v); }
        __syncthreads();
    }
}

struct RowCtx { int R, b, p, isctx, mrow; };
DI RowCtx row_ctx(int R) { RowCtx r; r.R = R; r.b = R / PB; r.p = R - r.b * PB; r.isctx = r.p < CTXL; r.mrow = r.isctx ? 8 : r.b; return r; }

DI void moe_combine(const Frame& F, const RowCtx& rc, f32x4 (&x)[4], const int* INV, const bf16_t* YE, const float* mod_prev  ) {
    const int myinv = (F.lane < 16) ? INV[(size_t)rc.R * 16 + F.lane] : -1;
    f32x4 s[4];
#pragma unroll
    for (int j = 0; j < 4; ++j) s[j] = (f32x4){0.f, 0.f, 0.f, 0.f};
    for (int e = 0; e < 16; ++e) { const int er = __shfl(myinv, e);
        if (er >= 0) { const bf16_t* yr = YE + (size_t)er * 1024 + 4 * F.lane;
#pragma unroll
            for (int j = 0; j < 4; ++j) { const u32x2 w = *(const u32x2*)(yr + j * 256); s[j][0] += bflo(w.x); s[j][1] += bfhi(w.x); s[j][2] += bflo(w.y); s[j][3] += bfhi(w.y); } } }
    const float* g5 = mod_prev + (size_t)rc.mrow * 6144 + 5 * 1024 + 4 * F.lane;
#pragma unroll
    for (int j = 0; j < 4; ++j) x[j] += *(const f32x4*)(g5 + j * 256) * s[j];
}
DI float row_rstd(const f32x4 (&x)[4]) {
    float ss = 0.f;
#pragma unroll
    for (int j = 0; j < 4; ++j) ss += (x[j][0] * x[j][0] + x[j][1] * x[j][1]) + (x[j][2] * x[j][2] + x[j][3] * x[j][3]);
    return 1.0f / sqrtf(wave_sum(ss) * (1.f / 1024.f) + RMS_EPS);
}
DI void row_modulate(const Frame& F, const f32x4 (&x)[4], float rstd, const float* g, const float* shift, const float* scale, f32x4 (&h)[4]) {
#pragma unroll
    for (int j = 0; j < 4; ++j) { const int c = j * 256 + 4 * F.lane; const f32x4 gv = *(const f32x4*)(g + c), sh = *(const f32x4*)(shift + c), sc = *(const f32x4*)(scale + c);
        h[j] = x[j] * rstd * gv * (sc + 1.0f) + sh; }
}
DI void row_store_bf16(const Frame& F, const f32x4 (&h)[4], bf16_t* dst) {
#pragma unroll
    for (int j = 0; j < 4; ++j) { u32x2 w; w.x = pk2(h[j][0], h[j][1]); w.y = pk2(h[j][2], h[j][3]); *(u32x2*)(dst + j * 256 + 4 * F.lane) = w; }
}

DI void phase_norm1(const Frame& F, int layer, const float* x_in, const float* ctx_in, float* X, bf16_t* H1, const float* MOD, const float* gmix, const int* INV, const bf16_t* YE) {
    const float* modl = MOD + (size_t)layer * 9 * 6144;
    for (int R = F.gw; R < MROWS; R += F.NGW) {
        const RowCtx rc = row_ctx(R);
        const float* src = (layer == 0) ? (rc.isctx ? ctx_in + ((size_t)rc.b * CTXL + rc.p) * 1024 : x_in + ((size_t)rc.b * SEQ + (rc.p - CTXL)) * 1024) : X + (size_t)R * 1024;
        f32x4 x[4];
#pragma unroll
        for (int j = 0; j < 4; ++j) x[j] = *(const f32x4*)(src + j * 256 + 4 * F.lane);
        if (layer > 0) moe_combine(F, rc, x, INV, YE, MOD + (size_t)(layer - 1) * 9 * 6144);
#pragma unroll
        for (int j = 0; j < 4; ++j) *(f32x4*)(X + (size_t)R * 1024 + j * 256 + 4 * F.lane) = x[j];
        const float rstd = row_rstd(x);
        f32x4 h[4]; row_modulate(F, x, rstd, gmix, modl + (size_t)rc.mrow * 6144, modl + (size_t)rc.mrow * 6144 + 1024, h);
        row_store_bf16(F, h, H1 + (size_t)R * 1024);
    }
}
DI void phase_final(const Frame& F, const float* X, float* out, const float* MOD, const float* gfin, const int* INV, const bf16_t* YE) {
    for (int q = F.gw; q < NB * SEQ; q += F.NGW) {
        const int b = q / SEQ, t = q - b * SEQ, R = b * PB + CTXL + t;
        const RowCtx rc = row_ctx(R);
        f32x4 x[4];
#pragma unroll
        for (int j = 0; j < 4; ++j) x[j] = *(const f32x4*)(X + (size_t)R * 1024 + j * 256 + 4 * F.lane);
        moe_combine(F, rc, x, INV, YE, MOD + (size_t)1 * 9 * 6144);
        const float rstd = row_rstd(x);
#pragma unroll
        for (int j = 0; j < 4; ++j) { const int c = j * 256 + 4 * F.lane; *(f32x4*)(out + (size_t)q * 1024 + c) = x[j] * rstd * *(const f32x4*)(gfin + c); }
    }
}

DI void phase_norm2(const Frame& F, int layer, bool skipctx, const float* X, bf16_t* H2, const float* MOD, const float* gffn, const float* w_router, float* AFF) {
    LAS float* wl = (LAS float*)F.lds;
    for (int idx = F.tid; idx < 16384; idx += 512) wl[(idx & 15) * 1024 + (idx >> 4)] = w_router[idx];
    __syncthreads();
    const float* modl = MOD + (size_t)layer * 9 * 6144;
    for (int R = F.gw; R < MROWS; R += F.NGW) {
        const RowCtx rc = row_ctx(R);
        if (skipctx && rc.isctx) continue;
        f32x4 x[4];
#pragma unroll
        for (int j = 0; j < 4; ++j) x[j] = *(const f32x4*)(X + (size_t)R * 1024 + j * 256 + 4 * F.lane);
        const float rstd = row_rstd(x);
        f32x4 h[4]; row_modulate(F, x, rstd, gffn, modl + (size_t)rc.mrow * 6144 + 3 * 1024, modl + (size_t)rc.mrow * 6144 + 4 * 1024, h);
        row_store_bf16(F, h, H2 + (size_t)R * 1024);
        float lg[16];
#pragma unroll
        for (int e = 0; e < 16; ++e) { float s = 0.f;
#pragma unroll
            for (int j = 0; j < 4; ++j) { const f32x4 w = *(const LAS f32x4*)(wl + e * 1024 + j * 256 + 4 * F.lane); s += (h[j][0] * w[0] + h[j][1] * w[1]) + (h[j][2] * w[2] + h[j][3] * w[3]); }
            lg[e] = wave_sum(s); }
        float mx = lg[0];
#pragma unroll
        for (int e = 1; e < 16; ++e) mx = fmaxf(mx, lg[e]);
        float den = 0.f, mine = 0.f;
#pragma unroll
        for (int e = 0; e < 16; ++e) { const float ex = expf(lg[e] - mx); den += ex; mine = (F.lane == e) ? ex : mine; }
        if (F.lane < 16) AFF[((size_t)rc.b * 16 + F.lane) * PB + rc.p] = mine / den;
    }
    __syncthreads();
}

DI int block_exscan(const Frame& F, int v, LAS int* wtot, int& total) {
    int incl = v;
#pragma unroll
    for (int o = 1; o < 64; o <<= 1) { const int t = __shfl_up(incl, o); if (F.lane >= o) incl += t; }
    if (F.lane == 63) wtot[F.wave] = incl;
    __syncthreads();
    int base = 0; total = 0;
#pragma unroll
    for (int w = 0; w < 8; ++w) { const int x = wtot[w]; if (w < F.wave) base += x; total += x; }
    __syncthreads();
    return base + incl - v;
}
DI void phase_topk(const Frame& F, int nitems, const float* AFF, int* SRC, float* GV, int* INV) {
    LAS int* wcnt = (LAS int*)F.lds;
    LAS int* wtot = wcnt + 16;
    for (int it = blockIdx.x; it < nitems; it += F.G) {
        const int isctx = it >= 128, be = it & 127, b = be >> 4, e = be & 15;
        const int n = isctx ? CTXL : SEQ, cap = isctx ? 32 : 256, p0 = isctx ? 0 : CTXL;
        const float* a = AFF + ((size_t)b * 16 + e) * PB + p0;
        unsigned v[4]; float av[4];
#pragma unroll
        for (int k = 0; k < 4; ++k) { const int idx = 4 * F.tid + k; av[k] = idx < n ? a[idx] : 0.f; v[k] = __builtin_bit_cast(unsigned, av[k]); }
        unsigned prefix = 0u;
        for (int bit = 30; bit >= 0; --bit) {
            const unsigned cand = prefix | (1u << bit);
            int c = 0;
#pragma unroll
            for (int k = 0; k < 4; ++k) c += __popcll(__ballot(v[k] >= cand));
            LAS int* wc = wcnt + (bit & 1) * 8;
            if (F.lane == 0) wc[F.wave] = c;
            __syncthreads();
            int tot = 0;
#pragma unroll
            for (int w = 0; w < 8; ++w) tot += wc[w];
            if (tot >= cap) prefix = cand;
        }
        __syncthreads();
        int ngt_t = 0, neq_t = 0;
#pragma unroll
        for (int k = 0; k < 4; ++k) { ngt_t += (v[k] > prefix) ? 1 : 0; neq_t += (v[k] == prefix) ? 1 : 0; }
        int ngt_total, neq_total;
        (void)block_exscan(F, ngt_t, wtot, ngt_total);
        int eq_rank = block_exscan(F, neq_t, wtot, neq_total);
        const int eq_take = cap - ngt_total;
        int sel[4], nsel_t = 0;
#pragma unroll
        for (int k = 0; k < 4; ++k) { int s = 0; if (v[k] > prefix) s = 1; else if (v[k] == prefix) { s = (eq_rank < eq_take) ? 1 : 0; ++eq_rank; } sel[k] = s; nsel_t += s; }
        int nsel_total;
        int slot = block_exscan(F, nsel_t, wtot, nsel_total);
        const int ebase = e * EROWS + (isctx ? 2048 + b * 32 : b * 256);
#pragma unroll
        for (int k = 0; k < 4; ++k) { const int idx = 4 * F.tid + k;
            if (idx < n) { const int R = b * PB + p0 + idx;
                if (sel[k]) { const int er = ebase + slot; ++slot; SRC[er] = R; GV[er] = av[k]; INV[(size_t)R * 16 + e] = er; }
                else INV[(size_t)R * 16 + e] = -1; } }
        __syncthreads();
    }
}
DI void phase_gather(const Frame& F, int rows_per_expert, const int* SRC, const bf16_t* H2, bf16_t* XG) {
    const int total = 16 * rows_per_expert;
    for (int q = F.gw; q < total; q += F.NGW) {
        const int e = q / rows_per_expert, s = q - e * rows_per_expert, er = e * EROWS + s;
        const int R = SRC[er];
        const u32x4 v0 = *(const u32x4*)(H2 + (size_t)R * 1024 + 8 * F.lane), v1 = *(const u32x4*)(H2 + (size_t)R * 1024 + 512 + 8 * F.lane);
        *(u32x4*)(XG + (size_t)er * 1024 + 8 * F.lane) = v0; *(u32x4*)(XG + (size_t)er * 1024 + 512 + 8 * F.lane) = v1;
    }
}

DI void phase_elem(const Frame& F, const LayerIn& P, const bf16_t* PA, const float* ROPE, bf16_t* QN, bf16_t* KN, bf16_t* XBC, float* DT, bf16_t* AU, bf16_t* YD) {
    const int l = F.lane;
    for (int R = F.gw; R < MROWS; R += F.NGW) {
        const RowCtx rc = row_ctx(R);
        const bf16_t* pr = PA + (size_t)R * PA_W;
        const bool has_prev = (rc.p != 0) && (rc.p != CTXL), has_next = (rc.p != CTXL - 1) && (rc.p != PB - 1);
        const int t = rc.p - CTXL;
#pragma unroll
        for (int which = 0; which < 2; ++which) {
            const int ll = which == 0 ? l : (l & 15);
            float v[8]; unpack8(*(const u32x4*)(pr + (which == 0 ? C_Q : C_K) + ll * 8), v);
            float ss = 0.f;
#pragma unroll
            for (int k = 0; k < 8; ++k) ss += v[k] * v[k];
            ss += __shfl_xor(ss, 1); ss += __shfl_xor(ss, 2); ss += __shfl_xor(ss, 4);
            const float rstd = 1.0f / sqrtf(ss * (1.f / 64.f) + RMS_EPS);
            const float* gn = (which == 0 ? P.q_norm_g : P.k_norm_g) + (ll & 7) * 8;
#pragma unroll
            for (int k = 0; k < 8; ++k) v[k] = v[k] * rstd * gn[k];
            float o[8];
            if (!rc.isctx) {
                const int hb = (ll & 7) >> 2, i0 = (ll & 1) * 8; const bool isx2 = (ll & 2) != 0;
                const float* cs = ROPE + (size_t)t * 64 + hb * 16 + i0;
#pragma unroll
                for (int k = 0; k < 8; ++k) { const float pv = __shfl_xor(v[k], 2); const float c = cs[k], s = cs[32 + k]; o[k] = isx2 ? (v[k] * c + pv * s) : (v[k] * c - pv * s); }
            } else {
#pragma unroll
                for (int k = 0; k < 8; ++k) o[k] = v[k];
            }
            if (which == 0) {
#pragma unroll
                for (int k = 0; k < 8; ++k) o[k] *= ATT_C2;
                *(u32x4*)(QN + (size_t)R * 512 + l * 8) = pack8(o);
            } else if (l < 16) *(u32x4*)(KN + (size_t)R * 128 + l * 8) = pack8(o);
        }
        for (int ch8 = l; ch8 < 96; ch8 += 64) {
            const int ch = ch8 * 8; float cur[8], prv[8], nxt[8];
            unpack8(*(const u32x4*)(pr + C_XBC + ch), cur);
            if (has_prev) unpack8(*(const u32x4*)(pr - PA_W + C_XBC + ch), prv); else {
#pragma unroll
                for (int k = 0; k < 8; ++k) prv[k] = 0.f; }
            if (has_next) unpack8(*(const u32x4*)(pr + PA_W + C_XBC + ch), nxt); else {
#pragma unroll
                for (int k = 0; k < 8; ++k) nxt[k] = 0.f; }
            float o[8];
#pragma unroll
            for (int k = 0; k < 8; ++k) { const float a = P.ssd_conv_w[ch + k] * prv[k] + P.ssd_conv_w[768 + ch + k] * cur[k] + P.ssd_conv_w[1536 + ch + k] * nxt[k] + P.ssd_conv_b[ch + k]; o[k] = silu_f(a); }
            *(u32x4*)(XBC + (size_t)R * 768 + ch) = pack8(o);
        }
        if (l < 16) { const int d = l >> 3, h = l & 7; DT[((size_t)d * MROWS + R) * 8 + h] = softplus_f(bf2f(pr[C_DT + h]) + P.ssd_dt_bias[d * 8 + h]); }
        if (l < 48) {
            const int g = l >> 1, a0 = (l & 1) * 8;
            *(u32x4*)(AU + ((size_t)g * 576 + (R >> 5)) * 768 + (R & 31) * 16 + a0) = *(const u32x4*)(pr + C_U + l * 8);
            const int ch = l * 8; float sb[8], g0[8], h0[8], m_c[8], m_p[8], m_n[8];
            unpack8(*(const u32x4*)(pr + C_SB + ch), sb);
            unpack8(*(const u32x4*)(pr + C_SG + ch), g0); unpack8(*(const u32x4*)(pr + C_SH + ch), h0);
#pragma unroll
            for (int k = 0; k < 8; ++k) m_c[k] = g0[k] * h0[k];
            if (has_prev) { unpack8(*(const u32x4*)(pr - PA_W + C_SG + ch), g0); unpack8(*(const u32x4*)(pr - PA_W + C_SH + ch), h0);
#pragma unroll
                for (int k = 0; k < 8; ++k) m_p[k] = g0[k] * h0[k]; } else {
#pragma unroll
                for (int k = 0; k < 8; ++k) m_p[k] = 0.f; }
            if (has_next) { unpack8(*(const u32x4*)(pr + PA_W + C_SG + ch), g0); unpack8(*(const u32x4*)(pr + PA_W + C_SH + ch), h0);
#pragma unroll
                for (int k = 0; k < 8; ++k) m_n[k] = g0[k] * h0[k]; } else {
#pragma unroll
                for (int k = 0; k < 8; ++k) m_n[k] = 0.f; }
            float o[8];
#pragma unroll
            for (int k = 0; k < 8; ++k) o[k] = sb[k] * (P.sc_conv_w[ch + k] * m_p[k] + P.sc_conv_w[384 + ch + k] * m_c[k] + P.sc_conv_w[768 + ch + k] * m_n[k]);
            *(u32x4*)(YD + (size_t)R * 384 + ch) = pack8(o);
        }
    }
}

typedef short v4i16_t __attribute__((ext_vector_type(4)));
DI int img_off(int row, int chunk) { return row * 128 + ((chunk ^ (row & 7)) << 4); }
DI s16x4 tr_read4(const LAS unsigned char* p) { return __builtin_bit_cast(s16x4, __builtin_amdgcn_ds_read_tr16_b64_v4i16((LAS v4i16_t*)p)); }
DI bf16x8 cat8(s16x4 lo, s16x4 hi) { return (bf16x8){lo[0], lo[1], lo[2], lo[3], hi[0], hi[1], hi[2], hi[3]}; }
DI unsigned cvtpk(float lo, float hi) { typedef __bf16 bf2 __attribute__((ext_vector_type(2))); f32x2 v = {lo, hi}; bf2 b = __builtin_convertvector(v, bf2); return __builtin_bit_cast(unsigned, b); }
#define MFMA32(a, b, c) __builtin_amdgcn_mfma_f32_32x32x16_bf16((a), (b), (c), 0, 0, 0)
DI int crow(int r, int hh) { return (r & 3) + 8 * (r >> 2) + 4 * hh; }

constexpr int SSD_XH = 0, SSD_BM = 65536, SSD_CM = 81920, SSD_ARR = 131072;
DI void ssd_load_images(const Frame& F, const bf16_t* XBC, int R0, int g, bool with_c) {
#pragma unroll
    for (int it = 0; it < 8; ++it) { const int idx = it * 512 + F.tid, h4 = idx >> 10, row = (idx >> 3) & 127, ch = idx & 7;
        *(LAS u32x4*)(F.lds + SSD_XH + h4 * 16384 + img_off(row, ch)) = *(const u32x4*)(XBC + (size_t)(R0 + row) * 768 + g * 256 + h4 * 64 + ch * 8); }
#pragma unroll
    for (int it = 0; it < 2; ++it) { const int idx = it * 512 + F.tid, row = idx >> 3, ch = idx & 7;
        *(LAS u32x4*)(F.lds + SSD_BM + img_off(row, ch)) = *(const u32x4*)(XBC + (size_t)(R0 + row) * 768 + 512 + g * 64 + ch * 8);
        if (with_c) *(LAS u32x4*)(F.lds + SSD_CM + img_off(row, ch)) = *(const u32x4*)(XBC + (size_t)(R0 + row) * 768 + 640 + g * 64 + ch * 8); }
}
struct Series { float dt0, dt1, cs0, cs1, ecs0, ecs1, tot; };
DI Series ssd_series(const Frame& F, const float* DT, const float* a_log, int R0, int h, int d) {
    Series s; const float a = -__expf(a_log[d * 8 + h]);
    s.dt0 = DT[((size_t)d * MROWS + R0 + 2 * F.lane) * 8 + h]; s.dt1 = DT[((size_t)d * MROWS + R0 + 2 * F.lane + 1) * 8 + h];
    const float ad0 = s.dt0 * a, ad1 = s.dt1 * a, pair = ad0 + ad1; float incl = pair;
#pragma unroll
    for (int o = 1; o < 64; o <<= 1) { const float t = __shfl_up(incl, o); if (F.lane >= o) incl += t; }
    const float excl = incl - pair;
    s.cs0 = excl + ad0; s.cs1 = incl; s.ecs0 = excl; s.ecs1 = excl + ad0; s.tot = __shfl(incl, 63);
    return s;
}

DI void ssd_chunk_states(const Frame& F, const LayerIn& P, const bf16_t* XBC, const float* DT, float* S, float* TOT) {
    LAS float* W = (LAS float*)(F.lds + SSD_ARR);
    const int lane = F.lane, hh = lane >> 5, q = (lane & 15) >> 2, pp = lane & 3, blk = (lane >> 4) & 1;
    const int h4 = F.wave & 3, d = F.wave >> 2;
    for (int it = blockIdx.x; it < 288; it += F.G) {
        const int b = it / 36, r = it % 36, c = r >> 1, g = r & 1, R0 = b * PB + c * 128, h = 4 * g + h4;
        ssd_load_images(F, XBC, R0, g, false);
        const Series s = ssd_series(F, DT, P.ssd_a_log, R0, h, d);
        float w0, w1;
        if (d == 0) { w0 = s.dt0 * __expf(s.tot - s.cs0); w1 = s.dt1 * __expf(s.tot - s.cs1); } else { w0 = s.dt0 * __expf(s.ecs0); w1 = s.dt1 * __expf(s.ecs1); }
        *(LAS f32x2*)(W + F.wave * 128 + 2 * lane) = (f32x2){w0, w1};
        if (lane == 0) TOT[(((size_t)b * 18 + c) * 8 + h) * 2 + d] = s.tot;
        __syncthreads();
        f32x16 acc[2][2];
#pragma unroll
        for (int i = 0; i < 2; ++i)
#pragma unroll
            for (int j = 0; j < 2; ++j)
#pragma unroll
                for (int k = 0; k < 16; ++k) acc[i][j][k] = 0.f;
        const LAS unsigned char* xh = F.lds + SSD_XH + h4 * 16384;
        const LAS unsigned char* bm = F.lds + SSD_BM;
#pragma unroll 2
        for (int st = 0; st < 8; ++st) {
            const int row = 16 * st + 8 * hh + q;
            const f32x4 wa = *(const LAS f32x4*)(W + F.wave * 128 + 16 * st + 8 * hh), wb = *(const LAS f32x4*)(W + F.wave * 128 + 16 * st + 8 * hh + 4);
            bf16x8 af[2], bfr[2];
#pragma unroll
            for (int t = 0; t < 2; ++t) { const int chunk = t * 4 + 2 * blk + (pp >> 1), within = 8 * (pp & 1);
                af[t] = cat8(tr_read4(bm + img_off(row, chunk) + within), tr_read4(bm + img_off(row + 4, chunk) + within));
                const s16x4 lo = tr_read4(xh + img_off(row, chunk) + within), hi = tr_read4(xh + img_off(row + 4, chunk) + within);
                u32x4 pw;
                pw.x = cvtpk(bf2f((bf16_t)lo[0]) * wa[0], bf2f((bf16_t)lo[1]) * wa[1]); pw.y = cvtpk(bf2f((bf16_t)lo[2]) * wa[2], bf2f((bf16_t)lo[3]) * wa[3]);
                pw.z = cvtpk(bf2f((bf16_t)hi[0]) * wb[0], bf2f((bf16_t)hi[1]) * wb[1]); pw.w = cvtpk(bf2f((bf16_t)hi[2]) * wb[2], bf2f((bf16_t)hi[3]) * wb[3]);
                bfr[t] = __builtin_bit_cast(bf16x8, pw); }
#pragma unroll
            for (int nt = 0; nt < 2; ++nt)
#pragma unroll
                for (int pt = 0; pt < 2; ++pt) acc[nt][pt] = MFMA32(af[nt], bfr[pt], acc[nt][pt]);
        }
        float* Sb = S + ((((size_t)b * 18 + c) * 8 + h) * 2 + d) * 4096;
#pragma unroll
        for (int nt = 0; nt < 2; ++nt)
#pragma unroll
            for (int pt = 0; pt < 2; ++pt)
#pragma unroll
                for (int q4 = 0; q4 < 4; ++q4) { const int p = pt * 32 + (lane & 31), n0 = nt * 32 + 8 * q4 + 4 * hh;
                    *(f32x4*)(Sb + p * 64 + n0) = (f32x4){acc[nt][pt][4 * q4], acc[nt][pt][4 * q4 + 1], acc[nt][pt][4 * q4 + 2], acc[nt][pt][4 * q4 + 3]}; }
        __syncthreads();
    }
}

DI void ssd_recurrence(const Frame& F, const float* S, const float* TOT, bf16_t* HIN) {
    for (int gi = blockIdx.x * 512 + F.tid; gi < 128 * 1024; gi += F.G * 512) {
        const int bhd = gi >> 10, e4 = (gi & 1023) * 4, b = bhd >> 4, h = (bhd >> 1) & 7, d = bhd & 1;
        f32x4 H = (f32x4){0.f, 0.f, 0.f, 0.f};
#pragma unroll 6
        for (int k = 0; k < 18; ++k) {
            const int c = (d == 0) ? k : (k < 2 ? 1 - k : 19 - k);
            const size_t st = (((size_t)b * 18 + c) * 8 + h) * 2 + d;
            u32x2 w; w.x = pk2(H[0], H[1]); w.y = pk2(H[2], H[3]);
            *(u32x2*)(HIN + st * 4096 + e4) = w;
            const f32x4 sv = *(const f32x4*)(S + st * 4096 + e4);
            H = H * __expf(TOT[st]) + sv;
        }
    }
}

DI void ssd_output(const Frame& F, const LayerIn& P, const bf16_t* XBC, const bf16_t* PA, const float* DT, const bf16_t* HIN, bf16_t* YB, float* SSQ, bool skipctx) {
    LAS float* ARR = (LAS float*)(F.lds + SSD_ARR);
    const int lane = F.lane, hh = lane >> 5, q = (lane & 15) >> 2, pp = lane & 3, blk = (lane >> 4) & 1, l31 = lane & 31;
    for (int it = blockIdx.x; it < 288; it += F.G) {
        const int b = it / 36, r_ = it % 36, c = r_ >> 1, g = r_ & 1, R0 = b * PB + c * 128;
        if (skipctx && c < 2) continue;
        ssd_load_images(F, XBC, R0, g, true);
        { const int h4 = F.wave & 3, d = F.wave >> 2, h = 4 * g + h4;
          const Series s = ssd_series(F, DT, P.ssd_a_log, R0, h, d);
          LAS float* A = ARR + h4 * 768;
          if (d == 0) { *(LAS f32x2*)(A + 0 * 128 + 2 * lane) = (f32x2){s.cs0, s.cs1}; *(LAS f32x2*)(A + 1 * 128 + 2 * lane) = (f32x2){s.dt0, s.dt1};
                        *(LAS f32x2*)(A + 2 * 128 + 2 * lane) = (f32x2){__expf(s.cs0), __expf(s.cs1)}; }
          else { *(LAS f32x2*)(A + 3 * 128 + 2 * lane) = (f32x2){s.ecs0, s.ecs1}; *(LAS f32x2*)(A + 4 * 128 + 2 * lane) = (f32x2){s.dt0, s.dt1};
                 *(LAS f32x2*)(A + 5 * 128 + 2 * lane) = (f32x2){__expf(s.tot - s.ecs0), __expf(s.tot - s.ecs1)}; } }
        __syncthreads();
        const int h4 = F.wave & 3, rh = F.wave >> 2, h = 4 * g + h4;
        const LAS float* A = ARR + h4 * 768;
        const LAS unsigned char* xh = F.lds + SSD_XH + h4 * 16384;
        const LAS unsigned char* bm = F.lds + SSD_BM;
        const LAS unsigned char* cm = F.lds + SSD_CM;
        f32x16 yacc[2][2];
#pragma unroll
        for (int i = 0; i < 2; ++i)
#pragma unroll
            for (int j = 0; j < 2; ++j)
#pragma unroll
                for (int k = 0; k < 16; ++k) yacc[i][j][k] = 0.f;
#pragma unroll
        for (int itl = 0; itl < 2; ++itl) {
            const int itile = 2 * rh + itl, irow = itile * 32 + l31;
            bf16x8 cf[4];
#pragma unroll
            for (int ks = 0; ks < 4; ++ks) cf[ks] = *(const LAS bf16x8*)(cm + img_off(irow, 2 * ks + hh));
#pragma unroll 1
            for (int d = 0; d < 2; ++d) {
                const bf16_t* Hs = HIN + (((((size_t)b * 18 + c) * 8 + h) * 2 + d) * 4096);
#pragma unroll
                for (int pt = 0; pt < 2; ++pt) {
                    f32x16 tmp;
#pragma unroll
                    for (int k = 0; k < 16; ++k) tmp[k] = 0.f;
#pragma unroll
                    for (int ks = 0; ks < 4; ++ks) { const bf16x8 hb = *(const bf16x8*)(Hs + (pt * 32 + l31) * 64 + 16 * ks + 8 * hh); tmp = MFMA32(cf[ks], hb, tmp); }
#pragma unroll
                    for (int q4 = 0; q4 < 4; ++q4) { const f32x4 ev = *(const LAS f32x4*)(A + (d == 0 ? 2 : 5) * 128 + itile * 32 + 8 * q4 + 4 * hh);
#pragma unroll
                        for (int k = 0; k < 4; ++k) yacc[itl][pt][4 * q4 + k] += tmp[4 * q4 + k] * ev[k]; }
                    __builtin_amdgcn_sched_barrier(0);
                }
            }
            const float csf_i = A[0 * 128 + irow], ecb_i = A[3 * 128 + irow];
#pragma unroll 1
            for (int jt = 0; jt < 4; ++jt) {
                f32x16 Z;
#pragma unroll
                for (int k = 0; k < 16; ++k) Z[k] = 0.f;
#pragma unroll
                for (int ks = 0; ks < 4; ++ks) { const bf16x8 bf_ = *(const LAS bf16x8*)(bm + img_off(jt * 32 + l31, 2 * ks + hh)); Z = MFMA32(bf_, cf[ks], Z); }
#pragma unroll
                for (int q4 = 0; q4 < 4; ++q4) { const int j0 = jt * 32 + 8 * q4 + 4 * hh;
                    f32x4 w = (f32x4){0.f, 0.f, 0.f, 0.f};
                    if (jt <= itile) { const f32x4 cj = *(const LAS f32x4*)(A + 0 * 128 + j0), dj = *(const LAS f32x4*)(A + 1 * 128 + j0);
#pragma unroll
                        for (int k = 0; k < 4; ++k) { const bool ok = (jt < itile) || (j0 + k <= irow); w[k] += ok ? __expf(fminf(csf_i - cj[k], 0.f)) * dj[k] : 0.f; } }
                    if (jt >= itile) { const f32x4 ej = *(const LAS f32x4*)(A + 3 * 128 + j0), dj = *(const LAS f32x4*)(A + 4 * 128 + j0);
#pragma unroll
                        for (int k = 0; k < 4; ++k) { const bool ok = (jt > itile) || (j0 + k >= irow); w[k] += ok ? __expf(fminf(ej[k] - ecb_i, 0.f)) * dj[k] : 0.f; } }
#pragma unroll
                    for (int k = 0; k < 4; ++k) Z[4 * q4 + k] *= w[k]; }
#pragma unroll
                for (int s = 0; s < 2; ++s) {
                    u32x4 zp; zp.x = cvtpk(Z[8 * s], Z[8 * s + 1]); zp.y = cvtpk(Z[8 * s + 2], Z[8 * s + 3]); zp.z = cvtpk(Z[8 * s + 4], Z[8 * s + 5]); zp.w = cvtpk(Z[8 * s + 6], Z[8 * s + 7]);
                    const bf16x8 za = __builtin_bit_cast(bf16x8, zp);
                    const int row = jt * 32 + 16 * s + 4 * hh + q;
#pragma unroll
                    for (int pt = 0; pt < 2; ++pt) { const int chunk = pt * 4 + 2 * blk + (pp >> 1), within = 8 * (pp & 1);
                        const bf16x8 xb = cat8(tr_read4(xh + img_off(row, chunk) + within), tr_read4(xh + img_off(row + 8, chunk) + within));
                        yacc[itl][pt] = MFMA32(za, xb, yacc[itl][pt]); }
                }
                __builtin_amdgcn_sched_barrier(0);
            }
        }
        __syncthreads();
        LAS float* Y = (LAS float*)F.lds;
#pragma unroll
        for (int itl = 0; itl < 2; ++itl)
#pragma unroll
            for (int pt = 0; pt < 2; ++pt)
#pragma unroll
                for (int r = 0; r < 16; ++r) Y[((2 * rh + itl) * 32 + crow(r, hh)) * 256 + h4 * 64 + pt * 32 + l31] = yacc[itl][pt][r];
        __syncthreads();
#pragma unroll 2
        for (int itn = 0; itn < 8; ++itn) { const int idx = itn * 512 + F.tid, row = idx >> 5, ch = idx & 31, R = R0 + row;
            const f32x4 y0 = *(const LAS f32x4*)(Y + row * 256 + ch * 8), y1 = *(const LAS f32x4*)(Y + row * 256 + ch * 8 + 4);
            float xv[8], zv[8]; unpack8(*(const u32x4*)(XBC + (size_t)R * 768 + g * 256 + ch * 8), xv); unpack8(*(const u32x4*)(PA + (size_t)R * PA_W + C_Z + g * 256 + ch * 8), zv);
            const float Dh = P.ssd_d[4 * g + (ch >> 3)]; float o[8], ss = 0.f;
#pragma unroll
            for (int k = 0; k < 8; ++k) { const float yv = (k < 4 ? y0[k] : y1[k - 4]) + Dh * xv[k]; o[k] = yv * silu_f(zv[k]); ss += o[k] * o[k]; }
            ss += __shfl_xor(ss, 1); ss += __shfl_xor(ss, 2); ss += __shfl_xor(ss, 4); ss += __shfl_xor(ss, 8); ss += __shfl_xor(ss, 16);
            if (ch == 0) SSQ[(size_t)R * 2 + g] = ss;
            *(u32x4*)(YB + (size_t)R * 512 + g * 256 + ch * 8) = pack8(o); }
        __syncthreads();
    }
}

DI void s5_recurrence(const Frame& F, const LayerIn& P, const float* S5S, bf16_t* AU) {
    if (F.gw >= 384) return;
    const int g = F.gw >> 4, b = (F.gw >> 1) & 7, d = F.gw & 1, p = F.lane;
    const float step = __expf(P.s5_lstep[d * 24 + g]);
    const float lr = P.s5_lre[(d * 24 + g) * 64 + p], li = P.s5_lim[(d * 24 + g) * 64 + p];
    const float mag = expf(32.f * lr * step), ang = 32.f * li * step, Lr = mag * cosf(ang), Li = mag * sinf(ang);
    float Hr = 0.f, Hi = 0.f;
#pragma unroll 8
    for (int k = 0; k < 72; ++k) {
        const int ck = (d == 0) ? k : (k < 8 ? 7 - k : 79 - k);
        const size_t m = (size_t)g * 576 + b * 72 + ck;
        AU[m * 768 + 512 + d * 128 + p] = (bf16_t)f2bf(Hr); AU[m * 768 + 512 + d * 128 + 64 + p] = (bf16_t)f2bf(Hi);
        const float sr = S5S[m * 256 + d * 128 + p], si = S5S[m * 256 + d * 128 + 64 + p];
        const float nr = Lr * Hr - Li * Hi + sr, ni = Lr * Hi + Li * Hr + si;
        Hr = nr; Hi = ni;
    }
}

namespace attn_body {
using bf16=__hip_bfloat16;
using bf16x8=__attribute__((ext_vector_type(8)))short;
using s16x4=__attribute__((ext_vector_type(4)))short;
using f32x16=__attribute__((ext_vector_type(16)))float;
using u32x4=__attribute__((ext_vector_type(4)))unsigned;
constexpr int D=64;
constexpr int NW=8,QBLK=32,QB=QBLK*NW,KVBLK=64;
__device__ __forceinline__ int crow(int r,int hi){return (r&3)+8*(r>>2)+4*hi;}
#define SBAR() __builtin_amdgcn_sched_barrier(0)
constexpr int NSLOT=3, SLOTB=8192;
constexpr int LDS_K=0, LDS_V=NSLOT*SLOTB, LDS_WS=2*NSLOT*SLOTB, LDS_OST=LDS_WS+NW*64*4, LDS_BYTES=LDS_OST+NW*4096;
constexpr float C2=0.125f*1.4426950408889634f;
__device__ __forceinline__ void glds16(const void*gsrc,unsigned lds_dst){unsigned keep;
  asm volatile("s_mov_b32 %0, m0\n\ts_mov_b32 m0, %2\n\ts_nop 0\n\tglobal_load_lds_dwordx4 %1, off\n\ts_mov_b32 m0, %0":"=&s"(keep):"v"(gsrc),"s"(lds_dst):"memory");}
__device__ __forceinline__ float max3f(float a,float b,float c){float r;asm("v_max3_f32 %0, %1, %2, %3":"=v"(r):"v"(a),"v"(b),"v"(c));return r;}
__device__ __forceinline__ float max2f(float a,float b){float r;asm("v_max_f32_e32 %0, %1, %2":"=v"(r):"v"(a),"v"(b));return r;}
__device__ __forceinline__ float fadd_s(float a,float b){float r;asm("v_add_f32_e32 %0, %1, %2":"=v"(r):"v"(a),"v"(b));return r;}
__device__ __forceinline__ float fsub_s(float a,float b){float r;asm("v_sub_f32_e32 %0, %1, %2":"=v"(r):"v"(a),"v"(b));return r;}
typedef float f32x2_t __attribute__((ext_vector_type(2))); typedef __bf16 bf16x2_t __attribute__((ext_vector_type(2)));
__device__ __forceinline__ unsigned cvtpk_s(float lo,float hi){f32x2_t v={lo,hi};bf16x2_t b=__builtin_convertvector(v,bf16x2_t);return __builtin_bit_cast(unsigned,b);}
#define WAIT_BAR(N) asm volatile("s_waitcnt vmcnt(" #N ") lgkmcnt(0)\n\ts_barrier":::"memory")

__device__ __forceinline__ void qkt(f32x16&p0,f32x16&p1,const char*Kslot,const bf16x8*qr,const f32x16&negm,int r32,int hi){
  const char*kb=Kslot+hi*1024+r32*16;
  #pragma unroll
  for(int d0=0;d0<4;++d0){
    const bf16x8 b0=*reinterpret_cast<const bf16x8*>(kb+d0*2048);
    const bf16x8 b1=*reinterpret_cast<const bf16x8*>(kb+d0*2048+512);
    if(d0==0){p0=__builtin_amdgcn_mfma_f32_32x32x16_bf16(b0,qr[0],negm,0,0,0);p1=__builtin_amdgcn_mfma_f32_32x32x16_bf16(b1,qr[0],negm,0,0,0);}
    else{p0=__builtin_amdgcn_mfma_f32_32x32x16_bf16(b0,qr[d0],p0,0,0,0);p1=__builtin_amdgcn_mfma_f32_32x32x16_bf16(b1,qr[d0],p1,0,0,0);}}
}
typedef __attribute__((address_space(3))) const char* lds_cptr;
typedef short v4i16_t __attribute__((ext_vector_type(4)));
__device__ __forceinline__ void kload8(bf16x8*kf,lds_cptr kp){
  kf[0]=*(const __attribute__((address_space(3))) bf16x8*)(kp);      kf[1]=*(const __attribute__((address_space(3))) bf16x8*)(kp+512);
  kf[2]=*(const __attribute__((address_space(3))) bf16x8*)(kp+2048); kf[3]=*(const __attribute__((address_space(3))) bf16x8*)(kp+2560);
  kf[4]=*(const __attribute__((address_space(3))) bf16x8*)(kp+4096); kf[5]=*(const __attribute__((address_space(3))) bf16x8*)(kp+4608);
  kf[6]=*(const __attribute__((address_space(3))) bf16x8*)(kp+6144); kf[7]=*(const __attribute__((address_space(3))) bf16x8*)(kp+6656);
}
__device__ __forceinline__ void kload2(bf16x8*kf,lds_cptr kp,int j){ kf[2*j]=*(const __attribute__((address_space(3))) bf16x8*)(kp+j*2048); kf[2*j+1]=*(const __attribute__((address_space(3))) bf16x8*)(kp+j*2048+512); }
__device__ __forceinline__ s16x4 vtr(lds_cptr p){ return __builtin_bit_cast(s16x4,__builtin_amdgcn_ds_read_tr16_b64_v4i16((__attribute__((address_space(3))) v4i16_t*)p)); }
__device__ __forceinline__ float rowmax(const f32x16&p0,const f32x16&p1){
  float a=max3f(p0[0],p0[1],p1[0]),b=max3f(p0[2],p0[3],p1[1]);a=max3f(a,p1[2],p1[3]);
  #pragma unroll
  for(int r=4;r<16;r+=4){a=max3f(a,p0[r],p0[r+1]);b=max3f(b,p0[r+2],p0[r+3]);a=max3f(a,p1[r],p1[r+1]);b=max3f(b,p1[r+2],p1[r+3]);}
  const float m=max2f(a,b);
  auto rr=__builtin_amdgcn_permlane32_swap(__float_as_uint(m),__float_as_uint(m),false,false);
  return max2f(__uint_as_float(rr[0]),__uint_as_float(rr[1]));
}
__device__ __forceinline__ void pv(f32x16*o,int vb,bf16x8 pa0,bf16x8 pa1,bf16x8 pa2,bf16x8 pa3){
  #pragma unroll
  for(int d0=0;d0<2;++d0){s16x4 lo[4],hi[4];
    #pragma unroll
    for(int ks=0;ks<4;++ks){
      asm volatile("ds_read_b64_tr_b16 %0,%1 offset:%c2":"=&v"(lo[ks]):"v"(vb),"i"(d0*4096+ks*1024):"memory");
      asm volatile("ds_read_b64_tr_b16 %0,%1 offset:%c2":"=&v"(hi[ks]):"v"(vb),"i"(d0*4096+ks*1024+512):"memory");}
    asm volatile("s_waitcnt lgkmcnt(0)":::"memory");SBAR();
    #define PK(k) (bf16x8){lo[k][0],lo[k][1],lo[k][2],lo[k][3],hi[k][0],hi[k][1],hi[k][2],hi[k][3]}
    o[d0]=__builtin_amdgcn_mfma_f32_32x32x16_bf16(pa0,PK(0),o[d0],0,0,0);
    o[d0]=__builtin_amdgcn_mfma_f32_32x32x16_bf16(pa1,PK(1),o[d0],0,0,0);
    o[d0]=__builtin_amdgcn_mfma_f32_32x32x16_bf16(pa2,PK(2),o[d0],0,0,0);
    o[d0]=__builtin_amdgcn_mfma_f32_32x32x16_bf16(pa3,PK(3),o[d0],0,0,0);
    #undef PK
  }
}

#ifndef ATTN_STORE16
#define ATTN_STORE16(p,v) (*(u32x4*)(p)=(v))
#endif
template<int THRL> __device__ __forceinline__ void attn_unit(const bf16*Qp,int qpitch,const bf16*__restrict__ Kp,int kpitch,const bf16*__restrict__ Vp,int vpitch,bf16*Op,int opitch,const int NT,char*shm){
  const int tid=fresh_tid(),lane=tid&63,r32=lane&31,hi=lane>>5; const int wid=__builtin_amdgcn_readfirstlane(tid>>6);
  const bf16*Qw=Qp+(long)(wid*QBLK)*qpitch;
  const bf16*Kh=Kp,*Vh=Vp;
  const unsigned lds0=(unsigned)(uintptr_t)shm;
  float*wsf=(float*)(shm+LDS_WS)+wid*64;
  const bf16*ksrc=Kh+(long)lane*kpitch+wid*8;
  const bf16*vsrc=Vh+(long)(16*(wid&3)+(lane>>2))*vpitch+(wid>>2)*32+(lane&3)*8;
  const unsigned kdst=lds0+LDS_K+wid*1024, vdst=lds0+LDS_V+wid*1024;
  #define DMA_K(t,slot) glds16(ksrc+(long)(t)*KVBLK*kpitch,(unsigned)__builtin_amdgcn_readfirstlane(kdst+(slot)))
  #define DMA_V(t,slot) glds16(vsrc+(long)(t)*KVBLK*vpitch,(unsigned)__builtin_amdgcn_readfirstlane(vdst+(slot)))
  const int vb0=(int)(lds0+LDS_V)+((lane>>4)&1)*32+(lane&3)*8+(4*hi+((lane&15)>>2))*64;
  const char*Kbase=shm+LDS_K; bf16x8 kf[8];
  const lds_cptr shm3=(lds_cptr)shm; const lds_cptr kp0=shm3+LDS_K+hi*1024+r32*16; const lds_cptr vp0=shm3+LDS_V+((lane>>4)&1)*32+(lane&3)*8+(4*hi+((lane&15)>>2))*64;
  DMA_K(0,0);DMA_V(0,0);DMA_K(1,SLOTB);
  bf16x8 qr[4];
  #pragma unroll
  for(int d0=0;d0<4;++d0)qr[d0]=*reinterpret_cast<const bf16x8*>(&Qw[(long)r32*qpitch+d0*16+hi*8]);
  float mhat=0.f,l_reg=0.f;f32x16 o[2];o[0]=f32x16{};o[1]=f32x16{};f32x16 negm=f32x16{};asm volatile("":"+v"(negm));
  #define CMASK(P0,P1,t) do{}while(0)
  bool resc=false;
  #define START(P0,P1) do{ const float rm=rowmax(P0,P1); resc=false; \
    { const float dl=rm; mhat=fadd_s(mhat,dl); \
      _Pragma("unroll") for(int r=0;r<16;++r){P0[r]=fsub_s(P0[r],dl);P1[r]=fsub_s(P1[r],dl);} \
      _Pragma("unroll") for(int r=0;r<16;++r)negm[r]=-mhat; asm volatile("":"+v"(negm)); } \
    _Pragma("unroll") for(int r=0;r<16;++r)P0[r]=__builtin_amdgcn_exp2f(P0[r]); }while(0)
  #define RESC() do{ if(resc){ asm volatile("s_waitcnt lgkmcnt(0)":::"memory"); \
      _Pragma("unroll") for(int d_=0;d_<2;++d_) _Pragma("unroll") for(int r=0;r<16;++r)o[d_][r]*=wsf[crow(r,hi)]; } }while(0)
  f32x16 pA0,pA1,pB0,pB1;
  int sl_prev=0,sl_cur=0,sl_next=SLOTB;
  #define ROT() do{sl_prev=sl_cur;sl_cur=sl_next;sl_next=(sl_next==(NSLOT-1)*SLOTB)?0:sl_next+SLOTB;}while(0)
  DMA_K(2,2*SLOTB);
  WAIT_BAR(3);
  qkt(pA0,pA1,Kbase,qr,negm,r32,hi);asm volatile("s_nop 15\n\ts_nop 7":"+v"(pA0),"+v"(pA1));CMASK(pA0,pA1,0);
  START(pA0,pA1);
  _Pragma("unroll") for(int r=0;r<16;++r)pA1[r]=__builtin_amdgcn_exp2f(pA1[r]);
  WAIT_BAR(0);
  DMA_K(3,0);DMA_V(1,SLOTB);
  ROT();
  kload8(kf,kp0+sl_cur);
  WAIT_BAR(2);
  s16x4 vlo[8],vhi[8]; u32x4 pw0,pw1,pw2,pw3;
  #define PKW(P,B) cvtpk_s(P[B],P[B+1])
  #define PAF(k) __builtin_bit_cast(bf16x8,pw##k)
  #define VFR(i) (bf16x8){vlo[i][0],vlo[i][1],vlo[i][2],vlo[i][3],vhi[i][0],vhi[i][1],vhi[i][2],vhi[i][3]}
  #define PIN(x) asm volatile("":"+v"(x))
  #define MX3(a,b,c) __builtin_fmaxf(__builtin_fmaxf((a),(b)),(c))
  #define GAPA(MF,A0,A1,A2,A3,W0,W1,PW) do{ MF; sacc+=A0; sacc+=A1; sacc+=A2; sacc+=A3; PIN(sacc); W0; W1; PIN(PW); SBAR(); }while(0)
  #define EX(v) __builtin_amdgcn_exp2f(v)
  #define GAPB(MF,X,B) do{ MF; X[B]=EX(X[B]); X[B+1]=EX(X[B+1]); X[B+2]=EX(X[B+2]); X[B+3]=EX(X[B+3]); PIN(X); SBAR(); }while(0)
  #define VRD(i) do{ vlo[i]=vtr(vp_+(((i)>>2)*4096+((i)&3)*1024)); vhi[i]=vtr(vp_+(((i)>>2)*4096+((i)&3)*1024+512)); }while(0)
  #define KRD(G,j) do{ if(G){ kload2(kf,kp0+sl_next,j); SBAR(); } }while(0)
  #define STEP(C0,C1,P0,P1,t,GK,GV,GL) do{ SBAR(); \
    const lds_cptr vp_=vp0+sl_prev; \
    VRD(0); SBAR(); float sacc=(P0[0]+P0[1]); \
    GAPA(C0=__builtin_amdgcn_mfma_f32_32x32x16_bf16(kf[0],qr[0],negm,0,0,0), P0[2],P0[3],P0[4],P0[5],     pw0[0]=PKW(P0,0), pw0[1]=PKW(P0,2), pw0); \
    VRD(4); SBAR(); GAPA(C1=__builtin_amdgcn_mfma_f32_32x32x16_bf16(kf[1],qr[0],negm,0,0,0), P0[6],P0[7],P0[8],P0[9],     pw0[2]=PKW(P0,4), pw0[3]=PKW(P0,6), pw0); \
    VRD(1); SBAR(); GAPA(C0=__builtin_amdgcn_mfma_f32_32x32x16_bf16(kf[2],qr[1],C0,0,0,0),   P0[10],P0[11],P0[12],P0[13], pw1[0]=PKW(P0,8), pw1[1]=PKW(P0,10), pw1); \
    VRD(5); SBAR(); GAPA(C1=__builtin_amdgcn_mfma_f32_32x32x16_bf16(kf[3],qr[1],C1,0,0,0),   P0[14],P0[15],P1[0],P1[1],   pw1[2]=PKW(P0,12),pw1[3]=PKW(P0,14), pw1); \
    VRD(2); SBAR(); GAPA(C0=__builtin_amdgcn_mfma_f32_32x32x16_bf16(kf[4],qr[2],C0,0,0,0),   P1[2],P1[3],P1[4],P1[5],     pw2[0]=PKW(P1,0), pw2[1]=PKW(P1,2), pw2); \
    VRD(6); SBAR(); GAPA(C1=__builtin_amdgcn_mfma_f32_32x32x16_bf16(kf[5],qr[2],C1,0,0,0),   P1[6],P1[7],P1[8],P1[9],     pw2[2]=PKW(P1,4), pw2[3]=PKW(P1,6), pw2); \
    VRD(3); SBAR(); GAPA(C0=__builtin_amdgcn_mfma_f32_32x32x16_bf16(kf[6],qr[3],C0,0,0,0),   P1[10],P1[11],P1[12],P1[13], pw3[0]=PKW(P1,8), pw3[1]=PKW(P1,10), pw3); \
    VRD(7); SBAR(); GAPA(C1=__builtin_amdgcn_mfma_f32_32x32x16_bf16(kf[7],qr[3],C1,0,0,0),   P1[14],P1[15],0.f,0.f,       pw3[2]=PKW(P1,12),pw3[3]=PKW(P1,14), pw3); \
    l_reg+=sacc; \
    if(GK){DMA_K((t)+3,sl_cur);} if(GV){DMA_V((t)+1,sl_next);} \
    CMASK(C0,C1,t); \
    { float a=MX3(C0[0],C0[1],C1[0]),b=MX3(C0[2],C0[3],C1[1]); a=MX3(a,C1[2],C1[3]); \
      _Pragma("unroll") for(int r=4;r<16;r+=4){a=MX3(a,C0[r],C0[r+1]);b=MX3(b,C0[r+2],C0[r+3]);a=MX3(a,C1[r],C1[r+1]);b=MX3(b,C1[r+2],C1[r+3]);} \
      float rm=__builtin_fmaxf(a,b); { auto rr=__builtin_amdgcn_permlane32_swap(__float_as_uint(rm),__float_as_uint(rm),false,false); rm=__builtin_fmaxf(__uint_as_float(rr[0]),__uint_as_float(rr[1])); } \
      resc=false; \
      if(__builtin_expect(__any(rm>(float)THRL),0)){ const float dl=__builtin_fmaxf(rm,0.f); mhat+=dl; \
        _Pragma("unroll") for(int r=0;r<16;++r){C0[r]-=dl;C1[r]-=dl;} \
        _Pragma("unroll") for(int r=0;r<16;++r)negm[r]=-mhat; asm volatile("":"+v"(negm)); \
        const float f=__builtin_amdgcn_exp2f(-dl); l_reg*=f; if(hi==0)wsf[r32]=f; resc=true; } } \
    SBAR(); \
    GAPB(o[0]=__builtin_amdgcn_mfma_f32_32x32x16_bf16(PAF(0),VFR(0),o[0],0,0,0), C0,0); \
    GAPB(o[1]=__builtin_amdgcn_mfma_f32_32x32x16_bf16(PAF(0),VFR(4),o[1],0,0,0), C0,4); \
    KRD(GL,0); GAPB(o[0]=__builtin_amdgcn_mfma_f32_32x32x16_bf16(PAF(1),VFR(1),o[0],0,0,0), C0,8); \
    KRD(GL,1); GAPB(o[1]=__builtin_amdgcn_mfma_f32_32x32x16_bf16(PAF(1),VFR(5),o[1],0,0,0), C0,12); \
    KRD(GL,2); GAPB(o[0]=__builtin_amdgcn_mfma_f32_32x32x16_bf16(PAF(2),VFR(2),o[0],0,0,0), C1,0); \
    KRD(GL,3); GAPB(o[1]=__builtin_amdgcn_mfma_f32_32x32x16_bf16(PAF(2),VFR(6),o[1],0,0,0), C1,4); \
    GAPB(o[0]=__builtin_amdgcn_mfma_f32_32x32x16_bf16(PAF(3),VFR(3),o[0],0,0,0), C1,8); \
    GAPB(o[1]=__builtin_amdgcn_mfma_f32_32x32x16_bf16(PAF(3),VFR(7),o[1],0,0,0), C1,12); \
    }while(0)
  int t=1;
  for(;t+5<NT;t+=2){
    STEP(pB0,pB1,pA0,pA1,t,true,true,true);     WAIT_BAR(2); RESC(); ROT();
    STEP(pA0,pA1,pB0,pB1,t+1,true,true,true);   WAIT_BAR(2); RESC(); ROT();
  }
  #define ENDW(tt) do{ if((tt)+3<NT){WAIT_BAR(2);} else if((tt)+2<NT){WAIT_BAR(1);} else {WAIT_BAR(0);} }while(0)
  for(;t+1<NT;t+=2){
    STEP(pB0,pB1,pA0,pA1,t,(t+3<NT),(t+1<NT),(t+1<NT));       ENDW(t);   RESC(); ROT();
    STEP(pA0,pA1,pB0,pB1,t+1,(t+4<NT),(t+2<NT),(t+2<NT));     ENDW(t+1); RESC(); ROT();
  }
  STEP(pB0,pB1,pA0,pA1,NT-1,false,false,false); RESC();
  { float sacc=pB0[0]+pB0[1]; _Pragma("unroll") for(int r=2;r<16;++r)sacc+=pB0[r]; _Pragma("unroll") for(int r=0;r<16;++r)sacc+=pB1[r]; l_reg+=sacc;
    pw0=(u32x4){PKW(pB0,0),PKW(pB0,2),PKW(pB0,4),PKW(pB0,6)};pw1=(u32x4){PKW(pB0,8),PKW(pB0,10),PKW(pB0,12),PKW(pB0,14)};pw2=(u32x4){PKW(pB1,0),PKW(pB1,2),PKW(pB1,4),PKW(pB1,6)};pw3=(u32x4){PKW(pB1,8),PKW(pB1,10),PKW(pB1,12),PKW(pB1,14)};
    SBAR(); pv(o,vb0+sl_cur,PAF(0),PAF(1),PAF(2),PAF(3)); }
  #undef PKW
  #undef PAF
  #undef VFR
  #undef PIN
  #undef MX3
  #undef GAPA
  #undef GAPB
  #undef EX
  #undef VRD
  #undef KRD
  #undef STEP
  #undef ENDW
  {auto rr=__builtin_amdgcn_permlane32_swap(__float_as_uint(l_reg),__float_as_uint(l_reg),false,false);l_reg=__uint_as_float(rr[0])+__uint_as_float(rr[1]);}
  if(hi==0)wsf[32+r32]=l_reg;asm volatile("s_waitcnt lgkmcnt(0)":::"memory");
  float rli[16];
  #pragma unroll
  for(int r=0;r<16;++r)rli[r]=__builtin_amdgcn_rcpf(wsf[32+crow(r,hi)]);
  bf16*Ow=Op+(long)(wid*QBLK)*opitch;
  { bf16*stg=(bf16*)(shm+LDS_OST)+wid*2048;
    #pragma unroll
    for(int r=0;r<16;++r){const int orow=crow(r,hi);
      #pragma unroll
      for(int d0=0;d0<2;++d0)stg[orow*64+d0*32+r32]=__float2bfloat16(o[d0][r]*rli[r]);}
    asm volatile("s_waitcnt lgkmcnt(0)":::"memory");
    #pragma unroll
    for(int i=0;i<4;++i){const int row=i*8+(lane>>3),ch=lane&7; const u32x4 v=*(const u32x4*)(stg+row*64+ch*8); ATTN_STORE16(Ow+(long)row*opitch+ch*8,v);} }
  asm volatile("s_waitcnt lgkmcnt(0)\n\ts_barrier":::"memory");
  #undef DMA_K
  #undef DMA_V
  #undef CMASK
  #undef START
  #undef RESC
  #undef ROT
}
constexpr int ATTN_LDS_BYTES=LDS_BYTES;
#undef SBAR
#undef WAIT_BAR
}


#define pMOD ((float*)(ws + WS_MOD))
#define pROPE ((float*)(ws + WS_ROPE))
#define pAFF ((float*)(ws + WS_AFF))
#define pINV ((int*)(ws + WS_INV))
#define pDT ((float*)(ws + WS_DT))
#define pSRC ((int*)(ws + WS_SRC))
#define pGV ((float*)(ws + WS_GV))
#define pSSQ ((float*)(ws + WS_SSQ))
#define pTOT ((float*)(ws + WS_TOT))
#define pX ((float*)(ws + WS_X))
#define pH ((bf16_t*)(ws + WS_H))
#define pYA ((bf16_t*)(ws + WS_YA))
#define pYB ((bf16_t*)(ws + WS_YB))
#define pPA ((bf16_t*)(ws + WS_PA))
#define pPG ((bf16_t*)(ws + WS_PG))
#define pMRG ((float*)(ws + WS_MRG))
#define pMRGB ((bf16_t*)(ws + WS_MRGB))
#define pXG ((bf16_t*)(ws + WS_XG))
#define pHID ((bf16_t*)(ws + WS_HID))
#define pYE ((bf16_t*)(ws + WS_YE))
#define pQN ((bf16_t*)(ws + WS_QN))
#define pKN ((bf16_t*)(ws + WS_KN))
#define pHIN ((bf16_t*)(ws + WS_HIN))
#define pXBC ((bf16_t*)(ws + WS_XBC))
#define pAU ((bf16_t*)(ws + WS_AU))
#define pSS ((float*)(ws + WS_S))
#define pYG ((bf16_t*)(ws + WS_YG))
#define pYC ((bf16_t*)(ws + WS_YC))
#define pS5S ((float*)(ws + WS_S5S))
#define pYD ((bf16_t*)(ws + WS_YD))
struct Args { const float* in[38]; float* out; unsigned char* ws; int ph_lo, ph_hi; };
constexpr int PH_PER_LAYER = 15, PH_FINAL = 2 * PH_PER_LAYER, PH_TOTAL = PH_FINAL + 1;

DI LayerIn layer_in(const Args& a, int L) {
    LayerIn P;
    P.norm_mix_g = a.in[6] + (size_t)L * 1024; P.norm_ffn_g = a.in[7] + (size_t)L * 1024;
    P.w_in = a.in[8] + (size_t)L * 1024 * NIN; P.q_norm_g = a.in[9] + L * 64; P.k_norm_g = a.in[10] + L * 64;
    P.ssd_conv_w = a.in[11] + L * 3 * 768; P.ssd_conv_b = a.in[12] + L * 768; P.ssd_dt_bias = a.in[13] + L * 16; P.ssd_a_log = a.in[14] + L * 16;
    P.ssd_d = a.in[15] + L * 8; P.ssd_norm_g = a.in[16] + L * 512;
    P.s5_lre = a.in[17] + L * 2 * 24 * 64; P.s5_lim = a.in[18] + L * 2 * 24 * 64; P.s5_lstep = a.in[19] + L * 48;
    P.s5_bre = a.in[20] + (size_t)L * 24 * 64 * 16; P.s5_bim = a.in[21] + (size_t)L * 24 * 64 * 16; P.s5_cre = a.in[22] + (size_t)L * 24 * 16 * 64; P.s5_cim = a.in[23] + (size_t)L * 24 * 16 * 64;
    P.s5_d = a.in[24] + L * 384; P.s5_wglu = a.in[25] + (size_t)L * 384 * 384; P.s5_bglu = a.in[26] + L * 384; P.sc_conv_w = a.in[27] + L * 3 * 384;
    P.w_br_attn = a.in[28] + (size_t)L * 512 * 1024; P.w_br_ssd = a.in[29] + (size_t)L * 512 * 1024; P.w_br_s5 = a.in[30] + (size_t)L * 384 * 1024; P.w_br_sc = a.in[31] + (size_t)L * 384 * 1024;
    P.w_out = a.in[32] + (size_t)L * 1024 * 1024; P.w_router = a.in[33] + (size_t)L * 1024 * 16;
    P.w_gate = a.in[34] + (size_t)L * 16 * 1024 * 1024; P.w_up = a.in[35] + (size_t)L * 16 * 1024 * 1024; P.w_down = a.in[36] + (size_t)L * 16 * 1024 * 1024;
    return P;
}

__global__ void __launch_bounds__(NWAVES * 64, 2) hybrid_fwd(Args args) {
    extern __shared__ __attribute__((aligned(16))) unsigned char lds_raw[];
    Frame F0;
#define F F0
    F.lds = (LAS unsigned char*)lds_raw;
    F.tid = threadIdx.x; F.lane = F.tid & 63; F.wave = __builtin_amdgcn_readfirstlane(F.tid >> 6);
    F.G = gridDim.x; { const int bx = blockIdx.x; F.vcu = (F.G % 8 == 0) ? (bx % 8) * (F.G / 8) + bx / 8 : bx; }
    F.gw = F.vcu * NWAVES + F.wave; F.NGW = F.G * NWAVES;
    unsigned char* ws = args.ws;
    volatile LAS unsigned* MISC = (volatile LAS unsigned*)(F.lds + LDSCTL_OFF);
    for (int u = F.tid; u < (LDS_BYTES - LDSCTL_OFF) / 4; u += NWAVES * 64) ((LAS unsigned*)(F.lds + LDSCTL_OFF))[u] = 0u;
    __syncthreads();
    XcdBarrier bar = xcd_barrier_post((unsigned*)(ws + WS_CTL) + CW_BAR, MISC + 8);
    const int lo = args.ph_lo, hi = args.ph_hi;
#ifndef PH_MASK
#define PH_MASK 0xFFFF
#endif
#define IN(k) (lo <= (k) && (k) < hi)
#define INL(j) (((PH_MASK >> (j)) & 1) && IN(base + (j)))
#define SEAM(k) do { if (IN((k) + 1)) xcd_barrier(bar); } while (0)

#undef F
#pragma unroll 1
    for (int L = 0; L < 2; ++L) {
        const int base = L * PH_PER_LAYER;
        if (hi <= base || lo >= base + PH_PER_LAYER) continue;
        const bool lastL = (L == 1);

        if (INL(0)) { const LayerIn P = layer_in(args, L); Frame F = F0; F.tid = fresh_tid(); F.lane = F.tid & 63;
            if (L == 0) { prep_mod(F, args.in[1], args.in[3], args.in[4], args.in[5], pMOD); prep_rope(F, pROPE); }
            prep_s5(F, P, ws);
            prep_small_weights(F, P, ws);
            SEAM(base + 0);
        }
        if (INL(1)) { const LayerIn P = layer_in(args, L); Frame F = F0; F.tid = fresh_tid(); F.lane = F.tid & 63; phase_norm1(F, L, args.in[0], args.in[2], pX, pH, pMOD, P.norm_mix_g, pINV, pYE); SEAM(base + 1); }
        if (INL(2)) { const LayerIn P = layer_in(args, L); Frame F = F0; F.tid = fresh_tid(); F.lane = F.tid & 63;
            pg8::Gemm g{pH, (const bf16_t*)(ws + W_WIN), 1024, 1024, 1024};
            RowSkipOrder S; S.init(NPROJ, F.G, (int)blockIdx.x, lastL ? 1 : 0, 2, 10);
            EpiProj E{pPA, PA_W, PA_W / 256, pPG, PG_W};
            pg8::gemm_phase<EpiProj, RowSkipOrder>(F.lds, g, S, E);
            SEAM(base + 2);
        }
        if (INL(3)) { const LayerIn P = layer_in(args, L); Frame F = F0; F.tid = fresh_tid(); F.lane = F.tid & 63; phase_elem(F, P, pPA, pROPE, pQN, pKN, pXBC, pDT, pAU, pYD); SEAM(base + 3); }
        if (INL(4)) { const LayerIn P = layer_in(args, L); Frame F = F0; F.tid = fresh_tid(); F.lane = F.tid & 63;
            using abf = attn_body::bf16;
#ifndef NO_ATTN
            for (int u = F.vcu; u < 512; u += F.G) { const int bk = u >> 5, r = u & 31, b = bk >> 1, kvh = bk & 1, h = kvh * 4 + (r >> 3), qb = r & 7;
                const size_t qrow = (size_t)b * PB + CTXL + qb * 256, krow = (size_t)b * PB;
                attn_body::attn_unit<8>((const abf*)(pQN + qrow * 512 + h * 64), 512, (const abf*)(pKN + krow * 128 + kvh * 64), 128, (const abf*)(pPA + krow * PA_W + C_V + kvh * 64), PA_W,
                                        (abf*)(pYA + qrow * 512 + h * 64), 512, 36, (char*)lds_raw); }
            if (!lastL) for (int u = F.vcu; u < 64; u += F.G) { const int b = u >> 3, h = u & 7, kvh = h >> 2; const size_t krow = (size_t)b * PB;
                attn_body::attn_unit<8>((const abf*)(pQN + krow * 512 + h * 64), 512, (const abf*)(pKN + krow * 128 + kvh * 64), 128, (const abf*)(pPA + krow * PA_W + C_V + kvh * 64), PA_W,
                                        (abf*)(pYA + krow * 512 + h * 64), 512, 4, (char*)lds_raw); }
#endif
            __syncthreads();
#ifndef NO_E1
            ssd_chunk_states(F, P, pXBC, pDT, pSS, pTOT);
#endif
#ifndef NO_S5S
            { pg8::Gemm g{pAU, (const bf16_t*)(ws + W_P), 768, 512, 512}; OrderS5S S{F.G, (int)blockIdx.x}; EpiS5S E{pS5S};
              pg8::gemm_phase<EpiS5S, OrderS5S>(F.lds, g, S, E); }
#endif
            SEAM(base + 4);
        }
        if (INL(5)) { const LayerIn P = layer_in(args, L); Frame F = F0; F.tid = fresh_tid(); F.lane = F.tid & 63; ssd_recurrence(F, pSS, pTOT, pHIN); s5_recurrence(F, P, pS5S, pAU); SEAM(base + 5); }
        if (INL(6)) { const LayerIn P = layer_in(args, L); Frame F = F0; F.tid = fresh_tid(); F.lane = F.tid & 63;
#ifndef NO_E3
            ssd_output(F, P, pXBC, pPA, pDT, pHIN, pYB, pSSQ, lastL);
#endif
#ifndef NO_S5Y
            { pg8::Gemm g{pAU, (const bf16_t*)(ws + W_TQ), 768, 768, 768}; OrderS5Y S{F.G, (int)blockIdx.x}; EpiS5Y E{pAU, pYG, P.s5_d};
              pg8::gemm_phase<EpiS5Y, OrderS5Y>(F.lds, g, S, E); }
#endif
            SEAM(base + 6);
        }
        if (INL(7)) { const LayerIn P = layer_in(args, L); Frame F = F0; F.tid = fresh_tid(); F.lane = F.tid & 63;
            pg8::Gemm g{pYG, (const bf16_t*)(ws + W_GLU), 384, 384, 384};
            RowSkipOrder S; S.init(512, F.G, (int)blockIdx.x, lastL ? 1 : 0, 0, 0);
            EpiGlu E{pYG, pYC, P.s5_bglu};
            pg8::gemm_phase<EpiGlu, RowSkipOrder>(F.lds, g, S, E);
            SEAM(base + 7);
        }
        if (INL(8)) { const LayerIn P = layer_in(args, L); Frame F = F0; F.tid = fresh_tid(); F.lane = F.tid & 63;
            RowSkipOrder S; S.init(1024, F.G, (int)blockIdx.x, lastL ? 1 : 0, 0, 0);
            { pg8::Gemm g{pYA, (const bf16_t*)(ws + W_BRA), 512, 512, 512}; EpiMerge E{pPG + 0 * 1024, pMRG, pMRGB, nullptr, 0}; pg8::gemm_phase<EpiMerge, RowSkipOrder>(F.lds, g, S, E); }
            { pg8::Gemm g{pYB, (const bf16_t*)(ws + W_BRB), 512, 512, 512}; EpiMerge E{pPG + 1 * 1024, pMRG, pMRGB, pSSQ, 1}; pg8::gemm_phase<EpiMerge, RowSkipOrder>(F.lds, g, S, E); }
            { pg8::Gemm g{pYC, (const bf16_t*)(ws + W_BRC), 384, 384, 384}; EpiMerge E{pPG + 2 * 1024, pMRG, pMRGB, nullptr, 1}; pg8::gemm_phase<EpiMerge, RowSkipOrder>(F.lds, g, S, E); }
            { pg8::Gemm g{pYD, (const bf16_t*)(ws + W_BRD), 384, 384, 384}; EpiMerge E{pPG + 3 * 1024, pMRG, pMRGB, nullptr, 2}; pg8::gemm_phase<EpiMerge, RowSkipOrder>(F.lds, g, S, E); }
            SEAM(base + 8);
        }
        if (INL(9)) { const LayerIn P = layer_in(args, L); Frame F = F0; F.tid = fresh_tid(); F.lane = F.tid & 63;
            pg8::Gemm g{pMRGB, (const bf16_t*)(ws + W_OUT), 1024, 1024, 1024};
            RowSkipOrder S; S.init(1024, F.G, (int)blockIdx.x, lastL ? 1 : 0, 0, 0);
            EpiWout E{pX, pMOD + (size_t)L * 9 * 6144};
            pg8::gemm_phase<EpiWout, RowSkipOrder>(F.lds, g, S, E);
            SEAM(base + 9);
        }
        if (INL(10)) { const LayerIn P = layer_in(args, L); Frame F = F0; F.tid = fresh_tid(); F.lane = F.tid & 63; phase_norm2(F, L, lastL, pX, pH, pMOD, P.norm_ffn_g, P.w_router, pAFF); SEAM(base + 10); }
        if (INL(11)) { const LayerIn P = layer_in(args, L); Frame F = F0; F.tid = fresh_tid(); F.lane = F.tid & 63; phase_topk(F, lastL ? 128 : 256, pAFF, pSRC, pGV, pINV); prep_expert_weights(F, P, ws); SEAM(base + 11); }
        if (INL(12)) { const LayerIn P = layer_in(args, L); Frame F = F0; F.tid = fresh_tid(); F.lane = F.tid & 63; phase_gather(F, lastL ? 2048 : 2304, pSRC, pH, pXG); SEAM(base + 12); }
        if (INL(13)) { const LayerIn P = layer_in(args, L); Frame F = F0; F.tid = fresh_tid(); F.lane = F.tid & 63;
            pg8::Gemm g{pXG, (const bf16_t*)(ws + WS_WGU), 1024, 1024, 1024}; OrderUp S{F.G, (int)blockIdx.x, lastL ? 8 : 9}; EpiUp E{pHID};
            pg8::gemm_phase<EpiUp, OrderUp>(F.lds, g, S, E);
            SEAM(base + 13);
        }
        if (INL(14)) { const LayerIn P = layer_in(args, L); Frame F = F0; F.tid = fresh_tid(); F.lane = F.tid & 63;
            pg8::Gemm g{pHID, (const bf16_t*)(ws + WS_WD), 1024, 1024, 1024}; OrderDown S{F.G, (int)blockIdx.x, lastL ? 8 : 9}; EpiDown E{pYE, pGV};
            pg8::gemm_phase<EpiDown, OrderDown>(F.lds, g, S, E);
            SEAM(base + 14);
        }
    }
    if (IN(PH_FINAL)) phase_final(F0, pX, args.out, pMOD, args.in[37], pINV, pYE);
#undef IN
#undef INL
#undef SEAM
}

#ifndef MK_N_LAUNCHES
#define MK_N_LAUNCHES 1
#endif
extern "C" void kernel_launch(void* const* d_in, const int* in_sizes, int n_in, void* d_out, int out_size, void* d_ws, size_t ws_size, hipStream_t stream) {
    static int grid = 0;
    if (grid == 0) {
        if (n_in != 38 || ws_size < WS_END) { fprintf(stderr, "kernel_launch: unexpected inputs (n_in %d, ws %zu)\n", n_in, ws_size); grid = -1; return; }
        int dev = 0, cus = 0;
        if (hipGetDevice(&dev) != hipSuccess || hipDeviceGetAttribute(&cus, hipDeviceAttributeMultiprocessorCount, dev) != hipSuccess) { grid = -1; return; }
        if (hipFuncSetAttribute((const void*)hybrid_fwd, hipFuncAttributeMaxDynamicSharedMemorySize, LDS_BYTES) != hipSuccess) { fprintf(stderr, "kernel_launch: hipFuncSetAttribute failed\n"); grid = -1; return; }
        (void)hipGetLastError();
        grid = (cus / 8) * 8;
        if (grid > 256) grid = 256;
    }
    if (grid < 0) return;
    if (hipMemsetAsync((char*)d_ws + WS_CTL, 0, CTL_ZERO_BYTES, stream) != hipSuccess) return;
    Args a{};
    for (int i = 0; i < 38; ++i) a.in[i] = (const float*)d_in[i];
    a.out = (float*)d_out; a.ws = (unsigned char*)d_ws;
#if MK_N_LAUNCHES == 1
    a.ph_lo = 0; a.ph_hi = PH_TOTAL;
    hipLaunchKernelGGL(hybrid_fwd, dim3(grid), dim3(NWAVES * 64), LDS_BYTES, stream, a);
#else
    for (int p = 0; p < PH_TOTAL; ++p) { a.ph_lo = p; a.ph_hi = p + 1; hipLaunchKernelGGL(hybrid_fwd, dim3(grid), dim3(NWAVES * 64), LDS_BYTES, stream, a); }
#endif
}
```

```cpp
#include <hip/hip_runtime.h>
#include <hip/hip_bf16.h>
#include <cstdio>
#include <cstdint>
#include <cmath>

#define DI __device__ __forceinline__
#define GAS __attribute__((address_space(1)))
#define LAS __attribute__((address_space(3)))
typedef unsigned short bf16_t;
typedef short bf16x8 __attribute__((ext_vector_type(8)));
typedef short s16x4 __attribute__((ext_vector_type(4)));
typedef float f32x2 __attribute__((ext_vector_type(2)));
typedef float f32x4 __attribute__((ext_vector_type(4)));
typedef float f32x16 __attribute__((ext_vector_type(16)));
typedef unsigned u32x2 __attribute__((ext_vector_type(2)));
typedef unsigned u32x4 __attribute__((ext_vector_type(4)));
typedef GAS unsigned gu32;

constexpr int DM = 1024, NB = 8, SEQ = 2048, CTXL = 256, PB = 2304, MROWS = NB * PB;
constexpr int NIN = 7688, NE = 16, EFF = 1024;
constexpr int C_Q = 0, C_K = 512, C_V = 640, C_Z = 768, C_XBC = 1280, C_DT = 2048, C_U = 2056, C_SB = 2440, C_SG = 2824, C_SH = 3208, C_G = 3592;
constexpr int PA_W = 3840, PG_W = 4096, NPROJ = PA_W + PG_W;
constexpr int EROWS = 2304;
constexpr float RMS_EPS = 1e-6f;
constexpr float ATT_C2 = 0.125f * 1.4426950408889634f;

constexpr size_t MiB = 1u << 20;
constexpr size_t WS_CTL = 0, CTL_ZERO_BYTES = 1 * MiB;
constexpr size_t WS_MOD = 1 * MiB;
constexpr size_t WS_ROPE = WS_MOD + 512 * 1024;
constexpr size_t WS_AFF = 2 * MiB;
constexpr size_t WS_INV = WS_AFF + 1280 * 1024;
constexpr size_t WS_DT = WS_INV + 1280 * 1024;
constexpr size_t WS_SRC = WS_DT + 1280 * 1024;
constexpr size_t WS_GV = WS_SRC + 256 * 1024;
constexpr size_t WS_SSQ = WS_GV + 256 * 1024;
constexpr size_t WS_TOT = WS_SSQ + 256 * 1024;
constexpr size_t WS_X = 8 * MiB;
constexpr size_t WS_W = 80 * MiB;
constexpr size_t W_WIN = WS_W;
constexpr size_t W_BRA = W_WIN + (size_t)NPROJ * 1024 * 2;
constexpr size_t W_BRB = W_BRA + 1024 * 512 * 2;
constexpr size_t W_BRC = W_BRB + 1024 * 512 * 2;
constexpr size_t W_BRD = W_BRC + 1024 * 384 * 2;
constexpr size_t W_OUT = W_BRD + 1024 * 384 * 2;
constexpr size_t W_GLU = W_OUT + 1024 * 1024 * 2;
constexpr size_t W_TQ = W_GLU + 512 * 384 * 2;
constexpr size_t W_P = W_TQ + (size_t)24 * 512 * 768 * 2;
constexpr size_t W_END = W_P + (size_t)24 * 256 * 512 * 2;
constexpr size_t WS_H = 126 * MiB;
constexpr size_t WS_YA = WS_H, WS_YB = WS_H + 18 * MiB;
constexpr size_t WS_PA = 162 * MiB;
constexpr size_t WS_MRG = WS_PA, WS_MRGB = WS_PA + 72 * MiB, WS_XG = WS_PA;
constexpr size_t WS_PG = 297 * MiB;
constexpr size_t WS_HID = WS_PG, WS_YE = WS_PG + 72 * MiB;
constexpr size_t WS_R5 = 441 * MiB;
constexpr size_t WS_QN = WS_R5;
constexpr size_t WS_KN = WS_R5 + 18 * MiB;
constexpr size_t WS_HIN = WS_R5;
constexpr size_t WS_XBC = WS_R5 + 23 * MiB;
constexpr size_t WS_AU = WS_R5 + 50 * MiB;
constexpr size_t WS_S = WS_R5 + 71 * MiB;
constexpr size_t WS_YG = WS_S, WS_YC = WS_S + 14 * MiB;
constexpr size_t WS_S5S = WS_R5 + 107 * MiB;
constexpr size_t WS_YD = WS_R5 + 121 * MiB;
constexpr size_t WS_WGU = WS_R5;
constexpr size_t WS_WD = WS_R5 + 64 * MiB;
constexpr size_t WS_END = 576 * MiB;
static_assert(W_END <= WS_H, "small weights fit");
static_assert(WS_AU + (size_t)24 * 576 * 768 * 2 <= WS_S && WS_XBC + (size_t)MROWS * 768 * 2 <= WS_AU && WS_S + (size_t)8 * 18 * 16 * 4096 * 4 <= WS_S5S, "R5 map");
static_assert(WS_S5S + (size_t)24 * 576 * 256 * 4 <= WS_YD && WS_YD + (size_t)MROWS * 384 * 2 <= WS_END && WS_WD + (size_t)32 * MiB <= WS_END, "R5 map 2");
static_assert(WS_TOT + 16384 <= WS_X && WS_ROPE + 2048 * 64 * 4 <= WS_AFF, "misc map");

constexpr int CW_BAR = 4096;

constexpr int NWAVES = 8;
constexpr int LDS_SCRATCH = 151552;
constexpr int LDSCTL_OFF = LDS_SCRATCH;
constexpr int LDS_BYTES = 155648;

#define LDS_WAIT() asm volatile("s_waitcnt lgkmcnt(0)" ::: "memory")
#define VM_WAIT() asm volatile("s_waitcnt vmcnt(0)" ::: "memory")
DI int fresh_tid() { int t = threadIdx.x; asm volatile("" : "+v"(t)); return t; }
DI unsigned f2bf(float f) { unsigned u = __builtin_bit_cast(unsigned, f); return (u + 0x7fffu + ((u >> 16) & 1u)) >> 16; }
DI unsigned pk2(float lo, float hi) { return f2bf(lo) | (f2bf(hi) << 16); }
DI float bflo(unsigned w) { return __builtin_bit_cast(float, w << 16); }
DI float bfhi(unsigned w) { return __builtin_bit_cast(float, w & 0xffff0000u); }
DI float bf2f(bf16_t h) { return __builtin_bit_cast(float, (unsigned)h << 16); }
DI float silu_f(float x) { return x / (1.f + __expf(-x)); }
DI float sigmoid_f(float x) { return 1.f / (1.f + __expf(-x)); }
DI float softplus_f(float x) { return fmaxf(x, 0.f) + log1pf(__expf(-fabsf(x))); }
DI float gelu_tanh_f(float x) { const float u = 0.7978845608028654f * (x + 0.044715f * x * x * x); const float t = 1.f - 2.f / (__expf(2.f * u) + 1.f); return 0.5f * x * (1.f + t); }
DI float wave_sum(float v) {
#pragma unroll
    for (int o = 1; o < 64; o <<= 1) v += __shfl_xor(v, o);
    return v;
}
DI void unpack8(const u32x4 w, float (&f)[8]) {
    f[0] = bflo(w.x); f[1] = bfhi(w.x); f[2] = bflo(w.y); f[3] = bfhi(w.y); f[4] = bflo(w.z); f[5] = bfhi(w.z); f[6] = bflo(w.w); f[7] = bfhi(w.w);
}
DI u32x4 pack8(const float (&f)[8]) { u32x4 w; w.x = pk2(f[0], f[1]); w.y = pk2(f[2], f[3]); w.z = pk2(f[4], f[5]); w.w = pk2(f[6], f[7]); return w; }

#define XB_TMO      128
#define XB_XCNT(j)  (256  + 64 * (j))
#define XB_XSUB(j)  (1280 + 64 * (j))
#define XB_XGEN(j)  (2304 + 64 * (j))
#define XB_TOP      3328
#define XB_TOPGEN   3392
#define XCD_BAR_WORDS 3456
#define XB_SPIN_CAP (1u << 20)
DI unsigned xb_ld(unsigned* p)              { return __hip_atomic_load(p, __ATOMIC_RELAXED, __HIP_MEMORY_SCOPE_AGENT); }
DI unsigned xb_add(unsigned* p, unsigned v) { return __hip_atomic_fetch_add(p, v, __ATOMIC_RELAXED, __HIP_MEMORY_SCOPE_AGENT); }
DI unsigned xb_xcc_id() { return (unsigned)__builtin_amdgcn_s_getreg((3 << 11) | 20) & 0xFu; }
#define XB_SPIN(cond, bar) do { unsigned _sp = 0; while (cond) { __builtin_amdgcn_s_sleep(1); \
    if ((++_sp & 255u) == 0u) { if (xb_ld(&(bar)[XB_TMO])) break; if (_sp > XB_SPIN_CAP) { atomicAdd(&(bar)[XB_TMO], 1u); break; } } } } while (0)
struct XcdBarrier { unsigned* bar; unsigned x; volatile LAS unsigned* st; };
DI XcdBarrier xcd_barrier_post(unsigned* bar, volatile LAS unsigned* st) {
    XcdBarrier b; b.bar = bar; b.x = xb_xcc_id(); b.st = st;
    if (threadIdx.x == 0) (void)xb_add(&bar[XB_XCNT(b.x)], 1u);
    return b;
}
DI void xcd_barrier_complete(unsigned* bar, unsigned x, unsigned& nloc, unsigned& nx) {
    const unsigned G = gridDim.x * gridDim.y * gridDim.z;
    unsigned sum, cnt, mine, sp = 0u;
    for (;;) {
        sum = 0u; cnt = 0u; mine = 0u;
#pragma unroll
        for (unsigned j = 0; j < 16; ++j) { const unsigned c = xb_ld(&bar[XB_XCNT(j)]); sum += c; cnt += (c > 0u) ? 1u : 0u; mine = (j == x) ? c : mine; }
        if (sum == G) break;
        __builtin_amdgcn_s_sleep(1);
        if ((++sp & 255u) == 0u) { if (xb_ld(&bar[XB_TMO])) break; if (sp > XB_SPIN_CAP) { atomicAdd(&bar[XB_TMO], 1u); break; } }
    }
    nloc = mine > 0u ? mine : 1u; nx = cnt > 0u ? cnt : 1u;
}
DI void xcd_barrier(const XcdBarrier& b) {
    asm volatile("s_waitcnt vmcnt(0)" ::: "memory");
    __syncthreads();
    if (threadIdx.x == 0) {
        unsigned* bar = b.bar;
        __builtin_amdgcn_s_waitcnt(0);
        unsigned nloc = b.st[0], nx = b.st[1];
        if (nloc == 0u) { xcd_barrier_complete(bar, b.x, nloc, nx); b.st[0] = nloc; b.st[1] = nx; }
        const unsigned old = xb_add(&bar[XB_XSUB(b.x)], 1u);
        const unsigned gen = old / nloc;
        if (old + 1u == (gen + 1u) * nloc) {
            __builtin_amdgcn_fence(__ATOMIC_RELEASE, "agent");
            asm volatile("s_waitcnt vmcnt(0)" ::: "memory");
            const unsigned og = xb_add(&bar[XB_TOP], 1u);
            const unsigned tg = og / nx;
            if (og + 1u == (tg + 1u) * nx) xb_add(&bar[XB_TOPGEN], 1u);
            else XB_SPIN(xb_ld(&bar[XB_TOPGEN]) == tg, bar);
            __builtin_amdgcn_fence(__ATOMIC_ACQUIRE, "agent");
            xb_add(&bar[XB_XGEN(b.x)], 1u);
            asm volatile("s_waitcnt vmcnt(0)" ::: "memory");
        } else {
            XB_SPIN(xb_ld(&bar[XB_XGEN(b.x)]) == gen, bar);
            __builtin_amdgcn_fence(__ATOMIC_ACQUIRE, "agent");
            asm volatile("s_waitcnt vmcnt(0)" ::: "memory");
        }
    }
    __syncthreads();
}

namespace pg8 {
constexpr int BM = 256, BK = 64, HALF = 128, HTB = HALF * BK * 2, STAGE_BYTES = 8 * HTB, NXCD = 8, WGM = 8;
__host__ __device__ __forceinline__ int lds_byte(int r, int c) { const int st = (r >> 4) * 2 + (c >> 5), rr = r & 15, cc = c & 31, ob = rr * 64 + cc * 2; return st * 1024 + (ob ^ (((ob >> 9) & 1) << 5)); }
__host__ __device__ __forceinline__ void stage_rc(int b, int& R, int& C) { const int st = b / 1024, sb = b % 1024, swz = sb ^ (((sb >> 9) & 1) << 5); R = (st >> 1) * 16 + swz / 64; C = (st & 1) * 32 + (swz % 64) / 2; }
__host__ __device__ __forceinline__ int perm32(int rho) { const int n = rho >> 4, i = rho & 15; return 8 * (i >> 2) + 4 * n + (i & 3); }

struct Unit { int arow, brow, pm, pn; };
struct Gemm { const bf16_t* A; const bf16_t* Bt; int lda, ldb, K; };

template <class Epi, class Sched, bool ALIGN_EPI = true>
DI void gemm_phase(LAS unsigned char* lds, const Gemm g, const Sched& S, const Epi& E) {
    const int tid = fresh_tid(), wid = __builtin_amdgcn_readfirstlane(tid >> 6), lane = tid & 63, wr = wid >> 2, wc = wid & 3, fr = lane & 15, fq = lane >> 4;
    const int K = g.K, nt = K / BK;
    unsigned voffA[2], voffB[2];
#pragma unroll
    for (int i = 0; i < 2; ++i) { int R, C; stage_rc(tid * 16 + i * 8192, R, C); const int Rb = Epi::PERM ? ((R & ~31) + perm32(R & 31)) : R;
        voffA[i] = (unsigned)(R * g.lda + C) * 2u; voffB[i] = (unsigned)(Rb * g.ldb + C) * 2u; }
    const size_t kstep = (size_t)(BK * 2);
    const size_t hA = (size_t)HALF * g.lda * 2, hB = (size_t)HALF * g.ldb * 2;
    const unsigned ldsw = (unsigned)wid * 1024u;
    const int aoff = lds_byte(wr * 64 + fr, fq * 8), boff = lds_byte(wc * 32 + fr, fq * 8);
#define PG8_SA(b, h) (((b) * 2 + (h)) * HTB)
#define PG8_SB(b, h) ((4 + (b) * 2 + (h)) * HTB)
#define PG8_STAGE(bufoff, gbase, voff) do { _Pragma("unroll") for (int _i = 0; _i < 2; ++_i) \
        __builtin_amdgcn_global_load_lds((const unsigned*)((const char*)(gbase) + (voff)[_i]), (LAS unsigned*)(lds + (bufoff) + ldsw + _i * 8192), 16, 0, 0); } while (0)
#define PG8_LDA(dst, b, h) do { _Pragma("unroll") for (int m = 0; m < 4; ++m) _Pragma("unroll") for (int k = 0; k < 2; ++k) dst[m][k] = *(const LAS bf16x8*)(lds + PG8_SA(b, h) + aoff + m * 2048 + k * 1024); } while (0)
#define PG8_LDB(dst, b, h) do { _Pragma("unroll") for (int n = 0; n < 2; ++n) _Pragma("unroll") for (int k = 0; k < 2; ++k) dst[n][k] = *(const LAS bf16x8*)(lds + PG8_SB(b, h) + boff + n * 2048 + k * 1024); } while (0)
#define PG8_MMA(ai, bj, At, Bt) do { __builtin_amdgcn_s_setprio(1); _Pragma("unroll") for (int m = 0; m < 4; ++m) _Pragma("unroll") for (int n = 0; n < 2; ++n) _Pragma("unroll") for (int k = 0; k < 2; ++k) \
        acc[ai][bj][m][n] = __builtin_amdgcn_mfma_f32_16x16x32_bf16(Bt[n][k], At[m][k], acc[ai][bj][m][n], 0, 0, 0); __builtin_amdgcn_s_setprio(0); } while (0)
#define PG8_WAIT_V(n) asm volatile("s_waitcnt vmcnt(" #n ")" ::: "memory")
#define PG8_WAIT_L(n) asm volatile("s_waitcnt lgkmcnt(" #n ")" ::: "memory")
#define PG8_BAR __builtin_amdgcn_s_barrier()
#define PG8_SCHED __builtin_amdgcn_sched_barrier(0)
    int ui = 0;
    Unit cur = S.next(0);
    if (cur.arow < 0) return;
    f32x4 acc[2][2][4][2];
#pragma unroll
    for (int a = 0; a < 2; ++a)
#pragma unroll
        for (int b = 0; b < 2; ++b)
#pragma unroll
            for (int m = 0; m < 4; ++m)
#pragma unroll
                for (int n = 0; n < 2; ++n) acc[a][b][m][n] = (f32x4){0.f, 0.f, 0.f, 0.f};
    bf16x8 At[4][2], B0[2][2], B1[2][2];
    const char* cA = (const char*)g.A + (size_t)cur.arow * g.lda * 2; const char* cB = (const char*)g.Bt + (size_t)cur.brow * g.ldb * 2;
    PG8_STAGE(PG8_SB(0, 0), cB, voffB); PG8_STAGE(PG8_SB(0, 1), cB + hB, voffB); PG8_STAGE(PG8_SA(0, 0), cA, voffA); PG8_STAGE(PG8_SA(0, 1), cA + hA, voffA);
    if (wr == 1) PG8_BAR;
    PG8_WAIT_V(2); PG8_BAR;
    PG8_STAGE(PG8_SB(1, 0), cB + kstep, voffB); PG8_STAGE(PG8_SA(1, 0), cA + kstep, voffA); PG8_STAGE(PG8_SB(1, 1), cB + hB + kstep, voffB);
    PG8_WAIT_V(6); PG8_BAR;
    for (;;) {
        const Unit nxt = S.next(ui + 1);
        const bool has_next = nxt.arow >= 0;
        const char* nA = has_next ? (const char*)g.A + (size_t)nxt.arow * g.lda * 2 : cA; const char* nB = has_next ? (const char*)g.Bt + (size_t)nxt.brow * g.ldb * 2 : cB;
#pragma unroll 1
        for (int t = 0; t < nt; t += 2) {
            const bool last = (t == nt - 2);
            const char* a1 = cA + (size_t)(t + 1) * kstep;
            const char* a2 = last ? nA : cA + (size_t)(t + 2) * kstep; const char* b2 = last ? nB : cB + (size_t)(t + 2) * kstep;
            const char* a3 = a2 + kstep; const char* b3 = b2 + kstep;
            PG8_LDB(B0, 0, 0); PG8_LDB(B1, 0, 1); PG8_SCHED; PG8_LDA(At, 0, 0); PG8_STAGE(PG8_SA(1, 1), a1 + hA, voffA);
            PG8_WAIT_V(8); PG8_WAIT_L(0); PG8_BAR; PG8_MMA(0, 0, At, B0); PG8_MMA(0, 1, At, B1); PG8_BAR; PG8_SCHED;
            PG8_LDA(At, 0, 1); PG8_STAGE(PG8_SB(0, 0), b2, voffB); PG8_STAGE(PG8_SB(0, 1), b2 + hB, voffB); PG8_STAGE(PG8_SA(0, 0), a2, voffA);
            PG8_WAIT_V(8); PG8_WAIT_L(0); PG8_BAR; PG8_MMA(1, 0, At, B0); PG8_MMA(1, 1, At, B1); PG8_BAR; PG8_SCHED;
            PG8_LDB(B0, 1, 0); PG8_LDB(B1, 1, 1); PG8_SCHED; PG8_LDA(At, 1, 0); PG8_STAGE(PG8_SA(0, 1), a2 + hA, voffA);
            PG8_WAIT_V(8); PG8_WAIT_L(0); PG8_BAR; PG8_MMA(0, 0, At, B0); PG8_MMA(0, 1, At, B1); PG8_BAR; PG8_SCHED;
            PG8_LDA(At, 1, 1); PG8_STAGE(PG8_SB(1, 0), b3, voffB); PG8_STAGE(PG8_SB(1, 1), b3 + hB, voffB); PG8_STAGE(PG8_SA(1, 0), a3, voffA);
            PG8_WAIT_V(8); PG8_WAIT_L(0); PG8_BAR; PG8_MMA(1, 0, At, B0); PG8_MMA(1, 1, At, B1); PG8_BAR; PG8_SCHED;
        }
        if constexpr (ALIGN_EPI) { if (wr == 0) PG8_BAR; }
        E(acc, cur, wr, wc, fr, fq);
        if (!has_next) break;
#pragma unroll
        for (int a = 0; a < 2; ++a)
#pragma unroll
            for (int b = 0; b < 2; ++b)
#pragma unroll
                for (int m = 0; m < 4; ++m)
#pragma unroll
                    for (int n = 0; n < 2; ++n) acc[a][b][m][n] = (f32x4){0.f, 0.f, 0.f, 0.f};
        cur = nxt; cA = nA; cB = nB; ++ui;
        if constexpr (ALIGN_EPI) { if (wr == 1) PG8_BAR; }
    }
    PG8_WAIT_V(0);
    if constexpr (!ALIGN_EPI) { if (wr == 0) PG8_BAR; }
    PG8_BAR;
#undef PG8_SA
#undef PG8_SB
#undef PG8_STAGE
#undef PG8_LDA
#undef PG8_LDB
#undef PG8_MMA
#undef PG8_WAIT_V
#undef PG8_WAIT_L
#undef PG8_BAR
#undef PG8_SCHED
}
}

using pg8::Unit;

struct EpiProj {
    static constexpr bool PERM = true;
    bf16_t* O0; int ld0; int split_pn; bf16_t* O1; int ld1;
    DI void operator()(const f32x4 (&acc)[2][2][4][2], const Unit& u, int wr, int wc, int fr, int fq) const {
        bf16_t* base; int ld, ct;
        if (u.pn < split_pn) { base = O0; ld = ld0; ct = u.pn * 256; } else { base = O1; ld = ld1; ct = (u.pn - split_pn) * 256; }
        const int row0 = u.arow + wr * 64 + fr, col0 = ct + wc * 32 + 8 * fq;
#pragma unroll
        for (int ai = 0; ai < 2; ++ai)
#pragma unroll
            for (int m = 0; m < 4; ++m) { bf16_t* rowp = base + (size_t)(row0 + ai * 128 + m * 16) * ld + col0;
#pragma unroll
                for (int bj = 0; bj < 2; ++bj) { const f32x4 v0 = acc[ai][bj][m][0], v1 = acc[ai][bj][m][1];
                    u32x4 w; w.x = pk2(v0[0], v0[1]); w.y = pk2(v0[2], v0[3]); w.z = pk2(v1[0], v1[1]); w.w = pk2(v1[2], v1[3]);
                    *(u32x4*)(rowp + bj * 128) = w; } }
    }
};

struct EpiMerge {
    static constexpr bool PERM = true;
    const bf16_t* G; float* MRG; bf16_t* MRGB; const float* ssq; int mode;
    DI void operator()(const f32x4 (&acc)[2][2][4][2], const Unit& u, int wr, int wc, int fr, int fq) const {
        const int row0 = u.arow + wr * 64 + fr, col0 = u.pn * 256 + wc * 32 + 8 * fq;
#pragma unroll
        for (int ai = 0; ai < 2; ++ai)
#pragma unroll
            for (int m = 0; m < 4; ++m) { const int row = row0 + ai * 128 + m * 16;
                float rs = 1.f; if (ssq) rs = 1.0f / sqrtf((ssq[2 * row] + ssq[2 * row + 1]) * (1.f / 512.f) + RMS_EPS);
#pragma unroll
                for (int bj = 0; bj < 2; ++bj) { const size_t off = (size_t)row * 1024 + col0 + bj * 128;
                    const u32x4 gw = *(const u32x4*)(G + (size_t)row * PG_W + col0 + bj * 128);
                    float gf[8]; unpack8(gw, gf);
                    f32x4 v0 = acc[ai][bj][m][0], v1 = acc[ai][bj][m][1];
#pragma unroll
                    for (int k = 0; k < 4; ++k) { v0[k] *= rs * sigmoid_f(gf[k]); v1[k] *= rs * sigmoid_f(gf[4 + k]); }
                    if (mode != 0) { v0 += *(const f32x4*)(MRG + off); v1 += *(const f32x4*)(MRG + off + 4); }
                    if (mode != 2) { *(f32x4*)(MRG + off) = v0; *(f32x4*)(MRG + off + 4) = v1; }
                    else { u32x4 w; w.x = pk2(v0[0], v0[1]); w.y = pk2(v0[2], v0[3]); w.z = pk2(v1[0], v1[1]); w.w = pk2(v1[2], v1[3]); *(u32x4*)(MRGB + off) = w; } __builtin_amdgcn_sched_barrier(0); } }
    }
};

struct EpiWout {
    static constexpr bool PERM = true;
    float* X; const float* modl;
    DI void operator()(const f32x4 (&acc)[2][2][4][2], const Unit& u, int wr, int wc, int fr, int fq) const {
        const int tile = u.arow / 256, b = tile / 9, jj = tile % 9, mrow = (jj == 0) ? 8 : b;
        const int row0 = u.arow + wr * 64 + fr, col0 = u.pn * 256 + wc * 32 + 8 * fq;
        const float* mg = modl + (size_t)mrow * 6144 + 2 * 1024;
#pragma unroll
        for (int bj = 0; bj < 2; ++bj) { const int col = col0 + bj * 128;
            const f32x4 g0 = *(const f32x4*)(mg + col), g1 = *(const f32x4*)(mg + col + 4);
#pragma unroll
            for (int ai = 0; ai < 2; ++ai)
#pragma unroll
                for (int m = 0; m < 4; ++m) { float* p = X + (size_t)(row0 + ai * 128 + m * 16) * 1024 + col;
                    f32x4 x0 = *(const f32x4*)p, x1 = *(const f32x4*)(p + 4);
                    x0 += g0 * acc[ai][bj][m][0]; x1 += g1 * acc[ai][bj][m][1];
                    *(f32x4*)p = x0; *(f32x4*)(p + 4) = x1; __builtin_amdgcn_sched_barrier(0); } }
    }
};

struct EpiGlu {
    static constexpr bool PERM = true;
    const bf16_t* YG; bf16_t* YC; const float* bglu;
    DI void operator()(const f32x4 (&acc)[2][2][4][2], const Unit& u, int wr, int wc, int fr, int fq) const {
        const int row0 = u.arow + wr * 64 + fr, col0 = u.pn * 256 + wc * 32 + 8 * fq;
#pragma unroll
        for (int bj = 0; bj < 2; ++bj) { const int col = col0 + bj * 128; if (u.pn == 1 && bj == 1) continue;
            const f32x4 b0 = *(const f32x4*)(bglu + col), b1 = *(const f32x4*)(bglu + col + 4);
#pragma unroll
            for (int ai = 0; ai < 2; ++ai)
#pragma unroll
                for (int m = 0; m < 4; ++m) { const size_t off = (size_t)(row0 + ai * 128 + m * 16) * 384 + col;
                    float y[8]; unpack8(*(const u32x4*)(YG + off), y);
                    const f32x4 a0 = acc[ai][bj][m][0] + b0, a1 = acc[ai][bj][m][1] + b1;
                    float o[8];
#pragma unroll
                    for (int k = 0; k < 4; ++k) { o[k] = y[k] * sigmoid_f(a0[k]); o[4 + k] = y[4 + k] * sigmoid_f(a1[k]); }
                    *(u32x4*)(YC + off) = pack8(o); __builtin_amdgcn_sched_barrier(0); } }
    }
};

struct EpiS5S {
    static constexpr bool PERM = true;
    float* S;
    DI void operator()(const f32x4 (&acc)[2][2][4][2], const Unit& u, int wr, int wc, int fr, int fq) const {
        const int m0 = u.pn * 256 + wr * 64 + fr, col0 = wc * 32 + 8 * fq;
#pragma unroll
        for (int ai = 0; ai < 2; ++ai)
#pragma unroll
            for (int m = 0; m < 4; ++m) { const int mm = m0 + ai * 128 + m * 16; if (u.pn == 2 && (ai == 1 || wr == 1)) continue;
                float* p = S + ((size_t)u.pm * 576 + mm) * 256 + col0;
#pragma unroll
                for (int bj = 0; bj < 2; ++bj) { *(f32x4*)(p + bj * 128) = acc[ai][bj][m][0]; *(f32x4*)(p + bj * 128 + 4) = acc[ai][bj][m][1]; } }
    }
};

struct EpiS5Y {
    static constexpr bool PERM = true;
    const bf16_t* AU; bf16_t* YG; const float* dsk;
    DI void operator()(const f32x4 (&acc)[2][2][4][2], const Unit& u, int wr, int wc, int fr, int fq) const {
        const int g = u.pm / 3, j = u.pm % 3;
        const int m0 = j * 256 + wr * 64 + fr, n0 = u.pn * 256 + wc * 32 + 8 * fq;
#pragma unroll
        for (int bj = 0; bj < 2; ++bj) { const int n = n0 + bj * 128, i = n >> 4, a0 = n & 15;
            const f32x4 d0 = *(const f32x4*)(dsk + g * 16 + a0), d1 = *(const f32x4*)(dsk + g * 16 + a0 + 4);
#pragma unroll
            for (int ai = 0; ai < 2; ++ai)
#pragma unroll
                for (int m = 0; m < 4; ++m) { const int mm = m0 + ai * 128 + m * 16; if (j == 2 && (ai == 1 || wr == 1)) continue;
                    float uu[8]; unpack8(*(const u32x4*)(AU + ((size_t)g * 576 + mm) * 768 + n), uu);
                    const f32x4 v0 = acc[ai][bj][m][0], v1 = acc[ai][bj][m][1];
                    float o[8];
#pragma unroll
                    for (int k = 0; k < 4; ++k) { o[k] = gelu_tanh_f(v0[k] + d0[k] * uu[k]); o[4 + k] = gelu_tanh_f(v1[k] + d1[k] * uu[4 + k]); }
                    *(u32x4*)(YG + (size_t)(mm * 32 + i) * 384 + g * 16 + a0) = pack8(o); __builtin_amdgcn_sched_barrier(0); } }
    }
};

struct EpiUp {
    static constexpr bool PERM = true;
    bf16_t* HID;
    DI void operator()(const f32x4 (&acc)[2][2][4][2], const Unit& u, int wr, int wc, int fr, int fq) const {
        const int row0 = u.arow + wr * 64 + fr, col0 = u.pn * 128 + wc * 32 + 8 * fq;
#pragma unroll
        for (int ai = 0; ai < 2; ++ai)
#pragma unroll
            for (int m = 0; m < 4; ++m) { const f32x4 g0 = acc[ai][0][m][0], g1 = acc[ai][0][m][1], u0 = acc[ai][1][m][0], u1 = acc[ai][1][m][1];
                float o[8];
#pragma unroll
                for (int k = 0; k < 4; ++k) { o[k] = silu_f(g0[k]) * u0[k]; o[4 + k] = silu_f(g1[k]) * u1[k]; }
                *(u32x4*)(HID + (size_t)(row0 + ai * 128 + m * 16) * 1024 + col0) = pack8(o); }
    }
};

struct EpiDown {
    static constexpr bool PERM = true;
    bf16_t* YE; const float* GV;
    DI void operator()(const f32x4 (&acc)[2][2][4][2], const Unit& u, int wr, int wc, int fr, int fq) const {
        const int row0 = u.arow + wr * 64 + fr, col0 = u.pn * 256 + wc * 32 + 8 * fq;
#pragma unroll
        for (int ai = 0; ai < 2; ++ai)
#pragma unroll
            for (int m = 0; m < 4; ++m) { const int row = row0 + ai * 128 + m * 16; const float gv = GV[row];
#pragma unroll
                for (int bj = 0; bj < 2; ++bj) { const f32x4 v0 = acc[ai][bj][m][0] * gv, v1 = acc[ai][bj][m][1] * gv;
                    u32x4 w; w.x = pk2(v0[0], v0[1]); w.y = pk2(v0[2], v0[3]); w.z = pk2(v1[0], v1[1]); w.w = pk2(v1[2], v1[3]);
                    *(u32x4*)(YE + (size_t)row * 1024 + col0 + bj * 128) = w; } }
    }
};

DI Unit mk_unit(int arow, int brow, int pm, int pn) { Unit u; u.arow = arow; u.brow = brow; u.pm = pm; u.pn = pn; return u; }
struct RowSkipOrder {
    int nN, G, c, skipctx, keep_lo, keep_hi, nmain, total;
    DI void init(int N, int G_, int c_, int skipctx_, int keep_lo_, int keep_hi_) { nN = N / 256; G = G_; c = c_; skipctx = skipctx_; keep_lo = keep_lo_; keep_hi = keep_hi_;
        nmain = (skipctx ? 64 : 72) * nN; total = nmain + (skipctx ? 8 * (keep_hi - keep_lo) : 0); }
    DI Unit next(int i) const {
        const int L0 = i * G + c; if (L0 >= total) return mk_unit(-1, 0, 0, 0);
        const int q = total / 8, r = total % 8, xcd = L0 % 8, off = L0 / 8;
        const int L = (xcd < r ? xcd * (q + 1) : r * (q + 1) + (xcd - r) * q) + off;
        const int nig = 8 * nN, gid = L / nig, rr = L % nig, lt = gid * 8 + (rr % 8);
        const int pm_main = skipctx ? ((lt / 8) * 9 + 1 + (lt % 8)) : lt, pn_main = rr / 8;
        const int Lc = L - nmain, pm_ctx = (Lc % 8) * 9, pn_ctx = keep_lo + Lc / 8;
        const bool main = L < nmain;
        const int pm = main ? pm_main : pm_ctx, pn = main ? pn_main : pn_ctx;
        return mk_unit(pm * 256, pn * 256, pm, pn);
    }
};
struct OrderS5S { int G, c; DI Unit next(int i) const { const int L = i * G + c; if (L >= 72) return mk_unit(-1, 0, 0, 0); const int g = L / 3, j = L % 3; return mk_unit(g * 576 + j * 256, g * 256, g, j); } };
struct OrderS5Y { int G, c; DI Unit next(int i) const { const int L = i * G + c; if (L >= 144) return mk_unit(-1, 0, 0, 0); const int g = L / 6, r = L % 6, j = r >> 1, nh = r & 1;
    return mk_unit(g * 576 + j * 256, g * 512 + nh * 256, g * 3 + j, nh); } };
struct OrderUp { int G, c, nJ; DI Unit next(int i) const { const int L = i * G + c; if (L >= 16 * nJ * 8) return mk_unit(-1, 0, 0, 0); const int n = L & 7, t = L >> 3, jt = t % nJ, e = t / nJ;
    return mk_unit(e * EROWS + jt * 256, e * 2048 + n * 256, e, n); } };
struct OrderDown { int G, c, nJ; DI Unit next(int i) const { const int L = i * G + c; if (L >= 16 * nJ * 4) return mk_unit(-1, 0, 0, 0); const int n = L & 3, t = L >> 2, jt = t % nJ, e = t / nJ;
    return mk_unit(e * EROWS + jt * 256, e * 1024 + n * 256, e, n); } };

struct Frame {
    LAS unsigned char* lds;
    int tid, lane, wave, G, vcu, gw, NGW;
};

template <class DstRow>
DI void tr_item(const float* __restrict__ W, int ldw, int nvalid, int nstore, int K, bf16_t* __restrict__ WT, int k0, int n0, const DstRow& drow, const float* __restrict__ kscale, LAS float* scr  , int lane) {
    const int c4 = (lane & 15) * 4, r0 = lane >> 4;
    f32x4 v[16];
#pragma unroll
    for (int i = 0; i < 16; ++i) { const int kk = 4 * i + r0; v[i] = (n0 + c4 < nvalid) ? *(const f32x4*)(W + (size_t)(k0 + kk) * ldw + n0 + c4) : (f32x4){0.f, 0.f, 0.f, 0.f}; }
#pragma unroll
    for (int i = 0; i < 16; ++i) { const int kk = 4 * i + r0; f32x4 x = v[i]; if (kscale) x = x * kscale[k0 + kk];
        LAS float* d = scr + kk * 65 + c4; d[0] = x[0]; d[1] = x[1]; d[2] = x[2]; d[3] = x[3]; }
    LDS_WAIT(); asm volatile("" ::: "memory");
    const int c = lane & 7;
#pragma unroll
    for (int j = 0; j < 8; ++j) { const int n = (lane >> 3) + 8 * j; const LAS float* s = scr + (8 * c) * 65 + n;
        u32x4 o; o.x = pk2(s[0 * 65], s[1 * 65]); o.y = pk2(s[2 * 65], s[3 * 65]); o.z = pk2(s[4 * 65], s[5 * 65]); o.w = pk2(s[6 * 65], s[7 * 65]);
        if (n0 + n < nstore) *(u32x4*)(WT + (size_t)drow(n0 + n) * K + k0 + 8 * c) = o; }
    LDS_WAIT(); asm volatile("" ::: "memory");
}
struct DrIdent { int off; DI int operator()(int n) const { return off + n; } };
struct DrWin { DI int operator()(int n) const { return n < C_G ? n : n + (PA_W - C_G); } };
struct DrGU { int base; DI int operator()(int f) const { return base + (f >> 7) * 256 + (f & 127); } };

struct LayerIn {
    const float *w_in, *q_norm_g, *k_norm_g, *ssd_conv_w, *ssd_conv_b, *ssd_dt_bias, *ssd_a_log, *ssd_d, *ssd_norm_g;
    const float *s5_lre, *s5_lim, *s5_lstep, *s5_bre, *s5_bim, *s5_cre, *s5_cim, *s5_d, *s5_wglu, *s5_bglu, *sc_conv_w;
    const float *w_br_attn, *w_br_ssd, *w_br_s5, *w_br_sc, *w_out, *w_router, *w_gate, *w_up, *w_down, *norm_mix_g, *norm_ffn_g;
};

DI void prep_small_weights(const Frame& F, const LayerIn& P, unsigned char* ws) {
    LAS float* scr = (LAS float*)(F.lds + F.wave * 16896);
    bf16_t* WIN = (bf16_t*)(ws + W_WIN);
    constexpr int NB_WIN = (NIN + 63) / 64;
    constexpr int I_WIN = 16 * NB_WIN, I_PAD = 62, I_BA = 8 * 16, I_BB = 8 * 16, I_BC = 6 * 16, I_BD = 6 * 16, I_OUT = 16 * 16, I_GLU = 6 * 8;
    constexpr int NIT = I_WIN + I_PAD + I_BA + I_BB + I_BC + I_BD + I_OUT + I_GLU;
    for (int it = F.gw; it < NIT; it += F.NGW) {
        int r = it;
        if (r < I_WIN) { const int kb = r / NB_WIN, nb = r % NB_WIN; tr_item(P.w_in, NIN, NIN, NIN, 1024, WIN, kb * 64, nb * 64, DrWin{}, nullptr, scr, F.lane); continue; } r -= I_WIN;
        if (r < I_PAD) {
#pragma unroll
            for (int j = 0; j < 8; ++j) { const int idx = j * 64 + F.lane, row = C_G + r * 4 + (idx >> 7), ch = idx & 127; *(u32x4*)(WIN + (size_t)row * 1024 + ch * 8) = (u32x4){0u, 0u, 0u, 0u}; }
            continue; } r -= I_PAD;
        if (r < I_BA) { tr_item(P.w_br_attn, 1024, 1024, 1024, 512, (bf16_t*)(ws + W_BRA), (r / 16) * 64, (r % 16) * 64, DrIdent{0}, nullptr, scr, F.lane); continue; } r -= I_BA;
        if (r < I_BB) { tr_item(P.w_br_ssd, 1024, 1024, 1024, 512, (bf16_t*)(ws + W_BRB), (r / 16) * 64, (r % 16) * 64, DrIdent{0}, P.ssd_norm_g, scr, F.lane); continue; } r -= I_BB;
        if (r < I_BC) { tr_item(P.w_br_s5, 1024, 1024, 1024, 384, (bf16_t*)(ws + W_BRC), (r / 16) * 64, (r % 16) * 64, DrIdent{0}, nullptr, scr, F.lane); continue; } r -= I_BC;
        if (r < I_BD) { tr_item(P.w_br_sc, 1024, 1024, 1024, 384, (bf16_t*)(ws + W_BRD), (r / 16) * 64, (r % 16) * 64, DrIdent{0}, nullptr, scr, F.lane); continue; } r -= I_BD;
        if (r < I_OUT) { tr_item(P.w_out, 1024, 1024, 1024, 1024, (bf16_t*)(ws + W_OUT), (r / 16) * 64, (r % 16) * 64, DrIdent{0}, nullptr, scr, F.lane); continue; } r -= I_OUT;
        tr_item(P.s5_wglu, 384, 384, 512, 384, (bf16_t*)(ws + W_GLU), (r / 8) * 64, (r % 8) * 64, DrIdent{0}, nullptr, scr, F.lane);
    }
}
DI void prep_expert_weights(const Frame& F, const LayerIn& P, unsigned char* ws) {
    LAS float* scr = (LAS float*)(F.lds + F.wave * 16896);
    constexpr int PER = 16 * 16, NIT = 3 * 16 * PER;
    for (int it = F.gw; it < NIT; it += F.NGW) {
        const int which = it / (16 * PER), r = it % (16 * PER), e = r / PER, q = r % PER, k0 = (q / 16) * 64, n0 = (q % 16) * 64;
        if (which == 0) tr_item(P.w_gate + (size_t)e * 1024 * 1024, 1024, 1024, 1024, 1024, (bf16_t*)(ws + WS_WGU), k0, n0, DrGU{e * 2048}, nullptr, scr, F.lane);
        else if (which == 1) tr_item(P.w_up + (size_t)e * 1024 * 1024, 1024, 1024, 1024, 1024, (bf16_t*)(ws + WS_WGU), k0, n0, DrGU{e * 2048 + 128}, nullptr, scr, F.lane);
        else tr_item(P.w_down + (size_t)e * 1024 * 1024, 1024, 1024, 1024, 1024, (bf16_t*)(ws + WS_WD), k0, n0, DrIdent{e * 1024}, nullptr, scr, F.lane);
    }
}

DI void prep_mod(const Frame& F, const float* __restrict__ c, const float* __restrict__ c_ctx, const float* __restrict__ w_mod, const float* __restrict__ b_mod, float* __restrict__ MOD) {
    if ((int)blockIdx.x >= 2 * 96) return;
    LAS float* sc = (LAS float*)F.lds;
    LAS float* red = sc + 9 * 1024;
    for (int o = F.tid; o < 9 * 1024; o += 512) { const float cv = (o < 8 * 1024) ? c[o] : c_ctx[o - 8 * 1024]; sc[o] = silu_f(cv); }
    __syncthreads();
    for (int it = blockIdx.x; it < 2 * 96; it += F.G) {
        const int l = it / 96, cb = it % 96, n = cb * 64 + F.lane;
        const float* W = w_mod + (size_t)l * 1024 * 6144;
        float acc[9];
#pragma unroll
        for (int r = 0; r < 9; ++r) acc[r] = 0.f;
        const int kbeg = F.wave * 128;
#pragma unroll 1
        for (int k8 = 0; k8 < 128; k8 += 16) { float w[16];
#pragma unroll
            for (int j = 0; j < 16; ++j) w[j] = W[(size_t)(kbeg + k8 + j) * 6144 + n];
#pragma unroll
            for (int j = 0; j < 16; ++j)
#pragma unroll
                for (int r = 0; r < 9; ++r) acc[r] += sc[r * 1024 + kbeg + k8 + j] * w[j]; }
#pragma unroll
        for (int r = 0; r < 9; ++r) red[(F.wave * 9 + r) * 64 + F.lane] = acc[r];
        __syncthreads();
        for (int o = F.tid; o < 9 * 64; o += 512) { const int r = o >> 6, ln = o & 63; float s = 0.f;
#pragma unroll
            for (int w = 0; w < 8; ++w) s += red[(w * 9 + r) * 64 + ln];
            MOD[((size_t)l * 9 + r) * 6144 + cb * 64 + ln] = s + b_mod[l * 6144 + cb * 64 + ln]; }
        __syncthreads();
    }
    __syncthreads();
}
DI void prep_rope(const Frame& F, float* ROPE) {
    for (int idx = blockIdx.x * 512 + F.tid; idx < 2048 * 32; idx += F.G * 512) {
        const int t = idx >> 5, j = idx & 31, i = j & 15;
        const float inv = powf(10000.f, -(float)(2 * i) / 32.f);
        const float pos = (j < 16) ? (float)(t >> 6) : (float)(t & 63);
        const float a = pos * inv;
        ROPE[t * 64 + j] = cosf(a); ROPE[t * 64 + 32 + j] = sinf(a);
    }
}

DI void prep_s5(const Frame& F, const LayerIn& P, unsigned char* ws) {
    if ((int)blockIdx.x >= 24) return;
    LAS float* pw = (LAS float*)F.lds;
    LAS float* bb = pw + 8448;
    LAS float* Kt = bb + 4096;
    LAS float* cc = Kt + 16384;
    for (int g = blockIdx.x; g < 24; g += F.G) {
        for (int o = F.tid; o < 2048; o += 512) cc[o] = (o < 1024) ? P.s5_cre[(size_t)g * 1024 + o] : P.s5_cim[(size_t)g * 1024 + o - 1024];
        if (F.tid < 128) { const int d = F.tid >> 6, p = F.tid & 63;
            const float step = __expf(P.s5_lstep[d * 24 + g]);
            const float lr = P.s5_lre[(d * 24 + g) * 64 + p], li = P.s5_lim[(d * 24 + g) * 64 + p];
            const float th = li * step, sh = sinf(0.5f * th);
            const float mag = expf(lr * step), abi = mag * sinf(th);
            const float nr = expm1f(lr * step) - 2.f * mag * sh * sh, ni = abi;
            const float den = lr * lr + li * li;
            const float cr = (nr * lr + ni * li) / den, ci = (ni * lr - nr * li) / den;
            for (int j = 0; j < 16; ++j) { const float br = P.s5_bre[((size_t)g * 64 + p) * 16 + j], bi = P.s5_bim[((size_t)g * 64 + p) * 16 + j];
                bb[((d * 64 + p) * 16 + j) * 2 + 0] = cr * br - ci * bi; bb[((d * 64 + p) * 16 + j) * 2 + 1] = cr * bi + ci * br; } }
        for (int o = F.tid; o < 2 * 64 * 33; o += 512) { const int dp = o / 33, tau = o % 33, d = dp >> 6, p = dp & 63;
            const float step = __expf(P.s5_lstep[d * 24 + g]);
            const float lr = P.s5_lre[(d * 24 + g) * 64 + p], li = P.s5_lim[(d * 24 + g) * 64 + p];
            const float m = expf(lr * step * (float)tau), a = li * step * (float)tau;
            pw[o * 2 + 0] = m * cosf(a); pw[o * 2 + 1] = m * sinf(a); }
        __syncthreads();
        for (int o = F.tid; o < 1024; o += 512) { const int d = o >> 9, tau = (o >> 4) & 31, a = o & 15; float s[16];
#pragma unroll
            for (int b_ = 0; b_ < 16; ++b_) s[b_] = 0.f;
            for (int p = 0; p < 64; ++p) { const float cre = cc[a * 64 + p], cim = cc[1024 + a * 64 + p];
                const float lr_ = pw[((d * 64 + p) * 33 + tau) * 2], li_ = pw[((d * 64 + p) * 33 + tau) * 2 + 1];
                const float wr_ = cre * lr_ - cim * li_, wi_ = cre * li_ + cim * lr_;
                const LAS f32x4* bp = (const LAS f32x4*)(bb + (d * 64 + p) * 32);
#pragma unroll
                for (int q4 = 0; q4 < 8; ++q4) { const f32x4 t = bp[q4]; s[2 * q4] += wr_ * t[0] - wi_ * t[1]; s[2 * q4 + 1] += wr_ * t[2] - wi_ * t[3]; } }
#pragma unroll
            for (int b_ = 0; b_ < 16; ++b_) Kt[o * 16 + b_] = s[b_]; }
        __syncthreads();
        bf16_t* TQ = (bf16_t*)(ws + W_TQ) + (size_t)g * 512 * 768;
        for (int o = F.tid; o < 512 * 96; o += 512) { const int row = o / 96, ch = o % 96, i = row >> 4, a = row & 15; float v[8];
            if (ch < 64) { const int j = ch >> 1, b0 = (ch & 1) * 8;
#pragma unroll
                for (int k = 0; k < 8; ++k) { float s = 0.f;
                    if (j <= i) s += Kt[((0 * 32 + (i - j)) * 16 + a) * 16 + b0 + k];
                    if (j >= i) s += Kt[((1 * 32 + (j - i)) * 16 + a) * 16 + b0 + k];
                    v[k] = s; } }
            else { const int c8 = (ch - 64) * 8, d = c8 >> 7, ri = (c8 >> 6) & 1, p0 = c8 & 63; const int tau = d == 0 ? (i + 1) : (32 - i);
#pragma unroll
                for (int k = 0; k < 8; ++k) { const int p = p0 + k;
                    const float cre = cc[a * 64 + p], cim = cc[1024 + a * 64 + p];
                    const float ar = pw[((d * 64 + p) * 33 + tau) * 2], ai = pw[((d * 64 + p) * 33 + tau) * 2 + 1];
                    v[k] = ri == 0 ? (cre * ar - cim * ai) : -(cre * ai + cim * ar); } }
            *(u32x4*)(TQ + (size_t)row * 768 + ch * 8) = pack8(v); }
        bf16_t* PP = (bf16_t*)(ws + W_P) + (size_t)g * 256 * 512;
        for (int o = F.tid; o < 256 * 64; o += 512) { const int row = o >> 6, ch = o & 63, d = row >> 7, ri = (row >> 6) & 1, p = row & 63, j = ch >> 1, b0 = (ch & 1) * 8;
            const int tau = d == 0 ? (31 - j) : j;
            const float ar = pw[((d * 64 + p) * 33 + tau) * 2], ai = pw[((d * 64 + p) * 33 + tau) * 2 + 1]; float v[8];
#pragma unroll
            for (int k = 0; k < 8; ++k) { const float br = bb[((d * 64 + p) * 16 + b0 + k) * 2], bi = bb[((d * 64 + p) * 16 + b0 + k) * 2 + 1];
                v[k] = ri == 0 ? (ar * br - ai * bi) : (ar * bi + ai * br); }
            *(u32x4*)(PP + (size_t)row * 512 + ch * 8) = pack8(v); }
        __syncthreads();
    }
}

struct RowCtx { int R, b, p, isctx, mrow; };
DI RowCtx row_ctx(int R) { RowCtx r; r.R = R; r.b = R / PB; r.p = R - r.b * PB; r.isctx = r.p < CTXL; r.mrow = r.isctx ? 8 : r.b; return r; }

DI void moe_combine(const Frame& F, const RowCtx& rc, f32x4 (&x)[4], const int* INV, const bf16_t* YE, const float* mod_prev  ) {
    const int myinv = (F.lane < 16) ? INV[(size_t)rc.R * 16 + F.lane] : -1;
    f32x4 s[4];
#pragma unroll
    for (int j = 0; j < 4; ++j) s[j] = (f32x4){0.f, 0.f, 0.f, 0.f};
    for (int e = 0; e < 16; ++e) { const int er = __shfl(myinv, e);
        if (er >= 0) { const bf16_t* yr = YE + (size_t)er * 1024 + 4 * F.lane;
#pragma unroll
            for (int j = 0; j < 4; ++j) { const u32x2 w = *(const u32x2*)(yr + j * 256); s[j][0] += bflo(w.x); s[j][1] += bfhi(w.x); s[j][2] += bflo(w.y); s[j][3] += bfhi(w.y); } } }
    const float* g5 = mod_prev + (size_t)rc.mrow * 6144 + 5 * 1024 + 4 * F.lane;
#pragma unroll
    for (int j = 0; j < 4; ++j) x[j] += *(const f32x4*)(g5 + j * 256) * s[j];
}
DI float row_rstd(const f32x4 (&x)[4]) {
    float ss = 0.f;
#pragma unroll
    for (int j = 0; j < 4; ++j) ss += (x[j][0] * x[j][0] + x[j][1] * x[j][1]) + (x[j][2] * x[j][2] + x[j][3] * x[j][3]);
    return 1.0f / sqrtf(wave_sum(ss) * (1.f / 1024.f) + RMS_EPS);
}
DI void row_modulate(const Frame& F, const f32x4 (&x)[4], float rstd, const float* g, const float* shift, const float* scale, f32x4 (&h)[4]) {
#pragma unroll
    for (int j = 0; j < 4; ++j) { const int c = j * 256 + 4 * F.lane; const f32x4 gv = *(const f32x4*)(g + c), sh = *(const f32x4*)(shift + c), sc = *(const f32x4*)(scale + c);
        h[j] = x[j] * rstd * gv * (sc + 1.0f) + sh; }
}
DI void row_store_bf16(const Frame& F, const f32x4 (&h)[4], bf16_t* dst) {
#pragma unroll
    for (int j = 0; j < 4; ++j) { u32x2 w; w.x = pk2(h[j][0], h[j][1]); w.y = pk2(h[j][2], h[j][3]); *(u32x2*)(dst + j * 256 + 4 * F.lane) = w; }
}

DI void phase_norm1(const Frame& F, int layer, const float* x_in, const float* ctx_in, float* X, bf16_t* H1, const float* MOD, const float* gmix, const int* INV, const bf16_t* YE) {
    const float* modl = MOD + (size_t)layer * 9 * 6144;
    for (int R = F.gw; R < MROWS; R += F.NGW) {
        const RowCtx rc = row_ctx(R);
        const float* src = (layer == 0) ? (rc.isctx ? ctx_in + ((size_t)rc.b * CTXL + rc.p) * 1024 : x_in + ((size_t)rc.b * SEQ + (rc.p - CTXL)) * 1024) : X + (size_t)R * 1024;
        f32x4 x[4];
#pragma unroll
        for (int j = 0; j < 4; ++j) x[j] = *(const f32x4*)(src + j * 256 + 4 * F.lane);
        if (layer > 0) moe_combine(F, rc, x, INV, YE, MOD + (size_t)(layer - 1) * 9 * 6144);
#pragma unroll
        for (int j = 0; j < 4; ++j) *(f32x4*)(X + (size_t)R * 1024 + j * 256 + 4 * F.lane) = x[j];
        const float rstd = row_rstd(x);
        f32x4 h[4]; row_modulate(F, x, rstd, gmix, modl + (size_t)rc.mrow * 6144, modl + (size_t)rc.mrow * 6144 + 1024, h);
        row_store_bf16(F, h, H1 + (size_t)R * 1024);
    }
}
DI void phase_final(const Frame& F, const float* X, float* out, const float* MOD, const float* gfin, const int* INV, const bf16_t* YE) {
    for (int q = F.gw; q < NB * SEQ; q += F.NGW) {
        const int b = q / SEQ, t = q - b * SEQ, R = b * PB + CTXL + t;
        const RowCtx rc = row_ctx(R);
        f32x4 x[4];
#pragma unroll
        for (int j = 0; j < 4; ++j) x[j] = *(const f32x4*)(X + (size_t)R * 1024 + j * 256 + 4 * F.lane);
        moe_combine(F, rc, x, INV, YE, MOD + (size_t)1 * 9 * 6144);
        const float rstd = row_rstd(x);
#pragma unroll
        for (int j = 0; j < 4; ++j) { const int c = j * 256 + 4 * F.lane; *(f32x4*)(out + (size_t)q * 1024 + c) = x[j] * rstd * *(const f32x4*)(gfin + c); }
    }
}

DI void phase_norm2(const Frame& F, int layer, bool skipctx, const float* X, bf16_t* H2, const float* MOD, const float* gffn, const float* w_router, float* AFF) {
    LAS float* wl = (LAS float*)F.lds;
    for (int idx = F.tid; idx < 16384; idx += 512) wl[(idx & 15) * 1024 + (idx >> 4)] = w_router[idx];
    __syncthreads();
    const float* modl = MOD + (size_t)layer * 9 * 6144;
    for (int R = F.gw; R < MROWS; R += F.NGW) {
        const RowCtx rc = row_ctx(R);
        if (skipctx && rc.isctx) continue;
        f32x4 x[4];
#pragma unroll
        for (int j = 0; j < 4; ++j) x[j] = *(const f32x4*)(X + (size_t)R * 1024 + j * 256 + 4 * F.lane);
        const float rstd = row_rstd(x);
        f32x4 h[4]; row_modulate(F, x, rstd, gffn, modl + (size_t)rc.mrow * 6144 + 3 * 1024, modl + (size_t)rc.mrow * 6144 + 4 * 1024, h);
        row_store_bf16(F, h, H2 + (size_t)R * 1024);
        float lg[16];
#pragma unroll
        for (int e = 0; e < 16; ++e) { float s = 0.f;
#pragma unroll
            for (int j = 0; j < 4; ++j) { const f32x4 w = *(const LAS f32x4*)(wl + e * 1024 + j * 256 + 4 * F.lane); s += (h[j][0] * w[0] + h[j][1] * w[1]) + (h[j][2] * w[2] + h[j][3] * w[3]); }
            lg[e] = wave_sum(s); }
        float mx = lg[0];
#pragma unroll
        for (int e = 1; e < 16; ++e) mx = fmaxf(mx, lg[e]);
        float den = 0.f, mine = 0.f;
#pragma unroll
        for (int e = 0; e < 16; ++e) { const float ex = expf(lg[e] - mx); den += ex; mine = (F.lane == e) ? ex : mine; }
        if (F.lane < 16) AFF[((size_t)rc.b * 16 + F.lane) * PB + rc.p] = mine / den;
    }
    __syncthreads();
}

DI int block_exscan(const Frame& F, int v, LAS int* wtot, int& total) {
    int incl = v;
#pragma unroll
    for (int o = 1; o < 64; o <<= 1) { const int t = __shfl_up(incl, o); if (F.lane >= o) incl += t; }
    if (F.lane == 63) wtot[F.wave] = incl;
    __syncthreads();
    int base = 0; total = 0;
#pragma unroll
    for (int w = 0; w < 8; ++w) { const int x = wtot[w]; if (w < F.wave) base += x; total += x; }
    __syncthreads();
    return base + incl - v;
}
DI void phase_topk(const Frame& F, int nitems, const float* AFF, int* SRC, float* GV, int* INV) {
    LAS int* wcnt = (LAS int*)F.lds;
    LAS int* wtot = wcnt + 16;
    for (int it = blockIdx.x; it < nitems; it += F.G) {
        const int isctx = it >= 128, be = it & 127, b = be >> 4, e = be & 15;
        const int n = isctx ? CTXL : SEQ, cap = isctx ? 32 : 256, p0 = isctx ? 0 : CTXL;
        const float* a = AFF + ((size_t)b * 16 + e) * PB + p0;
        unsigned v[4]; float av[4];
#pragma unroll
        for (int k = 0; k < 4; ++k) { const int idx = 4 * F.tid + k; av[k] = idx < n ? a[idx] : 0.f; v[k] = __builtin_bit_cast(unsigned, av[k]); }
        unsigned prefix = 0u;
        for (int bit = 30; bit >= 0; --bit) {
            const unsigned cand = prefix | (1u << bit);
            int c = 0;
#pragma unroll
            for (int k = 0; k < 4; ++k) c += __popcll(__ballot(v[k] >= cand));
            LAS int* wc = wcnt + (bit & 1) * 8;
            if (F.lane == 0) wc[F.wave] = c;
            __syncthreads();
            int tot = 0;
#pragma unroll
            for (int w = 0; w < 8; ++w) tot += wc[w];
            if (tot >= cap) prefix = cand;
        }
        __syncthreads();
        int ngt_t = 0, neq_t = 0;
#pragma unroll
        for (int k = 0; k < 4; ++k) { ngt_t += (v[k] > prefix) ? 1 : 0; neq_t += (v[k] == prefix) ? 1 : 0; }
        int ngt_total, neq_total;
        (void)block_exscan(F, ngt_t, wtot, ngt_total);
        int eq_rank = block_exscan(F, neq_t, wtot, neq_total);
        const int eq_take = cap - ngt_total;
        int sel[4], nsel_t = 0;
#pragma unroll
        for (int k = 0; k < 4; ++k) { int s = 0; if (v[k] > prefix) s = 1; else if (v[k] == prefix) { s = (eq_rank < eq_take) ? 1 : 0; ++eq_rank; } sel[k] = s; nsel_t += s; }
        int nsel_total;
        int slot = block_exscan(F, nsel_t, wtot, nsel_total);
        const int ebase = e * EROWS + (isctx ? 2048 + b * 32 : b * 256);
#pragma unroll
        for (int k = 0; k < 4; ++k) { const int idx = 4 * F.tid + k;
            if (idx < n) { const int R = b * PB + p0 + idx;
                if (sel[k]) { const int er = ebase + slot; ++slot; SRC[er] = R; GV[er] = av[k]; INV[(size_t)R * 16 + e] = er; }
                else INV[(size_t)R * 16 + e] = -1; } }
        __syncthreads();
    }
}
DI void phase_gather(const Frame& F, int rows_per_expert, const int* SRC, const bf16_t* H2, bf16_t* XG) {
    const int total = 16 * rows_per_expert;
    for (int q = F.gw; q < total; q += F.NGW) {
        const int e = q / rows_per_expert, s = q - e * rows_per_expert, er = e * EROWS + s;
        const int R = SRC[er];
        const u32x4 v0 = *(const u32x4*)(H2 + (size_t)R * 1024 + 8 * F.lane), v1 = *(const u32x4*)(H2 + (size_t)R * 1024 + 512 + 8 * F.lane);
        *(u32x4*)(XG + (size_t)er * 1024 + 8 * F.lane) = v0; *(u32x4*)(XG + (size_t)er * 1024 + 512 + 8 * F.lane) = v1;
    }
}

DI void phase_elem(const Frame& F, const LayerIn& P, const bf16_t* PA, const float* ROPE, bf16_t* QN, bf16_t* KN, bf16_t* XBC, float* DT, bf16_t* AU, bf16_t* YD) {
    const int l = F.lane;
    for (int R = F.gw; R < MROWS; R += F.NGW) {
        const RowCtx rc = row_ctx(R);
        const bf16_t* pr = PA + (size_t)R * PA_W;
        const bool has_prev = (rc.p != 0) && (rc.p != CTXL), has_next = (rc.p != CTXL - 1) && (rc.p != PB - 1);
        const int t = rc.p - CTXL;
#pragma unroll
        for (int which = 0; which < 2; ++which) {
            const int ll = which == 0 ? l : (l & 15);
            float v[8]; unpack8(*(const u32x4*)(pr + (which == 0 ? C_Q : C_K) + ll * 8), v);
            float ss = 0.f;
#pragma unroll
            for (int k = 0; k < 8; ++k) ss += v[k] * v[k];
            ss += __shfl_xor(ss, 1); ss += __shfl_xor(ss, 2); ss += __shfl_xor(ss, 4);
            const float rstd = 1.0f / sqrtf(ss * (1.f / 64.f) + RMS_EPS);
            const float* gn = (which == 0 ? P.q_norm_g : P.k_norm_g) + (ll & 7) * 8;
#pragma unroll
            for (int k = 0; k < 8; ++k) v[k] = v[k] * rstd * gn[k];
            float o[8];
            if (!rc.isctx) {
                const int hb = (ll & 7) >> 2, i0 = (ll & 1) * 8; const bool isx2 = (ll & 2) != 0;
                const float* cs = ROPE + (size_t)t * 64 + hb * 16 + i0;
#pragma unroll
                for (int k = 0; k < 8; ++k) { const float pv = __shfl_xor(v[k], 2); const float c = cs[k], s = cs[32 + k]; o[k] = isx2 ? (v[k] * c + pv * s) : (v[k] * c - pv * s); }
            } else {
#pragma unroll
                for (int k = 0; k < 8; ++k) o[k] = v[k];
            }
            if (which == 0) {
#pragma unroll
                for (int k = 0; k < 8; ++k) o[k] *= ATT_C2;
                *(u32x4*)(QN + (size_t)R * 512 + l * 8) = pack8(o);
            } else if (l < 16) *(u32x4*)(KN + (size_t)R * 128 + l * 8) = pack8(o);
        }
        for (int ch8 = l; ch8 < 96; ch8 += 64) {
            const int ch = ch8 * 8; float cur[8], prv[8], nxt[8];
            unpack8(*(const u32x4*)(pr + C_XBC + ch), cur);
            if (has_prev) unpack8(*(const u32x4*)(pr - PA_W + C_XBC + ch), prv); else {
#pragma unroll
                for (int k = 0; k < 8; ++k) prv[k] = 0.f; }
            if (has_next) unpack8(*(const u32x4*)(pr + PA_W + C_XBC + ch), nxt); else {
#pragma unroll
                for (int k = 0; k < 8; ++k) nxt[k] = 0.f; }
            float o[8];
#pragma unroll
            for (int k = 0; k < 8; ++k) { const float a = P.ssd_conv_w[ch + k] * prv[k] + P.ssd_conv_w[768 + ch + k] * cur[k] + P.ssd_conv_w[1536 + ch + k] * nxt[k] + P.ssd_conv_b[ch + k]; o[k] = silu_f(a); }
            *(u32x4*)(XBC + (size_t)R * 768 + ch) = pack8(o);
        }
        if (l < 16) { const int d = l >> 3, h = l & 7; DT[((size_t)d * MROWS + R) * 8 + h] = softplus_f(bf2f(pr[C_DT + h]) + P.ssd_dt_bias[d * 8 + h]); }
        if (l < 48) {
            const int g = l >> 1, a0 = (l & 1) * 8;
            *(u32x4*)(AU + ((size_t)g * 576 + (R >> 5)) * 768 + (R & 31) * 16 + a0) = *(const u32x4*)(pr + C_U + l * 8);
            const int ch = l * 8; float sb[8], g0[8], h0[8], m_c[8], m_p[8], m_n[8];
            unpack8(*(const u32x4*)(pr + C_SB + ch), sb);
            unpack8(*(const u32x4*)(pr + C_SG + ch), g0); unpack8(*(const u32x4*)(pr + C_SH + ch), h0);
#pragma unroll
            for (int k = 0; k < 8; ++k) m_c[k] = g0[k] * h0[k];
            if (has_prev) { unpack8(*(const u32x4*)(pr - PA_W + C_SG + ch), g0); unpack8(*(const u32x4*)(pr - PA_W + C_SH + ch), h0);
#pragma unroll
                for (int k = 0; k < 8; ++k) m_p[k] = g0[k] * h0[k]; } else {
#pragma unroll
                for (int k = 0; k < 8; ++k) m_p[k] = 0.f; }
            if (has_next) { unpack8(*(const u32x4*)(pr + PA_W + C_SG + ch), g0); unpack8(*(const u32x4*)(pr + PA_W + C_SH + ch), h0);
#pragma unroll
                for (int k = 0; k < 8; ++k) m_n[k] = g0[k] * h0[k]; } else {
#pragma unroll
                for (int k = 0; k < 8; ++k) m_n[k] = 0.f; }
            float o[8];
#pragma unroll
            for (int k = 0; k < 8; ++k) o[k] = sb[k] * (P.sc_conv_w[ch + k] * m_p[k] + P.sc_conv_w[384 + ch + k] * m_c[k] + P.sc_conv_w[768 + ch + k] * m_n[k]);
            *(u32x4*)(YD + (size_t)R * 384 + ch) = pack8(o);
        }
    }
}

typedef short v4i16_t __attribute__((ext_vector_type(4)));
DI int img_off(int row, int chunk) { return row * 128 + ((chunk ^ (row & 7)) << 4); }
DI s16x4 tr_read4(const LAS unsigned char* p) { return __builtin_bit_cast(s16x4, __builtin_amdgcn_ds_read_tr16_b64_v4i16((LAS v4i16_t*)p)); }
DI bf16x8 cat8(s16x4 lo, s16x4 hi) { return (bf16x8){lo[0], lo[1], lo[2], lo[3], hi[0], hi[1], hi[2], hi[3]}; }
DI unsigned cvtpk(float lo, float hi) { typedef __bf16 bf2 __attribute__((ext_vector_type(2))); f32x2 v = {lo, hi}; bf2 b = __builtin_convertvector(v, bf2); return __builtin_bit_cast(unsigned, b); }
#define MFMA32(a, b, c) __builtin_amdgcn_mfma_f32_32x32x16_bf16((a), (b), (c), 0, 0, 0)
DI int crow(int r, int hh) { return (r & 3) + 8 * (r >> 2) + 4 * hh; }

constexpr int SSD_XH = 0, SSD_BM = 65536, SSD_CM = 81920, SSD_ARR = 131072;
DI void ssd_load_images(const Frame& F, const bf16_t* XBC, int R0, int g, bool with_c) {
#pragma unroll
    for (int it = 0; it < 8; ++it) { const int idx = it * 512 + F.tid, h4 = idx >> 10, row = (idx >> 3) & 127, ch = idx & 7;
        *(LAS u32x4*)(F.lds + SSD_XH + h4 * 16384 + img_off(row, ch)) = *(const u32x4*)(XBC + (size_t)(R0 + row) * 768 + g * 256 + h4 * 64 + ch * 8); }
#pragma unroll
    for (int it = 0; it < 2; ++it) { const int idx = it * 512 + F.tid, row = idx >> 3, ch = idx & 7;
        *(LAS u32x4*)(F.lds + SSD_BM + img_off(row, ch)) = *(const u32x4*)(XBC + (size_t)(R0 + row) * 768 + 512 + g * 64 + ch * 8);
        if (with_c) *(LAS u32x4*)(F.lds + SSD_CM + img_off(row, ch)) = *(const u32x4*)(XBC + (size_t)(R0 + row) * 768 + 640 + g * 64 + ch * 8); }
}
struct Series { float dt0, dt1, cs0, cs1, ecs0, ecs1, tot; };
DI Series ssd_series(const Frame& F, const float* DT, const float* a_log, int R0, int h, int d) {
    Series s; const float a = -__expf(a_log[d * 8 + h]);
    s.dt0 = DT[((size_t)d * MROWS + R0 + 2 * F.lane) * 8 + h]; s.dt1 = DT[((size_t)d * MROWS + R0 + 2 * F.lane + 1) * 8 + h];
    const float ad0 = s.dt0 * a, ad1 = s.dt1 * a, pair = ad0 + ad1; float incl = pair;
#pragma unroll
    for (int o = 1; o < 64; o <<= 1) { const float t = __shfl_up(incl, o); if (F.lane >= o) incl += t; }
    const float excl = incl - pair;
    s.cs0 = excl + ad0; s.cs1 = incl; s.ecs0 = excl; s.ecs1 = excl + ad0; s.tot = __shfl(incl, 63);
    return s;
}

DI void ssd_chunk_states(const Frame& F, const LayerIn& P, const bf16_t* XBC, const float* DT, float* S, float* TOT) {
    LAS float* W = (LAS float*)(F.lds + SSD_ARR);
    const int lane = F.lane, hh = lane >> 5, q = (lane & 15) >> 2, pp = lane & 3, blk = (lane >> 4) & 1;
    const int h4 = F.wave & 3, d = F.wave >> 2;
    for (int it = blockIdx.x; it < 288; it += F.G) {
        const int b = it / 36, r = it % 36, c = r >> 1, g = r & 1, R0 = b * PB + c * 128, h = 4 * g + h4;
        ssd_load_images(F, XBC, R0, g, false);
        const Series s = ssd_series(F, DT, P.ssd_a_log, R0, h, d);
        float w0, w1;
        if (d == 0) { w0 = s.dt0 * __expf(s.tot - s.cs0); w1 = s.dt1 * __expf(s.tot - s.cs1); } else { w0 = s.dt0 * __expf(s.ecs0); w1 = s.dt1 * __expf(s.ecs1); }
        *(LAS f32x2*)(W + F.wave * 128 + 2 * lane) = (f32x2){w0, w1};
        if (lane == 0) TOT[(((size_t)b * 18 + c) * 8 + h) * 2 + d] = s.tot;
        __syncthreads();
        f32x16 acc[2][2];
#pragma unroll
        for (int i = 0; i < 2; ++i)
#pragma unroll
            for (int j = 0; j < 2; ++j)
#pragma unroll
                for (int k = 0; k < 16; ++k) acc[i][j][k] = 0.f;
        const LAS unsigned char* xh = F.lds + SSD_XH + h4 * 16384;
        const LAS unsigned char* bm = F.lds + SSD_BM;
#pragma unroll 2
        for (int st = 0; st < 8; ++st) {
            const int row = 16 * st + 8 * hh + q;
            const f32x4 wa = *(const LAS f32x4*)(W + F.wave * 128 + 16 * st + 8 * hh), wb = *(const LAS f32x4*)(W + F.wave * 128 + 16 * st + 8 * hh + 4);
            bf16x8 af[2], bfr[2];
#pragma unroll
            for (int t = 0; t < 2; ++t) { const int chunk = t * 4 + 2 * blk + (pp >> 1), within = 8 * (pp & 1);
                af[t] = cat8(tr_read4(bm + img_off(row, chunk) + within), tr_read4(bm + img_off(row + 4, chunk) + within));
                const s16x4 lo = tr_read4(xh + img_off(row, chunk) + within), hi = tr_read4(xh + img_off(row + 4, chunk) + within);
                u32x4 pw;
                pw.x = cvtpk(bf2f((bf16_t)lo[0]) * wa[0], bf2f((bf16_t)lo[1]) * wa[1]); pw.y = cvtpk(bf2f((bf16_t)lo[2]) * wa[2], bf2f((bf16_t)lo[3]) * wa[3]);
                pw.z = cvtpk(bf2f((bf16_t)hi[0]) * wb[0], bf2f((bf16_t)hi[1]) * wb[1]); pw.w = cvtpk(bf2f((bf16_t)hi[2]) * wb[2], bf2f((bf16_t)hi[3]) * wb[3]);
                bfr[t] = __builtin_bit_cast(bf16x8, pw); }
#pragma unroll
            for (int nt = 0; nt < 2; ++nt)
#pragma unroll
                for (int pt = 0; pt < 2; ++pt) acc[nt][pt] = MFMA32(af[nt], bfr[pt], acc[nt][pt]);
        }
        float* Sb = S + ((((size_t)b * 18 + c) * 8 + h) * 2 + d) * 4096;
#pragma unroll
        for (int nt = 0; nt < 2; ++nt)
#pragma unroll
            for (int pt = 0; pt < 2; ++pt)
#pragma unroll
                for (int q4 = 0; q4 < 4; ++q4) { const int p = pt * 32 + (lane & 31), n0 = nt * 32 + 8 * q4 + 4 * hh;
                    *(f32x4*)(Sb + p * 64 + n0) = (f32x4){acc[nt][pt][4 * q4], acc[nt][pt][4 * q4 + 1], acc[nt][pt][4 * q4 + 2], acc[nt][pt][4 * q4 + 3]}; }
        __syncthreads();
    }
}

DI void ssd_recurrence(const Frame& F, const float* __restrict__ S, const float* __restrict__ TOT, bf16_t* __restrict__ HIN) {
    for (int gi = blockIdx.x * 512 + F.tid; gi < 128 * 1024; gi += F.G * 512) {
        const int bhd = gi >> 10, e4 = (gi & 1023) * 4, b = bhd >> 4, h = (bhd >> 1) & 7, d = bhd & 1;
        f32x4 sv[18]; float dec[18];
#pragma unroll
        for (int k = 0; k < 18; ++k) { const int c = (d == 0) ? k : (k < 2 ? 1 - k : 19 - k);
            const size_t st = (((size_t)b * 18 + c) * 8 + h) * 2 + d;
            sv[k] = *(const f32x4*)(S + st * 4096 + e4); dec[k] = TOT[st]; }
        f32x4 H = (f32x4){0.f, 0.f, 0.f, 0.f};
#pragma unroll
        for (int k = 0; k < 18; ++k) { const int c = (d == 0) ? k : (k < 2 ? 1 - k : 19 - k);
            const size_t st = (((size_t)b * 18 + c) * 8 + h) * 2 + d;
            u32x2 w; w.x = pk2(H[0], H[1]); w.y = pk2(H[2], H[3]);
            *(u32x2*)(HIN + st * 4096 + e4) = w;
            H = H * __expf(dec[k]) + sv[k]; }
    }
}

DI void ssd_output(const Frame& F, const LayerIn& P, const bf16_t* XBC, const bf16_t* PA, const float* DT, const bf16_t* HIN, bf16_t* YB, float* SSQ, bool skipctx) {
    LAS float* ARR = (LAS float*)(F.lds + SSD_ARR);
    const int lane = F.lane, hh = lane >> 5, q = (lane & 15) >> 2, pp = lane & 3, blk = (lane >> 4) & 1, l31 = lane & 31;
    for (int it = blockIdx.x; it < 288; it += F.G) {
        const int b = it / 36, r_ = it % 36, c = r_ >> 1, g = r_ & 1, R0 = b * PB + c * 128;
        if (skipctx && c < 2) continue;
        ssd_load_images(F, XBC, R0, g, true);
        { const int h4 = F.wave & 3, d = F.wave >> 2, h = 4 * g + h4;
          const Series s = ssd_series(F, DT, P.ssd_a_log, R0, h, d);
          LAS float* A = ARR + h4 * 768;
          if (d == 0) { *(LAS f32x2*)(A + 0 * 128 + 2 * lane) = (f32x2){s.cs0, s.cs1}; *(LAS f32x2*)(A + 1 * 128 + 2 * lane) = (f32x2){s.dt0, s.dt1};
                        *(LAS f32x2*)(A + 2 * 128 + 2 * lane) = (f32x2){__expf(s.cs0), __expf(s.cs1)}; }
          else { *(LAS f32x2*)(A + 3 * 128 + 2 * lane) = (f32x2){s.ecs0, s.ecs1}; *(LAS f32x2*)(A + 4 * 128 + 2 * lane) = (f32x2){s.dt0, s.dt1};
                 *(LAS f32x2*)(A + 5 * 128 + 2 * lane) = (f32x2){__expf(s.tot - s.ecs0), __expf(s.tot - s.ecs1)}; } }
        __syncthreads();
        const int h4 = F.wave & 3, rh = F.wave >> 2, h = 4 * g + h4;
        const LAS float* A = ARR + h4 * 768;
        const LAS unsigned char* xh = F.lds + SSD_XH + h4 * 16384;
        const LAS unsigned char* bm = F.lds + SSD_BM;
        const LAS unsigned char* cm = F.lds + SSD_CM;
        f32x16 yacc[2][2];
#pragma unroll
        for (int i = 0; i < 2; ++i)
#pragma unroll
            for (int j = 0; j < 2; ++j)
#pragma unroll
                for (int k = 0; k < 16; ++k) yacc[i][j][k] = 0.f;
#pragma unroll
        for (int itl = 0; itl < 2; ++itl) {
            const int itile = 2 * rh + itl, irow = itile * 32 + l31;
            bf16x8 cf[4];
#pragma unroll
            for (int ks = 0; ks < 4; ++ks) cf[ks] = *(const LAS bf16x8*)(cm + img_off(irow, 2 * ks + hh));
#pragma unroll 1
            for (int d = 0; d < 2; ++d) {
                const bf16_t* Hs = HIN + (((((size_t)b * 18 + c) * 8 + h) * 2 + d) * 4096);
#pragma unroll
                for (int pt = 0; pt < 2; ++pt) {
                    f32x16 tmp;
#pragma unroll
                    for (int k = 0; k < 16; ++k) tmp[k] = 0.f;
#pragma unroll
                    for (int ks = 0; ks < 4; ++ks) { const bf16x8 hb = *(const bf16x8*)(Hs + (pt * 32 + l31) * 64 + 16 * ks + 8 * hh); tmp = MFMA32(cf[ks], hb, tmp); }
#pragma unroll
                    for (int q4 = 0; q4 < 4; ++q4) { const f32x4 ev = *(const LAS f32x4*)(A + (d == 0 ? 2 : 5) * 128 + itile * 32 + 8 * q4 + 4 * hh);
#pragma unroll
                        for (int k = 0; k < 4; ++k) yacc[itl][pt][4 * q4 + k] += tmp[4 * q4 + k] * ev[k]; }
                    __builtin_amdgcn_sched_barrier(0);
                }
            }
            const float csf_i = A[0 * 128 + irow], ecb_i = A[3 * 128 + irow];
#pragma unroll 1
            for (int jt = 0; jt < 4; ++jt) {
                f32x16 Z;
#pragma unroll
                for (int k = 0; k < 16; ++k) Z[k] = 0.f;
#pragma unroll
                for (int ks = 0; ks < 4; ++ks) { const bf16x8 bf_ = *(const LAS bf16x8*)(bm + img_off(jt * 32 + l31, 2 * ks + hh)); Z = MFMA32(bf_, cf[ks], Z); }
#pragma unroll
                for (int q4 = 0; q4 < 4; ++q4) { const int j0 = jt * 32 + 8 * q4 + 4 * hh;
                    f32x4 w = (f32x4){0.f, 0.f, 0.f, 0.f};
                    if (jt <= itile) { const f32x4 cj = *(const LAS f32x4*)(A + 0 * 128 + j0), dj = *(const LAS f32x4*)(A + 1 * 128 + j0);
#pragma unroll
                        for (int k = 0; k < 4; ++k) { const bool ok = (jt < itile) || (j0 + k <= irow); w[k] += ok ? __expf(fminf(csf_i - cj[k], 0.f)) * dj[k] : 0.f; } }
                    if (jt >= itile) { const f32x4 ej = *(const LAS f32x4*)(A + 3 * 128 + j0), dj = *(const LAS f32x4*)(A + 4 * 128 + j0);
#pragma unroll
                        for (int k = 0; k < 4; ++k) { const bool ok = (jt > itile) || (j0 + k >= irow); w[k] += ok ? __expf(fminf(ej[k] - ecb_i, 0.f)) * dj[k] : 0.f; } }
#pragma unroll
                    for (int k = 0; k < 4; ++k) Z[4 * q4 + k] *= w[k]; }
#pragma unroll
                for (int s = 0; s < 2; ++s) {
                    u32x4 zp; zp.x = cvtpk(Z[8 * s], Z[8 * s + 1]); zp.y = cvtpk(Z[8 * s + 2], Z[8 * s + 3]); zp.z = cvtpk(Z[8 * s + 4], Z[8 * s + 5]); zp.w = cvtpk(Z[8 * s + 6], Z[8 * s + 7]);
                    const bf16x8 za = __builtin_bit_cast(bf16x8, zp);
                    const int row = jt * 32 + 16 * s + 4 * hh + q;
#pragma unroll
                    for (int pt = 0; pt < 2; ++pt) { const int chunk = pt * 4 + 2 * blk + (pp >> 1), within = 8 * (pp & 1);
                        const bf16x8 xb = cat8(tr_read4(xh + img_off(row, chunk) + within), tr_read4(xh + img_off(row + 8, chunk) + within));
                        yacc[itl][pt] = MFMA32(za, xb, yacc[itl][pt]); }
                }
                __builtin_amdgcn_sched_barrier(0);
            }
        }
        __syncthreads();
        LAS float* Y = (LAS float*)F.lds;
#pragma unroll
        for (int itl = 0; itl < 2; ++itl)
#pragma unroll
            for (int pt = 0; pt < 2; ++pt)
#pragma unroll
                for (int r = 0; r < 16; ++r) Y[((2 * rh + itl) * 32 + crow(r, hh)) * 256 + h4 * 64 + pt * 32 + l31] = yacc[itl][pt][r];
        __syncthreads();
#pragma unroll 2
        for (int itn = 0; itn < 8; ++itn) { const int idx = itn * 512 + F.tid, row = idx >> 5, ch = idx & 31, R = R0 + row;
            const f32x4 y0 = *(const LAS f32x4*)(Y + row * 256 + ch * 8), y1 = *(const LAS f32x4*)(Y + row * 256 + ch * 8 + 4);
            float xv[8], zv[8]; unpack8(*(const u32x4*)(XBC + (size_t)R * 768 + g * 256 + ch * 8), xv); unpack8(*(const u32x4*)(PA + (size_t)R * PA_W + C_Z + g * 256 + ch * 8), zv);
            const float Dh = P.ssd_d[4 * g + (ch >> 3)]; float o[8], ss = 0.f;
#pragma unroll
            for (int k = 0; k < 8; ++k) { const float yv = (k < 4 ? y0[k] : y1[k - 4]) + Dh * xv[k]; o[k] = yv * silu_f(zv[k]); ss += o[k] * o[k]; }
            ss += __shfl_xor(ss, 1); ss += __shfl_xor(ss, 2); ss += __shfl_xor(ss, 4); ss += __shfl_xor(ss, 8); ss += __shfl_xor(ss, 16);
            if (ch == 0) SSQ[(size_t)R * 2 + g] = ss;
            *(u32x4*)(YB + (size_t)R * 512 + g * 256 + ch * 8) = pack8(o); }
        __syncthreads();
    }
}

DI void s5_recurrence(const Frame& F, const LayerIn& P, const float* __restrict__ S5S, bf16_t* __restrict__ AU) {
    if (F.gw >= 384) return;
    const int g = F.gw >> 4, b = (F.gw >> 1) & 7, d = F.gw & 1, p = F.lane;
    const float step = __expf(P.s5_lstep[d * 24 + g]);
    const float lr = P.s5_lre[(d * 24 + g) * 64 + p], li = P.s5_lim[(d * 24 + g) * 64 + p];
    const float mag = expf(32.f * lr * step), ang = 32.f * li * step, Lr = mag * cosf(ang), Li = mag * sinf(ang);
    float Hr = 0.f, Hi = 0.f;
#pragma unroll 1
    for (int kb = 0; kb < 72; kb += 24) {
        float sr[24], si[24];
#pragma unroll
        for (int k = 0; k < 24; ++k) { const int kk = kb + k, ck = (d == 0) ? kk : (kk < 8 ? 7 - kk : 79 - kk);
            const size_t m = (size_t)g * 576 + b * 72 + ck;
            sr[k] = S5S[m * 256 + d * 128 + p]; si[k] = S5S[m * 256 + d * 128 + 64 + p]; }
#pragma unroll
        for (int k = 0; k < 24; ++k) { const int kk = kb + k, ck = (d == 0) ? kk : (kk < 8 ? 7 - kk : 79 - kk);
            const size_t m = (size_t)g * 576 + b * 72 + ck;
            AU[m * 768 + 512 + d * 128 + p] = (bf16_t)f2bf(Hr); AU[m * 768 + 512 + d * 128 + 64 + p] = (bf16_t)f2bf(Hi);
            const float nr = Lr * Hr - Li * Hi + sr[k], ni = Lr * Hi + Li * Hr + si[k];
            Hr = nr; Hi = ni; }
    }
}

namespace attn_body {
using bf16=__hip_bfloat16;
using bf16x8=__attribute__((ext_vector_type(8)))short;
using s16x4=__attribute__((ext_vector_type(4)))short;
using f32x16=__attribute__((ext_vector_type(16)))float;
using u32x4=__attribute__((ext_vector_type(4)))unsigned;
constexpr int D=64;
constexpr int NW=8,QBLK=32,QB=QBLK*NW,KVBLK=64;
__device__ __forceinline__ int crow(int r,int hi){return (r&3)+8*(r>>2)+4*hi;}
#define SBAR() __builtin_amdgcn_sched_barrier(0)
constexpr int NSLOT=3, SLOTB=8192;
constexpr int LDS_K=0, LDS_V=NSLOT*SLOTB, LDS_WS=2*NSLOT*SLOTB, LDS_OST=LDS_WS+NW*64*4, LDS_BYTES=LDS_OST+NW*4096;
constexpr float C2=0.125f*1.4426950408889634f;
__device__ __forceinline__ void glds16(const void*gsrc,unsigned lds_dst){unsigned keep;
  asm volatile("s_mov_b32 %0, m0\n\ts_mov_b32 m0, %2\n\ts_nop 0\n\tglobal_load_lds_dwordx4 %1, off\n\ts_mov_b32 m0, %0":"=&s"(keep):"v"(gsrc),"s"(lds_dst):"memory");}
__device__ __forceinline__ float max3f(float a,float b,float c){float r;asm("v_max3_f32 %0, %1, %2, %3":"=v"(r):"v"(a),"v"(b),"v"(c));return r;}
__device__ __forceinline__ float max2f(float a,float b){float r;asm("v_max_f32_e32 %0, %1, %2":"=v"(r):"v"(a),"v"(b));return r;}
__device__ __forceinline__ float fadd_s(float a,float b){float r;asm("v_add_f32_e32 %0, %1, %2":"=v"(r):"v"(a),"v"(b));return r;}
__device__ __forceinline__ float fsub_s(float a,float b){float r;asm("v_sub_f32_e32 %0, %1, %2":"=v"(r):"v"(a),"v"(b));return r;}
typedef float f32x2_t __attribute__((ext_vector_type(2))); typedef __bf16 bf16x2_t __attribute__((ext_vector_type(2)));
__device__ __forceinline__ unsigned cvtpk_s(float lo,float hi){f32x2_t v={lo,hi};bf16x2_t b=__builtin_convertvector(v,bf16x2_t);return __builtin_bit_cast(unsigned,b);}
#define WAIT_BAR(N) asm volatile("s_waitcnt vmcnt(" #N ") lgkmcnt(0)\n\ts_barrier":::"memory")

__device__ __forceinline__ void qkt(f32x16&p0,f32x16&p1,const char*Kslot,const bf16x8*qr,const f32x16&negm,int r32,int hi){
  const char*kb=Kslot+hi*1024+r32*16;
  #pragma unroll
  for(int d0=0;d0<4;++d0){
    const bf16x8 b0=*reinterpret_cast<const bf16x8*>(kb+d0*2048);
    const bf16x8 b1=*reinterpret_cast<const bf16x8*>(kb+d0*2048+512);
    if(d0==0){p0=__builtin_amdgcn_mfma_f32_32x32x16_bf16(b0,qr[0],negm,0,0,0);p1=__builtin_amdgcn_mfma_f32_32x32x16_bf16(b1,qr[0],negm,0,0,0);}
    else{p0=__builtin_amdgcn_mfma_f32_32x32x16_bf16(b0,qr[d0],p0,0,0,0);p1=__builtin_amdgcn_mfma_f32_32x32x16_bf16(b1,qr[d0],p1,0,0,0);}}
}
typedef __attribute__((address_space(3))) const char* lds_cptr;
typedef short v4i16_t __attribute__((ext_vector_type(4)));
__device__ __forceinline__ void kload8(bf16x8*kf,lds_cptr kp){
  kf[0]=*(const __attribute__((address_space(3))) bf16x8*)(kp);      kf[1]=*(const __attribute__((address_space(3))) bf16x8*)(kp+512);
  kf[2]=*(const __attribute__((address_space(3))) bf16x8*)(kp+2048); kf[3]=*(const __attribute__((address_space(3))) bf16x8*)(kp+2560);
  kf[4]=*(const __attribute__((address_space(3))) bf16x8*)(kp+4096); kf[5]=*(const __attribute__((address_space(3))) bf16x8*)(kp+4608);
  kf[6]=*(const __attribute__((address_space(3))) bf16x8*)(kp+6144); kf[7]=*(const __attribute__((address_space(3))) bf16x8*)(kp+6656);
}
__device__ __forceinline__ void kload2(bf16x8*kf,lds_cptr kp,int j){ kf[2*j]=*(const __attribute__((address_space(3))) bf16x8*)(kp+j*2048); kf[2*j+1]=*(const __attribute__((address_space(3))) bf16x8*)(kp+j*2048+512); }
__device__ __forceinline__ s16x4 vtr(lds_cptr p){ return __builtin_bit_cast(s16x4,__builtin_amdgcn_ds_read_tr16_b64_v4i16((__attribute__((address_space(3))) v4i16_t*)p)); }
__device__ __forceinline__ float rowmax(const f32x16&p0,const f32x16&p1){
  float a=max3f(p0[0],p0[1],p1[0]),b=max3f(p0[2],p0[3],p1[1]);a=max3f(a,p1[2],p1[3]);
  #pragma unroll
  for(int r=4;r<16;r+=4){a=max3f(a,p0[r],p0[r+1]);b=max3f(b,p0[r+2],p0[r+3]);a=max3f(a,p1[r],p1[r+1]);b=max3f(b,p1[r+2],p1[r+3]);}
  const float m=max2f(a,b);
  auto rr=__builtin_amdgcn_permlane32_swap(__float_as_uint(m),__float_as_uint(m),false,false);
  return max2f(__uint_as_float(rr[0]),__uint_as_float(rr[1]));
}
__device__ __forceinline__ void pv(f32x16*o,int vb,bf16x8 pa0,bf16x8 pa1,bf16x8 pa2,bf16x8 pa3){
  #pragma unroll
  for(int d0=0;d0<2;++d0){s16x4 lo[4],hi[4];
    #pragma unroll
    for(int ks=0;ks<4;++ks){
      asm volatile("ds_read_b64_tr_b16 %0,%1 offset:%c2":"=&v"(lo[ks]):"v"(vb),"i"(d0*4096+ks*1024):"memory");
      asm volatile("ds_read_b64_tr_b16 %0,%1 offset:%c2":"=&v"(hi[ks]):"v"(vb),"i"(d0*4096+ks*1024+512):"memory");}
    asm volatile("s_waitcnt lgkmcnt(0)":::"memory");SBAR();
    #define PK(k) (bf16x8){lo[k][0],lo[k][1],lo[k][2],lo[k][3],hi[k][0],hi[k][1],hi[k][2],hi[k][3]}
    o[d0]=__builtin_amdgcn_mfma_f32_32x32x16_bf16(pa0,PK(0),o[d0],0,0,0);
    o[d0]=__builtin_amdgcn_mfma_f32_32x32x16_bf16(pa1,PK(1),o[d0],0,0,0);
    o[d0]=__builtin_amdgcn_mfma_f32_32x32x16_bf16(pa2,PK(2),o[d0],0,0,0);
    o[d0]=__builtin_amdgcn_mfma_f32_32x32x16_bf16(pa3,PK(3),o[d0],0,0,0);
    #undef PK
  }
}

#ifndef ATTN_STORE16
#define ATTN_STORE16(p,v) (*(u32x4*)(p)=(v))
#endif
template<int THRL> __device__ __forceinline__ void attn_unit(const bf16*Qp,int qpitch,const bf16*__restrict__ Kp,int kpitch,const bf16*__restrict__ Vp,int vpitch,bf16*Op,int opitch,const int NT,char*shm){
  const int tid=fresh_tid(),lane=tid&63,r32=lane&31,hi=lane>>5; const int wid=__builtin_amdgcn_readfirstlane(tid>>6);
  const bf16*Qw=Qp+(long)(wid*QBLK)*qpitch;
  const bf16*Kh=Kp,*Vh=Vp;
  const unsigned lds0=(unsigned)(uintptr_t)shm;
  float*wsf=(float*)(shm+LDS_WS)+wid*64;
  const bf16*ksrc=Kh+(long)lane*kpitch+wid*8;
  const bf16*vsrc=Vh+(long)(16*(wid&3)+(lane>>2))*vpitch+(wid>>2)*32+(lane&3)*8;
  const unsigned kdst=lds0+LDS_K+wid*1024, vdst=lds0+LDS_V+wid*1024;
  #define DMA_K(t,slot) glds16(ksrc+(long)(t)*KVBLK*kpitch,(unsigned)__builtin_amdgcn_readfirstlane(kdst+(slot)))
  #define DMA_V(t,slot) glds16(vsrc+(long)(t)*KVBLK*vpitch,(unsigned)__builtin_amdgcn_readfirstlane(vdst+(slot)))
  const int vb0=(int)(lds0+LDS_V)+((lane>>4)&1)*32+(lane&3)*8+(4*hi+((lane&15)>>2))*64;
  const char*Kbase=shm+LDS_K; bf16x8 kf[8];
  const lds_cptr shm3=(lds_cptr)shm; const lds_cptr kp0=shm3+LDS_K+hi*1024+r32*16; const lds_cptr vp0=shm3+LDS_V+((lane>>4)&1)*32+(lane&3)*8+(4*hi+((lane&15)>>2))*64;
  DMA_K(0,0);DMA_V(0,0);DMA_K(1,SLOTB);
  bf16x8 qr[4];
  #pragma unroll
  for(int d0=0;d0<4;++d0)qr[d0]=*reinterpret_cast<const bf16x8*>(&Qw[(long)r32*qpitch+d0*16+hi*8]);
  float mhat=0.f,l_reg=0.f;f32x16 o[2];o[0]=f32x16{};o[1]=f32x16{};f32x16 negm=f32x16{};asm volatile("":"+v"(negm));
  #define CMASK(P0,P1,t) do{}while(0)
  bool resc=false;
  #define START(P0,P1) do{ const float rm=rowmax(P0,P1); resc=false; \
    { const float dl=rm; mhat=fadd_s(mhat,dl); \
      _Pragma("unroll") for(int r=0;r<16;++r){P0[r]=fsub_s(P0[r],dl);P1[r]=fsub_s(P1[r],dl);} \
      _Pragma("unroll") for(int r=0;r<16;++r)negm[r]=-mhat; asm volatile("":"+v"(negm)); } \
    _Pragma("unroll") for(int r=0;r<16;++r)P0[r]=__builtin_amdgcn_exp2f(P0[r]); }while(0)
  #define RESC() do{ if(resc){ asm volatile("s_waitcnt lgkmcnt(0)":::"memory"); \
      _Pragma("unroll") for(int d_=0;d_<2;++d_) _Pragma("unroll") for(int r=0;r<16;++r)o[d_][r]*=wsf[crow(r,hi)]; } }while(0)
  f32x16 pA0,pA1,pB0,pB1;
  int sl_prev=0,sl_cur=0,sl_next=SLOTB;
  #define ROT() do{sl_prev=sl_cur;sl_cur=sl_next;sl_next=(sl_next==(NSLOT-1)*SLOTB)?0:sl_next+SLOTB;}while(0)
  DMA_K(2,2*SLOTB);
  WAIT_BAR(3);
  qkt(pA0,pA1,Kbase,qr,negm,r32,hi);asm volatile("s_nop 15\n\ts_nop 7":"+v"(pA0),"+v"(pA1));CMASK(pA0,pA1,0);
  START(pA0,pA1);
  _Pragma("unroll") for(int r=0;r<16;++r)pA1[r]=__builtin_amdgcn_exp2f(pA1[r]);
  WAIT_BAR(0);
  DMA_K(3,0);DMA_V(1,SLOTB);
  ROT();
  kload8(kf,kp0+sl_cur);
  WAIT_BAR(2);
  s16x4 vlo[8],vhi[8]; u32x4 pw0,pw1,pw2,pw3;
  #define PKW(P,B) cvtpk_s(P[B],P[B+1])
  #define PAF(k) __builtin_bit_cast(bf16x8,pw##k)
  #define VFR(i) (bf16x8){vlo[i][0],vlo[i][1],vlo[i][2],vlo[i][3],vhi[i][0],vhi[i][1],vhi[i][2],vhi[i][3]}
  #define PIN(x) asm volatile("":"+v"(x))
  #define MX3(a,b,c) __builtin_fmaxf(__builtin_fmaxf((a),(b)),(c))
  #define GAPA(MF,A0,A1,A2,A3,W0,W1,PW) do{ MF; sacc+=A0; sacc+=A1; sacc+=A2; sacc+=A3; PIN(sacc); W0; W1; PIN(PW); SBAR(); }while(0)
  #define EX(v) __builtin_amdgcn_exp2f(v)
  #define GAPB(MF,X,B) do{ MF; X[B]=EX(X[B]); X[B+1]=EX(X[B+1]); X[B+2]=EX(X[B+2]); X[B+3]=EX(X[B+3]); PIN(X); SBAR(); }while(0)
  #define VRD(i) do{ vlo[i]=vtr(vp_+(((i)>>2)*4096+((i)&3)*1024)); vhi[i]=vtr(vp_+(((i)>>2)*4096+((i)&3)*1024+512)); }while(0)
  #define KRD(G,j) do{ if(G){ kload2(kf,kp0+sl_next,j); SBAR(); } }while(0)
  #define STEP(C0,C1,P0,P1,t,GK,GV,GL) do{ SBAR(); \
    const lds_cptr vp_=vp0+sl_prev; \
    VRD(0); SBAR(); float sacc=(P0[0]+P0[1]); \
    GAPA(C0=__builtin_amdgcn_mfma_f32_32x32x16_bf16(kf[0],qr[0],negm,0,0,0), P0[2],P0[3],P0[4],P0[5],     pw0[0]=PKW(P0,0), pw0[1]=PKW(P0,2), pw0); \
    VRD(4); SBAR(); GAPA(C1=__builtin_amdgcn_mfma_f32_32x32x16_bf16(kf[1],qr[0],negm,0,0,0), P0[6],P0[7],P0[8],P0[9],     pw0[2]=PKW(P0,4), pw0[3]=PKW(P0,6), pw0); \
    VRD(1); SBAR(); GAPA(C0=__builtin_amdgcn_mfma_f32_32x32x16_bf16(kf[2],qr[1],C0,0,0,0),   P0[10],P0[11],P0[12],P0[13], pw1[0]=PKW(P0,8), pw1[1]=PKW(P0,10), pw1); \
    VRD(5); SBAR(); GAPA(C1=__builtin_amdgcn_mfma_f32_32x32x16_bf16(kf[3],qr[1],C1,0,0,0),   P0[14],P0[15],P1[0],P1[1],   pw1[2]=PKW(P0,12),pw1[3]=PKW(P0,14), pw1); \
    VRD(2); SBAR(); GAPA(C0=__builtin_amdgcn_mfma_f32_32x32x16_bf16(kf[4],qr[2],C0,0,0,0),   P1[2],P1[3],P1[4],P1[5],     pw2[0]=PKW(P1,0), pw2[1]=PKW(P1,2), pw2); \
    VRD(6); SBAR(); GAPA(C1=__builtin_amdgcn_mfma_f32_32x32x16_bf16(kf[5],qr[2],C1,0,0,0),   P1[6],P1[7],P1[8],P1[9],     pw2[2]=PKW(P1,4), pw2[3]=PKW(P1,6), pw2); \
    VRD(3); SBAR(); GAPA(C0=__builtin_amdgcn_mfma_f32_32x32x16_bf16(kf[6],qr[3],C0,0,0,0),   P1[10],P1[11],P1[12],P1[13], pw3[0]=PKW(P1,8), pw3[1]=PKW(P1,10), pw3); \
    VRD(7); SBAR(); GAPA(C1=__builtin_amdgcn_mfma_f32_32x32x16_bf16(kf[7],qr[3],C1,0,0,0),   P1[14],P1[15],0.f,0.f,       pw3[2]=PKW(P1,12),pw3[3]=PKW(P1,14), pw3); \
    l_reg+=sacc; \
    if(GK){DMA_K((t)+3,sl_cur);} if(GV){DMA_V((t)+1,sl_next);} \
    CMASK(C0,C1,t); \
    { float a=MX3(C0[0],C0[1],C1[0]),b=MX3(C0[2],C0[3],C1[1]); a=MX3(a,C1[2],C1[3]); \
      _Pragma("unroll") for(int r=4;r<16;r+=4){a=MX3(a,C0[r],C0[r+1]);b=MX3(b,C0[r+2],C0[r+3]);a=MX3(a,C1[r],C1[r+1]);b=MX3(b,C1[r+2],C1[r+3]);} \
      float rm=__builtin_fmaxf(a,b); { auto rr=__builtin_amdgcn_permlane32_swap(__float_as_uint(rm),__float_as_uint(rm),false,false); rm=__builtin_fmaxf(__uint_as_float(rr[0]),__uint_as_float(rr[1])); } \
      resc=false; \
      if(__builtin_expect(__any(rm>(float)THRL),0)){ const float dl=__builtin_fmaxf(rm,0.f); mhat+=dl; \
        _Pragma("unroll") for(int r=0;r<16;++r){C0[r]-=dl;C1[r]-=dl;} \
        _Pragma("unroll") for(int r=0;r<16;++r)negm[r]=-mhat; asm volatile("":"+v"(negm)); \
        const float f=__builtin_amdgcn_exp2f(-dl); l_reg*=f; if(hi==0)wsf[r32]=f; resc=true; } } \
    SBAR(); \
    GAPB(o[0]=__builtin_amdgcn_mfma_f32_32x32x16_bf16(PAF(0),VFR(0),o[0],0,0,0), C0,0); \
    GAPB(o[1]=__builtin_amdgcn_mfma_f32_32x32x16_bf16(PAF(0),VFR(4),o[1],0,0,0), C0,4); \
    KRD(GL,0); GAPB(o[0]=__builtin_amdgcn_mfma_f32_32x32x16_bf16(PAF(1),VFR(1),o[0],0,0,0), C0,8); \
    KRD(GL,1); GAPB(o[1]=__builtin_amdgcn_mfma_f32_32x32x16_bf16(PAF(1),VFR(5),o[1],0,0,0), C0,12); \
    KRD(GL,2); GAPB(o[0]=__builtin_amdgcn_mfma_f32_32x32x16_bf16(PAF(2),VFR(2),o[0],0,0,0), C1,0); \
    KRD(GL,3); GAPB(o[1]=__builtin_amdgcn_mfma_f32_32x32x16_bf16(PAF(2),VFR(6),o[1],0,0,0), C1,4); \
    GAPB(o[0]=__builtin_amdgcn_mfma_f32_32x32x16_bf16(PAF(3),VFR(3),o[0],0,0,0), C1,8); \
    GAPB(o[1]=__builtin_amdgcn_mfma_f32_32x32x16_bf16(PAF(3),VFR(7),o[1],0,0,0), C1,12); \
    }while(0)
  int t=1;
  for(;t+5<NT;t+=2){
    STEP(pB0,pB1,pA0,pA1,t,true,true,true);     WAIT_BAR(2); RESC(); ROT();
    STEP(pA0,pA1,pB0,pB1,t+1,true,true,true);   WAIT_BAR(2); RESC(); ROT();
  }
  #define ENDW(tt) do{ if((tt)+3<NT){WAIT_BAR(2);} else if((tt)+2<NT){WAIT_BAR(1);} else {WAIT_BAR(0);} }while(0)
  for(;t+1<NT;t+=2){
    STEP(pB0,pB1,pA0,pA1,t,(t+3<NT),(t+1<NT),(t+1<NT));       ENDW(t);   RESC(); ROT();
    STEP(pA0,pA1,pB0,pB1,t+1,(t+4<NT),(t+2<NT),(t+2<NT));     ENDW(t+1); RESC(); ROT();
  }
  STEP(pB0,pB1,pA0,pA1,NT-1,false,false,false); RESC();
  { float sacc=pB0[0]+pB0[1]; _Pragma("unroll") for(int r=2;r<16;++r)sacc+=pB0[r]; _Pragma("unroll") for(int r=0;r<16;++r)sacc+=pB1[r]; l_reg+=sacc;
    pw0=(u32x4){PKW(pB0,0),PKW(pB0,2),PKW(pB0,4),PKW(pB0,6)};pw1=(u32x4){PKW(pB0,8),PKW(pB0,10),PKW(pB0,12),PKW(pB0,14)};pw2=(u32x4){PKW(pB1,0),PKW(pB1,2),PKW(pB1,4),PKW(pB1,6)};pw3=(u32x4){PKW(pB1,8),PKW(pB1,10),PKW(pB1,12),PKW(pB1,14)};
    SBAR(); pv(o,vb0+sl_cur,PAF(0),PAF(1),PAF(2),PAF(3)); }
  #undef PKW
  #undef PAF
  #undef VFR
  #undef PIN
  #undef MX3
  #undef GAPA
  #undef GAPB
  #undef EX
  #undef VRD
  #undef KRD
  #undef STEP
  #undef ENDW
  {auto rr=__builtin_amdgcn_permlane32_swap(__float_as_uint(l_reg),__float_as_uint(l_reg),false,false);l_reg=__uint_as_float(rr[0])+__uint_as_float(rr[1]);}
  if(hi==0)wsf[32+r32]=l_reg;asm volatile("s_waitcnt lgkmcnt(0)":::"memory");
  float rli[16];
  #pragma unroll
  for(int r=0;r<16;++r)rli[r]=__builtin_amdgcn_rcpf(wsf[32+crow(r,hi)]);
  bf16*Ow=Op+(long)(wid*QBLK)*opitch;
  { bf16*stg=(bf16*)(shm+LDS_OST)+wid*2048;
    #pragma unroll
    for(int r=0;r<16;++r){const int orow=crow(r,hi);
      #pragma unroll
      for(int d0=0;d0<2;++d0)stg[orow*64+d0*32+r32]=__float2bfloat16(o[d0][r]*rli[r]);}
    asm volatile("s_waitcnt lgkmcnt(0)":::"memory");
    #pragma unroll
    for(int i=0;i<4;++i){const int row=i*8+(lane>>3),ch=lane&7; const u32x4 v=*(const u32x4*)(stg+row*64+ch*8); ATTN_STORE16(Ow+(long)row*opitch+ch*8,v);} }
  asm volatile("s_waitcnt lgkmcnt(0)\n\ts_barrier":::"memory");
  #undef DMA_K
  #undef DMA_V
  #undef CMASK
  #undef START
  #undef RESC
  #undef ROT
}
constexpr int ATTN_LDS_BYTES=LDS_BYTES;
#undef SBAR
#undef WAIT_BAR
}


#define pMOD ((float*)(ws + WS_MOD))
#define pROPE ((float*)(ws + WS_ROPE))
#define pAFF ((float*)(ws + WS_AFF))
#define pINV ((int*)(ws + WS_INV))
#define pDT ((float*)(ws + WS_DT))
#define pSRC ((int*)(ws + WS_SRC))
#define pGV ((float*)(ws + WS_GV))
#define pSSQ ((float*)(ws + WS_SSQ))
#define pTOT ((float*)(ws + WS_TOT))
#define pX ((float*)(ws + WS_X))
#define pH ((bf16_t*)(ws + WS_H))
#define pYA ((bf16_t*)(ws + WS_YA))
#define pYB ((bf16_t*)(ws + WS_YB))
#define pPA ((bf16_t*)(ws + WS_PA))
#define pPG ((bf16_t*)(ws + WS_PG))
#define pMRG ((float*)(ws + WS_MRG))
#define pMRGB ((bf16_t*)(ws + WS_MRGB))
#define pXG ((bf16_t*)(ws + WS_XG))
#define pHID ((bf16_t*)(ws + WS_HID))
#define pYE ((bf16_t*)(ws + WS_YE))
#define pQN ((bf16_t*)(ws + WS_QN))
#define pKN ((bf16_t*)(ws + WS_KN))
#define pHIN ((bf16_t*)(ws + WS_HIN))
#define pXBC ((bf16_t*)(ws + WS_XBC))
#define pAU ((bf16_t*)(ws + WS_AU))
#define pSS ((float*)(ws + WS_S))
#define pYG ((bf16_t*)(ws + WS_YG))
#define pYC ((bf16_t*)(ws + WS_YC))
#define pS5S ((float*)(ws + WS_S5S))
#define pYD ((bf16_t*)(ws + WS_YD))
struct Args { const float* in[38]; float* out; unsigned char* ws; int ph_lo, ph_hi; };
constexpr int PH_PER_LAYER = 15, PH_FINAL = 2 * PH_PER_LAYER, PH_TOTAL = PH_FINAL + 1;

DI LayerIn layer_in(const Args& a, int L) {
    LayerIn P;
    P.norm_mix_g = a.in[6] + (size_t)L * 1024; P.norm_ffn_g = a.in[7] + (size_t)L * 1024;
    P.w_in = a.in[8] + (size_t)L * 1024 * NIN; P.q_norm_g = a.in[9] + L * 64; P.k_norm_g = a.in[10] + L * 64;
    P.ssd_conv_w = a.in[11] + L * 3 * 768; P.ssd_conv_b = a.in[12] + L * 768; P.ssd_dt_bias = a.in[13] + L * 16; P.ssd_a_log = a.in[14] + L * 16;
    P.ssd_d = a.in[15] + L * 8; P.ssd_norm_g = a.in[16] + L * 512;
    P.s5_lre = a.in[17] + L * 2 * 24 * 64; P.s5_lim = a.in[18] + L * 2 * 24 * 64; P.s5_lstep = a.in[19] + L * 48;
    P.s5_bre = a.in[20] + (size_t)L * 24 * 64 * 16; P.s5_bim = a.in[21] + (size_t)L * 24 * 64 * 16; P.s5_cre = a.in[22] + (size_t)L * 24 * 16 * 64; P.s5_cim = a.in[23] + (size_t)L * 24 * 16 * 64;
    P.s5_d = a.in[24] + L * 384; P.s5_wglu = a.in[25] + (size_t)L * 384 * 384; P.s5_bglu = a.in[26] + L * 384; P.sc_conv_w = a.in[27] + L * 3 * 384;
    P.w_br_attn = a.in[28] + (size_t)L * 512 * 1024; P.w_br_ssd = a.in[29] + (size_t)L * 512 * 1024; P.w_br_s5 = a.in[30] + (size_t)L * 384 * 1024; P.w_br_sc = a.in[31] + (size_t)L * 384 * 1024;
    P.w_out = a.in[32] + (size_t)L * 1024 * 1024; P.w_router = a.in[33] + (size_t)L * 1024 * 16;
    P.w_gate = a.in[34] + (size_t)L * 16 * 1024 * 1024; P.w_up = a.in[35] + (size_t)L * 16 * 1024 * 1024; P.w_down = a.in[36] + (size_t)L * 16 * 1024 * 1024;
    return P;
}

__global__ void __launch_bounds__(NWAVES * 64, 2) hybrid_fwd(Args args) {
    extern __shared__ __attribute__((aligned(16))) unsigned char lds_raw[];
    Frame F0;
#define F F0
    F.lds = (LAS unsigned char*)lds_raw;
    F.tid = threadIdx.x; F.lane = F.tid & 63; F.wave = __builtin_amdgcn_readfirstlane(F.tid >> 6);
    F.G = gridDim.x; { const int bx = blockIdx.x; F.vcu = (F.G % 8 == 0) ? (bx % 8) * (F.G / 8) + bx / 8 : bx; }
    F.gw = F.vcu * NWAVES + F.wave; F.NGW = F.G * NWAVES;
    unsigned char* ws = args.ws;
    volatile LAS unsigned* MISC = (volatile LAS unsigned*)(F.lds + LDSCTL_OFF);
    for (int u = F.tid; u < (LDS_BYTES - LDSCTL_OFF) / 4; u += NWAVES * 64) ((LAS unsigned*)(F.lds + LDSCTL_OFF))[u] = 0u;
    __syncthreads();
    XcdBarrier bar = xcd_barrier_post((unsigned*)(ws + WS_CTL) + CW_BAR, MISC + 8);
    const int lo = args.ph_lo, hi = args.ph_hi;
#ifndef PH_MASK
#define PH_MASK 0xFFFF
#endif
#define IN(k) (lo <= (k) && (k) < hi)
#define INL(j) (((PH_MASK >> (j)) & 1) && IN(base + (j)))
#ifndef REPEAT_MASK
#define REPEAT_MASK 0
#endif
#define REP(j) for (int rep_ = 0; rep_ < 1 + ((REPEAT_MASK >> (j)) & 1); ++rep_)
#define SEAM(k) do { if (IN((k) + 1)) xcd_barrier(bar); } while (0)

#undef F
#pragma unroll 1
    for (int L = 0; L < 2; ++L) {
        const int base = L * PH_PER_LAYER;
        if (hi <= base || lo >= base + PH_PER_LAYER) continue;
        const bool lastL = (L == 1);

        if (INL(0)) REP(0) { const LayerIn P = layer_in(args, L); Frame F = F0; F.tid = fresh_tid(); F.lane = F.tid & 63; if (rep_) xcd_barrier(bar);
            if (L == 0) { prep_mod(F, args.in[1], args.in[3], args.in[4], args.in[5], pMOD); prep_rope(F, pROPE); }
            prep_s5(F, P, ws);
            prep_small_weights(F, P, ws);
            SEAM(base + 0);
        }
        if (INL(1)) REP(1) { const LayerIn P = layer_in(args, L); Frame F = F0; F.tid = fresh_tid(); F.lane = F.tid & 63; if (rep_) xcd_barrier(bar); phase_norm1(F, L, args.in[0], args.in[2], pX, pH, pMOD, P.norm_mix_g, pINV, pYE); SEAM(base + 1); }
        if (INL(2)) REP(2) { const LayerIn P = layer_in(args, L); Frame F = F0; F.tid = fresh_tid(); F.lane = F.tid & 63; if (rep_) xcd_barrier(bar);
            pg8::Gemm g{pH, (const bf16_t*)(ws + W_WIN), 1024, 1024, 1024};
            RowSkipOrder S; S.init(NPROJ, F.G, (int)blockIdx.x, lastL ? 1 : 0, 2, 10);
            EpiProj E{pPA, PA_W, PA_W / 256, pPG, PG_W};
            pg8::gemm_phase<EpiProj, RowSkipOrder>(F.lds, g, S, E);
            SEAM(base + 2);
        }
        if (INL(3)) REP(3) { const LayerIn P = layer_in(args, L); Frame F = F0; F.tid = fresh_tid(); F.lane = F.tid & 63; if (rep_) xcd_barrier(bar); phase_elem(F, P, pPA, pROPE, pQN, pKN, pXBC, pDT, pAU, pYD); SEAM(base + 3); }
        if (INL(4)) REP(4) { const LayerIn P = layer_in(args, L); Frame F = F0; F.tid = fresh_tid(); F.lane = F.tid & 63; if (rep_) xcd_barrier(bar);
            using abf = attn_body::bf16;
#ifndef NO_ATTN
            for (int u = F.vcu; u < 512; u += F.G) { const int bk = u >> 5, r = u & 31, b = bk >> 1, kvh = bk & 1, h = kvh * 4 + (r >> 3), qb = r & 7;
                const size_t qrow = (size_t)b * PB + CTXL + qb * 256, krow = (size_t)b * PB;
                attn_body::attn_unit<8>((const abf*)(pQN + qrow * 512 + h * 64), 512, (const abf*)(pKN + krow * 128 + kvh * 64), 128, (const abf*)(pPA + krow * PA_W + C_V + kvh * 64), PA_W,
                                        (abf*)(pYA + qrow * 512 + h * 64), 512, 36, (char*)lds_raw); }
            if (!lastL) for (int u = F.vcu; u < 64; u += F.G) { const int b = u >> 3, h = u & 7, kvh = h >> 2; const size_t krow = (size_t)b * PB;
                attn_body::attn_unit<8>((const abf*)(pQN + krow * 512 + h * 64), 512, (const abf*)(pKN + krow * 128 + kvh * 64), 128, (const abf*)(pPA + krow * PA_W + C_V + kvh * 64), PA_W,
                                        (abf*)(pYA + krow * 512 + h * 64), 512, 4, (char*)lds_raw); }
#endif
            __syncthreads();
#ifndef NO_E1
            ssd_chunk_states(F, P, pXBC, pDT, pSS, pTOT);
#endif
#ifndef NO_S5S
            { pg8::Gemm g{pAU, (const bf16_t*)(ws + W_P), 768, 512, 512}; OrderS5S S{F.G, (int)blockIdx.x}; EpiS5S E{pS5S};
              pg8::gemm_phase<EpiS5S, OrderS5S>(F.lds, g, S, E); }
#endif
            SEAM(base + 4);
        }
        if (INL(5)) REP(5) { const LayerIn P = layer_in(args, L); Frame F = F0; F.tid = fresh_tid(); F.lane = F.tid & 63; if (rep_) xcd_barrier(bar); ssd_recurrence(F, pSS, pTOT, pHIN); s5_recurrence(F, P, pS5S, pAU); SEAM(base + 5); }
        if (INL(6)) REP(6) { const LayerIn P = layer_in(args, L); Frame F = F0; F.tid = fresh_tid(); F.lane = F.tid & 63; if (rep_) xcd_barrier(bar);
#ifndef NO_E3
            ssd_output(F, P, pXBC, pPA, pDT, pHIN, pYB, pSSQ, lastL);
#endif
#ifndef NO_S5Y
            { pg8::Gemm g{pAU, (const bf16_t*)(ws + W_TQ), 768, 768, 768}; OrderS5Y S{F.G, (int)blockIdx.x}; EpiS5Y E{pAU, pYG, P.s5_d};
              pg8::gemm_phase<EpiS5Y, OrderS5Y>(F.lds, g, S, E); }
#endif
            SEAM(base + 6);
        }
        if (INL(7)) REP(7) { const LayerIn P = layer_in(args, L); Frame F = F0; F.tid = fresh_tid(); F.lane = F.tid & 63; if (rep_) xcd_barrier(bar);
            pg8::Gemm g{pYG, (const bf16_t*)(ws + W_GLU), 384, 384, 384};
            RowSkipOrder S; S.init(512, F.G, (int)blockIdx.x, lastL ? 1 : 0, 0, 0);
            EpiGlu E{pYG, pYC, P.s5_bglu};
            pg8::gemm_phase<EpiGlu, RowSkipOrder>(F.lds, g, S, E);
            SEAM(base + 7);
        }
        if (INL(8)) REP(8) { const LayerIn P = layer_in(args, L); Frame F = F0; F.tid = fresh_tid(); F.lane = F.tid & 63; if (rep_) xcd_barrier(bar);
            RowSkipOrder S; S.init(1024, F.G, (int)blockIdx.x, lastL ? 1 : 0, 0, 0);
            { pg8::Gemm g{pYA, (const bf16_t*)(ws + W_BRA), 512, 512, 512}; EpiMerge E{pPG + 0 * 1024, pMRG, pMRGB, nullptr, 0}; pg8::gemm_phase<EpiMerge, RowSkipOrder>(F.lds, g, S, E); }
            { pg8::Gemm g{pYB, (const bf16_t*)(ws + W_BRB), 512, 512, 512}; EpiMerge E{pPG + 1 * 1024, pMRG, pMRGB, pSSQ, 1}; pg8::gemm_phase<EpiMerge, RowSkipOrder>(F.lds, g, S, E); }
            { pg8::Gemm g{pYC, (const bf16_t*)(ws + W_BRC), 384, 384, 384}; EpiMerge E{pPG + 2 * 1024, pMRG, pMRGB, nullptr, 1}; pg8::gemm_phase<EpiMerge, RowSkipOrder>(F.lds, g, S, E); }
            { pg8::Gemm g{pYD, (const bf16_t*)(ws + W_BRD), 384, 384, 384}; EpiMerge E{pPG + 3 * 1024, pMRG, pMRGB, nullptr, 2}; pg8::gemm_phase<EpiMerge, RowSkipOrder>(F.lds, g, S, E); }
            SEAM(base + 8);
        }
        if (INL(9)) REP(9) { const LayerIn P = layer_in(args, L); Frame F = F0; F.tid = fresh_tid(); F.lane = F.tid & 63; if (rep_) xcd_barrier(bar);
            pg8::Gemm g{pMRGB, (const bf16_t*)(ws + W_OUT), 1024, 1024, 1024};
            RowSkipOrder S; S.init(1024, F.G, (int)blockIdx.x, lastL ? 1 : 0, 0, 0);
            EpiWout E{pX, pMOD + (size_t)L * 9 * 6144};
            pg8::gemm_phase<EpiWout, RowSkipOrder>(F.lds, g, S, E);
            SEAM(base + 9);
        }
        if (INL(10)) REP(10) { const LayerIn P = layer_in(args, L); Frame F = F0; F.tid = fresh_tid(); F.lane = F.tid & 63; if (rep_) xcd_barrier(bar); phase_norm2(F, L, lastL, pX, pH, pMOD, P.norm_ffn_g, P.w_router, pAFF); SEAM(base + 10); }
        if (INL(11)) REP(11) { const LayerIn P = layer_in(args, L); Frame F = F0; F.tid = fresh_tid(); F.lane = F.tid & 63; if (rep_) xcd_barrier(bar); phase_topk(F, lastL ? 128 : 256, pAFF, pSRC, pGV, pINV); prep_expert_weights(F, P, ws); SEAM(base + 11); }
        if (INL(12)) REP(12) { const LayerIn P = layer_in(args, L); Frame F = F0; F.tid = fresh_tid(); F.lane = F.tid & 63; if (rep_) xcd_barrier(bar); phase_gather(F, lastL ? 2048 : 2304, pSRC, pH, pXG); SEAM(base + 12); }
        if (INL(13)) REP(13) { const LayerIn P = layer_in(args, L); Frame F = F0; F.tid = fresh_tid(); F.lane = F.tid & 63; if (rep_) xcd_barrier(bar);
            pg8::Gemm g{pXG, (const bf16_t*)(ws + WS_WGU), 1024, 1024, 1024}; OrderUp S{F.G, (int)blockIdx.x, lastL ? 8 : 9}; EpiUp E{pHID};
            pg8::gemm_phase<EpiUp, OrderUp>(F.lds, g, S, E);
            SEAM(base + 13);
        }
        if (INL(14)) REP(14) { const LayerIn P = layer_in(args, L); Frame F = F0; F.tid = fresh_tid(); F.lane = F.tid & 63; if (rep_) xcd_barrier(bar);
            pg8::Gemm g{pHID, (const bf16_t*)(ws + WS_WD), 1024, 1024, 1024}; OrderDown S{F.G, (int)blockIdx.x, lastL ? 8 : 9}; EpiDown E{pYE, pGV};
            pg8::gemm_phase<EpiDown, OrderDown>(F.lds, g, S, E);
            SEAM(base + 14);
        }
    }
    if (IN(PH_FINAL)) phase_final(F0, pX, args.out, pMOD, args.in[37], pINV, pYE);
#undef IN
#undef INL
#undef SEAM
}

#ifndef MK_N_LAUNCHES
#define MK_N_LAUNCHES 1
#endif
extern "C" void kernel_launch(void* const* d_in, const int* in_sizes, int n_in, void* d_out, int out_size, void* d_ws, size_t ws_size, hipStream_t stream) {
    static int grid = 0;
    if (grid == 0) {
        if (n_in != 38 || ws_size < WS_END) { fprintf(stderr, "kernel_launch: unexpected inputs (n_in %d, ws %zu)\n", n_in, ws_size); grid = -1; return; }
        int dev = 0, cus = 0;
        if (hipGetDevice(&dev) != hipSuccess || hipDeviceGetAttribute(&cus, hipDeviceAttributeMultiprocessorCount, dev) != hipSuccess) { grid = -1; return; }
        if (hipFuncSetAttribute((const void*)hybrid_fwd, hipFuncAttributeMaxDynamicSharedMemorySize, LDS_BYTES) != hipSuccess) { fprintf(stderr, "kernel_launch: hipFuncSetAttribute failed\n"); grid = -1; return; }
        (void)hipGetLastError();
        grid = (cus / 8) * 8;
        if (grid > 256) grid = 256;
    }
    if (grid < 0) return;
    if (hipMemsetAsync((char*)d_ws + WS_CTL, 0, CTL_ZERO_BYTES, stream) != hipSuccess) return;
    Args a{};
    for (int i = 0; i < 38; ++i) a.in[i] = (const float*)d_in[i];
    a.out = (float*)d_out; a.ws = (unsigned char*)d_ws;
#if MK_N_LAUNCHES == 1
    a.ph_lo = 0; a.ph_hi = PH_TOTAL;
    hipLaunchKernelGGL(hybrid_fwd, dim3(grid), dim3(NWAVES * 64), LDS_BYTES, stream, a);
#else
    for (int p = 0; p < PH_TOTAL; ++p) { a.ph_lo = p; a.ph_hi = p + 1; hipLaunchKernelGGL(hybrid_fwd, dim3(grid), dim3(NWAVES * 64), LDS_BYTES, stream, a); }
#endif
}
```

```cpp
#include <hip/hip_runtime.h>
#include <hip/hip_bf16.h>
#include <cstdio>
#include <cstdint>
#include <cmath>

#define DI __device__ __forceinline__
#define GAS __attribute__((address_space(1)))
#define LAS __attribute__((address_space(3)))
typedef unsigned short bf16_t;
typedef short bf16x8 __attribute__((ext_vector_type(8)));
typedef short s16x4 __attribute__((ext_vector_type(4)));
typedef float f32x2 __attribute__((ext_vector_type(2)));
typedef float f32x4 __attribute__((ext_vector_type(4)));
typedef float f32x16 __attribute__((ext_vector_type(16)));
typedef unsigned u32x2 __attribute__((ext_vector_type(2)));
typedef unsigned u32x4 __attribute__((ext_vector_type(4)));
typedef GAS unsigned gu32;

constexpr int DM = 1024, NB = 8, SEQ = 2048, CTXL = 256, PB = 2304, MROWS = NB * PB;
constexpr int NIN = 7688, NE = 16, EFF = 1024;
constexpr int C_Q = 0, C_K = 512, C_V = 640, C_Z = 768, C_XBC = 1280, C_DT = 2048, C_U = 2056, C_SB = 2440, C_SG = 2824, C_SH = 3208, C_G = 3592;
constexpr int PA_W = 3840, PG_W = 4096, NPROJ = PA_W + PG_W;
constexpr int EROWS = 2304;
constexpr float RMS_EPS = 1e-6f;
constexpr float ATT_C2 = 0.125f * 1.4426950408889634f;

constexpr size_t MiB = 1u << 20;
constexpr size_t WS_CTL = 0, CTL_ZERO_BYTES = 1 * MiB;
constexpr size_t WS_MOD = 1 * MiB;
constexpr size_t WS_ROPE = WS_MOD + 512 * 1024;
constexpr size_t WS_AFF = 2 * MiB;
constexpr size_t WS_INV = WS_AFF + 1280 * 1024;
constexpr size_t WS_DT = WS_INV + 1280 * 1024;
constexpr size_t WS_SRC = WS_DT + 1280 * 1024;
constexpr size_t WS_GV = WS_SRC + 256 * 1024;
constexpr size_t WS_SSQ = WS_GV + 256 * 1024;
constexpr size_t WS_TOT = WS_SSQ + 256 * 1024;
constexpr size_t WS_X = 8 * MiB;
constexpr size_t WS_W = 80 * MiB;
constexpr size_t W_WIN = WS_W;
constexpr size_t W_BR4 = W_WIN + (size_t)NPROJ * 1024 * 2;
constexpr size_t W_OUT = W_BR4 + (size_t)1024 * 1792 * 2;
constexpr size_t W_GLU = W_OUT + 1024 * 1024 * 2;
constexpr size_t W_TQ = W_GLU + 512 * 384 * 2;
constexpr size_t W_P = W_TQ + (size_t)24 * 512 * 768 * 2;
constexpr size_t W_END = W_P + (size_t)24 * 256 * 512 * 2;
constexpr size_t WS_H = 126 * MiB;
constexpr size_t WS_YAB = WS_H;
constexpr size_t WS_PA = 162 * MiB;
constexpr size_t WS_MRGB = WS_PA + 72 * MiB, WS_XG = WS_PA;
constexpr size_t WS_PG = 297 * MiB;
constexpr size_t WS_HID = WS_PG, WS_YE = WS_PG + 72 * MiB;
constexpr size_t WS_R5 = 441 * MiB;
constexpr size_t WS_QN = WS_R5;
constexpr size_t WS_KN = WS_R5 + 18 * MiB;
constexpr size_t WS_HIN = WS_R5;
constexpr size_t WS_XBC = WS_R5 + 22 * MiB + 512 * 1024;
constexpr size_t WS_AU = WS_R5 + 49 * MiB + 512 * 1024;
constexpr size_t WS_S = WS_R5 + 70 * MiB;
constexpr size_t WS_YG = WS_S;
constexpr size_t WS_S5S = WS_R5 + 106 * MiB;
constexpr size_t WS_YCD = WS_S5S + 13 * MiB + 512 * 1024;
constexpr size_t WS_WGU = WS_R5;
constexpr size_t WS_WD = WS_R5 + 64 * MiB;
constexpr size_t WS_END = WS_YCD + 27 * MiB;
static_assert(W_END <= WS_H, "small weights fit");
static_assert(WS_AU + (size_t)24 * 576 * 768 * 2 <= WS_S && WS_XBC + (size_t)MROWS * 768 * 2 <= WS_AU && WS_S + (size_t)8 * 18 * 16 * 4096 * 4 <= WS_S5S, "R5 map");
static_assert(WS_S5S + (size_t)24 * 576 * 256 * 4 <= WS_YCD && WS_YCD + (size_t)MROWS * 768 * 2 <= WS_END && WS_WD + (size_t)32 * MiB <= WS_YCD && WS_END <= (size_t)588 * MiB, "R5 map 2");
static_assert(WS_TOT + 16384 <= WS_X && WS_ROPE + 2048 * 64 * 4 <= WS_AFF, "misc map");

constexpr int CW_BAR = 4096;

constexpr int NWAVES = 8;
constexpr int LDS_SCRATCH = 151552;
constexpr int LDSCTL_OFF = LDS_SCRATCH;
constexpr int LDS_BYTES = 155648;

#define LDS_WAIT() asm volatile("s_waitcnt lgkmcnt(0)" ::: "memory")
#define VM_WAIT() asm volatile("s_waitcnt vmcnt(0)" ::: "memory")
DI int fresh_tid() { int t = threadIdx.x; asm volatile("" : "+v"(t)); return t; }
DI unsigned f2bf(float f) { unsigned u = __builtin_bit_cast(unsigned, f); return (u + 0x7fffu + ((u >> 16) & 1u)) >> 16; }
DI unsigned pk2(float lo, float hi) { return f2bf(lo) | (f2bf(hi) << 16); }
DI float bflo(unsigned w) { return __builtin_bit_cast(float, w << 16); }
DI float bfhi(unsigned w) { return __builtin_bit_cast(float, w & 0xffff0000u); }
DI float bf2f(bf16_t h) { return __builtin_bit_cast(float, (unsigned)h << 16); }
DI float silu_f(float x) { return x / (1.f + __expf(-x)); }
DI float sigmoid_f(float x) { return 1.f / (1.f + __expf(-x)); }
DI float softplus_f(float x) { return fmaxf(x, 0.f) + log1pf(__expf(-fabsf(x))); }
DI float gelu_tanh_f(float x) { const float u = 0.7978845608028654f * (x + 0.044715f * x * x * x); const float t = 1.f - 2.f / (__expf(2.f * u) + 1.f); return 0.5f * x * (1.f + t); }
DI float wave_sum(float v) {
#pragma unroll
    for (int o = 1; o < 64; o <<= 1) v += __shfl_xor(v, o);
    return v;
}
DI void unpack8(const u32x4 w, float (&f)[8]) {
    f[0] = bflo(w.x); f[1] = bfhi(w.x); f[2] = bflo(w.y); f[3] = bfhi(w.y); f[4] = bflo(w.z); f[5] = bfhi(w.z); f[6] = bflo(w.w); f[7] = bfhi(w.w);
}
DI u32x4 pack8(const float (&f)[8]) { u32x4 w; w.x = pk2(f[0], f[1]); w.y = pk2(f[2], f[3]); w.z = pk2(f[4], f[5]); w.w = pk2(f[6], f[7]); return w; }

#define XB_TMO      128
#define XB_XCNT(j)  (256  + 64 * (j))
#define XB_XSUB(j)  (1280 + 64 * (j))
#define XB_XGEN(j)  (2304 + 64 * (j))
#define XB_TOP      3328
#define XB_TOPGEN   3392
#define XCD_BAR_WORDS 3456
#define XB_SPIN_CAP (1u << 20)
DI unsigned xb_ld(unsigned* p)              { return __hip_atomic_load(p, __ATOMIC_RELAXED, __HIP_MEMORY_SCOPE_AGENT); }
DI unsigned xb_add(unsigned* p, unsigned v) { return __hip_atomic_fetch_add(p, v, __ATOMIC_RELAXED, __HIP_MEMORY_SCOPE_AGENT); }
DI unsigned xb_xcc_id() { return (unsigned)__builtin_amdgcn_s_getreg((3 << 11) | 20) & 0xFu; }
#define XB_SPIN(cond, bar) do { unsigned _sp = 0; while (cond) { __builtin_amdgcn_s_sleep(1); \
    if ((++_sp & 255u) == 0u) { if (xb_ld(&(bar)[XB_TMO])) break; if (_sp > XB_SPIN_CAP) { atomicAdd(&(bar)[XB_TMO], 1u); break; } } } } while (0)
struct XcdBarrier { unsigned* bar; unsigned x; volatile LAS unsigned* st; };
DI XcdBarrier xcd_barrier_post(unsigned* bar, volatile LAS unsigned* st) {
    XcdBarrier b; b.bar = bar; b.x = xb_xcc_id(); b.st = st;
    if (threadIdx.x == 0) (void)xb_add(&bar[XB_XCNT(b.x)], 1u);
    return b;
}
DI void xcd_barrier_complete(unsigned* bar, unsigned x, unsigned& nloc, unsigned& nx) {
    const unsigned G = gridDim.x * gridDim.y * gridDim.z;
    unsigned sum, cnt, mine, sp = 0u;
    for (;;) {
        sum = 0u; cnt = 0u; mine = 0u;
#pragma unroll
        for (unsigned j = 0; j < 16; ++j) { const unsigned c = xb_ld(&bar[XB_XCNT(j)]); sum += c; cnt += (c > 0u) ? 1u : 0u; mine = (j == x) ? c : mine; }
        if (sum == G) break;
        __builtin_amdgcn_s_sleep(1);
        if ((++sp & 255u) == 0u) { if (xb_ld(&bar[XB_TMO])) break; if (sp > XB_SPIN_CAP) { atomicAdd(&bar[XB_TMO], 1u); break; } }
    }
    nloc = mine > 0u ? mine : 1u; nx = cnt > 0u ? cnt : 1u;
}
DI void xcd_barrier(const XcdBarrier& b) {
    asm volatile("s_waitcnt vmcnt(0)" ::: "memory");
    __syncthreads();
    if (threadIdx.x == 0) {
        unsigned* bar = b.bar;
        __builtin_amdgcn_s_waitcnt(0);
        unsigned nloc = b.st[0], nx = b.st[1];
        if (nloc == 0u) { xcd_barrier_complete(bar, b.x, nloc, nx); b.st[0] = nloc; b.st[1] = nx; }
        const unsigned old = xb_add(&bar[XB_XSUB(b.x)], 1u);
        const unsigned gen = old / nloc;
        if (old + 1u == (gen + 1u) * nloc) {
            __builtin_amdgcn_fence(__ATOMIC_RELEASE, "agent");
            asm volatile("s_waitcnt vmcnt(0)" ::: "memory");
            const unsigned og = xb_add(&bar[XB_TOP], 1u);
            const unsigned tg = og / nx;
            if (og + 1u == (tg + 1u) * nx) xb_add(&bar[XB_TOPGEN], 1u);
            else XB_SPIN(xb_ld(&bar[XB_TOPGEN]) == tg, bar);
            __builtin_amdgcn_fence(__ATOMIC_ACQUIRE, "agent");
            xb_add(&bar[XB_XGEN(b.x)], 1u);
            asm volatile("s_waitcnt vmcnt(0)" ::: "memory");
        } else {
            XB_SPIN(xb_ld(&bar[XB_XGEN(b.x)]) == gen, bar);
            __builtin_amdgcn_fence(__ATOMIC_ACQUIRE, "agent");
            asm volatile("s_waitcnt vmcnt(0)" ::: "memory");
        }
    }
    __syncthreads();
}

namespace pg8 {
constexpr int BM = 256, BK = 64, HALF = 128, HTB = HALF * BK * 2, STAGE_BYTES = 8 * HTB, NXCD = 8, WGM = 8;
__host__ __device__ __forceinline__ int lds_byte(int r, int c) { const int st = (r >> 4) * 2 + (c >> 5), rr = r & 15, cc = c & 31, ob = rr * 64 + cc * 2; return st * 1024 + (ob ^ (((ob >> 9) & 1) << 5)); }
__host__ __device__ __forceinline__ void stage_rc(int b, int& R, int& C) { const int st = b / 1024, sb = b % 1024, swz = sb ^ (((sb >> 9) & 1) << 5); R = (st >> 1) * 16 + swz / 64; C = (st & 1) * 32 + (swz % 64) / 2; }
__host__ __device__ __forceinline__ int perm32(int rho) { const int n = rho >> 4, i = rho & 15; return 8 * (i >> 2) + 4 * n + (i & 3); }

struct Unit { int arow, brow, pm, pn; };
struct Gemm { const bf16_t* A; const bf16_t* Bt; int lda, ldb, K; };

template <class Epi, class Sched, bool ALIGN_EPI = true>
DI void gemm_phase(LAS unsigned char* lds, const Gemm g, const Sched& S, const Epi& E) {
    const int tid = fresh_tid(), wid = __builtin_amdgcn_readfirstlane(tid >> 6), lane = tid & 63, wr = wid >> 2, wc = wid & 3, fr = lane & 15, fq = lane >> 4;
    const int K = g.K, nt = K / BK;
    unsigned voffA[2], voffB[2];
#pragma unroll
    for (int i = 0; i < 2; ++i) { int R, C; stage_rc(tid * 16 + i * 8192, R, C); const int Rb = Epi::PERM ? ((R & ~31) + perm32(R & 31)) : R;
        voffA[i] = (unsigned)(R * g.lda + C) * 2u; voffB[i] = (unsigned)(Rb * g.ldb + C) * 2u; }
    const size_t kstep = (size_t)(BK * 2);
    const size_t hA = (size_t)HALF * g.lda * 2, hB = (size_t)HALF * g.ldb * 2;
    const unsigned ldsw = (unsigned)wid * 1024u;
    const int aoff = lds_byte(wr * 64 + fr, fq * 8), boff = lds_byte(wc * 32 + fr, fq * 8);
#define PG8_SA(b, h) (((b) * 2 + (h)) * HTB)
#define PG8_SB(b, h) ((4 + (b) * 2 + (h)) * HTB)
#define PG8_STAGE(bufoff, gbase, voff) do { _Pragma("unroll") for (int _i = 0; _i < 2; ++_i) \
        __builtin_amdgcn_global_load_lds((const unsigned*)((const char*)(gbase) + (voff)[_i]), (LAS unsigned*)(lds + (bufoff) + ldsw + _i * 8192), 16, 0, 0); } while (0)
#define PG8_LDA(dst, b, h) do { _Pragma("unroll") for (int m = 0; m < 4; ++m) _Pragma("unroll") for (int k = 0; k < 2; ++k) dst[m][k] = *(const LAS bf16x8*)(lds + PG8_SA(b, h) + aoff + m * 2048 + k * 1024); } while (0)
#define PG8_LDB(dst, b, h) do { _Pragma("unroll") for (int n = 0; n < 2; ++n) _Pragma("unroll") for (int k = 0; k < 2; ++k) dst[n][k] = *(const LAS bf16x8*)(lds + PG8_SB(b, h) + boff + n * 2048 + k * 1024); } while (0)
#define PG8_MMA(ai, bj, At, Bt) do { __builtin_amdgcn_s_setprio(1); _Pragma("unroll") for (int m = 0; m < 4; ++m) _Pragma("unroll") for (int n = 0; n < 2; ++n) _Pragma("unroll") for (int k = 0; k < 2; ++k) \
        acc[ai][bj][m][n] = __builtin_amdgcn_mfma_f32_16x16x32_bf16(Bt[n][k], At[m][k], acc[ai][bj][m][n], 0, 0, 0); __builtin_amdgcn_s_setprio(0); } while (0)
#define PG8_WAIT_V(n) asm volatile("s_waitcnt vmcnt(" #n ")" ::: "memory")
#define PG8_WAIT_L(n) asm volatile("s_waitcnt lgkmcnt(" #n ")" ::: "memory")
#define PG8_BAR __builtin_amdgcn_s_barrier()
#define PG8_SCHED __builtin_amdgcn_sched_barrier(0)
    int ui = 0;
    Unit cur = S.next(0);
    if (cur.arow < 0) return;
    f32x4 acc[2][2][4][2];
#pragma unroll
    for (int a = 0; a < 2; ++a)
#pragma unroll
        for (int b = 0; b < 2; ++b)
#pragma unroll
            for (int m = 0; m < 4; ++m)
#pragma unroll
                for (int n = 0; n < 2; ++n) acc[a][b][m][n] = (f32x4){0.f, 0.f, 0.f, 0.f};
    bf16x8 At[4][2], B0[2][2], B1[2][2];
    const char* cA = (const char*)g.A + (size_t)cur.arow * g.lda * 2; const char* cB = (const char*)g.Bt + (size_t)cur.brow * g.ldb * 2;
    PG8_STAGE(PG8_SB(0, 0), cB, voffB); PG8_STAGE(PG8_SB(0, 1), cB + hB, voffB); PG8_STAGE(PG8_SA(0, 0), cA, voffA); PG8_STAGE(PG8_SA(0, 1), cA + hA, voffA);
    if (wr == 1) PG8_BAR;
    PG8_WAIT_V(2); PG8_BAR;
    PG8_STAGE(PG8_SB(1, 0), cB + kstep, voffB); PG8_STAGE(PG8_SA(1, 0), cA + kstep, voffA); PG8_STAGE(PG8_SB(1, 1), cB + hB + kstep, voffB);
    PG8_WAIT_V(6); PG8_BAR;
    for (;;) {
        const Unit nxt = S.next(ui + 1);
        const bool has_next = nxt.arow >= 0;
        const char* nA = has_next ? (const char*)g.A + (size_t)nxt.arow * g.lda * 2 : cA; const char* nB = has_next ? (const char*)g.Bt + (size_t)nxt.brow * g.ldb * 2 : cB;
#pragma unroll 1
        for (int t = 0; t < nt; t += 2) {
            const bool last = (t == nt - 2);
            const char* a1 = cA + (size_t)(t + 1) * kstep;
            const char* a2 = last ? nA : cA + (size_t)(t + 2) * kstep; const char* b2 = last ? nB : cB + (size_t)(t + 2) * kstep;
            const char* a3 = a2 + kstep; const char* b3 = b2 + kstep;
            PG8_LDB(B0, 0, 0); PG8_LDB(B1, 0, 1); PG8_SCHED; PG8_LDA(At, 0, 0); PG8_STAGE(PG8_SA(1, 1), a1 + hA, voffA);
            PG8_WAIT_V(8); PG8_WAIT_L(0); PG8_BAR; PG8_MMA(0, 0, At, B0); PG8_MMA(0, 1, At, B1); PG8_BAR; PG8_SCHED;
            PG8_LDA(At, 0, 1); PG8_STAGE(PG8_SB(0, 0), b2, voffB); PG8_STAGE(PG8_SB(0, 1), b2 + hB, voffB); PG8_STAGE(PG8_SA(0, 0), a2, voffA);
            PG8_WAIT_V(8); PG8_WAIT_L(0); PG8_BAR; PG8_MMA(1, 0, At, B0); PG8_MMA(1, 1, At, B1); PG8_BAR; PG8_SCHED;
            PG8_LDB(B0, 1, 0); PG8_LDB(B1, 1, 1); PG8_SCHED; PG8_LDA(At, 1, 0); PG8_STAGE(PG8_SA(0, 1), a2 + hA, voffA);
            PG8_WAIT_V(8); PG8_WAIT_L(0); PG8_BAR; PG8_MMA(0, 0, At, B0); PG8_MMA(0, 1, At, B1); PG8_BAR; PG8_SCHED;
            PG8_LDA(At, 1, 1); PG8_STAGE(PG8_SB(1, 0), b3, voffB); PG8_STAGE(PG8_SB(1, 1), b3 + hB, voffB); PG8_STAGE(PG8_SA(1, 0), a3, voffA);
            PG8_WAIT_V(8); PG8_WAIT_L(0); PG8_BAR; PG8_MMA(1, 0, At, B0); PG8_MMA(1, 1, At, B1); PG8_BAR; PG8_SCHED;
        }
        if constexpr (ALIGN_EPI) { if (wr == 0) PG8_BAR; }
        E(acc, cur, wr, wc, fr, fq);
        if (!has_next) break;
#pragma unroll
        for (int a = 0; a < 2; ++a)
#pragma unroll
            for (int b = 0; b < 2; ++b)
#pragma unroll
                for (int m = 0; m < 4; ++m)
#pragma unroll
                    for (int n = 0; n < 2; ++n) acc[a][b][m][n] = (f32x4){0.f, 0.f, 0.f, 0.f};
        cur = nxt; cA = nA; cB = nB; ++ui;
        if constexpr (ALIGN_EPI) { if (wr == 1) PG8_BAR; }
    }
    PG8_WAIT_V(0);
    if constexpr (!ALIGN_EPI) { if (wr == 0) PG8_BAR; }
    PG8_BAR;
#undef PG8_SA
#undef PG8_SB
#undef PG8_STAGE
#undef PG8_LDA
#undef PG8_LDB
#undef PG8_MMA
#undef PG8_WAIT_V
#undef PG8_WAIT_L
#undef PG8_BAR
#undef PG8_SCHED
}

struct MergeArgs { const bf16_t* YAB; const bf16_t* YCD; const bf16_t* W4T; const bf16_t* G; const float* ssq; bf16_t* MRGB; };
template <class Sched>
DI void gemm_merge_phase(LAS unsigned char* lds, const MergeArgs M, const Sched& S) {
    const int tid = fresh_tid(), wid = __builtin_amdgcn_readfirstlane(tid >> 6), lane = tid & 63, wr = wid >> 2, wc = wid & 3, fr = lane & 15, fq = lane >> 4;
    constexpr int NT = 28, LDB = 1792;
    unsigned vA0[2], vA1[2], voffB[2];
#pragma unroll
    for (int i = 0; i < 2; ++i) { int R, C; stage_rc(tid * 16 + i * 8192, R, C); const int Rb = (R & ~31) + perm32(R & 31);
        vA0[i] = (unsigned)(R * 1024 + C) * 2u; vA1[i] = (unsigned)(R * 768 + C) * 2u; voffB[i] = (unsigned)(Rb * LDB + C) * 2u; }
    const size_t kstep = (size_t)(BK * 2);
    const unsigned ldsw = (unsigned)wid * 1024u;
    const int aoff = lds_byte(wr * 64 + fr, fq * 8), boff = lds_byte(wc * 32 + fr, fq * 8);
#define PG8_SA(b, h) (((b) * 2 + (h)) * HTB)
#define PG8_SB(b, h) ((4 + (b) * 2 + (h)) * HTB)
#define PG8_STAGEB(bufoff, gbase) do { _Pragma("unroll") for (int _i = 0; _i < 2; ++_i) \
        __builtin_amdgcn_global_load_lds((const unsigned*)((const char*)(gbase) + voffB[_i]), (LAS unsigned*)(lds + (bufoff) + ldsw + _i * 8192), 16, 0, 0); } while (0)
#define PG8_STAGEA(bufoff, arow_, tt, hf) do { const bool ab_ = (tt) < 16; \
        const char* gp_ = ab_ ? (const char*)M.YAB + ((size_t)(arow_) + (hf) * HALF) * 2048 + (size_t)(tt) * 128 : (const char*)M.YCD + ((size_t)(arow_) + (hf) * HALF) * 1536 + (size_t)((tt) - 16) * 128; \
        const unsigned o0_ = ab_ ? vA0[0] : vA1[0], o1_ = ab_ ? vA0[1] : vA1[1]; \
        __builtin_amdgcn_global_load_lds((const unsigned*)(gp_ + o0_), (LAS unsigned*)(lds + (bufoff) + ldsw), 16, 0, 0); \
        __builtin_amdgcn_global_load_lds((const unsigned*)(gp_ + o1_), (LAS unsigned*)(lds + (bufoff) + ldsw + 8192), 16, 0, 0); } while (0)
#define PG8_LDA(dst, b, h) do { _Pragma("unroll") for (int m = 0; m < 4; ++m) _Pragma("unroll") for (int k = 0; k < 2; ++k) dst[m][k] = *(const LAS bf16x8*)(lds + PG8_SA(b, h) + aoff + m * 2048 + k * 1024); } while (0)
#define PG8_LDB(dst, b, h) do { _Pragma("unroll") for (int n = 0; n < 2; ++n) _Pragma("unroll") for (int k = 0; k < 2; ++k) dst[n][k] = *(const LAS bf16x8*)(lds + PG8_SB(b, h) + boff + n * 2048 + k * 1024); } while (0)
#define PG8_MMA(ai, At, Bt) do { __builtin_amdgcn_s_setprio(1); _Pragma("unroll") for (int m = 0; m < 4; ++m) _Pragma("unroll") for (int n = 0; n < 2; ++n) _Pragma("unroll") for (int k = 0; k < 2; ++k) \
        acc[ai][0][m][n] = __builtin_amdgcn_mfma_f32_16x16x32_bf16(Bt[n][k], At[m][k], acc[ai][0][m][n], 0, 0, 0); __builtin_amdgcn_s_setprio(0); } while (0)
#define PG8_WAIT_V(n) asm volatile("s_waitcnt vmcnt(" #n ")" ::: "memory")
#define PG8_WAIT_L(n) asm volatile("s_waitcnt lgkmcnt(" #n ")" ::: "memory")
#define PG8_BAR __builtin_amdgcn_s_barrier()
#define PG8_SCHED __builtin_amdgcn_sched_barrier(0)
    int ui = 0;
    Unit cur = S.next(0);
    if (cur.arow < 0) return;
    f32x4 acc[2][2][4][2];
#pragma unroll
    for (int a = 0; a < 2; ++a)
#pragma unroll
        for (int b = 0; b < 2; ++b)
#pragma unroll
            for (int m = 0; m < 4; ++m)
#pragma unroll
                for (int n = 0; n < 2; ++n) acc[a][b][m][n] = (f32x4){0.f, 0.f, 0.f, 0.f};
    bf16x8 At[4][2], B0[2][2];
    const char* cB = (const char*)M.W4T + (size_t)cur.brow * LDB * 2;
    int carow = cur.arow;
    PG8_STAGEB(PG8_SB(0, 0), cB); PG8_STAGEA(PG8_SA(0, 0), carow, 0, 0); PG8_STAGEA(PG8_SA(0, 1), carow, 0, 1);
    if (wr == 1) PG8_BAR;
    PG8_WAIT_V(2); PG8_BAR;
    PG8_STAGEB(PG8_SB(1, 0), cB + kstep); PG8_STAGEA(PG8_SA(1, 0), carow, 1, 0);
    PG8_WAIT_V(4); PG8_BAR;
    for (;;) {
        const Unit nxt = S.next(ui + 1);
        const bool has_next = nxt.arow >= 0;
        const int narow = has_next ? nxt.arow : carow; const char* nB = has_next ? (const char*)M.W4T + (size_t)nxt.brow * LDB * 2 : cB;
#pragma unroll 1
        for (int t = 0; t < NT; t += 2) {
            const bool last = (t == NT - 2);
            const int t2 = last ? 0 : t + 2, t3 = t2 + 1; const int arow2 = last ? narow : carow;
            const char* b2 = last ? nB : cB + (size_t)(t + 2) * kstep; const char* b3 = b2 + kstep;
            PG8_LDB(B0, 0, 0); PG8_SCHED; PG8_LDA(At, 0, 0); PG8_STAGEA(PG8_SA(1, 1), carow, t + 1, 1);
            PG8_WAIT_V(6); PG8_WAIT_L(0); PG8_BAR; PG8_MMA(0, At, B0); PG8_BAR; PG8_SCHED;
            PG8_LDA(At, 0, 1); PG8_STAGEB(PG8_SB(0, 0), b2); PG8_STAGEA(PG8_SA(0, 0), arow2, t2, 0);
            PG8_WAIT_V(6); PG8_WAIT_L(0); PG8_BAR; PG8_MMA(1, At, B0); PG8_BAR; PG8_SCHED;
            PG8_LDB(B0, 1, 0); PG8_SCHED; PG8_LDA(At, 1, 0); PG8_STAGEA(PG8_SA(0, 1), arow2, t2, 1);
            PG8_WAIT_V(6); PG8_WAIT_L(0); PG8_BAR; PG8_MMA(0, At, B0); PG8_BAR; PG8_SCHED;
            PG8_LDA(At, 1, 1); PG8_STAGEB(PG8_SB(1, 0), b3); PG8_STAGEA(PG8_SA(1, 0), arow2, t3, 0);
            PG8_WAIT_V(6); PG8_WAIT_L(0); PG8_BAR; PG8_MMA(1, At, B0); PG8_BAR; PG8_SCHED;
            if (t == 6 || t == 14 || t == 20 || t == 26) {
                const int seg = (t == 6) ? 0 : (t == 14) ? 1 : (t == 20) ? 2 : 3;
                int row0 = cur.arow + wr * 64 + fr, col = cur.pn * 128 + wc * 32 + 8 * fq;
                asm volatile("" : "+v"(row0), "+v"(col));
#pragma unroll
                for (int ai = 0; ai < 2; ++ai) {
                    u32x4 gw[4]; float rs[4];
#pragma unroll
                    for (int m = 0; m < 4; ++m) { const int row = row0 + ai * 128 + m * 16; gw[m] = *(const u32x4*)(M.G + (size_t)row * PG_W + seg * 1024 + col);
                        rs[m] = 1.f; if (seg == 1) { const f32x2 q2 = *(const f32x2*)(M.ssq + 2 * row); rs[m] = (q2[0] + q2[1]) * (1.f / 512.f) + RMS_EPS; } }
#pragma unroll
                    for (int m = 0; m < 4; ++m) { const int row = row0 + ai * 128 + m * 16;
                        const float r1 = (seg == 1) ? 1.0f / sqrtf(rs[m]) : 1.f;
                        float gf[8]; unpack8(gw[m], gf);
#pragma unroll
                        for (int k = 0; k < 4; ++k) { acc[ai][1][m][0][k] += acc[ai][0][m][0][k] * (r1 * sigmoid_f(gf[k])); acc[ai][1][m][1][k] += acc[ai][0][m][1][k] * (r1 * sigmoid_f(gf[4 + k])); }
                        acc[ai][0][m][0] = (f32x4){0.f, 0.f, 0.f, 0.f}; acc[ai][0][m][1] = (f32x4){0.f, 0.f, 0.f, 0.f};
                        if (seg == 3) { const f32x4 v0 = acc[ai][1][m][0], v1 = acc[ai][1][m][1];
                            u32x4 w; w.x = pk2(v0[0], v0[1]); w.y = pk2(v0[2], v0[3]); w.z = pk2(v1[0], v1[1]); w.w = pk2(v1[2], v1[3]);
                            *(u32x4*)(M.MRGB + (size_t)row * 1024 + col) = w;
                            acc[ai][1][m][0] = (f32x4){0.f, 0.f, 0.f, 0.f}; acc[ai][1][m][1] = (f32x4){0.f, 0.f, 0.f, 0.f}; } }
                    __builtin_amdgcn_sched_barrier(0); }
            }
        }
        if (!has_next) break;
        cur = nxt; carow = narow; cB = nB; ++ui;
    }
    PG8_WAIT_V(0);
    if (wr == 0) PG8_BAR;
    PG8_BAR;
#undef PG8_SA
#undef PG8_SB
#undef PG8_STAGEA
#undef PG8_STAGEB
#undef PG8_LDA
#undef PG8_LDB
#undef PG8_MMA
#undef PG8_WAIT_V
#undef PG8_WAIT_L
#undef PG8_BAR
#undef PG8_SCHED
}
}

using pg8::Unit;

struct EpiProj {
    static constexpr bool PERM = true;
    bf16_t* O0; int ld0; int split_pn; bf16_t* O1; int ld1;
    DI void operator()(const f32x4 (&acc)[2][2][4][2], const Unit& u, int wr, int wc, int fr, int fq) const {
        bf16_t* base; int ld, ct;
        if (u.pn < split_pn) { base = O0; ld = ld0; ct = u.pn * 256; } else { base = O1; ld = ld1; ct = (u.pn - split_pn) * 256; }
        const int row0 = u.arow + wr * 64 + fr, col0 = ct + wc * 32 + 8 * fq;
#pragma unroll
        for (int ai = 0; ai < 2; ++ai)
#pragma unroll
            for (int m = 0; m < 4; ++m) { bf16_t* rowp = base + (size_t)(row0 + ai * 128 + m * 16) * ld + col0;
#pragma unroll
                for (int bj = 0; bj < 2; ++bj) { const f32x4 v0 = acc[ai][bj][m][0], v1 = acc[ai][bj][m][1];
                    u32x4 w; w.x = pk2(v0[0], v0[1]); w.y = pk2(v0[2], v0[3]); w.z = pk2(v1[0], v1[1]); w.w = pk2(v1[2], v1[3]);
                    *(u32x4*)(rowp + bj * 128) = w; } }
    }
};

struct EpiWout {
    static constexpr bool PERM = true;
    float* X; const float* modl;
    DI void operator()(const f32x4 (&acc)[2][2][4][2], const Unit& u, int wr, int wc, int fr, int fq) const {
        const int tile = u.arow / 256, b = tile / 9, jj = tile % 9, mrow = (jj == 0) ? 8 : b;
        const int row0 = u.arow + wr * 64 + fr, col0 = u.pn * 256 + wc * 32 + 8 * fq;
        const float* mg = modl + (size_t)mrow * 6144 + 2 * 1024;
#pragma unroll
        for (int bj = 0; bj < 2; ++bj) { const int col = col0 + bj * 128;
            const f32x4 g0 = *(const f32x4*)(mg + col), g1 = *(const f32x4*)(mg + col + 4);
#pragma unroll
            for (int ai = 0; ai < 2; ++ai) { f32x4 x0[4], x1[4];
#pragma unroll
                for (int m = 0; m < 4; ++m) { const float* p = X + (size_t)(row0 + ai * 128 + m * 16) * 1024 + col; x0[m] = *(const f32x4*)p; x1[m] = *(const f32x4*)(p + 4); }
#pragma unroll
                for (int m = 0; m < 4; ++m) { float* p = X + (size_t)(row0 + ai * 128 + m * 16) * 1024 + col;
                    *(f32x4*)p = x0[m] + g0 * acc[ai][bj][m][0]; *(f32x4*)(p + 4) = x1[m] + g1 * acc[ai][bj][m][1]; }
                __builtin_amdgcn_sched_barrier(0); } }
    }
};

struct EpiGlu {
    static constexpr bool PERM = true;
    const bf16_t* YG; bf16_t* YC; const float* bglu;
    DI void operator()(const f32x4 (&acc)[2][2][4][2], const Unit& u, int wr, int wc, int fr, int fq) const {
        const int row0 = u.arow + wr * 64 + fr, col0 = u.pn * 256 + wc * 32 + 8 * fq;
#pragma unroll
        for (int bj = 0; bj < 2; ++bj) { const int col = col0 + bj * 128; if (u.pn == 1 && bj == 1) continue;
            const f32x4 b0 = *(const f32x4*)(bglu + col), b1 = *(const f32x4*)(bglu + col + 4);
#pragma unroll
            for (int ai = 0; ai < 2; ++ai) { u32x4 yw[4];
#pragma unroll
                for (int m = 0; m < 4; ++m) yw[m] = *(const u32x4*)(YG + (size_t)(row0 + ai * 128 + m * 16) * 384 + col);
#pragma unroll
                for (int m = 0; m < 4; ++m) { float y[8]; unpack8(yw[m], y);
                    const f32x4 a0 = acc[ai][bj][m][0] + b0, a1 = acc[ai][bj][m][1] + b1;
                    float o[8];
#pragma unroll
                    for (int k = 0; k < 4; ++k) { o[k] = y[k] * sigmoid_f(a0[k]); o[4 + k] = y[4 + k] * sigmoid_f(a1[k]); }
                    *(u32x4*)(YC + (size_t)(row0 + ai * 128 + m * 16) * 768 + col) = pack8(o); }
                __builtin_amdgcn_sched_barrier(0); } }
    }
};

struct EpiS5S {
    static constexpr bool PERM = true;
    float* S;
    DI void operator()(const f32x4 (&acc)[2][2][4][2], const Unit& u, int wr, int wc, int fr, int fq) const {
        const int m0 = u.pn * 256 + wr * 64 + fr, col0 = wc * 32 + 8 * fq;
#pragma unroll
        for (int ai = 0; ai < 2; ++ai)
#pragma unroll
            for (int m = 0; m < 4; ++m) { const int mm = m0 + ai * 128 + m * 16; if (u.pn == 2 && (ai == 1 || wr == 1)) continue;
                float* p = S + ((size_t)u.pm * 576 + mm) * 256 + col0;
#pragma unroll
                for (int bj = 0; bj < 2; ++bj) { *(f32x4*)(p + bj * 128) = acc[ai][bj][m][0]; *(f32x4*)(p + bj * 128 + 4) = acc[ai][bj][m][1]; } }
    }
};

struct EpiS5Y {
    static constexpr bool PERM = true;
    const bf16_t* AU; bf16_t* YG; const float* dsk;
    DI void operator()(const f32x4 (&acc)[2][2][4][2], const Unit& u, int wr, int wc, int fr, int fq) const {
        const int g = u.pm / 3, j = u.pm % 3;
        const int m0 = j * 256 + wr * 64 + fr, n0 = u.pn * 256 + wc * 32 + 8 * fq;
#pragma unroll
        for (int bj = 0; bj < 2; ++bj) { const int n = n0 + bj * 128, i = n >> 4, a0 = n & 15;
            const f32x4 d0 = *(const f32x4*)(dsk + g * 16 + a0), d1 = *(const f32x4*)(dsk + g * 16 + a0 + 4);
#pragma unroll
            for (int ai = 0; ai < 2; ++ai) { if (j == 2 && (ai == 1 || wr == 1)) continue;
                u32x4 uw[4];
#pragma unroll
                for (int m = 0; m < 4; ++m) uw[m] = *(const u32x4*)(AU + ((size_t)g * 576 + m0 + ai * 128 + m * 16) * 768 + n);
#pragma unroll
                for (int m = 0; m < 4; ++m) { const int mm = m0 + ai * 128 + m * 16; float uu[8]; unpack8(uw[m], uu);
                    const f32x4 v0 = acc[ai][bj][m][0], v1 = acc[ai][bj][m][1];
                    float o[8];
#pragma unroll
                    for (int k = 0; k < 4; ++k) { o[k] = gelu_tanh_f(v0[k] + d0[k] * uu[k]); o[4 + k] = gelu_tanh_f(v1[k] + d1[k] * uu[4 + k]); }
                    *(u32x4*)(YG + (size_t)(mm * 32 + i) * 384 + g * 16 + a0) = pack8(o); }
                __builtin_amdgcn_sched_barrier(0); } }
    }
};

struct EpiUp {
    static constexpr bool PERM = true;
    bf16_t* HID;
    DI void operator()(const f32x4 (&acc)[2][2][4][2], const Unit& u, int wr, int wc, int fr, int fq) const {
        const int row0 = u.arow + wr * 64 + fr, col0 = u.pn * 128 + wc * 32 + 8 * fq;
#pragma unroll
        for (int ai = 0; ai < 2; ++ai)
#pragma unroll
            for (int m = 0; m < 4; ++m) { const f32x4 g0 = acc[ai][0][m][0], g1 = acc[ai][0][m][1], u0 = acc[ai][1][m][0], u1 = acc[ai][1][m][1];
                float o[8];
#pragma unroll
                for (int k = 0; k < 4; ++k) { o[k] = silu_f(g0[k]) * u0[k]; o[4 + k] = silu_f(g1[k]) * u1[k]; }
                *(u32x4*)(HID + (size_t)(row0 + ai * 128 + m * 16) * 1024 + col0) = pack8(o); }
    }
};

struct EpiDown {
    static constexpr bool PERM = true;
    bf16_t* YE; const float* GV;
    DI void operator()(const f32x4 (&acc)[2][2][4][2], const Unit& u, int wr, int wc, int fr, int fq) const {
        const int row0 = u.arow + wr * 64 + fr, col0 = u.pn * 256 + wc * 32 + 8 * fq;
#pragma unroll
        for (int ai = 0; ai < 2; ++ai)
#pragma unroll
            for (int m = 0; m < 4; ++m) { const int row = row0 + ai * 128 + m * 16; const float gv = GV[row];
#pragma unroll
                for (int bj = 0; bj < 2; ++bj) { const f32x4 v0 = acc[ai][bj][m][0] * gv, v1 = acc[ai][bj][m][1] * gv;
                    u32x4 w; w.x = pk2(v0[0], v0[1]); w.y = pk2(v0[2], v0[3]); w.z = pk2(v1[0], v1[1]); w.w = pk2(v1[2], v1[3]);
                    *(u32x4*)(YE + (size_t)row * 1024 + col0 + bj * 128) = w; } }
    }
};

DI Unit mk_unit(int arow, int brow, int pm, int pn) { Unit u; u.arow = arow; u.brow = brow; u.pm = pm; u.pn = pn; return u; }
struct RowSkipOrder {
    int nN, G, c, skipctx, keep_lo, keep_hi, nmain, total, bstep;
    DI void init(int N, int G_, int c_, int skipctx_, int keep_lo_, int keep_hi_, int bstep_ = 256) { bstep = bstep_; nN = N / bstep_; G = G_; c = c_; skipctx = skipctx_; keep_lo = keep_lo_; keep_hi = keep_hi_;
        nmain = (skipctx ? 64 : 72) * nN; total = nmain + (skipctx ? 8 * (keep_hi - keep_lo) : 0); }
    DI Unit next(int i) const {
        const int L0 = i * G + c; if (L0 >= total) return mk_unit(-1, 0, 0, 0);
        const int q = total / 8, r = total % 8, xcd = L0 % 8, off = L0 / 8;
        const int L = (xcd < r ? xcd * (q + 1) : r * (q + 1) + (xcd - r) * q) + off;
        const int nig = 8 * nN, gid = L / nig, rr = L % nig, lt = gid * 8 + (rr % 8);
        const int pm_main = skipctx ? ((lt / 8) * 9 + 1 + (lt % 8)) : lt, pn_main = rr / 8;
        const int Lc = L - nmain, pm_ctx = (Lc % 8) * 9, pn_ctx = keep_lo + Lc / 8;
        const bool main = L < nmain;
        const int pm = main ? pm_main : pm_ctx, pn = main ? pn_main : pn_ctx;
        return mk_unit(pm * 256, pn * bstep, pm, pn);
    }
};
DI int xcd_remap(int L0, int total) { const int q = total / 8, r = total % 8, xcd = L0 % 8, off = L0 / 8; return (xcd < r ? xcd * (q + 1) : r * (q + 1) + (xcd - r) * q) + off; }
struct MergeOrder {
    int G, c, skipctx, total;
    DI void init(int G_, int c_, int skipctx_) { G = G_; c = c_; skipctx = skipctx_; total = (skipctx ? 64 : 72) * 8; }
    DI Unit next(int i) const {
        const int L0 = i * G + c; if (L0 >= total) return mk_unit(-1, 0, 0, 0);
        const int L = xcd_remap(L0, total), lt = L >> 3, pn = L & 7, pm = skipctx ? ((lt / 8) * 9 + 1 + (lt % 8)) : lt;
        return mk_unit(pm * 256, pn * 128, pm, pn);
    }
};
struct OrderS5S { int G, c; DI Unit next(int i) const { const int L = i * G + c; if (L >= 72) return mk_unit(-1, 0, 0, 0); const int g = L / 3, j = L % 3; return mk_unit(g * 576 + j * 256, g * 256, g, j); } };
struct OrderS5Y { int G, c; DI Unit next(int i) const { const int L = i * G + c; if (L >= 144) return mk_unit(-1, 0, 0, 0); const int g = L / 6, r = L % 6, j = r >> 1, nh = r & 1;
    return mk_unit(g * 576 + j * 256, g * 512 + nh * 256, g * 3 + j, nh); } };
struct OrderUp { int G, c, nJ; DI Unit next(int i) const { const int L0 = i * G + c, total = 16 * nJ * 8; if (L0 >= total) return mk_unit(-1, 0, 0, 0); const int L = xcd_remap(L0, total), n = L & 7, t = L >> 3, jt = t % nJ, e = t / nJ;
    return mk_unit(e * EROWS + jt * 256, e * 2048 + n * 256, e, n); } };
struct OrderDown { int G, c, nJ; DI Unit next(int i) const { const int L0 = i * G + c, total = 16 * nJ * 4; if (L0 >= total) return mk_unit(-1, 0, 0, 0); const int L = xcd_remap(L0, total), n = L & 3, t = L >> 2, jt = t % nJ, e = t / nJ;
    return mk_unit(e * EROWS + jt * 256, e * 1024 + n * 256, e, n); } };

struct Frame {
    LAS unsigned char* lds;
    int tid, lane, wave, G, vcu, gw, NGW;
};

template <class DstRow>
DI void tr_item(const float* __restrict__ W, int ldw, int nvalid, int nstore, int K, bf16_t* __restrict__ WT, int k0, int n0, const DstRow& drow, const float* __restrict__ kscale, LAS float* scr  , int lane, int kofs = 0) {
    const int c4 = (lane & 15) * 4, r0 = lane >> 4;
    f32x4 v[16];
#pragma unroll
    for (int i = 0; i < 16; ++i) { const int kk = 4 * i + r0; v[i] = (n0 + c4 < nvalid) ? *(const f32x4*)(W + (size_t)(k0 + kk) * ldw + n0 + c4) : (f32x4){0.f, 0.f, 0.f, 0.f}; }
#pragma unroll
    for (int i = 0; i < 16; ++i) { const int kk = 4 * i + r0; f32x4 x = v[i]; if (kscale) x = x * kscale[k0 + kk];
        LAS float* d = scr + kk * 65 + c4; d[0] = x[0]; d[1] = x[1]; d[2] = x[2]; d[3] = x[3]; }
    LDS_WAIT(); asm volatile("" ::: "memory");
    const int c = lane & 7;
#pragma unroll
    for (int j = 0; j < 8; ++j) { const int n = (lane >> 3) + 8 * j; const LAS float* s = scr + (8 * c) * 65 + n;
        u32x4 o; o.x = pk2(s[0 * 65], s[1 * 65]); o.y = pk2(s[2 * 65], s[3 * 65]); o.z = pk2(s[4 * 65], s[5 * 65]); o.w = pk2(s[6 * 65], s[7 * 65]);
        if (n0 + n < nstore) *(u32x4*)(WT + (size_t)drow(n0 + n) * K + kofs + k0 + 8 * c) = o; }
    LDS_WAIT(); asm volatile("" ::: "memory");
}
struct DrIdent { int off; DI int operator()(int n) const { return off + n; } };
struct DrWin { DI int operator()(int n) const { return n < C_G ? n : n + (PA_W - C_G); } };
struct DrGU { int base; DI int operator()(int f) const { return base + (f >> 7) * 256 + (f & 127); } };

struct LayerIn {
    const float *w_in, *q_norm_g, *k_norm_g, *ssd_conv_w, *ssd_conv_b, *ssd_dt_bias, *ssd_a_log, *ssd_d, *ssd_norm_g;
    const float *s5_lre, *s5_lim, *s5_lstep, *s5_bre, *s5_bim, *s5_cre, *s5_cim, *s5_d, *s5_wglu, *s5_bglu, *sc_conv_w;
    const float *w_br_attn, *w_br_ssd, *w_br_s5, *w_br_sc, *w_out, *w_router, *w_gate, *w_up, *w_down, *norm_mix_g, *norm_ffn_g;
};

DI void prep_small_weights(const Frame& F, const LayerIn& P, unsigned char* ws) {
    LAS float* scr = (LAS float*)(F.lds + F.wave * 16896);
    bf16_t* WIN = (bf16_t*)(ws + W_WIN);
    constexpr int NB_WIN = (NIN + 63) / 64;
    constexpr int I_WIN = 16 * NB_WIN, I_PAD = 62, I_BA = 8 * 16, I_BB = 8 * 16, I_BC = 6 * 16, I_BD = 6 * 16, I_OUT = 16 * 16, I_GLU = 6 * 8;
    constexpr int NIT = I_WIN + I_PAD + I_BA + I_BB + I_BC + I_BD + I_OUT + I_GLU;
    for (int it = F.gw; it < NIT; it += F.NGW) {
        int r = it;
        if (r < I_WIN) { const int kb = r / NB_WIN, nb = r % NB_WIN; tr_item(P.w_in, NIN, NIN, NIN, 1024, WIN, kb * 64, nb * 64, DrWin{}, nullptr, scr, F.lane); continue; } r -= I_WIN;
        if (r < I_PAD) {
#pragma unroll
            for (int j = 0; j < 8; ++j) { const int idx = j * 64 + F.lane, row = C_G + r * 4 + (idx >> 7), ch = idx & 127; *(u32x4*)(WIN + (size_t)row * 1024 + ch * 8) = (u32x4){0u, 0u, 0u, 0u}; }
            continue; } r -= I_PAD;
        if (r < I_BA) { tr_item(P.w_br_attn, 1024, 1024, 1024, 1792, (bf16_t*)(ws + W_BR4), (r / 16) * 64, (r % 16) * 64, DrIdent{0}, nullptr, scr, F.lane, 0); continue; } r -= I_BA;
        if (r < I_BB) { tr_item(P.w_br_ssd, 1024, 1024, 1024, 1792, (bf16_t*)(ws + W_BR4), (r / 16) * 64, (r % 16) * 64, DrIdent{0}, P.ssd_norm_g, scr, F.lane, 512); continue; } r -= I_BB;
        if (r < I_BC) { tr_item(P.w_br_s5, 1024, 1024, 1024, 1792, (bf16_t*)(ws + W_BR4), (r / 16) * 64, (r % 16) * 64, DrIdent{0}, nullptr, scr, F.lane, 1024); continue; } r -= I_BC;
        if (r < I_BD) { tr_item(P.w_br_sc, 1024, 1024, 1024, 1792, (bf16_t*)(ws + W_BR4), (r / 16) * 64, (r % 16) * 64, DrIdent{0}, nullptr, scr, F.lane, 1408); continue; } r -= I_BD;
        if (r < I_OUT) { tr_item(P.w_out, 1024, 1024, 1024, 1024, (bf16_t*)(ws + W_OUT), (r / 16) * 64, (r % 16) * 64, DrIdent{0}, nullptr, scr, F.lane); continue; } r -= I_OUT;
        tr_item(P.s5_wglu, 384, 384, 512, 384, (bf16_t*)(ws + W_GLU), (r / 8) * 64, (r % 8) * 64, DrIdent{0}, nullptr, scr, F.lane);
    }
}
DI void prep_expert_weights(const Frame& F, const LayerIn& P, unsigned char* ws, int first_wg) {
    if ((int)blockIdx.x < first_wg) return;
    LAS float* scr = (LAS float*)(F.lds + F.wave * 16896);
    constexpr int PER = 16 * 16, NIT = 3 * 16 * PER;
    for (int it = ((int)blockIdx.x - first_wg) * NWAVES + F.wave; it < NIT; it += (F.G - first_wg) * NWAVES) {
        const int which = it / (16 * PER), r = it % (16 * PER), e = r / PER, q = r % PER, k0 = (q / 16) * 64, n0 = (q % 16) * 64;
        if (which == 0) tr_item(P.w_gate + (size_t)e * 1024 * 1024, 1024, 1024, 1024, 1024, (bf16_t*)(ws + WS_WGU), k0, n0, DrGU{e * 2048}, nullptr, scr, F.lane);
        else if (which == 1) tr_item(P.w_up + (size_t)e * 1024 * 1024, 1024, 1024, 1024, 1024, (bf16_t*)(ws + WS_WGU), k0, n0, DrGU{e * 2048 + 128}, nullptr, scr, F.lane);
        else tr_item(P.w_down + (size_t)e * 1024 * 1024, 1024, 1024, 1024, 1024, (bf16_t*)(ws + WS_WD), k0, n0, DrIdent{e * 1024}, nullptr, scr, F.lane);
    }
}

DI void prep_mod(const Frame& F, const float* __restrict__ c, const float* __restrict__ c_ctx, const float* __restrict__ w_mod, const float* __restrict__ b_mod, float* __restrict__ MOD) {
    if ((int)blockIdx.x >= 2 * 96) return;
    LAS float* sc = (LAS float*)F.lds;
    LAS float* red = sc + 9 * 1024;
    for (int o = F.tid; o < 9 * 1024; o += 512) { const float cv = (o < 8 * 1024) ? c[o] : c_ctx[o - 8 * 1024]; sc[o] = silu_f(cv); }
    __syncthreads();
    for (int it = blockIdx.x; it < 2 * 96; it += F.G) {
        const int l = it / 96, cb = it % 96, n = cb * 64 + F.lane;
        const float* W = w_mod + (size_t)l * 1024 * 6144;
        float acc[9];
#pragma unroll
        for (int r = 0; r < 9; ++r) acc[r] = 0.f;
        const int kbeg = F.wave * 128;
#pragma unroll 1
        for (int k8 = 0; k8 < 128; k8 += 16) { float w[16];
#pragma unroll
            for (int j = 0; j < 16; ++j) w[j] = W[(size_t)(kbeg + k8 + j) * 6144 + n];
#pragma unroll
            for (int j = 0; j < 16; ++j)
#pragma unroll
                for (int r = 0; r < 9; ++r) acc[r] += sc[r * 1024 + kbeg + k8 + j] * w[j]; }
#pragma unroll
        for (int r = 0; r < 9; ++r) red[(F.wave * 9 + r) * 64 + F.lane] = acc[r];
        __syncthreads();
        for (int o = F.tid; o < 9 * 64; o += 512) { const int r = o >> 6, ln = o & 63; float s = 0.f;
#pragma unroll
            for (int w = 0; w < 8; ++w) s += red[(w * 9 + r) * 64 + ln];
            MOD[((size_t)l * 9 + r) * 6144 + cb * 64 + ln] = s + b_mod[l * 6144 + cb * 64 + ln]; }
        __syncthreads();
    }
    __syncthreads();
}
DI void prep_rope(const Frame& F, float* ROPE) {
    for (int idx = blockIdx.x * 512 + F.tid; idx < 2048 * 32; idx += F.G * 512) {
        const int t = idx >> 5, j = idx & 31, i = j & 15;
        const float inv = powf(10000.f, -(float)(2 * i) / 32.f);
        const float pos = (j < 16) ? (float)(t >> 6) : (float)(t & 63);
        const float a = pos * inv;
        ROPE[t * 64 + j] = cosf(a); ROPE[t * 64 + 32 + j] = sinf(a);
    }
}

DI void prep_s5(const Frame& F, const LayerIn& P, unsigned char* ws) {
    if ((int)blockIdx.x >= 24) return;
    LAS float* pw = (LAS float*)F.lds;
    LAS float* bb = pw + 8448;
    LAS float* Kt = bb + 4096;
    LAS float* cc = Kt + 16896;
    for (int g = blockIdx.x; g < 24; g += F.G) {
        for (int o = F.tid; o < 2048; o += 512) cc[o] = (o < 1024) ? P.s5_cre[(size_t)g * 1024 + o] : P.s5_cim[(size_t)g * 1024 + o - 1024];
        if (F.tid < 128) { const int d = F.tid >> 6, p = F.tid & 63;
            const float step = __expf(P.s5_lstep[d * 24 + g]);
            const float lr = P.s5_lre[(d * 24 + g) * 64 + p], li = P.s5_lim[(d * 24 + g) * 64 + p];
            const float th = li * step, sh = sinf(0.5f * th);
            const float mag = expf(lr * step), abi = mag * sinf(th);
            const float nr = expm1f(lr * step) - 2.f * mag * sh * sh, ni = abi;
            const float den = lr * lr + li * li;
            const float cr = (nr * lr + ni * li) / den, ci = (ni * lr - nr * li) / den;
            for (int j = 0; j < 16; ++j) { const float br = P.s5_bre[((size_t)g * 64 + p) * 16 + j], bi = P.s5_bim[((size_t)g * 64 + p) * 16 + j];
                bb[((d * 64 + p) * 16 + j) * 2 + 0] = cr * br - ci * bi; bb[((d * 64 + p) * 16 + j) * 2 + 1] = cr * bi + ci * br; } }
        for (int o = F.tid; o < 2 * 64 * 33; o += 512) { const int dp = o / 33, tau = o % 33, d = dp >> 6, p = dp & 63;
            const float step = __expf(P.s5_lstep[d * 24 + g]);
            const float lr = P.s5_lre[(d * 24 + g) * 64 + p], li = P.s5_lim[(d * 24 + g) * 64 + p];
            const float m = expf(lr * step * (float)tau), a = li * step * (float)tau;
            pw[o * 2 + 0] = m * cosf(a); pw[o * 2 + 1] = m * sinf(a); }
        __syncthreads();
        for (int o = F.tid; o < 1024; o += 512) { const int d = o >> 9, a = (o >> 5) & 15, tau = o & 31; float s[16];
#pragma unroll
            for (int b_ = 0; b_ < 16; ++b_) s[b_] = 0.f;
            for (int p = 0; p < 64; ++p) { const float cre = cc[a * 64 + p], cim = cc[1024 + a * 64 + p];
                const f32x2 lp = *(const LAS f32x2*)(pw + ((d * 64 + p) * 33 + tau) * 2);
                const float wr_ = cre * lp[0] - cim * lp[1], wi_ = cre * lp[1] + cim * lp[0];
                const LAS f32x4* bp = (const LAS f32x4*)(bb + (d * 64 + p) * 32);
#pragma unroll
                for (int q4 = 0; q4 < 8; ++q4) { const f32x4 t = bp[q4]; s[2 * q4] += wr_ * t[0] - wi_ * t[1]; s[2 * q4 + 1] += wr_ * t[2] - wi_ * t[3]; } }
#pragma unroll
            for (int b_ = 0; b_ < 16; ++b_) Kt[((d * 16 + a) * 16 + b_) * 33 + tau] = s[b_]; }
        __syncthreads();
        bf16_t* TQ = (bf16_t*)(ws + W_TQ) + (size_t)g * 512 * 768;
        for (int o = F.tid; o < 512 * 64; o += 512) { const int row = o >> 6, ch = o & 63, i = row >> 4, a = row & 15, b0 = (ch >> 5) * 8, j = ch & 31; float v[8];
#pragma unroll
            for (int k = 0; k < 8; ++k) { float s = 0.f;
                if (j <= i) s += Kt[((0 * 16 + a) * 16 + b0 + k) * 33 + (i - j)];
                if (j >= i) s += Kt[((1 * 16 + a) * 16 + b0 + k) * 33 + (j - i)];
                v[k] = s; }
            *(u32x4*)(TQ + (size_t)row * 768 + j * 16 + b0) = pack8(v); }
        for (int o = F.tid; o < 512 * 128; o += 512) { const int row = o >> 7, dp = o & 127, d = dp >> 6, p = dp & 63, i = row >> 4, a = row & 15; const int tau = d == 0 ? (i + 1) : (32 - i);
            const float cre = cc[a * 64 + p], cim = cc[1024 + a * 64 + p];
            const f32x2 lp = *(const LAS f32x2*)(pw + ((d * 64 + p) * 33 + tau) * 2);
            TQ[(size_t)row * 768 + 512 + d * 128 + p] = (bf16_t)f2bf(cre * lp[0] - cim * lp[1]);
            TQ[(size_t)row * 768 + 512 + d * 128 + 64 + p] = (bf16_t)f2bf(-(cre * lp[1] + cim * lp[0])); }
        bf16_t* PP = (bf16_t*)(ws + W_P) + (size_t)g * 256 * 512;
        for (int o = F.tid; o < 2 * 64 * 32; o += 512) { const int d = o >> 11, p = (o >> 5) & 63, j = o & 31; const int tau = d == 0 ? (31 - j) : j;
            const f32x2 lp = *(const LAS f32x2*)(pw + ((d * 64 + p) * 33 + tau) * 2);
            const LAS f32x4* bp = (const LAS f32x4*)(bb + (d * 64 + p) * 32);
            float vr[16], vi[16];
#pragma unroll
            for (int q4 = 0; q4 < 8; ++q4) { const f32x4 t = bp[q4];
                vr[2 * q4] = lp[0] * t[0] - lp[1] * t[1]; vi[2 * q4] = lp[0] * t[1] + lp[1] * t[0];
                vr[2 * q4 + 1] = lp[0] * t[2] - lp[1] * t[3]; vi[2 * q4 + 1] = lp[0] * t[3] + lp[1] * t[2]; }
            float h0[8], h1[8];
#pragma unroll
            for (int k = 0; k < 8; ++k) { h0[k] = vr[k]; h1[k] = vr[8 + k]; }
            bf16_t* pr = PP + (size_t)(d * 128 + p) * 512 + j * 16;
            *(u32x4*)pr = pack8(h0); *(u32x4*)(pr + 8) = pack8(h1);
#pragma unroll
            for (int k = 0; k < 8; ++k) { h0[k] = vi[k]; h1[k] = vi[8 + k]; }
            bf16_t* pi = PP + (size_t)(d * 128 + 64 + p) * 512 + j * 16;
            *(u32x4*)pi = pack8(h0); *(u32x4*)(pi + 8) = pack8(h1); }
        __syncthreads();
    }
}

struct RowCtx { int R, b, p, isctx, mrow; };
DI RowCtx row_ctx(int R) { RowCtx r; r.R = R; r.b = R / PB; r.p = R - r.b * PB; r.isctx = r.p < CTXL; r.mrow = r.isctx ? 8 : r.b; return r; }

DI void moe_combine(const Frame& F, const RowCtx& rc, f32x4 (&x)[4], const int* INV, const bf16_t* YE, const float* mod_prev  ) {
    const int myinv = (F.lane < 16) ? INV[(size_t)rc.R * 16 + F.lane] : -1;
    f32x4 s[4];
#pragma unroll
    for (int j = 0; j < 4; ++j) s[j] = (f32x4){0.f, 0.f, 0.f, 0.f};
    for (int e = 0; e < 16; ++e) { const int er = __shfl(myinv, e);
        if (er >= 0) { const bf16_t* yr = YE + (size_t)er * 1024 + 4 * F.lane;
#pragma unroll
            for (int j = 0; j < 4; ++j) { const u32x2 w = *(const u32x2*)(yr + j * 256); s[j][0] += bflo(w.x); s[j][1] += bfhi(w.x); s[j][2] += bflo(w.y); s[j][3] += bfhi(w.y); } } }
    const float* g5 = mod_prev + (size_t)rc.mrow * 6144 + 5 * 1024 + 4 * F.lane;
#pragma unroll
    for (int j = 0; j < 4; ++j) x[j] += *(const f32x4*)(g5 + j * 256) * s[j];
}
DI float row_rstd(const f32x4 (&x)[4]) {
    float ss = 0.f;
#pragma unroll
    for (int j = 0; j < 4; ++j) ss += (x[j][0] * x[j][0] + x[j][1] * x[j][1]) + (x[j][2] * x[j][2] + x[j][3] * x[j][3]);
    return 1.0f / sqrtf(wave_sum(ss) * (1.f / 1024.f) + RMS_EPS);
}
DI void row_modulate(const Frame& F, const f32x4 (&x)[4], float rstd, const float* g, const float* shift, const float* scale, f32x4 (&h)[4]) {
#pragma unroll
    for (int j = 0; j < 4; ++j) { const int c = j * 256 + 4 * F.lane; const f32x4 gv = *(const f32x4*)(g + c), sh = *(const f32x4*)(shift + c), sc = *(const f32x4*)(scale + c);
        h[j] = x[j] * rstd * gv * (sc + 1.0f) + sh; }
}
DI void row_store_bf16(const Frame& F, const f32x4 (&h)[4], bf16_t* dst) {
#pragma unroll
    for (int j = 0; j < 4; ++j) { u32x2 w; w.x = pk2(h[j][0], h[j][1]); w.y = pk2(h[j][2], h[j][3]); *(u32x2*)(dst + j * 256 + 4 * F.lane) = w; }
}

DI void phase_norm1(const Frame& F, int layer, const float* x_in, const float* ctx_in, float* X, bf16_t* H1, const float* MOD, const float* gmix, const int* INV, const bf16_t* YE) {
    const float* modl = MOD + (size_t)layer * 9 * 6144;
    for (int R = F.gw; R < MROWS; R += F.NGW) {
        const RowCtx rc = row_ctx(R);
        const float* src = (layer == 0) ? (rc.isctx ? ctx_in + ((size_t)rc.b * CTXL + rc.p) * 1024 : x_in + ((size_t)rc.b * SEQ + (rc.p - CTXL)) * 1024) : X + (size_t)R * 1024;
        f32x4 x[4];
#pragma unroll
        for (int j = 0; j < 4; ++j) x[j] = *(const f32x4*)(src + j * 256 + 4 * F.lane);
        if (layer > 0) moe_combine(F, rc, x, INV, YE, MOD + (size_t)(layer - 1) * 9 * 6144);
#pragma unroll
        for (int j = 0; j < 4; ++j) *(f32x4*)(X + (size_t)R * 1024 + j * 256 + 4 * F.lane) = x[j];
        const float rstd = row_rstd(x);
        f32x4 h[4]; row_modulate(F, x, rstd, gmix, modl + (size_t)rc.mrow * 6144, modl + (size_t)rc.mrow * 6144 + 1024, h);
        row_store_bf16(F, h, H1 + (size_t)R * 1024);
    }
}
DI void phase_final(const Frame& F, const float* X, float* out, const float* MOD, const float* gfin, const int* INV, const bf16_t* YE) {
    for (int q = F.gw; q < NB * SEQ; q += F.NGW) {
        const int b = q / SEQ, t = q - b * SEQ, R = b * PB + CTXL + t;
        const RowCtx rc = row_ctx(R);
        f32x4 x[4];
#pragma unroll
        for (int j = 0; j < 4; ++j) x[j] = *(const f32x4*)(X + (size_t)R * 1024 + j * 256 + 4 * F.lane);
        moe_combine(F, rc, x, INV, YE, MOD + (size_t)1 * 9 * 6144);
        const float rstd = row_rstd(x);
#pragma unroll
        for (int j = 0; j < 4; ++j) { const int c = j * 256 + 4 * F.lane; *(f32x4*)(out + (size_t)q * 1024 + c) = x[j] * rstd * *(const f32x4*)(gfin + c); }
    }
}

DI void phase_norm2(const Frame& F, int layer, bool skipctx, const float* X, bf16_t* H2, const float* MOD, const float* gffn, const float* w_router, float* AFF) {
    LAS float* wl = (LAS float*)F.lds;
    for (int idx = F.tid; idx < 16384; idx += 512) wl[(idx & 15) * 1024 + (idx >> 4)] = w_router[idx];
    __syncthreads();
    const float* modl = MOD + (size_t)layer * 9 * 6144;
    for (int R = F.gw; R < MROWS; R += F.NGW) {
        const RowCtx rc = row_ctx(R);
        if (skipctx && rc.isctx) continue;
        f32x4 x[4];
#pragma unroll
        for (int j = 0; j < 4; ++j) x[j] = *(const f32x4*)(X + (size_t)R * 1024 + j * 256 + 4 * F.lane);
        const float rstd = row_rstd(x);
        f32x4 h[4]; row_modulate(F, x, rstd, gffn, modl + (size_t)rc.mrow * 6144 + 3 * 1024, modl + (size_t)rc.mrow * 6144 + 4 * 1024, h);
        row_store_bf16(F, h, H2 + (size_t)R * 1024);
        float lg[16];
#pragma unroll
        for (int e = 0; e < 16; ++e) { float s = 0.f;
#pragma unroll
            for (int j = 0; j < 4; ++j) { const f32x4 w = *(const LAS f32x4*)(wl + e * 1024 + j * 256 + 4 * F.lane); s += (h[j][0] * w[0] + h[j][1] * w[1]) + (h[j][2] * w[2] + h[j][3] * w[3]); }
            lg[e] = wave_sum(s); }
        float mx = lg[0];
#pragma unroll
        for (int e = 1; e < 16; ++e) mx = fmaxf(mx, lg[e]);
        float den = 0.f, mine = 0.f;
#pragma unroll
        for (int e = 0; e < 16; ++e) { const float ex = expf(lg[e] - mx); den += ex; mine = (F.lane == e) ? ex : mine; }
        if (F.lane < 16) AFF[((size_t)rc.b * 16 + F.lane) * PB + rc.p] = mine / den;
    }
    __syncthreads();
}

DI int block_exscan(const Frame& F, int v, LAS int* wtot, int& total) {
    int incl = v;
#pragma unroll
    for (int o = 1; o < 64; o <<= 1) { const int t = __shfl_up(incl, o); if (F.lane >= o) incl += t; }
    if (F.lane == 63) wtot[F.wave] = incl;
    __syncthreads();
    int base = 0; total = 0;
#pragma unroll
    for (int w = 0; w < 8; ++w) { const int x = wtot[w]; if (w < F.wave) base += x; total += x; }
    __syncthreads();
    return base + incl - v;
}
DI void phase_topk(const Frame& F, int nitems, const float* AFF, int* SRC, float* GV, int* INV) {
    LAS int* wcnt = (LAS int*)F.lds;
    LAS int* wtot = wcnt + 16;
    for (int it = blockIdx.x; it < nitems; it += F.G) {
        const int isctx = it >= 128, be = it & 127, b = be >> 4, e = be & 15;
        const int n = isctx ? CTXL : SEQ, cap = isctx ? 32 : 256, p0 = isctx ? 0 : CTXL;
        const float* a = AFF + ((size_t)b * 16 + e) * PB + p0;
        unsigned v[4]; float av[4];
#pragma unroll
        for (int k = 0; k < 4; ++k) { const int idx = 4 * F.tid + k; av[k] = idx < n ? a[idx] : 0.f; v[k] = __builtin_bit_cast(unsigned, av[k]); }
        unsigned prefix = 0u;
        for (int bit = 30; bit >= 0; --bit) {
            const unsigned cand = prefix | (1u << bit);
            int c = 0;
#pragma unroll
            for (int k = 0; k < 4; ++k) c += __popcll(__ballot(v[k] >= cand));
            LAS int* wc = wcnt + (bit & 1) * 8;
            if (F.lane == 0) wc[F.wave] = c;
            __syncthreads();
            int tot = 0;
#pragma unroll
            for (int w = 0; w < 8; ++w) tot += wc[w];
            if (tot >= cap) prefix = cand;
        }
        __syncthreads();
        int ngt_t = 0, neq_t = 0;
#pragma unroll
        for (int k = 0; k < 4; ++k) { ngt_t += (v[k] > prefix) ? 1 : 0; neq_t += (v[k] == prefix) ? 1 : 0; }
        int ngt_total, neq_total;
        (void)block_exscan(F, ngt_t, wtot, ngt_total);
        int eq_rank = block_exscan(F, neq_t, wtot, neq_total);
        const int eq_take = cap - ngt_total;
        int sel[4], nsel_t = 0;
#pragma unroll
        for (int k = 0; k < 4; ++k) { int s = 0; if (v[k] > prefix) s = 1; else if (v[k] == prefix) { s = (eq_rank < eq_take) ? 1 : 0; ++eq_rank; } sel[k] = s; nsel_t += s; }
        int nsel_total;
        int slot = block_exscan(F, nsel_t, wtot, nsel_total);
        const int ebase = e * EROWS + (isctx ? 2048 + b * 32 : b * 256);
#pragma unroll
        for (int k = 0; k < 4; ++k) { const int idx = 4 * F.tid + k;
            if (idx < n) { const int R = b * PB + p0 + idx;
                if (sel[k]) { const int er = ebase + slot; ++slot; SRC[er] = R; GV[er] = av[k]; INV[(size_t)R * 16 + e] = er; }
                else INV[(size_t)R * 16 + e] = -1; } }
        __syncthreads();
    }
}
DI void phase_gather(const Frame& F, int rows_per_expert, const int* __restrict__ SRC, const bf16_t* __restrict__ H2, bf16_t* __restrict__ XG) {
    const int total = 16 * rows_per_expert;
    for (int q = F.gw * 4; q < total; q += F.NGW * 4) {
        const int e = q / rows_per_expert, s = q - e * rows_per_expert, er = e * EROWS + s;
        int R[4];
#pragma unroll
        for (int u = 0; u < 4; ++u) R[u] = SRC[er + u];
        u32x4 v0[4], v1[4];
#pragma unroll
        for (int u = 0; u < 4; ++u) { v0[u] = *(const u32x4*)(H2 + (size_t)R[u] * 1024 + 8 * F.lane); v1[u] = *(const u32x4*)(H2 + (size_t)R[u] * 1024 + 512 + 8 * F.lane); }
#pragma unroll
        for (int u = 0; u < 4; ++u) { *(u32x4*)(XG + (size_t)(er + u) * 1024 + 8 * F.lane) = v0[u]; *(u32x4*)(XG + (size_t)(er + u) * 1024 + 512 + 8 * F.lane) = v1[u]; }
    }
}

DI void qk_norm_rope(const float (&vin)[8], int ll, const float* __restrict__ gn, bool rope, const float* __restrict__ cs, float (&o)[8]) {
    float v[8]; float ss = 0.f;
#pragma unroll
    for (int k = 0; k < 8; ++k) ss += vin[k] * vin[k];
    ss += __shfl_xor(ss, 1); ss += __shfl_xor(ss, 2); ss += __shfl_xor(ss, 4);
    const float rstd = 1.0f / sqrtf(ss * (1.f / 64.f) + RMS_EPS);
#pragma unroll
    for (int k = 0; k < 8; ++k) v[k] = vin[k] * rstd * gn[k];
    const bool isx2 = (ll & 2) != 0;
#pragma unroll
    for (int k = 0; k < 8; ++k) { const float pv = __shfl_xor(v[k], 2); const float c = rope ? cs[k] : 1.f, s = rope ? cs[32 + k] : 0.f; o[k] = isx2 ? (v[k] * c + pv * s) : (v[k] * c - pv * s); }
}
DI void phase_elem(const Frame& F, const LayerIn& P, const bf16_t* __restrict__ PA, const float* __restrict__ ROPE, bf16_t* __restrict__ QN, bf16_t* __restrict__ KN, bf16_t* __restrict__ XBC,
                   float* __restrict__ DT, bf16_t* __restrict__ AU, bf16_t* __restrict__ YCD) {
    const int l = F.lane;
    for (int R0 = F.gw * 4; R0 < MROWS; R0 += F.NGW * 4) {
        const RowCtx rc = row_ctx(R0);
        const bf16_t* pr = PA + (size_t)R0 * PA_W;
        const bool has_prev = (rc.p != 0) && (rc.p != CTXL), has_next = (rc.p + 3 != CTXL - 1) && (rc.p + 3 != PB - 1);
        const bool rope = !rc.isctx; const int t0 = rope ? rc.p - CTXL : 0;
        { const int hb = (l & 7) >> 2, i0 = (l & 1) * 8; const float* gn = P.q_norm_g + (l & 7) * 8;
#pragma unroll
          for (int h2 = 0; h2 < 2; ++h2) { u32x4 w[2];
#pragma unroll
            for (int u = 0; u < 2; ++u) w[u] = *(const u32x4*)(pr + (size_t)(2 * h2 + u) * PA_W + C_Q + l * 8);
#pragma unroll
            for (int u = 0; u < 2; ++u) { float v[8], o[8]; unpack8(w[u], v);
                qk_norm_rope(v, l, gn, rope, ROPE + (size_t)(t0 + 2 * h2 + u) * 64 + hb * 16 + i0, o);
#pragma unroll
                for (int k = 0; k < 8; ++k) o[k] *= ATT_C2;
                *(u32x4*)(QN + (size_t)(R0 + 2 * h2 + u) * 512 + l * 8) = pack8(o); } } }
        { const int u = l >> 4, ll = l & 15, hb = (ll & 7) >> 2, i0 = (ll & 1) * 8;
          float v[8], o[8]; unpack8(*(const u32x4*)(pr + (size_t)u * PA_W + C_K + ll * 8), v);
          qk_norm_rope(v, ll, P.k_norm_g + (ll & 7) * 8, rope, ROPE + (size_t)(t0 + u) * 64 + hb * 16 + i0, o);
          *(u32x4*)(KN + (size_t)(R0 + u) * 128 + ll * 8) = pack8(o); }
#pragma unroll
        for (int pass = 0; pass < 2; ++pass) { const int ch8 = pass * 64 + l; if (ch8 >= 96) continue;
            const int ch = ch8 * 8; u32x4 w[6];
#pragma unroll
            for (int u = 0; u < 6; ++u) { const bool ok = (u == 0) ? has_prev : (u == 5) ? has_next : true;
                w[u] = ok ? *(const u32x4*)(pr + (ptrdiff_t)(u - 1) * PA_W + C_XBC + ch) : (u32x4){0u, 0u, 0u, 0u}; }
            float w0[8], w1[8], w2[8], bs[8];
#pragma unroll
            for (int k = 0; k < 8; ++k) { w0[k] = P.ssd_conv_w[ch + k]; w1[k] = P.ssd_conv_w[768 + ch + k]; w2[k] = P.ssd_conv_w[1536 + ch + k]; bs[k] = P.ssd_conv_b[ch + k]; }
            float a[8], b[8], c[8]; unpack8(w[0], a); unpack8(w[1], b);
#pragma unroll
            for (int u = 0; u < 4; ++u) { unpack8(w[u + 2], c); float o[8];
#pragma unroll
                for (int k = 0; k < 8; ++k) { o[k] = silu_f(w0[k] * a[k] + w1[k] * b[k] + w2[k] * c[k] + bs[k]); a[k] = b[k]; b[k] = c[k]; }
                *(u32x4*)(XBC + (size_t)(R0 + u) * 768 + ch) = pack8(o); } }
        { const int u = l >> 4, d = (l >> 3) & 1, h = l & 7; DT[((size_t)d * MROWS + R0 + u) * 8 + h] = softplus_f(bf2f(pr[(size_t)u * PA_W + C_DT + h]) + P.ssd_dt_bias[d * 8 + h]); }
        if (l < 48) {
            const int g = l >> 1, a0 = (l & 1) * 8, ch = l * 8;
            u32x4 uw[4], sb[4], sg[6], sh[6];
#pragma unroll
            for (int u = 0; u < 4; ++u) { uw[u] = *(const u32x4*)(pr + (size_t)u * PA_W + C_U + ch); sb[u] = *(const u32x4*)(pr + (size_t)u * PA_W + C_SB + ch); }
#pragma unroll
            for (int u = 0; u < 6; ++u) { const bool ok = (u == 0) ? has_prev : (u == 5) ? has_next : true;
                sg[u] = ok ? *(const u32x4*)(pr + (ptrdiff_t)(u - 1) * PA_W + C_SG + ch) : (u32x4){0u, 0u, 0u, 0u};
                sh[u] = ok ? *(const u32x4*)(pr + (ptrdiff_t)(u - 1) * PA_W + C_SH + ch) : (u32x4){0u, 0u, 0u, 0u}; }
#pragma unroll
            for (int u = 0; u < 4; ++u) *(u32x4*)(AU + ((size_t)g * 576 + ((R0 + u) >> 5)) * 768 + ((R0 + u) & 31) * 16 + a0) = uw[u];
            float w0[8], w1[8], w2[8];
#pragma unroll
            for (int k = 0; k < 8; ++k) { w0[k] = P.sc_conv_w[ch + k]; w1[k] = P.sc_conv_w[384 + ch + k]; w2[k] = P.sc_conv_w[768 + ch + k]; }
            float a[8], b[8], c[8], x[8], y[8];
            unpack8(sg[0], x); unpack8(sh[0], y);
#pragma unroll
            for (int k = 0; k < 8; ++k) a[k] = x[k] * y[k];
            unpack8(sg[1], x); unpack8(sh[1], y);
#pragma unroll
            for (int k = 0; k < 8; ++k) b[k] = x[k] * y[k];
#pragma unroll
            for (int u = 0; u < 4; ++u) { unpack8(sg[u + 2], x); unpack8(sh[u + 2], y); float s[8], o[8]; unpack8(sb[u], s);
#pragma unroll
                for (int k = 0; k < 8; ++k) { c[k] = x[k] * y[k]; o[k] = s[k] * (w0[k] * a[k] + w1[k] * b[k] + w2[k] * c[k]); a[k] = b[k]; b[k] = c[k]; }
                *(u32x4*)(YCD + (size_t)(R0 + u) * 768 + 384 + ch) = pack8(o); }
        }
    }
}

typedef short v4i16_t __attribute__((ext_vector_type(4)));
DI int img_off(int row, int chunk) { return row * 128 + ((chunk ^ (row & 7)) << 4); }
DI s16x4 tr_read4(const LAS unsigned char* p) { return __builtin_bit_cast(s16x4, __builtin_amdgcn_ds_read_tr16_b64_v4i16((LAS v4i16_t*)p)); }
DI bf16x8 cat8(s16x4 lo, s16x4 hi) { return (bf16x8){lo[0], lo[1], lo[2], lo[3], hi[0], hi[1], hi[2], hi[3]}; }
DI unsigned cvtpk(float lo, float hi) { typedef __bf16 bf2 __attribute__((ext_vector_type(2))); f32x2 v = {lo, hi}; bf2 b = __builtin_convertvector(v, bf2); return __builtin_bit_cast(unsigned, b); }
#define MFMA32(a, b, c) __builtin_amdgcn_mfma_f32_32x32x16_bf16((a), (b), (c), 0, 0, 0)
DI int crow(int r, int hh) { return (r & 3) + 8 * (r >> 2) + 4 * hh; }

constexpr int SSD_XH = 0, SSD_BM = 65536, SSD_CM = 81920, SSD_ARR = 131072;
DI void ssd_load_images(const Frame& F, const bf16_t* XBC, int R0, int g, bool with_c) {
#pragma unroll
    for (int it = 0; it < 8; ++it) { const int idx = it * 512 + F.tid, h4 = idx >> 10, row = (idx >> 3) & 127, ch = idx & 7;
        *(LAS u32x4*)(F.lds + SSD_XH + h4 * 16384 + img_off(row, ch)) = *(const u32x4*)(XBC + (size_t)(R0 + row) * 768 + g * 256 + h4 * 64 + ch * 8); }
#pragma unroll
    for (int it = 0; it < 2; ++it) { const int idx = it * 512 + F.tid, row = idx >> 3, ch = idx & 7;
        *(LAS u32x4*)(F.lds + SSD_BM + img_off(row, ch)) = *(const u32x4*)(XBC + (size_t)(R0 + row) * 768 + 512 + g * 64 + ch * 8);
        if (with_c) *(LAS u32x4*)(F.lds + SSD_CM + img_off(row, ch)) = *(const u32x4*)(XBC + (size_t)(R0 + row) * 768 + 640 + g * 64 + ch * 8); }
}
struct Series { float dt0, dt1, cs0, cs1, ecs0, ecs1, tot; };
DI Series ssd_series(const Frame& F, const float* DT, const float* a_log, int R0, int h, int d) {
    Series s; const float a = -__expf(a_log[d * 8 + h]);
    s.dt0 = DT[((size_t)d * MROWS + R0 + 2 * F.lane) * 8 + h]; s.dt1 = DT[((size_t)d * MROWS + R0 + 2 * F.lane + 1) * 8 + h];
    const float ad0 = s.dt0 * a, ad1 = s.dt1 * a, pair = ad0 + ad1; float incl = pair;
#pragma unroll
    for (int o = 1; o < 64; o <<= 1) { const float t = __shfl_up(incl, o); if (F.lane >= o) incl += t; }
    const float excl = incl - pair;
    s.cs0 = excl + ad0; s.cs1 = incl; s.ecs0 = excl; s.ecs1 = excl + ad0; s.tot = __shfl(incl, 63);
    return s;
}

DI void ssd_chunk_states(const Frame& F, const LayerIn& P, const bf16_t* XBC, const float* DT, float* S, float* TOT) {
    LAS float* W = (LAS float*)(F.lds + SSD_ARR);
    const int lane = F.lane, hh = lane >> 5, q = (lane & 15) >> 2, pp = lane & 3, blk = (lane >> 4) & 1;
    const int h4 = F.wave & 3, d = F.wave >> 2;
    for (int it = blockIdx.x; it < 288; it += F.G) {
        const int b = it / 36, r = it % 36, c = r >> 1, g = r & 1, R0 = b * PB + c * 128, h = 4 * g + h4;
        ssd_load_images(F, XBC, R0, g, false);
        const Series s = ssd_series(F, DT, P.ssd_a_log, R0, h, d);
        float w0, w1;
        if (d == 0) { w0 = s.dt0 * __expf(s.tot - s.cs0); w1 = s.dt1 * __expf(s.tot - s.cs1); } else { w0 = s.dt0 * __expf(s.ecs0); w1 = s.dt1 * __expf(s.ecs1); }
        *(LAS f32x2*)(W + F.wave * 128 + 2 * lane) = (f32x2){w0, w1};
        if (lane == 0) TOT[(((size_t)b * 18 + c) * 8 + h) * 2 + d] = s.tot;
        __syncthreads();
        f32x16 acc[2][2];
#pragma unroll
        for (int i = 0; i < 2; ++i)
#pragma unroll
            for (int j = 0; j < 2; ++j)
#pragma unroll
                for (int k = 0; k < 16; ++k) acc[i][j][k] = 0.f;
        const LAS unsigned char* xh = F.lds + SSD_XH + h4 * 16384;
        const LAS unsigned char* bm = F.lds + SSD_BM;
#pragma unroll 2
        for (int st = 0; st < 8; ++st) {
            const int row = 16 * st + 8 * hh + q;
            const f32x4 wa = *(const LAS f32x4*)(W + F.wave * 128 + 16 * st + 8 * hh), wb = *(const LAS f32x4*)(W + F.wave * 128 + 16 * st + 8 * hh + 4);
            bf16x8 af[2], bfr[2];
#pragma unroll
            for (int t = 0; t < 2; ++t) { const int chunk = t * 4 + 2 * blk + (pp >> 1), within = 8 * (pp & 1);
                af[t] = cat8(tr_read4(bm + img_off(row, chunk) + within), tr_read4(bm + img_off(row + 4, chunk) + within));
                const s16x4 lo = tr_read4(xh + img_off(row, chunk) + within), hi = tr_read4(xh + img_off(row + 4, chunk) + within);
                u32x4 pw;
                pw.x = cvtpk(bf2f((bf16_t)lo[0]) * wa[0], bf2f((bf16_t)lo[1]) * wa[1]); pw.y = cvtpk(bf2f((bf16_t)lo[2]) * wa[2], bf2f((bf16_t)lo[3]) * wa[3]);
                pw.z = cvtpk(bf2f((bf16_t)hi[0]) * wb[0], bf2f((bf16_t)hi[1]) * wb[1]); pw.w = cvtpk(bf2f((bf16_t)hi[2]) * wb[2], bf2f((bf16_t)hi[3]) * wb[3]);
                bfr[t] = __builtin_bit_cast(bf16x8, pw); }
#pragma unroll
            for (int nt = 0; nt < 2; ++nt)
#pragma unroll
                for (int pt = 0; pt < 2; ++pt) acc[nt][pt] = MFMA32(af[nt], bfr[pt], acc[nt][pt]);
        }
        float* Sb = S + ((((size_t)b * 18 + c) * 8 + h) * 2 + d) * 4096;
#pragma unroll
        for (int nt = 0; nt < 2; ++nt)
#pragma unroll
            for (int pt = 0; pt < 2; ++pt)
#pragma unroll
                for (int q4 = 0; q4 < 4; ++q4) { const int p = pt * 32 + (lane & 31), n0 = nt * 32 + 8 * q4 + 4 * hh;
                    *(f32x4*)(Sb + p * 64 + n0) = (f32x4){acc[nt][pt][4 * q4], acc[nt][pt][4 * q4 + 1], acc[nt][pt][4 * q4 + 2], acc[nt][pt][4 * q4 + 3]}; }
        __syncthreads();
    }
}

DI void ssd_recurrence(const Frame& F, const float* __restrict__ S, const float* __restrict__ TOT, bf16_t* __restrict__ HIN) {
    for (int gi = blockIdx.x * 512 + F.tid; gi < 128 * 1024; gi += F.G * 512) {
        const int bhd = gi >> 10, e4 = (gi & 1023) * 4, b = bhd >> 4, h = (bhd >> 1) & 7, d = bhd & 1;
        f32x4 sv[18]; float dec[18];
#pragma unroll
        for (int k = 0; k < 18; ++k) { const int c = (d == 0) ? k : (k < 2 ? 1 - k : 19 - k);
            const size_t st = (((size_t)b * 18 + c) * 8 + h) * 2 + d;
            sv[k] = *(const f32x4*)(S + st * 4096 + e4); dec[k] = TOT[st]; }
        f32x4 H = (f32x4){0.f, 0.f, 0.f, 0.f};
#pragma unroll
        for (int k = 0; k < 18; ++k) { const int c = (d == 0) ? k : (k < 2 ? 1 - k : 19 - k);
            const size_t st = (((size_t)b * 18 + c) * 8 + h) * 2 + d;
            u32x2 w; w.x = pk2(H[0], H[1]); w.y = pk2(H[2], H[3]);
            *(u32x2*)(HIN + st * 4096 + e4) = w;
            H = H * __expf(dec[k]) + sv[k]; }
    }
}

DI void ssd_output(const Frame& F, const LayerIn& P, const bf16_t* XBC, const bf16_t* PA, const float* DT, const bf16_t* HIN, bf16_t* YB, float* SSQ, bool skipctx) {
    LAS float* ARR = (LAS float*)(F.lds + SSD_ARR);
    const int lane = F.lane, hh = lane >> 5, q = (lane & 15) >> 2, pp = lane & 3, blk = (lane >> 4) & 1, l31 = lane & 31;
    for (int it = blockIdx.x; it < 288; it += F.G) {
        const int b = it / 36, r_ = it % 36, c = r_ >> 1, g = r_ & 1, R0 = b * PB + c * 128;
        if (skipctx && c < 2) continue;
        ssd_load_images(F, XBC, R0, g, true);
        { const int h4 = F.wave & 3, d = F.wave >> 2, h = 4 * g + h4;
          const Series s = ssd_series(F, DT, P.ssd_a_log, R0, h, d);
          LAS float* A = ARR + h4 * 768;
          if (d == 0) { *(LAS f32x2*)(A + 0 * 128 + 2 * lane) = (f32x2){s.cs0, s.cs1}; *(LAS f32x2*)(A + 1 * 128 + 2 * lane) = (f32x2){s.dt0, s.dt1};
                        *(LAS f32x2*)(A + 2 * 128 + 2 * lane) = (f32x2){__expf(s.cs0), __expf(s.cs1)}; }
          else { *(LAS f32x2*)(A + 3 * 128 + 2 * lane) = (f32x2){s.ecs0, s.ecs1}; *(LAS f32x2*)(A + 4 * 128 + 2 * lane) = (f32x2){s.dt0, s.dt1};
                 *(LAS f32x2*)(A + 5 * 128 + 2 * lane) = (f32x2){__expf(s.tot - s.ecs0), __expf(s.tot - s.ecs1)}; } }
        __syncthreads();
        const int h4 = F.wave & 3, rh = F.wave >> 2, h = 4 * g + h4;
        const LAS float* A = ARR + h4 * 768;
        const LAS unsigned char* xh = F.lds + SSD_XH + h4 * 16384;
        const LAS unsigned char* bm = F.lds + SSD_BM;
        const LAS unsigned char* cm = F.lds + SSD_CM;
        f32x16 yacc[2][2];
#pragma unroll
        for (int i = 0; i < 2; ++i)
#pragma unroll
            for (int j = 0; j < 2; ++j)
#pragma unroll
                for (int k = 0; k < 16; ++k) yacc[i][j][k] = 0.f;
#pragma unroll
        for (int itl = 0; itl < 2; ++itl) {
            const int itile = 2 * rh + itl, irow = itile * 32 + l31;
            bf16x8 cf[4];
#pragma unroll
            for (int ks = 0; ks < 4; ++ks) cf[ks] = *(const LAS bf16x8*)(cm + img_off(irow, 2 * ks + hh));
#pragma unroll 1
            for (int d = 0; d < 2; ++d) {
                const bf16_t* Hs = HIN + (((((size_t)b * 18 + c) * 8 + h) * 2 + d) * 4096);
#pragma unroll
                for (int pt = 0; pt < 2; ++pt) {
                    f32x16 tmp;
#pragma unroll
                    for (int k = 0; k < 16; ++k) tmp[k] = 0.f;
#pragma unroll
                    for (int ks = 0; ks < 4; ++ks) { const bf16x8 hb = *(const bf16x8*)(Hs + (pt * 32 + l31) * 64 + 16 * ks + 8 * hh); tmp = MFMA32(cf[ks], hb, tmp); }
#pragma unroll
                    for (int q4 = 0; q4 < 4; ++q4) { const f32x4 ev = *(const LAS f32x4*)(A + (d == 0 ? 2 : 5) * 128 + itile * 32 + 8 * q4 + 4 * hh);
#pragma unroll
                        for (int k = 0; k < 4; ++k) yacc[itl][pt][4 * q4 + k] += tmp[4 * q4 + k] * ev[k]; }
                    __builtin_amdgcn_sched_barrier(0);
                }
            }
            const float csf_i = A[0 * 128 + irow], ecb_i = A[3 * 128 + irow];
#pragma unroll 1
            for (int jt = 0; jt < 4; ++jt) {
                f32x16 Z;
#pragma unroll
                for (int k = 0; k < 16; ++k) Z[k] = 0.f;
#pragma unroll
                for (int ks = 0; ks < 4; ++ks) { const bf16x8 bf_ = *(const LAS bf16x8*)(bm + img_off(jt * 32 + l31, 2 * ks + hh)); Z = MFMA32(bf_, cf[ks], Z); }
#pragma unroll
                for (int q4 = 0; q4 < 4; ++q4) { const int j0 = jt * 32 + 8 * q4 + 4 * hh;
                    f32x4 w = (f32x4){0.f, 0.f, 0.f, 0.f};
                    if (jt <= itile) { const f32x4 cj = *(const LAS f32x4*)(A + 0 * 128 + j0), dj = *(const LAS f32x4*)(A + 1 * 128 + j0);
#pragma unroll
                        for (int k = 0; k < 4; ++k) { const bool ok = (jt < itile) || (j0 + k <= irow); w[k] += ok ? __expf(fminf(csf_i - cj[k], 0.f)) * dj[k] : 0.f; } }
                    if (jt >= itile) { const f32x4 ej = *(const LAS f32x4*)(A + 3 * 128 + j0), dj = *(const LAS f32x4*)(A + 4 * 128 + j0);
#pragma unroll
                        for (int k = 0; k < 4; ++k) { const bool ok = (jt > itile) || (j0 + k >= irow); w[k] += ok ? __expf(fminf(ej[k] - ecb_i, 0.f)) * dj[k] : 0.f; } }
#pragma unroll
                    for (int k = 0; k < 4; ++k) Z[4 * q4 + k] *= w[k]; }
#pragma unroll
                for (int s = 0; s < 2; ++s) {
                    u32x4 zp; zp.x = cvtpk(Z[8 * s], Z[8 * s + 1]); zp.y = cvtpk(Z[8 * s + 2], Z[8 * s + 3]); zp.z = cvtpk(Z[8 * s + 4], Z[8 * s + 5]); zp.w = cvtpk(Z[8 * s + 6], Z[8 * s + 7]);
                    const bf16x8 za = __builtin_bit_cast(bf16x8, zp);
                    const int row = jt * 32 + 16 * s + 4 * hh + q;
#pragma unroll
                    for (int pt = 0; pt < 2; ++pt) { const int chunk = pt * 4 + 2 * blk + (pp >> 1), within = 8 * (pp & 1);
                        const bf16x8 xb = cat8(tr_read4(xh + img_off(row, chunk) + within), tr_read4(xh + img_off(row + 8, chunk) + within));
                        yacc[itl][pt] = MFMA32(za, xb, yacc[itl][pt]); }
                }
                __builtin_amdgcn_sched_barrier(0);
            }
        }
        __syncthreads();
        LAS float* Y = (LAS float*)F.lds;
#pragma unroll
        for (int itl = 0; itl < 2; ++itl)
#pragma unroll
            for (int pt = 0; pt < 2; ++pt)
#pragma unroll
                for (int r = 0; r < 16; ++r) Y[((2 * rh + itl) * 32 + crow(r, hh)) * 256 + h4 * 64 + pt * 32 + l31] = yacc[itl][pt][r];
        __syncthreads();
#pragma unroll 2
        for (int itn = 0; itn < 8; ++itn) { const int idx = itn * 512 + F.tid, row = idx >> 5, ch = idx & 31, R = R0 + row;
            const f32x4 y0 = *(const LAS f32x4*)(Y + row * 256 + ch * 8), y1 = *(const LAS f32x4*)(Y + row * 256 + ch * 8 + 4);
            float xv[8], zv[8]; unpack8(*(const u32x4*)(XBC + (size_t)R * 768 + g * 256 + ch * 8), xv); unpack8(*(const u32x4*)(PA + (size_t)R * PA_W + C_Z + g * 256 + ch * 8), zv);
            const float Dh = P.ssd_d[4 * g + (ch >> 3)]; float o[8], ss = 0.f;
#pragma unroll
            for (int k = 0; k < 8; ++k) { const float yv = (k < 4 ? y0[k] : y1[k - 4]) + Dh * xv[k]; o[k] = yv * silu_f(zv[k]); ss += o[k] * o[k]; }
            ss += __shfl_xor(ss, 1); ss += __shfl_xor(ss, 2); ss += __shfl_xor(ss, 4); ss += __shfl_xor(ss, 8); ss += __shfl_xor(ss, 16);
            if (ch == 0) SSQ[(size_t)R * 2 + g] = ss;
            *(u32x4*)(YB + (size_t)R * 1024 + 512 + g * 256 + ch * 8) = pack8(o); }
        __syncthreads();
    }
}

DI void s5_recurrence(const Frame& F, const LayerIn& P, const float* __restrict__ S5S, bf16_t* __restrict__ AU) {
    if (F.gw >= 384) return;
    const int g = F.gw >> 4, b = (F.gw >> 1) & 7, d = F.gw & 1, p = F.lane;
    const float step = __expf(P.s5_lstep[d * 24 + g]);
    const float lr = P.s5_lre[(d * 24 + g) * 64 + p], li = P.s5_lim[(d * 24 + g) * 64 + p];
    const float mag = expf(32.f * lr * step), ang = 32.f * li * step, Lr = mag * cosf(ang), Li = mag * sinf(ang);
    float Hr = 0.f, Hi = 0.f;
#pragma unroll 1
    for (int kb = 0; kb < 72; kb += 24) {
        float sr[24], si[24];
#pragma unroll
        for (int k = 0; k < 24; ++k) { const int kk = kb + k, ck = (d == 0) ? kk : (kk < 8 ? 7 - kk : 79 - kk);
            const size_t m = (size_t)g * 576 + b * 72 + ck;
            sr[k] = S5S[m * 256 + d * 128 + p]; si[k] = S5S[m * 256 + d * 128 + 64 + p]; }
#pragma unroll
        for (int k = 0; k < 24; ++k) { const int kk = kb + k, ck = (d == 0) ? kk : (kk < 8 ? 7 - kk : 79 - kk);
            const size_t m = (size_t)g * 576 + b * 72 + ck;
            AU[m * 768 + 512 + d * 128 + p] = (bf16_t)f2bf(Hr); AU[m * 768 + 512 + d * 128 + 64 + p] = (bf16_t)f2bf(Hi);
            const float nr = Lr * Hr - Li * Hi + sr[k], ni = Lr * Hi + Li * Hr + si[k];
            Hr = nr; Hi = ni; }
    }
}

namespace attn_body {
using bf16=__hip_bfloat16;
using bf16x8=__attribute__((ext_vector_type(8)))short;
using s16x4=__attribute__((ext_vector_type(4)))short;
using f32x16=__attribute__((ext_vector_type(16)))float;
using u32x4=__attribute__((ext_vector_type(4)))unsigned;
constexpr int D=64;
constexpr int NW=8,QBLK=32,QB=QBLK*NW,KVBLK=64;
__device__ __forceinline__ int crow(int r,int hi){return (r&3)+8*(r>>2)+4*hi;}
#define SBAR() __builtin_amdgcn_sched_barrier(0)
constexpr int NSLOT=3, SLOTB=8192;
constexpr int LDS_K=0, LDS_V=NSLOT*SLOTB, LDS_WS=2*NSLOT*SLOTB, LDS_OST=LDS_WS+NW*64*4, LDS_BYTES=LDS_OST+NW*4096;
constexpr float C2=0.125f*1.4426950408889634f;
__device__ __forceinline__ void glds16(const void*gsrc,unsigned lds_dst){unsigned keep;
  asm volatile("s_mov_b32 %0, m0\n\ts_mov_b32 m0, %2\n\ts_nop 0\n\tglobal_load_lds_dwordx4 %1, off\n\ts_mov_b32 m0, %0":"=&s"(keep):"v"(gsrc),"s"(lds_dst):"memory");}
__device__ __forceinline__ float max3f(float a,float b,float c){float r;asm("v_max3_f32 %0, %1, %2, %3":"=v"(r):"v"(a),"v"(b),"v"(c));return r;}
__device__ __forceinline__ float max2f(float a,float b){float r;asm("v_max_f32_e32 %0, %1, %2":"=v"(r):"v"(a),"v"(b));return r;}
__device__ __forceinline__ float fadd_s(float a,float b){float r;asm("v_add_f32_e32 %0, %1, %2":"=v"(r):"v"(a),"v"(b));return r;}
__device__ __forceinline__ float fsub_s(float a,float b){float r;asm("v_sub_f32_e32 %0, %1, %2":"=v"(r):"v"(a),"v"(b));return r;}
typedef float f32x2_t __attribute__((ext_vector_type(2))); typedef __bf16 bf16x2_t __attribute__((ext_vector_type(2)));
__device__ __forceinline__ unsigned cvtpk_s(float lo,float hi){f32x2_t v={lo,hi};bf16x2_t b=__builtin_convertvector(v,bf16x2_t);return __builtin_bit_cast(unsigned,b);}
#define WAIT_BAR(N) asm volatile("s_waitcnt vmcnt(" #N ") lgkmcnt(0)\n\ts_barrier":::"memory")

__device__ __forceinline__ void qkt(f32x16&p0,f32x16&p1,const char*Kslot,const bf16x8*qr,const f32x16&negm,int r32,int hi){
  const char*kb=Kslot+hi*1024+r32*16;
  #pragma unroll
  for(int d0=0;d0<4;++d0){
    const bf16x8 b0=*reinterpret_cast<const bf16x8*>(kb+d0*2048);
    const bf16x8 b1=*reinterpret_cast<const bf16x8*>(kb+d0*2048+512);
    if(d0==0){p0=__builtin_amdgcn_mfma_f32_32x32x16_bf16(b0,qr[0],negm,0,0,0);p1=__builtin_amdgcn_mfma_f32_32x32x16_bf16(b1,qr[0],negm,0,0,0);}
    else{p0=__builtin_amdgcn_mfma_f32_32x32x16_bf16(b0,qr[d0],p0,0,0,0);p1=__builtin_amdgcn_mfma_f32_32x32x16_bf16(b1,qr[d0],p1,0,0,0);}}
}
typedef __attribute__((address_space(3))) const char* lds_cptr;
typedef short v4i16_t __attribute__((ext_vector_type(4)));
__device__ __forceinline__ void kload8(bf16x8*kf,lds_cptr kp){
  kf[0]=*(const __attribute__((address_space(3))) bf16x8*)(kp);      kf[1]=*(const __attribute__((address_space(3))) bf16x8*)(kp+512);
  kf[2]=*(const __attribute__((address_space(3))) bf16x8*)(kp+2048); kf[3]=*(const __attribute__((address_space(3))) bf16x8*)(kp+2560);
  kf[4]=*(const __attribute__((address_space(3))) bf16x8*)(kp+4096); kf[5]=*(const __attribute__((address_space(3))) bf16x8*)(kp+4608);
  kf[6]=*(const __attribute__((address_space(3))) bf16x8*)(kp+6144); kf[7]=*(const __attribute__((address_space(3))) bf16x8*)(kp+6656);
}
__device__ __forceinline__ void kload2(bf16x8*kf,lds_cptr kp,int j){ kf[2*j]=*(const __attribute__((address_space(3))) bf16x8*)(kp+j*2048); kf[2*j+1]=*(const __attribute__((address_space(3))) bf16x8*)(kp+j*2048+512); }
__device__ __forceinline__ s16x4 vtr(lds_cptr p){ return __builtin_bit_cast(s16x4,__builtin_amdgcn_ds_read_tr16_b64_v4i16((__attribute__((address_space(3))) v4i16_t*)p)); }
__device__ __forceinline__ float rowmax(const f32x16&p0,const f32x16&p1){
  float a=max3f(p0[0],p0[1],p1[0]),b=max3f(p0[2],p0[3],p1[1]);a=max3f(a,p1[2],p1[3]);
  #pragma unroll
  for(int r=4;r<16;r+=4){a=max3f(a,p0[r],p0[r+1]);b=max3f(b,p0[r+2],p0[r+3]);a=max3f(a,p1[r],p1[r+1]);b=max3f(b,p1[r+2],p1[r+3]);}
  const float m=max2f(a,b);
  auto rr=__builtin_amdgcn_permlane32_swap(__float_as_uint(m),__float_as_uint(m),false,false);
  return max2f(__uint_as_float(rr[0]),__uint_as_float(rr[1]));
}
__device__ __forceinline__ void pv(f32x16*o,int vb,bf16x8 pa0,bf16x8 pa1,bf16x8 pa2,bf16x8 pa3){
  #pragma unroll
  for(int d0=0;d0<2;++d0){s16x4 lo[4],hi[4];
    #pragma unroll
    for(int ks=0;ks<4;++ks){
      asm volatile("ds_read_b64_tr_b16 %0,%1 offset:%c2":"=&v"(lo[ks]):"v"(vb),"i"(d0*4096+ks*1024):"memory");
      asm volatile("ds_read_b64_tr_b16 %0,%1 offset:%c2":"=&v"(hi[ks]):"v"(vb),"i"(d0*4096+ks*1024+512):"memory");}
    asm volatile("s_waitcnt lgkmcnt(0)":::"memory");SBAR();
    #define PK(k) (bf16x8){lo[k][0],lo[k][1],lo[k][2],lo[k][3],hi[k][0],hi[k][1],hi[k][2],hi[k][3]}
    o[d0]=__builtin_amdgcn_mfma_f32_32x32x16_bf16(pa0,PK(0),o[d0],0,0,0);
    o[d0]=__builtin_amdgcn_mfma_f32_32x32x16_bf16(pa1,PK(1),o[d0],0,0,0);
    o[d0]=__builtin_amdgcn_mfma_f32_32x32x16_bf16(pa2,PK(2),o[d0],0,0,0);
    o[d0]=__builtin_amdgcn_mfma_f32_32x32x16_bf16(pa3,PK(3),o[d0],0,0,0);
    #undef PK
  }
}

#ifndef ATTN_STORE16
#define ATTN_STORE16(p,v) (*(u32x4*)(p)=(v))
#endif
template<int THRL> __device__ __forceinline__ void attn_unit(const bf16*Qp,int qpitch,const bf16*__restrict__ Kp,int kpitch,const bf16*__restrict__ Vp,int vpitch,bf16*Op,int opitch,const int NT,char*shm){
  const int tid=fresh_tid(),lane=tid&63,r32=lane&31,hi=lane>>5; const int wid=__builtin_amdgcn_readfirstlane(tid>>6);
  const bf16*Qw=Qp+(long)(wid*QBLK)*qpitch;
  const bf16*Kh=Kp,*Vh=Vp;
  const unsigned lds0=(unsigned)(uintptr_t)shm;
  float*wsf=(float*)(shm+LDS_WS)+wid*64;
  const bf16*ksrc=Kh+(long)lane*kpitch+wid*8;
  const bf16*vsrc=Vh+(long)(16*(wid&3)+(lane>>2))*vpitch+(wid>>2)*32+(lane&3)*8;
  const unsigned kdst=lds0+LDS_K+wid*1024, vdst=lds0+LDS_V+wid*1024;
  #define DMA_K(t,slot) glds16(ksrc+(long)(t)*KVBLK*kpitch,(unsigned)__builtin_amdgcn_readfirstlane(kdst+(slot)))
  #define DMA_V(t,slot) glds16(vsrc+(long)(t)*KVBLK*vpitch,(unsigned)__builtin_amdgcn_readfirstlane(vdst+(slot)))
  const int vb0=(int)(lds0+LDS_V)+((lane>>4)&1)*32+(lane&3)*8+(4*hi+((lane&15)>>2))*64;
  const char*Kbase=shm+LDS_K; bf16x8 kf[8];
  const lds_cptr shm3=(lds_cptr)shm; const lds_cptr kp0=shm3+LDS_K+hi*1024+r32*16; const lds_cptr vp0=shm3+LDS_V+((lane>>4)&1)*32+(lane&3)*8+(4*hi+((lane&15)>>2))*64;
  DMA_K(0,0);DMA_V(0,0);DMA_K(1,SLOTB);
  bf16x8 qr[4];
  #pragma unroll
  for(int d0=0;d0<4;++d0)qr[d0]=*reinterpret_cast<const bf16x8*>(&Qw[(long)r32*qpitch+d0*16+hi*8]);
  float mhat=0.f,l_reg=0.f;f32x16 o[2];o[0]=f32x16{};o[1]=f32x16{};f32x16 negm=f32x16{};asm volatile("":"+v"(negm));
  #define CMASK(P0,P1,t) do{}while(0)
  bool resc=false;
  #define START(P0,P1) do{ const float rm=rowmax(P0,P1); resc=false; \
    { const float dl=rm; mhat=fadd_s(mhat,dl); \
      _Pragma("unroll") for(int r=0;r<16;++r){P0[r]=fsub_s(P0[r],dl);P1[r]=fsub_s(P1[r],dl);} \
      _Pragma("unroll") for(int r=0;r<16;++r)negm[r]=-mhat; asm volatile("":"+v"(negm)); } \
    _Pragma("unroll") for(int r=0;r<16;++r)P0[r]=__builtin_amdgcn_exp2f(P0[r]); }while(0)
  #define RESC() do{ if(resc){ asm volatile("s_waitcnt lgkmcnt(0)":::"memory"); \
      _Pragma("unroll") for(int d_=0;d_<2;++d_) _Pragma("unroll") for(int r=0;r<16;++r)o[d_][r]*=wsf[crow(r,hi)]; } }while(0)
  f32x16 pA0,pA1,pB0,pB1;
  int sl_prev=0,sl_cur=0,sl_next=SLOTB;
  #define ROT() do{sl_prev=sl_cur;sl_cur=sl_next;sl_next=(sl_next==(NSLOT-1)*SLOTB)?0:sl_next+SLOTB;}while(0)
  DMA_K(2,2*SLOTB);
  WAIT_BAR(3);
  qkt(pA0,pA1,Kbase,qr,negm,r32,hi);asm volatile("s_nop 15\n\ts_nop 7":"+v"(pA0),"+v"(pA1));CMASK(pA0,pA1,0);
  START(pA0,pA1);
  _Pragma("unroll") for(int r=0;r<16;++r)pA1[r]=__builtin_amdgcn_exp2f(pA1[r]);
  WAIT_BAR(0);
  DMA_K(3,0);DMA_V(1,SLOTB);
  ROT();
  kload8(kf,kp0+sl_cur);
  WAIT_BAR(2);
  s16x4 vlo[8],vhi[8]; u32x4 pw0,pw1,pw2,pw3;
  #define PKW(P,B) cvtpk_s(P[B],P[B+1])
  #define PAF(k) __builtin_bit_cast(bf16x8,pw##k)
  #define VFR(i) (bf16x8){vlo[i][0],vlo[i][1],vlo[i][2],vlo[i][3],vhi[i][0],vhi[i][1],vhi[i][2],vhi[i][3]}
  #define PIN(x) asm volatile("":"+v"(x))
  #define MX3(a,b,c) __builtin_fmaxf(__builtin_fmaxf((a),(b)),(c))
  #define GAPA(MF,A0,A1,A2,A3,W0,W1,PW) do{ MF; sacc+=A0; sacc+=A1; sacc+=A2; sacc+=A3; PIN(sacc); W0; W1; PIN(PW); SBAR(); }while(0)
  #define EX(v) __builtin_amdgcn_exp2f(v)
  #define GAPB(MF,X,B) do{ MF; X[B]=EX(X[B]); X[B+1]=EX(X[B+1]); X[B+2]=EX(X[B+2]); X[B+3]=EX(X[B+3]); PIN(X); SBAR(); }while(0)
  #define VRD(i) do{ vlo[i]=vtr(vp_+(((i)>>2)*4096+((i)&3)*1024)); vhi[i]=vtr(vp_+(((i)>>2)*4096+((i)&3)*1024+512)); }while(0)
  #define KRD(G,j) do{ if(G){ kload2(kf,kp0+sl_next,j); SBAR(); } }while(0)
  #define STEP(C0,C1,P0,P1,t,GK,GV,GL) do{ SBAR(); \
    const lds_cptr vp_=vp0+sl_prev; \
    VRD(0); SBAR(); float sacc=(P0[0]+P0[1]); \
    GAPA(C0=__builtin_amdgcn_mfma_f32_32x32x16_bf16(kf[0],qr[0],negm,0,0,0), P0[2],P0[3],P0[4],P0[5],     pw0[0]=PKW(P0,0), pw0[1]=PKW(P0,2), pw0); \
    VRD(4); SBAR(); GAPA(C1=__builtin_amdgcn_mfma_f32_32x32x16_bf16(kf[1],qr[0],negm,0,0,0), P0[6],P0[7],P0[8],P0[9],     pw0[2]=PKW(P0,4), pw0[3]=PKW(P0,6), pw0); \
    VRD(1); SBAR(); GAPA(C0=__builtin_amdgcn_mfma_f32_32x32x16_bf16(kf[2],qr[1],C0,0,0,0),   P0[10],P0[11],P0[12],P0[13], pw1[0]=PKW(P0,8), pw1[1]=PKW(P0,10), pw1); \
    VRD(5); SBAR(); GAPA(C1=__builtin_amdgcn_mfma_f32_32x32x16_bf16(kf[3],qr[1],C1,0,0,0),   P0[14],P0[15],P1[0],P1[1],   pw1[2]=PKW(P0,12),pw1[3]=PKW(P0,14), pw1); \
    VRD(2); SBAR(); GAPA(C0=__builtin_amdgcn_mfma_f32_32x32x16_bf16(kf[4],qr[2],C0,0,0,0),   P1[2],P1[3],P1[4],P1[5],     pw2[0]=PKW(P1,0), pw2[1]=PKW(P1,2), pw2); \
    VRD(6); SBAR(); GAPA(C1=__builtin_amdgcn_mfma_f32_32x32x16_bf16(kf[5],qr[2],C1,0,0,0),   P1[6],P1[7],P1[8],P1[9],     pw2[2]=PKW(P1,4), pw2[3]=PKW(P1,6), pw2); \
    VRD(3); SBAR(); GAPA(C0=__builtin_amdgcn_mfma_f32_32x32x16_bf16(kf[6],qr[3],C0,0,0,0),   P1[10],P1[11],P1[12],P1[13], pw3[0]=PKW(P1,8), pw3[1]=PKW(P1,10), pw3); \
    VRD(7); SBAR(); GAPA(C1=__builtin_amdgcn_mfma_f32_32x32x16_bf16(kf[7],qr[3],C1,0,0,0),   P1[14],P1[15],0.f,0.f,       pw3[2]=PKW(P1,12),pw3[3]=PKW(P1,14), pw3); \
    l_reg+=sacc; \
    if(GK){DMA_K((t)+3,sl_cur);} if(GV){DMA_V((t)+1,sl_next);} \
    CMASK(C0,C1,t); \
    { float a=MX3(C0[0],C0[1],C1[0]),b=MX3(C0[2],C0[3],C1[1]); a=MX3(a,C1[2],C1[3]); \
      _Pragma("unroll") for(int r=4;r<16;r+=4){a=MX3(a,C0[r],C0[r+1]);b=MX3(b,C0[r+2],C0[r+3]);a=MX3(a,C1[r],C1[r+1]);b=MX3(b,C1[r+2],C1[r+3]);} \
      float rm=__builtin_fmaxf(a,b); { auto rr=__builtin_amdgcn_permlane32_swap(__float_as_uint(rm),__float_as_uint(rm),false,false); rm=__builtin_fmaxf(__uint_as_float(rr[0]),__uint_as_float(rr[1])); } \
      resc=false; \
      if(__builtin_expect(__any(rm>(float)THRL),0)){ const float dl=__builtin_fmaxf(rm,0.f); mhat+=dl; \
        _Pragma("unroll") for(int r=0;r<16;++r){C0[r]-=dl;C1[r]-=dl;} \
        _Pragma("unroll") for(int r=0;r<16;++r)negm[r]=-mhat; asm volatile("":"+v"(negm)); \
        const float f=__builtin_amdgcn_exp2f(-dl); l_reg*=f; if(hi==0)wsf[r32]=f; resc=true; } } \
    SBAR(); \
    GAPB(o[0]=__builtin_amdgcn_mfma_f32_32x32x16_bf16(PAF(0),VFR(0),o[0],0,0,0), C0,0); \
    GAPB(o[1]=__builtin_amdgcn_mfma_f32_32x32x16_bf16(PAF(0),VFR(4),o[1],0,0,0), C0,4); \
    KRD(GL,0); GAPB(o[0]=__builtin_amdgcn_mfma_f32_32x32x16_bf16(PAF(1),VFR(1),o[0],0,0,0), C0,8); \
    KRD(GL,1); GAPB(o[1]=__builtin_amdgcn_mfma_f32_32x32x16_bf16(PAF(1),VFR(5),o[1],0,0,0), C0,12); \
    KRD(GL,2); GAPB(o[0]=__builtin_amdgcn_mfma_f32_32x32x16_bf16(PAF(2),VFR(2),o[0],0,0,0), C1,0); \
    KRD(GL,3); GAPB(o[1]=__builtin_amdgcn_mfma_f32_32x32x16_bf16(PAF(2),VFR(6),o[1],0,0,0), C1,4); \
    GAPB(o[0]=__builtin_amdgcn_mfma_f32_32x32x16_bf16(PAF(3),VFR(3),o[0],0,0,0), C1,8); \
    GAPB(o[1]=__builtin_amdgcn_mfma_f32_32x32x16_bf16(PAF(3),VFR(7),o[1],0,0,0), C1,12); \
    }while(0)
  int t=1;
  for(;t+5<NT;t+=2){
    STEP(pB0,pB1,pA0,pA1,t,true,true,true);     WAIT_BAR(2); RESC(); ROT();
    STEP(pA0,pA1,pB0,pB1,t+1,true,true,true);   WAIT_BAR(2); RESC(); ROT();
  }
  #define ENDW(tt) do{ if((tt)+3<NT){WAIT_BAR(2);} else if((tt)+2<NT){WAIT_BAR(1);} else {WAIT_BAR(0);} }while(0)
  for(;t+1<NT;t+=2){
    STEP(pB0,pB1,pA0,pA1,t,(t+3<NT),(t+1<NT),(t+1<NT));       ENDW(t);   RESC(); ROT();
    STEP(pA0,pA1,pB0,pB1,t+1,(t+4<NT),(t+2<NT),(t+2<NT));     ENDW(t+1); RESC(); ROT();
  }
  STEP(pB0,pB1,pA0,pA1,NT-1,false,false,false); RESC();
  { float sacc=pB0[0]+pB0[1]; _Pragma("unroll") for(int r=2;r<16;++r)sacc+=pB0[r]; _Pragma("unroll") for(int r=0;r<16;++r)sacc+=pB1[r]; l_reg+=sacc;
    pw0=(u32x4){PKW(pB0,0),PKW(pB0,2),PKW(pB0,4),PKW(pB0,6)};pw1=(u32x4){PKW(pB0,8),PKW(pB0,10),PKW(pB0,12),PKW(pB0,14)};pw2=(u32x4){PKW(pB1,0),PKW(pB1,2),PKW(pB1,4),PKW(pB1,6)};pw3=(u32x4){PKW(pB1,8),PKW(pB1,10),PKW(pB1,12),PKW(pB1,14)};
    SBAR(); pv(o,vb0+sl_cur,PAF(0),PAF(1),PAF(2),PAF(3)); }
  #undef PKW
  #undef PAF
  #undef VFR
  #undef PIN
  #undef MX3
  #undef GAPA
  #undef GAPB
  #undef EX
  #undef VRD
  #undef KRD
  #undef STEP
  #undef ENDW
  {auto rr=__builtin_amdgcn_permlane32_swap(__float_as_uint(l_reg),__float_as_uint(l_reg),false,false);l_reg=__uint_as_float(rr[0])+__uint_as_float(rr[1]);}
  if(hi==0)wsf[32+r32]=l_reg;asm volatile("s_waitcnt lgkmcnt(0)":::"memory");
  float rli[16];
  #pragma unroll
  for(int r=0;r<16;++r)rli[r]=__builtin_amdgcn_rcpf(wsf[32+crow(r,hi)]);
  bf16*Ow=Op+(long)(wid*QBLK)*opitch;
  { bf16*stg=(bf16*)(shm+LDS_OST)+wid*2048;
    #pragma unroll
    for(int r=0;r<16;++r){const int orow=crow(r,hi);
      #pragma unroll
      for(int d0=0;d0<2;++d0)stg[orow*64+d0*32+r32]=__float2bfloat16(o[d0][r]*rli[r]);}
    asm volatile("s_waitcnt lgkmcnt(0)":::"memory");
    #pragma unroll
    for(int i=0;i<4;++i){const int row=i*8+(lane>>3),ch=lane&7; const u32x4 v=*(const u32x4*)(stg+row*64+ch*8); ATTN_STORE16(Ow+(long)row*opitch+ch*8,v);} }
  asm volatile("s_waitcnt lgkmcnt(0)\n\ts_barrier":::"memory");
  #undef DMA_K
  #undef DMA_V
  #undef CMASK
  #undef START
  #undef RESC
  #undef ROT
}
constexpr int ATTN_LDS_BYTES=LDS_BYTES;
#undef SBAR
#undef WAIT_BAR
}


#define pMOD ((float*)(ws + WS_MOD))
#define pROPE ((float*)(ws + WS_ROPE))
#define pAFF ((float*)(ws + WS_AFF))
#define pINV ((int*)(ws + WS_INV))
#define pDT ((float*)(ws + WS_DT))
#define pSRC ((int*)(ws + WS_SRC))
#define pGV ((float*)(ws + WS_GV))
#define pSSQ ((float*)(ws + WS_SSQ))
#define pTOT ((float*)(ws + WS_TOT))
#define pX ((float*)(ws + WS_X))
#define pH ((bf16_t*)(ws + WS_H))
#define pYAB ((bf16_t*)(ws + WS_YAB))
#define pPA ((bf16_t*)(ws + WS_PA))
#define pPG ((bf16_t*)(ws + WS_PG))
#define pMRGB ((bf16_t*)(ws + WS_MRGB))
#define pXG ((bf16_t*)(ws + WS_XG))
#define pHID ((bf16_t*)(ws + WS_HID))
#define pYE ((bf16_t*)(ws + WS_YE))
#define pQN ((bf16_t*)(ws + WS_QN))
#define pKN ((bf16_t*)(ws + WS_KN))
#define pHIN ((bf16_t*)(ws + WS_HIN))
#define pXBC ((bf16_t*)(ws + WS_XBC))
#define pAU ((bf16_t*)(ws + WS_AU))
#define pSS ((float*)(ws + WS_S))
#define pYG ((bf16_t*)(ws + WS_YG))
#define pS5S ((float*)(ws + WS_S5S))
#define pYCD ((bf16_t*)(ws + WS_YCD))
struct Args { const float* in[38]; float* out; unsigned char* ws; int ph_lo, ph_hi; };
constexpr int PH_PER_LAYER = 15, PH_FINAL = 2 * PH_PER_LAYER, PH_TOTAL = PH_FINAL + 1;

DI LayerIn layer_in(const Args& a, int L) {
    LayerIn P;
    P.norm_mix_g = a.in[6] + (size_t)L * 1024; P.norm_ffn_g = a.in[7] + (size_t)L * 1024;
    P.w_in = a.in[8] + (size_t)L * 1024 * NIN; P.q_norm_g = a.in[9] + L * 64; P.k_norm_g = a.in[10] + L * 64;
    P.ssd_conv_w = a.in[11] + L * 3 * 768; P.ssd_conv_b = a.in[12] + L * 768; P.ssd_dt_bias = a.in[13] + L * 16; P.ssd_a_log = a.in[14] + L * 16;
    P.ssd_d = a.in[15] + L * 8; P.ssd_norm_g = a.in[16] + L * 512;
    P.s5_lre = a.in[17] + L * 2 * 24 * 64; P.s5_lim = a.in[18] + L * 2 * 24 * 64; P.s5_lstep = a.in[19] + L * 48;
    P.s5_bre = a.in[20] + (size_t)L * 24 * 64 * 16; P.s5_bim = a.in[21] + (size_t)L * 24 * 64 * 16; P.s5_cre = a.in[22] + (size_t)L * 24 * 16 * 64; P.s5_cim = a.in[23] + (size_t)L * 24 * 16 * 64;
    P.s5_d = a.in[24] + L * 384; P.s5_wglu = a.in[25] + (size_t)L * 384 * 384; P.s5_bglu = a.in[26] + L * 384; P.sc_conv_w = a.in[27] + L * 3 * 384;
    P.w_br_attn = a.in[28] + (size_t)L * 512 * 1024; P.w_br_ssd = a.in[29] + (size_t)L * 512 * 1024; P.w_br_s5 = a.in[30] + (size_t)L * 384 * 1024; P.w_br_sc = a.in[31] + (size_t)L * 384 * 1024;
    P.w_out = a.in[32] + (size_t)L * 1024 * 1024; P.w_router = a.in[33] + (size_t)L * 1024 * 16;
    P.w_gate = a.in[34] + (size_t)L * 16 * 1024 * 1024; P.w_up = a.in[35] + (size_t)L * 16 * 1024 * 1024; P.w_down = a.in[36] + (size_t)L * 16 * 1024 * 1024;
    return P;
}

__global__ void __launch_bounds__(NWAVES * 64, 2) hybrid_fwd(Args args) {
    extern __shared__ __attribute__((aligned(16))) unsigned char lds_raw[];
    Frame F0;
#define F F0
    F.lds = (LAS unsigned char*)lds_raw;
    F.tid = threadIdx.x; F.lane = F.tid & 63; F.wave = __builtin_amdgcn_readfirstlane(F.tid >> 6);
    F.G = gridDim.x; { const int bx = blockIdx.x; F.vcu = (F.G % 8 == 0) ? (bx % 8) * (F.G / 8) + bx / 8 : bx; }
    F.gw = F.vcu * NWAVES + F.wave; F.NGW = F.G * NWAVES;
    unsigned char* ws = args.ws;
    volatile LAS unsigned* MISC = (volatile LAS unsigned*)(F.lds + LDSCTL_OFF);
    for (int u = F.tid; u < (LDS_BYTES - LDSCTL_OFF) / 4; u += NWAVES * 64) ((LAS unsigned*)(F.lds + LDSCTL_OFF))[u] = 0u;
    __syncthreads();
    XcdBarrier bar = xcd_barrier_post((unsigned*)(ws + WS_CTL) + CW_BAR, MISC + 8);
    const int lo = args.ph_lo, hi = args.ph_hi;
#ifndef PH_MASK
#define PH_MASK 0xFFFF
#endif
#define IN(k) (lo <= (k) && (k) < hi)
#define INL(j) (((PH_MASK >> (j)) & 1) && IN(base + (j)))
#ifndef REPEAT_MASK
#define REPEAT_MASK 0
#endif
#define REP(j) for (int rep_ = 0; rep_ < 1 + ((REPEAT_MASK >> (j)) & 1); ++rep_)
#define SEAM(k) do { if (IN((k) + 1)) xcd_barrier(bar); } while (0)

#undef F
#pragma unroll 1
    for (int L = 0; L < 2; ++L) {
        const int base = L * PH_PER_LAYER;
        if (hi <= base || lo >= base + PH_PER_LAYER) continue;
        const bool lastL = (L == 1);

        if (L == 0 && INL(0)) REP(0) { const LayerIn P = layer_in(args, L); Frame F = F0; F.tid = fresh_tid(); F.lane = F.tid & 63; if (rep_) xcd_barrier(bar);
#ifndef SUBREP_MOD
#define SUBREP_MOD 0
#endif
#ifndef SUBREP_S5
#define SUBREP_S5 0
#endif
#ifndef SUBREP_SW
#define SUBREP_SW 0
#endif
            if (L == 0) { for (int q_ = 0; q_ <= SUBREP_MOD; ++q_) { prep_mod(F, args.in[1], args.in[3], args.in[4], args.in[5], pMOD); prep_rope(F, pROPE); } }
            for (int q_ = 0; q_ <= SUBREP_S5; ++q_) prep_s5(F, P, ws);
            for (int q_ = 0; q_ <= SUBREP_SW; ++q_) prep_small_weights(F, P, ws);
            SEAM(base + 0);
        }
        if (INL(1)) REP(1) { const LayerIn P = layer_in(args, L); Frame F = F0; F.tid = fresh_tid(); F.lane = F.tid & 63; if (rep_) xcd_barrier(bar); phase_norm1(F, L, args.in[0], args.in[2], pX, pH, pMOD, P.norm_mix_g, pINV, pYE); SEAM(base + 1); }
        if (INL(2)) REP(2) { const LayerIn P = layer_in(args, L); Frame F = F0; F.tid = fresh_tid(); F.lane = F.tid & 63; if (rep_) xcd_barrier(bar);
            pg8::Gemm g{pH, (const bf16_t*)(ws + W_WIN), 1024, 1024, 1024};
            RowSkipOrder S; S.init(NPROJ, F.G, (int)blockIdx.x, lastL ? 1 : 0, 2, 10);
            EpiProj E{pPA, PA_W, PA_W / 256, pPG, PG_W};
            pg8::gemm_phase<EpiProj, RowSkipOrder>(F.lds, g, S, E);
            SEAM(base + 2);
        }
        if (INL(3)) REP(3) { const LayerIn P = layer_in(args, L); Frame F = F0; F.tid = fresh_tid(); F.lane = F.tid & 63; if (rep_) xcd_barrier(bar); phase_elem(F, P, pPA, pROPE, pQN, pKN, pXBC, pDT, pAU, pYCD); SEAM(base + 3); }
        if (INL(4)) REP(4) { const LayerIn P = layer_in(args, L); Frame F = F0; F.tid = fresh_tid(); F.lane = F.tid & 63; if (rep_) xcd_barrier(bar);
            using abf = attn_body::bf16;
#ifndef NO_ATTN
            for (int u = F.vcu; u < 512; u += F.G) { const int bk = u >> 5, r = u & 31, b = bk >> 1, kvh = bk & 1, h = kvh * 4 + (r >> 3), qb = r & 7;
                const size_t qrow = (size_t)b * PB + CTXL + qb * 256, krow = (size_t)b * PB;
                attn_body::attn_unit<8>((const abf*)(pQN + qrow * 512 + h * 64), 512, (const abf*)(pKN + krow * 128 + kvh * 64), 128, (const abf*)(pPA + krow * PA_W + C_V + kvh * 64), PA_W,
                                        (abf*)(pYAB + qrow * 1024 + h * 64), 1024, 36, (char*)lds_raw); }
            if (!lastL) for (int u = F.vcu; u < 64; u += F.G) { const int b = u >> 3, h = u & 7, kvh = h >> 2; const size_t krow = (size_t)b * PB;
                attn_body::attn_unit<8>((const abf*)(pQN + krow * 512 + h * 64), 512, (const abf*)(pKN + krow * 128 + kvh * 64), 128, (const abf*)(pPA + krow * PA_W + C_V + kvh * 64), PA_W,
                                        (abf*)(pYAB + krow * 1024 + h * 64), 1024, 4, (char*)lds_raw); }
#endif
            __syncthreads();
#ifndef NO_E1
            ssd_chunk_states(F, P, pXBC, pDT, pSS, pTOT);
#endif
#ifndef NO_S5S
            { pg8::Gemm g{pAU, (const bf16_t*)(ws + W_P), 768, 512, 512}; OrderS5S S{F.G, (int)blockIdx.x}; EpiS5S E{pS5S};
              pg8::gemm_phase<EpiS5S, OrderS5S>(F.lds, g, S, E); }
#endif
            SEAM(base + 4);
        }
        if (INL(5)) REP(5) { const LayerIn P = layer_in(args, L); Frame F = F0; F.tid = fresh_tid(); F.lane = F.tid & 63; if (rep_) xcd_barrier(bar); ssd_recurrence(F, pSS, pTOT, pHIN); s5_recurrence(F, P, pS5S, pAU); SEAM(base + 5); }
        if (INL(6)) REP(6) { const LayerIn P = layer_in(args, L); Frame F = F0; F.tid = fresh_tid(); F.lane = F.tid & 63; if (rep_) xcd_barrier(bar);
#ifndef NO_E3
            ssd_output(F, P, pXBC, pPA, pDT, pHIN, pYAB, pSSQ, lastL);
#endif
#ifndef NO_S5Y
            { pg8::Gemm g{pAU, (const bf16_t*)(ws + W_TQ), 768, 768, 768}; OrderS5Y S{F.G, (int)blockIdx.x}; EpiS5Y E{pAU, pYG, P.s5_d};
              pg8::gemm_phase<EpiS5Y, OrderS5Y>(F.lds, g, S, E); }
#endif
            SEAM(base + 6);
        }
        if (INL(7)) REP(7) { const LayerIn P = layer_in(args, L); Frame F = F0; F.tid = fresh_tid(); F.lane = F.tid & 63; if (rep_) xcd_barrier(bar);
            pg8::Gemm g{pYG, (const bf16_t*)(ws + W_GLU), 384, 384, 384};
            RowSkipOrder S; S.init(512, F.G, (int)blockIdx.x, lastL ? 1 : 0, 0, 0);
            EpiGlu E{pYG, pYCD, P.s5_bglu};
            pg8::gemm_phase<EpiGlu, RowSkipOrder>(F.lds, g, S, E);
            SEAM(base + 7);
        }
        if (INL(8)) REP(8) { const LayerIn P = layer_in(args, L); Frame F = F0; F.tid = fresh_tid(); F.lane = F.tid & 63; if (rep_) xcd_barrier(bar);
            MergeOrder S; S.init(F.G, (int)blockIdx.x, lastL ? 1 : 0);
            pg8::MergeArgs MA{pYAB, pYCD, (const bf16_t*)(ws + W_BR4), pPG, pSSQ, pMRGB};
            pg8::gemm_merge_phase<MergeOrder>(F.lds, MA, S);
            SEAM(base + 8);
        }
        if (INL(9)) REP(9) { const LayerIn P = layer_in(args, L); Frame F = F0; F.tid = fresh_tid(); F.lane = F.tid & 63; if (rep_) xcd_barrier(bar);
            pg8::Gemm g{pMRGB, (const bf16_t*)(ws + W_OUT), 1024, 1024, 1024};
            RowSkipOrder S; S.init(1024, F.G, (int)blockIdx.x, lastL ? 1 : 0, 0, 0);
            EpiWout E{pX, pMOD + (size_t)L * 9 * 6144};
            pg8::gemm_phase<EpiWout, RowSkipOrder>(F.lds, g, S, E);
            SEAM(base + 9);
        }
        if (INL(10)) REP(10) { const LayerIn P = layer_in(args, L); Frame F = F0; F.tid = fresh_tid(); F.lane = F.tid & 63; if (rep_) xcd_barrier(bar); phase_norm2(F, L, lastL, pX, pH, pMOD, P.norm_ffn_g, P.w_router, pAFF); SEAM(base + 10); }
        if (INL(11)) REP(11) { const LayerIn P = layer_in(args, L); Frame F = F0; F.tid = fresh_tid(); F.lane = F.tid & 63; if (rep_) xcd_barrier(bar); phase_topk(F, lastL ? 128 : 256, pAFF, pSRC, pGV, pINV);
            if (L == 0) { const LayerIn P1 = layer_in(args, 1); prep_s5(F, P1, ws); __syncthreads(); prep_small_weights(F, P1, ws); }
            prep_expert_weights(F, P, ws, (L == 0) ? 24 : 0); SEAM(base + 11); }
        if (INL(12)) REP(12) { const LayerIn P = layer_in(args, L); Frame F = F0; F.tid = fresh_tid(); F.lane = F.tid & 63; if (rep_) xcd_barrier(bar); phase_gather(F, lastL ? 2048 : 2304, pSRC, pH, pXG); SEAM(base + 12); }
        if (INL(13)) REP(13) { const LayerIn P = layer_in(args, L); Frame F = F0; F.tid = fresh_tid(); F.lane = F.tid & 63; if (rep_) xcd_barrier(bar);
            pg8::Gemm g{pXG, (const bf16_t*)(ws + WS_WGU), 1024, 1024, 1024}; OrderUp S{F.G, (int)blockIdx.x, lastL ? 8 : 9}; EpiUp E{pHID};
            pg8::gemm_phase<EpiUp, OrderUp>(F.lds, g, S, E);
            SEAM(base + 13);
        }
        if (INL(14)) REP(14) { const LayerIn P = layer_in(args, L); Frame F = F0; F.tid = fresh_tid(); F.lane = F.tid & 63; if (rep_) xcd_barrier(bar);
            pg8::Gemm g{pHID, (const bf16_t*)(ws + WS_WD), 1024, 1024, 1024}; OrderDown S{F.G, (int)blockIdx.x, lastL ? 8 : 9}; EpiDown E{pYE, pGV};
            pg8::gemm_phase<EpiDown, OrderDown>(F.lds, g, S, E);
            SEAM(base + 14);
        }
    }
#ifdef EXTRA_BARRIERS
    for (int eb = 0; eb < EXTRA_BARRIERS; ++eb) xcd_barrier(bar);
#endif
    if (IN(PH_FINAL)) phase_final(F0, pX, args.out, pMOD, args.in[37], pINV, pYE);
#undef IN
#undef INL
#undef SEAM
}

#ifndef MK_N_LAUNCHES
#define MK_N_LAUNCHES 1
#endif
extern "C" void kernel_launch(void* const* d_in, const int* in_sizes, int n_in, void* d_out, int out_size, void* d_ws, size_t ws_size, hipStream_t stream) {
    static int grid = 0;
    if (grid == 0) {
        if (n_in != 38 || ws_size < WS_END) { fprintf(stderr, "kernel_launch: unexpected inputs (n_in %d, ws %zu)\n", n_in, ws_size); grid = -1; return; }
        int dev = 0, cus = 0;
        if (hipGetDevice(&dev) != hipSuccess || hipDeviceGetAttribute(&cus, hipDeviceAttributeMultiprocessorCount, dev) != hipSuccess) { grid = -1; return; }
        if (hipFuncSetAttribute((const void*)hybrid_fwd, hipFuncAttributeMaxDynamicSharedMemorySize, LDS_BYTES) != hipSuccess) { fprintf(stderr, "kernel_launch: hipFuncSetAttribute failed\n"); grid = -1; return; }
        (void)hipGetLastError();
        grid = (cus / 8) * 8;
        if (grid > 256) grid = 256;
    }
    if (grid < 0) return;
    if (hipMemsetAsync((char*)d_ws + WS_CTL, 0, CTL_ZERO_BYTES, stream) != hipSuccess) return;
    Args a{};
    for (int i = 0; i < 38; ++i) a.in[i] = (const float*)d_in[i];
    a.out = (float*)d_out; a.ws = (unsigned char*)d_ws;
#if MK_N_LAUNCHES == 1
    a.ph_lo = 0; a.ph_hi = PH_TOTAL;
    hipLaunchKernelGGL(hybrid_fwd, dim3(grid), dim3(NWAVES * 64), LDS_BYTES, stream, a);
#else
    for (int p = 0; p < PH_TOTAL; ++p) { a.ph_lo = p; a.ph_hi = p + 1; hipLaunchKernelGGL(hybrid_fwd, dim3(grid), dim3(NWAVES * 64), LDS_BYTES, stream, a); }
#endif
}
```

```cpp
#include <hip/hip_runtime.h>
#include <hip/hip_bf16.h>
#include <cstdio>
#include <cstdint>
#include <cmath>

#define DI __device__ __forceinline__
#define GAS __attribute__((address_space(1)))
#define LAS __attribute__((address_space(3)))
typedef unsigned short bf16_t;
typedef short bf16x8 __attribute__((ext_vector_type(8)));
typedef short s16x4 __attribute__((ext_vector_type(4)));
typedef float f32x2 __attribute__((ext_vector_type(2)));
typedef float f32x4 __attribute__((ext_vector_type(4)));
typedef float f32x16 __attribute__((ext_vector_type(16)));
typedef unsigned u32x2 __attribute__((ext_vector_type(2)));
typedef unsigned u32x4 __attribute__((ext_vector_type(4)));
typedef GAS unsigned gu32;

constexpr int DM = 1024, NB = 8, SEQ = 2048, CTXL = 256, PB = 2304, MROWS = NB * PB;
constexpr int NIN = 7688, NE = 16, EFF = 1024;
constexpr int C_Q = 0, C_K = 512, C_V = 640, C_Z = 768, C_XBC = 1280, C_DT = 2048, C_U = 2056, C_SB = 2440, C_SG = 2824, C_SH = 3208, C_G = 3592;
constexpr int PA_W = 3840, PG_W = 4096, NPROJ = PA_W + PG_W;
constexpr int EROWS = 2304;
constexpr float RMS_EPS = 1e-6f;
constexpr float ATT_C2 = 0.125f * 1.4426950408889634f;

constexpr size_t MiB = 1u << 20;
constexpr size_t WS_CTL = 0, CTL_ZERO_BYTES = 1 * MiB;
constexpr size_t WS_MOD = 1 * MiB;
constexpr size_t WS_ROPE = WS_MOD + 512 * 1024;
constexpr size_t WS_AFF = 2 * MiB;
constexpr size_t WS_INV = WS_AFF + 1280 * 1024;
constexpr size_t WS_DT = WS_INV + 1280 * 1024;
constexpr size_t WS_SRC = WS_DT + 1280 * 1024;
constexpr size_t WS_GV = WS_SRC + 256 * 1024;
constexpr size_t WS_SSQ = WS_GV + 256 * 1024;
constexpr size_t WS_TOT = WS_SSQ + 256 * 1024;
constexpr size_t WS_X = 8 * MiB;
constexpr size_t WS_W = 80 * MiB;
constexpr size_t W_WIN = WS_W;
constexpr size_t W_BR4 = W_WIN + (size_t)NPROJ * 1024 * 2;
constexpr size_t W_OUT = W_BR4 + (size_t)1024 * 1792 * 2;
constexpr size_t W_GLU = W_OUT + 1024 * 1024 * 2;
constexpr size_t W_TQ = W_GLU + 512 * 384 * 2;
constexpr size_t W_P = W_TQ + (size_t)24 * 512 * 768 * 2;
constexpr size_t W_END = W_P + (size_t)24 * 256 * 512 * 2;
constexpr size_t WS_H = 126 * MiB;
constexpr size_t WS_YAB = WS_H;
constexpr size_t WS_PA = 162 * MiB;
constexpr size_t WS_MRGB = WS_PA, WS_XG = WS_PA, WS_Y = WS_PA + 72 * MiB;
constexpr size_t WS_PG = 297 * MiB;
constexpr size_t WS_HID = WS_PG, WS_YE = WS_PG + 72 * MiB;
constexpr size_t WS_R5 = 441 * MiB;
constexpr size_t WS_QN = WS_R5;
constexpr size_t WS_KN = WS_R5 + 18 * MiB;
constexpr size_t WS_HIN = WS_R5;
constexpr size_t WS_XBC = WS_R5 + 22 * MiB + 512 * 1024;
constexpr size_t WS_AU = WS_R5 + 49 * MiB + 512 * 1024;
constexpr size_t WS_S = WS_R5 + 70 * MiB;
constexpr size_t WS_YG = WS_S;
constexpr size_t WS_S5S = WS_R5 + 106 * MiB;
constexpr size_t WS_YCD = WS_S5S + 13 * MiB + 512 * 1024;
constexpr size_t WS_WGU = WS_R5;
constexpr size_t WS_WD = WS_R5 + 64 * MiB;
constexpr size_t WS_END = WS_YCD + 27 * MiB;
static_assert(W_END <= WS_H, "small weights fit");
static_assert(WS_AU + (size_t)24 * 576 * 768 * 2 <= WS_S && WS_XBC + (size_t)MROWS * 768 * 2 <= WS_AU && WS_S + (size_t)8 * 18 * 16 * 4096 * 4 <= WS_S5S, "R5 map");
static_assert(WS_S5S + (size_t)24 * 576 * 256 * 4 <= WS_YCD && WS_YCD + (size_t)MROWS * 768 * 2 <= WS_END && WS_WD + (size_t)32 * MiB <= WS_YCD && WS_END <= (size_t)588 * MiB, "R5 map 2");
static_assert(WS_TOT + 16384 <= WS_X && WS_ROPE + 2048 * 64 * 4 <= WS_AFF, "misc map");

constexpr int CW_BAR = 4096;

constexpr int NWAVES = 8;
constexpr int LDS_SCRATCH = 151552;
constexpr int LDSCTL_OFF = LDS_SCRATCH;
constexpr int LDS_BYTES = 155648;

#define LDS_WAIT() asm volatile("s_waitcnt lgkmcnt(0)" ::: "memory")
#define VM_WAIT() asm volatile("s_waitcnt vmcnt(0)" ::: "memory")
DI int fresh_tid() { int t = threadIdx.x; asm volatile("" : "+v"(t)); return t; }
DI unsigned f2bf(float f) { unsigned u = __builtin_bit_cast(unsigned, f); return (u + 0x7fffu + ((u >> 16) & 1u)) >> 16; }
DI unsigned pk2(float lo, float hi) { return f2bf(lo) | (f2bf(hi) << 16); }
DI float bflo(unsigned w) { return __builtin_bit_cast(float, w << 16); }
DI float bfhi(unsigned w) { return __builtin_bit_cast(float, w & 0xffff0000u); }
DI float bf2f(bf16_t h) { return __builtin_bit_cast(float, (unsigned)h << 16); }
DI float silu_f(float x) { return x / (1.f + __expf(-x)); }
DI float sigmoid_f(float x) { return 1.f / (1.f + __expf(-x)); }
DI float softplus_f(float x) { return fmaxf(x, 0.f) + log1pf(__expf(-fabsf(x))); }
DI float gelu_tanh_f(float x) { const float u = 0.7978845608028654f * (x + 0.044715f * x * x * x); const float t = 1.f - 2.f / (__expf(2.f * u) + 1.f); return 0.5f * x * (1.f + t); }
DI float wave_sum(float v) {
#pragma unroll
    for (int o = 1; o < 64; o <<= 1) v += __shfl_xor(v, o);
    return v;
}
DI void unpack8(const u32x4 w, float (&f)[8]) {
    f[0] = bflo(w.x); f[1] = bfhi(w.x); f[2] = bflo(w.y); f[3] = bfhi(w.y); f[4] = bflo(w.z); f[5] = bfhi(w.z); f[6] = bflo(w.w); f[7] = bfhi(w.w);
}
DI u32x4 pack8(const float (&f)[8]) { u32x4 w; w.x = pk2(f[0], f[1]); w.y = pk2(f[2], f[3]); w.z = pk2(f[4], f[5]); w.w = pk2(f[6], f[7]); return w; }

#define XB_TMO      128
#define XB_XCNT(j)  (256  + 64 * (j))
#define XB_XSUB(j)  (1280 + 64 * (j))
#define XB_XGEN(j)  (2304 + 64 * (j))
#define XB_TOP      3328
#define XB_TOPGEN   3392
#define XCD_BAR_WORDS 3456
#define XB_SPIN_CAP (1u << 20)
DI unsigned xb_ld(unsigned* p)              { return __hip_atomic_load(p, __ATOMIC_RELAXED, __HIP_MEMORY_SCOPE_AGENT); }
DI unsigned xb_add(unsigned* p, unsigned v) { return __hip_atomic_fetch_add(p, v, __ATOMIC_RELAXED, __HIP_MEMORY_SCOPE_AGENT); }
DI unsigned xb_xcc_id() { return (unsigned)__builtin_amdgcn_s_getreg((3 << 11) | 20) & 0xFu; }
#define XB_SPIN(cond, bar) do { unsigned _sp = 0; while (cond) { __builtin_amdgcn_s_sleep(1); \
    if ((++_sp & 255u) == 0u) { if (xb_ld(&(bar)[XB_TMO])) break; if (_sp > XB_SPIN_CAP) { atomicAdd(&(bar)[XB_TMO], 1u); break; } } } } while (0)
struct XcdBarrier { unsigned* bar; unsigned x; volatile LAS unsigned* st; };
DI XcdBarrier xcd_barrier_post(unsigned* bar, volatile LAS unsigned* st) {
    XcdBarrier b; b.bar = bar; b.x = xb_xcc_id(); b.st = st;
    if (threadIdx.x == 0) (void)xb_add(&bar[XB_XCNT(b.x)], 1u);
    return b;
}
DI void xcd_barrier_complete(unsigned* bar, unsigned x, unsigned& nloc, unsigned& nx) {
    const unsigned G = gridDim.x * gridDim.y * gridDim.z;
    unsigned sum, cnt, mine, sp = 0u;
    for (;;) {
        sum = 0u; cnt = 0u; mine = 0u;
#pragma unroll
        for (unsigned j = 0; j < 16; ++j) { const unsigned c = xb_ld(&bar[XB_XCNT(j)]); sum += c; cnt += (c > 0u) ? 1u : 0u; mine = (j == x) ? c : mine; }
        if (sum == G) break;
        __builtin_amdgcn_s_sleep(1);
        if ((++sp & 255u) == 0u) { if (xb_ld(&bar[XB_TMO])) break; if (sp > XB_SPIN_CAP) { atomicAdd(&bar[XB_TMO], 1u); break; } }
    }
    nloc = mine > 0u ? mine : 1u; nx = cnt > 0u ? cnt : 1u;
}
DI void xcd_barrier(const XcdBarrier& b) {
    asm volatile("s_waitcnt vmcnt(0)" ::: "memory");
    __syncthreads();
    if (threadIdx.x == 0) {
        unsigned* bar = b.bar;
        __builtin_amdgcn_s_waitcnt(0);
        unsigned nloc = b.st[0], nx = b.st[1];
        if (nloc == 0u) { xcd_barrier_complete(bar, b.x, nloc, nx); b.st[0] = nloc; b.st[1] = nx; }
        const unsigned old = xb_add(&bar[XB_XSUB(b.x)], 1u);
        const unsigned gen = old / nloc;
        if (old + 1u == (gen + 1u) * nloc) {
            __builtin_amdgcn_fence(__ATOMIC_RELEASE, "agent");
            asm volatile("s_waitcnt vmcnt(0)" ::: "memory");
            const unsigned og = xb_add(&bar[XB_TOP], 1u);
            const unsigned tg = og / nx;
            if (og + 1u == (tg + 1u) * nx) xb_add(&bar[XB_TOPGEN], 1u);
            else XB_SPIN(xb_ld(&bar[XB_TOPGEN]) == tg, bar);
            __builtin_amdgcn_fence(__ATOMIC_ACQUIRE, "agent");
            xb_add(&bar[XB_XGEN(b.x)], 1u);
            asm volatile("s_waitcnt vmcnt(0)" ::: "memory");
        } else {
            XB_SPIN(xb_ld(&bar[XB_XGEN(b.x)]) == gen, bar);
            __builtin_amdgcn_fence(__ATOMIC_ACQUIRE, "agent");
            asm volatile("s_waitcnt vmcnt(0)" ::: "memory");
        }
    }
    __syncthreads();
}

namespace pg8 {
constexpr int BM = 256, BK = 64, HALF = 128, HTB = HALF * BK * 2, STAGE_BYTES = 8 * HTB, NXCD = 8, WGM = 8;
__host__ __device__ __forceinline__ int lds_byte(int r, int c) { const int st = (r >> 4) * 2 + (c >> 5), rr = r & 15, cc = c & 31, ob = rr * 64 + cc * 2; return st * 1024 + (ob ^ (((ob >> 9) & 1) << 5)); }
__host__ __device__ __forceinline__ void stage_rc(int b, int& R, int& C) { const int st = b / 1024, sb = b % 1024, swz = sb ^ (((sb >> 9) & 1) << 5); R = (st >> 1) * 16 + swz / 64; C = (st & 1) * 32 + (swz % 64) / 2; }
__host__ __device__ __forceinline__ int perm32(int rho) { const int n = rho >> 4, i = rho & 15; return 8 * (i >> 2) + 4 * n + (i & 3); }

struct Unit { int arow, brow, pm, pn; };
struct Gemm { const bf16_t* A; const bf16_t* Bt; int lda, ldb, K; };

template <class Epi, class Sched, bool ALIGN_EPI = true>
DI void gemm_phase(LAS unsigned char* lds, const Gemm g, const Sched& S, const Epi& E) {
    const int tid = fresh_tid(), wid = __builtin_amdgcn_readfirstlane(tid >> 6), lane = tid & 63, wr = wid >> 2, wc = wid & 3, fr = lane & 15, fq = lane >> 4;
    const int K = g.K, nt = K / BK;
    unsigned voffA[2], voffB[2];
#pragma unroll
    for (int i = 0; i < 2; ++i) { int R, C; stage_rc(tid * 16 + i * 8192, R, C); const int Rb = Epi::PERM ? ((R & ~31) + perm32(R & 31)) : R;
        voffA[i] = (unsigned)(R * g.lda + C) * 2u; voffB[i] = (unsigned)(Rb * g.ldb + C) * 2u; }
    const size_t kstep = (size_t)(BK * 2);
    const size_t hA = (size_t)HALF * g.lda * 2, hB = (size_t)HALF * g.ldb * 2;
    const unsigned ldsw = (unsigned)wid * 1024u;
    const int aoff = lds_byte(wr * 64 + fr, fq * 8), boff = lds_byte(wc * 32 + fr, fq * 8);
#define PG8_SA(b, h) (((b) * 2 + (h)) * HTB)
#define PG8_SB(b, h) ((4 + (b) * 2 + (h)) * HTB)
#define PG8_STAGE(bufoff, gbase, voff) do { _Pragma("unroll") for (int _i = 0; _i < 2; ++_i) \
        __builtin_amdgcn_global_load_lds((const unsigned*)((const char*)(gbase) + (voff)[_i]), (LAS unsigned*)(lds + (bufoff) + ldsw + _i * 8192), 16, 0, 0); } while (0)
#define PG8_LDA(dst, b, h) do { _Pragma("unroll") for (int m = 0; m < 4; ++m) _Pragma("unroll") for (int k = 0; k < 2; ++k) dst[m][k] = *(const LAS bf16x8*)(lds + PG8_SA(b, h) + aoff + m * 2048 + k * 1024); } while (0)
#define PG8_LDB(dst, b, h) do { _Pragma("unroll") for (int n = 0; n < 2; ++n) _Pragma("unroll") for (int k = 0; k < 2; ++k) dst[n][k] = *(const LAS bf16x8*)(lds + PG8_SB(b, h) + boff + n * 2048 + k * 1024); } while (0)
#define PG8_MMA(ai, bj, At, Bt) do { __builtin_amdgcn_s_setprio(1); _Pragma("unroll") for (int m = 0; m < 4; ++m) _Pragma("unroll") for (int n = 0; n < 2; ++n) _Pragma("unroll") for (int k = 0; k < 2; ++k) \
        acc[ai][bj][m][n] = __builtin_amdgcn_mfma_f32_16x16x32_bf16(Bt[n][k], At[m][k], acc[ai][bj][m][n], 0, 0, 0); __builtin_amdgcn_s_setprio(0); } while (0)
#define PG8_WAIT_V(n) asm volatile("s_waitcnt vmcnt(" #n ")" ::: "memory")
#define PG8_WAIT_L(n) asm volatile("s_waitcnt lgkmcnt(" #n ")" ::: "memory")
#define PG8_BAR __builtin_amdgcn_s_barrier()
#define PG8_SCHED __builtin_amdgcn_sched_barrier(0)
    int ui = 0;
    Unit cur = S.next(0);
    if (cur.arow < 0) return;
    f32x4 acc[2][2][4][2];
#pragma unroll
    for (int a = 0; a < 2; ++a)
#pragma unroll
        for (int b = 0; b < 2; ++b)
#pragma unroll
            for (int m = 0; m < 4; ++m)
#pragma unroll
                for (int n = 0; n < 2; ++n) acc[a][b][m][n] = (f32x4){0.f, 0.f, 0.f, 0.f};
    bf16x8 At[4][2], B0[2][2], B1[2][2];
    const char* cA = (const char*)g.A + (size_t)cur.arow * g.lda * 2; const char* cB = (const char*)g.Bt + (size_t)cur.brow * g.ldb * 2;
    PG8_STAGE(PG8_SB(0, 0), cB, voffB); PG8_STAGE(PG8_SB(0, 1), cB + hB, voffB); PG8_STAGE(PG8_SA(0, 0), cA, voffA); PG8_STAGE(PG8_SA(0, 1), cA + hA, voffA);
    if (wr == 1) PG8_BAR;
    PG8_WAIT_V(2); PG8_BAR;
    PG8_STAGE(PG8_SB(1, 0), cB + kstep, voffB); PG8_STAGE(PG8_SA(1, 0), cA + kstep, voffA); PG8_STAGE(PG8_SB(1, 1), cB + hB + kstep, voffB);
    PG8_WAIT_V(6); PG8_BAR;
    for (;;) {
        const Unit nxt = S.next(ui + 1);
        const bool has_next = nxt.arow >= 0;
        const char* nA = has_next ? (const char*)g.A + (size_t)nxt.arow * g.lda * 2 : cA; const char* nB = has_next ? (const char*)g.Bt + (size_t)nxt.brow * g.ldb * 2 : cB;
#pragma unroll 1
        for (int t = 0; t < nt; t += 2) {
            const bool last = (t == nt - 2);
            const char* a1 = cA + (size_t)(t + 1) * kstep;
            const char* a2 = last ? nA : cA + (size_t)(t + 2) * kstep; const char* b2 = last ? nB : cB + (size_t)(t + 2) * kstep;
            const char* a3 = a2 + kstep; const char* b3 = b2 + kstep;
            PG8_LDB(B0, 0, 0); PG8_LDB(B1, 0, 1); PG8_SCHED; PG8_LDA(At, 0, 0); PG8_STAGE(PG8_SA(1, 1), a1 + hA, voffA);
            PG8_WAIT_V(8); PG8_WAIT_L(0); PG8_BAR; PG8_MMA(0, 0, At, B0); PG8_MMA(0, 1, At, B1); PG8_BAR; PG8_SCHED;
            PG8_LDA(At, 0, 1); PG8_STAGE(PG8_SB(0, 0), b2, voffB); PG8_STAGE(PG8_SB(0, 1), b2 + hB, voffB); PG8_STAGE(PG8_SA(0, 0), a2, voffA);
            PG8_WAIT_V(8); PG8_WAIT_L(0); PG8_BAR; PG8_MMA(1, 0, At, B0); PG8_MMA(1, 1, At, B1); PG8_BAR; PG8_SCHED;
            PG8_LDB(B0, 1, 0); PG8_LDB(B1, 1, 1); PG8_SCHED; PG8_LDA(At, 1, 0); PG8_STAGE(PG8_SA(0, 1), a2 + hA, voffA);
            PG8_WAIT_V(8); PG8_WAIT_L(0); PG8_BAR; PG8_MMA(0, 0, At, B0); PG8_MMA(0, 1, At, B1); PG8_BAR; PG8_SCHED;
            PG8_LDA(At, 1, 1); PG8_STAGE(PG8_SB(1, 0), b3, voffB); PG8_STAGE(PG8_SB(1, 1), b3 + hB, voffB); PG8_STAGE(PG8_SA(1, 0), a3, voffA);
            PG8_WAIT_V(8); PG8_WAIT_L(0); PG8_BAR; PG8_MMA(1, 0, At, B0); PG8_MMA(1, 1, At, B1); PG8_BAR; PG8_SCHED;
        }
        if constexpr (ALIGN_EPI) { if (wr == 0) PG8_BAR; }
        E(acc, cur, wr, wc, fr, fq);
        if (!has_next) break;
#pragma unroll
        for (int a = 0; a < 2; ++a)
#pragma unroll
            for (int b = 0; b < 2; ++b)
#pragma unroll
                for (int m = 0; m < 4; ++m)
#pragma unroll
                    for (int n = 0; n < 2; ++n) acc[a][b][m][n] = (f32x4){0.f, 0.f, 0.f, 0.f};
        cur = nxt; cA = nA; cB = nB; ++ui;
        if constexpr (ALIGN_EPI) { if (wr == 1) PG8_BAR; }
    }
    PG8_WAIT_V(0);
    if constexpr (!ALIGN_EPI) { if (wr == 0) PG8_BAR; }
    PG8_BAR;
#undef PG8_SA
#undef PG8_SB
#undef PG8_STAGE
#undef PG8_LDA
#undef PG8_LDB
#undef PG8_MMA
#undef PG8_WAIT_V
#undef PG8_WAIT_L
#undef PG8_BAR
#undef PG8_SCHED
}

struct MergeArgs { const bf16_t* YAB; const bf16_t* YCD; const bf16_t* W4T; const bf16_t* G; bf16_t* MRGB; };
template <class Sched>
DI void gemm_merge_phase(LAS unsigned char* lds, const MergeArgs M, const Sched& S) {
    const int tid = fresh_tid(), wid = __builtin_amdgcn_readfirstlane(tid >> 6), lane = tid & 63, wr = wid >> 2, wc = wid & 3, fr = lane & 15, fq = lane >> 4;
    constexpr int NT = 28, LDB = 1792;
    unsigned vA0[2], vA1[2], voffB[2];
#pragma unroll
    for (int i = 0; i < 2; ++i) { int R, C; stage_rc(tid * 16 + i * 8192, R, C); const int Rb = (R & ~31) + perm32(R & 31);
        vA0[i] = (unsigned)(R * 1024 + C) * 2u; vA1[i] = (unsigned)(R * 768 + C) * 2u; voffB[i] = (unsigned)(Rb * LDB + C) * 2u; }
    const size_t kstep = (size_t)(BK * 2);
    const unsigned ldsw = (unsigned)wid * 1024u;
    const int aoff = lds_byte(wr * 64 + fr, fq * 8), boff = lds_byte(wc * 32 + fr, fq * 8);
#define PG8_SA(b, h) (((b) * 2 + (h)) * HTB)
#define PG8_SB(b, h) ((4 + (b) * 2 + (h)) * HTB)
#define PG8_STAGEB(bufoff, gbase) do { _Pragma("unroll") for (int _i = 0; _i < 2; ++_i) \
        __builtin_amdgcn_global_load_lds((const unsigned*)((const char*)(gbase) + voffB[_i]), (LAS unsigned*)(lds + (bufoff) + ldsw + _i * 8192), 16, 0, 0); } while (0)
#define PG8_STAGEA(bufoff, arow_, tt, hf) do { const bool ab_ = (tt) < 16; \
        const char* gp_ = ab_ ? (const char*)M.YAB + ((size_t)(arow_) + (hf) * HALF) * 2048 + (size_t)(tt) * 128 : (const char*)M.YCD + ((size_t)(arow_) + (hf) * HALF) * 1536 + (size_t)((tt) - 16) * 128; \
        const unsigned o0_ = ab_ ? vA0[0] : vA1[0], o1_ = ab_ ? vA0[1] : vA1[1]; \
        __builtin_amdgcn_global_load_lds((const unsigned*)(gp_ + o0_), (LAS unsigned*)(lds + (bufoff) + ldsw), 16, 0, 0); \
        __builtin_amdgcn_global_load_lds((const unsigned*)(gp_ + o1_), (LAS unsigned*)(lds + (bufoff) + ldsw + 8192), 16, 0, 0); } while (0)
#define PG8_LDA(dst, b, h) do { _Pragma("unroll") for (int m = 0; m < 4; ++m) _Pragma("unroll") for (int k = 0; k < 2; ++k) dst[m][k] = *(const LAS bf16x8*)(lds + PG8_SA(b, h) + aoff + m * 2048 + k * 1024); } while (0)
#define PG8_LDB(dst, b, h) do { _Pragma("unroll") for (int n = 0; n < 2; ++n) _Pragma("unroll") for (int k = 0; k < 2; ++k) dst[n][k] = *(const LAS bf16x8*)(lds + PG8_SB(b, h) + boff + n * 2048 + k * 1024); } while (0)
#define PG8_MMA(ai, At, Bt) do { __builtin_amdgcn_s_setprio(1); _Pragma("unroll") for (int m = 0; m < 4; ++m) _Pragma("unroll") for (int n = 0; n < 2; ++n) _Pragma("unroll") for (int k = 0; k < 2; ++k) \
        acc[ai][0][m][n] = __builtin_amdgcn_mfma_f32_16x16x32_bf16(Bt[n][k], At[m][k], acc[ai][0][m][n], 0, 0, 0); __builtin_amdgcn_s_setprio(0); } while (0)
#define PG8_WAIT_V(n) asm volatile("s_waitcnt vmcnt(" #n ")" ::: "memory")
#define PG8_WAIT_L(n) asm volatile("s_waitcnt lgkmcnt(" #n ")" ::: "memory")
#define PG8_BAR __builtin_amdgcn_s_barrier()
#define PG8_SCHED __builtin_amdgcn_sched_barrier(0)
    int ui = 0;
    Unit cur = S.next(0);
    if (cur.arow < 0) return;
    f32x4 acc[2][2][4][2];
#pragma unroll
    for (int a = 0; a < 2; ++a)
#pragma unroll
        for (int b = 0; b < 2; ++b)
#pragma unroll
            for (int m = 0; m < 4; ++m)
#pragma unroll
                for (int n = 0; n < 2; ++n) acc[a][b][m][n] = (f32x4){0.f, 0.f, 0.f, 0.f};
    bf16x8 At[4][2], B0[2][2];
    const char* cB = (const char*)M.W4T + (size_t)cur.brow * LDB * 2;
    int carow = cur.arow;
    PG8_STAGEB(PG8_SB(0, 0), cB); PG8_STAGEA(PG8_SA(0, 0), carow, 0, 0); PG8_STAGEA(PG8_SA(0, 1), carow, 0, 1);
    if (wr == 1) PG8_BAR;
    PG8_WAIT_V(2); PG8_BAR;
    PG8_STAGEB(PG8_SB(1, 0), cB + kstep); PG8_STAGEA(PG8_SA(1, 0), carow, 1, 0);
    PG8_WAIT_V(4); PG8_BAR;
    for (;;) {
        const Unit nxt = S.next(ui + 1);
        const bool has_next = nxt.arow >= 0;
        const int narow = has_next ? nxt.arow : carow; const char* nB = has_next ? (const char*)M.W4T + (size_t)nxt.brow * LDB * 2 : cB;
#pragma unroll 1
        for (int t = 0; t < NT; t += 2) {
            const bool last = (t == NT - 2);
            const bool fold_it = (t == 6 || t == 14 || t == 20 || t == 26);
            u32x4 gw0[4]; int fseg = 0;
            if (fold_it) {
                const int seg = (t == 6) ? 0 : (t == 14) ? 1 : (t == 20) ? 2 : 3; fseg = seg;
                int row0 = cur.arow + wr * 64 + fr, col = cur.pn * 128 + wc * 32 + 8 * fq;
                asm volatile("" : "+v"(row0), "+v"(col));
#pragma unroll
                for (int m = 0; m < 4; ++m) gw0[m] = *(const u32x4*)(M.G + (size_t)(row0 + m * 16) * PG_W + seg * 1024 + col);
            }
            const int t2 = last ? 0 : t + 2, t3 = t2 + 1; const int arow2 = last ? narow : carow;
            const char* b2 = last ? nB : cB + (size_t)(t + 2) * kstep; const char* b3 = b2 + kstep;
            PG8_LDB(B0, 0, 0); PG8_SCHED; PG8_LDA(At, 0, 0); PG8_STAGEA(PG8_SA(1, 1), carow, t + 1, 1);
            PG8_WAIT_V(6); PG8_WAIT_L(0); PG8_BAR; PG8_MMA(0, At, B0); PG8_BAR; PG8_SCHED;
            PG8_LDA(At, 0, 1); PG8_STAGEB(PG8_SB(0, 0), b2); PG8_STAGEA(PG8_SA(0, 0), arow2, t2, 0);
            PG8_WAIT_V(6); PG8_WAIT_L(0); PG8_BAR; PG8_MMA(1, At, B0); PG8_BAR; PG8_SCHED;
            PG8_LDB(B0, 1, 0); PG8_SCHED; PG8_LDA(At, 1, 0); PG8_STAGEA(PG8_SA(0, 1), arow2, t2, 1);
            PG8_WAIT_V(6); PG8_WAIT_L(0); PG8_BAR; PG8_MMA(0, At, B0); PG8_BAR; PG8_SCHED;
            PG8_LDA(At, 1, 1); PG8_STAGEB(PG8_SB(1, 0), b3); PG8_STAGEA(PG8_SA(1, 0), arow2, t3, 0);
            PG8_WAIT_V(6); PG8_WAIT_L(0); PG8_BAR; PG8_MMA(1, At, B0); PG8_BAR; PG8_SCHED;
            if (fold_it) {
                u32x4 gw1[4];
                { int row1 = cur.arow + 128 + wr * 64 + fr, col = cur.pn * 128 + wc * 32 + 8 * fq;
                  asm volatile("" : "+v"(row1), "+v"(col));
#pragma unroll
                  for (int m = 0; m < 4; ++m) gw1[m] = *(const u32x4*)(M.G + (size_t)(row1 + m * 16) * PG_W + fseg * 1024 + col); }
#pragma unroll
                for (int ai = 0; ai < 2; ++ai)
#pragma unroll
                    for (int m = 0; m < 4; ++m) {
                        float gf[8]; unpack8(ai == 0 ? gw0[m] : gw1[m], gf);
#pragma unroll
                        for (int k = 0; k < 4; ++k) { acc[ai][1][m][0][k] += acc[ai][0][m][0][k] * sigmoid_f(gf[k]); acc[ai][1][m][1][k] += acc[ai][0][m][1][k] * sigmoid_f(gf[4 + k]); }
                        acc[ai][0][m][0] = (f32x4){0.f, 0.f, 0.f, 0.f}; acc[ai][0][m][1] = (f32x4){0.f, 0.f, 0.f, 0.f}; }
                if (t == NT - 2) {
                    int row0 = cur.arow + wr * 64 + fr, col = cur.pn * 128 + wc * 32 + 8 * fq;
                    asm volatile("" : "+v"(row0), "+v"(col));
#pragma unroll
                    for (int ai = 0; ai < 2; ++ai)
#pragma unroll
                        for (int m = 0; m < 4; ++m) { const f32x4 v0 = acc[ai][1][m][0], v1 = acc[ai][1][m][1];
                            u32x4 w; w.x = pk2(v0[0], v0[1]); w.y = pk2(v0[2], v0[3]); w.z = pk2(v1[0], v1[1]); w.w = pk2(v1[2], v1[3]);
                            *(u32x4*)(M.MRGB + (size_t)(row0 + ai * 128 + m * 16) * 1024 + col) = w;
                            acc[ai][1][m][0] = (f32x4){0.f, 0.f, 0.f, 0.f}; acc[ai][1][m][1] = (f32x4){0.f, 0.f, 0.f, 0.f}; } }
            }
        }
        if (!has_next) break;
        cur = nxt; carow = narow; cB = nB; ++ui;
    }
    PG8_WAIT_V(0);
    if (wr == 0) PG8_BAR;
    PG8_BAR;
#undef PG8_SA
#undef PG8_SB
#undef PG8_STAGEA
#undef PG8_STAGEB
#undef PG8_LDA
#undef PG8_LDB
#undef PG8_MMA
#undef PG8_WAIT_V
#undef PG8_WAIT_L
#undef PG8_BAR
#undef PG8_SCHED
}
}

using pg8::Unit;

struct EpiProj {
    static constexpr bool PERM = true;
    bf16_t* O0; int ld0; int split_pn; bf16_t* O1; int ld1;
    DI void operator()(const f32x4 (&acc)[2][2][4][2], const Unit& u, int wr, int wc, int fr, int fq) const {
        bf16_t* base; int ld, ct;
        if (u.pn < split_pn) { base = O0; ld = ld0; ct = u.pn * 256; } else { base = O1; ld = ld1; ct = (u.pn - split_pn) * 256; }
        const int row0 = u.arow + wr * 64 + fr, col0 = ct + wc * 32 + 8 * fq;
#pragma unroll
        for (int ai = 0; ai < 2; ++ai)
#pragma unroll
            for (int m = 0; m < 4; ++m) { bf16_t* rowp = base + (size_t)(row0 + ai * 128 + m * 16) * ld + col0;
#pragma unroll
                for (int bj = 0; bj < 2; ++bj) { const f32x4 v0 = acc[ai][bj][m][0], v1 = acc[ai][bj][m][1];
                    u32x4 w; w.x = pk2(v0[0], v0[1]); w.y = pk2(v0[2], v0[3]); w.z = pk2(v1[0], v1[1]); w.w = pk2(v1[2], v1[3]);
                    *(u32x4*)(rowp + bj * 128) = w; } }
    }
};

struct EpiWout {
    static constexpr bool PERM = true;
    bf16_t* Y;
    DI void operator()(const f32x4 (&acc)[2][2][4][2], const Unit& u, int wr, int wc, int fr, int fq) const {
        const int row0 = u.arow + wr * 64 + fr, col0 = u.pn * 256 + wc * 32 + 8 * fq;
#pragma unroll
        for (int ai = 0; ai < 2; ++ai)
#pragma unroll
            for (int m = 0; m < 4; ++m) { bf16_t* rowp = Y + (size_t)(row0 + ai * 128 + m * 16) * 1024 + col0;
#pragma unroll
                for (int bj = 0; bj < 2; ++bj) { const f32x4 v0 = acc[ai][bj][m][0], v1 = acc[ai][bj][m][1];
                    u32x4 w; w.x = pk2(v0[0], v0[1]); w.y = pk2(v0[2], v0[3]); w.z = pk2(v1[0], v1[1]); w.w = pk2(v1[2], v1[3]);
                    *(u32x4*)(rowp + bj * 128) = w; } }
    }
};

struct EpiGlu {
    static constexpr bool PERM = true;
    const bf16_t* YG; bf16_t* YC; const float* bglu;
    DI void operator()(const f32x4 (&acc)[2][2][4][2], const Unit& u, int wr, int wc, int fr, int fq) const {
        const int row0 = u.arow + wr * 64 + fr, col0 = u.pn * 256 + wc * 32 + 8 * fq;
#pragma unroll
        for (int bj = 0; bj < 2; ++bj) { const int col = col0 + bj * 128; if (u.pn == 1 && bj == 1) continue;
            const f32x4 b0 = *(const f32x4*)(bglu + col), b1 = *(const f32x4*)(bglu + col + 4);
#pragma unroll
            for (int ai = 0; ai < 2; ++ai) { u32x4 yw[4];
#pragma unroll
                for (int m = 0; m < 4; ++m) yw[m] = *(const u32x4*)(YG + (size_t)(row0 + ai * 128 + m * 16) * 384 + col);
#pragma unroll
                for (int m = 0; m < 4; ++m) { float y[8]; unpack8(yw[m], y);
                    const f32x4 a0 = acc[ai][bj][m][0] + b0, a1 = acc[ai][bj][m][1] + b1;
                    float o[8];
#pragma unroll
                    for (int k = 0; k < 4; ++k) { o[k] = y[k] * sigmoid_f(a0[k]); o[4 + k] = y[4 + k] * sigmoid_f(a1[k]); }
                    *(u32x4*)(YC + (size_t)(row0 + ai * 128 + m * 16) * 768 + col) = pack8(o); }
                __builtin_amdgcn_sched_barrier(0); } }
    }
};

struct EpiS5S {
    static constexpr bool PERM = true;
    float* S;
    DI void operator()(const f32x4 (&acc)[2][2][4][2], const Unit& u, int wr, int wc, int fr, int fq) const {
        const int m0 = u.pn * 256 + wr * 64 + fr, col0 = wc * 32 + 8 * fq;
#pragma unroll
        for (int ai = 0; ai < 2; ++ai)
#pragma unroll
            for (int m = 0; m < 4; ++m) { const int mm = m0 + ai * 128 + m * 16; if (u.pn == 2 && (ai == 1 || wr == 1)) continue;
                float* p = S + ((size_t)u.pm * 576 + mm) * 256 + col0;
#pragma unroll
                for (int bj = 0; bj < 2; ++bj) { *(f32x4*)(p + bj * 128) = acc[ai][bj][m][0]; *(f32x4*)(p + bj * 128 + 4) = acc[ai][bj][m][1]; } }
    }
};

struct EpiS5Y {
    static constexpr bool PERM = true;
    const bf16_t* AU; bf16_t* YG; const float* dsk;
    DI void operator()(const f32x4 (&acc)[2][2][4][2], const Unit& u, int wr, int wc, int fr, int fq) const {
        const int g = u.pm / 3, j = u.pm % 3;
        const int m0 = j * 256 + wr * 64 + fr, n0 = u.pn * 256 + wc * 32 + 8 * fq;
#pragma unroll
        for (int bj = 0; bj < 2; ++bj) { const int n = n0 + bj * 128, i = n >> 4, a0 = n & 15;
            const f32x4 d0 = *(const f32x4*)(dsk + g * 16 + a0), d1 = *(const f32x4*)(dsk + g * 16 + a0 + 4);
#pragma unroll
            for (int ai = 0; ai < 2; ++ai) { if (j == 2 && (ai == 1 || wr == 1)) continue;
                u32x4 uw[4];
#pragma unroll
                for (int m = 0; m < 4; ++m) uw[m] = *(const u32x4*)(AU + ((size_t)g * 576 + m0 + ai * 128 + m * 16) * 768 + n);
#pragma unroll
                for (int m = 0; m < 4; ++m) { const int mm = m0 + ai * 128 + m * 16; float uu[8]; unpack8(uw[m], uu);
                    const f32x4 v0 = acc[ai][bj][m][0], v1 = acc[ai][bj][m][1];
                    float o[8];
#pragma unroll
                    for (int k = 0; k < 4; ++k) { o[k] = gelu_tanh_f(v0[k] + d0[k] * uu[k]); o[4 + k] = gelu_tanh_f(v1[k] + d1[k] * uu[4 + k]); }
                    *(u32x4*)(YG + (size_t)(mm * 32 + i) * 384 + g * 16 + a0) = pack8(o); }
                __builtin_amdgcn_sched_barrier(0); } }
    }
};

struct EpiUp {
    static constexpr bool PERM = true;
    bf16_t* HID;
    DI void operator()(const f32x4 (&acc)[2][2][4][2], const Unit& u, int wr, int wc, int fr, int fq) const {
        const int row0 = u.arow + wr * 64 + fr, col0 = u.pn * 128 + wc * 32 + 8 * fq;
#pragma unroll
        for (int ai = 0; ai < 2; ++ai)
#pragma unroll
            for (int m = 0; m < 4; ++m) { const f32x4 g0 = acc[ai][0][m][0], g1 = acc[ai][0][m][1], u0 = acc[ai][1][m][0], u1 = acc[ai][1][m][1];
                float o[8];
#pragma unroll
                for (int k = 0; k < 4; ++k) { o[k] = silu_f(g0[k]) * u0[k]; o[4 + k] = silu_f(g1[k]) * u1[k]; }
                *(u32x4*)(HID + (size_t)(row0 + ai * 128 + m * 16) * 1024 + col0) = pack8(o); }
    }
};

struct EpiDown {
    static constexpr bool PERM = true;
    bf16_t* YE; const float* GV;
    DI void operator()(const f32x4 (&acc)[2][2][4][2], const Unit& u, int wr, int wc, int fr, int fq) const {
        const int row0 = u.arow + wr * 64 + fr, col0 = u.pn * 256 + wc * 32 + 8 * fq;
#pragma unroll
        for (int ai = 0; ai < 2; ++ai)
#pragma unroll
            for (int m = 0; m < 4; ++m) { const int row = row0 + ai * 128 + m * 16; const float gv = GV[row];
#pragma unroll
                for (int bj = 0; bj < 2; ++bj) { const f32x4 v0 = acc[ai][bj][m][0] * gv, v1 = acc[ai][bj][m][1] * gv;
                    u32x4 w; w.x = pk2(v0[0], v0[1]); w.y = pk2(v0[2], v0[3]); w.z = pk2(v1[0], v1[1]); w.w = pk2(v1[2], v1[3]);
                    *(u32x4*)(YE + (size_t)row * 1024 + col0 + bj * 128) = w; } }
    }
};

DI Unit mk_unit(int arow, int brow, int pm, int pn) { Unit u; u.arow = arow; u.brow = brow; u.pm = pm; u.pn = pn; return u; }
struct RowSkipOrder {
    int nN, G, c, skipctx, keep_lo, keep_hi, nmain, total, bstep;
    DI void init(int N, int G_, int c_, int skipctx_, int keep_lo_, int keep_hi_, int bstep_ = 256) { bstep = bstep_; nN = N / bstep_; G = G_; c = c_; skipctx = skipctx_; keep_lo = keep_lo_; keep_hi = keep_hi_;
        nmain = (skipctx ? 64 : 72) * nN; total = nmain + (skipctx ? 8 * (keep_hi - keep_lo) : 0); }
    DI Unit next(int i) const {
        const int L0 = i * G + c; if (L0 >= total) return mk_unit(-1, 0, 0, 0);
        const int q = total / 8, r = total % 8, xcd = L0 % 8, off = L0 / 8;
        const int L = (xcd < r ? xcd * (q + 1) : r * (q + 1) + (xcd - r) * q) + off;
        const int nig = 8 * nN, gid = L / nig, rr = L % nig, lt = gid * 8 + (rr % 8);
        const int pm_main = skipctx ? ((lt / 8) * 9 + 1 + (lt % 8)) : lt, pn_main = rr / 8;
        const int Lc = L - nmain, pm_ctx = (Lc % 8) * 9, pn_ctx = keep_lo + Lc / 8;
        const bool main = L < nmain;
        const int pm = main ? pm_main : pm_ctx, pn = main ? pn_main : pn_ctx;
        return mk_unit(pm * 256, pn * bstep, pm, pn);
    }
};
DI int xcd_remap(int L0, int total) { const int q = total / 8, r = total % 8, xcd = L0 % 8, off = L0 / 8; return (xcd < r ? xcd * (q + 1) : r * (q + 1) + (xcd - r) * q) + off; }
struct MergeOrder {
    int G, c, skipctx, total;
    DI void init(int G_, int c_, int skipctx_) { G = G_; c = c_; skipctx = skipctx_; total = (skipctx ? 64 : 72) * 8; }
    DI Unit next(int i) const {
        const int L0 = i * G + c; if (L0 >= total) return mk_unit(-1, 0, 0, 0);
        const int L = xcd_remap(L0, total), lt = L >> 3, pn = L & 7, pm = skipctx ? ((lt / 8) * 9 + 1 + (lt % 8)) : lt;
        return mk_unit(pm * 256, pn * 128, pm, pn);
    }
};
struct OrderS5S { int G, c; DI Unit next(int i) const { const int L = i * G + c; if (L >= 72) return mk_unit(-1, 0, 0, 0); const int g = L / 3, j = L % 3; return mk_unit(g * 576 + j * 256, g * 256, g, j); } };
struct OrderS5Y { int G, c; DI Unit next(int i) const { const int L = i * G + c; if (L >= 144) return mk_unit(-1, 0, 0, 0); const int g = L / 6, r = L % 6, j = r >> 1, nh = r & 1;
    return mk_unit(g * 576 + j * 256, g * 512 + nh * 256, g * 3 + j, nh); } };
struct OrderUp { int G, c, nJ; DI Unit next(int i) const { const int L0 = i * G + c, total = 16 * nJ * 8; if (L0 >= total) return mk_unit(-1, 0, 0, 0); const int L = xcd_remap(L0, total), n = L & 7, t = L >> 3, jt = t % nJ, e = t / nJ;
    return mk_unit(e * EROWS + jt * 256, e * 2048 + n * 256, e, n); } };
struct OrderDown { int G, c, nJ; DI Unit next(int i) const { const int L0 = i * G + c, total = 16 * nJ * 4; if (L0 >= total) return mk_unit(-1, 0, 0, 0); const int L = xcd_remap(L0, total), n = L & 3, t = L >> 2, jt = t % nJ, e = t / nJ;
    return mk_unit(e * EROWS + jt * 256, e * 1024 + n * 256, e, n); } };

struct Frame {
    LAS unsigned char* lds;
    int tid, lane, wave, G, vcu, gw, NGW;
};

template <class DstRow>
DI void tr_item(const float* __restrict__ W, int ldw, int nvalid, int nstore, int K, bf16_t* __restrict__ WT, int k0, int n0, const DstRow& drow, const float* __restrict__ kscale, LAS float* scr  , int lane, int kofs = 0) {
    const int c4 = (lane & 15) * 4, r0 = lane >> 4;
    f32x4 v[16];
#pragma unroll
    for (int i = 0; i < 16; ++i) { const int kk = 4 * i + r0; v[i] = (n0 + c4 < nvalid) ? *(const f32x4*)(W + (size_t)(k0 + kk) * ldw + n0 + c4) : (f32x4){0.f, 0.f, 0.f, 0.f}; }
#pragma unroll
    for (int i = 0; i < 16; ++i) { const int kk = 4 * i + r0; f32x4 x = v[i]; if (kscale) x = x * kscale[k0 + kk];
        LAS float* d = scr + kk * 65 + c4; d[0] = x[0]; d[1] = x[1]; d[2] = x[2]; d[3] = x[3]; }
    LDS_WAIT(); asm volatile("" ::: "memory");
    const int c = lane & 7;
#pragma unroll
    for (int j = 0; j < 8; ++j) { const int n = (lane >> 3) + 8 * j; const LAS float* s = scr + (8 * c) * 65 + n;
        u32x4 o; o.x = pk2(s[0 * 65], s[1 * 65]); o.y = pk2(s[2 * 65], s[3 * 65]); o.z = pk2(s[4 * 65], s[5 * 65]); o.w = pk2(s[6 * 65], s[7 * 65]);
        if (n0 + n < nstore) *(u32x4*)(WT + (size_t)drow(n0 + n) * K + kofs + k0 + 8 * c) = o; }
    LDS_WAIT(); asm volatile("" ::: "memory");
}
struct DrIdent { int off; DI int operator()(int n) const { return off + n; } };
struct DrWin { DI int operator()(int n) const { return n < C_G ? n : n + (PA_W - C_G); } };
struct DrGU { int base; DI int operator()(int f) const { return base + (f >> 7) * 256 + (f & 127); } };

struct LayerIn {
    const float *w_in, *q_norm_g, *k_norm_g, *ssd_conv_w, *ssd_conv_b, *ssd_dt_bias, *ssd_a_log, *ssd_d, *ssd_norm_g;
    const float *s5_lre, *s5_lim, *s5_lstep, *s5_bre, *s5_bim, *s5_cre, *s5_cim, *s5_d, *s5_wglu, *s5_bglu, *sc_conv_w;
    const float *w_br_attn, *w_br_ssd, *w_br_s5, *w_br_sc, *w_out, *w_router, *w_gate, *w_up, *w_down, *norm_mix_g, *norm_ffn_g;
};

DI void prep_small_weights(const Frame& F, const LayerIn& P, unsigned char* ws) {
    LAS float* scr = (LAS float*)(F.lds + F.wave * 16896);
    bf16_t* WIN = (bf16_t*)(ws + W_WIN);
    constexpr int NB_WIN = (NIN + 63) / 64;
    constexpr int I_WIN = 16 * NB_WIN, I_PAD = 62, I_BA = 8 * 16, I_BB = 8 * 16, I_BC = 6 * 16, I_BD = 6 * 16, I_OUT = 16 * 16, I_GLU = 6 * 8;
    constexpr int NIT = I_WIN + I_PAD + I_BA + I_BB + I_BC + I_BD + I_OUT + I_GLU;
    for (int it = F.gw; it < NIT; it += F.NGW) {
        int r = it;
        if (r < I_WIN) { const int kb = r / NB_WIN, nb = r % NB_WIN; tr_item(P.w_in, NIN, NIN, NIN, 1024, WIN, kb * 64, nb * 64, DrWin{}, nullptr, scr, F.lane); continue; } r -= I_WIN;
        if (r < I_PAD) {
#pragma unroll
            for (int j = 0; j < 8; ++j) { const int idx = j * 64 + F.lane, row = C_G + r * 4 + (idx >> 7), ch = idx & 127; *(u32x4*)(WIN + (size_t)row * 1024 + ch * 8) = (u32x4){0u, 0u, 0u, 0u}; }
            continue; } r -= I_PAD;
        if (r < I_BA) { tr_item(P.w_br_attn, 1024, 1024, 1024, 1792, (bf16_t*)(ws + W_BR4), (r / 16) * 64, (r % 16) * 64, DrIdent{0}, nullptr, scr, F.lane, 0); continue; } r -= I_BA;
        if (r < I_BB) { tr_item(P.w_br_ssd, 1024, 1024, 1024, 1792, (bf16_t*)(ws + W_BR4), (r / 16) * 64, (r % 16) * 64, DrIdent{0}, P.ssd_norm_g, scr, F.lane, 512); continue; } r -= I_BB;
        if (r < I_BC) { tr_item(P.w_br_s5, 1024, 1024, 1024, 1792, (bf16_t*)(ws + W_BR4), (r / 16) * 64, (r % 16) * 64, DrIdent{0}, nullptr, scr, F.lane, 1024); continue; } r -= I_BC;
        if (r < I_BD) { tr_item(P.w_br_sc, 1024, 1024, 1024, 1792, (bf16_t*)(ws + W_BR4), (r / 16) * 64, (r % 16) * 64, DrIdent{0}, nullptr, scr, F.lane, 1408); continue; } r -= I_BD;
        if (r < I_OUT) { tr_item(P.w_out, 1024, 1024, 1024, 1024, (bf16_t*)(ws + W_OUT), (r / 16) * 64, (r % 16) * 64, DrIdent{0}, nullptr, scr, F.lane); continue; } r -= I_OUT;
        tr_item(P.s5_wglu, 384, 384, 512, 384, (bf16_t*)(ws + W_GLU), (r / 8) * 64, (r % 8) * 64, DrIdent{0}, nullptr, scr, F.lane);
    }
}
DI void prep_expert_weights(const Frame& F, const LayerIn& P, unsigned char* ws, int first_wg, int item_lo, int item_hi) {
    if ((int)blockIdx.x < first_wg) return;
    LAS float* scr = (LAS float*)(F.lds + F.wave * 16896);
    constexpr int PER = 16 * 16;
    for (int it = item_lo + ((int)blockIdx.x - first_wg) * NWAVES + F.wave; it < item_hi; it += (F.G - first_wg) * NWAVES) {
        const int which = it / (16 * PER), r = it % (16 * PER), e = r / PER, q = r % PER, k0 = (q / 16) * 64, n0 = (q % 16) * 64;
        if (which == 0) tr_item(P.w_gate + (size_t)e * 1024 * 1024, 1024, 1024, 1024, 1024, (bf16_t*)(ws + WS_WGU), k0, n0, DrGU{e * 2048}, nullptr, scr, F.lane);
        else if (which == 1) tr_item(P.w_up + (size_t)e * 1024 * 1024, 1024, 1024, 1024, 1024, (bf16_t*)(ws + WS_WGU), k0, n0, DrGU{e * 2048 + 128}, nullptr, scr, F.lane);
        else tr_item(P.w_down + (size_t)e * 1024 * 1024, 1024, 1024, 1024, 1024, (bf16_t*)(ws + WS_WD), k0, n0, DrIdent{e * 1024}, nullptr, scr, F.lane);
    }
}
constexpr int EXPERT_W_ITEMS = 3 * 16 * 16 * 16;

DI void prep_mod(const Frame& F, const float* __restrict__ c, const float* __restrict__ c_ctx, const float* __restrict__ w_mod, const float* __restrict__ b_mod, float* __restrict__ MOD) {
    if ((int)blockIdx.x >= 2 * 96) return;
    LAS float* sc = (LAS float*)F.lds;
    LAS float* red = sc + 9 * 1024;
    for (int o = F.tid; o < 9 * 1024; o += 512) { const float cv = (o < 8 * 1024) ? c[o] : c_ctx[o - 8 * 1024]; sc[o] = silu_f(cv); }
    __syncthreads();
    for (int it = blockIdx.x; it < 2 * 96; it += F.G) {
        const int l = it / 96, cb = it % 96, n = cb * 64 + F.lane;
        const float* W = w_mod + (size_t)l * 1024 * 6144;
        float acc[9];
#pragma unroll
        for (int r = 0; r < 9; ++r) acc[r] = 0.f;
        const int kbeg = F.wave * 128;
#pragma unroll 1
        for (int k8 = 0; k8 < 128; k8 += 16) { float w[16];
#pragma unroll
            for (int j = 0; j < 16; ++j) w[j] = W[(size_t)(kbeg + k8 + j) * 6144 + n];
#pragma unroll
            for (int j = 0; j < 16; ++j)
#pragma unroll
                for (int r = 0; r < 9; ++r) acc[r] += sc[r * 1024 + kbeg + k8 + j] * w[j]; }
#pragma unroll
        for (int r = 0; r < 9; ++r) red[(F.wave * 9 + r) * 64 + F.lane] = acc[r];
        __syncthreads();
        for (int o = F.tid; o < 9 * 64; o += 512) { const int r = o >> 6, ln = o & 63; float s = 0.f;
#pragma unroll
            for (int w = 0; w < 8; ++w) s += red[(w * 9 + r) * 64 + ln];
            MOD[((size_t)l * 9 + r) * 6144 + cb * 64 + ln] = s + b_mod[l * 6144 + cb * 64 + ln]; }
        __syncthreads();
    }
    __syncthreads();
}
DI void prep_rope(const Frame& F, float* ROPE) {
    for (int idx = blockIdx.x * 512 + F.tid; idx < 2048 * 32; idx += F.G * 512) {
        const int t = idx >> 5, j = idx & 31, i = j & 15;
        const float inv = powf(10000.f, -(float)(2 * i) / 32.f);
        const float pos = (j < 16) ? (float)(t >> 6) : (float)(t & 63);
        const float a = pos * inv;
        ROPE[t * 64 + j] = cosf(a); ROPE[t * 64 + 32 + j] = sinf(a);
    }
}

DI void prep_s5(const Frame& F, const LayerIn& P, unsigned char* ws) {
    if ((int)blockIdx.x >= 96) return;
    LAS float* pw = (LAS float*)F.lds;
    LAS float* bb = pw + 8448;
    LAS float* Kt = bb + 4096;
    LAS float* cc = Kt + 16896;
    LAS float* prm = cc + 2048;
    for (int it = blockIdx.x; it < 96; it += F.G) {
        const int g = it >> 2, qt = it & 3;
        for (int o = F.tid; o < 2048; o += 512) cc[o] = (o < 1024) ? P.s5_cre[(size_t)g * 1024 + o] : P.s5_cim[(size_t)g * 1024 + o - 1024];
        for (int o = F.tid; o < 2048; o += 512) prm[264 + o] = (o < 1024) ? P.s5_bre[(size_t)g * 1024 + o] : P.s5_bim[(size_t)g * 1024 + o - 1024];
        if (F.tid < 256) { const int d = (F.tid >> 6) & 1, p = F.tid & 63; prm[F.tid] = (F.tid < 128) ? P.s5_lre[(d * 24 + g) * 64 + p] : P.s5_lim[(d * 24 + g) * 64 + p]; }
        if (F.tid < 2) prm[256 + F.tid] = __expf(P.s5_lstep[F.tid * 24 + g]);
        __syncthreads();
        if (F.tid < 128) { const int d = F.tid >> 6, p = F.tid & 63;
            const float step = prm[256 + d], lr = prm[d * 64 + p], li = prm[128 + d * 64 + p];
            const float th = li * step, sh = sinf(0.5f * th);
            const float mag = expf(lr * step), abi = mag * sinf(th);
            const float nr = expm1f(lr * step) - 2.f * mag * sh * sh, ni = abi;
            const float den = lr * lr + li * li;
            const float cr = (nr * lr + ni * li) / den, ci = (ni * lr - nr * li) / den;
#pragma unroll
            for (int j = 0; j < 16; ++j) { const float br = prm[264 + p * 16 + j], bi = prm[264 + 1024 + p * 16 + j];
                bb[((d * 64 + p) * 16 + j) * 2 + 0] = cr * br - ci * bi; bb[((d * 64 + p) * 16 + j) * 2 + 1] = cr * bi + ci * br; } }
        for (int o = F.tid; o < 2 * 64 * 33; o += 512) { const int dp = o / 33, tau = o % 33, d = dp >> 6, p = dp & 63;
            const float step = prm[256 + d], lr = prm[d * 64 + p], li = prm[128 + d * 64 + p];
            const float m = expf(lr * step * (float)tau), a = li * step * (float)tau;
            pw[o * 2 + 0] = m * cosf(a); pw[o * 2 + 1] = m * sinf(a); }
        __syncthreads();
        for (int o = F.tid; o < 1024; o += 512) { const int d = o >> 9, a = (o >> 5) & 15, tau = o & 31; float s[16];
#pragma unroll
            for (int b_ = 0; b_ < 16; ++b_) s[b_] = 0.f;
            for (int p = 0; p < 64; ++p) { const float cre = cc[a * 64 + p], cim = cc[1024 + a * 64 + p];
                const f32x2 lp = *(const LAS f32x2*)(pw + ((d * 64 + p) * 33 + tau) * 2);
                const float wr_ = cre * lp[0] - cim * lp[1], wi_ = cre * lp[1] + cim * lp[0];
                const LAS f32x4* bp = (const LAS f32x4*)(bb + (d * 64 + p) * 32);
#pragma unroll
                for (int q4 = 0; q4 < 8; ++q4) { const f32x4 t = bp[q4]; s[2 * q4] += wr_ * t[0] - wi_ * t[1]; s[2 * q4 + 1] += wr_ * t[2] - wi_ * t[3]; } }
#pragma unroll
            for (int b_ = 0; b_ < 16; ++b_) Kt[((d * 16 + a) * 16 + b_) * 33 + tau] = s[b_]; }
        __syncthreads();
        bf16_t* TQ = (bf16_t*)(ws + W_TQ) + (size_t)g * 512 * 768;
        for (int o = F.tid; o < 128 * 64; o += 512) { const int row = qt * 128 + (o >> 6), ch = o & 63, i = row >> 4, a = row & 15, b0 = (ch >> 5) * 8, j = ch & 31; float v[8];
#pragma unroll
            for (int k = 0; k < 8; ++k) { float s_ = 0.f;
                if (j <= i) s_ += Kt[((0 * 16 + a) * 16 + b0 + k) * 33 + (i - j)];
                if (j >= i) s_ += Kt[((1 * 16 + a) * 16 + b0 + k) * 33 + (j - i)];
                v[k] = s_; }
            *(u32x4*)(TQ + (size_t)row * 768 + j * 16 + b0) = pack8(v); }
        for (int o = F.tid; o < 128 * 128; o += 512) { const int row = qt * 128 + (o >> 7), dp = o & 127, d = dp >> 6, p = dp & 63, i = row >> 4, a = row & 15; const int tau = d == 0 ? (i + 1) : (32 - i);
            const float cre = cc[a * 64 + p], cim = cc[1024 + a * 64 + p];
            const f32x2 lp = *(const LAS f32x2*)(pw + ((d * 64 + p) * 33 + tau) * 2);
            TQ[(size_t)row * 768 + 512 + d * 128 + p] = (bf16_t)f2bf(cre * lp[0] - cim * lp[1]);
            TQ[(size_t)row * 768 + 512 + d * 128 + 64 + p] = (bf16_t)f2bf(-(cre * lp[1] + cim * lp[0])); }
        bf16_t* PP = (bf16_t*)(ws + W_P) + (size_t)g * 256 * 512;
        for (int o = F.tid; o < 2 * 16 * 32; o += 512) { const int d = o >> 9, p = qt * 16 + ((o >> 5) & 15), j = o & 31; const int tau = d == 0 ? (31 - j) : j;
            const f32x2 lp = *(const LAS f32x2*)(pw + ((d * 64 + p) * 33 + tau) * 2);
            const LAS f32x4* bp = (const LAS f32x4*)(bb + (d * 64 + p) * 32);
            float vr[16], vi[16];
#pragma unroll
            for (int q4 = 0; q4 < 8; ++q4) { const f32x4 t = bp[q4];
                vr[2 * q4] = lp[0] * t[0] - lp[1] * t[1]; vi[2 * q4] = lp[0] * t[1] + lp[1] * t[0];
                vr[2 * q4 + 1] = lp[0] * t[2] - lp[1] * t[3]; vi[2 * q4 + 1] = lp[0] * t[3] + lp[1] * t[2]; }
            float h0[8], h1[8];
#pragma unroll
            for (int k = 0; k < 8; ++k) { h0[k] = vr[k]; h1[k] = vr[8 + k]; }
            bf16_t* pr = PP + (size_t)(d * 128 + p) * 512 + j * 16;
            *(u32x4*)pr = pack8(h0); *(u32x4*)(pr + 8) = pack8(h1);
#pragma unroll
            for (int k = 0; k < 8; ++k) { h0[k] = vi[k]; h1[k] = vi[8 + k]; }
            bf16_t* pi = PP + (size_t)(d * 128 + 64 + p) * 512 + j * 16;
            *(u32x4*)pi = pack8(h0); *(u32x4*)(pi + 8) = pack8(h1); }
        __syncthreads();
    }
}

struct RowCtx { int R, b, p, isctx, mrow; };
DI RowCtx row_ctx(int R) { RowCtx r; r.R = R; r.b = R / PB; r.p = R - r.b * PB; r.isctx = r.p < CTXL; r.mrow = r.isctx ? 8 : r.b; return r; }

DI void moe_combine(const Frame& F, const RowCtx& rc, f32x4 (&x)[4], const int* INV, const bf16_t* YE, const float* mod_prev  ) {
    const int myinv = (F.lane < 16) ? INV[(size_t)rc.R * 16 + F.lane] : -1;
    f32x4 s[4];
#pragma unroll
    for (int j = 0; j < 4; ++j) s[j] = (f32x4){0.f, 0.f, 0.f, 0.f};
    for (int e = 0; e < 16; ++e) { const int er = __shfl(myinv, e);
        if (er >= 0) { const bf16_t* yr = YE + (size_t)er * 1024 + 4 * F.lane;
#pragma unroll
            for (int j = 0; j < 4; ++j) { const u32x2 w = *(const u32x2*)(yr + j * 256); s[j][0] += bflo(w.x); s[j][1] += bfhi(w.x); s[j][2] += bflo(w.y); s[j][3] += bfhi(w.y); } } }
    const float* g5 = mod_prev + (size_t)rc.mrow * 6144 + 5 * 1024 + 4 * F.lane;
#pragma unroll
    for (int j = 0; j < 4; ++j) x[j] += *(const f32x4*)(g5 + j * 256) * s[j];
}
DI void add_mixer(const Frame& F, const RowCtx& rc, f32x4 (&x)[4], const bf16_t* __restrict__ Y, const float* modl  ) {
    const float* g2 = modl + (size_t)rc.mrow * 6144 + 2 * 1024 + 4 * F.lane;
    const bf16_t* yr = Y + (size_t)rc.R * 1024 + 4 * F.lane;
#pragma unroll
    for (int j = 0; j < 4; ++j) { const u32x2 w = *(const u32x2*)(yr + j * 256); const f32x4 g = *(const f32x4*)(g2 + j * 256);
        x[j][0] += g[0] * bflo(w.x); x[j][1] += g[1] * bfhi(w.x); x[j][2] += g[2] * bflo(w.y); x[j][3] += g[3] * bfhi(w.y); }
}
DI float row_rstd(const f32x4 (&x)[4]) {
    float ss = 0.f;
#pragma unroll
    for (int j = 0; j < 4; ++j) ss += (x[j][0] * x[j][0] + x[j][1] * x[j][1]) + (x[j][2] * x[j][2] + x[j][3] * x[j][3]);
    return 1.0f / sqrtf(wave_sum(ss) * (1.f / 1024.f) + RMS_EPS);
}
DI void row_modulate(const Frame& F, const f32x4 (&x)[4], float rstd, const float* g, const float* shift, const float* scale, f32x4 (&h)[4]) {
#pragma unroll
    for (int j = 0; j < 4; ++j) { const int c = j * 256 + 4 * F.lane; const f32x4 gv = *(const f32x4*)(g + c), sh = *(const f32x4*)(shift + c), sc = *(const f32x4*)(scale + c);
        h[j] = x[j] * rstd * gv * (sc + 1.0f) + sh; }
}
DI void row_store_bf16(const Frame& F, const f32x4 (&h)[4], bf16_t* dst) {
#pragma unroll
    for (int j = 0; j < 4; ++j) { u32x2 w; w.x = pk2(h[j][0], h[j][1]); w.y = pk2(h[j][2], h[j][3]); *(u32x2*)(dst + j * 256 + 4 * F.lane) = w; }
}

DI void phase_norm1(const Frame& F, int layer, const float* x_in, const float* ctx_in, float* X, bf16_t* H1, const float* MOD, const float* gmix, const int* INV, const bf16_t* YE, const bf16_t* Y) {
    const float* modl = MOD + (size_t)layer * 9 * 6144;
    for (int R = F.gw; R < MROWS; R += F.NGW) {
        const RowCtx rc = row_ctx(R);
        const float* src = (layer == 0) ? (rc.isctx ? ctx_in + ((size_t)rc.b * CTXL + rc.p) * 1024 : x_in + ((size_t)rc.b * SEQ + (rc.p - CTXL)) * 1024) : X + (size_t)R * 1024;
        f32x4 x[4];
#pragma unroll
        for (int j = 0; j < 4; ++j) x[j] = *(const f32x4*)(src + j * 256 + 4 * F.lane);
        if (layer > 0) { add_mixer(F, rc, x, Y, MOD + (size_t)(layer - 1) * 9 * 6144); moe_combine(F, rc, x, INV, YE, MOD + (size_t)(layer - 1) * 9 * 6144); }
#pragma unroll
        for (int j = 0; j < 4; ++j) *(f32x4*)(X + (size_t)R * 1024 + j * 256 + 4 * F.lane) = x[j];
        const float rstd = row_rstd(x);
        f32x4 h[4]; row_modulate(F, x, rstd, gmix, modl + (size_t)rc.mrow * 6144, modl + (size_t)rc.mrow * 6144 + 1024, h);
        row_store_bf16(F, h, H1 + (size_t)R * 1024);
    }
}
DI void phase_final(const Frame& F, const float* X, float* out, const float* MOD, const float* gfin, const int* INV, const bf16_t* YE, const bf16_t* Y) {
    for (int q = F.gw; q < NB * SEQ; q += F.NGW) {
        const int b = q / SEQ, t = q - b * SEQ, R = b * PB + CTXL + t;
        const RowCtx rc = row_ctx(R);
        f32x4 x[4];
#pragma unroll
        for (int j = 0; j < 4; ++j) x[j] = *(const f32x4*)(X + (size_t)R * 1024 + j * 256 + 4 * F.lane);
        add_mixer(F, rc, x, Y, MOD + (size_t)1 * 9 * 6144);
        moe_combine(F, rc, x, INV, YE, MOD + (size_t)1 * 9 * 6144);
        const float rstd = row_rstd(x);
#pragma unroll
        for (int j = 0; j < 4; ++j) { const int c = j * 256 + 4 * F.lane; *(f32x4*)(out + (size_t)q * 1024 + c) = x[j] * rstd * *(const f32x4*)(gfin + c); }
    }
}

DI void phase_norm2(const Frame& F, int layer, bool skipctx, const float* X, const bf16_t* Y, bf16_t* H2, const float* MOD, const float* gffn, const float* w_router, float* AFF) {
    LAS float* wl = (LAS float*)F.lds;
    for (int idx = F.tid; idx < 16384; idx += 512) wl[(idx & 15) * 1024 + (idx >> 4)] = w_router[idx];
    __syncthreads();
    const float* modl = MOD + (size_t)layer * 9 * 6144;
    for (int R = F.gw; R < MROWS; R += F.NGW) {
        const RowCtx rc = row_ctx(R);
        if (skipctx && rc.isctx) continue;
        f32x4 x[4];
#pragma unroll
        for (int j = 0; j < 4; ++j) x[j] = *(const f32x4*)(X + (size_t)R * 1024 + j * 256 + 4 * F.lane);
        add_mixer(F, rc, x, Y, modl);
        const float rstd = row_rstd(x);
        f32x4 h[4]; row_modulate(F, x, rstd, gffn, modl + (size_t)rc.mrow * 6144 + 3 * 1024, modl + (size_t)rc.mrow * 6144 + 4 * 1024, h);
        row_store_bf16(F, h, H2 + (size_t)R * 1024);
        float lg[16];
#pragma unroll
        for (int e = 0; e < 16; ++e) { float s = 0.f;
#pragma unroll
            for (int j = 0; j < 4; ++j) { const f32x4 w = *(const LAS f32x4*)(wl + e * 1024 + j * 256 + 4 * F.lane); s += (h[j][0] * w[0] + h[j][1] * w[1]) + (h[j][2] * w[2] + h[j][3] * w[3]); }
            lg[e] = wave_sum(s); }
        float mx = lg[0];
#pragma unroll
        for (int e = 1; e < 16; ++e) mx = fmaxf(mx, lg[e]);
        float den = 0.f, mine = 0.f;
#pragma unroll
        for (int e = 0; e < 16; ++e) { const float ex = expf(lg[e] - mx); den += ex; mine = (F.lane == e) ? ex : mine; }
        if (F.lane < 16) AFF[((size_t)rc.b * 16 + F.lane) * PB + rc.p] = mine / den;
    }
    __syncthreads();
}

DI int block_exscan(const Frame& F, int v, LAS int* wtot, int& total) {
    int incl = v;
#pragma unroll
    for (int o = 1; o < 64; o <<= 1) { const int t = __shfl_up(incl, o); if (F.lane >= o) incl += t; }
    if (F.lane == 63) wtot[F.wave] = incl;
    __syncthreads();
    int base = 0; total = 0;
#pragma unroll
    for (int w = 0; w < 8; ++w) { const int x = wtot[w]; if (w < F.wave) base += x; total += x; }
    __syncthreads();
    return base + incl - v;
}
DI void phase_topk(const Frame& F, int nitems, const float* AFF, int* SRC, float* GV, int* INV) {
    LAS int* wcnt = (LAS int*)F.lds;
    LAS int* wtot = wcnt + 16;
    for (int it = blockIdx.x; it < nitems; it += F.G) {
        const int isctx = it >= 128, be = it & 127, b = be >> 4, e = be & 15;
        const int n = isctx ? CTXL : SEQ, cap = isctx ? 32 : 256, p0 = isctx ? 0 : CTXL;
        const float* a = AFF + ((size_t)b * 16 + e) * PB + p0;
        unsigned v[4]; float av[4];
#pragma unroll
        for (int k = 0; k < 4; ++k) { const int idx = 4 * F.tid + k; av[k] = idx < n ? a[idx] : 0.f; v[k] = __builtin_bit_cast(unsigned, av[k]); }
        unsigned prefix = 0u;
        for (int bit = 30; bit >= 0; --bit) {
            const unsigned cand = prefix | (1u << bit);
            int c = 0;
#pragma unroll
            for (int k = 0; k < 4; ++k) c += __popcll(__ballot(v[k] >= cand));
            LAS int* wc = wcnt + (bit & 1) * 8;
            if (F.lane == 0) wc[F.wave] = c;
            __syncthreads();
            int tot = 0;
#pragma unroll
            for (int w = 0; w < 8; ++w) tot += wc[w];
            if (tot >= cap) prefix = cand;
        }
        __syncthreads();
        int ngt_t = 0, neq_t = 0;
#pragma unroll
        for (int k = 0; k < 4; ++k) { ngt_t += (v[k] > prefix) ? 1 : 0; neq_t += (v[k] == prefix) ? 1 : 0; }
        int ngt_total, neq_total;
        (void)block_exscan(F, ngt_t, wtot, ngt_total);
        int eq_rank = block_exscan(F, neq_t, wtot, neq_total);
        const int eq_take = cap - ngt_total;
        int sel[4], nsel_t = 0;
#pragma unroll
        for (int k = 0; k < 4; ++k) { int s = 0; if (v[k] > prefix) s = 1; else if (v[k] == prefix) { s = (eq_rank < eq_take) ? 1 : 0; ++eq_rank; } sel[k] = s; nsel_t += s; }
        int nsel_total;
        int slot = block_exscan(F, nsel_t, wtot, nsel_total);
        const int ebase = e * EROWS + (isctx ? 2048 + b * 32 : b * 256);
#pragma unroll
        for (int k = 0; k < 4; ++k) { const int idx = 4 * F.tid + k;
            if (idx < n) { const int R = b * PB + p0 + idx;
                if (sel[k]) { const int er = ebase + slot; ++slot; SRC[er] = R; GV[er] = av[k]; INV[(size_t)R * 16 + e] = er; }
                else INV[(size_t)R * 16 + e] = -1; } }
        __syncthreads();
    }
}
DI void phase_gather(const Frame& F, int rows_per_expert, const int* __restrict__ SRC, const bf16_t* __restrict__ H2, bf16_t* __restrict__ XG) {
    const int total = 16 * rows_per_expert;
    for (int q = F.gw * 4; q < total; q += F.NGW * 4) {
        const int e = q / rows_per_expert, s = q - e * rows_per_expert, er = e * EROWS + s;
        int R[4];
#pragma unroll
        for (int u = 0; u < 4; ++u) R[u] = SRC[er + u];
        u32x4 v0[4], v1[4];
#pragma unroll
        for (int u = 0; u < 4; ++u) { v0[u] = *(const u32x4*)(H2 + (size_t)R[u] * 1024 + 8 * F.lane); v1[u] = *(const u32x4*)(H2 + (size_t)R[u] * 1024 + 512 + 8 * F.lane); }
#pragma unroll
        for (int u = 0; u < 4; ++u) { *(u32x4*)(XG + (size_t)(er + u) * 1024 + 8 * F.lane) = v0[u]; *(u32x4*)(XG + (size_t)(er + u) * 1024 + 512 + 8 * F.lane) = v1[u]; }
    }
}

DI void qk_norm_rope(const float (&vin)[8], int ll, const float* __restrict__ gn, bool rope, const float* __restrict__ cs, float (&o)[8]) {
    float v[8]; float ss = 0.f;
#pragma unroll
    for (int k = 0; k < 8; ++k) ss += vin[k] * vin[k];
    ss += __shfl_xor(ss, 1); ss += __shfl_xor(ss, 2); ss += __shfl_xor(ss, 4);
    const float rstd = 1.0f / sqrtf(ss * (1.f / 64.f) + RMS_EPS);
#pragma unroll
    for (int k = 0; k < 8; ++k) v[k] = vin[k] * rstd * gn[k];
    const bool isx2 = (ll & 2) != 0;
#pragma unroll
    for (int k = 0; k < 8; ++k) { const float pv = __shfl_xor(v[k], 2); const float c = rope ? cs[k] : 1.f, s = rope ? cs[32 + k] : 0.f; o[k] = isx2 ? (v[k] * c + pv * s) : (v[k] * c - pv * s); }
}
DI void phase_elem(const Frame& F, const LayerIn& P, const bf16_t* __restrict__ PA, const float* __restrict__ ROPE, bf16_t* __restrict__ QN, bf16_t* __restrict__ KN, bf16_t* __restrict__ XBC,
                   float* __restrict__ DT, bf16_t* __restrict__ AU, bf16_t* __restrict__ YCD) {
    const int l = F.lane;
    for (int R0 = F.gw * 4; R0 < MROWS; R0 += F.NGW * 4) {
        const RowCtx rc = row_ctx(R0);
        const bf16_t* pr = PA + (size_t)R0 * PA_W;
        const bool has_prev = (rc.p != 0) && (rc.p != CTXL), has_next = (rc.p + 3 != CTXL - 1) && (rc.p + 3 != PB - 1);
        const bool rope = !rc.isctx; const int t0 = rope ? rc.p - CTXL : 0;
        { const int hb = (l & 7) >> 2, i0 = (l & 1) * 8; const float* gn = P.q_norm_g + (l & 7) * 8;
#pragma unroll
          for (int h2 = 0; h2 < 2; ++h2) { u32x4 w[2];
#pragma unroll
            for (int u = 0; u < 2; ++u) w[u] = *(const u32x4*)(pr + (size_t)(2 * h2 + u) * PA_W + C_Q + l * 8);
#pragma unroll
            for (int u = 0; u < 2; ++u) { float v[8], o[8]; unpack8(w[u], v);
                qk_norm_rope(v, l, gn, rope, ROPE + (size_t)(t0 + 2 * h2 + u) * 64 + hb * 16 + i0, o);
#pragma unroll
                for (int k = 0; k < 8; ++k) o[k] *= ATT_C2;
                *(u32x4*)(QN + (size_t)(R0 + 2 * h2 + u) * 512 + l * 8) = pack8(o); } } }
        { const int u = l >> 4, ll = l & 15, hb = (ll & 7) >> 2, i0 = (ll & 1) * 8;
          float v[8], o[8]; unpack8(*(const u32x4*)(pr + (size_t)u * PA_W + C_K + ll * 8), v);
          qk_norm_rope(v, ll, P.k_norm_g + (ll & 7) * 8, rope, ROPE + (size_t)(t0 + u) * 64 + hb * 16 + i0, o);
          *(u32x4*)(KN + (size_t)(R0 + u) * 128 + ll * 8) = pack8(o); }
#pragma unroll
        for (int pass = 0; pass < 2; ++pass) { const int ch8 = pass * 64 + l; if (ch8 >= 96) continue;
            const int ch = ch8 * 8; u32x4 w[6];
#pragma unroll
            for (int u = 0; u < 6; ++u) { const bool ok = (u == 0) ? has_prev : (u == 5) ? has_next : true;
                w[u] = ok ? *(const u32x4*)(pr + (ptrdiff_t)(u - 1) * PA_W + C_XBC + ch) : (u32x4){0u, 0u, 0u, 0u}; }
            float w0[8], w1[8], w2[8], bs[8];
#pragma unroll
            for (int k = 0; k < 8; ++k) { w0[k] = P.ssd_conv_w[ch + k]; w1[k] = P.ssd_conv_w[768 + ch + k]; w2[k] = P.ssd_conv_w[1536 + ch + k]; bs[k] = P.ssd_conv_b[ch + k]; }
            float a[8], b[8], c[8]; unpack8(w[0], a); unpack8(w[1], b);
#pragma unroll
            for (int u = 0; u < 4; ++u) { unpack8(w[u + 2], c); float o[8];
#pragma unroll
                for (int k = 0; k < 8; ++k) { o[k] = silu_f(w0[k] * a[k] + w1[k] * b[k] + w2[k] * c[k] + bs[k]); a[k] = b[k]; b[k] = c[k]; }
                *(u32x4*)(XBC + (size_t)(R0 + u) * 768 + ch) = pack8(o); } }
        { const int u = l >> 4, d = (l >> 3) & 1, h = l & 7; DT[((size_t)d * MROWS + R0 + u) * 8 + h] = softplus_f(bf2f(pr[(size_t)u * PA_W + C_DT + h]) + P.ssd_dt_bias[d * 8 + h]); }
        if (l < 48) {
            const int g = l >> 1, a0 = (l & 1) * 8, ch = l * 8;
            u32x4 uw[4], sb[4], sg[6], sh[6];
#pragma unroll
            for (int u = 0; u < 4; ++u) { uw[u] = *(const u32x4*)(pr + (size_t)u * PA_W + C_U + ch); sb[u] = *(const u32x4*)(pr + (size_t)u * PA_W + C_SB + ch); }
#pragma unroll
            for (int u = 0; u < 6; ++u) { const bool ok = (u == 0) ? has_prev : (u == 5) ? has_next : true;
                sg[u] = ok ? *(const u32x4*)(pr + (ptrdiff_t)(u - 1) * PA_W + C_SG + ch) : (u32x4){0u, 0u, 0u, 0u};
                sh[u] = ok ? *(const u32x4*)(pr + (ptrdiff_t)(u - 1) * PA_W + C_SH + ch) : (u32x4){0u, 0u, 0u, 0u}; }
#pragma unroll
            for (int u = 0; u < 4; ++u) *(u32x4*)(AU + ((size_t)g * 576 + ((R0 + u) >> 5)) * 768 + ((R0 + u) & 31) * 16 + a0) = uw[u];
            float w0[8], w1[8], w2[8];
#pragma unroll
            for (int k = 0; k < 8; ++k) { w0[k] = P.sc_conv_w[ch + k]; w1[k] = P.sc_conv_w[384 + ch + k]; w2[k] = P.sc_conv_w[768 + ch + k]; }
            float a[8], b[8], c[8], x[8], y[8];
            unpack8(sg[0], x); unpack8(sh[0], y);
#pragma unroll
            for (int k = 0; k < 8; ++k) a[k] = x[k] * y[k];
            unpack8(sg[1], x); unpack8(sh[1], y);
#pragma unroll
            for (int k = 0; k < 8; ++k) b[k] = x[k] * y[k];
#pragma unroll
            for (int u = 0; u < 4; ++u) { unpack8(sg[u + 2], x); unpack8(sh[u + 2], y); float s[8], o[8]; unpack8(sb[u], s);
#pragma unroll
                for (int k = 0; k < 8; ++k) { c[k] = x[k] * y[k]; o[k] = s[k] * (w0[k] * a[k] + w1[k] * b[k] + w2[k] * c[k]); a[k] = b[k]; b[k] = c[k]; }
                *(u32x4*)(YCD + (size_t)(R0 + u) * 768 + 384 + ch) = pack8(o); }
        }
    }
}

typedef short v4i16_t __attribute__((ext_vector_type(4)));
DI int img_off(int row, int chunk) { return row * 128 + ((chunk ^ (row & 7)) << 4); }
DI s16x4 tr_read4(const LAS unsigned char* p) { return __builtin_bit_cast(s16x4, __builtin_amdgcn_ds_read_tr16_b64_v4i16((LAS v4i16_t*)p)); }
DI bf16x8 cat8(s16x4 lo, s16x4 hi) { return (bf16x8){lo[0], lo[1], lo[2], lo[3], hi[0], hi[1], hi[2], hi[3]}; }
DI unsigned cvtpk(float lo, float hi) { typedef __bf16 bf2 __attribute__((ext_vector_type(2))); f32x2 v = {lo, hi}; bf2 b = __builtin_convertvector(v, bf2); return __builtin_bit_cast(unsigned, b); }
#define MFMA32(a, b, c) __builtin_amdgcn_mfma_f32_32x32x16_bf16((a), (b), (c), 0, 0, 0)
DI int crow(int r, int hh) { return (r & 3) + 8 * (r >> 2) + 4 * hh; }

constexpr int SSD_XH = 0, SSD_BM = 65536, SSD_CM = 81920, SSD_ARR = 131072;
DI void ssd_load_images(const Frame& F, const bf16_t* XBC, int R0, int g, bool with_c) {
#pragma unroll
    for (int it = 0; it < 8; ++it) { const int idx = it * 512 + F.tid, h4 = idx >> 10, row = (idx >> 3) & 127, ch = idx & 7;
        *(LAS u32x4*)(F.lds + SSD_XH + h4 * 16384 + img_off(row, ch)) = *(const u32x4*)(XBC + (size_t)(R0 + row) * 768 + g * 256 + h4 * 64 + ch * 8); }
#pragma unroll
    for (int it = 0; it < 2; ++it) { const int idx = it * 512 + F.tid, row = idx >> 3, ch = idx & 7;
        *(LAS u32x4*)(F.lds + SSD_BM + img_off(row, ch)) = *(const u32x4*)(XBC + (size_t)(R0 + row) * 768 + 512 + g * 64 + ch * 8);
        if (with_c) *(LAS u32x4*)(F.lds + SSD_CM + img_off(row, ch)) = *(const u32x4*)(XBC + (size_t)(R0 + row) * 768 + 640 + g * 64 + ch * 8); }
}
struct Series { float dt0, dt1, cs0, cs1, ecs0, ecs1, tot; };
DI Series ssd_series(const Frame& F, const float* DT, const float* a_log, int R0, int h, int d) {
    Series s; const float a = -__expf(a_log[d * 8 + h]);
    s.dt0 = DT[((size_t)d * MROWS + R0 + 2 * F.lane) * 8 + h]; s.dt1 = DT[((size_t)d * MROWS + R0 + 2 * F.lane + 1) * 8 + h];
    const float ad0 = s.dt0 * a, ad1 = s.dt1 * a, pair = ad0 + ad1; float incl = pair;
#pragma unroll
    for (int o = 1; o < 64; o <<= 1) { const float t = __shfl_up(incl, o); if (F.lane >= o) incl += t; }
    const float excl = incl - pair;
    s.cs0 = excl + ad0; s.cs1 = incl; s.ecs0 = excl; s.ecs1 = excl + ad0; s.tot = __shfl(incl, 63);
    return s;
}

DI void ssd_chunk_states(const Frame& F, const LayerIn& P, const bf16_t* XBC, const float* DT, float* S, float* TOT) {
    LAS float* W = (LAS float*)(F.lds + SSD_ARR);
    const int lane = F.lane, hh = lane >> 5, q = (lane & 15) >> 2, pp = lane & 3, blk = (lane >> 4) & 1;
    const int h4 = F.wave & 3, d = F.wave >> 2;
    for (int it = blockIdx.x; it < 288; it += F.G) {
        const int b = it / 36, r = it % 36, c = r >> 1, g = r & 1, R0 = b * PB + c * 128, h = 4 * g + h4;
        ssd_load_images(F, XBC, R0, g, false);
        const Series s = ssd_series(F, DT, P.ssd_a_log, R0, h, d);
        float w0, w1;
        if (d == 0) { w0 = s.dt0 * __expf(s.tot - s.cs0); w1 = s.dt1 * __expf(s.tot - s.cs1); } else { w0 = s.dt0 * __expf(s.ecs0); w1 = s.dt1 * __expf(s.ecs1); }
        *(LAS f32x2*)(W + F.wave * 128 + 2 * lane) = (f32x2){w0, w1};
        if (lane == 0) TOT[(((size_t)b * 18 + c) * 8 + h) * 2 + d] = s.tot;
        __syncthreads();
        f32x16 acc[2][2];
#pragma unroll
        for (int i = 0; i < 2; ++i)
#pragma unroll
            for (int j = 0; j < 2; ++j)
#pragma unroll
                for (int k = 0; k < 16; ++k) acc[i][j][k] = 0.f;
        const LAS unsigned char* xh = F.lds + SSD_XH + h4 * 16384;
        const LAS unsigned char* bm = F.lds + SSD_BM;
#pragma unroll 2
        for (int st = 0; st < 8; ++st) {
            const int row = 16 * st + 8 * hh + q;
            const f32x4 wa = *(const LAS f32x4*)(W + F.wave * 128 + 16 * st + 8 * hh), wb = *(const LAS f32x4*)(W + F.wave * 128 + 16 * st + 8 * hh + 4);
            bf16x8 af[2], bfr[2];
#pragma unroll
            for (int t = 0; t < 2; ++t) { const int chunk = t * 4 + 2 * blk + (pp >> 1), within = 8 * (pp & 1);
                af[t] = cat8(tr_read4(bm + img_off(row, chunk) + within), tr_read4(bm + img_off(row + 4, chunk) + within));
                const s16x4 lo = tr_read4(xh + img_off(row, chunk) + within), hi = tr_read4(xh + img_off(row + 4, chunk) + within);
                u32x4 pw;
                pw.x = cvtpk(bf2f((bf16_t)lo[0]) * wa[0], bf2f((bf16_t)lo[1]) * wa[1]); pw.y = cvtpk(bf2f((bf16_t)lo[2]) * wa[2], bf2f((bf16_t)lo[3]) * wa[3]);
                pw.z = cvtpk(bf2f((bf16_t)hi[0]) * wb[0], bf2f((bf16_t)hi[1]) * wb[1]); pw.w = cvtpk(bf2f((bf16_t)hi[2]) * wb[2], bf2f((bf16_t)hi[3]) * wb[3]);
                bfr[t] = __builtin_bit_cast(bf16x8, pw); }
#pragma unroll
            for (int nt = 0; nt < 2; ++nt)
#pragma unroll
                for (int pt = 0; pt < 2; ++pt) acc[nt][pt] = MFMA32(af[nt], bfr[pt], acc[nt][pt]);
        }
        float* Sb = S + ((((size_t)b * 18 + c) * 8 + h) * 2 + d) * 4096;
#pragma unroll
        for (int nt = 0; nt < 2; ++nt)
#pragma unroll
            for (int pt = 0; pt < 2; ++pt)
#pragma unroll
                for (int q4 = 0; q4 < 4; ++q4) { const int p = pt * 32 + (lane & 31), n0 = nt * 32 + 8 * q4 + 4 * hh;
                    *(f32x4*)(Sb + p * 64 + n0) = (f32x4){acc[nt][pt][4 * q4], acc[nt][pt][4 * q4 + 1], acc[nt][pt][4 * q4 + 2], acc[nt][pt][4 * q4 + 3]}; }
        __syncthreads();
    }
}

DI void ssd_recurrence(const Frame& F, const float* __restrict__ S, const float* __restrict__ TOT, bf16_t* __restrict__ HIN) {
    for (int gi = blockIdx.x * 512 + F.tid; gi < 128 * 1024; gi += F.G * 512) {
        const int bhd = gi >> 10, e4 = (gi & 1023) * 4, b = bhd >> 4, h = (bhd >> 1) & 7, d = bhd & 1;
        f32x4 sv[18]; float dec[18];
#pragma unroll
        for (int k = 0; k < 18; ++k) { const int c = (d == 0) ? k : (k < 2 ? 1 - k : 19 - k);
            const size_t st = (((size_t)b * 18 + c) * 8 + h) * 2 + d;
            sv[k] = *(const f32x4*)(S + st * 4096 + e4); dec[k] = TOT[st]; }
        f32x4 H = (f32x4){0.f, 0.f, 0.f, 0.f};
#pragma unroll
        for (int k = 0; k < 18; ++k) { const int c = (d == 0) ? k : (k < 2 ? 1 - k : 19 - k);
            const size_t st = (((size_t)b * 18 + c) * 8 + h) * 2 + d;
            u32x2 w; w.x = pk2(H[0], H[1]); w.y = pk2(H[2], H[3]);
            *(u32x2*)(HIN + st * 4096 + e4) = w;
            H = H * __expf(dec[k]) + sv[k]; }
    }
}

DI void ssd_output(const Frame& F, const LayerIn& P, const bf16_t* XBC, const bf16_t* PA, const float* DT, const bf16_t* HIN, bf16_t* YB, float* SSQ, bool skipctx) {
    LAS float* ARR = (LAS float*)(F.lds + SSD_ARR);
    const int lane = F.lane, hh = lane >> 5, q = (lane & 15) >> 2, pp = lane & 3, blk = (lane >> 4) & 1, l31 = lane & 31;
    for (int it = blockIdx.x; it < 288; it += F.G) {
        const int b = it / 36, r_ = it % 36, c = r_ >> 1, g = r_ & 1, R0 = b * PB + c * 128;
        if (skipctx && c < 2) continue;
        ssd_load_images(F, XBC, R0, g, true);
        { const int h4 = F.wave & 3, d = F.wave >> 2, h = 4 * g + h4;
          const Series s = ssd_series(F, DT, P.ssd_a_log, R0, h, d);
          LAS float* A = ARR + h4 * 768;
          if (d == 0) { *(LAS f32x2*)(A + 0 * 128 + 2 * lane) = (f32x2){s.cs0, s.cs1}; *(LAS f32x2*)(A + 1 * 128 + 2 * lane) = (f32x2){s.dt0, s.dt1};
                        *(LAS f32x2*)(A + 2 * 128 + 2 * lane) = (f32x2){__expf(s.cs0), __expf(s.cs1)}; }
          else { *(LAS f32x2*)(A + 3 * 128 + 2 * lane) = (f32x2){s.ecs0, s.ecs1}; *(LAS f32x2*)(A + 4 * 128 + 2 * lane) = (f32x2){s.dt0, s.dt1};
                 *(LAS f32x2*)(A + 5 * 128 + 2 * lane) = (f32x2){__expf(s.tot - s.ecs0), __expf(s.tot - s.ecs1)}; } }
        __syncthreads();
        const int h4 = F.wave & 3, rh = F.wave >> 2, h = 4 * g + h4;
        const LAS float* A = ARR + h4 * 768;
        const LAS unsigned char* xh = F.lds + SSD_XH + h4 * 16384;
        const LAS unsigned char* bm = F.lds + SSD_BM;
        const LAS unsigned char* cm = F.lds + SSD_CM;
        f32x16 yacc[2][2];
#pragma unroll
        for (int i = 0; i < 2; ++i)
#pragma unroll
            for (int j = 0; j < 2; ++j)
#pragma unroll
                for (int k = 0; k < 16; ++k) yacc[i][j][k] = 0.f;
#pragma unroll
        for (int itl = 0; itl < 2; ++itl) {
            const int itile = 2 * rh + itl, irow = itile * 32 + l31;
            bf16x8 cf[4];
#pragma unroll
            for (int ks = 0; ks < 4; ++ks) cf[ks] = *(const LAS bf16x8*)(cm + img_off(irow, 2 * ks + hh));
#pragma unroll 1
            for (int d = 0; d < 2; ++d) {
                const bf16_t* Hs = HIN + (((((size_t)b * 18 + c) * 8 + h) * 2 + d) * 4096);
                bf16x8 hb[2][4];
#pragma unroll
                for (int pt = 0; pt < 2; ++pt)
#pragma unroll
                    for (int ks = 0; ks < 4; ++ks) hb[pt][ks] = *(const bf16x8*)(Hs + (pt * 32 + l31) * 64 + 16 * ks + 8 * hh);
#pragma unroll
                for (int pt = 0; pt < 2; ++pt) {
                    f32x16 tmp;
#pragma unroll
                    for (int k = 0; k < 16; ++k) tmp[k] = 0.f;
#pragma unroll
                    for (int ks = 0; ks < 4; ++ks) tmp = MFMA32(cf[ks], hb[pt][ks], tmp);
#pragma unroll
                    for (int q4 = 0; q4 < 4; ++q4) { const f32x4 ev = *(const LAS f32x4*)(A + (d == 0 ? 2 : 5) * 128 + itile * 32 + 8 * q4 + 4 * hh);
#pragma unroll
                        for (int k = 0; k < 4; ++k) yacc[itl][pt][4 * q4 + k] += tmp[4 * q4 + k] * ev[k]; }
                }
                __builtin_amdgcn_sched_barrier(0);
            }
            const float csf_i = A[0 * 128 + irow], ecb_i = A[3 * 128 + irow];
#pragma unroll 1
            for (int jt = 0; jt < 4; ++jt) {
                f32x16 Z;
#pragma unroll
                for (int k = 0; k < 16; ++k) Z[k] = 0.f;
#pragma unroll
                for (int ks = 0; ks < 4; ++ks) { const bf16x8 bf_ = *(const LAS bf16x8*)(bm + img_off(jt * 32 + l31, 2 * ks + hh)); Z = MFMA32(bf_, cf[ks], Z); }
#pragma unroll
                for (int q4 = 0; q4 < 4; ++q4) { const int j0 = jt * 32 + 8 * q4 + 4 * hh;
                    f32x4 w = (f32x4){0.f, 0.f, 0.f, 0.f};
                    if (jt <= itile) { const f32x4 cj = *(const LAS f32x4*)(A + 0 * 128 + j0), dj = *(const LAS f32x4*)(A + 1 * 128 + j0);
#pragma unroll
                        for (int k = 0; k < 4; ++k) { const bool ok = (jt < itile) || (j0 + k <= irow); w[k] += ok ? __expf(fminf(csf_i - cj[k], 0.f)) * dj[k] : 0.f; } }
                    if (jt >= itile) { const f32x4 ej = *(const LAS f32x4*)(A + 3 * 128 + j0), dj = *(const LAS f32x4*)(A + 4 * 128 + j0);
#pragma unroll
                        for (int k = 0; k < 4; ++k) { const bool ok = (jt > itile) || (j0 + k >= irow); w[k] += ok ? __expf(fminf(ej[k] - ecb_i, 0.f)) * dj[k] : 0.f; } }
#pragma unroll
                    for (int k = 0; k < 4; ++k) Z[4 * q4 + k] *= w[k]; }
#pragma unroll
                for (int s = 0; s < 2; ++s) {
                    u32x4 zp; zp.x = cvtpk(Z[8 * s], Z[8 * s + 1]); zp.y = cvtpk(Z[8 * s + 2], Z[8 * s + 3]); zp.z = cvtpk(Z[8 * s + 4], Z[8 * s + 5]); zp.w = cvtpk(Z[8 * s + 6], Z[8 * s + 7]);
                    const bf16x8 za = __builtin_bit_cast(bf16x8, zp);
                    const int row = jt * 32 + 16 * s + 4 * hh + q;
#pragma unroll
                    for (int pt = 0; pt < 2; ++pt) { const int chunk = pt * 4 + 2 * blk + (pp >> 1), within = 8 * (pp & 1);
                        const bf16x8 xb = cat8(tr_read4(xh + img_off(row, chunk) + within), tr_read4(xh + img_off(row + 8, chunk) + within));
                        yacc[itl][pt] = MFMA32(za, xb, yacc[itl][pt]); }
                }
                __builtin_amdgcn_sched_barrier(0);
            }
        }
        __syncthreads();
        LAS float* Y = (LAS float*)F.lds;
#pragma unroll
        for (int itl = 0; itl < 2; ++itl)
#pragma unroll
            for (int pt = 0; pt < 2; ++pt)
#pragma unroll
                for (int r = 0; r < 16; ++r) Y[((2 * rh + itl) * 32 + crow(r, hh)) * 256 + h4 * 64 + pt * 32 + l31] = yacc[itl][pt][r];
        __syncthreads();
#pragma unroll 1
        for (int it4 = 0; it4 < 8; it4 += 4) {
            u32x4 xw[4], zw[4];
#pragma unroll
            for (int u = 0; u < 4; ++u) { const int idx = (it4 + u) * 512 + F.tid, row = idx >> 5, ch = idx & 31, R = R0 + row;
                xw[u] = *(const u32x4*)(XBC + (size_t)R * 768 + g * 256 + ch * 8); zw[u] = *(const u32x4*)(PA + (size_t)R * PA_W + C_Z + g * 256 + ch * 8); }
#pragma unroll
            for (int u = 0; u < 4; ++u) { const int idx = (it4 + u) * 512 + F.tid, row = idx >> 5, ch = idx & 31, R = R0 + row;
                const f32x4 y0 = *(const LAS f32x4*)(Y + row * 256 + ch * 8), y1 = *(const LAS f32x4*)(Y + row * 256 + ch * 8 + 4);
                float xv[8], zv[8]; unpack8(xw[u], xv); unpack8(zw[u], zv);
                const float Dh = P.ssd_d[4 * g + (ch >> 3)]; float o[8], ss = 0.f;
#pragma unroll
                for (int k = 0; k < 8; ++k) { const float yv = (k < 4 ? y0[k] : y1[k - 4]) + Dh * xv[k]; o[k] = yv * silu_f(zv[k]); ss += o[k] * o[k]; }
                ss += __shfl_xor(ss, 1); ss += __shfl_xor(ss, 2); ss += __shfl_xor(ss, 4); ss += __shfl_xor(ss, 8); ss += __shfl_xor(ss, 16);
                if (ch == 0) SSQ[(size_t)R * 2 + g] = ss;
                *(u32x4*)(YB + (size_t)R * 1024 + 512 + g * 256 + ch * 8) = pack8(o); }
        }
        __syncthreads();
    }
}

DI void s5_recurrence(const Frame& F, const LayerIn& P, const float* __restrict__ S5S, bf16_t* __restrict__ AU) {
    if (F.gw >= 384) return;
    const int g = F.gw >> 4, b = (F.gw >> 1) & 7, d = F.gw & 1, p = F.lane;
    const float step = __expf(P.s5_lstep[d * 24 + g]);
    const float lr = P.s5_lre[(d * 24 + g) * 64 + p], li = P.s5_lim[(d * 24 + g) * 64 + p];
    const float mag = expf(32.f * lr * step), ang = 32.f * li * step, Lr = mag * cosf(ang), Li = mag * sinf(ang);
    float Hr = 0.f, Hi = 0.f;
#pragma unroll 1
    for (int kb = 0; kb < 72; kb += 24) {
        float sr[24], si[24];
#pragma unroll
        for (int k = 0; k < 24; ++k) { const int kk = kb + k, ck = (d == 0) ? kk : (kk < 8 ? 7 - kk : 79 - kk);
            const size_t m = (size_t)g * 576 + b * 72 + ck;
            sr[k] = S5S[m * 256 + d * 128 + p]; si[k] = S5S[m * 256 + d * 128 + 64 + p]; }
#pragma unroll
        for (int k = 0; k < 24; ++k) { const int kk = kb + k, ck = (d == 0) ? kk : (kk < 8 ? 7 - kk : 79 - kk);
            const size_t m = (size_t)g * 576 + b * 72 + ck;
            AU[m * 768 + 512 + d * 128 + p] = (bf16_t)f2bf(Hr); AU[m * 768 + 512 + d * 128 + 64 + p] = (bf16_t)f2bf(Hi);
            const float nr = Lr * Hr - Li * Hi + sr[k], ni = Lr * Hi + Li * Hr + si[k];
            Hr = nr; Hi = ni; }
    }
}

namespace attn_body {
using bf16=__hip_bfloat16;
using bf16x8=__attribute__((ext_vector_type(8)))short;
using s16x4=__attribute__((ext_vector_type(4)))short;
using f32x16=__attribute__((ext_vector_type(16)))float;
using u32x4=__attribute__((ext_vector_type(4)))unsigned;
constexpr int D=64;
constexpr int NW=8,QBLK=32,QB=QBLK*NW,KVBLK=64;
__device__ __forceinline__ int crow(int r,int hi){return (r&3)+8*(r>>2)+4*hi;}
#define SBAR() __builtin_amdgcn_sched_barrier(0)
constexpr int NSLOT=3, SLOTB=8192;
constexpr int LDS_K=0, LDS_V=NSLOT*SLOTB, LDS_WS=2*NSLOT*SLOTB, LDS_OST=LDS_WS+NW*64*4, LDS_BYTES=LDS_OST+NW*4096;
constexpr float C2=0.125f*1.4426950408889634f;
__device__ __forceinline__ void glds16(const void*gsrc,unsigned lds_dst){unsigned keep;
  asm volatile("s_mov_b32 %0, m0\n\ts_mov_b32 m0, %2\n\ts_nop 0\n\tglobal_load_lds_dwordx4 %1, off\n\ts_mov_b32 m0, %0":"=&s"(keep):"v"(gsrc),"s"(lds_dst):"memory");}
__device__ __forceinline__ float max3f(float a,float b,float c){float r;asm("v_max3_f32 %0, %1, %2, %3":"=v"(r):"v"(a),"v"(b),"v"(c));return r;}
__device__ __forceinline__ float max2f(float a,float b){float r;asm("v_max_f32_e32 %0, %1, %2":"=v"(r):"v"(a),"v"(b));return r;}
__device__ __forceinline__ float fadd_s(float a,float b){float r;asm("v_add_f32_e32 %0, %1, %2":"=v"(r):"v"(a),"v"(b));return r;}
__device__ __forceinline__ float fsub_s(float a,float b){float r;asm("v_sub_f32_e32 %0, %1, %2":"=v"(r):"v"(a),"v"(b));return r;}
typedef float f32x2_t __attribute__((ext_vector_type(2))); typedef __bf16 bf16x2_t __attribute__((ext_vector_type(2)));
__device__ __forceinline__ unsigned cvtpk_s(float lo,float hi){f32x2_t v={lo,hi};bf16x2_t b=__builtin_convertvector(v,bf16x2_t);return __builtin_bit_cast(unsigned,b);}
#define WAIT_BAR(N) asm volatile("s_waitcnt vmcnt(" #N ") lgkmcnt(0)\n\ts_barrier":::"memory")

__device__ __forceinline__ void qkt(f32x16&p0,f32x16&p1,const char*Kslot,const bf16x8*qr,const f32x16&negm,int r32,int hi){
  const char*kb=Kslot+hi*1024+r32*16;
  #pragma unroll
  for(int d0=0;d0<4;++d0){
    const bf16x8 b0=*reinterpret_cast<const bf16x8*>(kb+d0*2048);
    const bf16x8 b1=*reinterpret_cast<const bf16x8*>(kb+d0*2048+512);
    if(d0==0){p0=__builtin_amdgcn_mfma_f32_32x32x16_bf16(b0,qr[0],negm,0,0,0);p1=__builtin_amdgcn_mfma_f32_32x32x16_bf16(b1,qr[0],negm,0,0,0);}
    else{p0=__builtin_amdgcn_mfma_f32_32x32x16_bf16(b0,qr[d0],p0,0,0,0);p1=__builtin_amdgcn_mfma_f32_32x32x16_bf16(b1,qr[d0],p1,0,0,0);}}
}
typedef __attribute__((address_space(3))) const char* lds_cptr;
typedef short v4i16_t __attribute__((ext_vector_type(4)));
__device__ __forceinline__ void kload8(bf16x8*kf,lds_cptr kp){
  kf[0]=*(const __attribute__((address_space(3))) bf16x8*)(kp);      kf[1]=*(const __attribute__((address_space(3))) bf16x8*)(kp+512);
  kf[2]=*(const __attribute__((address_space(3))) bf16x8*)(kp+2048); kf[3]=*(const __attribute__((address_space(3))) bf16x8*)(kp+2560);
  kf[4]=*(const __attribute__((address_space(3))) bf16x8*)(kp+4096); kf[5]=*(const __attribute__((address_space(3))) bf16x8*)(kp+4608);
  kf[6]=*(const __attribute__((address_space(3))) bf16x8*)(kp+6144); kf[7]=*(const __attribute__((address_space(3))) bf16x8*)(kp+6656);
}
__device__ __forceinline__ void kload2(bf16x8*kf,lds_cptr kp,int j){ kf[2*j]=*(const __attribute__((address_space(3))) bf16x8*)(kp+j*2048); kf[2*j+1]=*(const __attribute__((address_space(3))) bf16x8*)(kp+j*2048+512); }
__device__ __forceinline__ s16x4 vtr(lds_cptr p){ return __builtin_bit_cast(s16x4,__builtin_amdgcn_ds_read_tr16_b64_v4i16((__attribute__((address_space(3))) v4i16_t*)p)); }
__device__ __forceinline__ float rowmax(const f32x16&p0,const f32x16&p1){
  float a=max3f(p0[0],p0[1],p1[0]),b=max3f(p0[2],p0[3],p1[1]);a=max3f(a,p1[2],p1[3]);
  #pragma unroll
  for(int r=4;r<16;r+=4){a=max3f(a,p0[r],p0[r+1]);b=max3f(b,p0[r+2],p0[r+3]);a=max3f(a,p1[r],p1[r+1]);b=max3f(b,p1[r+2],p1[r+3]);}
  const float m=max2f(a,b);
  auto rr=__builtin_amdgcn_permlane32_swap(__float_as_uint(m),__float_as_uint(m),false,false);
  return max2f(__uint_as_float(rr[0]),__uint_as_float(rr[1]));
}
__device__ __forceinline__ void pv(f32x16*o,int vb,bf16x8 pa0,bf16x8 pa1,bf16x8 pa2,bf16x8 pa3){
  #pragma unroll
  for(int d0=0;d0<2;++d0){s16x4 lo[4],hi[4];
    #pragma unroll
    for(int ks=0;ks<4;++ks){
      asm volatile("ds_read_b64_tr_b16 %0,%1 offset:%c2":"=&v"(lo[ks]):"v"(vb),"i"(d0*4096+ks*1024):"memory");
      asm volatile("ds_read_b64_tr_b16 %0,%1 offset:%c2":"=&v"(hi[ks]):"v"(vb),"i"(d0*4096+ks*1024+512):"memory");}
    asm volatile("s_waitcnt lgkmcnt(0)":::"memory");SBAR();
    #define PK(k) (bf16x8){lo[k][0],lo[k][1],lo[k][2],lo[k][3],hi[k][0],hi[k][1],hi[k][2],hi[k][3]}
    o[d0]=__builtin_amdgcn_mfma_f32_32x32x16_bf16(pa0,PK(0),o[d0],0,0,0);
    o[d0]=__builtin_amdgcn_mfma_f32_32x32x16_bf16(pa1,PK(1),o[d0],0,0,0);
    o[d0]=__builtin_amdgcn_mfma_f32_32x32x16_bf16(pa2,PK(2),o[d0],0,0,0);
    o[d0]=__builtin_amdgcn_mfma_f32_32x32x16_bf16(pa3,PK(3),o[d0],0,0,0);
    #undef PK
  }
}

#ifndef ATTN_STORE16
#define ATTN_STORE16(p,v) (*(u32x4*)(p)=(v))
#endif
template<int THRL> __device__ __forceinline__ void attn_unit(const bf16*Qp,int qpitch,const bf16*__restrict__ Kp,int kpitch,const bf16*__restrict__ Vp,int vpitch,bf16*Op,int opitch,const int NT,char*shm){
  const int tid=fresh_tid(),lane=tid&63,r32=lane&31,hi=lane>>5; const int wid=__builtin_amdgcn_readfirstlane(tid>>6);
  const bf16*Qw=Qp+(long)(wid*QBLK)*qpitch;
  const bf16*Kh=Kp,*Vh=Vp;
  const unsigned lds0=(unsigned)(uintptr_t)shm;
  float*wsf=(float*)(shm+LDS_WS)+wid*64;
  const bf16*ksrc=Kh+(long)lane*kpitch+wid*8;
  const bf16*vsrc=Vh+(long)(16*(wid&3)+(lane>>2))*vpitch+(wid>>2)*32+(lane&3)*8;
  const unsigned kdst=lds0+LDS_K+wid*1024, vdst=lds0+LDS_V+wid*1024;
  #define DMA_K(t,slot) glds16(ksrc+(long)(t)*KVBLK*kpitch,(unsigned)__builtin_amdgcn_readfirstlane(kdst+(slot)))
  #define DMA_V(t,slot) glds16(vsrc+(long)(t)*KVBLK*vpitch,(unsigned)__builtin_amdgcn_readfirstlane(vdst+(slot)))
  const int vb0=(int)(lds0+LDS_V)+((lane>>4)&1)*32+(lane&3)*8+(4*hi+((lane&15)>>2))*64;
  const char*Kbase=shm+LDS_K; bf16x8 kf[8];
  const lds_cptr shm3=(lds_cptr)shm; const lds_cptr kp0=shm3+LDS_K+hi*1024+r32*16; const lds_cptr vp0=shm3+LDS_V+((lane>>4)&1)*32+(lane&3)*8+(4*hi+((lane&15)>>2))*64;
  DMA_K(0,0);DMA_V(0,0);DMA_K(1,SLOTB);
  bf16x8 qr[4];
  #pragma unroll
  for(int d0=0;d0<4;++d0)qr[d0]=*reinterpret_cast<const bf16x8*>(&Qw[(long)r32*qpitch+d0*16+hi*8]);
  float mhat=0.f,l_reg=0.f;f32x16 o[2];o[0]=f32x16{};o[1]=f32x16{};f32x16 negm=f32x16{};asm volatile("":"+v"(negm));
  #define CMASK(P0,P1,t) do{}while(0)
  bool resc=false;
  #define START(P0,P1) do{ const float rm=rowmax(P0,P1); resc=false; \
    { const float dl=rm; mhat=fadd_s(mhat,dl); \
      _Pragma("unroll") for(int r=0;r<16;++r){P0[r]=fsub_s(P0[r],dl);P1[r]=fsub_s(P1[r],dl);} \
      _Pragma("unroll") for(int r=0;r<16;++r)negm[r]=-mhat; asm volatile("":"+v"(negm)); } \
    _Pragma("unroll") for(int r=0;r<16;++r)P0[r]=__builtin_amdgcn_exp2f(P0[r]); }while(0)
  #define RESC() do{ if(resc){ asm volatile("s_waitcnt lgkmcnt(0)":::"memory"); \
      _Pragma("unroll") for(int d_=0;d_<2;++d_) _Pragma("unroll") for(int r=0;r<16;++r)o[d_][r]*=wsf[crow(r,hi)]; } }while(0)
  f32x16 pA0,pA1,pB0,pB1;
  int sl_prev=0,sl_cur=0,sl_next=SLOTB;
  #define ROT() do{sl_prev=sl_cur;sl_cur=sl_next;sl_next=(sl_next==(NSLOT-1)*SLOTB)?0:sl_next+SLOTB;}while(0)
  DMA_K(2,2*SLOTB);
  WAIT_BAR(3);
  qkt(pA0,pA1,Kbase,qr,negm,r32,hi);asm volatile("s_nop 15\n\ts_nop 7":"+v"(pA0),"+v"(pA1));CMASK(pA0,pA1,0);
  START(pA0,pA1);
  _Pragma("unroll") for(int r=0;r<16;++r)pA1[r]=__builtin_amdgcn_exp2f(pA1[r]);
  WAIT_BAR(0);
  DMA_K(3,0);DMA_V(1,SLOTB);
  ROT();
  kload8(kf,kp0+sl_cur);
  WAIT_BAR(2);
  s16x4 vlo[8],vhi[8]; u32x4 pw0,pw1,pw2,pw3;
  #define PKW(P,B) cvtpk_s(P[B],P[B+1])
  #define PAF(k) __builtin_bit_cast(bf16x8,pw##k)
  #define VFR(i) (bf16x8){vlo[i][0],vlo[i][1],vlo[i][2],vlo[i][3],vhi[i][0],vhi[i][1],vhi[i][2],vhi[i][3]}
  #define PIN(x) asm volatile("":"+v"(x))
  #define MX3(a,b,c) __builtin_fmaxf(__builtin_fmaxf((a),(b)),(c))
  #define GAPA(MF,A0,A1,A2,A3,W0,W1,PW) do{ MF; sacc+=A0; sacc+=A1; sacc+=A2; sacc+=A3; PIN(sacc); W0; W1; PIN(PW); SBAR(); }while(0)
  #define EX(v) __builtin_amdgcn_exp2f(v)
  #define GAPB(MF,X,B) do{ MF; X[B]=EX(X[B]); X[B+1]=EX(X[B+1]); X[B+2]=EX(X[B+2]); X[B+3]=EX(X[B+3]); PIN(X); SBAR(); }while(0)
  #define VRD(i) do{ vlo[i]=vtr(vp_+(((i)>>2)*4096+((i)&3)*1024)); vhi[i]=vtr(vp_+(((i)>>2)*4096+((i)&3)*1024+512)); }while(0)
  #define KRD(G,j) do{ if(G){ kload2(kf,kp0+sl_next,j); SBAR(); } }while(0)
  #define STEP(C0,C1,P0,P1,t,GK,GV,GL) do{ SBAR(); \
    const lds_cptr vp_=vp0+sl_prev; \
    VRD(0); SBAR(); float sacc=(P0[0]+P0[1]); \
    GAPA(C0=__builtin_amdgcn_mfma_f32_32x32x16_bf16(kf[0],qr[0],negm,0,0,0), P0[2],P0[3],P0[4],P0[5],     pw0[0]=PKW(P0,0), pw0[1]=PKW(P0,2), pw0); \
    VRD(4); SBAR(); GAPA(C1=__builtin_amdgcn_mfma_f32_32x32x16_bf16(kf[1],qr[0],negm,0,0,0), P0[6],P0[7],P0[8],P0[9],     pw0[2]=PKW(P0,4), pw0[3]=PKW(P0,6), pw0); \
    VRD(1); SBAR(); GAPA(C0=__builtin_amdgcn_mfma_f32_32x32x16_bf16(kf[2],qr[1],C0,0,0,0),   P0[10],P0[11],P0[12],P0[13], pw1[0]=PKW(P0,8), pw1[1]=PKW(P0,10), pw1); \
    VRD(5); SBAR(); GAPA(C1=__builtin_amdgcn_mfma_f32_32x32x16_bf16(kf[3],qr[1],C1,0,0,0),   P0[14],P0[15],P1[0],P1[1],   pw1[2]=PKW(P0,12),pw1[3]=PKW(P0,14), pw1); \
    VRD(2); SBAR(); GAPA(C0=__builtin_amdgcn_mfma_f32_32x32x16_bf16(kf[4],qr[2],C0,0,0,0),   P1[2],P1[3],P1[4],P1[5],     pw2[0]=PKW(P1,0), pw2[1]=PKW(P1,2), pw2); \
    VRD(6); SBAR(); GAPA(C1=__builtin_amdgcn_mfma_f32_32x32x16_bf16(kf[5],qr[2],C1,0,0,0),   P1[6],P1[7],P1[8],P1[9],     pw2[2]=PKW(P1,4), pw2[3]=PKW(P1,6), pw2); \
    VRD(3); SBAR(); GAPA(C0=__builtin_amdgcn_mfma_f32_32x32x16_bf16(kf[6],qr[3],C0,0,0,0),   P1[10],P1[11],P1[12],P1[13], pw3[0]=PKW(P1,8), pw3[1]=PKW(P1,10), pw3); \
    VRD(7); SBAR(); GAPA(C1=__builtin_amdgcn_mfma_f32_32x32x16_bf16(kf[7],qr[3],C1,0,0,0),   P1[14],P1[15],0.f,0.f,       pw3[2]=PKW(P1,12),pw3[3]=PKW(P1,14), pw3); \
    l_reg+=sacc; \
    if(GK){DMA_K((t)+3,sl_cur);} if(GV){DMA_V((t)+1,sl_next);} \
    CMASK(C0,C1,t); \
    { float a=MX3(C0[0],C0[1],C1[0]),b=MX3(C0[2],C0[3],C1[1]); a=MX3(a,C1[2],C1[3]); \
      _Pragma("unroll") for(int r=4;r<16;r+=4){a=MX3(a,C0[r],C0[r+1]);b=MX3(b,C0[r+2],C0[r+3]);a=MX3(a,C1[r],C1[r+1]);b=MX3(b,C1[r+2],C1[r+3]);} \
      float rm=__builtin_fmaxf(a,b); { auto rr=__builtin_amdgcn_permlane32_swap(__float_as_uint(rm),__float_as_uint(rm),false,false); rm=__builtin_fmaxf(__uint_as_float(rr[0]),__uint_as_float(rr[1])); } \
      resc=false; \
      if(__builtin_expect(__any(rm>(float)THRL),0)){ const float dl=__builtin_fmaxf(rm,0.f); mhat+=dl; \
        _Pragma("unroll") for(int r=0;r<16;++r){C0[r]-=dl;C1[r]-=dl;} \
        _Pragma("unroll") for(int r=0;r<16;++r)negm[r]=-mhat; asm volatile("":"+v"(negm)); \
        const float f=__builtin_amdgcn_exp2f(-dl); l_reg*=f; if(hi==0)wsf[r32]=f; resc=true; } } \
    SBAR(); \
    GAPB(o[0]=__builtin_amdgcn_mfma_f32_32x32x16_bf16(PAF(0),VFR(0),o[0],0,0,0), C0,0); \
    GAPB(o[1]=__builtin_amdgcn_mfma_f32_32x32x16_bf16(PAF(0),VFR(4),o[1],0,0,0), C0,4); \
    KRD(GL,0); GAPB(o[0]=__builtin_amdgcn_mfma_f32_32x32x16_bf16(PAF(1),VFR(1),o[0],0,0,0), C0,8); \
    KRD(GL,1); GAPB(o[1]=__builtin_amdgcn_mfma_f32_32x32x16_bf16(PAF(1),VFR(5),o[1],0,0,0), C0,12); \
    KRD(GL,2); GAPB(o[0]=__builtin_amdgcn_mfma_f32_32x32x16_bf16(PAF(2),VFR(2),o[0],0,0,0), C1,0); \
    KRD(GL,3); GAPB(o[1]=__builtin_amdgcn_mfma_f32_32x32x16_bf16(PAF(2),VFR(6),o[1],0,0,0), C1,4); \
    GAPB(o[0]=__builtin_amdgcn_mfma_f32_32x32x16_bf16(PAF(3),VFR(3),o[0],0,0,0), C1,8); \
    GAPB(o[1]=__builtin_amdgcn_mfma_f32_32x32x16_bf16(PAF(3),VFR(7),o[1],0,0,0), C1,12); \
    }while(0)
  int t=1;
  for(;t+5<NT;t+=2){
    STEP(pB0,pB1,pA0,pA1,t,true,true,true);     WAIT_BAR(2); RESC(); ROT();
    STEP(pA0,pA1,pB0,pB1,t+1,true,true,true);   WAIT_BAR(2); RESC(); ROT();
  }
  #define ENDW(tt) do{ if((tt)+3<NT){WAIT_BAR(2);} else if((tt)+2<NT){WAIT_BAR(1);} else {WAIT_BAR(0);} }while(0)
  for(;t+1<NT;t+=2){
    STEP(pB0,pB1,pA0,pA1,t,(t+3<NT),(t+1<NT),(t+1<NT));       ENDW(t);   RESC(); ROT();
    STEP(pA0,pA1,pB0,pB1,t+1,(t+4<NT),(t+2<NT),(t+2<NT));     ENDW(t+1); RESC(); ROT();
  }
  STEP(pB0,pB1,pA0,pA1,NT-1,false,false,false); RESC();
  { float sacc=pB0[0]+pB0[1]; _Pragma("unroll") for(int r=2;r<16;++r)sacc+=pB0[r]; _Pragma("unroll") for(int r=0;r<16;++r)sacc+=pB1[r]; l_reg+=sacc;
    pw0=(u32x4){PKW(pB0,0),PKW(pB0,2),PKW(pB0,4),PKW(pB0,6)};pw1=(u32x4){PKW(pB0,8),PKW(pB0,10),PKW(pB0,12),PKW(pB0,14)};pw2=(u32x4){PKW(pB1,0),PKW(pB1,2),PKW(pB1,4),PKW(pB1,6)};pw3=(u32x4){PKW(pB1,8),PKW(pB1,10),PKW(pB1,12),PKW(pB1,14)};
    SBAR(); pv(o,vb0+sl_cur,PAF(0),PAF(1),PAF(2),PAF(3)); }
  #undef PKW
  #undef PAF
  #undef VFR
  #undef PIN
  #undef MX3
  #undef GAPA
  #undef GAPB
  #undef EX
  #undef VRD
  #undef KRD
  #undef STEP
  #undef ENDW
  {auto rr=__builtin_amdgcn_permlane32_swap(__float_as_uint(l_reg),__float_as_uint(l_reg),false,false);l_reg=__uint_as_float(rr[0])+__uint_as_float(rr[1]);}
  if(hi==0)wsf[32+r32]=l_reg;asm volatile("s_waitcnt lgkmcnt(0)":::"memory");
  float rli[16];
  #pragma unroll
  for(int r=0;r<16;++r)rli[r]=__builtin_amdgcn_rcpf(wsf[32+crow(r,hi)]);
  bf16*Ow=Op+(long)(wid*QBLK)*opitch;
  { bf16*stg=(bf16*)(shm+LDS_OST)+wid*2048;
    #pragma unroll
    for(int r=0;r<16;++r){const int orow=crow(r,hi);
      #pragma unroll
      for(int d0=0;d0<2;++d0)stg[orow*64+d0*32+r32]=__float2bfloat16(o[d0][r]*rli[r]);}
    asm volatile("s_waitcnt lgkmcnt(0)":::"memory");
    #pragma unroll
    for(int i=0;i<4;++i){const int row=i*8+(lane>>3),ch=lane&7; const u32x4 v=*(const u32x4*)(stg+row*64+ch*8); ATTN_STORE16(Ow+(long)row*opitch+ch*8,v);} }
  asm volatile("s_waitcnt lgkmcnt(0)\n\ts_barrier":::"memory");
  #undef DMA_K
  #undef DMA_V
  #undef CMASK
  #undef START
  #undef RESC
  #undef ROT
}
constexpr int ATTN_LDS_BYTES=LDS_BYTES;
#undef SBAR
#undef WAIT_BAR
}


#define pMOD ((float*)(ws + WS_MOD))
#define pROPE ((float*)(ws + WS_ROPE))
#define pAFF ((float*)(ws + WS_AFF))
#define pINV ((int*)(ws + WS_INV))
#define pDT ((float*)(ws + WS_DT))
#define pSRC ((int*)(ws + WS_SRC))
#define pGV ((float*)(ws + WS_GV))
#define pSSQ ((float*)(ws + WS_SSQ))
#define pTOT ((float*)(ws + WS_TOT))
#define pX ((float*)(ws + WS_X))
#define pH ((bf16_t*)(ws + WS_H))
#define pYAB ((bf16_t*)(ws + WS_YAB))
#define pPA ((bf16_t*)(ws + WS_PA))
#define pPG ((bf16_t*)(ws + WS_PG))
#define pMRGB ((bf16_t*)(ws + WS_MRGB))
#define pY ((bf16_t*)(ws + WS_Y))
#define pXG ((bf16_t*)(ws + WS_XG))
#define pHID ((bf16_t*)(ws + WS_HID))
#define pYE ((bf16_t*)(ws + WS_YE))
#define pQN ((bf16_t*)(ws + WS_QN))
#define pKN ((bf16_t*)(ws + WS_KN))
#define pHIN ((bf16_t*)(ws + WS_HIN))
#define pXBC ((bf16_t*)(ws + WS_XBC))
#define pAU ((bf16_t*)(ws + WS_AU))
#define pSS ((float*)(ws + WS_S))
#define pYG ((bf16_t*)(ws + WS_YG))
#define pS5S ((float*)(ws + WS_S5S))
#define pYCD ((bf16_t*)(ws + WS_YCD))
constexpr int EW_SPLIT1 = 5376, EW_SPLIT2 = 9856;
struct Args { const float* in[38]; float* out; unsigned char* ws; int ph_lo, ph_hi; };
constexpr int PH_PER_LAYER = 15, PH_FINAL = 2 * PH_PER_LAYER, PH_TOTAL = PH_FINAL + 1;

DI LayerIn layer_in(const Args& a, int L) {
    LayerIn P;
    P.norm_mix_g = a.in[6] + (size_t)L * 1024; P.norm_ffn_g = a.in[7] + (size_t)L * 1024;
    P.w_in = a.in[8] + (size_t)L * 1024 * NIN; P.q_norm_g = a.in[9] + L * 64; P.k_norm_g = a.in[10] + L * 64;
    P.ssd_conv_w = a.in[11] + L * 3 * 768; P.ssd_conv_b = a.in[12] + L * 768; P.ssd_dt_bias = a.in[13] + L * 16; P.ssd_a_log = a.in[14] + L * 16;
    P.ssd_d = a.in[15] + L * 8; P.ssd_norm_g = a.in[16] + L * 512;
    P.s5_lre = a.in[17] + L * 2 * 24 * 64; P.s5_lim = a.in[18] + L * 2 * 24 * 64; P.s5_lstep = a.in[19] + L * 48;
    P.s5_bre = a.in[20] + (size_t)L * 24 * 64 * 16; P.s5_bim = a.in[21] + (size_t)L * 24 * 64 * 16; P.s5_cre = a.in[22] + (size_t)L * 24 * 16 * 64; P.s5_cim = a.in[23] + (size_t)L * 24 * 16 * 64;
    P.s5_d = a.in[24] + L * 384; P.s5_wglu = a.in[25] + (size_t)L * 384 * 384; P.s5_bglu = a.in[26] + L * 384; P.sc_conv_w = a.in[27] + L * 3 * 384;
    P.w_br_attn = a.in[28] + (size_t)L * 512 * 1024; P.w_br_ssd = a.in[29] + (size_t)L * 512 * 1024; P.w_br_s5 = a.in[30] + (size_t)L * 384 * 1024; P.w_br_sc = a.in[31] + (size_t)L * 384 * 1024;
    P.w_out = a.in[32] + (size_t)L * 1024 * 1024; P.w_router = a.in[33] + (size_t)L * 1024 * 16;
    P.w_gate = a.in[34] + (size_t)L * 16 * 1024 * 1024; P.w_up = a.in[35] + (size_t)L * 16 * 1024 * 1024; P.w_down = a.in[36] + (size_t)L * 16 * 1024 * 1024;
    return P;
}

__global__ void __launch_bounds__(NWAVES * 64, 2) hybrid_fwd(Args args) {
    extern __shared__ __attribute__((aligned(16))) unsigned char lds_raw[];
    Frame F0;
#define F F0
    F.lds = (LAS unsigned char*)lds_raw;
    F.tid = threadIdx.x; F.lane = F.tid & 63; F.wave = __builtin_amdgcn_readfirstlane(F.tid >> 6);
    F.G = gridDim.x; { const int bx = blockIdx.x; F.vcu = (F.G % 8 == 0) ? (bx % 8) * (F.G / 8) + bx / 8 : bx; }
    F.gw = F.vcu * NWAVES + F.wave; F.NGW = F.G * NWAVES;
    unsigned char* ws = args.ws;
    volatile LAS unsigned* MISC = (volatile LAS unsigned*)(F.lds + LDSCTL_OFF);
    for (int u = F.tid; u < (LDS_BYTES - LDSCTL_OFF) / 4; u += NWAVES * 64) ((LAS unsigned*)(F.lds + LDSCTL_OFF))[u] = 0u;
    __syncthreads();
    XcdBarrier bar = xcd_barrier_post((unsigned*)(ws + WS_CTL) + CW_BAR, MISC + 8);
    const int lo = args.ph_lo, hi = args.ph_hi;
#ifndef PH_MASK
#define PH_MASK 0xFFFF
#endif
#define IN(k) (lo <= (k) && (k) < hi)
#define INL(j) (((PH_MASK >> (j)) & 1) && IN(base + (j)))
#ifndef REPEAT_MASK
#define REPEAT_MASK 0
#endif
#define REP(j) for (int rep_ = 0; rep_ < 1 + ((REPEAT_MASK >> (j)) & 1); ++rep_)
#define SEAM(k) do { if (IN((k) + 1)) xcd_barrier(bar); } while (0)

#undef F
#pragma unroll 1
    for (int L = 0; L < 2; ++L) {
        const int base = L * PH_PER_LAYER;
        if (hi <= base || lo >= base + PH_PER_LAYER) continue;
        const bool lastL = (L == 1);

        if (L == 0 && INL(0)) REP(0) { const LayerIn P = layer_in(args, L); Frame F = F0; F.tid = fresh_tid(); F.lane = F.tid & 63; if (rep_) xcd_barrier(bar);
#ifndef SUBREP_MOD
#define SUBREP_MOD 0
#endif
#ifndef SUBREP_S5
#define SUBREP_S5 0
#endif
#ifndef SUBREP_SW
#define SUBREP_SW 0
#endif
            if (L == 0) { for (int q_ = 0; q_ <= SUBREP_MOD; ++q_) { prep_mod(F, args.in[1], args.in[3], args.in[4], args.in[5], pMOD); prep_rope(F, pROPE); } }
            for (int q_ = 0; q_ <= SUBREP_S5; ++q_) prep_s5(F, P, ws);
            for (int q_ = 0; q_ <= SUBREP_SW; ++q_) prep_small_weights(F, P, ws);
            SEAM(base + 0);
        }
        if (INL(1)) REP(1) { const LayerIn P = layer_in(args, L); Frame F = F0; F.tid = fresh_tid(); F.lane = F.tid & 63; if (rep_) xcd_barrier(bar); phase_norm1(F, L, args.in[0], args.in[2], pX, pH, pMOD, P.norm_mix_g, pINV, pYE, pY); SEAM(base + 1); }
        if (INL(2)) REP(2) { const LayerIn P = layer_in(args, L); Frame F = F0; F.tid = fresh_tid(); F.lane = F.tid & 63; if (rep_) xcd_barrier(bar);
            pg8::Gemm g{pH, (const bf16_t*)(ws + W_WIN), 1024, 1024, 1024};
            RowSkipOrder S; S.init(NPROJ, F.G, (int)blockIdx.x, lastL ? 1 : 0, 2, 10);
            EpiProj E{pPA, PA_W, PA_W / 256, pPG, PG_W};
            pg8::gemm_phase<EpiProj, RowSkipOrder>(F.lds, g, S, E);
            SEAM(base + 2);
        }
        if (INL(3)) REP(3) { const LayerIn P = layer_in(args, L); Frame F = F0; F.tid = fresh_tid(); F.lane = F.tid & 63; if (rep_) xcd_barrier(bar); phase_elem(F, P, pPA, pROPE, pQN, pKN, pXBC, pDT, pAU, pYCD); SEAM(base + 3); }
        if (INL(4)) REP(4) { const LayerIn P = layer_in(args, L); Frame F = F0; F.tid = fresh_tid(); F.lane = F.tid & 63; if (rep_) xcd_barrier(bar);
            using abf = attn_body::bf16;
#ifndef NO_ATTN
            for (int u = F.vcu; u < 512; u += F.G) { const int bk = u >> 5, r = u & 31, b = bk >> 1, kvh = bk & 1, h = kvh * 4 + (r >> 3), qb = r & 7;
                const size_t qrow = (size_t)b * PB + CTXL + qb * 256, krow = (size_t)b * PB;
                attn_body::attn_unit<8>((const abf*)(pQN + qrow * 512 + h * 64), 512, (const abf*)(pKN + krow * 128 + kvh * 64), 128, (const abf*)(pPA + krow * PA_W + C_V + kvh * 64), PA_W,
                                        (abf*)(pYAB + qrow * 1024 + h * 64), 1024, 36, (char*)lds_raw); }
            if (!lastL) for (int u = F.vcu; u < 64; u += F.G) { const int b = u >> 3, h = u & 7, kvh = h >> 2; const size_t krow = (size_t)b * PB;
                attn_body::attn_unit<8>((const abf*)(pQN + krow * 512 + h * 64), 512, (const abf*)(pKN + krow * 128 + kvh * 64), 128, (const abf*)(pPA + krow * PA_W + C_V + kvh * 64), PA_W,
                                        (abf*)(pYAB + krow * 1024 + h * 64), 1024, 4, (char*)lds_raw); }
#endif
            __syncthreads();
#ifndef NO_E1
            ssd_chunk_states(F, P, pXBC, pDT, pSS, pTOT);
#endif
#ifndef NO_S5S
            { pg8::Gemm g{pAU, (const bf16_t*)(ws + W_P), 768, 512, 512}; OrderS5S S{F.G, (int)blockIdx.x}; EpiS5S E{pS5S};
              pg8::gemm_phase<EpiS5S, OrderS5S>(F.lds, g, S, E); }
#endif
            SEAM(base + 4);
        }
        if (INL(5)) REP(5) { const LayerIn P = layer_in(args, L); Frame F = F0; F.tid = fresh_tid(); F.lane = F.tid & 63; if (rep_) xcd_barrier(bar); ssd_recurrence(F, pSS, pTOT, pHIN); s5_recurrence(F, P, pS5S, pAU); SEAM(base + 5); }
        if (INL(6)) REP(6) { const LayerIn P = layer_in(args, L); Frame F = F0; F.tid = fresh_tid(); F.lane = F.tid & 63; if (rep_) xcd_barrier(bar);
#ifndef NO_E3
            ssd_output(F, P, pXBC, pPA, pDT, pHIN, pYAB, pSSQ, lastL);
#endif
#ifndef NO_S5Y
            { pg8::Gemm g{pAU, (const bf16_t*)(ws + W_TQ), 768, 768, 768}; OrderS5Y S{F.G, (int)blockIdx.x}; EpiS5Y E{pAU, pYG, P.s5_d};
              pg8::gemm_phase<EpiS5Y, OrderS5Y>(F.lds, g, S, E); }
#endif
            SEAM(base + 6);
        }
        if (INL(7)) REP(7) { const LayerIn P = layer_in(args, L); Frame F = F0; F.tid = fresh_tid(); F.lane = F.tid & 63; if (rep_) xcd_barrier(bar);
            for (int R = F.gw; R < MROWS; R += F.NGW) {
                if (lastL && (R % PB) < CTXL) continue;
                const float rs = 1.0f / sqrtf((pSSQ[2 * R] + pSSQ[2 * R + 1]) * (1.f / 512.f) + RMS_EPS);
                bf16_t* yb = pYAB + (size_t)R * 1024 + 512 + 8 * F.lane; float v[8]; unpack8(*(const u32x4*)yb, v);
#pragma unroll
                for (int k = 0; k < 8; ++k) v[k] *= rs;
                *(u32x4*)yb = pack8(v); }
            pg8::Gemm g{pYG, (const bf16_t*)(ws + W_GLU), 384, 384, 384};
            RowSkipOrder S; S.init(512, F.G, (int)blockIdx.x, lastL ? 1 : 0, 0, 0);
            EpiGlu E{pYG, pYCD, P.s5_bglu};
            pg8::gemm_phase<EpiGlu, RowSkipOrder>(F.lds, g, S, E);
            SEAM(base + 7);
        }
        if (INL(8)) REP(8) { const LayerIn P = layer_in(args, L); Frame F = F0; F.tid = fresh_tid(); F.lane = F.tid & 63; if (rep_) xcd_barrier(bar);
            MergeOrder S; S.init(F.G, (int)blockIdx.x, lastL ? 1 : 0);
            pg8::MergeArgs MA{pYAB, pYCD, (const bf16_t*)(ws + W_BR4), pPG, pMRGB};
            pg8::gemm_merge_phase<MergeOrder>(F.lds, MA, S);
            if (!lastL) { __syncthreads(); prep_expert_weights(F, P, ws, 64, 0, EW_SPLIT1); }
            SEAM(base + 8);
        }
        if (INL(9)) REP(9) { const LayerIn P = layer_in(args, L); Frame F = F0; F.tid = fresh_tid(); F.lane = F.tid & 63; if (rep_) xcd_barrier(bar);
            pg8::Gemm g{pMRGB, (const bf16_t*)(ws + W_OUT), 1024, 1024, 1024};
            RowSkipOrder S; S.init(1024, F.G, (int)blockIdx.x, lastL ? 1 : 0, 0, 0);
            EpiWout E{pY};
            pg8::gemm_phase<EpiWout, RowSkipOrder>(F.lds, g, S, E);
            if (!lastL) { __syncthreads(); prep_expert_weights(F, P, ws, 32, EW_SPLIT1, EW_SPLIT2); }
            SEAM(base + 9);
        }
        if (INL(10)) REP(10) { const LayerIn P = layer_in(args, L); Frame F = F0; F.tid = fresh_tid(); F.lane = F.tid & 63; if (rep_) xcd_barrier(bar); phase_norm2(F, L, lastL, pX, pY, pH, pMOD, P.norm_ffn_g, P.w_router, pAFF); SEAM(base + 10); }
        if (INL(11)) REP(11) { const LayerIn P = layer_in(args, L); Frame F = F0; F.tid = fresh_tid(); F.lane = F.tid & 63; if (rep_) xcd_barrier(bar); phase_topk(F, lastL ? 128 : 256, pAFF, pSRC, pGV, pINV);
            if (L == 0) { const LayerIn P1 = layer_in(args, 1); prep_s5(F, P1, ws); __syncthreads(); prep_small_weights(F, P1, ws); }
            prep_expert_weights(F, P, ws, (L == 0) ? 96 : 0, (L == 0) ? EW_SPLIT2 : 0, EXPERT_W_ITEMS); SEAM(base + 11); }
        if (INL(12)) REP(12) { const LayerIn P = layer_in(args, L); Frame F = F0; F.tid = fresh_tid(); F.lane = F.tid & 63; if (rep_) xcd_barrier(bar); phase_gather(F, lastL ? 2048 : 2304, pSRC, pH, pXG); SEAM(base + 12); }
        if (INL(13)) REP(13) { const LayerIn P = layer_in(args, L); Frame F = F0; F.tid = fresh_tid(); F.lane = F.tid & 63; if (rep_) xcd_barrier(bar);
            pg8::Gemm g{pXG, (const bf16_t*)(ws + WS_WGU), 1024, 1024, 1024}; OrderUp S{F.G, (int)blockIdx.x, lastL ? 8 : 9}; EpiUp E{pHID};
            pg8::gemm_phase<EpiUp, OrderUp>(F.lds, g, S, E);
            SEAM(base + 13);
        }
        if (INL(14)) REP(14) { const LayerIn P = layer_in(args, L); Frame F = F0; F.tid = fresh_tid(); F.lane = F.tid & 63; if (rep_) xcd_barrier(bar);
            pg8::Gemm g{pHID, (const bf16_t*)(ws + WS_WD), 1024, 1024, 1024}; OrderDown S{F.G, (int)blockIdx.x, lastL ? 8 : 9}; EpiDown E{pYE, pGV};
            pg8::gemm_phase<EpiDown, OrderDown>(F.lds, g, S, E);
            SEAM(base + 14);
        }
    }
#ifdef EXTRA_BARRIERS
    for (int eb = 0; eb < EXTRA_BARRIERS; ++eb) xcd_barrier(bar);
#endif
    if (IN(PH_FINAL)) phase_final(F0, pX, args.out, pMOD, args.in[37], pINV, pYE, pY);
#undef IN
#undef INL
#undef SEAM
}

#ifndef MK_N_LAUNCHES
#define MK_N_LAUNCHES 1
#endif
extern "C" void kernel_launch(void* const* d_in, const int* in_sizes, int n_in, void* d_out, int out_size, void* d_ws, size_t ws_size, hipStream_t stream) {
    static int grid = 0;
    if (grid == 0) {
        if (n_in != 38 || ws_size < WS_END) { fprintf(stderr, "kernel_launch: unexpected inputs (n_in %d, ws %zu)\n", n_in, ws_size); grid = -1; return; }
        int dev = 0, cus = 0;
        if (hipGetDevice(&dev) != hipSuccess || hipDeviceGetAttribute(&cus, hipDeviceAttributeMultiprocessorCount, dev) != hipSuccess) { grid = -1; return; }
        if (hipFuncSetAttribute((const void*)hybrid_fwd, hipFuncAttributeMaxDynamicSharedMemorySize, LDS_BYTES) != hipSuccess) { fprintf(stderr, "kernel_launch: hipFuncSetAttribute failed\n"); grid = -1; return; }
        (void)hipGetLastError();
        grid = (cus / 8) * 8;
        if (grid > 256) grid = 256;
    }
    if (grid < 0) return;
    if (hipMemsetAsync((char*)d_ws + WS_CTL, 0, CTL_ZERO_BYTES, stream) != hipSuccess) return;
    Args a{};
    for (int i = 0; i < 38; ++i) a.in[i] = (const float*)d_in[i];
    a.out = (float*)d_out; a.ws = (unsigned char*)d_ws;
#if MK_N_LAUNCHES == 1
    a.ph_lo = 0; a.ph_hi = PH_TOTAL;
    hipLaunchKernelGGL(hybrid_fwd, dim3(grid), dim3(NWAVES * 64), LDS_BYTES, stream, a);
#else
    for (int p = 0; p < PH_TOTAL; ++p) { a.ph_lo = p; a.ph_hi = p + 1; hipLaunchKernelGGL(hybrid_fwd, dim3(grid), dim3(NWAVES * 64), LDS_BYTES, stream, a); }
#endif
}
```

```cpp
#include <hip/hip_runtime.h>
#include <hip/hip_bf16.h>
#include <cstdio>
#include <cstdint>
#include <cmath>

#define DI __device__ __forceinline__
#define GAS __attribute__((address_space(1)))
#define LAS __attribute__((address_space(3)))
typedef unsigned short bf16_t;
typedef short bf16x8 __attribute__((ext_vector_type(8)));
typedef short s16x4 __attribute__((ext_vector_type(4)));
typedef float f32x2 __attribute__((ext_vector_type(2)));
typedef float f32x4 __attribute__((ext_vector_type(4)));
typedef float f32x16 __attribute__((ext_vector_type(16)));
typedef unsigned u32x2 __attribute__((ext_vector_type(2)));
typedef unsigned u32x4 __attribute__((ext_vector_type(4)));
typedef GAS unsigned gu32;

constexpr int DM = 1024, NB = 8, SEQ = 2048, CTXL = 256, PB = 2304, MROWS = NB * PB;
constexpr int NIN = 7688, NE = 16, EFF = 1024;
constexpr int C_Q = 0, C_K = 512, C_V = 640, C_Z = 768, C_XBC = 1280, C_DT = 2048, C_U = 2056, C_SB = 2440, C_SG = 2824, C_SH = 3208, C_G = 3592;
constexpr int PA_W = 3840, PG_W = 4096, NPROJ = PA_W + PG_W;
constexpr int EROWS = 2304;
constexpr float RMS_EPS = 1e-6f;
constexpr float ATT_C2 = 0.125f * 1.4426950408889634f;

constexpr size_t MiB = 1u << 20;
constexpr size_t WS_CTL = 0, CTL_ZERO_BYTES = 1 * MiB;
constexpr size_t WS_MOD = 1 * MiB;
constexpr size_t WS_ROPE = WS_MOD + 512 * 1024;
constexpr size_t WS_AFF = 2 * MiB;
constexpr size_t WS_INV = WS_AFF + 1280 * 1024;
constexpr size_t WS_DT = WS_INV + 1280 * 1024;
constexpr size_t WS_SRC = WS_DT + 1280 * 1024;
constexpr size_t WS_GV = WS_SRC + 256 * 1024;
constexpr size_t WS_SSQ = WS_GV + 256 * 1024;
constexpr size_t WS_TOT = WS_SSQ + 256 * 1024;
constexpr size_t WS_X = 8 * MiB;
constexpr size_t WS_W = 80 * MiB;
constexpr size_t W_WIN = WS_W;
constexpr size_t W_BR4 = W_WIN + (size_t)NPROJ * 1024 * 2;
constexpr size_t W_OUT = W_BR4 + (size_t)1024 * 1792 * 2;
constexpr size_t W_GLU = W_OUT + 1024 * 1024 * 2;
constexpr size_t W_TQ = W_GLU + 512 * 384 * 2;
constexpr size_t W_P = W_TQ + (size_t)24 * 512 * 768 * 2;
constexpr size_t W_END = W_P + (size_t)24 * 256 * 512 * 2;
constexpr size_t WS_H = 126 * MiB;
constexpr size_t WS_YAB = WS_H;
constexpr size_t WS_PA = 162 * MiB;
constexpr size_t WS_MRGB = WS_PA, WS_XG = WS_PA, WS_Y = WS_PA + 72 * MiB;
constexpr size_t WS_PG = 297 * MiB;
constexpr size_t WS_HID = WS_PG, WS_YE = WS_PG + 72 * MiB;
constexpr size_t WS_R5 = 441 * MiB;
constexpr size_t WS_QN = WS_R5;
constexpr size_t WS_KN = WS_R5 + 18 * MiB;
constexpr size_t WS_HIN = WS_R5;
constexpr size_t WS_XBC = WS_R5 + 22 * MiB + 512 * 1024;
constexpr size_t WS_AU = WS_R5 + 49 * MiB + 512 * 1024;
constexpr size_t WS_S = WS_R5 + 70 * MiB;
constexpr size_t WS_YG = WS_S;
constexpr size_t WS_S5S = WS_R5 + 106 * MiB;
constexpr size_t WS_YCD = WS_S5S + 13 * MiB + 512 * 1024;
constexpr size_t WS_WGU = WS_R5;
constexpr size_t WS_WD = WS_R5 + 64 * MiB;
constexpr size_t WS_END = WS_YCD + 27 * MiB;
static_assert(W_END <= WS_H, "small weights fit");
static_assert(WS_AU + (size_t)24 * 576 * 768 * 2 <= WS_S && WS_XBC + (size_t)MROWS * 768 * 2 <= WS_AU && WS_S + (size_t)8 * 18 * 16 * 4096 * 4 <= WS_S5S, "R5 map");
static_assert(WS_S5S + (size_t)24 * 576 * 256 * 4 <= WS_YCD && WS_YCD + (size_t)MROWS * 768 * 2 <= WS_END && WS_WD + (size_t)32 * MiB <= WS_YCD && WS_END <= (size_t)588 * MiB, "R5 map 2");
static_assert(WS_TOT + 16384 <= WS_X && WS_ROPE + 2048 * 64 * 4 <= WS_AFF, "misc map");

constexpr int CW_BAR = 4096;

constexpr int NWAVES = 8;
constexpr int LDS_SCRATCH = 151552;
constexpr int LDSCTL_OFF = LDS_SCRATCH;
constexpr int LDS_BYTES = 155648;

#define LDS_WAIT() asm volatile("s_waitcnt lgkmcnt(0)" ::: "memory")
#define VM_WAIT() asm volatile("s_waitcnt vmcnt(0)" ::: "memory")
DI int fresh_tid() { int t = threadIdx.x; asm volatile("" : "+v"(t)); return t; }
DI unsigned f2bf(float f) { unsigned u = __builtin_bit_cast(unsigned, f); return (u + 0x7fffu + ((u >> 16) & 1u)) >> 16; }
DI unsigned pk2(float lo, float hi) { return f2bf(lo) | (f2bf(hi) << 16); }
DI float bflo(unsigned w) { return __builtin_bit_cast(float, w << 16); }
DI float bfhi(unsigned w) { return __builtin_bit_cast(float, w & 0xffff0000u); }
DI float bf2f(bf16_t h) { return __builtin_bit_cast(float, (unsigned)h << 16); }
DI float silu_f(float x) { return x / (1.f + __expf(-x)); }
DI float sigmoid_f(float x) { return 1.f / (1.f + __expf(-x)); }
DI float softplus_f(float x) { return fmaxf(x, 0.f) + log1pf(__expf(-fabsf(x))); }
DI float gelu_tanh_f(float x) { const float u = 0.7978845608028654f * (x + 0.044715f * x * x * x); const float t = 1.f - 2.f / (__expf(2.f * u) + 1.f); return 0.5f * x * (1.f + t); }
DI float wave_sum(float v) {
#pragma unroll
    for (int o = 1; o < 64; o <<= 1) v += __shfl_xor(v, o);
    return v;
}
DI void unpack8(const u32x4 w, float (&f)[8]) {
    f[0] = bflo(w.x); f[1] = bfhi(w.x); f[2] = bflo(w.y); f[3] = bfhi(w.y); f[4] = bflo(w.z); f[5] = bfhi(w.z); f[6] = bflo(w.w); f[7] = bfhi(w.w);
}
DI u32x4 pack8(const float (&f)[8]) { u32x4 w; w.x = pk2(f[0], f[1]); w.y = pk2(f[2], f[3]); w.z = pk2(f[4], f[5]); w.w = pk2(f[6], f[7]); return w; }

#define XB_TMO      128
#define XB_XCNT(j)  (256  + 64 * (j))
#define XB_XSUB(j)  (1280 + 64 * (j))
#define XB_XGEN(j)  (2304 + 64 * (j))
#define XB_TOP      3328
#define XB_TOPGEN   3392
#define XCD_BAR_WORDS 3456
#define XB_SPIN_CAP (1u << 20)
DI unsigned xb_ld(unsigned* p)              { return __hip_atomic_load(p, __ATOMIC_RELAXED, __HIP_MEMORY_SCOPE_AGENT); }
DI unsigned xb_add(unsigned* p, unsigned v) { return __hip_atomic_fetch_add(p, v, __ATOMIC_RELAXED, __HIP_MEMORY_SCOPE_AGENT); }
DI unsigned xb_xcc_id() { return (unsigned)__builtin_amdgcn_s_getreg((3 << 11) | 20) & 0xFu; }
#define XB_SPIN(cond, bar) do { unsigned _sp = 0; while (cond) { __builtin_amdgcn_s_sleep(1); \
    if ((++_sp & 255u) == 0u) { if (xb_ld(&(bar)[XB_TMO])) break; if (_sp > XB_SPIN_CAP) { atomicAdd(&(bar)[XB_TMO], 1u); break; } } } } while (0)
struct XcdBarrier { unsigned* bar; unsigned x; volatile LAS unsigned* st; };
DI XcdBarrier xcd_barrier_post(unsigned* bar, volatile LAS unsigned* st) {
    XcdBarrier b; b.bar = bar; b.x = xb_xcc_id(); b.st = st;
    if (threadIdx.x == 0) (void)xb_add(&bar[XB_XCNT(b.x)], 1u);
    return b;
}
DI void xcd_barrier_complete(unsigned* bar, unsigned x, unsigned& nloc, unsigned& nx) {
    const unsigned G = gridDim.x * gridDim.y * gridDim.z;
    unsigned sum, cnt, mine, sp = 0u;
    for (;;) {
        sum = 0u; cnt = 0u; mine = 0u;
#pragma unroll
        for (unsigned j = 0; j < 16; ++j) { const unsigned c = xb_ld(&bar[XB_XCNT(j)]); sum += c; cnt += (c > 0u) ? 1u : 0u; mine = (j == x) ? c : mine; }
        if (sum == G) break;
        __builtin_amdgcn_s_sleep(1);
        if ((++sp & 255u) == 0u) { if (xb_ld(&bar[XB_TMO])) break; if (sp > XB_SPIN_CAP) { atomicAdd(&bar[XB_TMO], 1u); break; } }
    }
    nloc = mine > 0u ? mine : 1u; nx = cnt > 0u ? cnt : 1u;
}
DI void xcd_barrier(const XcdBarrier& b) {
    asm volatile("s_waitcnt vmcnt(0)" ::: "memory");
    __syncthreads();
    if (threadIdx.x == 0) {
        unsigned* bar = b.bar;
        __builtin_amdgcn_s_waitcnt(0);
        unsigned nloc = b.st[0], nx = b.st[1];
        if (nloc == 0u) { xcd_barrier_complete(bar, b.x, nloc, nx); b.st[0] = nloc; b.st[1] = nx; }
        const unsigned old = xb_add(&bar[XB_XSUB(b.x)], 1u);
        const unsigned gen = old / nloc;
        if (old + 1u == (gen + 1u) * nloc) {
            __builtin_amdgcn_fence(__ATOMIC_RELEASE, "agent");
            asm volatile("s_waitcnt vmcnt(0)" ::: "memory");
            const unsigned og = xb_add(&bar[XB_TOP], 1u);
            const unsigned tg = og / nx;
            if (og + 1u == (tg + 1u) * nx) xb_add(&bar[XB_TOPGEN], 1u);
            else XB_SPIN(xb_ld(&bar[XB_TOPGEN]) == tg, bar);
            __builtin_amdgcn_fence(__ATOMIC_ACQUIRE, "agent");
            xb_add(&bar[XB_XGEN(b.x)], 1u);
            asm volatile("s_waitcnt vmcnt(0)" ::: "memory");
        } else {
            XB_SPIN(xb_ld(&bar[XB_XGEN(b.x)]) == gen, bar);
            __builtin_amdgcn_fence(__ATOMIC_ACQUIRE, "agent");
            asm volatile("s_waitcnt vmcnt(0)" ::: "memory");
        }
    }
    __syncthreads();
}

namespace pg8 {
constexpr int BM = 256, BK = 64, HALF = 128, HTB = HALF * BK * 2, STAGE_BYTES = 8 * HTB, NXCD = 8, WGM = 8;
__host__ __device__ __forceinline__ int lds_byte(int r, int c) { const int st = (r >> 4) * 2 + (c >> 5), rr = r & 15, cc = c & 31, ob = rr * 64 + cc * 2; return st * 1024 + (ob ^ (((ob >> 9) & 1) << 5)); }
__host__ __device__ __forceinline__ void stage_rc(int b, int& R, int& C) { const int st = b / 1024, sb = b % 1024, swz = sb ^ (((sb >> 9) & 1) << 5); R = (st >> 1) * 16 + swz / 64; C = (st & 1) * 32 + (swz % 64) / 2; }
__host__ __device__ __forceinline__ int perm32(int rho) { const int n = rho >> 4, i = rho & 15; return 8 * (i >> 2) + 4 * n + (i & 3); }

struct Unit { int arow, brow, pm, pn; };
struct Gemm { const bf16_t* A; const bf16_t* Bt; int lda, ldb, K; };

template <class Epi, class Sched, bool ALIGN_EPI = true>
DI void gemm_phase(LAS unsigned char* lds, const Gemm g, const Sched& S, const Epi& E) {
    const int tid = fresh_tid(), wid = __builtin_amdgcn_readfirstlane(tid >> 6), lane = tid & 63, wr = wid >> 2, wc = wid & 3, fr = lane & 15, fq = lane >> 4;
    const int K = g.K, nt = K / BK;
    unsigned voffA[2], voffB[2];
#pragma unroll
    for (int i = 0; i < 2; ++i) { int R, C; stage_rc(tid * 16 + i * 8192, R, C); const int Rb = Epi::PERM ? ((R & ~31) + perm32(R & 31)) : R;
        voffA[i] = (unsigned)(R * g.lda + C) * 2u; voffB[i] = (unsigned)(Rb * g.ldb + C) * 2u; }
    const size_t kstep = (size_t)(BK * 2);
    const size_t hA = (size_t)HALF * g.lda * 2, hB = (size_t)HALF * g.ldb * 2;
    const unsigned ldsw = (unsigned)wid * 1024u;
    const int aoff = lds_byte(wr * 64 + fr, fq * 8), boff = lds_byte(wc * 32 + fr, fq * 8);
#define PG8_SA(b, h) (((b) * 2 + (h)) * HTB)
#define PG8_SB(b, h) ((4 + (b) * 2 + (h)) * HTB)
#define PG8_STAGE(bufoff, gbase, voff) do { _Pragma("unroll") for (int _i = 0; _i < 2; ++_i) \
        __builtin_amdgcn_global_load_lds((const unsigned*)((const char*)(gbase) + (voff)[_i]), (LAS unsigned*)(lds + (bufoff) + ldsw + _i * 8192), 16, 0, 0); } while (0)
#define PG8_LDA(dst, b, h) do { _Pragma("unroll") for (int m = 0; m < 4; ++m) _Pragma("unroll") for (int k = 0; k < 2; ++k) dst[m][k] = *(const LAS bf16x8*)(lds + PG8_SA(b, h) + aoff + m * 2048 + k * 1024); } while (0)
#define PG8_LDB(dst, b, h) do { _Pragma("unroll") for (int n = 0; n < 2; ++n) _Pragma("unroll") for (int k = 0; k < 2; ++k) dst[n][k] = *(const LAS bf16x8*)(lds + PG8_SB(b, h) + boff + n * 2048 + k * 1024); } while (0)
#define PG8_MMA(ai, bj, At, Bt) do { __builtin_amdgcn_s_setprio(1); _Pragma("unroll") for (int m = 0; m < 4; ++m) _Pragma("unroll") for (int n = 0; n < 2; ++n) _Pragma("unroll") for (int k = 0; k < 2; ++k) \
        acc[ai][bj][m][n] = __builtin_amdgcn_mfma_f32_16x16x32_bf16(Bt[n][k], At[m][k], acc[ai][bj][m][n], 0, 0, 0); __builtin_amdgcn_s_setprio(0); } while (0)
#define PG8_WAIT_V(n) asm volatile("s_waitcnt vmcnt(" #n ")" ::: "memory")
#define PG8_WAIT_L(n) asm volatile("s_waitcnt lgkmcnt(" #n ")" ::: "memory")
#define PG8_BAR __builtin_amdgcn_s_barrier()
#define PG8_SCHED __builtin_amdgcn_sched_barrier(0)
    int ui = 0;
    Unit cur = S.next(0);
    if (cur.arow < 0) return;
    f32x4 acc[2][2][4][2];
#pragma unroll
    for (int a = 0; a < 2; ++a)
#pragma unroll
        for (int b = 0; b < 2; ++b)
#pragma unroll
            for (int m = 0; m < 4; ++m)
#pragma unroll
                for (int n = 0; n < 2; ++n) acc[a][b][m][n] = (f32x4){0.f, 0.f, 0.f, 0.f};
    bf16x8 At[4][2], B0[2][2], B1[2][2];
    const char* cA = (const char*)g.A + (size_t)cur.arow * g.lda * 2; const char* cB = (const char*)g.Bt + (size_t)cur.brow * g.ldb * 2;
    PG8_STAGE(PG8_SB(0, 0), cB, voffB); PG8_STAGE(PG8_SB(0, 1), cB + hB, voffB); PG8_STAGE(PG8_SA(0, 0), cA, voffA); PG8_STAGE(PG8_SA(0, 1), cA + hA, voffA);
    if (wr == 1) PG8_BAR;
    PG8_WAIT_V(2); PG8_BAR;
    PG8_STAGE(PG8_SB(1, 0), cB + kstep, voffB); PG8_STAGE(PG8_SA(1, 0), cA + kstep, voffA); PG8_STAGE(PG8_SB(1, 1), cB + hB + kstep, voffB);
    PG8_WAIT_V(6); PG8_BAR;
    for (;;) {
        const Unit nxt = S.next(ui + 1);
        const bool has_next = nxt.arow >= 0;
        const char* nA = has_next ? (const char*)g.A + (size_t)nxt.arow * g.lda * 2 : cA; const char* nB = has_next ? (const char*)g.Bt + (size_t)nxt.brow * g.ldb * 2 : cB;
#pragma unroll 1
        for (int t = 0; t < nt; t += 2) {
            const bool last = (t == nt - 2);
            const char* a1 = cA + (size_t)(t + 1) * kstep;
            const char* a2 = last ? nA : cA + (size_t)(t + 2) * kstep; const char* b2 = last ? nB : cB + (size_t)(t + 2) * kstep;
            const char* a3 = a2 + kstep; const char* b3 = b2 + kstep;
            PG8_LDB(B0, 0, 0); PG8_LDB(B1, 0, 1); PG8_SCHED; PG8_LDA(At, 0, 0); PG8_STAGE(PG8_SA(1, 1), a1 + hA, voffA);
            PG8_WAIT_V(8); PG8_WAIT_L(0); PG8_BAR; PG8_MMA(0, 0, At, B0); PG8_MMA(0, 1, At, B1); PG8_BAR; PG8_SCHED;
            PG8_LDA(At, 0, 1); PG8_STAGE(PG8_SB(0, 0), b2, voffB); PG8_STAGE(PG8_SB(0, 1), b2 + hB, voffB); PG8_STAGE(PG8_SA(0, 0), a2, voffA);
            PG8_WAIT_V(8); PG8_WAIT_L(0); PG8_BAR; PG8_MMA(1, 0, At, B0); PG8_MMA(1, 1, At, B1); PG8_BAR; PG8_SCHED;
            PG8_LDB(B0, 1, 0); PG8_LDB(B1, 1, 1); PG8_SCHED; PG8_LDA(At, 1, 0); PG8_STAGE(PG8_SA(0, 1), a2 + hA, voffA);
            PG8_WAIT_V(8); PG8_WAIT_L(0); PG8_BAR; PG8_MMA(0, 0, At, B0); PG8_MMA(0, 1, At, B1); PG8_BAR; PG8_SCHED;
            PG8_LDA(At, 1, 1); PG8_STAGE(PG8_SB(1, 0), b3, voffB); PG8_STAGE(PG8_SB(1, 1), b3 + hB, voffB); PG8_STAGE(PG8_SA(1, 0), a3, voffA);
            PG8_WAIT_V(8); PG8_WAIT_L(0); PG8_BAR; PG8_MMA(1, 0, At, B0); PG8_MMA(1, 1, At, B1); PG8_BAR; PG8_SCHED;
        }
        if constexpr (ALIGN_EPI) { if (wr == 0) PG8_BAR; }
        E(acc, cur, wr, wc, fr, fq);
        if (!has_next) break;
#pragma unroll
        for (int a = 0; a < 2; ++a)
#pragma unroll
            for (int b = 0; b < 2; ++b)
#pragma unroll
                for (int m = 0; m < 4; ++m)
#pragma unroll
                    for (int n = 0; n < 2; ++n) acc[a][b][m][n] = (f32x4){0.f, 0.f, 0.f, 0.f};
        cur = nxt; cA = nA; cB = nB; ++ui;
        if constexpr (ALIGN_EPI) { if (wr == 1) PG8_BAR; }
    }
    PG8_WAIT_V(0);
    if constexpr (!ALIGN_EPI) { if (wr == 0) PG8_BAR; }
    PG8_BAR;
#undef PG8_SA
#undef PG8_SB
#undef PG8_STAGE
#undef PG8_LDA
#undef PG8_LDB
#undef PG8_MMA
#undef PG8_WAIT_V
#undef PG8_WAIT_L
#undef PG8_BAR
#undef PG8_SCHED
}

template <class Epi, class Sched, bool ALIGN_EPI = true>
DI void gemm_phase_gather(LAS unsigned char* lds, const Gemm g, const int* __restrict__ grow, const Sched& S, const Epi& E) {
    const int tid = fresh_tid(), wid = __builtin_amdgcn_readfirstlane(tid >> 6), lane = tid & 63, wr = wid >> 2, wc = wid & 3, fr = lane & 15, fq = lane >> 4;
    const int K = g.K, nt = K / BK;
    unsigned voffB[2]; int RA[2]; unsigned CA2[2];
#pragma unroll
    for (int i = 0; i < 2; ++i) { int R, C; stage_rc(tid * 16 + i * 8192, R, C); const int Rb = Epi::PERM ? ((R & ~31) + perm32(R & 31)) : R;
        RA[i] = R; CA2[i] = (unsigned)C * 2u; voffB[i] = (unsigned)(Rb * g.ldb + C) * 2u; }
    unsigned vAc[2][2];
#define PG8_GOFF(dst, arow_) do { _Pragma("unroll") for (int h_ = 0; h_ < 2; ++h_) _Pragma("unroll") for (int i_ = 0; i_ < 2; ++i_) \
        dst[h_][i_] = (unsigned)grow[(arow_) + h_ * HALF + RA[i_]] * (unsigned)(g.lda * 2) + CA2[i_]; } while (0)
    const size_t kstep = (size_t)(BK * 2);
    const size_t hB = (size_t)HALF * g.ldb * 2;
    const unsigned ldsw = (unsigned)wid * 1024u;
    const int aoff = lds_byte(wr * 64 + fr, fq * 8), boff = lds_byte(wc * 32 + fr, fq * 8);
#define PG8_SA(b, h) (((b) * 2 + (h)) * HTB)
#define PG8_SB(b, h) ((4 + (b) * 2 + (h)) * HTB)
#define PG8_STAGE(bufoff, gbase, voff) do { _Pragma("unroll") for (int _i = 0; _i < 2; ++_i) \
        __builtin_amdgcn_global_load_lds((const unsigned*)((const char*)(gbase) + (voff)[_i]), (LAS unsigned*)(lds + (bufoff) + ldsw + _i * 8192), 16, 0, 0); } while (0)
#define PG8_STAGEA(bufoff, kbyte, vv, hf) do { _Pragma("unroll") for (int _i = 0; _i < 2; ++_i) \
        __builtin_amdgcn_global_load_lds((const unsigned*)((const char*)g.A + (kbyte) + vv[hf][_i]), (LAS unsigned*)(lds + (bufoff) + ldsw + _i * 8192), 16, 0, 0); } while (0)
#define PG8_LDA(dst, b, h) do { _Pragma("unroll") for (int m = 0; m < 4; ++m) _Pragma("unroll") for (int k = 0; k < 2; ++k) dst[m][k] = *(const LAS bf16x8*)(lds + PG8_SA(b, h) + aoff + m * 2048 + k * 1024); } while (0)
#define PG8_LDB(dst, b, h) do { _Pragma("unroll") for (int n = 0; n < 2; ++n) _Pragma("unroll") for (int k = 0; k < 2; ++k) dst[n][k] = *(const LAS bf16x8*)(lds + PG8_SB(b, h) + boff + n * 2048 + k * 1024); } while (0)
#define PG8_MMA(ai, bj, At, Bt) do { __builtin_amdgcn_s_setprio(1); _Pragma("unroll") for (int m = 0; m < 4; ++m) _Pragma("unroll") for (int n = 0; n < 2; ++n) _Pragma("unroll") for (int k = 0; k < 2; ++k) \
        acc[ai][bj][m][n] = __builtin_amdgcn_mfma_f32_16x16x32_bf16(Bt[n][k], At[m][k], acc[ai][bj][m][n], 0, 0, 0); __builtin_amdgcn_s_setprio(0); } while (0)
#define PG8_WAIT_V(n) asm volatile("s_waitcnt vmcnt(" #n ")" ::: "memory")
#define PG8_WAIT_L(n) asm volatile("s_waitcnt lgkmcnt(" #n ")" ::: "memory")
#define PG8_BAR __builtin_amdgcn_s_barrier()
#define PG8_SCHED __builtin_amdgcn_sched_barrier(0)
    int ui = 0;
    Unit cur = S.next(0);
    if (cur.arow < 0) return;
    f32x4 acc[2][2][4][2];
#pragma unroll
    for (int a = 0; a < 2; ++a)
#pragma unroll
        for (int b = 0; b < 2; ++b)
#pragma unroll
            for (int m = 0; m < 4; ++m)
#pragma unroll
                for (int n = 0; n < 2; ++n) acc[a][b][m][n] = (f32x4){0.f, 0.f, 0.f, 0.f};
    bf16x8 At[4][2], B0[2][2], B1[2][2];
    const char* cB = (const char*)g.Bt + (size_t)cur.brow * g.ldb * 2;
    PG8_GOFF(vAc, cur.arow);
    PG8_STAGE(PG8_SB(0, 0), cB, voffB); PG8_STAGE(PG8_SB(0, 1), cB + hB, voffB); PG8_STAGEA(PG8_SA(0, 0), 0, vAc, 0); PG8_STAGEA(PG8_SA(0, 1), 0, vAc, 1);
    if (wr == 1) PG8_BAR;
    PG8_WAIT_V(2); PG8_BAR;
    PG8_STAGE(PG8_SB(1, 0), cB + kstep, voffB); PG8_STAGEA(PG8_SA(1, 0), kstep, vAc, 0); PG8_STAGE(PG8_SB(1, 1), cB + hB + kstep, voffB);
    PG8_WAIT_V(6); PG8_BAR;
    for (;;) {
        const Unit nxt = S.next(ui + 1);
        const bool has_next = nxt.arow >= 0;
        const char* nB = has_next ? (const char*)g.Bt + (size_t)nxt.brow * g.ldb * 2 : cB;
        int rawn[2][2];
#pragma unroll
        for (int h_ = 0; h_ < 2; ++h_)
#pragma unroll
            for (int i_ = 0; i_ < 2; ++i_) rawn[h_][i_] = has_next ? grow[nxt.arow + h_ * HALF + RA[i_]] : 0;
#pragma unroll 1
        for (int t = 0; t < nt; t += 2) {
            const bool last = (t == nt - 2);
            const size_t k1 = (size_t)(t + 1) * kstep, k2 = last ? 0 : (size_t)(t + 2) * kstep, k3 = k2 + kstep;
            const char* b2 = last ? nB : cB + (size_t)(t + 2) * kstep; const char* b3 = b2 + kstep;
            PG8_LDB(B0, 0, 0); PG8_LDB(B1, 0, 1); PG8_SCHED; PG8_LDA(At, 0, 0); PG8_STAGEA(PG8_SA(1, 1), k1, vAc, 1);
            if (last && has_next) {
#pragma unroll
                for (int h_ = 0; h_ < 2; ++h_)
#pragma unroll
                    for (int i_ = 0; i_ < 2; ++i_) vAc[h_][i_] = (unsigned)rawn[h_][i_] * (unsigned)(g.lda * 2) + CA2[i_]; }
            PG8_WAIT_V(8); PG8_WAIT_L(0); PG8_BAR; PG8_MMA(0, 0, At, B0); PG8_MMA(0, 1, At, B1); PG8_BAR; PG8_SCHED;
            PG8_LDA(At, 0, 1); PG8_STAGE(PG8_SB(0, 0), b2, voffB); PG8_STAGE(PG8_SB(0, 1), b2 + hB, voffB); PG8_STAGEA(PG8_SA(0, 0), k2, vAc, 0);
            PG8_WAIT_V(8); PG8_WAIT_L(0); PG8_BAR; PG8_MMA(1, 0, At, B0); PG8_MMA(1, 1, At, B1); PG8_BAR; PG8_SCHED;
            PG8_LDB(B0, 1, 0); PG8_LDB(B1, 1, 1); PG8_SCHED; PG8_LDA(At, 1, 0); PG8_STAGEA(PG8_SA(0, 1), k2, vAc, 1);
            PG8_WAIT_V(8); PG8_WAIT_L(0); PG8_BAR; PG8_MMA(0, 0, At, B0); PG8_MMA(0, 1, At, B1); PG8_BAR; PG8_SCHED;
            PG8_LDA(At, 1, 1); PG8_STAGE(PG8_SB(1, 0), b3, voffB); PG8_STAGE(PG8_SB(1, 1), b3 + hB, voffB); PG8_STAGEA(PG8_SA(1, 0), k3, vAc, 0);
            PG8_WAIT_V(8); PG8_WAIT_L(0); PG8_BAR; PG8_MMA(1, 0, At, B0); PG8_MMA(1, 1, At, B1); PG8_BAR; PG8_SCHED;
        }
        if constexpr (ALIGN_EPI) { if (wr == 0) PG8_BAR; }
        E(acc, cur, wr, wc, fr, fq);
        if (!has_next) break;
#pragma unroll
        for (int a = 0; a < 2; ++a)
#pragma unroll
            for (int b = 0; b < 2; ++b)
#pragma unroll
                for (int m = 0; m < 4; ++m)
#pragma unroll
                    for (int n = 0; n < 2; ++n) acc[a][b][m][n] = (f32x4){0.f, 0.f, 0.f, 0.f};
        cur = nxt; cB = nB; ++ui;
        if constexpr (ALIGN_EPI) { if (wr == 1) PG8_BAR; }
    }
    PG8_WAIT_V(0);
    if constexpr (!ALIGN_EPI) { if (wr == 0) PG8_BAR; }
    PG8_BAR;
#undef PG8_SA
#undef PG8_SB
#undef PG8_STAGE
#undef PG8_STAGEA
#undef PG8_GOFF
#undef PG8_LDA
#undef PG8_LDB
#undef PG8_MMA
#undef PG8_WAIT_V
#undef PG8_WAIT_L
#undef PG8_BAR
#undef PG8_SCHED
}

struct MergeArgs { const bf16_t* YAB; const bf16_t* YCD; const bf16_t* W4T; const bf16_t* G; bf16_t* MRGB; };
template <class Sched>
DI void gemm_merge_phase(LAS unsigned char* lds, const MergeArgs M, const Sched& S) {
    const int tid = fresh_tid(), wid = __builtin_amdgcn_readfirstlane(tid >> 6), lane = tid & 63, wr = wid >> 2, wc = wid & 3, fr = lane & 15, fq = lane >> 4;
    constexpr int NT = 28, LDB = 1792;
    unsigned vA0[2], vA1[2], voffB[2];
#pragma unroll
    for (int i = 0; i < 2; ++i) { int R, C; stage_rc(tid * 16 + i * 8192, R, C); const int Rb = (R & ~31) + perm32(R & 31);
        vA0[i] = (unsigned)(R * 1024 + C) * 2u; vA1[i] = (unsigned)(R * 768 + C) * 2u; voffB[i] = (unsigned)(Rb * LDB + C) * 2u; }
    const size_t kstep = (size_t)(BK * 2);
    const unsigned ldsw = (unsigned)wid * 1024u;
    const int aoff = lds_byte(wr * 64 + fr, fq * 8), boff = lds_byte(wc * 32 + fr, fq * 8);
#define PG8_SA(b, h) (((b) * 2 + (h)) * HTB)
#define PG8_SB(b, h) ((4 + (b) * 2 + (h)) * HTB)
#define PG8_STAGEB(bufoff, gbase) do { _Pragma("unroll") for (int _i = 0; _i < 2; ++_i) \
        __builtin_amdgcn_global_load_lds((const unsigned*)((const char*)(gbase) + voffB[_i]), (LAS unsigned*)(lds + (bufoff) + ldsw + _i * 8192), 16, 0, 0); } while (0)
#define PG8_STAGEA(bufoff, arow_, tt, hf) do { const bool ab_ = (tt) < 16; \
        const char* gp_ = ab_ ? (const char*)M.YAB + ((size_t)(arow_) + (hf) * HALF) * 2048 + (size_t)(tt) * 128 : (const char*)M.YCD + ((size_t)(arow_) + (hf) * HALF) * 1536 + (size_t)((tt) - 16) * 128; \
        const unsigned o0_ = ab_ ? vA0[0] : vA1[0], o1_ = ab_ ? vA0[1] : vA1[1]; \
        __builtin_amdgcn_global_load_lds((const unsigned*)(gp_ + o0_), (LAS unsigned*)(lds + (bufoff) + ldsw), 16, 0, 0); \
        __builtin_amdgcn_global_load_lds((const unsigned*)(gp_ + o1_), (LAS unsigned*)(lds + (bufoff) + ldsw + 8192), 16, 0, 0); } while (0)
#define PG8_LDA(dst, b, h) do { _Pragma("unroll") for (int m = 0; m < 4; ++m) _Pragma("unroll") for (int k = 0; k < 2; ++k) dst[m][k] = *(const LAS bf16x8*)(lds + PG8_SA(b, h) + aoff + m * 2048 + k * 1024); } while (0)
#define PG8_LDB(dst, b, h) do { _Pragma("unroll") for (int n = 0; n < 2; ++n) _Pragma("unroll") for (int k = 0; k < 2; ++k) dst[n][k] = *(const LAS bf16x8*)(lds + PG8_SB(b, h) + boff + n * 2048 + k * 1024); } while (0)
#define PG8_MMA(ai, At, Bt) do { __builtin_amdgcn_s_setprio(1); _Pragma("unroll") for (int m = 0; m < 4; ++m) _Pragma("unroll") for (int n = 0; n < 2; ++n) _Pragma("unroll") for (int k = 0; k < 2; ++k) \
        acc[ai][0][m][n] = __builtin_amdgcn_mfma_f32_16x16x32_bf16(Bt[n][k], At[m][k], acc[ai][0][m][n], 0, 0, 0); __builtin_amdgcn_s_setprio(0); } while (0)
#define PG8_WAIT_V(n) asm volatile("s_waitcnt vmcnt(" #n ")" ::: "memory")
#define PG8_WAIT_L(n) asm volatile("s_waitcnt lgkmcnt(" #n ")" ::: "memory")
#define PG8_BAR __builtin_amdgcn_s_barrier()
#define PG8_SCHED __builtin_amdgcn_sched_barrier(0)
    int ui = 0;
    Unit cur = S.next(0);
    if (cur.arow < 0) return;
    f32x4 acc[2][2][4][2];
#pragma unroll
    for (int a = 0; a < 2; ++a)
#pragma unroll
        for (int b = 0; b < 2; ++b)
#pragma unroll
            for (int m = 0; m < 4; ++m)
#pragma unroll
                for (int n = 0; n < 2; ++n) acc[a][b][m][n] = (f32x4){0.f, 0.f, 0.f, 0.f};
    bf16x8 At[4][2], B0[2][2];
    const char* cB = (const char*)M.W4T + (size_t)cur.brow * LDB * 2;
    int carow = cur.arow;
    PG8_STAGEB(PG8_SB(0, 0), cB); PG8_STAGEA(PG8_SA(0, 0), carow, 0, 0); PG8_STAGEA(PG8_SA(0, 1), carow, 0, 1);
    if (wr == 1) PG8_BAR;
    PG8_WAIT_V(2); PG8_BAR;
    PG8_STAGEB(PG8_SB(1, 0), cB + kstep); PG8_STAGEA(PG8_SA(1, 0), carow, 1, 0);
    PG8_WAIT_V(4); PG8_BAR;
    for (;;) {
        const Unit nxt = S.next(ui + 1);
        const bool has_next = nxt.arow >= 0;
        const int narow = has_next ? nxt.arow : carow; const char* nB = has_next ? (const char*)M.W4T + (size_t)nxt.brow * LDB * 2 : cB;
#pragma unroll 1
        for (int t = 0; t < NT; t += 2) {
            const bool last = (t == NT - 2);
            const bool fold_it = (t == 6 || t == 14 || t == 20 || t == 26);
            u32x4 gw0[4]; int fseg = 0;
            if (fold_it) {
                const int seg = (t == 6) ? 0 : (t == 14) ? 1 : (t == 20) ? 2 : 3; fseg = seg;
                int row0 = cur.arow + wr * 64 + fr, col = cur.pn * 128 + wc * 32 + 8 * fq;
                asm volatile("" : "+v"(row0), "+v"(col));
#pragma unroll
                for (int m = 0; m < 4; ++m) gw0[m] = *(const u32x4*)(M.G + (size_t)(row0 + m * 16) * PG_W + seg * 1024 + col);
            }
            const int t2 = last ? 0 : t + 2, t3 = t2 + 1; const int arow2 = last ? narow : carow;
            const char* b2 = last ? nB : cB + (size_t)(t + 2) * kstep; const char* b3 = b2 + kstep;
            PG8_LDB(B0, 0, 0); PG8_SCHED; PG8_LDA(At, 0, 0); PG8_STAGEA(PG8_SA(1, 1), carow, t + 1, 1);
            PG8_WAIT_V(6); PG8_WAIT_L(0); PG8_BAR; PG8_MMA(0, At, B0); PG8_BAR; PG8_SCHED;
            PG8_LDA(At, 0, 1); PG8_STAGEB(PG8_SB(0, 0), b2); PG8_STAGEA(PG8_SA(0, 0), arow2, t2, 0);
            PG8_WAIT_V(6); PG8_WAIT_L(0); PG8_BAR; PG8_MMA(1, At, B0); PG8_BAR; PG8_SCHED;
            PG8_LDB(B0, 1, 0); PG8_SCHED; PG8_LDA(At, 1, 0); PG8_STAGEA(PG8_SA(0, 1), arow2, t2, 1);
            PG8_WAIT_V(6); PG8_WAIT_L(0); PG8_BAR; PG8_MMA(0, At, B0); PG8_BAR; PG8_SCHED;
            PG8_LDA(At, 1, 1); PG8_STAGEB(PG8_SB(1, 0), b3); PG8_STAGEA(PG8_SA(1, 0), arow2, t3, 0);
            PG8_WAIT_V(6); PG8_WAIT_L(0); PG8_BAR; PG8_MMA(1, At, B0); PG8_BAR; PG8_SCHED;
            if (fold_it) {
                u32x4 gw1[4];
                { int row1 = cur.arow + 128 + wr * 64 + fr, col = cur.pn * 128 + wc * 32 + 8 * fq;
                  asm volatile("" : "+v"(row1), "+v"(col));
#pragma unroll
                  for (int m = 0; m < 4; ++m) gw1[m] = *(const u32x4*)(M.G + (size_t)(row1 + m * 16) * PG_W + fseg * 1024 + col); }
#pragma unroll
                for (int ai = 0; ai < 2; ++ai)
#pragma unroll
                    for (int m = 0; m < 4; ++m) {
                        float gf[8]; unpack8(ai == 0 ? gw0[m] : gw1[m], gf);
#pragma unroll
                        for (int k = 0; k < 4; ++k) { acc[ai][1][m][0][k] += acc[ai][0][m][0][k] * sigmoid_f(gf[k]); acc[ai][1][m][1][k] += acc[ai][0][m][1][k] * sigmoid_f(gf[4 + k]); }
                        acc[ai][0][m][0] = (f32x4){0.f, 0.f, 0.f, 0.f}; acc[ai][0][m][1] = (f32x4){0.f, 0.f, 0.f, 0.f}; }
                if (t == NT - 2) {
                    int row0 = cur.arow + wr * 64 + fr, col = cur.pn * 128 + wc * 32 + 8 * fq;
                    asm volatile("" : "+v"(row0), "+v"(col));
#pragma unroll
                    for (int ai = 0; ai < 2; ++ai)
#pragma unroll
                        for (int m = 0; m < 4; ++m) { const f32x4 v0 = acc[ai][1][m][0], v1 = acc[ai][1][m][1];
                            u32x4 w; w.x = pk2(v0[0], v0[1]); w.y = pk2(v0[2], v0[3]); w.z = pk2(v1[0], v1[1]); w.w = pk2(v1[2], v1[3]);
                            *(u32x4*)(M.MRGB + (size_t)(row0 + ai * 128 + m * 16) * 1024 + col) = w;
                            acc[ai][1][m][0] = (f32x4){0.f, 0.f, 0.f, 0.f}; acc[ai][1][m][1] = (f32x4){0.f, 0.f, 0.f, 0.f}; } }
            }
        }
        if (!has_next) break;
        cur = nxt; carow = narow; cB = nB; ++ui;
    }
    PG8_WAIT_V(0);
    if (wr == 0) PG8_BAR;
    PG8_BAR;
#undef PG8_SA
#undef PG8_SB
#undef PG8_STAGEA
#undef PG8_STAGEB
#undef PG8_LDA
#undef PG8_LDB
#undef PG8_MMA
#undef PG8_WAIT_V
#undef PG8_WAIT_L
#undef PG8_BAR
#undef PG8_SCHED
}
}

using pg8::Unit;

struct EpiProj {
    static constexpr bool PERM = true;
    bf16_t* O0; int ld0; int split_pn; bf16_t* O1; int ld1;
    DI void operator()(const f32x4 (&acc)[2][2][4][2], const Unit& u, int wr, int wc, int fr, int fq) const {
        bf16_t* base; int ld, ct;
        if (u.pn < split_pn) { base = O0; ld = ld0; ct = u.pn * 256; } else { base = O1; ld = ld1; ct = (u.pn - split_pn) * 256; }
        const int row0 = u.arow + wr * 64 + fr, col0 = ct + wc * 32 + 8 * fq;
#pragma unroll
        for (int ai = 0; ai < 2; ++ai)
#pragma unroll
            for (int m = 0; m < 4; ++m) { bf16_t* rowp = base + (size_t)(row0 + ai * 128 + m * 16) * ld + col0;
#pragma unroll
                for (int bj = 0; bj < 2; ++bj) { const f32x4 v0 = acc[ai][bj][m][0], v1 = acc[ai][bj][m][1];
                    u32x4 w; w.x = pk2(v0[0], v0[1]); w.y = pk2(v0[2], v0[3]); w.z = pk2(v1[0], v1[1]); w.w = pk2(v1[2], v1[3]);
                    *(u32x4*)(rowp + bj * 128) = w; } }
    }
};

struct EpiWout {
    static constexpr bool PERM = true;
    bf16_t* Y;
    DI void operator()(const f32x4 (&acc)[2][2][4][2], const Unit& u, int wr, int wc, int fr, int fq) const {
        const int row0 = u.arow + wr * 64 + fr, col0 = u.pn * 256 + wc * 32 + 8 * fq;
#pragma unroll
        for (int ai = 0; ai < 2; ++ai)
#pragma unroll
            for (int m = 0; m < 4; ++m) { bf16_t* rowp = Y + (size_t)(row0 + ai * 128 + m * 16) * 1024 + col0;
#pragma unroll
                for (int bj = 0; bj < 2; ++bj) { const f32x4 v0 = acc[ai][bj][m][0], v1 = acc[ai][bj][m][1];
                    u32x4 w; w.x = pk2(v0[0], v0[1]); w.y = pk2(v0[2], v0[3]); w.z = pk2(v1[0], v1[1]); w.w = pk2(v1[2], v1[3]);
                    *(u32x4*)(rowp + bj * 128) = w; } }
    }
};

struct EpiGlu {
    static constexpr bool PERM = true;
    const bf16_t* YG; bf16_t* YC; const float* bglu;
    DI void operator()(const f32x4 (&acc)[2][2][4][2], const Unit& u, int wr, int wc, int fr, int fq) const {
        const int row0 = u.arow + wr * 64 + fr, col0 = u.pn * 256 + wc * 32 + 8 * fq;
#pragma unroll
        for (int bj = 0; bj < 2; ++bj) { const int col = col0 + bj * 128; if (u.pn == 1 && bj == 1) continue;
            const f32x4 b0 = *(const f32x4*)(bglu + col), b1 = *(const f32x4*)(bglu + col + 4);
#pragma unroll
            for (int ai = 0; ai < 2; ++ai) { u32x4 yw[4];
#pragma unroll
                for (int m = 0; m < 4; ++m) yw[m] = *(const u32x4*)(YG + (size_t)(row0 + ai * 128 + m * 16) * 384 + col);
#pragma unroll
                for (int m = 0; m < 4; ++m) { float y[8]; unpack8(yw[m], y);
                    const f32x4 a0 = acc[ai][bj][m][0] + b0, a1 = acc[ai][bj][m][1] + b1;
                    float o[8];
#pragma unroll
                    for (int k = 0; k < 4; ++k) { o[k] = y[k] * sigmoid_f(a0[k]); o[4 + k] = y[4 + k] * sigmoid_f(a1[k]); }
                    *(u32x4*)(YC + (size_t)(row0 + ai * 128 + m * 16) * 768 + col) = pack8(o); }
                __builtin_amdgcn_sched_barrier(0); } }
    }
};

struct EpiS5S {
    static constexpr bool PERM = true;
    float* S;
    DI void operator()(const f32x4 (&acc)[2][2][4][2], const Unit& u, int wr, int wc, int fr, int fq) const {
        const int m0 = u.pn * 256 + wr * 64 + fr, col0 = wc * 32 + 8 * fq;
#pragma unroll
        for (int ai = 0; ai < 2; ++ai)
#pragma unroll
            for (int m = 0; m < 4; ++m) { const int mm = m0 + ai * 128 + m * 16; if (u.pn == 2 && (ai == 1 || wr == 1)) continue;
                float* p = S + ((size_t)u.pm * 576 + mm) * 256 + col0;
#pragma unroll
                for (int bj = 0; bj < 2; ++bj) { *(f32x4*)(p + bj * 128) = acc[ai][bj][m][0]; *(f32x4*)(p + bj * 128 + 4) = acc[ai][bj][m][1]; } }
    }
};

struct EpiS5Y {
    static constexpr bool PERM = true;
    const bf16_t* AU; bf16_t* YG; const float* dsk;
    DI void operator()(const f32x4 (&acc)[2][2][4][2], const Unit& u, int wr, int wc, int fr, int fq) const {
        const int g = u.pm / 3, j = u.pm % 3;
        const int m0 = j * 256 + wr * 64 + fr, n0 = u.pn * 256 + wc * 32 + 8 * fq;
#pragma unroll
        for (int bj = 0; bj < 2; ++bj) { const int n = n0 + bj * 128, i = n >> 4, a0 = n & 15;
            const f32x4 d0 = *(const f32x4*)(dsk + g * 16 + a0), d1 = *(const f32x4*)(dsk + g * 16 + a0 + 4);
#pragma unroll
            for (int ai = 0; ai < 2; ++ai) { if (j == 2 && (ai == 1 || wr == 1)) continue;
                u32x4 uw[4];
#pragma unroll
                for (int m = 0; m < 4; ++m) uw[m] = *(const u32x4*)(AU + ((size_t)g * 576 + m0 + ai * 128 + m * 16) * 768 + n);
#pragma unroll
                for (int m = 0; m < 4; ++m) { const int mm = m0 + ai * 128 + m * 16; float uu[8]; unpack8(uw[m], uu);
                    const f32x4 v0 = acc[ai][bj][m][0], v1 = acc[ai][bj][m][1];
                    float o[8];
#pragma unroll
                    for (int k = 0; k < 4; ++k) { o[k] = gelu_tanh_f(v0[k] + d0[k] * uu[k]); o[4 + k] = gelu_tanh_f(v1[k] + d1[k] * uu[4 + k]); }
                    *(u32x4*)(YG + (size_t)(mm * 32 + i) * 384 + g * 16 + a0) = pack8(o); }
                __builtin_amdgcn_sched_barrier(0); } }
    }
};

struct EpiUp {
    static constexpr bool PERM = true;
    bf16_t* HID;
    DI void operator()(const f32x4 (&acc)[2][2][4][2], const Unit& u, int wr, int wc, int fr, int fq) const {
        const int row0 = u.arow + wr * 64 + fr, col0 = u.pn * 128 + wc * 32 + 8 * fq;
#pragma unroll
        for (int ai = 0; ai < 2; ++ai)
#pragma unroll
            for (int m = 0; m < 4; ++m) { const f32x4 g0 = acc[ai][0][m][0], g1 = acc[ai][0][m][1], u0 = acc[ai][1][m][0], u1 = acc[ai][1][m][1];
                float o[8];
#pragma unroll
                for (int k = 0; k < 4; ++k) { o[k] = silu_f(g0[k]) * u0[k]; o[4 + k] = silu_f(g1[k]) * u1[k]; }
                *(u32x4*)(HID + (size_t)(row0 + ai * 128 + m * 16) * 1024 + col0) = pack8(o); }
    }
};

struct EpiDown {
    static constexpr bool PERM = true;
    bf16_t* YE; const float* GV;
    DI void operator()(const f32x4 (&acc)[2][2][4][2], const Unit& u, int wr, int wc, int fr, int fq) const {
        const int row0 = u.arow + wr * 64 + fr, col0 = u.pn * 256 + wc * 32 + 8 * fq;
#pragma unroll
        for (int ai = 0; ai < 2; ++ai)
#pragma unroll
            for (int m = 0; m < 4; ++m) { const int row = row0 + ai * 128 + m * 16; const float gv = GV[row];
#pragma unroll
                for (int bj = 0; bj < 2; ++bj) { const f32x4 v0 = acc[ai][bj][m][0] * gv, v1 = acc[ai][bj][m][1] * gv;
                    u32x4 w; w.x = pk2(v0[0], v0[1]); w.y = pk2(v0[2], v0[3]); w.z = pk2(v1[0], v1[1]); w.w = pk2(v1[2], v1[3]);
                    *(u32x4*)(YE + (size_t)row * 1024 + col0 + bj * 128) = w; } }
    }
};

DI Unit mk_unit(int arow, int brow, int pm, int pn) { Unit u; u.arow = arow; u.brow = brow; u.pm = pm; u.pn = pn; return u; }
struct RowSkipOrder {
    int nN, G, c, skipctx, keep_lo, keep_hi, nmain, total, bstep;
    DI void init(int N, int G_, int c_, int skipctx_, int keep_lo_, int keep_hi_, int bstep_ = 256) { bstep = bstep_; nN = N / bstep_; G = G_; c = c_; skipctx = skipctx_; keep_lo = keep_lo_; keep_hi = keep_hi_;
        nmain = (skipctx ? 64 : 72) * nN; total = nmain + (skipctx ? 8 * (keep_hi - keep_lo) : 0); }
    DI Unit next(int i) const {
        const int L0 = i * G + c; if (L0 >= total) return mk_unit(-1, 0, 0, 0);
        const int q = total / 8, r = total % 8, xcd = L0 % 8, off = L0 / 8;
        const int L = (xcd < r ? xcd * (q + 1) : r * (q + 1) + (xcd - r) * q) + off;
        const int nig = 8 * nN, gid = L / nig, rr = L % nig, lt = gid * 8 + (rr % 8);
        const int pm_main = skipctx ? ((lt / 8) * 9 + 1 + (lt % 8)) : lt, pn_main = rr / 8;
        const int Lc = L - nmain, pm_ctx = (Lc % 8) * 9, pn_ctx = keep_lo + Lc / 8;
        const bool main = L < nmain;
        const int pm = main ? pm_main : pm_ctx, pn = main ? pn_main : pn_ctx;
        return mk_unit(pm * 256, pn * bstep, pm, pn);
    }
};
DI int xcd_remap(int L0, int total) { const int q = total / 8, r = total % 8, xcd = L0 % 8, off = L0 / 8; return (xcd < r ? xcd * (q + 1) : r * (q + 1) + (xcd - r) * q) + off; }
struct MergeOrder {
    int G, c, skipctx, total;
    DI void init(int G_, int c_, int skipctx_) { G = G_; c = c_; skipctx = skipctx_; total = (skipctx ? 64 : 72) * 8; }
    DI Unit next(int i) const {
        const int L0 = i * G + c; if (L0 >= total) return mk_unit(-1, 0, 0, 0);
        const int L = xcd_remap(L0, total), lt = L >> 3, pn = L & 7, pm = skipctx ? ((lt / 8) * 9 + 1 + (lt % 8)) : lt;
        return mk_unit(pm * 256, pn * 128, pm, pn);
    }
};
struct OrderS5S { int G, c; DI Unit next(int i) const { const int L = i * G + c; if (L >= 72) return mk_unit(-1, 0, 0, 0); const int g = L / 3, j = L % 3; return mk_unit(g * 576 + j * 256, g * 256, g, j); } };
struct OrderS5Y { int G, c; DI Unit next(int i) const { const int L = i * G + c; if (L >= 144) return mk_unit(-1, 0, 0, 0); const int g = L / 6, r = L % 6, j = r >> 1, nh = r & 1;
    return mk_unit(g * 576 + j * 256, g * 512 + nh * 256, g * 3 + j, nh); } };
struct OrderUp { int G, c, nJ; DI Unit next(int i) const { const int L0 = i * G + c, total = 16 * nJ * 8; if (L0 >= total) return mk_unit(-1, 0, 0, 0); const int L = xcd_remap(L0, total), n = L & 7, t = L >> 3, jt = t % nJ, e = t / nJ;
    return mk_unit(e * EROWS + jt * 256, e * 2048 + n * 256, e, n); } };
struct OrderDown { int G, c, nJ; DI Unit next(int i) const { const int L0 = i * G + c, total = 16 * nJ * 4; if (L0 >= total) return mk_unit(-1, 0, 0, 0); const int L = xcd_remap(L0, total), n = L & 3, t = L >> 2, jt = t % nJ, e = t / nJ;
    return mk_unit(e * EROWS + jt * 256, e * 1024 + n * 256, e, n); } };

struct Frame {
    LAS unsigned char* lds;
    int tid, lane, wave, G, vcu, gw, NGW;
};

template <class DstRow>
DI void tr_item(const float* __restrict__ W, int ldw, int nvalid, int nstore, int K, bf16_t* __restrict__ WT, int k0, int n0, const DstRow& drow, const float* __restrict__ kscale, LAS float* scr  , int lane, int kofs = 0) {
    const int c4 = (lane & 15) * 4, r0 = lane >> 4;
    f32x4 v[16];
#pragma unroll
    for (int i = 0; i < 16; ++i) { const int kk = 4 * i + r0; v[i] = (n0 + c4 < nvalid) ? *(const f32x4*)(W + (size_t)(k0 + kk) * ldw + n0 + c4) : (f32x4){0.f, 0.f, 0.f, 0.f}; }
#pragma unroll
    for (int i = 0; i < 16; ++i) { const int kk = 4 * i + r0; f32x4 x = v[i]; if (kscale) x = x * kscale[k0 + kk];
        LAS float* d = scr + kk * 65 + c4; d[0] = x[0]; d[1] = x[1]; d[2] = x[2]; d[3] = x[3]; }
    LDS_WAIT(); asm volatile("" ::: "memory");
    const int c = lane & 7;
#pragma unroll
    for (int j = 0; j < 8; ++j) { const int n = (lane >> 3) + 8 * j; const LAS float* s = scr + (8 * c) * 65 + n;
        u32x4 o; o.x = pk2(s[0 * 65], s[1 * 65]); o.y = pk2(s[2 * 65], s[3 * 65]); o.z = pk2(s[4 * 65], s[5 * 65]); o.w = pk2(s[6 * 65], s[7 * 65]);
        if (n0 + n < nstore) *(u32x4*)(WT + (size_t)drow(n0 + n) * K + kofs + k0 + 8 * c) = o; }
    LDS_WAIT(); asm volatile("" ::: "memory");
}
struct DrIdent { int off; DI int operator()(int n) const { return off + n; } };
struct DrWin { DI int operator()(int n) const { return n < C_G ? n : n + (PA_W - C_G); } };
struct DrGU { int base; DI int operator()(int f) const { return base + (f >> 7) * 256 + (f & 127); } };

struct LayerIn {
    const float *w_in, *q_norm_g, *k_norm_g, *ssd_conv_w, *ssd_conv_b, *ssd_dt_bias, *ssd_a_log, *ssd_d, *ssd_norm_g;
    const float *s5_lre, *s5_lim, *s5_lstep, *s5_bre, *s5_bim, *s5_cre, *s5_cim, *s5_d, *s5_wglu, *s5_bglu, *sc_conv_w;
    const float *w_br_attn, *w_br_ssd, *w_br_s5, *w_br_sc, *w_out, *w_router, *w_gate, *w_up, *w_down, *norm_mix_g, *norm_ffn_g;
};

DI void prep_small_weights(const Frame& F, const LayerIn& P, unsigned char* ws) {
    LAS float* scr = (LAS float*)(F.lds + F.wave * 16896);
    bf16_t* WIN = (bf16_t*)(ws + W_WIN);
    constexpr int NB_WIN = (NIN + 63) / 64;
    constexpr int I_WIN = 16 * NB_WIN, I_PAD = 62, I_BA = 8 * 16, I_BB = 8 * 16, I_BC = 6 * 16, I_BD = 6 * 16, I_OUT = 16 * 16, I_GLU = 6 * 8;
    constexpr int NIT = I_WIN + I_PAD + I_BA + I_BB + I_BC + I_BD + I_OUT + I_GLU;
    for (int it = F.gw; it < NIT; it += F.NGW) {
        int r = it;
        if (r < I_WIN) { const int kb = r / NB_WIN, nb = r % NB_WIN; tr_item(P.w_in, NIN, NIN, NIN, 1024, WIN, kb * 64, nb * 64, DrWin{}, nullptr, scr, F.lane); continue; } r -= I_WIN;
        if (r < I_PAD) {
#pragma unroll
            for (int j = 0; j < 8; ++j) { const int idx = j * 64 + F.lane, row = C_G + r * 4 + (idx >> 7), ch = idx & 127; *(u32x4*)(WIN + (size_t)row * 1024 + ch * 8) = (u32x4){0u, 0u, 0u, 0u}; }
            continue; } r -= I_PAD;
        if (r < I_BA) { tr_item(P.w_br_attn, 1024, 1024, 1024, 1792, (bf16_t*)(ws + W_BR4), (r / 16) * 64, (r % 16) * 64, DrIdent{0}, nullptr, scr, F.lane, 0); continue; } r -= I_BA;
        if (r < I_BB) { tr_item(P.w_br_ssd, 1024, 1024, 1024, 1792, (bf16_t*)(ws + W_BR4), (r / 16) * 64, (r % 16) * 64, DrIdent{0}, P.ssd_norm_g, scr, F.lane, 512); continue; } r -= I_BB;
        if (r < I_BC) { tr_item(P.w_br_s5, 1024, 1024, 1024, 1792, (bf16_t*)(ws + W_BR4), (r / 16) * 64, (r % 16) * 64, DrIdent{0}, nullptr, scr, F.lane, 1024); continue; } r -= I_BC;
        if (r < I_BD) { tr_item(P.w_br_sc, 1024, 1024, 1024, 1792, (bf16_t*)(ws + W_BR4), (r / 16) * 64, (r % 16) * 64, DrIdent{0}, nullptr, scr, F.lane, 1408); continue; } r -= I_BD;
        if (r < I_OUT) { tr_item(P.w_out, 1024, 1024, 1024, 1024, (bf16_t*)(ws + W_OUT), (r / 16) * 64, (r % 16) * 64, DrIdent{0}, nullptr, scr, F.lane); continue; } r -= I_OUT;
        tr_item(P.s5_wglu, 384, 384, 512, 384, (bf16_t*)(ws + W_GLU), (r / 8) * 64, (r % 8) * 64, DrIdent{0}, nullptr, scr, F.lane);
    }
}
DI void prep_expert_weights(const Frame& F, const LayerIn& P, unsigned char* ws, int first_wg, int item_lo, int item_hi) {
    if ((int)blockIdx.x < first_wg) return;
    LAS float* scr = (LAS float*)(F.lds + F.wave * 16896);
    constexpr int PER = 16 * 16;
    for (int it = item_lo + ((int)blockIdx.x - first_wg) * NWAVES + F.wave; it < item_hi; it += (F.G - first_wg) * NWAVES) {
        const int which = it / (16 * PER), r = it % (16 * PER), e = r / PER, q = r % PER, k0 = (q / 16) * 64, n0 = (q % 16) * 64;
        if (which == 0) tr_item(P.w_gate + (size_t)e * 1024 * 1024, 1024, 1024, 1024, 1024, (bf16_t*)(ws + WS_WGU), k0, n0, DrGU{e * 2048}, nullptr, scr, F.lane);
        else if (which == 1) tr_item(P.w_up + (size_t)e * 1024 * 1024, 1024, 1024, 1024, 1024, (bf16_t*)(ws + WS_WGU), k0, n0, DrGU{e * 2048 + 128}, nullptr, scr, F.lane);
        else tr_item(P.w_down + (size_t)e * 1024 * 1024, 1024, 1024, 1024, 1024, (bf16_t*)(ws + WS_WD), k0, n0, DrIdent{e * 1024}, nullptr, scr, F.lane);
    }
}
constexpr int EXPERT_W_ITEMS = 3 * 16 * 16 * 16;

DI void prep_mod(const Frame& F, const float* __restrict__ c, const float* __restrict__ c_ctx, const float* __restrict__ w_mod, const float* __restrict__ b_mod, float* __restrict__ MOD) {
    if ((int)blockIdx.x >= 2 * 96) return;
    LAS float* sc = (LAS float*)F.lds;
    LAS float* red = sc + 9 * 1024;
    for (int o = F.tid; o < 9 * 1024; o += 512) { const float cv = (o < 8 * 1024) ? c[o] : c_ctx[o - 8 * 1024]; sc[o] = silu_f(cv); }
    __syncthreads();
    for (int it = blockIdx.x; it < 2 * 96; it += F.G) {
        const int l = it / 96, cb = it % 96, n = cb * 64 + F.lane;
        const float* W = w_mod + (size_t)l * 1024 * 6144;
        float acc[9];
#pragma unroll
        for (int r = 0; r < 9; ++r) acc[r] = 0.f;
        const int kbeg = F.wave * 128;
#pragma unroll 1
        for (int k8 = 0; k8 < 128; k8 += 16) { float w[16];
#pragma unroll
            for (int j = 0; j < 16; ++j) w[j] = W[(size_t)(kbeg + k8 + j) * 6144 + n];
#pragma unroll
            for (int j = 0; j < 16; ++j)
#pragma unroll
                for (int r = 0; r < 9; ++r) acc[r] += sc[r * 1024 + kbeg + k8 + j] * w[j]; }
#pragma unroll
        for (int r = 0; r < 9; ++r) red[(F.wave * 9 + r) * 64 + F.lane] = acc[r];
        __syncthreads();
        for (int o = F.tid; o < 9 * 64; o += 512) { const int r = o >> 6, ln = o & 63; float s = 0.f;
#pragma unroll
            for (int w = 0; w < 8; ++w) s += red[(w * 9 + r) * 64 + ln];
            MOD[((size_t)l * 9 + r) * 6144 + cb * 64 + ln] = s + b_mod[l * 6144 + cb * 64 + ln]; }
        __syncthreads();
    }
    __syncthreads();
}
DI void prep_rope(const Frame& F, float* ROPE) {
    for (int idx = blockIdx.x * 512 + F.tid; idx < 2048 * 32; idx += F.G * 512) {
        const int t = idx >> 5, j = idx & 31, i = j & 15;
        const float inv = powf(10000.f, -(float)(2 * i) / 32.f);
        const float pos = (j < 16) ? (float)(t >> 6) : (float)(t & 63);
        const float a = pos * inv;
        ROPE[t * 64 + j] = cosf(a); ROPE[t * 64 + 32 + j] = sinf(a);
    }
}

DI void prep_s5(const Frame& F, const LayerIn& P, unsigned char* ws) {
    if ((int)blockIdx.x >= 96) return;
    LAS float* pw = (LAS float*)F.lds;
    LAS float* bb = pw + 8448;
    LAS float* Kt = bb + 4096;
    LAS float* cc = Kt + 16896;
    LAS float* prm = cc + 2048;
    for (int it = blockIdx.x; it < 96; it += F.G) {
        const int g = it >> 2, qt = it & 3;
        for (int o = F.tid; o < 2048; o += 512) cc[o] = (o < 1024) ? P.s5_cre[(size_t)g * 1024 + o] : P.s5_cim[(size_t)g * 1024 + o - 1024];
        for (int o = F.tid; o < 2048; o += 512) prm[264 + o] = (o < 1024) ? P.s5_bre[(size_t)g * 1024 + o] : P.s5_bim[(size_t)g * 1024 + o - 1024];
        if (F.tid < 256) { const int d = (F.tid >> 6) & 1, p = F.tid & 63; prm[F.tid] = (F.tid < 128) ? P.s5_lre[(d * 24 + g) * 64 + p] : P.s5_lim[(d * 24 + g) * 64 + p]; }
        if (F.tid < 2) prm[256 + F.tid] = __expf(P.s5_lstep[F.tid * 24 + g]);
        __syncthreads();
        if (F.tid < 128) { const int d = F.tid >> 6, p = F.tid & 63;
            const float step = prm[256 + d], lr = prm[d * 64 + p], li = prm[128 + d * 64 + p];
            const float th = li * step, sh = sinf(0.5f * th);
            const float mag = expf(lr * step), abi = mag * sinf(th);
            const float nr = expm1f(lr * step) - 2.f * mag * sh * sh, ni = abi;
            const float den = lr * lr + li * li;
            const float cr = (nr * lr + ni * li) / den, ci = (ni * lr - nr * li) / den;
#pragma unroll
            for (int j = 0; j < 16; ++j) { const float br = prm[264 + p * 16 + j], bi = prm[264 + 1024 + p * 16 + j];
                bb[((d * 64 + p) * 16 + j) * 2 + 0] = cr * br - ci * bi; bb[((d * 64 + p) * 16 + j) * 2 + 1] = cr * bi + ci * br; } }
        for (int o = F.tid; o < 2 * 64 * 33; o += 512) { const int dp = o / 33, tau = o % 33, d = dp >> 6, p = dp & 63;
            const float step = prm[256 + d], lr = prm[d * 64 + p], li = prm[128 + d * 64 + p];
            const float m = expf(lr * step * (float)tau), a = li * step * (float)tau;
            pw[o * 2 + 0] = m * cosf(a); pw[o * 2 + 1] = m * sinf(a); }
        __syncthreads();
        for (int o = F.tid; o < 1024; o += 512) { const int d = o >> 9, a = (o >> 5) & 15, tau = o & 31; float s[16];
#pragma unroll
            for (int b_ = 0; b_ < 16; ++b_) s[b_] = 0.f;
            for (int p = 0; p < 64; ++p) { const float cre = cc[a * 64 + p], cim = cc[1024 + a * 64 + p];
                const f32x2 lp = *(const LAS f32x2*)(pw + ((d * 64 + p) * 33 + tau) * 2);
                const float wr_ = cre * lp[0] - cim * lp[1], wi_ = cre * lp[1] + cim * lp[0];
                const LAS f32x4* bp = (const LAS f32x4*)(bb + (d * 64 + p) * 32);
#pragma unroll
                for (int q4 = 0; q4 < 8; ++q4) { const f32x4 t = bp[q4]; s[2 * q4] += wr_ * t[0] - wi_ * t[1]; s[2 * q4 + 1] += wr_ * t[2] - wi_ * t[3]; } }
#pragma unroll
            for (int b_ = 0; b_ < 16; ++b_) Kt[((d * 16 + a) * 16 + b_) * 33 + tau] = s[b_]; }
        __syncthreads();
        bf16_t* TQ = (bf16_t*)(ws + W_TQ) + (size_t)g * 512 * 768;
        for (int o = F.tid; o < 128 * 64; o += 512) { const int row = qt * 128 + (o >> 6), ch = o & 63, i = row >> 4, a = row & 15, b0 = (ch >> 5) * 8, j = ch & 31; float v[8];
#pragma unroll
            for (int k = 0; k < 8; ++k) { float s_ = 0.f;
                if (j <= i) s_ += Kt[((0 * 16 + a) * 16 + b0 + k) * 33 + (i - j)];
                if (j >= i) s_ += Kt[((1 * 16 + a) * 16 + b0 + k) * 33 + (j - i)];
                v[k] = s_; }
            *(u32x4*)(TQ + (size_t)row * 768 + j * 16 + b0) = pack8(v); }
        for (int o = F.tid; o < 128 * 128; o += 512) { const int row = qt * 128 + (o >> 7), dp = o & 127, d = dp >> 6, p = dp & 63, i = row >> 4, a = row & 15; const int tau = d == 0 ? (i + 1) : (32 - i);
            const float cre = cc[a * 64 + p], cim = cc[1024 + a * 64 + p];
            const f32x2 lp = *(const LAS f32x2*)(pw + ((d * 64 + p) * 33 + tau) * 2);
            TQ[(size_t)row * 768 + 512 + d * 128 + p] = (bf16_t)f2bf(cre * lp[0] - cim * lp[1]);
            TQ[(size_t)row * 768 + 512 + d * 128 + 64 + p] = (bf16_t)f2bf(-(cre * lp[1] + cim * lp[0])); }
        bf16_t* PP = (bf16_t*)(ws + W_P) + (size_t)g * 256 * 512;
        for (int o = F.tid; o < 2 * 16 * 32; o += 512) { const int d = o >> 9, p = qt * 16 + ((o >> 5) & 15), j = o & 31; const int tau = d == 0 ? (31 - j) : j;
            const f32x2 lp = *(const LAS f32x2*)(pw + ((d * 64 + p) * 33 + tau) * 2);
            const LAS f32x4* bp = (const LAS f32x4*)(bb + (d * 64 + p) * 32);
            float vr[16], vi[16];
#pragma unroll
            for (int q4 = 0; q4 < 8; ++q4) { const f32x4 t = bp[q4];
                vr[2 * q4] = lp[0] * t[0] - lp[1] * t[1]; vi[2 * q4] = lp[0] * t[1] + lp[1] * t[0];
                vr[2 * q4 + 1] = lp[0] * t[2] - lp[1] * t[3]; vi[2 * q4 + 1] = lp[0] * t[3] + lp[1] * t[2]; }
            float h0[8], h1[8];
#pragma unroll
            for (int k = 0; k < 8; ++k) { h0[k] = vr[k]; h1[k] = vr[8 + k]; }
            bf16_t* pr = PP + (size_t)(d * 128 + p) * 512 + j * 16;
            *(u32x4*)pr = pack8(h0); *(u32x4*)(pr + 8) = pack8(h1);
#pragma unroll
            for (int k = 0; k < 8; ++k) { h0[k] = vi[k]; h1[k] = vi[8 + k]; }
            bf16_t* pi = PP + (size_t)(d * 128 + 64 + p) * 512 + j * 16;
            *(u32x4*)pi = pack8(h0); *(u32x4*)(pi + 8) = pack8(h1); }
        __syncthreads();
    }
}

struct RowCtx { int R, b, p, isctx, mrow; };
DI RowCtx row_ctx(int R) { RowCtx r; r.R = R; r.b = R / PB; r.p = R - r.b * PB; r.isctx = r.p < CTXL; r.mrow = r.isctx ? 8 : r.b; return r; }

DI void moe_combine(const Frame& F, const RowCtx& rc, f32x4 (&x)[4], const int* INV, const bf16_t* YE, const float* mod_prev  ) {
    const int myinv = (F.lane < 16) ? INV[(size_t)rc.R * 16 + F.lane] : -1;
    f32x4 s[4];
#pragma unroll
    for (int j = 0; j < 4; ++j) s[j] = (f32x4){0.f, 0.f, 0.f, 0.f};
    for (int e = 0; e < 16; ++e) { const int er = __shfl(myinv, e);
        if (er >= 0) { const bf16_t* yr = YE + (size_t)er * 1024 + 4 * F.lane;
#pragma unroll
            for (int j = 0; j < 4; ++j) { const u32x2 w = *(const u32x2*)(yr + j * 256); s[j][0] += bflo(w.x); s[j][1] += bfhi(w.x); s[j][2] += bflo(w.y); s[j][3] += bfhi(w.y); } } }
    const float* g5 = mod_prev + (size_t)rc.mrow * 6144 + 5 * 1024 + 4 * F.lane;
#pragma unroll
    for (int j = 0; j < 4; ++j) x[j] += *(const f32x4*)(g5 + j * 256) * s[j];
}
DI void add_mixer(const Frame& F, const RowCtx& rc, f32x4 (&x)[4], const bf16_t* __restrict__ Y, const float* modl  ) {
    const float* g2 = modl + (size_t)rc.mrow * 6144 + 2 * 1024 + 4 * F.lane;
    const bf16_t* yr = Y + (size_t)rc.R * 1024 + 4 * F.lane;
#pragma unroll
    for (int j = 0; j < 4; ++j) { const u32x2 w = *(const u32x2*)(yr + j * 256); const f32x4 g = *(const f32x4*)(g2 + j * 256);
        x[j][0] += g[0] * bflo(w.x); x[j][1] += g[1] * bfhi(w.x); x[j][2] += g[2] * bflo(w.y); x[j][3] += g[3] * bfhi(w.y); }
}
DI float row_rstd(const f32x4 (&x)[4]) {
    float ss = 0.f;
#pragma unroll
    for (int j = 0; j < 4; ++j) ss += (x[j][0] * x[j][0] + x[j][1] * x[j][1]) + (x[j][2] * x[j][2] + x[j][3] * x[j][3]);
    return 1.0f / sqrtf(wave_sum(ss) * (1.f / 1024.f) + RMS_EPS);
}
DI void row_modulate(const Frame& F, const f32x4 (&x)[4], float rstd, const float* g, const float* shift, const float* scale, f32x4 (&h)[4]) {
#pragma unroll
    for (int j = 0; j < 4; ++j) { const int c = j * 256 + 4 * F.lane; const f32x4 gv = *(const f32x4*)(g + c), sh = *(const f32x4*)(shift + c), sc = *(const f32x4*)(scale + c);
        h[j] = x[j] * rstd * gv * (sc + 1.0f) + sh; }
}
DI void row_store_bf16(const Frame& F, const f32x4 (&h)[4], bf16_t* dst) {
#pragma unroll
    for (int j = 0; j < 4; ++j) { u32x2 w; w.x = pk2(h[j][0], h[j][1]); w.y = pk2(h[j][2], h[j][3]); *(u32x2*)(dst + j * 256 + 4 * F.lane) = w; }
}

DI void phase_norm1(const Frame& F, int layer, const float* x_in, const float* ctx_in, float* X, bf16_t* H1, const float* MOD, const float* gmix, const int* INV, const bf16_t* YE, const bf16_t* Y) {
    const float* modl = MOD + (size_t)layer * 9 * 6144;
    for (int R = F.gw; R < MROWS; R += F.NGW) {
        const RowCtx rc = row_ctx(R);
        const float* src = rc.isctx ? ctx_in + ((size_t)rc.b * CTXL + rc.p) * 1024 : x_in + ((size_t)rc.b * SEQ + (rc.p - CTXL)) * 1024;
        f32x4 x[4];
#pragma unroll
        for (int j = 0; j < 4; ++j) x[j] = *(const f32x4*)(src + j * 256 + 4 * F.lane);
        if (layer > 0) { add_mixer(F, rc, x, Y, MOD + (size_t)(layer - 1) * 9 * 6144); moe_combine(F, rc, x, INV, YE, MOD + (size_t)(layer - 1) * 9 * 6144); }
        if (layer > 0) {
#pragma unroll
            for (int j = 0; j < 4; ++j) *(f32x4*)(X + (size_t)R * 1024 + j * 256 + 4 * F.lane) = x[j]; }
        const float rstd = row_rstd(x);
        f32x4 h[4]; row_modulate(F, x, rstd, gmix, modl + (size_t)rc.mrow * 6144, modl + (size_t)rc.mrow * 6144 + 1024, h);
        row_store_bf16(F, h, H1 + (size_t)R * 1024);
    }
}
DI void phase_final(const Frame& F, const float* X, float* out, const float* MOD, const float* gfin, const int* INV, const bf16_t* YE, const bf16_t* Y) {
    for (int q = F.gw; q < NB * SEQ; q += F.NGW) {
        const int b = q / SEQ, t = q - b * SEQ, R = b * PB + CTXL + t;
        const RowCtx rc = row_ctx(R);
        f32x4 x[4];
#pragma unroll
        for (int j = 0; j < 4; ++j) x[j] = *(const f32x4*)(X + (size_t)R * 1024 + j * 256 + 4 * F.lane);
        add_mixer(F, rc, x, Y, MOD + (size_t)1 * 9 * 6144);
        moe_combine(F, rc, x, INV, YE, MOD + (size_t)1 * 9 * 6144);
        const float rstd = row_rstd(x);
#pragma unroll
        for (int j = 0; j < 4; ++j) { const int c = j * 256 + 4 * F.lane; *(f32x4*)(out + (size_t)q * 1024 + c) = x[j] * rstd * *(const f32x4*)(gfin + c); }
    }
}

DI void phase_norm2(const Frame& F, int layer, bool skipctx, const float* x_in, const float* ctx_in, const float* X, const bf16_t* Y, bf16_t* H2, const float* MOD, const float* gffn, const float* w_router, float* AFF) {
    LAS float* wl = (LAS float*)F.lds;
    for (int idx = F.tid; idx < 16384; idx += 512) wl[(idx & 15) * 1024 + (idx >> 4)] = w_router[idx];
    __syncthreads();
    const float* modl = MOD + (size_t)layer * 9 * 6144;
    for (int R = F.gw; R < MROWS; R += F.NGW) {
        const RowCtx rc = row_ctx(R);
        if (skipctx && rc.isctx) continue;
        const float* src = (layer > 0) ? X + (size_t)R * 1024 : (rc.isctx ? ctx_in + ((size_t)rc.b * CTXL + rc.p) * 1024 : x_in + ((size_t)rc.b * SEQ + (rc.p - CTXL)) * 1024);
        f32x4 x[4];
#pragma unroll
        for (int j = 0; j < 4; ++j) x[j] = *(const f32x4*)(src + j * 256 + 4 * F.lane);
        add_mixer(F, rc, x, Y, modl);
        const float rstd = row_rstd(x);
        f32x4 h[4]; row_modulate(F, x, rstd, gffn, modl + (size_t)rc.mrow * 6144 + 3 * 1024, modl + (size_t)rc.mrow * 6144 + 4 * 1024, h);
        row_store_bf16(F, h, H2 + (size_t)R * 1024);
        float lg[16];
#pragma unroll
        for (int e = 0; e < 16; ++e) { float s = 0.f;
#pragma unroll
            for (int j = 0; j < 4; ++j) { const f32x4 w = *(const LAS f32x4*)(wl + e * 1024 + j * 256 + 4 * F.lane); s += (h[j][0] * w[0] + h[j][1] * w[1]) + (h[j][2] * w[2] + h[j][3] * w[3]); }
            lg[e] = wave_sum(s); }
        float mx = lg[0];
#pragma unroll
        for (int e = 1; e < 16; ++e) mx = fmaxf(mx, lg[e]);
        float den = 0.f, mine = 0.f;
#pragma unroll
        for (int e = 0; e < 16; ++e) { const float ex = expf(lg[e] - mx); den += ex; mine = (F.lane == e) ? ex : mine; }
        if (F.lane < 16) AFF[((size_t)rc.b * 16 + F.lane) * PB + rc.p] = mine / den;
    }
    __syncthreads();
}

DI int block_exscan(const Frame& F, int v, LAS int* wtot, int& total) {
    int incl = v;
#pragma unroll
    for (int o = 1; o < 64; o <<= 1) { const int t = __shfl_up(incl, o); if (F.lane >= o) incl += t; }
    if (F.lane == 63) wtot[F.wave] = incl;
    __syncthreads();
    int base = 0; total = 0;
#pragma unroll
    for (int w = 0; w < 8; ++w) { const int x = wtot[w]; if (w < F.wave) base += x; total += x; }
    __syncthreads();
    return base + incl - v;
}
DI void phase_topk(const Frame& F, int nitems, const float* AFF, int* SRC, float* GV, int* INV) {
    LAS int* wcnt = (LAS int*)F.lds;
    LAS int* wtot = wcnt + 16;
    for (int it = blockIdx.x; it < nitems; it += F.G) {
        const int isctx = it >= 128, be = it & 127, b = be >> 4, e = be & 15;
        const int n = isctx ? CTXL : SEQ, cap = isctx ? 32 : 256, p0 = isctx ? 0 : CTXL;
        const float* a = AFF + ((size_t)b * 16 + e) * PB + p0;
        unsigned v[4]; float av[4];
#pragma unroll
        for (int k = 0; k < 4; ++k) { const int idx = 4 * F.tid + k; av[k] = idx < n ? a[idx] : 0.f; v[k] = __builtin_bit_cast(unsigned, av[k]); }
        unsigned prefix = 0u;
        for (int bit = 30; bit >= 0; --bit) {
            const unsigned cand = prefix | (1u << bit);
            int c = 0;
#pragma unroll
            for (int k = 0; k < 4; ++k) c += __popcll(__ballot(v[k] >= cand));
            LAS int* wc = wcnt + (bit & 1) * 8;
            if (F.lane == 0) wc[F.wave] = c;
            __syncthreads();
            int tot = 0;
#pragma unroll
            for (int w = 0; w < 8; ++w) tot += wc[w];
            if (tot >= cap) prefix = cand;
        }
        __syncthreads();
        int ngt_t = 0, neq_t = 0;
#pragma unroll
        for (int k = 0; k < 4; ++k) { ngt_t += (v[k] > prefix) ? 1 : 0; neq_t += (v[k] == prefix) ? 1 : 0; }
        int ngt_total, neq_total;
        (void)block_exscan(F, ngt_t, wtot, ngt_total);
        int eq_rank = block_exscan(F, neq_t, wtot, neq_total);
        const int eq_take = cap - ngt_total;
        int sel[4], nsel_t = 0;
#pragma unroll
        for (int k = 0; k < 4; ++k) { int s = 0; if (v[k] > prefix) s = 1; else if (v[k] == prefix) { s = (eq_rank < eq_take) ? 1 : 0; ++eq_rank; } sel[k] = s; nsel_t += s; }
        int nsel_total;
        int slot = block_exscan(F, nsel_t, wtot, nsel_total);
        const int ebase = e * EROWS + (isctx ? 2048 + b * 32 : b * 256);
#pragma unroll
        for (int k = 0; k < 4; ++k) { const int idx = 4 * F.tid + k;
            if (idx < n) { const int R = b * PB + p0 + idx;
                if (sel[k]) { const int er = ebase + slot; ++slot; SRC[er] = R; GV[er] = av[k]; INV[(size_t)R * 16 + e] = er; }
                else INV[(size_t)R * 16 + e] = -1; } }
        __syncthreads();
    }
}
DI void phase_gather(const Frame& F, int rows_per_expert, const int* __restrict__ SRC, const bf16_t* __restrict__ H2, bf16_t* __restrict__ XG) {
    const int total = 16 * rows_per_expert;
    for (int q = F.gw * 4; q < total; q += F.NGW * 4) {
        const int e = q / rows_per_expert, s = q - e * rows_per_expert, er = e * EROWS + s;
        int R[4];
#pragma unroll
        for (int u = 0; u < 4; ++u) R[u] = SRC[er + u];
        u32x4 v0[4], v1[4];
#pragma unroll
        for (int u = 0; u < 4; ++u) { v0[u] = *(const u32x4*)(H2 + (size_t)R[u] * 1024 + 8 * F.lane); v1[u] = *(const u32x4*)(H2 + (size_t)R[u] * 1024 + 512 + 8 * F.lane); }
#pragma unroll
        for (int u = 0; u < 4; ++u) { *(u32x4*)(XG + (size_t)(er + u) * 1024 + 8 * F.lane) = v0[u]; *(u32x4*)(XG + (size_t)(er + u) * 1024 + 512 + 8 * F.lane) = v1[u]; }
    }
}

DI void qk_norm_rope(const float (&vin)[8], int ll, const float* __restrict__ gn, bool rope, const float* __restrict__ cs, float (&o)[8]) {
    float v[8]; float ss = 0.f;
#pragma unroll
    for (int k = 0; k < 8; ++k) ss += vin[k] * vin[k];
    ss += __shfl_xor(ss, 1); ss += __shfl_xor(ss, 2); ss += __shfl_xor(ss, 4);
    const float rstd = 1.0f / sqrtf(ss * (1.f / 64.f) + RMS_EPS);
#pragma unroll
    for (int k = 0; k < 8; ++k) v[k] = vin[k] * rstd * gn[k];
    const bool isx2 = (ll & 2) != 0;
#pragma unroll
    for (int k = 0; k < 8; ++k) { const float pv = __shfl_xor(v[k], 2); const float c = rope ? cs[k] : 1.f, s = rope ? cs[32 + k] : 0.f; o[k] = isx2 ? (v[k] * c + pv * s) : (v[k] * c - pv * s); }
}
DI void phase_elem(const Frame& F, const LayerIn& P, const bf16_t* __restrict__ PA, const float* __restrict__ ROPE, bf16_t* __restrict__ QN, bf16_t* __restrict__ KN, bf16_t* __restrict__ XBC,
                   float* __restrict__ DT, bf16_t* __restrict__ AU, bf16_t* __restrict__ YCD) {
    const int l = F.lane;
    for (int R0 = F.gw * 4; R0 < MROWS; R0 += F.NGW * 4) {
        const RowCtx rc = row_ctx(R0);
        const bf16_t* pr = PA + (size_t)R0 * PA_W;
        const bool has_prev = (rc.p != 0) && (rc.p != CTXL), has_next = (rc.p + 3 != CTXL - 1) && (rc.p + 3 != PB - 1);
        const bool rope = !rc.isctx; const int t0 = rope ? rc.p - CTXL : 0;
        { const int hb = (l & 7) >> 2, i0 = (l & 1) * 8; const float* gn = P.q_norm_g + (l & 7) * 8;
#pragma unroll
          for (int h2 = 0; h2 < 2; ++h2) { u32x4 w[2];
#pragma unroll
            for (int u = 0; u < 2; ++u) w[u] = *(const u32x4*)(pr + (size_t)(2 * h2 + u) * PA_W + C_Q + l * 8);
#pragma unroll
            for (int u = 0; u < 2; ++u) { float v[8], o[8]; unpack8(w[u], v);
                qk_norm_rope(v, l, gn, rope, ROPE + (size_t)(t0 + 2 * h2 + u) * 64 + hb * 16 + i0, o);
#pragma unroll
                for (int k = 0; k < 8; ++k) o[k] *= ATT_C2;
                *(u32x4*)(QN + (size_t)(R0 + 2 * h2 + u) * 512 + l * 8) = pack8(o); } } }
        { const int u = l >> 4, ll = l & 15, hb = (ll & 7) >> 2, i0 = (ll & 1) * 8;
          float v[8], o[8]; unpack8(*(const u32x4*)(pr + (size_t)u * PA_W + C_K + ll * 8), v);
          qk_norm_rope(v, ll, P.k_norm_g + (ll & 7) * 8, rope, ROPE + (size_t)(t0 + u) * 64 + hb * 16 + i0, o);
          *(u32x4*)(KN + (size_t)(R0 + u) * 128 + ll * 8) = pack8(o); }
#pragma unroll
        for (int pass = 0; pass < 2; ++pass) { const int ch8 = pass * 64 + l; if (ch8 >= 96) continue;
            const int ch = ch8 * 8; u32x4 w[6];
#pragma unroll
            for (int u = 0; u < 6; ++u) { const bool ok = (u == 0) ? has_prev : (u == 5) ? has_next : true;
                w[u] = ok ? *(const u32x4*)(pr + (ptrdiff_t)(u - 1) * PA_W + C_XBC + ch) : (u32x4){0u, 0u, 0u, 0u}; }
            float w0[8], w1[8], w2[8], bs[8];
#pragma unroll
            for (int k = 0; k < 8; ++k) { w0[k] = P.ssd_conv_w[ch + k]; w1[k] = P.ssd_conv_w[768 + ch + k]; w2[k] = P.ssd_conv_w[1536 + ch + k]; bs[k] = P.ssd_conv_b[ch + k]; }
            float a[8], b[8], c[8]; unpack8(w[0], a); unpack8(w[1], b);
#pragma unroll
            for (int u = 0; u < 4; ++u) { unpack8(w[u + 2], c); float o[8];
#pragma unroll
                for (int k = 0; k < 8; ++k) { o[k] = silu_f(w0[k] * a[k] + w1[k] * b[k] + w2[k] * c[k] + bs[k]); a[k] = b[k]; b[k] = c[k]; }
                *(u32x4*)(XBC + (size_t)(R0 + u) * 768 + ch) = pack8(o); } }
        { const int u = l >> 4, d = (l >> 3) & 1, h = l & 7; DT[((size_t)d * MROWS + R0 + u) * 8 + h] = softplus_f(bf2f(pr[(size_t)u * PA_W + C_DT + h]) + P.ssd_dt_bias[d * 8 + h]); }
        if (l < 48) {
            const int g = l >> 1, a0 = (l & 1) * 8, ch = l * 8;
            u32x4 uw[4], sb[4], sg[6], sh[6];
#pragma unroll
            for (int u = 0; u < 4; ++u) { uw[u] = *(const u32x4*)(pr + (size_t)u * PA_W + C_U + ch); sb[u] = *(const u32x4*)(pr + (size_t)u * PA_W + C_SB + ch); }
#pragma unroll
            for (int u = 0; u < 6; ++u) { const bool ok = (u == 0) ? has_prev : (u == 5) ? has_next : true;
                sg[u] = ok ? *(const u32x4*)(pr + (ptrdiff_t)(u - 1) * PA_W + C_SG + ch) : (u32x4){0u, 0u, 0u, 0u};
                sh[u] = ok ? *(const u32x4*)(pr + (ptrdiff_t)(u - 1) * PA_W + C_SH + ch) : (u32x4){0u, 0u, 0u, 0u}; }
#pragma unroll
            for (int u = 0; u < 4; ++u) *(u32x4*)(AU + ((size_t)g * 576 + ((R0 + u) >> 5)) * 768 + ((R0 + u) & 31) * 16 + a0) = uw[u];
            float w0[8], w1[8], w2[8];
#pragma unroll
            for (int k = 0; k < 8; ++k) { w0[k] = P.sc_conv_w[ch + k]; w1[k] = P.sc_conv_w[384 + ch + k]; w2[k] = P.sc_conv_w[768 + ch + k]; }
            float a[8], b[8], c[8], x[8], y[8];
            unpack8(sg[0], x); unpack8(sh[0], y);
#pragma unroll
            for (int k = 0; k < 8; ++k) a[k] = x[k] * y[k];
            unpack8(sg[1], x); unpack8(sh[1], y);
#pragma unroll
            for (int k = 0; k < 8; ++k) b[k] = x[k] * y[k];
#pragma unroll
            for (int u = 0; u < 4; ++u) { unpack8(sg[u + 2], x); unpack8(sh[u + 2], y); float s[8], o[8]; unpack8(sb[u], s);
#pragma unroll
                for (int k = 0; k < 8; ++k) { c[k] = x[k] * y[k]; o[k] = s[k] * (w0[k] * a[k] + w1[k] * b[k] + w2[k] * c[k]); a[k] = b[k]; b[k] = c[k]; }
                *(u32x4*)(YCD + (size_t)(R0 + u) * 768 + 384 + ch) = pack8(o); }
        }
    }
}

typedef short v4i16_t __attribute__((ext_vector_type(4)));
DI int img_off(int row, int chunk) { return row * 128 + ((chunk ^ (row & 7)) << 4); }
DI s16x4 tr_read4(const LAS unsigned char* p) { return __builtin_bit_cast(s16x4, __builtin_amdgcn_ds_read_tr16_b64_v4i16((LAS v4i16_t*)p)); }
DI bf16x8 cat8(s16x4 lo, s16x4 hi) { return (bf16x8){lo[0], lo[1], lo[2], lo[3], hi[0], hi[1], hi[2], hi[3]}; }
DI unsigned cvtpk(float lo, float hi) { typedef __bf16 bf2 __attribute__((ext_vector_type(2))); f32x2 v = {lo, hi}; bf2 b = __builtin_convertvector(v, bf2); return __builtin_bit_cast(unsigned, b); }
#define MFMA32(a, b, c) __builtin_amdgcn_mfma_f32_32x32x16_bf16((a), (b), (c), 0, 0, 0)
DI int crow(int r, int hh) { return (r & 3) + 8 * (r >> 2) + 4 * hh; }

constexpr int SSD_XH = 0, SSD_BM = 65536, SSD_CM = 81920, SSD_ARR = 131072;
DI void ssd_load_images(const Frame& F, const bf16_t* XBC, int R0, int g, bool with_c) {
#pragma unroll
    for (int it = 0; it < 8; ++it) { const int idx = it * 512 + F.tid, h4 = idx >> 10, row = (idx >> 3) & 127, ch = idx & 7;
        *(LAS u32x4*)(F.lds + SSD_XH + h4 * 16384 + img_off(row, ch)) = *(const u32x4*)(XBC + (size_t)(R0 + row) * 768 + g * 256 + h4 * 64 + ch * 8); }
#pragma unroll
    for (int it = 0; it < 2; ++it) { const int idx = it * 512 + F.tid, row = idx >> 3, ch = idx & 7;
        *(LAS u32x4*)(F.lds + SSD_BM + img_off(row, ch)) = *(const u32x4*)(XBC + (size_t)(R0 + row) * 768 + 512 + g * 64 + ch * 8);
        if (with_c) *(LAS u32x4*)(F.lds + SSD_CM + img_off(row, ch)) = *(const u32x4*)(XBC + (size_t)(R0 + row) * 768 + 640 + g * 64 + ch * 8); }
}
struct Series { float dt0, dt1, cs0, cs1, ecs0, ecs1, tot; };
DI Series ssd_series(const Frame& F, const float* DT, const float* a_log, int R0, int h, int d) {
    Series s; const float a = -__expf(a_log[d * 8 + h]);
    s.dt0 = DT[((size_t)d * MROWS + R0 + 2 * F.lane) * 8 + h]; s.dt1 = DT[((size_t)d * MROWS + R0 + 2 * F.lane + 1) * 8 + h];
    const float ad0 = s.dt0 * a, ad1 = s.dt1 * a, pair = ad0 + ad1; float incl = pair;
#pragma unroll
    for (int o = 1; o < 64; o <<= 1) { const float t = __shfl_up(incl, o); if (F.lane >= o) incl += t; }
    const float excl = incl - pair;
    s.cs0 = excl + ad0; s.cs1 = incl; s.ecs0 = excl; s.ecs1 = excl + ad0; s.tot = __shfl(incl, 63);
    return s;
}

DI void ssd_chunk_states(const Frame& F, const LayerIn& P, const bf16_t* XBC, const float* DT, float* S, float* TOT) {
    LAS float* W = (LAS float*)(F.lds + SSD_ARR);
    const int lane = F.lane, hh = lane >> 5, q = (lane & 15) >> 2, pp = lane & 3, blk = (lane >> 4) & 1;
    const int h4 = F.wave & 3, d = F.wave >> 2;
    for (int it = blockIdx.x; it < 288; it += F.G) {
        const int b = it / 36, r = it % 36, c = r >> 1, g = r & 1, R0 = b * PB + c * 128, h = 4 * g + h4;
        ssd_load_images(F, XBC, R0, g, false);
        const Series s = ssd_series(F, DT, P.ssd_a_log, R0, h, d);
        float w0, w1;
        if (d == 0) { w0 = s.dt0 * __expf(s.tot - s.cs0); w1 = s.dt1 * __expf(s.tot - s.cs1); } else { w0 = s.dt0 * __expf(s.ecs0); w1 = s.dt1 * __expf(s.ecs1); }
        *(LAS f32x2*)(W + F.wave * 128 + 2 * lane) = (f32x2){w0, w1};
        if (lane == 0) TOT[(((size_t)b * 18 + c) * 8 + h) * 2 + d] = s.tot;
        __syncthreads();
        f32x16 acc[2][2];
#pragma unroll
        for (int i = 0; i < 2; ++i)
#pragma unroll
            for (int j = 0; j < 2; ++j)
#pragma unroll
                for (int k = 0; k < 16; ++k) acc[i][j][k] = 0.f;
        const LAS unsigned char* xh = F.lds + SSD_XH + h4 * 16384;
        const LAS unsigned char* bm = F.lds + SSD_BM;
#pragma unroll 2
        for (int st = 0; st < 8; ++st) {
            const int row = 16 * st + 8 * hh + q;
            const f32x4 wa = *(const LAS f32x4*)(W + F.wave * 128 + 16 * st + 8 * hh), wb = *(const LAS f32x4*)(W + F.wave * 128 + 16 * st + 8 * hh + 4);
            bf16x8 af[2], bfr[2];
#pragma unroll
            for (int t = 0; t < 2; ++t) { const int chunk = t * 4 + 2 * blk + (pp >> 1), within = 8 * (pp & 1);
                af[t] = cat8(tr_read4(bm + img_off(row, chunk) + within), tr_read4(bm + img_off(row + 4, chunk) + within));
                const s16x4 lo = tr_read4(xh + img_off(row, chunk) + within), hi = tr_read4(xh + img_off(row + 4, chunk) + within);
                u32x4 pw;
                pw.x = cvtpk(bf2f((bf16_t)lo[0]) * wa[0], bf2f((bf16_t)lo[1]) * wa[1]); pw.y = cvtpk(bf2f((bf16_t)lo[2]) * wa[2], bf2f((bf16_t)lo[3]) * wa[3]);
                pw.z = cvtpk(bf2f((bf16_t)hi[0]) * wb[0], bf2f((bf16_t)hi[1]) * wb[1]); pw.w = cvtpk(bf2f((bf16_t)hi[2]) * wb[2], bf2f((bf16_t)hi[3]) * wb[3]);
                bfr[t] = __builtin_bit_cast(bf16x8, pw); }
#pragma unroll
            for (int nt = 0; nt < 2; ++nt)
#pragma unroll
                for (int pt = 0; pt < 2; ++pt) acc[nt][pt] = MFMA32(af[nt], bfr[pt], acc[nt][pt]);
        }
        float* Sb = S + ((((size_t)b * 18 + c) * 8 + h) * 2 + d) * 4096;
#pragma unroll
        for (int nt = 0; nt < 2; ++nt)
#pragma unroll
            for (int pt = 0; pt < 2; ++pt)
#pragma unroll
                for (int q4 = 0; q4 < 4; ++q4) { const int p = pt * 32 + (lane & 31), n0 = nt * 32 + 8 * q4 + 4 * hh;
                    *(f32x4*)(Sb + p * 64 + n0) = (f32x4){acc[nt][pt][4 * q4], acc[nt][pt][4 * q4 + 1], acc[nt][pt][4 * q4 + 2], acc[nt][pt][4 * q4 + 3]}; }
        __syncthreads();
    }
}

DI void ssd_recurrence(const Frame& F, const float* __restrict__ S, const float* __restrict__ TOT, bf16_t* __restrict__ HIN) {
    for (int gi = blockIdx.x * 512 + F.tid; gi < 128 * 1024; gi += F.G * 512) {
        const int bhd = gi >> 10, e4 = (gi & 1023) * 4, b = bhd >> 4, h = (bhd >> 1) & 7, d = bhd & 1;
        f32x4 sv[18]; float dec[18];
#pragma unroll
        for (int k = 0; k < 18; ++k) { const int c = (d == 0) ? k : (k < 2 ? 1 - k : 19 - k);
            const size_t st = (((size_t)b * 18 + c) * 8 + h) * 2 + d;
            sv[k] = *(const f32x4*)(S + st * 4096 + e4); dec[k] = TOT[st]; }
        f32x4 H = (f32x4){0.f, 0.f, 0.f, 0.f};
#pragma unroll
        for (int k = 0; k < 18; ++k) { const int c = (d == 0) ? k : (k < 2 ? 1 - k : 19 - k);
            const size_t st = (((size_t)b * 18 + c) * 8 + h) * 2 + d;
            u32x2 w; w.x = pk2(H[0], H[1]); w.y = pk2(H[2], H[3]);
            *(u32x2*)(HIN + st * 4096 + e4) = w;
            H = H * __expf(dec[k]) + sv[k]; }
    }
}

DI void ssd_output(const Frame& F, const LayerIn& P, const bf16_t* XBC, const bf16_t* PA, const float* DT, const bf16_t* HIN, bf16_t* YB, float* SSQ, bool skipctx) {
    LAS float* ARR = (LAS float*)(F.lds + SSD_ARR);
    const int lane = F.lane, hh = lane >> 5, q = (lane & 15) >> 2, pp = lane & 3, blk = (lane >> 4) & 1, l31 = lane & 31;
    for (int it = blockIdx.x; it < 288; it += F.G) {
        const int b = it / 36, r_ = it % 36, c = r_ >> 1, g = r_ & 1, R0 = b * PB + c * 128;
        if (skipctx && c < 2) continue;
        ssd_load_images(F, XBC, R0, g, true);
        { const int h4 = F.wave & 3, d = F.wave >> 2, h = 4 * g + h4;
          const Series s = ssd_series(F, DT, P.ssd_a_log, R0, h, d);
          LAS float* A = ARR + h4 * 768;
          if (d == 0) { *(LAS f32x2*)(A + 0 * 128 + 2 * lane) = (f32x2){s.cs0, s.cs1}; *(LAS f32x2*)(A + 1 * 128 + 2 * lane) = (f32x2){s.dt0, s.dt1};
                        *(LAS f32x2*)(A + 2 * 128 + 2 * lane) = (f32x2){__expf(s.cs0), __expf(s.cs1)}; }
          else { *(LAS f32x2*)(A + 3 * 128 + 2 * lane) = (f32x2){s.ecs0, s.ecs1}; *(LAS f32x2*)(A + 4 * 128 + 2 * lane) = (f32x2){s.dt0, s.dt1};
                 *(LAS f32x2*)(A + 5 * 128 + 2 * lane) = (f32x2){__expf(s.tot - s.ecs0), __expf(s.tot - s.ecs1)}; } }
        __syncthreads();
        const int h4 = F.wave & 3, rh = F.wave >> 2, h = 4 * g + h4;
        const LAS float* A = ARR + h4 * 768;
        const LAS unsigned char* xh = F.lds + SSD_XH + h4 * 16384;
        const LAS unsigned char* bm = F.lds + SSD_BM;
        const LAS unsigned char* cm = F.lds + SSD_CM;
        f32x16 yacc[2][2];
#pragma unroll
        for (int i = 0; i < 2; ++i)
#pragma unroll
            for (int j = 0; j < 2; ++j)
#pragma unroll
                for (int k = 0; k < 16; ++k) yacc[i][j][k] = 0.f;
#pragma unroll
        for (int itl = 0; itl < 2; ++itl) {
            const int itile = 2 * rh + itl, irow = itile * 32 + l31;
            bf16x8 cf[4];
#pragma unroll
            for (int ks = 0; ks < 4; ++ks) cf[ks] = *(const LAS bf16x8*)(cm + img_off(irow, 2 * ks + hh));
#pragma unroll 1
            for (int d = 0; d < 2; ++d) {
                const bf16_t* Hs = HIN + (((((size_t)b * 18 + c) * 8 + h) * 2 + d) * 4096);
                bf16x8 hb[2][4];
#pragma unroll
                for (int pt = 0; pt < 2; ++pt)
#pragma unroll
                    for (int ks = 0; ks < 4; ++ks) hb[pt][ks] = *(const bf16x8*)(Hs + (pt * 32 + l31) * 64 + 16 * ks + 8 * hh);
#pragma unroll
                for (int pt = 0; pt < 2; ++pt) {
                    f32x16 tmp;
#pragma unroll
                    for (int k = 0; k < 16; ++k) tmp[k] = 0.f;
#pragma unroll
                    for (int ks = 0; ks < 4; ++ks) tmp = MFMA32(cf[ks], hb[pt][ks], tmp);
#pragma unroll
                    for (int q4 = 0; q4 < 4; ++q4) { const f32x4 ev = *(const LAS f32x4*)(A + (d == 0 ? 2 : 5) * 128 + itile * 32 + 8 * q4 + 4 * hh);
#pragma unroll
                        for (int k = 0; k < 4; ++k) yacc[itl][pt][4 * q4 + k] += tmp[4 * q4 + k] * ev[k]; }
                }
                __builtin_amdgcn_sched_barrier(0);
            }
            const float csf_i = A[0 * 128 + irow], ecb_i = A[3 * 128 + irow];
#pragma unroll 1
            for (int jt = 0; jt < 4; ++jt) {
                f32x16 Z;
#pragma unroll
                for (int k = 0; k < 16; ++k) Z[k] = 0.f;
#pragma unroll
                for (int ks = 0; ks < 4; ++ks) { const bf16x8 bf_ = *(const LAS bf16x8*)(bm + img_off(jt * 32 + l31, 2 * ks + hh)); Z = MFMA32(bf_, cf[ks], Z); }
#pragma unroll
                for (int q4 = 0; q4 < 4; ++q4) { const int j0 = jt * 32 + 8 * q4 + 4 * hh;
                    f32x4 w = (f32x4){0.f, 0.f, 0.f, 0.f};
                    if (jt <= itile) { const f32x4 cj = *(const LAS f32x4*)(A + 0 * 128 + j0), dj = *(const LAS f32x4*)(A + 1 * 128 + j0);
#pragma unroll
                        for (int k = 0; k < 4; ++k) { const bool ok = (jt < itile) || (j0 + k <= irow); w[k] += ok ? __expf(fminf(csf_i - cj[k], 0.f)) * dj[k] : 0.f; } }
                    if (jt >= itile) { const f32x4 ej = *(const LAS f32x4*)(A + 3 * 128 + j0), dj = *(const LAS f32x4*)(A + 4 * 128 + j0);
#pragma unroll
                        for (int k = 0; k < 4; ++k) { const bool ok = (jt > itile) || (j0 + k >= irow); w[k] += ok ? __expf(fminf(ej[k] - ecb_i, 0.f)) * dj[k] : 0.f; } }
#pragma unroll
                    for (int k = 0; k < 4; ++k) Z[4 * q4 + k] *= w[k]; }
#pragma unroll
                for (int s = 0; s < 2; ++s) {
                    u32x4 zp; zp.x = cvtpk(Z[8 * s], Z[8 * s + 1]); zp.y = cvtpk(Z[8 * s + 2], Z[8 * s + 3]); zp.z = cvtpk(Z[8 * s + 4], Z[8 * s + 5]); zp.w = cvtpk(Z[8 * s + 6], Z[8 * s + 7]);
                    const bf16x8 za = __builtin_bit_cast(bf16x8, zp);
                    const int row = jt * 32 + 16 * s + 4 * hh + q;
#pragma unroll
                    for (int pt = 0; pt < 2; ++pt) { const int chunk = pt * 4 + 2 * blk + (pp >> 1), within = 8 * (pp & 1);
                        const bf16x8 xb = cat8(tr_read4(xh + img_off(row, chunk) + within), tr_read4(xh + img_off(row + 8, chunk) + within));
                        yacc[itl][pt] = MFMA32(za, xb, yacc[itl][pt]); }
                }
                __builtin_amdgcn_sched_barrier(0);
            }
        }
        __syncthreads();
        LAS float* Y = (LAS float*)F.lds;
#pragma unroll
        for (int itl = 0; itl < 2; ++itl)
#pragma unroll
            for (int pt = 0; pt < 2; ++pt)
#pragma unroll
                for (int r = 0; r < 16; ++r) Y[((2 * rh + itl) * 32 + crow(r, hh)) * 256 + h4 * 64 + pt * 32 + l31] = yacc[itl][pt][r];
        __syncthreads();
#pragma unroll 1
        for (int it4 = 0; it4 < 8; it4 += 4) {
            u32x4 xw[4], zw[4];
#pragma unroll
            for (int u = 0; u < 4; ++u) { const int idx = (it4 + u) * 512 + F.tid, row = idx >> 5, ch = idx & 31, R = R0 + row;
                xw[u] = *(const u32x4*)(XBC + (size_t)R * 768 + g * 256 + ch * 8); zw[u] = *(const u32x4*)(PA + (size_t)R * PA_W + C_Z + g * 256 + ch * 8); }
#pragma unroll
            for (int u = 0; u < 4; ++u) { const int idx = (it4 + u) * 512 + F.tid, row = idx >> 5, ch = idx & 31, R = R0 + row;
                const f32x4 y0 = *(const LAS f32x4*)(Y + row * 256 + ch * 8), y1 = *(const LAS f32x4*)(Y + row * 256 + ch * 8 + 4);
                float xv[8], zv[8]; unpack8(xw[u], xv); unpack8(zw[u], zv);
                const float Dh = P.ssd_d[4 * g + (ch >> 3)]; float o[8], ss = 0.f;
#pragma unroll
                for (int k = 0; k < 8; ++k) { const float yv = (k < 4 ? y0[k] : y1[k - 4]) + Dh * xv[k]; o[k] = yv * silu_f(zv[k]); ss += o[k] * o[k]; }
                ss += __shfl_xor(ss, 1); ss += __shfl_xor(ss, 2); ss += __shfl_xor(ss, 4); ss += __shfl_xor(ss, 8); ss += __shfl_xor(ss, 16);
                if (ch == 0) SSQ[(size_t)R * 2 + g] = ss;
                *(u32x4*)(YB + (size_t)R * 1024 + 512 + g * 256 + ch * 8) = pack8(o); }
        }
        __syncthreads();
    }
}

DI void s5_recurrence(const Frame& F, const LayerIn& P, const float* __restrict__ S5S, bf16_t* __restrict__ AU) {
    if (F.gw >= 384) return;
    const int g = F.gw >> 4, b = (F.gw >> 1) & 7, d = F.gw & 1, p = F.lane;
    const float step = __expf(P.s5_lstep[d * 24 + g]);
    const float lr = P.s5_lre[(d * 24 + g) * 64 + p], li = P.s5_lim[(d * 24 + g) * 64 + p];
    const float mag = expf(32.f * lr * step), ang = 32.f * li * step, Lr = mag * cosf(ang), Li = mag * sinf(ang);
    float Hr = 0.f, Hi = 0.f;
#pragma unroll 1
    for (int kb = 0; kb < 72; kb += 24) {
        float sr[24], si[24];
#pragma unroll
        for (int k = 0; k < 24; ++k) { const int kk = kb + k, ck = (d == 0) ? kk : (kk < 8 ? 7 - kk : 79 - kk);
            const size_t m = (size_t)g * 576 + b * 72 + ck;
            sr[k] = S5S[m * 256 + d * 128 + p]; si[k] = S5S[m * 256 + d * 128 + 64 + p]; }
#pragma unroll
        for (int k = 0; k < 24; ++k) { const int kk = kb + k, ck = (d == 0) ? kk : (kk < 8 ? 7 - kk : 79 - kk);
            const size_t m = (size_t)g * 576 + b * 72 + ck;
            AU[m * 768 + 512 + d * 128 + p] = (bf16_t)f2bf(Hr); AU[m * 768 + 512 + d * 128 + 64 + p] = (bf16_t)f2bf(Hi);
            const float nr = Lr * Hr - Li * Hi + sr[k], ni = Lr * Hi + Li * Hr + si[k];
            Hr = nr; Hi = ni; }
    }
}

namespace attn_body {
using bf16=__hip_bfloat16;
using bf16x8=__attribute__((ext_vector_type(8)))short;
using s16x4=__attribute__((ext_vector_type(4)))short;
using f32x16=__attribute__((ext_vector_type(16)))float;
using u32x4=__attribute__((ext_vector_type(4)))unsigned;
constexpr int D=64;
constexpr int NW=8,QBLK=32,QB=QBLK*NW,KVBLK=64;
__device__ __forceinline__ int crow(int r,int hi){return (r&3)+8*(r>>2)+4*hi;}
#define SBAR() __builtin_amdgcn_sched_barrier(0)
constexpr int NSLOT=3, SLOTB=8192;
constexpr int LDS_K=0, LDS_V=NSLOT*SLOTB, LDS_WS=2*NSLOT*SLOTB, LDS_OST=LDS_WS+NW*64*4, LDS_BYTES=LDS_OST+NW*4096;
constexpr float C2=0.125f*1.4426950408889634f;
__device__ __forceinline__ void glds16(const void*gsrc,unsigned lds_dst){unsigned keep;
  asm volatile("s_mov_b32 %0, m0\n\ts_mov_b32 m0, %2\n\ts_nop 0\n\tglobal_load_lds_dwordx4 %1, off\n\ts_mov_b32 m0, %0":"=&s"(keep):"v"(gsrc),"s"(lds_dst):"memory");}
__device__ __forceinline__ float max3f(float a,float b,float c){float r;asm("v_max3_f32 %0, %1, %2, %3":"=v"(r):"v"(a),"v"(b),"v"(c));return r;}
__device__ __forceinline__ float max2f(float a,float b){float r;asm("v_max_f32_e32 %0, %1, %2":"=v"(r):"v"(a),"v"(b));return r;}
__device__ __forceinline__ float fadd_s(float a,float b){float r;asm("v_add_f32_e32 %0, %1, %2":"=v"(r):"v"(a),"v"(b));return r;}
__device__ __forceinline__ float fsub_s(float a,float b){float r;asm("v_sub_f32_e32 %0, %1, %2":"=v"(r):"v"(a),"v"(b));return r;}
typedef float f32x2_t __attribute__((ext_vector_type(2))); typedef __bf16 bf16x2_t __attribute__((ext_vector_type(2)));
__device__ __forceinline__ unsigned cvtpk_s(float lo,float hi){f32x2_t v={lo,hi};bf16x2_t b=__builtin_convertvector(v,bf16x2_t);return __builtin_bit_cast(unsigned,b);}
#define WAIT_BAR(N) asm volatile("s_waitcnt vmcnt(" #N ") lgkmcnt(0)\n\ts_barrier":::"memory")

__device__ __forceinline__ void qkt(f32x16&p0,f32x16&p1,const char*Kslot,const bf16x8*qr,const f32x16&negm,int r32,int hi){
  const char*kb=Kslot+hi*1024+r32*16;
  #pragma unroll
  for(int d0=0;d0<4;++d0){
    const bf16x8 b0=*reinterpret_cast<const bf16x8*>(kb+d0*2048);
    const bf16x8 b1=*reinterpret_cast<const bf16x8*>(kb+d0*2048+512);
    if(d0==0){p0=__builtin_amdgcn_mfma_f32_32x32x16_bf16(b0,qr[0],negm,0,0,0);p1=__builtin_amdgcn_mfma_f32_32x32x16_bf16(b1,qr[0],negm,0,0,0);}
    else{p0=__builtin_amdgcn_mfma_f32_32x32x16_bf16(b0,qr[d0],p0,0,0,0);p1=__builtin_amdgcn_mfma_f32_32x32x16_bf16(b1,qr[d0],p1,0,0,0);}}
}
typedef __attribute__((address_space(3))) const char* lds_cptr;
typedef short v4i16_t __attribute__((ext_vector_type(4)));
__device__ __forceinline__ void kload8(bf16x8*kf,lds_cptr kp){
  kf[0]=*(const __attribute__((address_space(3))) bf16x8*)(kp);      kf[1]=*(const __attribute__((address_space(3))) bf16x8*)(kp+512);
  kf[2]=*(const __attribute__((address_space(3))) bf16x8*)(kp+2048); kf[3]=*(const __attribute__((address_space(3))) bf16x8*)(kp+2560);
  kf[4]=*(const __attribute__((address_space(3))) bf16x8*)(kp+4096); kf[5]=*(const __attribute__((address_space(3))) bf16x8*)(kp+4608);
  kf[6]=*(const __attribute__((address_space(3))) bf16x8*)(kp+6144); kf[7]=*(const __attribute__((address_space(3))) bf16x8*)(kp+6656);
}
__device__ __forceinline__ void kload2(bf16x8*kf,lds_cptr kp,int j){ kf[2*j]=*(const __attribute__((address_space(3))) bf16x8*)(kp+j*2048); kf[2*j+1]=*(const __attribute__((address_space(3))) bf16x8*)(kp+j*2048+512); }
__device__ __forceinline__ s16x4 vtr(lds_cptr p){ return __builtin_bit_cast(s16x4,__builtin_amdgcn_ds_read_tr16_b64_v4i16((__attribute__((address_space(3))) v4i16_t*)p)); }
__device__ __forceinline__ float rowmax(const f32x16&p0,const f32x16&p1){
  float a=max3f(p0[0],p0[1],p1[0]),b=max3f(p0[2],p0[3],p1[1]);a=max3f(a,p1[2],p1[3]);
  #pragma unroll
  for(int r=4;r<16;r+=4){a=max3f(a,p0[r],p0[r+1]);b=max3f(b,p0[r+2],p0[r+3]);a=max3f(a,p1[r],p1[r+1]);b=max3f(b,p1[r+2],p1[r+3]);}
  const float m=max2f(a,b);
  auto rr=__builtin_amdgcn_permlane32_swap(__float_as_uint(m),__float_as_uint(m),false,false);
  return max2f(__uint_as_float(rr[0]),__uint_as_float(rr[1]));
}
__device__ __forceinline__ void pv(f32x16*o,int vb,bf16x8 pa0,bf16x8 pa1,bf16x8 pa2,bf16x8 pa3){
  #pragma unroll
  for(int d0=0;d0<2;++d0){s16x4 lo[4],hi[4];
    #pragma unroll
    for(int ks=0;ks<4;++ks){
      asm volatile("ds_read_b64_tr_b16 %0,%1 offset:%c2":"=&v"(lo[ks]):"v"(vb),"i"(d0*4096+ks*1024):"memory");
      asm volatile("ds_read_b64_tr_b16 %0,%1 offset:%c2":"=&v"(hi[ks]):"v"(vb),"i"(d0*4096+ks*1024+512):"memory");}
    asm volatile("s_waitcnt lgkmcnt(0)":::"memory");SBAR();
    #define PK(k) (bf16x8){lo[k][0],lo[k][1],lo[k][2],lo[k][3],hi[k][0],hi[k][1],hi[k][2],hi[k][3]}
    o[d0]=__builtin_amdgcn_mfma_f32_32x32x16_bf16(pa0,PK(0),o[d0],0,0,0);
    o[d0]=__builtin_amdgcn_mfma_f32_32x32x16_bf16(pa1,PK(1),o[d0],0,0,0);
    o[d0]=__builtin_amdgcn_mfma_f32_32x32x16_bf16(pa2,PK(2),o[d0],0,0,0);
    o[d0]=__builtin_amdgcn_mfma_f32_32x32x16_bf16(pa3,PK(3),o[d0],0,0,0);
    #undef PK
  }
}

#ifndef ATTN_STORE16
#define ATTN_STORE16(p,v) (*(u32x4*)(p)=(v))
#endif
template<int THRL> __device__ __forceinline__ void attn_unit(const bf16*Qp,int qpitch,const bf16*__restrict__ Kp,int kpitch,const bf16*__restrict__ Vp,int vpitch,bf16*Op,int opitch,const int NT,char*shm){
  const int tid=fresh_tid(),lane=tid&63,r32=lane&31,hi=lane>>5; const int wid=__builtin_amdgcn_readfirstlane(tid>>6);
  const bf16*Qw=Qp+(long)(wid*QBLK)*qpitch;
  const bf16*Kh=Kp,*Vh=Vp;
  const unsigned lds0=(unsigned)(uintptr_t)shm;
  float*wsf=(float*)(shm+LDS_WS)+wid*64;
  const bf16*ksrc=Kh+(long)lane*kpitch+wid*8;
  const bf16*vsrc=Vh+(long)(16*(wid&3)+(lane>>2))*vpitch+(wid>>2)*32+(lane&3)*8;
  const unsigned kdst=lds0+LDS_K+wid*1024, vdst=lds0+LDS_V+wid*1024;
  #define DMA_K(t,slot) glds16(ksrc+(long)(t)*KVBLK*kpitch,(unsigned)__builtin_amdgcn_readfirstlane(kdst+(slot)))
  #define DMA_V(t,slot) glds16(vsrc+(long)(t)*KVBLK*vpitch,(unsigned)__builtin_amdgcn_readfirstlane(vdst+(slot)))
  const int vb0=(int)(lds0+LDS_V)+((lane>>4)&1)*32+(lane&3)*8+(4*hi+((lane&15)>>2))*64;
  const char*Kbase=shm+LDS_K; bf16x8 kf[8];
  const lds_cptr shm3=(lds_cptr)shm; const lds_cptr kp0=shm3+LDS_K+hi*1024+r32*16; const lds_cptr vp0=shm3+LDS_V+((lane>>4)&1)*32+(lane&3)*8+(4*hi+((lane&15)>>2))*64;
  DMA_K(0,0);DMA_V(0,0);DMA_K(1,SLOTB);
  bf16x8 qr[4];
  #pragma unroll
  for(int d0=0;d0<4;++d0)qr[d0]=*reinterpret_cast<const bf16x8*>(&Qw[(long)r32*qpitch+d0*16+hi*8]);
  float mhat=0.f,l_reg=0.f;f32x16 o[2];o[0]=f32x16{};o[1]=f32x16{};f32x16 negm=f32x16{};asm volatile("":"+v"(negm));
  #define CMASK(P0,P1,t) do{}while(0)
  bool resc=false;
  #define START(P0,P1) do{ const float rm=rowmax(P0,P1); resc=false; \
    { const float dl=rm; mhat=fadd_s(mhat,dl); \
      _Pragma("unroll") for(int r=0;r<16;++r){P0[r]=fsub_s(P0[r],dl);P1[r]=fsub_s(P1[r],dl);} \
      _Pragma("unroll") for(int r=0;r<16;++r)negm[r]=-mhat; asm volatile("":"+v"(negm)); } \
    _Pragma("unroll") for(int r=0;r<16;++r)P0[r]=__builtin_amdgcn_exp2f(P0[r]); }while(0)
  #define RESC() do{ if(resc){ asm volatile("s_waitcnt lgkmcnt(0)":::"memory"); \
      _Pragma("unroll") for(int d_=0;d_<2;++d_) _Pragma("unroll") for(int r=0;r<16;++r)o[d_][r]*=wsf[crow(r,hi)]; } }while(0)
  f32x16 pA0,pA1,pB0,pB1;
  int sl_prev=0,sl_cur=0,sl_next=SLOTB;
  #define ROT() do{sl_prev=sl_cur;sl_cur=sl_next;sl_next=(sl_next==(NSLOT-1)*SLOTB)?0:sl_next+SLOTB;}while(0)
  DMA_K(2,2*SLOTB);
  WAIT_BAR(3);
  qkt(pA0,pA1,Kbase,qr,negm,r32,hi);asm volatile("s_nop 15\n\ts_nop 7":"+v"(pA0),"+v"(pA1));CMASK(pA0,pA1,0);
  START(pA0,pA1);
  _Pragma("unroll") for(int r=0;r<16;++r)pA1[r]=__builtin_amdgcn_exp2f(pA1[r]);
  WAIT_BAR(0);
  DMA_K(3,0);DMA_V(1,SLOTB);
  ROT();
  kload8(kf,kp0+sl_cur);
  WAIT_BAR(2);
  s16x4 vlo[8],vhi[8]; u32x4 pw0,pw1,pw2,pw3;
  #define PKW(P,B) cvtpk_s(P[B],P[B+1])
  #define PAF(k) __builtin_bit_cast(bf16x8,pw##k)
  #define VFR(i) (bf16x8){vlo[i][0],vlo[i][1],vlo[i][2],vlo[i][3],vhi[i][0],vhi[i][1],vhi[i][2],vhi[i][3]}
  #define PIN(x) asm volatile("":"+v"(x))
  #define MX3(a,b,c) __builtin_fmaxf(__builtin_fmaxf((a),(b)),(c))
  #define GAPA(MF,A0,A1,A2,A3,W0,W1,PW) do{ MF; sacc+=A0; sacc+=A1; sacc+=A2; sacc+=A3; PIN(sacc); W0; W1; PIN(PW); SBAR(); }while(0)
  #define EX(v) __builtin_amdgcn_exp2f(v)
  #define GAPB(MF,X,B) do{ MF; X[B]=EX(X[B]); X[B+1]=EX(X[B+1]); X[B+2]=EX(X[B+2]); X[B+3]=EX(X[B+3]); PIN(X); SBAR(); }while(0)
  #define VRD(i) do{ vlo[i]=vtr(vp_+(((i)>>2)*4096+((i)&3)*1024)); vhi[i]=vtr(vp_+(((i)>>2)*4096+((i)&3)*1024+512)); }while(0)
  #define KRD(G,j) do{ if(G){ kload2(kf,kp0+sl_next,j); SBAR(); } }while(0)
  #define STEP(C0,C1,P0,P1,t,GK,GV,GL) do{ SBAR(); \
    const lds_cptr vp_=vp0+sl_prev; \
    VRD(0); SBAR(); float sacc=(P0[0]+P0[1]); \
    GAPA(C0=__builtin_amdgcn_mfma_f32_32x32x16_bf16(kf[0],qr[0],negm,0,0,0), P0[2],P0[3],P0[4],P0[5],     pw0[0]=PKW(P0,0), pw0[1]=PKW(P0,2), pw0); \
    VRD(4); SBAR(); GAPA(C1=__builtin_amdgcn_mfma_f32_32x32x16_bf16(kf[1],qr[0],negm,0,0,0), P0[6],P0[7],P0[8],P0[9],     pw0[2]=PKW(P0,4), pw0[3]=PKW(P0,6), pw0); \
    VRD(1); SBAR(); GAPA(C0=__builtin_amdgcn_mfma_f32_32x32x16_bf16(kf[2],qr[1],C0,0,0,0),   P0[10],P0[11],P0[12],P0[13], pw1[0]=PKW(P0,8), pw1[1]=PKW(P0,10), pw1); \
    VRD(5); SBAR(); GAPA(C1=__builtin_amdgcn_mfma_f32_32x32x16_bf16(kf[3],qr[1],C1,0,0,0),   P0[14],P0[15],P1[0],P1[1],   pw1[2]=PKW(P0,12),pw1[3]=PKW(P0,14), pw1); \
    VRD(2); SBAR(); GAPA(C0=__builtin_amdgcn_mfma_f32_32x32x16_bf16(kf[4],qr[2],C0,0,0,0),   P1[2],P1[3],P1[4],P1[5],     pw2[0]=PKW(P1,0), pw2[1]=PKW(P1,2), pw2); \
    VRD(6); SBAR(); GAPA(C1=__builtin_amdgcn_mfma_f32_32x32x16_bf16(kf[5],qr[2],C1,0,0,0),   P1[6],P1[7],P1[8],P1[9],     pw2[2]=PKW(P1,4), pw2[3]=PKW(P1,6), pw2); \
    VRD(3); SBAR(); GAPA(C0=__builtin_amdgcn_mfma_f32_32x32x16_bf16(kf[6],qr[3],C0,0,0,0),   P1[10],P1[11],P1[12],P1[13], pw3[0]=PKW(P1,8), pw3[1]=PKW(P1,10), pw3); \
    VRD(7); SBAR(); GAPA(C1=__builtin_amdgcn_mfma_f32_32x32x16_bf16(kf[7],qr[3],C1,0,0,0),   P1[14],P1[15],0.f,0.f,       pw3[2]=PKW(P1,12),pw3[3]=PKW(P1,14), pw3); \
    l_reg+=sacc; \
    if(GK){DMA_K((t)+3,sl_cur);} if(GV){DMA_V((t)+1,sl_next);} \
    CMASK(C0,C1,t); \
    { float a=MX3(C0[0],C0[1],C1[0]),b=MX3(C0[2],C0[3],C1[1]); a=MX3(a,C1[2],C1[3]); \
      _Pragma("unroll") for(int r=4;r<16;r+=4){a=MX3(a,C0[r],C0[r+1]);b=MX3(b,C0[r+2],C0[r+3]);a=MX3(a,C1[r],C1[r+1]);b=MX3(b,C1[r+2],C1[r+3]);} \
      float rm=__builtin_fmaxf(a,b); { auto rr=__builtin_amdgcn_permlane32_swap(__float_as_uint(rm),__float_as_uint(rm),false,false); rm=__builtin_fmaxf(__uint_as_float(rr[0]),__uint_as_float(rr[1])); } \
      resc=false; \
      if(__builtin_expect(__any(rm>(float)THRL),0)){ const float dl=__builtin_fmaxf(rm,0.f); mhat+=dl; \
        _Pragma("unroll") for(int r=0;r<16;++r){C0[r]-=dl;C1[r]-=dl;} \
        _Pragma("unroll") for(int r=0;r<16;++r)negm[r]=-mhat; asm volatile("":"+v"(negm)); \
        const float f=__builtin_amdgcn_exp2f(-dl); l_reg*=f; if(hi==0)wsf[r32]=f; resc=true; } } \
    SBAR(); \
    GAPB(o[0]=__builtin_amdgcn_mfma_f32_32x32x16_bf16(PAF(0),VFR(0),o[0],0,0,0), C0,0); \
    GAPB(o[1]=__builtin_amdgcn_mfma_f32_32x32x16_bf16(PAF(0),VFR(4),o[1],0,0,0), C0,4); \
    KRD(GL,0); GAPB(o[0]=__builtin_amdgcn_mfma_f32_32x32x16_bf16(PAF(1),VFR(1),o[0],0,0,0), C0,8); \
    KRD(GL,1); GAPB(o[1]=__builtin_amdgcn_mfma_f32_32x32x16_bf16(PAF(1),VFR(5),o[1],0,0,0), C0,12); \
    KRD(GL,2); GAPB(o[0]=__builtin_amdgcn_mfma_f32_32x32x16_bf16(PAF(2),VFR(2),o[0],0,0,0), C1,0); \
    KRD(GL,3); GAPB(o[1]=__builtin_amdgcn_mfma_f32_32x32x16_bf16(PAF(2),VFR(6),o[1],0,0,0), C1,4); \
    GAPB(o[0]=__builtin_amdgcn_mfma_f32_32x32x16_bf16(PAF(3),VFR(3),o[0],0,0,0), C1,8); \
    GAPB(o[1]=__builtin_amdgcn_mfma_f32_32x32x16_bf16(PAF(3),VFR(7),o[1],0,0,0), C1,12); \
    }while(0)
  int t=1;
  for(;t+5<NT;t+=2){
    STEP(pB0,pB1,pA0,pA1,t,true,true,true);     WAIT_BAR(2); RESC(); ROT();
    STEP(pA0,pA1,pB0,pB1,t+1,true,true,true);   WAIT_BAR(2); RESC(); ROT();
  }
  #define ENDW(tt) do{ if((tt)+3<NT){WAIT_BAR(2);} else if((tt)+2<NT){WAIT_BAR(1);} else {WAIT_BAR(0);} }while(0)
  for(;t+1<NT;t+=2){
    STEP(pB0,pB1,pA0,pA1,t,(t+3<NT),(t+1<NT),(t+1<NT));       ENDW(t);   RESC(); ROT();
    STEP(pA0,pA1,pB0,pB1,t+1,(t+4<NT),(t+2<NT),(t+2<NT));     ENDW(t+1); RESC(); ROT();
  }
  STEP(pB0,pB1,pA0,pA1,NT-1,false,false,false); RESC();
  { float sacc=pB0[0]+pB0[1]; _Pragma("unroll") for(int r=2;r<16;++r)sacc+=pB0[r]; _Pragma("unroll") for(int r=0;r<16;++r)sacc+=pB1[r]; l_reg+=sacc;
    pw0=(u32x4){PKW(pB0,0),PKW(pB0,2),PKW(pB0,4),PKW(pB0,6)};pw1=(u32x4){PKW(pB0,8),PKW(pB0,10),PKW(pB0,12),PKW(pB0,14)};pw2=(u32x4){PKW(pB1,0),PKW(pB1,2),PKW(pB1,4),PKW(pB1,6)};pw3=(u32x4){PKW(pB1,8),PKW(pB1,10),PKW(pB1,12),PKW(pB1,14)};
    SBAR(); pv(o,vb0+sl_cur,PAF(0),PAF(1),PAF(2),PAF(3)); }
  #undef PKW
  #undef PAF
  #undef VFR
  #undef PIN
  #undef MX3
  #undef GAPA
  #undef GAPB
  #undef EX
  #undef VRD
  #undef KRD
  #undef STEP
  #undef ENDW
  {auto rr=__builtin_amdgcn_permlane32_swap(__float_as_uint(l_reg),__float_as_uint(l_reg),false,false);l_reg=__uint_as_float(rr[0])+__uint_as_float(rr[1]);}
  if(hi==0)wsf[32+r32]=l_reg;asm volatile("s_waitcnt lgkmcnt(0)":::"memory");
  float rli[16];
  #pragma unroll
  for(int r=0;r<16;++r)rli[r]=__builtin_amdgcn_rcpf(wsf[32+crow(r,hi)]);
  bf16*Ow=Op+(long)(wid*QBLK)*opitch;
  { bf16*stg=(bf16*)(shm+LDS_OST)+wid*2048;
    #pragma unroll
    for(int r=0;r<16;++r){const int orow=crow(r,hi);
      #pragma unroll
      for(int d0=0;d0<2;++d0)stg[orow*64+d0*32+r32]=__float2bfloat16(o[d0][r]*rli[r]);}
    asm volatile("s_waitcnt lgkmcnt(0)":::"memory");
    #pragma unroll
    for(int i=0;i<4;++i){const int row=i*8+(lane>>3),ch=lane&7; const u32x4 v=*(const u32x4*)(stg+row*64+ch*8); ATTN_STORE16(Ow+(long)row*opitch+ch*8,v);} }
  asm volatile("s_waitcnt lgkmcnt(0)\n\ts_barrier":::"memory");
  #undef DMA_K
  #undef DMA_V
  #undef CMASK
  #undef START
  #undef RESC
  #undef ROT
}
constexpr int ATTN_LDS_BYTES=LDS_BYTES;
#undef SBAR
#undef WAIT_BAR
}


#define pMOD ((float*)(ws + WS_MOD))
#define pROPE ((float*)(ws + WS_ROPE))
#define pAFF ((float*)(ws + WS_AFF))
#define pINV ((int*)(ws + WS_INV))
#define pDT ((float*)(ws + WS_DT))
#define pSRC ((int*)(ws + WS_SRC))
#define pGV ((float*)(ws + WS_GV))
#define pSSQ ((float*)(ws + WS_SSQ))
#define pTOT ((float*)(ws + WS_TOT))
#define pX ((float*)(ws + WS_X))
#define pH ((bf16_t*)(ws + WS_H))
#define pYAB ((bf16_t*)(ws + WS_YAB))
#define pPA ((bf16_t*)(ws + WS_PA))
#define pPG ((bf16_t*)(ws + WS_PG))
#define pMRGB ((bf16_t*)(ws + WS_MRGB))
#define pY ((bf16_t*)(ws + WS_Y))
#define pXG ((bf16_t*)(ws + WS_XG))
#define pHID ((bf16_t*)(ws + WS_HID))
#define pYE ((bf16_t*)(ws + WS_YE))
#define pQN ((bf16_t*)(ws + WS_QN))
#define pKN ((bf16_t*)(ws + WS_KN))
#define pHIN ((bf16_t*)(ws + WS_HIN))
#define pXBC ((bf16_t*)(ws + WS_XBC))
#define pAU ((bf16_t*)(ws + WS_AU))
#define pSS ((float*)(ws + WS_S))
#define pYG ((bf16_t*)(ws + WS_YG))
#define pS5S ((float*)(ws + WS_S5S))
#define pYCD ((bf16_t*)(ws + WS_YCD))
constexpr int EW_SPLIT1 = 5376, EW_SPLIT2 = 9856;
struct Args { const float* in[38]; float* out; unsigned char* ws; int ph_lo, ph_hi; };
constexpr int PH_PER_LAYER = 15, PH_FINAL = 2 * PH_PER_LAYER, PH_TOTAL = PH_FINAL + 1;

DI LayerIn layer_in(const Args& a, int L) {
    LayerIn P;
    P.norm_mix_g = a.in[6] + (size_t)L * 1024; P.norm_ffn_g = a.in[7] + (size_t)L * 1024;
    P.w_in = a.in[8] + (size_t)L * 1024 * NIN; P.q_norm_g = a.in[9] + L * 64; P.k_norm_g = a.in[10] + L * 64;
    P.ssd_conv_w = a.in[11] + L * 3 * 768; P.ssd_conv_b = a.in[12] + L * 768; P.ssd_dt_bias = a.in[13] + L * 16; P.ssd_a_log = a.in[14] + L * 16;
    P.ssd_d = a.in[15] + L * 8; P.ssd_norm_g = a.in[16] + L * 512;
    P.s5_lre = a.in[17] + L * 2 * 24 * 64; P.s5_lim = a.in[18] + L * 2 * 24 * 64; P.s5_lstep = a.in[19] + L * 48;
    P.s5_bre = a.in[20] + (size_t)L * 24 * 64 * 16; P.s5_bim = a.in[21] + (size_t)L * 24 * 64 * 16; P.s5_cre = a.in[22] + (size_t)L * 24 * 16 * 64; P.s5_cim = a.in[23] + (size_t)L * 24 * 16 * 64;
    P.s5_d = a.in[24] + L * 384; P.s5_wglu = a.in[25] + (size_t)L * 384 * 384; P.s5_bglu = a.in[26] + L * 384; P.sc_conv_w = a.in[27] + L * 3 * 384;
    P.w_br_attn = a.in[28] + (size_t)L * 512 * 1024; P.w_br_ssd = a.in[29] + (size_t)L * 512 * 1024; P.w_br_s5 = a.in[30] + (size_t)L * 384 * 1024; P.w_br_sc = a.in[31] + (size_t)L * 384 * 1024;
    P.w_out = a.in[32] + (size_t)L * 1024 * 1024; P.w_router = a.in[33] + (size_t)L * 1024 * 16;
    P.w_gate = a.in[34] + (size_t)L * 16 * 1024 * 1024; P.w_up = a.in[35] + (size_t)L * 16 * 1024 * 1024; P.w_down = a.in[36] + (size_t)L * 16 * 1024 * 1024;
    return P;
}

__global__ void __launch_bounds__(NWAVES * 64, 2) hybrid_fwd(Args args) {
    extern __shared__ __attribute__((aligned(16))) unsigned char lds_raw[];
    Frame F0;
#define F F0
    F.lds = (LAS unsigned char*)lds_raw;
    F.tid = threadIdx.x; F.lane = F.tid & 63; F.wave = __builtin_amdgcn_readfirstlane(F.tid >> 6);
    F.G = gridDim.x; { const int bx = blockIdx.x; F.vcu = (F.G % 8 == 0) ? (bx % 8) * (F.G / 8) + bx / 8 : bx; }
    F.gw = F.vcu * NWAVES + F.wave; F.NGW = F.G * NWAVES;
    unsigned char* ws = args.ws;
    volatile LAS unsigned* MISC = (volatile LAS unsigned*)(F.lds + LDSCTL_OFF);
    for (int u = F.tid; u < (LDS_BYTES - LDSCTL_OFF) / 4; u += NWAVES * 64) ((LAS unsigned*)(F.lds + LDSCTL_OFF))[u] = 0u;
    __syncthreads();
    XcdBarrier bar = xcd_barrier_post((unsigned*)(ws + WS_CTL) + CW_BAR, MISC + 8);
    const int lo = args.ph_lo, hi = args.ph_hi;
#ifndef PH_MASK
#define PH_MASK 0xFFFF
#endif
#define IN(k) (lo <= (k) && (k) < hi)
#define INL(j) (((PH_MASK >> (j)) & 1) && IN(base + (j)))
#ifndef REPEAT_MASK
#define REPEAT_MASK 0
#endif
#define REP(j) for (int rep_ = 0; rep_ < 1 + ((REPEAT_MASK >> (j)) & 1); ++rep_)
#define SEAM(k) do { if (IN((k) + 1)) xcd_barrier(bar); } while (0)

#undef F
#pragma unroll 1
    for (int L = 0; L < 2; ++L) {
        const int base = L * PH_PER_LAYER;
        if (hi <= base || lo >= base + PH_PER_LAYER) continue;
        const bool lastL = (L == 1);

        if (L == 0 && INL(0)) REP(0) { const LayerIn P = layer_in(args, L); Frame F = F0; F.tid = fresh_tid(); F.lane = F.tid & 63; if (rep_) xcd_barrier(bar);
#ifndef SUBREP_MOD
#define SUBREP_MOD 0
#endif
#ifndef SUBREP_S5
#define SUBREP_S5 0
#endif
#ifndef SUBREP_SW
#define SUBREP_SW 0
#endif
            if (L == 0) { for (int q_ = 0; q_ <= SUBREP_MOD; ++q_) { prep_mod(F, args.in[1], args.in[3], args.in[4], args.in[5], pMOD); prep_rope(F, pROPE); } }
            for (int q_ = 0; q_ <= SUBREP_S5; ++q_) prep_s5(F, P, ws);
            for (int q_ = 0; q_ <= SUBREP_SW; ++q_) prep_small_weights(F, P, ws);
            SEAM(base + 0);
        }
        if (INL(1)) REP(1) { const LayerIn P = layer_in(args, L); Frame F = F0; F.tid = fresh_tid(); F.lane = F.tid & 63; if (rep_) xcd_barrier(bar); phase_norm1(F, L, args.in[0], args.in[2], pX, pH, pMOD, P.norm_mix_g, pINV, pYE, pY); SEAM(base + 1); }
        if (INL(2)) REP(2) { const LayerIn P = layer_in(args, L); Frame F = F0; F.tid = fresh_tid(); F.lane = F.tid & 63; if (rep_) xcd_barrier(bar);
            pg8::Gemm g{pH, (const bf16_t*)(ws + W_WIN), 1024, 1024, 1024};
            RowSkipOrder S; S.init(NPROJ, F.G, (int)blockIdx.x, lastL ? 1 : 0, 2, 10);
            EpiProj E{pPA, PA_W, PA_W / 256, pPG, PG_W};
            pg8::gemm_phase<EpiProj, RowSkipOrder>(F.lds, g, S, E);
            SEAM(base + 2);
        }
        if (INL(3)) REP(3) { const LayerIn P = layer_in(args, L); Frame F = F0; F.tid = fresh_tid(); F.lane = F.tid & 63; if (rep_) xcd_barrier(bar); phase_elem(F, P, pPA, pROPE, pQN, pKN, pXBC, pDT, pAU, pYCD); SEAM(base + 3); }
        if (INL(4)) REP(4) { const LayerIn P = layer_in(args, L); Frame F = F0; F.tid = fresh_tid(); F.lane = F.tid & 63; if (rep_) xcd_barrier(bar);
            using abf = attn_body::bf16;
#ifndef NO_ATTN
            for (int u = F.vcu; u < 512; u += F.G) { const int bk = u >> 5, r = u & 31, b = bk >> 1, kvh = bk & 1, h = kvh * 4 + (r >> 3), qb = r & 7;
                const size_t qrow = (size_t)b * PB + CTXL + qb * 256, krow = (size_t)b * PB;
                attn_body::attn_unit<8>((const abf*)(pQN + qrow * 512 + h * 64), 512, (const abf*)(pKN + krow * 128 + kvh * 64), 128, (const abf*)(pPA + krow * PA_W + C_V + kvh * 64), PA_W,
                                        (abf*)(pYAB + qrow * 1024 + h * 64), 1024, 36, (char*)lds_raw); }
            if (!lastL) for (int u = F.vcu; u < 64; u += F.G) { const int b = u >> 3, h = u & 7, kvh = h >> 2; const size_t krow = (size_t)b * PB;
                attn_body::attn_unit<8>((const abf*)(pQN + krow * 512 + h * 64), 512, (const abf*)(pKN + krow * 128 + kvh * 64), 128, (const abf*)(pPA + krow * PA_W + C_V + kvh * 64), PA_W,
                                        (abf*)(pYAB + krow * 1024 + h * 64), 1024, 4, (char*)lds_raw); }
#endif
            __syncthreads();
#ifndef NO_E1
            ssd_chunk_states(F, P, pXBC, pDT, pSS, pTOT);
#endif
#ifndef NO_S5S
            { pg8::Gemm g{pAU, (const bf16_t*)(ws + W_P), 768, 512, 512}; OrderS5S S{F.G, (int)((blockIdx.x + F.G - 184) % F.G)}; EpiS5S E{pS5S};
              pg8::gemm_phase<EpiS5S, OrderS5S>(F.lds, g, S, E); }
#endif
            SEAM(base + 4);
        }
        if (INL(5)) REP(5) { const LayerIn P = layer_in(args, L); Frame F = F0; F.tid = fresh_tid(); F.lane = F.tid & 63; if (rep_) xcd_barrier(bar); ssd_recurrence(F, pSS, pTOT, pHIN); s5_recurrence(F, P, pS5S, pAU); SEAM(base + 5); }
        if (INL(6)) REP(6) { const LayerIn P = layer_in(args, L); Frame F = F0; F.tid = fresh_tid(); F.lane = F.tid & 63; if (rep_) xcd_barrier(bar);
#ifndef NO_E3
            ssd_output(F, P, pXBC, pPA, pDT, pHIN, pYAB, pSSQ, lastL);
#endif
#ifndef NO_S5Y
            { pg8::Gemm g{pAU, (const bf16_t*)(ws + W_TQ), 768, 768, 768}; OrderS5Y S{F.G, (int)((blockIdx.x + F.G - 112) % F.G)}; EpiS5Y E{pAU, pYG, P.s5_d};
              pg8::gemm_phase<EpiS5Y, OrderS5Y>(F.lds, g, S, E); }
#endif
            SEAM(base + 6);
        }
        if (INL(7)) REP(7) { const LayerIn P = layer_in(args, L); Frame F = F0; F.tid = fresh_tid(); F.lane = F.tid & 63; if (rep_) xcd_barrier(bar);
            for (int R = F.gw; R < MROWS; R += F.NGW) {
                if (lastL && (R % PB) < CTXL) continue;
                const float rs = 1.0f / sqrtf((pSSQ[2 * R] + pSSQ[2 * R + 1]) * (1.f / 512.f) + RMS_EPS);
                bf16_t* yb = pYAB + (size_t)R * 1024 + 512 + 8 * F.lane; float v[8]; unpack8(*(const u32x4*)yb, v);
#pragma unroll
                for (int k = 0; k < 8; ++k) v[k] *= rs;
                *(u32x4*)yb = pack8(v); }
            pg8::Gemm g{pYG, (const bf16_t*)(ws + W_GLU), 384, 384, 384};
            RowSkipOrder S; S.init(512, F.G, (int)blockIdx.x, lastL ? 1 : 0, 0, 0);
            EpiGlu E{pYG, pYCD, P.s5_bglu};
            pg8::gemm_phase<EpiGlu, RowSkipOrder>(F.lds, g, S, E);
            SEAM(base + 7);
        }
        if (INL(8)) REP(8) { const LayerIn P = layer_in(args, L); Frame F = F0; F.tid = fresh_tid(); F.lane = F.tid & 63; if (rep_) xcd_barrier(bar);
            MergeOrder S; S.init(F.G, (int)blockIdx.x, lastL ? 1 : 0);
            pg8::MergeArgs MA{pYAB, pYCD, (const bf16_t*)(ws + W_BR4), pPG, pMRGB};
            pg8::gemm_merge_phase<MergeOrder>(F.lds, MA, S);
            if (!lastL) { __syncthreads(); prep_expert_weights(F, P, ws, 64, 0, EW_SPLIT1); }
            SEAM(base + 8);
        }
        if (INL(9)) REP(9) { const LayerIn P = layer_in(args, L); Frame F = F0; F.tid = fresh_tid(); F.lane = F.tid & 63; if (rep_) xcd_barrier(bar);
            pg8::Gemm g{pMRGB, (const bf16_t*)(ws + W_OUT), 1024, 1024, 1024};
            RowSkipOrder S; S.init(1024, F.G, (int)blockIdx.x, lastL ? 1 : 0, 0, 0);
            EpiWout E{pY};
            pg8::gemm_phase<EpiWout, RowSkipOrder>(F.lds, g, S, E);
            if (!lastL) { __syncthreads(); prep_expert_weights(F, P, ws, 32, EW_SPLIT1, EW_SPLIT2); }
            SEAM(base + 9);
        }
        if (INL(10)) REP(10) { const LayerIn P = layer_in(args, L); Frame F = F0; F.tid = fresh_tid(); F.lane = F.tid & 63; if (rep_) xcd_barrier(bar); phase_norm2(F, L, lastL, args.in[0], args.in[2], pX, pY, pH, pMOD, P.norm_ffn_g, P.w_router, pAFF); SEAM(base + 10); }
        if (INL(11)) REP(11) { const LayerIn P = layer_in(args, L); Frame F = F0; F.tid = fresh_tid(); F.lane = F.tid & 63; if (rep_) xcd_barrier(bar); phase_topk(F, lastL ? 128 : 256, pAFF, pSRC, pGV, pINV);
            if (L == 0) { const LayerIn P1 = layer_in(args, 1); prep_s5(F, P1, ws); __syncthreads(); prep_small_weights(F, P1, ws); }
            prep_expert_weights(F, P, ws, (L == 0) ? 96 : 0, (L == 0) ? EW_SPLIT2 : 0, EXPERT_W_ITEMS); SEAM(base + 12); }
        if (INL(13)) REP(13) { const LayerIn P = layer_in(args, L); Frame F = F0; F.tid = fresh_tid(); F.lane = F.tid & 63; if (rep_) xcd_barrier(bar);
            pg8::Gemm g{pH, (const bf16_t*)(ws + WS_WGU), 1024, 1024, 1024}; OrderUp S{F.G, (int)blockIdx.x, lastL ? 8 : 9}; EpiUp E{pHID};
            pg8::gemm_phase_gather<EpiUp, OrderUp>(F.lds, g, pSRC, S, E);
            SEAM(base + 13);
        }
        if (INL(14)) REP(14) { const LayerIn P = layer_in(args, L); Frame F = F0; F.tid = fresh_tid(); F.lane = F.tid & 63; if (rep_) xcd_barrier(bar);
            pg8::Gemm g{pHID, (const bf16_t*)(ws + WS_WD), 1024, 1024, 1024}; OrderDown S{F.G, (int)blockIdx.x, lastL ? 8 : 9}; EpiDown E{pYE, pGV};
            pg8::gemm_phase<EpiDown, OrderDown>(F.lds, g, S, E);
            SEAM(base + 14);
        }
    }
#ifdef EXTRA_BARRIERS
    for (int eb = 0; eb < EXTRA_BARRIERS; ++eb) xcd_barrier(bar);
#endif
    if (IN(PH_FINAL)) phase_final(F0, pX, args.out, pMOD, args.in[37], pINV, pYE, pY);
#undef IN
#undef INL
#undef SEAM
}

#ifndef MK_N_LAUNCHES
#define MK_N_LAUNCHES 1
#endif
extern "C" void kernel_launch(void* const* d_in, const int* in_sizes, int n_in, void* d_out, int out_size, void* d_ws, size_t ws_size, hipStream_t stream) {
    static int grid = 0;
    if (grid == 0) {
        if (n_in != 38 || ws_size < WS_END) { fprintf(stderr, "kernel_launch: unexpected inputs (n_in %d, ws %zu)\n", n_in, ws_size); grid = -1; return; }
        int dev = 0, cus = 0;
        if (hipGetDevice(&dev) != hipSuccess || hipDeviceGetAttribute(&cus, hipDeviceAttributeMultiprocessorCount, dev) != hipSuccess) { grid = -1; return; }
        if (hipFuncSetAttribute((const void*)hybrid_fwd, hipFuncAttributeMaxDynamicSharedMemorySize, LDS_BYTES) != hipSuccess) { fprintf(stderr, "kernel_launch: hipFuncSetAttribute failed\n"); grid = -1; return; }
        (void)hipGetLastError();
        grid = (cus / 8) * 8;
        if (grid > 256) grid = 256;
    }
    if (grid < 0) return;
    if (hipMemsetAsync((char*)d_ws + WS_CTL, 0, CTL_ZERO_BYTES, stream) != hipSuccess) return;
    Args a{};
    for (int i = 0; i < 38; ++i) a.in[i] = (const float*)d_in[i];
    a.out = (float*)d_out; a.ws = (unsigned char*)d_ws;
#if MK_N_LAUNCHES == 1
    a.ph_lo = 0; a.ph_hi = PH_TOTAL;
    hipLaunchKernelGGL(hybrid_fwd, dim3(grid), dim3(NWAVES * 64), LDS_BYTES, stream, a);
#else
    for (int p = 0; p < PH_TOTAL; ++p) { a.ph_lo = p; a.ph_hi = p + 1; hipLaunchKernelGGL(hybrid_fwd, dim3(grid), dim3(NWAVES * 64), LDS_BYTES, stream, a); }
#endif
}
```

```cpp
#include <hip/hip_runtime.h>
#include <hip/hip_bf16.h>
#include <cstdio>
#include <cstdint>
#include <cmath>

#define DI __device__ __forceinline__
#define GAS __attribute__((address_space(1)))
#define LAS __attribute__((address_space(3)))
typedef unsigned short bf16_t;
typedef short bf16x8 __attribute__((ext_vector_type(8)));
typedef short s16x4 __attribute__((ext_vector_type(4)));
typedef float f32x2 __attribute__((ext_vector_type(2)));
typedef float f32x4 __attribute__((ext_vector_type(4)));
typedef float f32x16 __attribute__((ext_vector_type(16)));
typedef unsigned u32x2 __attribute__((ext_vector_type(2)));
typedef unsigned u32x4 __attribute__((ext_vector_type(4)));
typedef GAS unsigned gu32;

constexpr int DM = 1024, NB = 8, SEQ = 2048, CTXL = 256, PB = 2304, MROWS = NB * PB;
constexpr int NIN = 7688, NE = 16, EFF = 1024;
constexpr int C_Q = 0, C_K = 512, C_V = 640, C_Z = 768, C_XBC = 1280, C_DT = 2048, C_U = 2056, C_SB = 2440, C_SG = 2824, C_SH = 3208, C_G = 3592;
constexpr int PA_W = 3840, PG_W = 4096, NPROJ = PA_W + PG_W;
constexpr int EROWS = 2304;
constexpr float RMS_EPS = 1e-6f;
constexpr float ATT_C2 = 0.125f * 1.4426950408889634f;

constexpr size_t MiB = 1u << 20;
constexpr size_t WS_CTL = 0, CTL_ZERO_BYTES = 1 * MiB;
constexpr size_t WS_MOD = 1 * MiB;
constexpr size_t WS_ROPE = WS_MOD + 512 * 1024;
constexpr size_t WS_AFF = 2 * MiB;
constexpr size_t WS_INV = WS_AFF + 1280 * 1024;
constexpr size_t WS_DT = WS_INV + 1280 * 1024;
constexpr size_t WS_SRC = WS_DT + 1280 * 1024;
constexpr size_t WS_GV = WS_SRC + 256 * 1024;
constexpr size_t WS_SSQ = WS_GV + 256 * 1024;
constexpr size_t WS_TOT = WS_SSQ + 256 * 1024;
constexpr size_t WS_X = 8 * MiB;
constexpr size_t WS_W = 80 * MiB;
constexpr size_t W_WIN = WS_W;
constexpr size_t W_BR4 = W_WIN + (size_t)NPROJ * 1024 * 2;
constexpr size_t W_OUT = W_BR4 + (size_t)1024 * 1792 * 2;
constexpr size_t W_GLU = W_OUT + 1024 * 1024 * 2;
constexpr size_t W_TQ = W_GLU + 512 * 384 * 2;
constexpr size_t W_P = W_TQ + (size_t)24 * 512 * 768 * 2;
constexpr size_t W_END = W_P + (size_t)24 * 256 * 512 * 2;
constexpr size_t WS_H = 126 * MiB;
constexpr size_t WS_YAB = WS_H;
constexpr size_t WS_PA = 162 * MiB;
constexpr size_t WS_MRGB = WS_PA, WS_XG = WS_PA, WS_Y = WS_PA + 72 * MiB;
constexpr size_t WS_PG = 297 * MiB;
constexpr size_t WS_HID = WS_PG, WS_YE = WS_PG + 72 * MiB;
constexpr size_t WS_R5 = 441 * MiB;
constexpr size_t WS_QN = WS_R5;
constexpr size_t WS_KN = WS_R5 + 18 * MiB;
constexpr size_t WS_HIN = WS_R5;
constexpr size_t WS_XBC = WS_R5 + 22 * MiB + 512 * 1024;
constexpr size_t WS_AU = WS_R5 + 49 * MiB + 512 * 1024;
constexpr size_t WS_S = WS_R5 + 70 * MiB;
constexpr size_t WS_YG = WS_S;
constexpr size_t WS_S5S = WS_R5 + 106 * MiB;
constexpr size_t WS_YCD = WS_S5S + 13 * MiB + 512 * 1024;
constexpr size_t WS_WGU = WS_R5;
constexpr size_t WS_WD = WS_R5 + 64 * MiB;
constexpr size_t WS_END = WS_YCD + 27 * MiB;
static_assert(W_END <= WS_H, "small weights fit");
static_assert(WS_AU + (size_t)24 * 576 * 768 * 2 <= WS_S && WS_XBC + (size_t)MROWS * 768 * 2 <= WS_AU && WS_S + (size_t)8 * 18 * 16 * 4096 * 4 <= WS_S5S, "R5 map");
static_assert(WS_S5S + (size_t)24 * 576 * 256 * 4 <= WS_YCD && WS_YCD + (size_t)MROWS * 768 * 2 <= WS_END && WS_WD + (size_t)32 * MiB <= WS_YCD && WS_END <= (size_t)588 * MiB, "R5 map 2");
static_assert(WS_TOT + 16384 <= WS_X && WS_ROPE + 2048 * 64 * 4 <= WS_AFF, "misc map");

constexpr int CW_BAR = 4096;

constexpr int NWAVES = 8;
constexpr int LDS_SCRATCH = 151552;
constexpr int LDSCTL_OFF = LDS_SCRATCH;
constexpr int LDS_BYTES = 155648;

#define LDS_WAIT() asm volatile("s_waitcnt lgkmcnt(0)" ::: "memory")
#define VM_WAIT() asm volatile("s_waitcnt vmcnt(0)" ::: "memory")
DI int fresh_tid() { int t = threadIdx.x; asm volatile("" : "+v"(t)); return t; }
DI unsigned f2bf(float f) { unsigned u = __builtin_bit_cast(unsigned, f); return (u + 0x7fffu + ((u >> 16) & 1u)) >> 16; }
DI unsigned pk2(float lo, float hi) { return f2bf(lo) | (f2bf(hi) << 16); }
DI float bflo(unsigned w) { return __builtin_bit_cast(float, w << 16); }
DI float bfhi(unsigned w) { return __builtin_bit_cast(float, w & 0xffff0000u); }
DI float bf2f(bf16_t h) { return __builtin_bit_cast(float, (unsigned)h << 16); }
DI float silu_f(float x) { return x / (1.f + __expf(-x)); }
DI float sigmoid_f(float x) { return 1.f / (1.f + __expf(-x)); }
DI float softplus_f(float x) { return fmaxf(x, 0.f) + log1pf(__expf(-fabsf(x))); }
DI float gelu_tanh_f(float x) { const float u = 0.7978845608028654f * (x + 0.044715f * x * x * x); const float t = 1.f - 2.f / (__expf(2.f * u) + 1.f); return 0.5f * x * (1.f + t); }
DI float wave_sum(float v) {
#pragma unroll
    for (int o = 1; o < 64; o <<= 1) v += __shfl_xor(v, o);
    return v;
}
DI void unpack8(const u32x4 w, float (&f)[8]) {
    f[0] = bflo(w.x); f[1] = bfhi(w.x); f[2] = bflo(w.y); f[3] = bfhi(w.y); f[4] = bflo(w.z); f[5] = bfhi(w.z); f[6] = bflo(w.w); f[7] = bfhi(w.w);
}
DI u32x4 pack8(const float (&f)[8]) { u32x4 w; w.x = pk2(f[0], f[1]); w.y = pk2(f[2], f[3]); w.z = pk2(f[4], f[5]); w.w = pk2(f[6], f[7]); return w; }

#define XB_TMO      128
#define XB_XCNT(j)  (256  + 64 * (j))
#define XB_XSUB(j)  (1280 + 64 * (j))
#define XB_XGEN(j)  (2304 + 64 * (j))
#define XB_TOP      3328
#define XB_TOPGEN   3392
#define XCD_BAR_WORDS 3456
#define XB_SPIN_CAP (1u << 20)
DI unsigned xb_ld(unsigned* p)              { return __hip_atomic_load(p, __ATOMIC_RELAXED, __HIP_MEMORY_SCOPE_AGENT); }
DI unsigned xb_add(unsigned* p, unsigned v) { return __hip_atomic_fetch_add(p, v, __ATOMIC_RELAXED, __HIP_MEMORY_SCOPE_AGENT); }
DI unsigned xb_xcc_id() { return (unsigned)__builtin_amdgcn_s_getreg((3 << 11) | 20) & 0xFu; }
#define XB_SPIN(cond, bar) do { unsigned _sp = 0; while (cond) { __builtin_amdgcn_s_sleep(1); \
    if ((++_sp & 255u) == 0u) { if (xb_ld(&(bar)[XB_TMO])) break; if (_sp > XB_SPIN_CAP) { atomicAdd(&(bar)[XB_TMO], 1u); break; } } } } while (0)
struct XcdBarrier { unsigned* bar; unsigned x; volatile LAS unsigned* st; };
DI XcdBarrier xcd_barrier_post(unsigned* bar, volatile LAS unsigned* st) {
    XcdBarrier b; b.bar = bar; b.x = xb_xcc_id(); b.st = st;
    if (threadIdx.x == 0) (void)xb_add(&bar[XB_XCNT(b.x)], 1u);
    return b;
}
DI void xcd_barrier_complete(unsigned* bar, unsigned x, unsigned& nloc, unsigned& nx) {
    const unsigned G = gridDim.x * gridDim.y * gridDim.z;
    unsigned sum, cnt, mine, sp = 0u;
    for (;;) {
        sum = 0u; cnt = 0u; mine = 0u;
#pragma unroll
        for (unsigned j = 0; j < 16; ++j) { const unsigned c = xb_ld(&bar[XB_XCNT(j)]); sum += c; cnt += (c > 0u) ? 1u : 0u; mine = (j == x) ? c : mine; }
        if (sum == G) break;
        __builtin_amdgcn_s_sleep(1);
        if ((++sp & 255u) == 0u) { if (xb_ld(&bar[XB_TMO])) break; if (sp > XB_SPIN_CAP) { atomicAdd(&bar[XB_TMO], 1u); break; } }
    }
    nloc = mine > 0u ? mine : 1u; nx = cnt > 0u ? cnt : 1u;
}
DI void xcd_barrier(const XcdBarrier& b) {
    asm volatile("s_waitcnt vmcnt(0)" ::: "memory");
    __syncthreads();
    if (threadIdx.x == 0) {
        unsigned* bar = b.bar;
        asm volatile("" : "+s"(bar));
        __builtin_amdgcn_s_waitcnt(0);
        unsigned nloc = b.st[0], nx = b.st[1];
        if (nloc == 0u) { xcd_barrier_complete(bar, b.x, nloc, nx); b.st[0] = nloc; b.st[1] = nx; }
        const unsigned old = xb_add(&bar[XB_XSUB(b.x)], 1u);
        const unsigned gen = old / nloc;
        if (old + 1u == (gen + 1u) * nloc) {
            __builtin_amdgcn_fence(__ATOMIC_RELEASE, "agent");
            asm volatile("s_waitcnt vmcnt(0)" ::: "memory");
            const unsigned og = xb_add(&bar[XB_TOP], 1u);
            const unsigned tg = og / nx;
            if (og + 1u == (tg + 1u) * nx) xb_add(&bar[XB_TOPGEN], 1u);
            else XB_SPIN(xb_ld(&bar[XB_TOPGEN]) == tg, bar);
            __builtin_amdgcn_fence(__ATOMIC_ACQUIRE, "agent");
            xb_add(&bar[XB_XGEN(b.x)], 1u);
            asm volatile("s_waitcnt vmcnt(0)" ::: "memory");
        } else {
            XB_SPIN(xb_ld(&bar[XB_XGEN(b.x)]) == gen, bar);
            __builtin_amdgcn_fence(__ATOMIC_ACQUIRE, "agent");
            asm volatile("s_waitcnt vmcnt(0)" ::: "memory");
        }
    }
    __syncthreads();
}

namespace pg8 {
constexpr int BM = 256, BK = 64, HALF = 128, HTB = HALF * BK * 2, STAGE_BYTES = 8 * HTB, NXCD = 8, WGM = 8;
__host__ __device__ __forceinline__ int lds_byte(int r, int c) { const int st = (r >> 4) * 2 + (c >> 5), rr = r & 15, cc = c & 31, ob = rr * 64 + cc * 2; return st * 1024 + (ob ^ (((ob >> 9) & 1) << 5)); }
__host__ __device__ __forceinline__ void stage_rc(int b, int& R, int& C) { const int st = b / 1024, sb = b % 1024, swz = sb ^ (((sb >> 9) & 1) << 5); R = (st >> 1) * 16 + swz / 64; C = (st & 1) * 32 + (swz % 64) / 2; }
__host__ __device__ __forceinline__ int perm32(int rho) { const int n = rho >> 4, i = rho & 15; return 8 * (i >> 2) + 4 * n + (i & 3); }

struct Unit { int arow, brow, pm, pn; };
struct Gemm { const bf16_t* A; const bf16_t* Bt; int lda, ldb, K; };

template <class Epi, class Sched, bool ALIGN_EPI = true>
DI void gemm_phase(LAS unsigned char* lds, const Gemm g, const Sched& S, const Epi& E) {
    const int tid = fresh_tid(), wid = __builtin_amdgcn_readfirstlane(tid >> 6), lane = tid & 63, wr = wid >> 2, wc = wid & 3, fr = lane & 15, fq = lane >> 4;
    const int K = g.K, nt = K / BK;
    unsigned voffA[2], voffB[2];
#pragma unroll
    for (int i = 0; i < 2; ++i) { int R, C; stage_rc(tid * 16 + i * 8192, R, C); const int Rb = Epi::PERM ? ((R & ~31) + perm32(R & 31)) : R;
        voffA[i] = (unsigned)(R * g.lda + C) * 2u; voffB[i] = (unsigned)(Rb * g.ldb + C) * 2u; }
    const size_t kstep = (size_t)(BK * 2);
    const size_t hA = (size_t)HALF * g.lda * 2, hB = (size_t)HALF * g.ldb * 2;
    const unsigned ldsw = (unsigned)wid * 1024u;
    const int aoff = lds_byte(wr * 64 + fr, fq * 8), boff = lds_byte(wc * 32 + fr, fq * 8);
#define PG8_SA(b, h) (((b) * 2 + (h)) * HTB)
#define PG8_SB(b, h) ((4 + (b) * 2 + (h)) * HTB)
#define PG8_STAGE(bufoff, gbase, voff) do { _Pragma("unroll") for (int _i = 0; _i < 2; ++_i) \
        __builtin_amdgcn_global_load_lds((const unsigned*)((const char*)(gbase) + (voff)[_i]), (LAS unsigned*)(lds + (bufoff) + ldsw + _i * 8192), 16, 0, 0); } while (0)
#define PG8_LDA(dst, b, h) do { _Pragma("unroll") for (int m = 0; m < 4; ++m) _Pragma("unroll") for (int k = 0; k < 2; ++k) dst[m][k] = *(const LAS bf16x8*)(lds + PG8_SA(b, h) + aoff + m * 2048 + k * 1024); } while (0)
#define PG8_LDB(dst, b, h) do { _Pragma("unroll") for (int n = 0; n < 2; ++n) _Pragma("unroll") for (int k = 0; k < 2; ++k) dst[n][k] = *(const LAS bf16x8*)(lds + PG8_SB(b, h) + boff + n * 2048 + k * 1024); } while (0)
#define PG8_MMA(ai, bj, At, Bt) do { __builtin_amdgcn_s_setprio(1); _Pragma("unroll") for (int m = 0; m < 4; ++m) _Pragma("unroll") for (int n = 0; n < 2; ++n) _Pragma("unroll") for (int k = 0; k < 2; ++k) \
        acc[ai][bj][m][n] = __builtin_amdgcn_mfma_f32_16x16x32_bf16(Bt[n][k], At[m][k], acc[ai][bj][m][n], 0, 0, 0); __builtin_amdgcn_s_setprio(0); } while (0)
#define PG8_WAIT_V(n) asm volatile("s_waitcnt vmcnt(" #n ")" ::: "memory")
#define PG8_WAIT_L(n) asm volatile("s_waitcnt lgkmcnt(" #n ")" ::: "memory")
#define PG8_BAR __builtin_amdgcn_s_barrier()
#define PG8_SCHED __builtin_amdgcn_sched_barrier(0)
    int ui = 0;
    Unit cur = S.next(0);
    if (cur.arow < 0) return;
    f32x4 acc[2][2][4][2];
#pragma unroll
    for (int a = 0; a < 2; ++a)
#pragma unroll
        for (int b = 0; b < 2; ++b)
#pragma unroll
            for (int m = 0; m < 4; ++m)
#pragma unroll
                for (int n = 0; n < 2; ++n) acc[a][b][m][n] = (f32x4){0.f, 0.f, 0.f, 0.f};
    bf16x8 At[4][2], B0[2][2], B1[2][2];
    const char* cA = (const char*)g.A + (size_t)cur.arow * g.lda * 2; const char* cB = (const char*)g.Bt + (size_t)cur.brow * g.ldb * 2;
    PG8_STAGE(PG8_SB(0, 0), cB, voffB); PG8_STAGE(PG8_SB(0, 1), cB + hB, voffB); PG8_STAGE(PG8_SA(0, 0), cA, voffA); PG8_STAGE(PG8_SA(0, 1), cA + hA, voffA);
    if (wr == 1) PG8_BAR;
    PG8_WAIT_V(2); PG8_BAR;
    PG8_STAGE(PG8_SB(1, 0), cB + kstep, voffB); PG8_STAGE(PG8_SA(1, 0), cA + kstep, voffA); PG8_STAGE(PG8_SB(1, 1), cB + hB + kstep, voffB);
    PG8_WAIT_V(6); PG8_BAR;
    for (;;) {
        const Unit nxt = S.next(ui + 1);
        const bool has_next = nxt.arow >= 0;
        const char* nA = has_next ? (const char*)g.A + (size_t)nxt.arow * g.lda * 2 : cA; const char* nB = has_next ? (const char*)g.Bt + (size_t)nxt.brow * g.ldb * 2 : cB;
#pragma unroll 1
        for (int t = 0; t < nt; t += 2) {
            const bool last = (t == nt - 2);
            const char* a1 = cA + (size_t)(t + 1) * kstep;
            const char* a2 = last ? nA : cA + (size_t)(t + 2) * kstep; const char* b2 = last ? nB : cB + (size_t)(t + 2) * kstep;
            const char* a3 = a2 + kstep; const char* b3 = b2 + kstep;
            PG8_LDB(B0, 0, 0); PG8_LDB(B1, 0, 1); PG8_SCHED; PG8_LDA(At, 0, 0); PG8_STAGE(PG8_SA(1, 1), a1 + hA, voffA);
            PG8_WAIT_V(8); PG8_WAIT_L(0); PG8_BAR; PG8_MMA(0, 0, At, B0); PG8_MMA(0, 1, At, B1); PG8_BAR; PG8_SCHED;
            PG8_LDA(At, 0, 1); PG8_STAGE(PG8_SB(0, 0), b2, voffB); PG8_STAGE(PG8_SB(0, 1), b2 + hB, voffB); PG8_STAGE(PG8_SA(0, 0), a2, voffA);
            PG8_WAIT_V(8); PG8_WAIT_L(0); PG8_BAR; PG8_MMA(1, 0, At, B0); PG8_MMA(1, 1, At, B1); PG8_BAR; PG8_SCHED;
            PG8_LDB(B0, 1, 0); PG8_LDB(B1, 1, 1); PG8_SCHED; PG8_LDA(At, 1, 0); PG8_STAGE(PG8_SA(0, 1), a2 + hA, voffA);
            PG8_WAIT_V(8); PG8_WAIT_L(0); PG8_BAR; PG8_MMA(0, 0, At, B0); PG8_MMA(0, 1, At, B1); PG8_BAR; PG8_SCHED;
            PG8_LDA(At, 1, 1); PG8_STAGE(PG8_SB(1, 0), b3, voffB); PG8_STAGE(PG8_SB(1, 1), b3 + hB, voffB); PG8_STAGE(PG8_SA(1, 0), a3, voffA);
            PG8_WAIT_V(8); PG8_WAIT_L(0); PG8_BAR; PG8_MMA(1, 0, At, B0); PG8_MMA(1, 1, At, B1); PG8_BAR; PG8_SCHED;
        }
        if constexpr (ALIGN_EPI) { if (wr == 0) PG8_BAR; }
        E(acc, cur, wr, wc, fr, fq);
        if (!has_next) break;
#pragma unroll
        for (int a = 0; a < 2; ++a)
#pragma unroll
            for (int b = 0; b < 2; ++b)
#pragma unroll
                for (int m = 0; m < 4; ++m)
#pragma unroll
                    for (int n = 0; n < 2; ++n) acc[a][b][m][n] = (f32x4){0.f, 0.f, 0.f, 0.f};
        cur = nxt; cA = nA; cB = nB; ++ui;
        if constexpr (ALIGN_EPI) { if (wr == 1) PG8_BAR; }
    }
    PG8_WAIT_V(0);
    if constexpr (!ALIGN_EPI) { if (wr == 0) PG8_BAR; }
    PG8_BAR;
#undef PG8_SA
#undef PG8_SB
#undef PG8_STAGE
#undef PG8_LDA
#undef PG8_LDB
#undef PG8_MMA
#undef PG8_WAIT_V
#undef PG8_WAIT_L
#undef PG8_BAR
#undef PG8_SCHED
}

template <class Epi, class Sched, bool ALIGN_EPI = true>
DI void gemm_phase_gather(LAS unsigned char* lds, const Gemm g, const int* __restrict__ grow, const Sched& S, const Epi& E) {
    const int tid = fresh_tid(), wid = __builtin_amdgcn_readfirstlane(tid >> 6), lane = tid & 63, wr = wid >> 2, wc = wid & 3, fr = lane & 15, fq = lane >> 4;
    const int K = g.K, nt = K / BK;
    unsigned voffB[2];
#pragma unroll
    for (int i = 0; i < 2; ++i) { int R, C; stage_rc(tid * 16 + i * 8192, R, C); const int Rb = Epi::PERM ? ((R & ~31) + perm32(R & 31)) : R;
        voffB[i] = (unsigned)(Rb * g.ldb + C) * 2u; }
#define PG8_RA(i_) ([&]{ int R_, C_; stage_rc(tid * 16 + (i_) * 8192, R_, C_); return R_; }())
#define PG8_CA2(i_) ([&]{ int R_, C_; stage_rc(tid * 16 + (i_) * 8192, R_, C_); return (unsigned)C_ * 2u; }())
    unsigned vAc[2][2];
#define PG8_GOFF(dst, arow_) do { _Pragma("unroll") for (int h_ = 0; h_ < 2; ++h_) _Pragma("unroll") for (int i_ = 0; i_ < 2; ++i_) \
        dst[h_][i_] = (unsigned)grow[(arow_) + h_ * HALF + PG8_RA(i_)] * (unsigned)(g.lda * 2) + PG8_CA2(i_); } while (0)
    const size_t kstep = (size_t)(BK * 2);
    const size_t hB = (size_t)HALF * g.ldb * 2;
    const unsigned ldsw = (unsigned)wid * 1024u;
    const int aoff = lds_byte(wr * 64 + fr, fq * 8), boff = lds_byte(wc * 32 + fr, fq * 8);
#define PG8_SA(b, h) (((b) * 2 + (h)) * HTB)
#define PG8_SB(b, h) ((4 + (b) * 2 + (h)) * HTB)
#define PG8_STAGE(bufoff, gbase, voff) do { _Pragma("unroll") for (int _i = 0; _i < 2; ++_i) \
        __builtin_amdgcn_global_load_lds((const unsigned*)((const char*)(gbase) + (voff)[_i]), (LAS unsigned*)(lds + (bufoff) + ldsw + _i * 8192), 16, 0, 0); } while (0)
#define PG8_STAGEA(bufoff, kbyte, vv, hf) do { _Pragma("unroll") for (int _i = 0; _i < 2; ++_i) \
        __builtin_amdgcn_global_load_lds((const unsigned*)((const char*)g.A + (kbyte) + vv[hf][_i]), (LAS unsigned*)(lds + (bufoff) + ldsw + _i * 8192), 16, 0, 0); } while (0)
#define PG8_LDA(dst, b, h) do { _Pragma("unroll") for (int m = 0; m < 4; ++m) _Pragma("unroll") for (int k = 0; k < 2; ++k) dst[m][k] = *(const LAS bf16x8*)(lds + PG8_SA(b, h) + aoff + m * 2048 + k * 1024); } while (0)
#define PG8_LDB(dst, b, h) do { _Pragma("unroll") for (int n = 0; n < 2; ++n) _Pragma("unroll") for (int k = 0; k < 2; ++k) dst[n][k] = *(const LAS bf16x8*)(lds + PG8_SB(b, h) + boff + n * 2048 + k * 1024); } while (0)
#define PG8_MMA(ai, bj, At, Bt) do { __builtin_amdgcn_s_setprio(1); _Pragma("unroll") for (int m = 0; m < 4; ++m) _Pragma("unroll") for (int n = 0; n < 2; ++n) _Pragma("unroll") for (int k = 0; k < 2; ++k) \
        acc[ai][bj][m][n] = __builtin_amdgcn_mfma_f32_16x16x32_bf16(Bt[n][k], At[m][k], acc[ai][bj][m][n], 0, 0, 0); __builtin_amdgcn_s_setprio(0); } while (0)
#define PG8_WAIT_V(n) asm volatile("s_waitcnt vmcnt(" #n ")" ::: "memory")
#define PG8_WAIT_L(n) asm volatile("s_waitcnt lgkmcnt(" #n ")" ::: "memory")
#define PG8_BAR __builtin_amdgcn_s_barrier()
#define PG8_SCHED __builtin_amdgcn_sched_barrier(0)
    int ui = 0;
    Unit cur = S.next(0);
    if (cur.arow < 0) return;
    f32x4 acc[2][2][4][2];
#pragma unroll
    for (int a = 0; a < 2; ++a)
#pragma unroll
        for (int b = 0; b < 2; ++b)
#pragma unroll
            for (int m = 0; m < 4; ++m)
#pragma unroll
                for (int n = 0; n < 2; ++n) acc[a][b][m][n] = (f32x4){0.f, 0.f, 0.f, 0.f};
    bf16x8 At[4][2], B0[2][2], B1[2][2];
    const char* cB = (const char*)g.Bt + (size_t)cur.brow * g.ldb * 2;
    PG8_GOFF(vAc, cur.arow);
    PG8_STAGE(PG8_SB(0, 0), cB, voffB); PG8_STAGE(PG8_SB(0, 1), cB + hB, voffB); PG8_STAGEA(PG8_SA(0, 0), 0, vAc, 0); PG8_STAGEA(PG8_SA(0, 1), 0, vAc, 1);
    if (wr == 1) PG8_BAR;
    PG8_WAIT_V(2); PG8_BAR;
    PG8_STAGE(PG8_SB(1, 0), cB + kstep, voffB); PG8_STAGEA(PG8_SA(1, 0), kstep, vAc, 0); PG8_STAGE(PG8_SB(1, 1), cB + hB + kstep, voffB);
    PG8_WAIT_V(6); PG8_BAR;
    for (;;) {
        const Unit nxt = S.next(ui + 1);
        const bool has_next = nxt.arow >= 0;
        const char* nB = has_next ? (const char*)g.Bt + (size_t)nxt.brow * g.ldb * 2 : cB;
        int rawn[2][2];
#pragma unroll
        for (int h_ = 0; h_ < 2; ++h_)
#pragma unroll
            for (int i_ = 0; i_ < 2; ++i_) rawn[h_][i_] = has_next ? grow[nxt.arow + h_ * HALF + PG8_RA(i_)] : 0;
#pragma unroll 1
        for (int t = 0; t < nt; t += 2) {
            const bool last = (t == nt - 2);
            const size_t k1 = (size_t)(t + 1) * kstep, k2 = last ? 0 : (size_t)(t + 2) * kstep, k3 = k2 + kstep;
            const char* b2 = last ? nB : cB + (size_t)(t + 2) * kstep; const char* b3 = b2 + kstep;
            PG8_LDB(B0, 0, 0); PG8_LDB(B1, 0, 1); PG8_SCHED; PG8_LDA(At, 0, 0); PG8_STAGEA(PG8_SA(1, 1), k1, vAc, 1);
            if (last && has_next) {
#pragma unroll
                for (int h_ = 0; h_ < 2; ++h_)
#pragma unroll
                    for (int i_ = 0; i_ < 2; ++i_) vAc[h_][i_] = (unsigned)rawn[h_][i_] * (unsigned)(g.lda * 2) + PG8_CA2(i_); }
            PG8_WAIT_V(8); PG8_WAIT_L(0); PG8_BAR; PG8_MMA(0, 0, At, B0); PG8_MMA(0, 1, At, B1); PG8_BAR; PG8_SCHED;
            PG8_LDA(At, 0, 1); PG8_STAGE(PG8_SB(0, 0), b2, voffB); PG8_STAGE(PG8_SB(0, 1), b2 + hB, voffB); PG8_STAGEA(PG8_SA(0, 0), k2, vAc, 0);
            PG8_WAIT_V(8); PG8_WAIT_L(0); PG8_BAR; PG8_MMA(1, 0, At, B0); PG8_MMA(1, 1, At, B1); PG8_BAR; PG8_SCHED;
            PG8_LDB(B0, 1, 0); PG8_LDB(B1, 1, 1); PG8_SCHED; PG8_LDA(At, 1, 0); PG8_STAGEA(PG8_SA(0, 1), k2, vAc, 1);
            PG8_WAIT_V(8); PG8_WAIT_L(0); PG8_BAR; PG8_MMA(0, 0, At, B0); PG8_MMA(0, 1, At, B1); PG8_BAR; PG8_SCHED;
            PG8_LDA(At, 1, 1); PG8_STAGE(PG8_SB(1, 0), b3, voffB); PG8_STAGE(PG8_SB(1, 1), b3 + hB, voffB); PG8_STAGEA(PG8_SA(1, 0), k3, vAc, 0);
            PG8_WAIT_V(8); PG8_WAIT_L(0); PG8_BAR; PG8_MMA(1, 0, At, B0); PG8_MMA(1, 1, At, B1); PG8_BAR; PG8_SCHED;
        }
        if constexpr (ALIGN_EPI) { if (wr == 0) PG8_BAR; }
        E(acc, cur, wr, wc, fr, fq);
        if (!has_next) break;
#pragma unroll
        for (int a = 0; a < 2; ++a)
#pragma unroll
            for (int b = 0; b < 2; ++b)
#pragma unroll
                for (int m = 0; m < 4; ++m)
#pragma unroll
                    for (int n = 0; n < 2; ++n) acc[a][b][m][n] = (f32x4){0.f, 0.f, 0.f, 0.f};
        cur = nxt; cB = nB; ++ui;
        if constexpr (ALIGN_EPI) { if (wr == 1) PG8_BAR; }
    }
    PG8_WAIT_V(0);
    if constexpr (!ALIGN_EPI) { if (wr == 0) PG8_BAR; }
    PG8_BAR;
#undef PG8_SA
#undef PG8_SB
#undef PG8_STAGE
#undef PG8_STAGEA
#undef PG8_GOFF
#undef PG8_RA
#undef PG8_CA2
#undef PG8_LDA
#undef PG8_LDB
#undef PG8_MMA
#undef PG8_WAIT_V
#undef PG8_WAIT_L
#undef PG8_BAR
#undef PG8_SCHED
}

struct MergeArgs { const bf16_t* YAB; const bf16_t* YCD; const bf16_t* W4T; const bf16_t* G; bf16_t* MRGB; };
template <class Sched>
DI void gemm_merge_phase(LAS unsigned char* lds, const MergeArgs M, const Sched& S) {
    const int tid = fresh_tid(), wid = __builtin_amdgcn_readfirstlane(tid >> 6), lane = tid & 63, wr = wid >> 2, wc = wid & 3, fr = lane & 15, fq = lane >> 4;
    constexpr int NT = 28, LDB = 1792;
    unsigned vA0[2], vA1[2], voffB[2];
#pragma unroll
    for (int i = 0; i < 2; ++i) { int R, C; stage_rc(tid * 16 + i * 8192, R, C); const int Rb = (R & ~31) + perm32(R & 31);
        vA0[i] = (unsigned)(R * 1024 + C) * 2u; vA1[i] = (unsigned)(R * 768 + C) * 2u; voffB[i] = (unsigned)(Rb * LDB + C) * 2u; }
    const size_t kstep = (size_t)(BK * 2);
    const unsigned ldsw = (unsigned)wid * 1024u;
    const int aoff = lds_byte(wr * 64 + fr, fq * 8), boff = lds_byte(wc * 32 + fr, fq * 8);
#define PG8_SA(b, h) (((b) * 2 + (h)) * HTB)
#define PG8_SB(b, h) ((4 + (b) * 2 + (h)) * HTB)
#define PG8_STAGEB(bufoff, gbase) do { _Pragma("unroll") for (int _i = 0; _i < 2; ++_i) \
        __builtin_amdgcn_global_load_lds((const unsigned*)((const char*)(gbase) + voffB[_i]), (LAS unsigned*)(lds + (bufoff) + ldsw + _i * 8192), 16, 0, 0); } while (0)
#define PG8_STAGEA(bufoff, arow_, tt, hf) do { const bool ab_ = (tt) < 16; \
        const char* gp_ = ab_ ? (const char*)M.YAB + ((size_t)(arow_) + (hf) * HALF) * 2048 + (size_t)(tt) * 128 : (const char*)M.YCD + ((size_t)(arow_) + (hf) * HALF) * 1536 + (size_t)((tt) - 16) * 128; \
        const unsigned o0_ = ab_ ? vA0[0] : vA1[0], o1_ = ab_ ? vA0[1] : vA1[1]; \
        __builtin_amdgcn_global_load_lds((const unsigned*)(gp_ + o0_), (LAS unsigned*)(lds + (bufoff) + ldsw), 16, 0, 0); \
        __builtin_amdgcn_global_load_lds((const unsigned*)(gp_ + o1_), (LAS unsigned*)(lds + (bufoff) + ldsw + 8192), 16, 0, 0); } while (0)
#define PG8_LDA(dst, b, h) do { _Pragma("unroll") for (int m = 0; m < 4; ++m) _Pragma("unroll") for (int k = 0; k < 2; ++k) dst[m][k] = *(const LAS bf16x8*)(lds + PG8_SA(b, h) + aoff + m * 2048 + k * 1024); } while (0)
#define PG8_LDB(dst, b, h) do { _Pragma("unroll") for (int n = 0; n < 2; ++n) _Pragma("unroll") for (int k = 0; k < 2; ++k) dst[n][k] = *(const LAS bf16x8*)(lds + PG8_SB(b, h) + boff + n * 2048 + k * 1024); } while (0)
#define PG8_MMA(ai, At, Bt) do { __builtin_amdgcn_s_setprio(1); _Pragma("unroll") for (int m = 0; m < 4; ++m) _Pragma("unroll") for (int n = 0; n < 2; ++n) _Pragma("unroll") for (int k = 0; k < 2; ++k) \
        acc[ai][0][m][n] = __builtin_amdgcn_mfma_f32_16x16x32_bf16(Bt[n][k], At[m][k], acc[ai][0][m][n], 0, 0, 0); __builtin_amdgcn_s_setprio(0); } while (0)
#define PG8_WAIT_V(n) asm volatile("s_waitcnt vmcnt(" #n ")" ::: "memory")
#define PG8_WAIT_L(n) asm volatile("s_waitcnt lgkmcnt(" #n ")" ::: "memory")
#define PG8_BAR __builtin_amdgcn_s_barrier()
#define PG8_SCHED __builtin_amdgcn_sched_barrier(0)
    int ui = 0;
    Unit cur = S.next(0);
    if (cur.arow < 0) return;
    f32x4 acc[2][2][4][2];
#pragma unroll
    for (int a = 0; a < 2; ++a)
#pragma unroll
        for (int b = 0; b < 2; ++b)
#pragma unroll
            for (int m = 0; m < 4; ++m)
#pragma unroll
                for (int n = 0; n < 2; ++n) acc[a][b][m][n] = (f32x4){0.f, 0.f, 0.f, 0.f};
    bf16x8 At[4][2], B0[2][2];
    const char* cB = (const char*)M.W4T + (size_t)cur.brow * LDB * 2;
    int carow = cur.arow;
    PG8_STAGEB(PG8_SB(0, 0), cB); PG8_STAGEA(PG8_SA(0, 0), carow, 0, 0); PG8_STAGEA(PG8_SA(0, 1), carow, 0, 1);
    if (wr == 1) PG8_BAR;
    PG8_WAIT_V(2); PG8_BAR;
    PG8_STAGEB(PG8_SB(1, 0), cB + kstep); PG8_STAGEA(PG8_SA(1, 0), carow, 1, 0);
    PG8_WAIT_V(4); PG8_BAR;
    for (;;) {
        const Unit nxt = S.next(ui + 1);
        const bool has_next = nxt.arow >= 0;
        const int narow = has_next ? nxt.arow : carow; const char* nB = has_next ? (const char*)M.W4T + (size_t)nxt.brow * LDB * 2 : cB;
#pragma unroll 1
        for (int t = 0; t < NT; t += 2) {
            const bool last = (t == NT - 2);
            const bool fold_it = (t == 6 || t == 14 || t == 20 || t == 26);
            u32x4 gw0[4]; int fseg = 0;
            if (fold_it) {
                const int seg = (t == 6) ? 0 : (t == 14) ? 1 : (t == 20) ? 2 : 3; fseg = seg;
                int row0 = cur.arow + wr * 64 + fr, col = cur.pn * 128 + wc * 32 + 8 * fq;
                asm volatile("" : "+v"(row0), "+v"(col));
#pragma unroll
                for (int m = 0; m < 4; ++m) gw0[m] = *(const u32x4*)(M.G + (size_t)(row0 + m * 16) * PG_W + seg * 1024 + col);
            }
            const int t2 = last ? 0 : t + 2, t3 = t2 + 1; const int arow2 = last ? narow : carow;
            const char* b2 = last ? nB : cB + (size_t)(t + 2) * kstep; const char* b3 = b2 + kstep;
            PG8_LDB(B0, 0, 0); PG8_SCHED; PG8_LDA(At, 0, 0); PG8_STAGEA(PG8_SA(1, 1), carow, t + 1, 1);
            PG8_WAIT_V(6); PG8_WAIT_L(0); PG8_BAR; PG8_MMA(0, At, B0); PG8_BAR; PG8_SCHED;
            PG8_LDA(At, 0, 1); PG8_STAGEB(PG8_SB(0, 0), b2); PG8_STAGEA(PG8_SA(0, 0), arow2, t2, 0);
            PG8_WAIT_V(6); PG8_WAIT_L(0); PG8_BAR; PG8_MMA(1, At, B0); PG8_BAR; PG8_SCHED;
            PG8_LDB(B0, 1, 0); PG8_SCHED; PG8_LDA(At, 1, 0); PG8_STAGEA(PG8_SA(0, 1), arow2, t2, 1);
            PG8_WAIT_V(6); PG8_WAIT_L(0); PG8_BAR; PG8_MMA(0, At, B0); PG8_BAR; PG8_SCHED;
            PG8_LDA(At, 1, 1); PG8_STAGEB(PG8_SB(1, 0), b3); PG8_STAGEA(PG8_SA(1, 0), arow2, t3, 0);
            PG8_WAIT_V(6); PG8_WAIT_L(0); PG8_BAR; PG8_MMA(1, At, B0); PG8_BAR; PG8_SCHED;
            if (fold_it) {
                u32x4 gw1[4];
                { int row1 = cur.arow + 128 + wr * 64 + fr, col = cur.pn * 128 + wc * 32 + 8 * fq;
                  asm volatile("" : "+v"(row1), "+v"(col));
#pragma unroll
                  for (int m = 0; m < 4; ++m) gw1[m] = *(const u32x4*)(M.G + (size_t)(row1 + m * 16) * PG_W + fseg * 1024 + col); }
#pragma unroll
                for (int ai = 0; ai < 2; ++ai)
#pragma unroll
                    for (int m = 0; m < 4; ++m) {
                        float gf[8]; unpack8(ai == 0 ? gw0[m] : gw1[m], gf);
#pragma unroll
                        for (int k = 0; k < 4; ++k) { acc[ai][1][m][0][k] += acc[ai][0][m][0][k] * sigmoid_f(gf[k]); acc[ai][1][m][1][k] += acc[ai][0][m][1][k] * sigmoid_f(gf[4 + k]); }
                        acc[ai][0][m][0] = (f32x4){0.f, 0.f, 0.f, 0.f}; acc[ai][0][m][1] = (f32x4){0.f, 0.f, 0.f, 0.f}; }
                if (t == NT - 2) {
                    int row0 = cur.arow + wr * 64 + fr, col = cur.pn * 128 + wc * 32 + 8 * fq;
                    asm volatile("" : "+v"(row0), "+v"(col));
#pragma unroll
                    for (int ai = 0; ai < 2; ++ai)
#pragma unroll
                        for (int m = 0; m < 4; ++m) { const f32x4 v0 = acc[ai][1][m][0], v1 = acc[ai][1][m][1];
                            u32x4 w; w.x = pk2(v0[0], v0[1]); w.y = pk2(v0[2], v0[3]); w.z = pk2(v1[0], v1[1]); w.w = pk2(v1[2], v1[3]);
                            *(u32x4*)(M.MRGB + (size_t)(row0 + ai * 128 + m * 16) * 1024 + col) = w;
                            acc[ai][1][m][0] = (f32x4){0.f, 0.f, 0.f, 0.f}; acc[ai][1][m][1] = (f32x4){0.f, 0.f, 0.f, 0.f}; } }
            }
        }
        if (!has_next) break;
        cur = nxt; carow = narow; cB = nB; ++ui;
    }
    PG8_WAIT_V(0);
    if (wr == 0) PG8_BAR;
    PG8_BAR;
#undef PG8_SA
#undef PG8_SB
#undef PG8_STAGEA
#undef PG8_STAGEB
#undef PG8_LDA
#undef PG8_LDB
#undef PG8_MMA
#undef PG8_WAIT_V
#undef PG8_WAIT_L
#undef PG8_BAR
#undef PG8_SCHED
}
}

using pg8::Unit;

struct EpiProj {
    static constexpr bool PERM = true;
    bf16_t* O0; int ld0; int split_pn; bf16_t* O1; int ld1;
    DI void operator()(const f32x4 (&acc)[2][2][4][2], const Unit& u, int wr, int wc, int fr, int fq) const {
        bf16_t* base; int ld, ct;
        if (u.pn < split_pn) { base = O0; ld = ld0; ct = u.pn * 256; } else { base = O1; ld = ld1; ct = (u.pn - split_pn) * 256; }
        const int row0 = u.arow + wr * 64 + fr, col0 = ct + wc * 32 + 8 * fq;
#pragma unroll
        for (int ai = 0; ai < 2; ++ai)
#pragma unroll
            for (int m = 0; m < 4; ++m) { bf16_t* rowp = base + (size_t)(row0 + ai * 128 + m * 16) * ld + col0;
#pragma unroll
                for (int bj = 0; bj < 2; ++bj) { const f32x4 v0 = acc[ai][bj][m][0], v1 = acc[ai][bj][m][1];
                    u32x4 w; w.x = pk2(v0[0], v0[1]); w.y = pk2(v0[2], v0[3]); w.z = pk2(v1[0], v1[1]); w.w = pk2(v1[2], v1[3]);
                    *(u32x4*)(rowp + bj * 128) = w; } }
    }
};

struct EpiWout {
    static constexpr bool PERM = true;
    bf16_t* Y;
    DI void operator()(const f32x4 (&acc)[2][2][4][2], const Unit& u, int wr, int wc, int fr, int fq) const {
        const int row0 = u.arow + wr * 64 + fr, col0 = u.pn * 256 + wc * 32 + 8 * fq;
#pragma unroll
        for (int ai = 0; ai < 2; ++ai)
#pragma unroll
            for (int m = 0; m < 4; ++m) { bf16_t* rowp = Y + (size_t)(row0 + ai * 128 + m * 16) * 1024 + col0;
#pragma unroll
                for (int bj = 0; bj < 2; ++bj) { const f32x4 v0 = acc[ai][bj][m][0], v1 = acc[ai][bj][m][1];
                    u32x4 w; w.x = pk2(v0[0], v0[1]); w.y = pk2(v0[2], v0[3]); w.z = pk2(v1[0], v1[1]); w.w = pk2(v1[2], v1[3]);
                    *(u32x4*)(rowp + bj * 128) = w; } }
    }
};

struct EpiGlu {
    static constexpr bool PERM = true;
    const bf16_t* YG; bf16_t* YC; const float* bglu;
    DI void operator()(const f32x4 (&acc)[2][2][4][2], const Unit& u, int wr, int wc, int fr, int fq) const {
        const int row0 = u.arow + wr * 64 + fr, col0 = u.pn * 256 + wc * 32 + 8 * fq;
#pragma unroll
        for (int bj = 0; bj < 2; ++bj) { const int col = col0 + bj * 128; if (u.pn == 1 && bj == 1) continue;
            const f32x4 b0 = *(const f32x4*)(bglu + col), b1 = *(const f32x4*)(bglu + col + 4);
#pragma unroll
            for (int ai = 0; ai < 2; ++ai) { u32x4 yw[4];
#pragma unroll
                for (int m = 0; m < 4; ++m) yw[m] = *(const u32x4*)(YG + (size_t)(row0 + ai * 128 + m * 16) * 384 + col);
#pragma unroll
                for (int m = 0; m < 4; ++m) { float y[8]; unpack8(yw[m], y);
                    const f32x4 a0 = acc[ai][bj][m][0] + b0, a1 = acc[ai][bj][m][1] + b1;
                    float o[8];
#pragma unroll
                    for (int k = 0; k < 4; ++k) { o[k] = y[k] * sigmoid_f(a0[k]); o[4 + k] = y[4 + k] * sigmoid_f(a1[k]); }
                    *(u32x4*)(YC + (size_t)(row0 + ai * 128 + m * 16) * 768 + col) = pack8(o); }
                __builtin_amdgcn_sched_barrier(0); } }
    }
};

struct EpiS5S {
    static constexpr bool PERM = true;
    float* S;
    DI void operator()(const f32x4 (&acc)[2][2][4][2], const Unit& u, int wr, int wc, int fr, int fq) const {
        const int m0 = u.pn * 256 + wr * 64 + fr, col0 = wc * 32 + 8 * fq;
#pragma unroll
        for (int ai = 0; ai < 2; ++ai)
#pragma unroll
            for (int m = 0; m < 4; ++m) { const int mm = m0 + ai * 128 + m * 16; if (u.pn == 2 && (ai == 1 || wr == 1)) continue;
                float* p = S + ((size_t)u.pm * 576 + mm) * 256 + col0;
#pragma unroll
                for (int bj = 0; bj < 2; ++bj) { *(f32x4*)(p + bj * 128) = acc[ai][bj][m][0]; *(f32x4*)(p + bj * 128 + 4) = acc[ai][bj][m][1]; } }
    }
};

struct EpiS5Y {
    static constexpr bool PERM = true;
    const bf16_t* AU; bf16_t* YG; const float* dsk;
    DI void operator()(const f32x4 (&acc)[2][2][4][2], const Unit& u, int wr, int wc, int fr, int fq) const {
        const int g = u.pm / 3, j = u.pm % 3;
        const int m0 = j * 256 + wr * 64 + fr, n0 = u.pn * 256 + wc * 32 + 8 * fq;
#pragma unroll
        for (int bj = 0; bj < 2; ++bj) { const int n = n0 + bj * 128, i = n >> 4, a0 = n & 15;
            const f32x4 d0 = *(const f32x4*)(dsk + g * 16 + a0), d1 = *(const f32x4*)(dsk + g * 16 + a0 + 4);
#pragma unroll
            for (int ai = 0; ai < 2; ++ai) { if (j == 2 && (ai == 1 || wr == 1)) continue;
                u32x4 uw[4];
#pragma unroll
                for (int m = 0; m < 4; ++m) uw[m] = *(const u32x4*)(AU + ((size_t)g * 576 + m0 + ai * 128 + m * 16) * 768 + n);
#pragma unroll
                for (int m = 0; m < 4; ++m) { const int mm = m0 + ai * 128 + m * 16; float uu[8]; unpack8(uw[m], uu);
                    const f32x4 v0 = acc[ai][bj][m][0], v1 = acc[ai][bj][m][1];
                    float o[8];
#pragma unroll
                    for (int k = 0; k < 4; ++k) { o[k] = gelu_tanh_f(v0[k] + d0[k] * uu[k]); o[4 + k] = gelu_tanh_f(v1[k] + d1[k] * uu[4 + k]); }
                    *(u32x4*)(YG + (size_t)(mm * 32 + i) * 384 + g * 16 + a0) = pack8(o); }
                __builtin_amdgcn_sched_barrier(0); } }
    }
};

struct EpiUp {
    static constexpr bool PERM = true;
    bf16_t* HID;
    DI void operator()(const f32x4 (&acc)[2][2][4][2], const Unit& u, int wr, int wc, int fr, int fq) const {
        const int row0 = u.arow + wr * 64 + fr, col0 = u.pn * 128 + wc * 32 + 8 * fq;
#pragma unroll
        for (int ai = 0; ai < 2; ++ai)
#pragma unroll
            for (int m = 0; m < 4; ++m) { const f32x4 g0 = acc[ai][0][m][0], g1 = acc[ai][0][m][1], u0 = acc[ai][1][m][0], u1 = acc[ai][1][m][1];
                float o[8];
#pragma unroll
                for (int k = 0; k < 4; ++k) { o[k] = silu_f(g0[k]) * u0[k]; o[4 + k] = silu_f(g1[k]) * u1[k]; }
                *(u32x4*)(HID + (size_t)(row0 + ai * 128 + m * 16) * 1024 + col0) = pack8(o); }
    }
};

struct EpiDown {
    static constexpr bool PERM = true;
    bf16_t* YE; const float* GV;
    DI void operator()(const f32x4 (&acc)[2][2][4][2], const Unit& u, int wr, int wc, int fr, int fq) const {
        const int row0 = u.arow + wr * 64 + fr, col0 = u.pn * 256 + wc * 32 + 8 * fq;
#pragma unroll
        for (int ai = 0; ai < 2; ++ai)
#pragma unroll
            for (int m = 0; m < 4; ++m) { const int row = row0 + ai * 128 + m * 16; const float gv = GV[row];
#pragma unroll
                for (int bj = 0; bj < 2; ++bj) { const f32x4 v0 = acc[ai][bj][m][0] * gv, v1 = acc[ai][bj][m][1] * gv;
                    u32x4 w; w.x = pk2(v0[0], v0[1]); w.y = pk2(v0[2], v0[3]); w.z = pk2(v1[0], v1[1]); w.w = pk2(v1[2], v1[3]);
                    *(u32x4*)(YE + (size_t)row * 1024 + col0 + bj * 128) = w; } }
    }
};

DI Unit mk_unit(int arow, int brow, int pm, int pn) { Unit u; u.arow = arow; u.brow = brow; u.pm = pm; u.pn = pn; return u; }
struct RowSkipOrder {
    int nN, G, c, skipctx, keep_lo, keep_hi, nmain, total, bstep;
    DI void init(int N, int G_, int c_, int skipctx_, int keep_lo_, int keep_hi_, int bstep_ = 256) { bstep = bstep_; nN = N / bstep_; G = G_; c = c_; skipctx = skipctx_; keep_lo = keep_lo_; keep_hi = keep_hi_;
        nmain = (skipctx ? 64 : 72) * nN; total = nmain + (skipctx ? 8 * (keep_hi - keep_lo) : 0); }
    DI Unit next(int i) const {
        const int L0 = i * G + c; if (L0 >= total) return mk_unit(-1, 0, 0, 0);
        const int q = total / 8, r = total % 8, xcd = L0 % 8, off = L0 / 8;
        const int L = (xcd < r ? xcd * (q + 1) : r * (q + 1) + (xcd - r) * q) + off;
        const int nig = 8 * nN, gid = L / nig, rr = L % nig, lt = gid * 8 + (rr % 8);
        const int pm_main = skipctx ? ((lt / 8) * 9 + 1 + (lt % 8)) : lt, pn_main = rr / 8;
        const int Lc = L - nmain, pm_ctx = (Lc % 8) * 9, pn_ctx = keep_lo + Lc / 8;
        const bool main = L < nmain;
        const int pm = main ? pm_main : pm_ctx, pn = main ? pn_main : pn_ctx;
        return mk_unit(pm * 256, pn * bstep, pm, pn);
    }
};
DI int xcd_remap(int L0, int total) { const int q = total / 8, r = total % 8, xcd = L0 % 8, off = L0 / 8; return (xcd < r ? xcd * (q + 1) : r * (q + 1) + (xcd - r) * q) + off; }
struct MergeOrder {
    int G, c, skipctx, total;
    DI void init(int G_, int c_, int skipctx_) { G = G_; c = c_; skipctx = skipctx_; total = (skipctx ? 64 : 72) * 8; }
    DI Unit next(int i) const {
        const int L0 = i * G + c; if (L0 >= total) return mk_unit(-1, 0, 0, 0);
        const int L = xcd_remap(L0, total), lt = L >> 3, pn = L & 7, pm = skipctx ? ((lt / 8) * 9 + 1 + (lt % 8)) : lt;
        return mk_unit(pm * 256, pn * 128, pm, pn);
    }
};
struct OrderS5S { int G, c; DI Unit next(int i) const { const int L = i * G + c; if (L >= 72) return mk_unit(-1, 0, 0, 0); const int g = L / 3, j = L % 3; return mk_unit(g * 576 + j * 256, g * 256, g, j); } };
struct OrderS5Y { int G, c; DI Unit next(int i) const { const int L = i * G + c; if (L >= 144) return mk_unit(-1, 0, 0, 0); const int g = L / 6, r = L % 6, j = r >> 1, nh = r & 1;
    return mk_unit(g * 576 + j * 256, g * 512 + nh * 256, g * 3 + j, nh); } };
struct OrderUp { int G, c, nJ; DI Unit next(int i) const { const int L0 = i * G + c, total = 16 * nJ * 8; if (L0 >= total) return mk_unit(-1, 0, 0, 0); const int L = xcd_remap(L0, total), n = L & 7, t = L >> 3, jt = t % nJ, e = t / nJ;
    return mk_unit(e * EROWS + jt * 256, e * 2048 + n * 256, e, n); } };
struct OrderDown { int G, c, nJ; DI Unit next(int i) const { const int L0 = i * G + c, total = 16 * nJ * 4; if (L0 >= total) return mk_unit(-1, 0, 0, 0); const int L = xcd_remap(L0, total), n = L & 3, t = L >> 2, jt = t % nJ, e = t / nJ;
    return mk_unit(e * EROWS + jt * 256, e * 1024 + n * 256, e, n); } };

struct Frame {
    LAS unsigned char* lds;
    int tid, lane, wave, G, vcu, gw, NGW;
};

template <class DstRow>
DI void tr_item(const float* __restrict__ W, int ldw, int nvalid, int nstore, int K, bf16_t* __restrict__ WT, int k0, int n0, const DstRow& drow, const float* __restrict__ kscale, LAS float* scr  , int lane, int kofs = 0) {
    const int c4 = (lane & 15) * 4, r0 = lane >> 4;
    f32x4 v[16];
#pragma unroll
    for (int i = 0; i < 16; ++i) { const int kk = 4 * i + r0; v[i] = (n0 + c4 < nvalid) ? *(const f32x4*)(W + (size_t)(k0 + kk) * ldw + n0 + c4) : (f32x4){0.f, 0.f, 0.f, 0.f}; }
#pragma unroll
    for (int i = 0; i < 16; ++i) { const int kk = 4 * i + r0; f32x4 x = v[i]; if (kscale) x = x * kscale[k0 + kk];
        LAS float* d = scr + kk * 65 + c4; d[0] = x[0]; d[1] = x[1]; d[2] = x[2]; d[3] = x[3]; }
    LDS_WAIT(); asm volatile("" ::: "memory");
    const int c = lane & 7;
#pragma unroll
    for (int j = 0; j < 8; ++j) { const int n = (lane >> 3) + 8 * j; const LAS float* s = scr + (8 * c) * 65 + n;
        u32x4 o; o.x = pk2(s[0 * 65], s[1 * 65]); o.y = pk2(s[2 * 65], s[3 * 65]); o.z = pk2(s[4 * 65], s[5 * 65]); o.w = pk2(s[6 * 65], s[7 * 65]);
        if (n0 + n < nstore) *(u32x4*)(WT + (size_t)drow(n0 + n) * K + kofs + k0 + 8 * c) = o; }
    LDS_WAIT(); asm volatile("" ::: "memory");
}
struct DrIdent { int off; DI int operator()(int n) const { return off + n; } };
struct DrWin { DI int operator()(int n) const { return n < C_G ? n : n + (PA_W - C_G); } };
struct DrGU { int base; DI int operator()(int f) const { return base + (f >> 7) * 256 + (f & 127); } };

struct LayerIn {
    const float *w_in, *q_norm_g, *k_norm_g, *ssd_conv_w, *ssd_conv_b, *ssd_dt_bias, *ssd_a_log, *ssd_d, *ssd_norm_g;
    const float *s5_lre, *s5_lim, *s5_lstep, *s5_bre, *s5_bim, *s5_cre, *s5_cim, *s5_d, *s5_wglu, *s5_bglu, *sc_conv_w;
    const float *w_br_attn, *w_br_ssd, *w_br_s5, *w_br_sc, *w_out, *w_router, *w_gate, *w_up, *w_down, *norm_mix_g, *norm_ffn_g;
};

DI void prep_small_weights(const Frame& F, const LayerIn& P, unsigned char* ws, int part = 0, int first_wg = 0) {
    if ((int)blockIdx.x < first_wg) return;
    LAS float* scr = (LAS float*)(F.lds + F.wave * 16896);
    bf16_t* WIN = (bf16_t*)(ws + W_WIN);
    constexpr int NB_WIN = (NIN + 63) / 64;
    constexpr int I_WIN = 16 * NB_WIN, I_PAD = 62, I_BA = 8 * 16, I_BB = 8 * 16, I_BC = 6 * 16, I_BD = 6 * 16, I_OUT = 16 * 16, I_GLU = 6 * 8;
    constexpr int NIT = I_WIN + I_PAD + I_BA + I_BB + I_BC + I_BD + I_OUT + I_GLU;
    for (int it = ((int)blockIdx.x - first_wg) * NWAVES + F.wave; it < NIT; it += (F.G - first_wg) * NWAVES) {
        int r = it;
        { const bool is_out = (it >= NIT - I_GLU - I_OUT) && (it < NIT - I_GLU); if ((part == 1 && is_out) || (part == 2 && !is_out)) continue; }
        if (r < I_WIN) { const int kb = r / NB_WIN, nb = r % NB_WIN; tr_item(P.w_in, NIN, NIN, NIN, 1024, WIN, kb * 64, nb * 64, DrWin{}, nullptr, scr, F.lane); continue; } r -= I_WIN;
        if (r < I_PAD) {
#pragma unroll
            for (int j = 0; j < 8; ++j) { const int idx = j * 64 + F.lane, row = C_G + r * 4 + (idx >> 7), ch = idx & 127; *(u32x4*)(WIN + (size_t)row * 1024 + ch * 8) = (u32x4){0u, 0u, 0u, 0u}; }
            continue; } r -= I_PAD;
        if (r < I_BA) { tr_item(P.w_br_attn, 1024, 1024, 1024, 1792, (bf16_t*)(ws + W_BR4), (r / 16) * 64, (r % 16) * 64, DrIdent{0}, nullptr, scr, F.lane, 0); continue; } r -= I_BA;
        if (r < I_BB) { tr_item(P.w_br_ssd, 1024, 1024, 1024, 1792, (bf16_t*)(ws + W_BR4), (r / 16) * 64, (r % 16) * 64, DrIdent{0}, P.ssd_norm_g, scr, F.lane, 512); continue; } r -= I_BB;
        if (r < I_BC) { tr_item(P.w_br_s5, 1024, 1024, 1024, 1792, (bf16_t*)(ws + W_BR4), (r / 16) * 64, (r % 16) * 64, DrIdent{0}, nullptr, scr, F.lane, 1024); continue; } r -= I_BC;
        if (r < I_BD) { tr_item(P.w_br_sc, 1024, 1024, 1024, 1792, (bf16_t*)(ws + W_BR4), (r / 16) * 64, (r % 16) * 64, DrIdent{0}, nullptr, scr, F.lane, 1408); continue; } r -= I_BD;
        if (r < I_OUT) { tr_item(P.w_out, 1024, 1024, 1024, 1024, (bf16_t*)(ws + W_OUT), (r / 16) * 64, (r % 16) * 64, DrIdent{0}, nullptr, scr, F.lane); continue; } r -= I_OUT;
        tr_item(P.s5_wglu, 384, 384, 512, 384, (bf16_t*)(ws + W_GLU), (r / 8) * 64, (r % 8) * 64, DrIdent{0}, nullptr, scr, F.lane);
    }
}
DI void prep_expert_weights(const Frame& F, const LayerIn& P, unsigned char* ws, int first_wg, int item_lo, int item_hi, bf16_t* wgu = nullptr) {
    if ((int)blockIdx.x < first_wg) return;
    LAS float* scr = (LAS float*)(F.lds + F.wave * 16896);
    if (!wgu) wgu = (bf16_t*)(ws + WS_WGU);
    constexpr int PER = 16 * 16;
    for (int it = item_lo + ((int)blockIdx.x - first_wg) * NWAVES + F.wave; it < item_hi; it += (F.G - first_wg) * NWAVES) {
        const int which = it / (16 * PER), r = it % (16 * PER), e = r / PER, q = r % PER, k0 = (q / 16) * 64, n0 = (q % 16) * 64;
        if (which == 0) tr_item(P.w_gate + (size_t)e * 1024 * 1024, 1024, 1024, 1024, 1024, wgu, k0, n0, DrGU{e * 2048}, nullptr, scr, F.lane);
        else if (which == 1) tr_item(P.w_up + (size_t)e * 1024 * 1024, 1024, 1024, 1024, 1024, wgu, k0, n0, DrGU{e * 2048 + 128}, nullptr, scr, F.lane);
        else tr_item(P.w_down + (size_t)e * 1024 * 1024, 1024, 1024, 1024, 1024, (bf16_t*)(ws + WS_WD), k0, n0, DrIdent{e * 1024}, nullptr, scr, F.lane);
    }
}
constexpr int EXPERT_W_ITEMS = 3 * 16 * 16 * 16;

DI void prep_mod(const Frame& F, const float* __restrict__ c, const float* __restrict__ c_ctx, const float* __restrict__ w_mod, const float* __restrict__ b_mod, float* __restrict__ MOD) {
    if ((int)blockIdx.x >= 2 * 96) return;
    LAS float* sc = (LAS float*)F.lds;
    LAS float* red = sc + 9 * 1024;
    for (int o = F.tid; o < 9 * 1024; o += 512) { const float cv = (o < 8 * 1024) ? c[o] : c_ctx[o - 8 * 1024]; sc[o] = silu_f(cv); }
    __syncthreads();
    for (int it = blockIdx.x; it < 2 * 96; it += F.G) {
        const int l = it / 96, cb = it % 96, n = cb * 64 + F.lane;
        const float* W = w_mod + (size_t)l * 1024 * 6144;
        float acc[9];
#pragma unroll
        for (int r = 0; r < 9; ++r) acc[r] = 0.f;
        const int kbeg = F.wave * 128;
#pragma unroll 1
        for (int k8 = 0; k8 < 128; k8 += 16) { float w[16];
#pragma unroll
            for (int j = 0; j < 16; ++j) w[j] = W[(size_t)(kbeg + k8 + j) * 6144 + n];
#pragma unroll
            for (int j = 0; j < 16; ++j)
#pragma unroll
                for (int r = 0; r < 9; ++r) acc[r] += sc[r * 1024 + kbeg + k8 + j] * w[j]; }
#pragma unroll
        for (int r = 0; r < 9; ++r) red[(F.wave * 9 + r) * 64 + F.lane] = acc[r];
        __syncthreads();
        for (int o = F.tid; o < 9 * 64; o += 512) { const int r = o >> 6, ln = o & 63; float s = 0.f;
#pragma unroll
            for (int w = 0; w < 8; ++w) s += red[(w * 9 + r) * 64 + ln];
            MOD[((size_t)l * 9 + r) * 6144 + cb * 64 + ln] = s + b_mod[l * 6144 + cb * 64 + ln]; }
        __syncthreads();
    }
    __syncthreads();
}
DI void prep_rope(const Frame& F, float* ROPE) {
    for (int idx = blockIdx.x * 512 + F.tid; idx < 2048 * 32; idx += F.G * 512) {
        const int t = idx >> 5, j = idx & 31, i = j & 15;
        const float inv = powf(10000.f, -(float)(2 * i) / 32.f);
        const float pos = (j < 16) ? (float)(t >> 6) : (float)(t & 63);
        const float a = pos * inv;
        ROPE[t * 64 + j] = cosf(a); ROPE[t * 64 + 32 + j] = sinf(a);
    }
}

DI void prep_s5(const Frame& F, const LayerIn& P, unsigned char* ws, int wg_off = 0) {
    const int wgi = (int)blockIdx.x - wg_off;
    if (wgi < 0 || wgi >= 96) return;
    LAS float* pw = (LAS float*)F.lds;
    LAS float* bb = pw + 8448;
    LAS float* Kt = bb + 4096;
    LAS float* cc = Kt + 16896;
    LAS float* prm = cc + 2048;
    for (int it = wgi; it < 96; it += F.G) {
        const int g = it >> 2, qt = it & 3;
        for (int o = F.tid; o < 2048; o += 512) cc[o] = (o < 1024) ? P.s5_cre[(size_t)g * 1024 + o] : P.s5_cim[(size_t)g * 1024 + o - 1024];
        for (int o = F.tid; o < 2048; o += 512) prm[264 + o] = (o < 1024) ? P.s5_bre[(size_t)g * 1024 + o] : P.s5_bim[(size_t)g * 1024 + o - 1024];
        if (F.tid < 256) { const int d = (F.tid >> 6) & 1, p = F.tid & 63; prm[F.tid] = (F.tid < 128) ? P.s5_lre[(d * 24 + g) * 64 + p] : P.s5_lim[(d * 24 + g) * 64 + p]; }
        if (F.tid < 2) prm[256 + F.tid] = __expf(P.s5_lstep[F.tid * 24 + g]);
        __syncthreads();
        if (F.tid < 128) { const int d = F.tid >> 6, p = F.tid & 63;
            const float step = prm[256 + d], lr = prm[d * 64 + p], li = prm[128 + d * 64 + p];
            const float th = li * step, sh = sinf(0.5f * th);
            const float mag = expf(lr * step), abi = mag * sinf(th);
            const float nr = expm1f(lr * step) - 2.f * mag * sh * sh, ni = abi;
            const float den = lr * lr + li * li;
            const float cr = (nr * lr + ni * li) / den, ci = (ni * lr - nr * li) / den;
#pragma unroll
            for (int j = 0; j < 16; ++j) { const float br = prm[264 + p * 16 + j], bi = prm[264 + 1024 + p * 16 + j];
                bb[((d * 64 + p) * 16 + j) * 2 + 0] = cr * br - ci * bi; bb[((d * 64 + p) * 16 + j) * 2 + 1] = cr * bi + ci * br; } }
        for (int o = F.tid; o < 2 * 64 * 33; o += 512) { const int dp = o / 33, tau = o % 33, d = dp >> 6, p = dp & 63;
            const float step = prm[256 + d], lr = prm[d * 64 + p], li = prm[128 + d * 64 + p];
            const float m = expf(lr * step * (float)tau), a = li * step * (float)tau;
            pw[o * 2 + 0] = m * cosf(a); pw[o * 2 + 1] = m * sinf(a); }
        __syncthreads();
        for (int o = F.tid; o < 1024; o += 512) { const int d = o >> 9, a = (o >> 5) & 15, tau = o & 31; float s[16];
#pragma unroll
            for (int b_ = 0; b_ < 16; ++b_) s[b_] = 0.f;
            for (int p = 0; p < 64; ++p) { const float cre = cc[a * 64 + p], cim = cc[1024 + a * 64 + p];
                const f32x2 lp = *(const LAS f32x2*)(pw + ((d * 64 + p) * 33 + tau) * 2);
                const float wr_ = cre * lp[0] - cim * lp[1], wi_ = cre * lp[1] + cim * lp[0];
                const LAS f32x4* bp = (const LAS f32x4*)(bb + (d * 64 + p) * 32);
#pragma unroll
                for (int q4 = 0; q4 < 8; ++q4) { const f32x4 t = bp[q4]; s[2 * q4] += wr_ * t[0] - wi_ * t[1]; s[2 * q4 + 1] += wr_ * t[2] - wi_ * t[3]; } }
#pragma unroll
            for (int b_ = 0; b_ < 16; ++b_) Kt[((d * 16 + a) * 16 + b_) * 33 + tau] = s[b_]; }
        __syncthreads();
        bf16_t* TQ = (bf16_t*)(ws + W_TQ) + (size_t)g * 512 * 768;
        for (int o = F.tid; o < 128 * 64; o += 512) { const int row = qt * 128 + (o >> 6), ch = o & 63, i = row >> 4, a = row & 15, b0 = (ch >> 5) * 8, j = ch & 31; float v[8];
#pragma unroll
            for (int k = 0; k < 8; ++k) { float s_ = 0.f;
                if (j <= i) s_ += Kt[((0 * 16 + a) * 16 + b0 + k) * 33 + (i - j)];
                if (j >= i) s_ += Kt[((1 * 16 + a) * 16 + b0 + k) * 33 + (j - i)];
                v[k] = s_; }
            *(u32x4*)(TQ + (size_t)row * 768 + j * 16 + b0) = pack8(v); }
        for (int o = F.tid; o < 128 * 128; o += 512) { const int row = qt * 128 + (o >> 7), dp = o & 127, d = dp >> 6, p = dp & 63, i = row >> 4, a = row & 15; const int tau = d == 0 ? (i + 1) : (32 - i);
            const float cre = cc[a * 64 + p], cim = cc[1024 + a * 64 + p];
            const f32x2 lp = *(const LAS f32x2*)(pw + ((d * 64 + p) * 33 + tau) * 2);
            TQ[(size_t)row * 768 + 512 + d * 128 + p] = (bf16_t)f2bf(cre * lp[0] - cim * lp[1]);
            TQ[(size_t)row * 768 + 512 + d * 128 + 64 + p] = (bf16_t)f2bf(-(cre * lp[1] + cim * lp[0])); }
        bf16_t* PP = (bf16_t*)(ws + W_P) + (size_t)g * 256 * 512;
        for (int o = F.tid; o < 2 * 16 * 32; o += 512) { const int d = o >> 9, p = qt * 16 + ((o >> 5) & 15), j = o & 31; const int tau = d == 0 ? (31 - j) : j;
            const f32x2 lp = *(const LAS f32x2*)(pw + ((d * 64 + p) * 33 + tau) * 2);
            const LAS f32x4* bp = (const LAS f32x4*)(bb + (d * 64 + p) * 32);
            float vr[16], vi[16];
#pragma unroll
            for (int q4 = 0; q4 < 8; ++q4) { const f32x4 t = bp[q4];
                vr[2 * q4] = lp[0] * t[0] - lp[1] * t[1]; vi[2 * q4] = lp[0] * t[1] + lp[1] * t[0];
                vr[2 * q4 + 1] = lp[0] * t[2] - lp[1] * t[3]; vi[2 * q4 + 1] = lp[0] * t[3] + lp[1] * t[2]; }
            float h0[8], h1[8];
#pragma unroll
            for (int k = 0; k < 8; ++k) { h0[k] = vr[k]; h1[k] = vr[8 + k]; }
            bf16_t* pr = PP + (size_t)(d * 128 + p) * 512 + j * 16;
            *(u32x4*)pr = pack8(h0); *(u32x4*)(pr + 8) = pack8(h1);
#pragma unroll
            for (int k = 0; k < 8; ++k) { h0[k] = vi[k]; h1[k] = vi[8 + k]; }
            bf16_t* pi = PP + (size_t)(d * 128 + 64 + p) * 512 + j * 16;
            *(u32x4*)pi = pack8(h0); *(u32x4*)(pi + 8) = pack8(h1); }
        __syncthreads();
    }
}

struct RowCtx { int R, b, p, isctx, mrow; };
DI RowCtx row_ctx(int R) { RowCtx r; r.R = R; r.b = R / PB; r.p = R - r.b * PB; r.isctx = r.p < CTXL; r.mrow = r.isctx ? 8 : r.b; return r; }

DI void moe_combine(const Frame& F, const RowCtx& rc, f32x4 (&x)[4], const int* INV, const bf16_t* YE, const float* mod_prev  ) {
    const int myinv = (F.lane < 16) ? INV[(size_t)rc.R * 16 + F.lane] : -1;
    f32x4 s[4];
#pragma unroll
    for (int j = 0; j < 4; ++j) s[j] = (f32x4){0.f, 0.f, 0.f, 0.f};
    for (int e = 0; e < 16; ++e) { const int er = __shfl(myinv, e);
        if (er >= 0) { const bf16_t* yr = YE + (size_t)er * 1024 + 4 * F.lane;
#pragma unroll
            for (int j = 0; j < 4; ++j) { const u32x2 w = *(const u32x2*)(yr + j * 256); s[j][0] += bflo(w.x); s[j][1] += bfhi(w.x); s[j][2] += bflo(w.y); s[j][3] += bfhi(w.y); } } }
    const float* g5 = mod_prev + (size_t)rc.mrow * 6144 + 5 * 1024 + 4 * F.lane;
#pragma unroll
    for (int j = 0; j < 4; ++j) x[j] += *(const f32x4*)(g5 + j * 256) * s[j];
}
DI void add_mixer(const Frame& F, const RowCtx& rc, f32x4 (&x)[4], const bf16_t* __restrict__ Y, const float* modl  ) {
    const float* g2 = modl + (size_t)rc.mrow * 6144 + 2 * 1024 + 4 * F.lane;
    const bf16_t* yr = Y + (size_t)rc.R * 1024 + 4 * F.lane;
#pragma unroll
    for (int j = 0; j < 4; ++j) { const u32x2 w = *(const u32x2*)(yr + j * 256); const f32x4 g = *(const f32x4*)(g2 + j * 256);
        x[j][0] += g[0] * bflo(w.x); x[j][1] += g[1] * bfhi(w.x); x[j][2] += g[2] * bflo(w.y); x[j][3] += g[3] * bfhi(w.y); }
}
DI float row_rstd(const f32x4 (&x)[4]) {
    float ss = 0.f;
#pragma unroll
    for (int j = 0; j < 4; ++j) ss += (x[j][0] * x[j][0] + x[j][1] * x[j][1]) + (x[j][2] * x[j][2] + x[j][3] * x[j][3]);
    return 1.0f / sqrtf(wave_sum(ss) * (1.f / 1024.f) + RMS_EPS);
}
DI void row_modulate(const Frame& F, const f32x4 (&x)[4], float rstd, const float* g, const float* shift, const float* scale, f32x4 (&h)[4]) {
#pragma unroll
    for (int j = 0; j < 4; ++j) { const int c = j * 256 + 4 * F.lane; const f32x4 gv = *(const f32x4*)(g + c), sh = *(const f32x4*)(shift + c), sc = *(const f32x4*)(scale + c);
        h[j] = x[j] * rstd * gv * (sc + 1.0f) + sh; }
}
DI void row_store_bf16(const Frame& F, const f32x4 (&h)[4], bf16_t* dst) {
#pragma unroll
    for (int j = 0; j < 4; ++j) { u32x2 w; w.x = pk2(h[j][0], h[j][1]); w.y = pk2(h[j][2], h[j][3]); *(u32x2*)(dst + j * 256 + 4 * F.lane) = w; }
}

DI void phase_norm1(const Frame& F, int layer, const float* x_in, const float* ctx_in, float* X, bf16_t* H1, const float* MOD, const float* gmix, const int* INV, const bf16_t* YE, const bf16_t* Y) {
    const float* modl = MOD + (size_t)layer * 9 * 6144;
    for (int R = F.gw; R < MROWS; R += F.NGW) {
        const RowCtx rc = row_ctx(R);
        const float* src = rc.isctx ? ctx_in + ((size_t)rc.b * CTXL + rc.p) * 1024 : x_in + ((size_t)rc.b * SEQ + (rc.p - CTXL)) * 1024;
        f32x4 x[4];
#pragma unroll
        for (int j = 0; j < 4; ++j) x[j] = *(const f32x4*)(src + j * 256 + 4 * F.lane);
        if (layer > 0) { add_mixer(F, rc, x, Y, MOD + (size_t)(layer - 1) * 9 * 6144); moe_combine(F, rc, x, INV, YE, MOD + (size_t)(layer - 1) * 9 * 6144); }
        if (layer > 0) {
#pragma unroll
            for (int j = 0; j < 4; ++j) *(f32x4*)(X + (size_t)R * 1024 + j * 256 + 4 * F.lane) = x[j]; }
        const float rstd = row_rstd(x);
        f32x4 h[4]; row_modulate(F, x, rstd, gmix, modl + (size_t)rc.mrow * 6144, modl + (size_t)rc.mrow * 6144 + 1024, h);
        row_store_bf16(F, h, H1 + (size_t)R * 1024);
    }
}
DI void phase_final(const Frame& F, const float* X, float* out, const float* MOD, const float* gfin, const int* INV, const bf16_t* YE, const bf16_t* Y) {
    for (int q = F.gw; q < NB * SEQ; q += F.NGW) {
        const int b = q / SEQ, t = q - b * SEQ, R = b * PB + CTXL + t;
        const RowCtx rc = row_ctx(R);
        f32x4 x[4];
#pragma unroll
        for (int j = 0; j < 4; ++j) x[j] = *(const f32x4*)(X + (size_t)R * 1024 + j * 256 + 4 * F.lane);
        add_mixer(F, rc, x, Y, MOD + (size_t)1 * 9 * 6144);
        moe_combine(F, rc, x, INV, YE, MOD + (size_t)1 * 9 * 6144);
        const float rstd = row_rstd(x);
#pragma unroll
        for (int j = 0; j < 4; ++j) { const int c = j * 256 + 4 * F.lane; *(f32x4*)(out + (size_t)q * 1024 + c) = x[j] * rstd * *(const f32x4*)(gfin + c); }
    }
}

DI void phase_norm2(const Frame& F, int layer, bool skipctx, const float* x_in, const float* ctx_in, const float* X, const bf16_t* Y, bf16_t* H2, const float* MOD, const float* gffn, const float* w_router, float* AFF) {
    LAS float* wl = (LAS float*)F.lds;
    for (int idx = F.tid; idx < 16384; idx += 512) wl[(idx & 15) * 1024 + (idx >> 4)] = w_router[idx];
    __syncthreads();
    const float* modl = MOD + (size_t)layer * 9 * 6144;
    for (int R = F.gw; R < MROWS; R += F.NGW) {
        const RowCtx rc = row_ctx(R);
        if (skipctx && rc.isctx) continue;
        const float* src = (layer > 0) ? X + (size_t)R * 1024 : (rc.isctx ? ctx_in + ((size_t)rc.b * CTXL + rc.p) * 1024 : x_in + ((size_t)rc.b * SEQ + (rc.p - CTXL)) * 1024);
        f32x4 x[4];
#pragma unroll
        for (int j = 0; j < 4; ++j) x[j] = *(const f32x4*)(src + j * 256 + 4 * F.lane);
        add_mixer(F, rc, x, Y, modl);
        const float rstd = row_rstd(x);
        f32x4 h[4]; row_modulate(F, x, rstd, gffn, modl + (size_t)rc.mrow * 6144 + 3 * 1024, modl + (size_t)rc.mrow * 6144 + 4 * 1024, h);
        row_store_bf16(F, h, H2 + (size_t)R * 1024);
        float lg[16];
#pragma unroll
        for (int e = 0; e < 16; ++e) { float s = 0.f;
#pragma unroll
            for (int j = 0; j < 4; ++j) { const f32x4 w = *(const LAS f32x4*)(wl + e * 1024 + j * 256 + 4 * F.lane); s += (h[j][0] * w[0] + h[j][1] * w[1]) + (h[j][2] * w[2] + h[j][3] * w[3]); }
            lg[e] = wave_sum(s); }
        float mx = lg[0];
#pragma unroll
        for (int e = 1; e < 16; ++e) mx = fmaxf(mx, lg[e]);
        float den = 0.f, mine = 0.f;
#pragma unroll
        for (int e = 0; e < 16; ++e) { const float ex = expf(lg[e] - mx); den += ex; mine = (F.lane == e) ? ex : mine; }
        if (F.lane < 16) AFF[((size_t)rc.b * 16 + F.lane) * PB + rc.p] = mine / den;
    }
    __syncthreads();
}

DI int block_exscan(const Frame& F, int v, LAS int* wtot, int& total) {
    int incl = v;
#pragma unroll
    for (int o = 1; o < 64; o <<= 1) { const int t = __shfl_up(incl, o); if (F.lane >= o) incl += t; }
    if (F.lane == 63) wtot[F.wave] = incl;
    __syncthreads();
    int base = 0; total = 0;
#pragma unroll
    for (int w = 0; w < 8; ++w) { const int x = wtot[w]; if (w < F.wave) base += x; total += x; }
    __syncthreads();
    return base + incl - v;
}
DI void phase_topk(const Frame& F, int nitems, const float* AFF, int* SRC, float* GV, int* INV) {
    LAS int* wcnt = (LAS int*)F.lds;
    LAS int* wtot = wcnt + 16;
    for (int it = blockIdx.x; it < nitems; it += F.G) {
        const int isctx = it >= 128, be = it & 127, b = be >> 4, e = be & 15;
        const int n = isctx ? CTXL : SEQ, cap = isctx ? 32 : 256, p0 = isctx ? 0 : CTXL;
        const float* a = AFF + ((size_t)b * 16 + e) * PB + p0;
        unsigned v[4]; float av[4];
#pragma unroll
        for (int k = 0; k < 4; ++k) { const int idx = 4 * F.tid + k; av[k] = idx < n ? a[idx] : 0.f; v[k] = __builtin_bit_cast(unsigned, av[k]); }
        unsigned prefix = 0u;
        for (int bit = 30; bit >= 0; --bit) {
            const unsigned cand = prefix | (1u << bit);
            int c = 0;
#pragma unroll
            for (int k = 0; k < 4; ++k) c += __popcll(__ballot(v[k] >= cand));
            LAS int* wc = wcnt + (bit & 1) * 8;
            if (F.lane == 0) wc[F.wave] = c;
            __syncthreads();
            int tot = 0;
#pragma unroll
            for (int w = 0; w < 8; ++w) tot += wc[w];
            if (tot >= cap) prefix = cand;
        }
        __syncthreads();
        int ngt_t = 0, neq_t = 0;
#pragma unroll
        for (int k = 0; k < 4; ++k) { ngt_t += (v[k] > prefix) ? 1 : 0; neq_t += (v[k] == prefix) ? 1 : 0; }
        int ngt_total, neq_total;
        (void)block_exscan(F, ngt_t, wtot, ngt_total);
        int eq_rank = block_exscan(F, neq_t, wtot, neq_total);
        const int eq_take = cap - ngt_total;
        int sel[4], nsel_t = 0;
#pragma unroll
        for (int k = 0; k < 4; ++k) { int s = 0; if (v[k] > prefix) s = 1; else if (v[k] == prefix) { s = (eq_rank < eq_take) ? 1 : 0; ++eq_rank; } sel[k] = s; nsel_t += s; }
        int nsel_total;
        int slot = block_exscan(F, nsel_t, wtot, nsel_total);
        const int ebase = e * EROWS + (isctx ? 2048 + b * 32 : b * 256);
#pragma unroll
        for (int k = 0; k < 4; ++k) { const int idx = 4 * F.tid + k;
            if (idx < n) { const int R = b * PB + p0 + idx;
                if (sel[k]) { const int er = ebase + slot; ++slot; SRC[er] = R; GV[er] = av[k]; INV[(size_t)R * 16 + e] = er; }
                else INV[(size_t)R * 16 + e] = -1; } }
        __syncthreads();
    }
}
DI void phase_gather(const Frame& F, int rows_per_expert, const int* __restrict__ SRC, const bf16_t* __restrict__ H2, bf16_t* __restrict__ XG) {
    const int total = 16 * rows_per_expert;
    for (int q = F.gw * 4; q < total; q += F.NGW * 4) {
        const int e = q / rows_per_expert, s = q - e * rows_per_expert, er = e * EROWS + s;
        int R[4];
#pragma unroll
        for (int u = 0; u < 4; ++u) R[u] = SRC[er + u];
        u32x4 v0[4], v1[4];
#pragma unroll
        for (int u = 0; u < 4; ++u) { v0[u] = *(const u32x4*)(H2 + (size_t)R[u] * 1024 + 8 * F.lane); v1[u] = *(const u32x4*)(H2 + (size_t)R[u] * 1024 + 512 + 8 * F.lane); }
#pragma unroll
        for (int u = 0; u < 4; ++u) { *(u32x4*)(XG + (size_t)(er + u) * 1024 + 8 * F.lane) = v0[u]; *(u32x4*)(XG + (size_t)(er + u) * 1024 + 512 + 8 * F.lane) = v1[u]; }
    }
}

DI void qk_norm_rope(const float (&vin)[8], int ll, const float* __restrict__ gn, bool rope, const float* __restrict__ cs, float (&o)[8]) {
    float v[8]; float ss = 0.f;
#pragma unroll
    for (int k = 0; k < 8; ++k) ss += vin[k] * vin[k];
    ss += __shfl_xor(ss, 1); ss += __shfl_xor(ss, 2); ss += __shfl_xor(ss, 4);
    const float rstd = 1.0f / sqrtf(ss * (1.f / 64.f) + RMS_EPS);
#pragma unroll
    for (int k = 0; k < 8; ++k) v[k] = vin[k] * rstd * gn[k];
    const bool isx2 = (ll & 2) != 0;
#pragma unroll
    for (int k = 0; k < 8; ++k) { const float pv = __shfl_xor(v[k], 2); const float c = rope ? cs[k] : 1.f, s = rope ? cs[32 + k] : 0.f; o[k] = isx2 ? (v[k] * c + pv * s) : (v[k] * c - pv * s); }
}
DI void phase_elem(const Frame& F, const LayerIn& P, const bf16_t* __restrict__ PA, const float* __restrict__ ROPE, bf16_t* __restrict__ QN, bf16_t* __restrict__ KN, bf16_t* __restrict__ XBC,
                   float* __restrict__ DT, bf16_t* __restrict__ AU, bf16_t* __restrict__ YCD) {
    const int l = F.lane;
    for (int R0 = F.gw * 4; R0 < MROWS; R0 += F.NGW * 4) {
        const RowCtx rc = row_ctx(R0);
        const bf16_t* pr = PA + (size_t)R0 * PA_W;
        const bool has_prev = (rc.p != 0) && (rc.p != CTXL), has_next = (rc.p + 3 != CTXL - 1) && (rc.p + 3 != PB - 1);
        const bool rope = !rc.isctx; const int t0 = rope ? rc.p - CTXL : 0;
        { const int hb = (l & 7) >> 2, i0 = (l & 1) * 8; const float* gn = P.q_norm_g + (l & 7) * 8;
#pragma unroll
          for (int h2 = 0; h2 < 2; ++h2) { u32x4 w[2];
#pragma unroll
            for (int u = 0; u < 2; ++u) w[u] = *(const u32x4*)(pr + (size_t)(2 * h2 + u) * PA_W + C_Q + l * 8);
#pragma unroll
            for (int u = 0; u < 2; ++u) { float v[8], o[8]; unpack8(w[u], v);
                qk_norm_rope(v, l, gn, rope, ROPE + (size_t)(t0 + 2 * h2 + u) * 64 + hb * 16 + i0, o);
#pragma unroll
                for (int k = 0; k < 8; ++k) o[k] *= ATT_C2;
                *(u32x4*)(QN + (size_t)(R0 + 2 * h2 + u) * 512 + l * 8) = pack8(o); } } }
        { const int u = l >> 4, ll = l & 15, hb = (ll & 7) >> 2, i0 = (ll & 1) * 8;
          float v[8], o[8]; unpack8(*(const u32x4*)(pr + (size_t)u * PA_W + C_K + ll * 8), v);
          qk_norm_rope(v, ll, P.k_norm_g + (ll & 7) * 8, rope, ROPE + (size_t)(t0 + u) * 64 + hb * 16 + i0, o);
          *(u32x4*)(KN + (size_t)(R0 + u) * 128 + ll * 8) = pack8(o); }
#pragma unroll
        for (int pass = 0; pass < 2; ++pass) { const int ch8 = pass * 64 + l; if (ch8 >= 96) continue;
            const int ch = ch8 * 8; u32x4 w[6];
#pragma unroll
            for (int u = 0; u < 6; ++u) { const bool ok = (u == 0) ? has_prev : (u == 5) ? has_next : true;
                w[u] = ok ? *(const u32x4*)(pr + (ptrdiff_t)(u - 1) * PA_W + C_XBC + ch) : (u32x4){0u, 0u, 0u, 0u}; }
            float w0[8], w1[8], w2[8], bs[8];
#pragma unroll
            for (int k = 0; k < 8; ++k) { w0[k] = P.ssd_conv_w[ch + k]; w1[k] = P.ssd_conv_w[768 + ch + k]; w2[k] = P.ssd_conv_w[1536 + ch + k]; bs[k] = P.ssd_conv_b[ch + k]; }
            float a[8], b[8], c[8]; unpack8(w[0], a); unpack8(w[1], b);
#pragma unroll
            for (int u = 0; u < 4; ++u) { unpack8(w[u + 2], c); float o[8];
#pragma unroll
                for (int k = 0; k < 8; ++k) { o[k] = silu_f(w0[k] * a[k] + w1[k] * b[k] + w2[k] * c[k] + bs[k]); a[k] = b[k]; b[k] = c[k]; }
                *(u32x4*)(XBC + (size_t)(R0 + u) * 768 + ch) = pack8(o); } }
        { const int u = l >> 4, d = (l >> 3) & 1, h = l & 7; DT[((size_t)d * MROWS + R0 + u) * 8 + h] = softplus_f(bf2f(pr[(size_t)u * PA_W + C_DT + h]) + P.ssd_dt_bias[d * 8 + h]); }
        if (l < 48) {
            const int g = l >> 1, a0 = (l & 1) * 8, ch = l * 8;
            u32x4 uw[4], sb[4], sg[6], sh[6];
#pragma unroll
            for (int u = 0; u < 4; ++u) { uw[u] = *(const u32x4*)(pr + (size_t)u * PA_W + C_U + ch); sb[u] = *(const u32x4*)(pr + (size_t)u * PA_W + C_SB + ch); }
#pragma unroll
            for (int u = 0; u < 6; ++u) { const bool ok = (u == 0) ? has_prev : (u == 5) ? has_next : true;
                sg[u] = ok ? *(const u32x4*)(pr + (ptrdiff_t)(u - 1) * PA_W + C_SG + ch) : (u32x4){0u, 0u, 0u, 0u};
                sh[u] = ok ? *(const u32x4*)(pr + (ptrdiff_t)(u - 1) * PA_W + C_SH + ch) : (u32x4){0u, 0u, 0u, 0u}; }
#pragma unroll
            for (int u = 0; u < 4; ++u) *(u32x4*)(AU + ((size_t)g * 576 + ((R0 + u) >> 5)) * 768 + ((R0 + u) & 31) * 16 + a0) = uw[u];
            float w0[8], w1[8], w2[8];
#pragma unroll
            for (int k = 0; k < 8; ++k) { w0[k] = P.sc_conv_w[ch + k]; w1[k] = P.sc_conv_w[384 + ch + k]; w2[k] = P.sc_conv_w[768 + ch + k]; }
            float a[8], b[8], c[8], x[8], y[8];
            unpack8(sg[0], x); unpack8(sh[0], y);
#pragma unroll
            for (int k = 0; k < 8; ++k) a[k] = x[k] * y[k];
            unpack8(sg[1], x); unpack8(sh[1], y);
#pragma unroll
            for (int k = 0; k < 8; ++k) b[k] = x[k] * y[k];
#pragma unroll
            for (int u = 0; u < 4; ++u) { unpack8(sg[u + 2], x); unpack8(sh[u + 2], y); float s[8], o[8]; unpack8(sb[u], s);
#pragma unroll
                for (int k = 0; k < 8; ++k) { c[k] = x[k] * y[k]; o[k] = s[k] * (w0[k] * a[k] + w1[k] * b[k] + w2[k] * c[k]); a[k] = b[k]; b[k] = c[k]; }
                *(u32x4*)(YCD + (size_t)(R0 + u) * 768 + 384 + ch) = pack8(o); }
        }
    }
}

typedef short v4i16_t __attribute__((ext_vector_type(4)));
DI int img_off(int row, int chunk) { return row * 128 + ((chunk ^ (row & 7)) << 4); }
DI s16x4 tr_read4(const LAS unsigned char* p) { return __builtin_bit_cast(s16x4, __builtin_amdgcn_ds_read_tr16_b64_v4i16((LAS v4i16_t*)p)); }
DI bf16x8 cat8(s16x4 lo, s16x4 hi) { return (bf16x8){lo[0], lo[1], lo[2], lo[3], hi[0], hi[1], hi[2], hi[3]}; }
DI unsigned cvtpk(float lo, float hi) { typedef __bf16 bf2 __attribute__((ext_vector_type(2))); f32x2 v = {lo, hi}; bf2 b = __builtin_convertvector(v, bf2); return __builtin_bit_cast(unsigned, b); }
#define MFMA32(a, b, c) __builtin_amdgcn_mfma_f32_32x32x16_bf16((a), (b), (c), 0, 0, 0)
DI int crow(int r, int hh) { return (r & 3) + 8 * (r >> 2) + 4 * hh; }

constexpr int SSD_XH = 0, SSD_BM = 65536, SSD_CM = 81920, SSD_ARR = 131072;
DI void ssd_load_images(const Frame& F, const bf16_t* XBC, int R0, int g, bool with_c) {
#pragma unroll
    for (int it = 0; it < 8; ++it) { const int idx = it * 512 + F.tid, h4 = idx >> 10, row = (idx >> 3) & 127, ch = idx & 7;
        *(LAS u32x4*)(F.lds + SSD_XH + h4 * 16384 + img_off(row, ch)) = *(const u32x4*)(XBC + (size_t)(R0 + row) * 768 + g * 256 + h4 * 64 + ch * 8); }
#pragma unroll
    for (int it = 0; it < 2; ++it) { const int idx = it * 512 + F.tid, row = idx >> 3, ch = idx & 7;
        *(LAS u32x4*)(F.lds + SSD_BM + img_off(row, ch)) = *(const u32x4*)(XBC + (size_t)(R0 + row) * 768 + 512 + g * 64 + ch * 8);
        if (with_c) *(LAS u32x4*)(F.lds + SSD_CM + img_off(row, ch)) = *(const u32x4*)(XBC + (size_t)(R0 + row) * 768 + 640 + g * 64 + ch * 8); }
}
struct Series { float dt0, dt1, cs0, cs1, ecs0, ecs1, tot; };
DI Series ssd_series(const Frame& F, const float* DT, const float* a_log, int R0, int h, int d) {
    Series s; const float a = -__expf(a_log[d * 8 + h]);
    s.dt0 = DT[((size_t)d * MROWS + R0 + 2 * F.lane) * 8 + h]; s.dt1 = DT[((size_t)d * MROWS + R0 + 2 * F.lane + 1) * 8 + h];
    const float ad0 = s.dt0 * a, ad1 = s.dt1 * a, pair = ad0 + ad1; float incl = pair;
#pragma unroll
    for (int o = 1; o < 64; o <<= 1) { const float t = __shfl_up(incl, o); if (F.lane >= o) incl += t; }
    const float excl = incl - pair;
    s.cs0 = excl + ad0; s.cs1 = incl; s.ecs0 = excl; s.ecs1 = excl + ad0; s.tot = __shfl(incl, 63);
    return s;
}

DI void ssd_chunk_states(const Frame& F, const LayerIn& P, const bf16_t* XBC, const float* DT, float* S, float* TOT) {
    LAS float* W = (LAS float*)(F.lds + SSD_ARR);
    const int lane = F.lane, hh = lane >> 5, q = (lane & 15) >> 2, pp = lane & 3, blk = (lane >> 4) & 1;
    const int h4 = F.wave & 3, d = F.wave >> 2;
    for (int it = blockIdx.x; it < 288; it += F.G) {
        const int b = it / 36, r = it % 36, c = r >> 1, g = r & 1, R0 = b * PB + c * 128, h = 4 * g + h4;
        ssd_load_images(F, XBC, R0, g, false);
        const Series s = ssd_series(F, DT, P.ssd_a_log, R0, h, d);
        float w0, w1;
        if (d == 0) { w0 = s.dt0 * __expf(s.tot - s.cs0); w1 = s.dt1 * __expf(s.tot - s.cs1); } else { w0 = s.dt0 * __expf(s.ecs0); w1 = s.dt1 * __expf(s.ecs1); }
        *(LAS f32x2*)(W + F.wave * 128 + 2 * lane) = (f32x2){w0, w1};
        if (lane == 0) TOT[(((size_t)b * 18 + c) * 8 + h) * 2 + d] = s.tot;
        __syncthreads();
        f32x16 acc[2][2];
#pragma unroll
        for (int i = 0; i < 2; ++i)
#pragma unroll
            for (int j = 0; j < 2; ++j)
#pragma unroll
                for (int k = 0; k < 16; ++k) acc[i][j][k] = 0.f;
        const LAS unsigned char* xh = F.lds + SSD_XH + h4 * 16384;
        const LAS unsigned char* bm = F.lds + SSD_BM;
#pragma unroll 2
        for (int st = 0; st < 8; ++st) {
            const int row = 16 * st + 8 * hh + q;
            const f32x4 wa = *(const LAS f32x4*)(W + F.wave * 128 + 16 * st + 8 * hh), wb = *(const LAS f32x4*)(W + F.wave * 128 + 16 * st + 8 * hh + 4);
            bf16x8 af[2], bfr[2];
#pragma unroll
            for (int t = 0; t < 2; ++t) { const int chunk = t * 4 + 2 * blk + (pp >> 1), within = 8 * (pp & 1);
                af[t] = cat8(tr_read4(bm + img_off(row, chunk) + within), tr_read4(bm + img_off(row + 4, chunk) + within));
                const s16x4 lo = tr_read4(xh + img_off(row, chunk) + within), hi = tr_read4(xh + img_off(row + 4, chunk) + within);
                u32x4 pw;
                pw.x = cvtpk(bf2f((bf16_t)lo[0]) * wa[0], bf2f((bf16_t)lo[1]) * wa[1]); pw.y = cvtpk(bf2f((bf16_t)lo[2]) * wa[2], bf2f((bf16_t)lo[3]) * wa[3]);
                pw.z = cvtpk(bf2f((bf16_t)hi[0]) * wb[0], bf2f((bf16_t)hi[1]) * wb[1]); pw.w = cvtpk(bf2f((bf16_t)hi[2]) * wb[2], bf2f((bf16_t)hi[3]) * wb[3]);
                bfr[t] = __builtin_bit_cast(bf16x8, pw); }
#pragma unroll
            for (int nt = 0; nt < 2; ++nt)
#pragma unroll
                for (int pt = 0; pt < 2; ++pt) acc[nt][pt] = MFMA32(af[nt], bfr[pt], acc[nt][pt]);
        }
        float* Sb = S + ((((size_t)b * 18 + c) * 8 + h) * 2 + d) * 4096;
#pragma unroll
        for (int nt = 0; nt < 2; ++nt)
#pragma unroll
            for (int pt = 0; pt < 2; ++pt)
#pragma unroll
                for (int q4 = 0; q4 < 4; ++q4) { const int p = pt * 32 + (lane & 31), n0 = nt * 32 + 8 * q4 + 4 * hh;
                    *(f32x4*)(Sb + p * 64 + n0) = (f32x4){acc[nt][pt][4 * q4], acc[nt][pt][4 * q4 + 1], acc[nt][pt][4 * q4 + 2], acc[nt][pt][4 * q4 + 3]}; }
        __syncthreads();
    }
}

DI void ssd_recurrence(const Frame& F, const float* __restrict__ S, const float* __restrict__ TOT, bf16_t* __restrict__ HIN) {
    for (int gi = blockIdx.x * 512 + F.tid; gi < 128 * 1024; gi += F.G * 512) {
        const int bhd = gi >> 10, e4 = (gi & 1023) * 4, b = bhd >> 4, h = (bhd >> 1) & 7, d = bhd & 1;
        f32x4 sv[18]; float dec[18];
#pragma unroll
        for (int k = 0; k < 18; ++k) { const int c = (d == 0) ? k : (k < 2 ? 1 - k : 19 - k);
            const size_t st = (((size_t)b * 18 + c) * 8 + h) * 2 + d;
            sv[k] = *(const f32x4*)(S + st * 4096 + e4); dec[k] = TOT[st]; }
        float z0 = 0.f; asm volatile("" : "+v"(z0));
        f32x4 H = (f32x4){z0, z0, z0, z0};
#pragma unroll
        for (int k = 0; k < 18; ++k) { const int c = (d == 0) ? k : (k < 2 ? 1 - k : 19 - k);
            const size_t st = (((size_t)b * 18 + c) * 8 + h) * 2 + d;
            u32x2 w; w.x = pk2(H[0], H[1]); w.y = pk2(H[2], H[3]);
            *(u32x2*)(HIN + st * 4096 + e4) = w;
            H = H * __expf(dec[k]) + sv[k]; }
    }
}

DI void ssd_output(const Frame& F, const LayerIn& P, const bf16_t* XBC, const bf16_t* PA, const float* DT, const bf16_t* HIN, bf16_t* YB, float* SSQ, bool skipctx) {
    LAS float* ARR = (LAS float*)(F.lds + SSD_ARR);
    const int lane = F.lane, hh = lane >> 5, q = (lane & 15) >> 2, pp = lane & 3, blk = (lane >> 4) & 1, l31 = lane & 31;
    for (int it = blockIdx.x; it < 288; it += F.G) {
        const int b = it / 36, r_ = it % 36, c = r_ >> 1, g = r_ & 1, R0 = b * PB + c * 128;
        if (skipctx && c < 2) continue;
        ssd_load_images(F, XBC, R0, g, true);
        { const int h4 = F.wave & 3, d = F.wave >> 2, h = 4 * g + h4;
          const Series s = ssd_series(F, DT, P.ssd_a_log, R0, h, d);
          LAS float* A = ARR + h4 * 768;
          if (d == 0) { *(LAS f32x2*)(A + 0 * 128 + 2 * lane) = (f32x2){s.cs0, s.cs1}; *(LAS f32x2*)(A + 1 * 128 + 2 * lane) = (f32x2){s.dt0, s.dt1};
                        *(LAS f32x2*)(A + 2 * 128 + 2 * lane) = (f32x2){__expf(s.cs0), __expf(s.cs1)}; }
          else { *(LAS f32x2*)(A + 3 * 128 + 2 * lane) = (f32x2){s.ecs0, s.ecs1}; *(LAS f32x2*)(A + 4 * 128 + 2 * lane) = (f32x2){s.dt0, s.dt1};
                 *(LAS f32x2*)(A + 5 * 128 + 2 * lane) = (f32x2){__expf(s.tot - s.ecs0), __expf(s.tot - s.ecs1)}; } }
        __syncthreads();
        const int h4 = F.wave & 3, rh = F.wave >> 2, h = 4 * g + h4;
        const LAS float* A = ARR + h4 * 768;
        const LAS unsigned char* xh = F.lds + SSD_XH + h4 * 16384;
        const LAS unsigned char* bm = F.lds + SSD_BM;
        const LAS unsigned char* cm = F.lds + SSD_CM;
        f32x16 yacc[2][2];
#pragma unroll
        for (int i = 0; i < 2; ++i)
#pragma unroll
            for (int j = 0; j < 2; ++j)
#pragma unroll
                for (int k = 0; k < 16; ++k) yacc[i][j][k] = 0.f;
#pragma unroll
        for (int itl = 0; itl < 2; ++itl) {
            const int itile = 2 * rh + itl, irow = itile * 32 + l31;
            bf16x8 cf[4];
#pragma unroll
            for (int ks = 0; ks < 4; ++ks) cf[ks] = *(const LAS bf16x8*)(cm + img_off(irow, 2 * ks + hh));
#pragma unroll 1
            for (int d = 0; d < 2; ++d) {
                const bf16_t* Hs = HIN + (((((size_t)b * 18 + c) * 8 + h) * 2 + d) * 4096);
                bf16x8 hb[2][4];
#pragma unroll
                for (int pt = 0; pt < 2; ++pt)
#pragma unroll
                    for (int ks = 0; ks < 4; ++ks) hb[pt][ks] = *(const bf16x8*)(Hs + (pt * 32 + l31) * 64 + 16 * ks + 8 * hh);
#pragma unroll
                for (int pt = 0; pt < 2; ++pt) {
                    f32x16 tmp;
#pragma unroll
                    for (int k = 0; k < 16; ++k) tmp[k] = 0.f;
#pragma unroll
                    for (int ks = 0; ks < 4; ++ks) tmp = MFMA32(cf[ks], hb[pt][ks], tmp);
#pragma unroll
                    for (int q4 = 0; q4 < 4; ++q4) { const f32x4 ev = *(const LAS f32x4*)(A + (d == 0 ? 2 : 5) * 128 + itile * 32 + 8 * q4 + 4 * hh);
#pragma unroll
                        for (int k = 0; k < 4; ++k) yacc[itl][pt][4 * q4 + k] += tmp[4 * q4 + k] * ev[k]; }
                }
                __builtin_amdgcn_sched_barrier(0);
            }
            const float csf_i = A[0 * 128 + irow], ecb_i = A[3 * 128 + irow];
#pragma unroll 1
            for (int jt = 0; jt < 4; ++jt) {
                f32x16 Z;
#pragma unroll
                for (int k = 0; k < 16; ++k) Z[k] = 0.f;
#pragma unroll
                for (int ks = 0; ks < 4; ++ks) { const bf16x8 bf_ = *(const LAS bf16x8*)(bm + img_off(jt * 32 + l31, 2 * ks + hh)); Z = MFMA32(bf_, cf[ks], Z); }
#pragma unroll
                for (int q4 = 0; q4 < 4; ++q4) { const int j0 = jt * 32 + 8 * q4 + 4 * hh;
                    f32x4 w = (f32x4){0.f, 0.f, 0.f, 0.f};
                    if (jt <= itile) { const f32x4 cj = *(const LAS f32x4*)(A + 0 * 128 + j0), dj = *(const LAS f32x4*)(A + 1 * 128 + j0);
#pragma unroll
                        for (int k = 0; k < 4; ++k) { const bool ok = (jt < itile) || (j0 + k <= irow); w[k] += ok ? __expf(fminf(csf_i - cj[k], 0.f)) * dj[k] : 0.f; } }
                    if (jt >= itile) { const f32x4 ej = *(const LAS f32x4*)(A + 3 * 128 + j0), dj = *(const LAS f32x4*)(A + 4 * 128 + j0);
#pragma unroll
                        for (int k = 0; k < 4; ++k) { const bool ok = (jt > itile) || (j0 + k >= irow); w[k] += ok ? __expf(fminf(ej[k] - ecb_i, 0.f)) * dj[k] : 0.f; } }
#pragma unroll
                    for (int k = 0; k < 4; ++k) Z[4 * q4 + k] *= w[k]; }
#pragma unroll
                for (int s = 0; s < 2; ++s) {
                    u32x4 zp; zp.x = cvtpk(Z[8 * s], Z[8 * s + 1]); zp.y = cvtpk(Z[8 * s + 2], Z[8 * s + 3]); zp.z = cvtpk(Z[8 * s + 4], Z[8 * s + 5]); zp.w = cvtpk(Z[8 * s + 6], Z[8 * s + 7]);
                    const bf16x8 za = __builtin_bit_cast(bf16x8, zp);
                    const int row = jt * 32 + 16 * s + 4 * hh + q;
#pragma unroll
                    for (int pt = 0; pt < 2; ++pt) { const int chunk = pt * 4 + 2 * blk + (pp >> 1), within = 8 * (pp & 1);
                        const bf16x8 xb = cat8(tr_read4(xh + img_off(row, chunk) + within), tr_read4(xh + img_off(row + 8, chunk) + within));
                        yacc[itl][pt] = MFMA32(za, xb, yacc[itl][pt]); }
                }
                __builtin_amdgcn_sched_barrier(0);
            }
        }
        __syncthreads();
        LAS float* Y = (LAS float*)F.lds;
#pragma unroll
        for (int itl = 0; itl < 2; ++itl)
#pragma unroll
            for (int pt = 0; pt < 2; ++pt)
#pragma unroll
                for (int r = 0; r < 16; ++r) Y[((2 * rh + itl) * 32 + crow(r, hh)) * 256 + h4 * 64 + pt * 32 + l31] = yacc[itl][pt][r];
        __syncthreads();
#pragma unroll 1
        for (int it4 = 0; it4 < 8; it4 += 4) {
            u32x4 xw[4], zw[4];
#pragma unroll
            for (int u = 0; u < 4; ++u) { const int idx = (it4 + u) * 512 + F.tid, row = idx >> 5, ch = idx & 31, R = R0 + row;
                xw[u] = *(const u32x4*)(XBC + (size_t)R * 768 + g * 256 + ch * 8); zw[u] = *(const u32x4*)(PA + (size_t)R * PA_W + C_Z + g * 256 + ch * 8); }
#pragma unroll
            for (int u = 0; u < 4; ++u) { const int idx = (it4 + u) * 512 + F.tid, row = idx >> 5, ch = idx & 31, R = R0 + row;
                const f32x4 y0 = *(const LAS f32x4*)(Y + row * 256 + ch * 8), y1 = *(const LAS f32x4*)(Y + row * 256 + ch * 8 + 4);
                float xv[8], zv[8]; unpack8(xw[u], xv); unpack8(zw[u], zv);
                const float Dh = P.ssd_d[4 * g + (ch >> 3)]; float o[8], ss = 0.f;
#pragma unroll
                for (int k = 0; k < 8; ++k) { const float yv = (k < 4 ? y0[k] : y1[k - 4]) + Dh * xv[k]; o[k] = yv * silu_f(zv[k]); ss += o[k] * o[k]; }
                ss += __shfl_xor(ss, 1); ss += __shfl_xor(ss, 2); ss += __shfl_xor(ss, 4); ss += __shfl_xor(ss, 8); ss += __shfl_xor(ss, 16);
                if (ch == 0) SSQ[(size_t)R * 2 + g] = ss;
                *(u32x4*)(YB + (size_t)R * 1024 + 512 + g * 256 + ch * 8) = pack8(o); }
        }
        __syncthreads();
    }
}

DI void s5_recurrence(const Frame& F, const LayerIn& P, const float* __restrict__ S5S, bf16_t* __restrict__ AU) {
    if (F.gw >= 384) return;
    const int g = F.gw >> 4, b = (F.gw >> 1) & 7, d = F.gw & 1, p = F.lane;
    const float step = __expf(P.s5_lstep[d * 24 + g]);
    const float lr = P.s5_lre[(d * 24 + g) * 64 + p], li = P.s5_lim[(d * 24 + g) * 64 + p];
    const float mag = expf(32.f * lr * step), ang = 32.f * li * step, Lr = mag * cosf(ang), Li = mag * sinf(ang);
    float Hr = 0.f, Hi = 0.f;
#pragma unroll 1
    for (int kb = 0; kb < 72; kb += 24) {
        float sr[24], si[24];
#pragma unroll
        for (int k = 0; k < 24; ++k) { const int kk = kb + k, ck = (d == 0) ? kk : (kk < 8 ? 7 - kk : 79 - kk);
            const size_t m = (size_t)g * 576 + b * 72 + ck;
            sr[k] = S5S[m * 256 + d * 128 + p]; si[k] = S5S[m * 256 + d * 128 + 64 + p]; }
#pragma unroll
        for (int k = 0; k < 24; ++k) { const int kk = kb + k, ck = (d == 0) ? kk : (kk < 8 ? 7 - kk : 79 - kk);
            const size_t m = (size_t)g * 576 + b * 72 + ck;
            AU[m * 768 + 512 + d * 128 + p] = (bf16_t)f2bf(Hr); AU[m * 768 + 512 + d * 128 + 64 + p] = (bf16_t)f2bf(Hi);
            const float nr = Lr * Hr - Li * Hi + sr[k], ni = Lr * Hi + Li * Hr + si[k];
            Hr = nr; Hi = ni; }
    }
}

namespace attn_body {
using bf16=__hip_bfloat16;
using bf16x8=__attribute__((ext_vector_type(8)))short;
using s16x4=__attribute__((ext_vector_type(4)))short;
using f32x16=__attribute__((ext_vector_type(16)))float;
using u32x4=__attribute__((ext_vector_type(4)))unsigned;
constexpr int D=64;
constexpr int NW=8,QBLK=32,QB=QBLK*NW,KVBLK=64;
__device__ __forceinline__ int crow(int r,int hi){return (r&3)+8*(r>>2)+4*hi;}
#define SBAR() __builtin_amdgcn_sched_barrier(0)
constexpr int NSLOT=3, SLOTB=8192;
constexpr int LDS_K=0, LDS_V=NSLOT*SLOTB, LDS_WS=2*NSLOT*SLOTB, LDS_OST=LDS_WS+NW*64*4, LDS_BYTES=LDS_OST+NW*4096;
constexpr float C2=0.125f*1.4426950408889634f;
__device__ __forceinline__ void glds16(const void*gsrc,unsigned lds_dst){unsigned keep;
  asm volatile("s_mov_b32 %0, m0\n\ts_mov_b32 m0, %2\n\ts_nop 0\n\tglobal_load_lds_dwordx4 %1, off\n\ts_mov_b32 m0, %0":"=&s"(keep):"v"(gsrc),"s"(lds_dst):"memory");}
__device__ __forceinline__ float max3f(float a,float b,float c){float r;asm("v_max3_f32 %0, %1, %2, %3":"=v"(r):"v"(a),"v"(b),"v"(c));return r;}
__device__ __forceinline__ float max2f(float a,float b){float r;asm("v_max_f32_e32 %0, %1, %2":"=v"(r):"v"(a),"v"(b));return r;}
__device__ __forceinline__ float fadd_s(float a,float b){float r;asm("v_add_f32_e32 %0, %1, %2":"=v"(r):"v"(a),"v"(b));return r;}
__device__ __forceinline__ float fsub_s(float a,float b){float r;asm("v_sub_f32_e32 %0, %1, %2":"=v"(r):"v"(a),"v"(b));return r;}
typedef float f32x2_t __attribute__((ext_vector_type(2))); typedef __bf16 bf16x2_t __attribute__((ext_vector_type(2)));
__device__ __forceinline__ unsigned cvtpk_s(float lo,float hi){f32x2_t v={lo,hi};bf16x2_t b=__builtin_convertvector(v,bf16x2_t);return __builtin_bit_cast(unsigned,b);}
#define WAIT_BAR(N) asm volatile("s_waitcnt vmcnt(" #N ") lgkmcnt(0)\n\ts_barrier":::"memory")

__device__ __forceinline__ void qkt(f32x16&p0,f32x16&p1,const char*Kslot,const bf16x8*qr,const f32x16&negm,int r32,int hi){
  const char*kb=Kslot+hi*1024+r32*16;
  #pragma unroll
  for(int d0=0;d0<4;++d0){
    const bf16x8 b0=*reinterpret_cast<const bf16x8*>(kb+d0*2048);
    const bf16x8 b1=*reinterpret_cast<const bf16x8*>(kb+d0*2048+512);
    if(d0==0){p0=__builtin_amdgcn_mfma_f32_32x32x16_bf16(b0,qr[0],negm,0,0,0);p1=__builtin_amdgcn_mfma_f32_32x32x16_bf16(b1,qr[0],negm,0,0,0);}
    else{p0=__builtin_amdgcn_mfma_f32_32x32x16_bf16(b0,qr[d0],p0,0,0,0);p1=__builtin_amdgcn_mfma_f32_32x32x16_bf16(b1,qr[d0],p1,0,0,0);}}
}
typedef __attribute__((address_space(3))) const char* lds_cptr;
typedef short v4i16_t __attribute__((ext_vector_type(4)));
__device__ __forceinline__ void kload8(bf16x8*kf,lds_cptr kp){
  kf[0]=*(const __attribute__((address_space(3))) bf16x8*)(kp);      kf[1]=*(const __attribute__((address_space(3))) bf16x8*)(kp+512);
  kf[2]=*(const __attribute__((address_space(3))) bf16x8*)(kp+2048); kf[3]=*(const __attribute__((address_space(3))) bf16x8*)(kp+2560);
  kf[4]=*(const __attribute__((address_space(3))) bf16x8*)(kp+4096); kf[5]=*(const __attribute__((address_space(3))) bf16x8*)(kp+4608);
  kf[6]=*(const __attribute__((address_space(3))) bf16x8*)(kp+6144); kf[7]=*(const __attribute__((address_space(3))) bf16x8*)(kp+6656);
}
__device__ __forceinline__ void kload2(bf16x8*kf,lds_cptr kp,int j){ kf[2*j]=*(const __attribute__((address_space(3))) bf16x8*)(kp+j*2048); kf[2*j+1]=*(const __attribute__((address_space(3))) bf16x8*)(kp+j*2048+512); }
__device__ __forceinline__ s16x4 vtr(lds_cptr p){ return __builtin_bit_cast(s16x4,__builtin_amdgcn_ds_read_tr16_b64_v4i16((__attribute__((address_space(3))) v4i16_t*)p)); }
__device__ __forceinline__ float rowmax(const f32x16&p0,const f32x16&p1){
  float a=max3f(p0[0],p0[1],p1[0]),b=max3f(p0[2],p0[3],p1[1]);a=max3f(a,p1[2],p1[3]);
  #pragma unroll
  for(int r=4;r<16;r+=4){a=max3f(a,p0[r],p0[r+1]);b=max3f(b,p0[r+2],p0[r+3]);a=max3f(a,p1[r],p1[r+1]);b=max3f(b,p1[r+2],p1[r+3]);}
  const float m=max2f(a,b);
  auto rr=__builtin_amdgcn_permlane32_swap(__float_as_uint(m),__float_as_uint(m),false,false);
  return max2f(__uint_as_float(rr[0]),__uint_as_float(rr[1]));
}
__device__ __forceinline__ void pv(f32x16*o,int vb,bf16x8 pa0,bf16x8 pa1,bf16x8 pa2,bf16x8 pa3){
  #pragma unroll
  for(int d0=0;d0<2;++d0){s16x4 lo[4],hi[4];
    #pragma unroll
    for(int ks=0;ks<4;++ks){
      asm volatile("ds_read_b64_tr_b16 %0,%1 offset:%c2":"=&v"(lo[ks]):"v"(vb),"i"(d0*4096+ks*1024):"memory");
      asm volatile("ds_read_b64_tr_b16 %0,%1 offset:%c2":"=&v"(hi[ks]):"v"(vb),"i"(d0*4096+ks*1024+512):"memory");}
    asm volatile("s_waitcnt lgkmcnt(0)":::"memory");SBAR();
    #define PK(k) (bf16x8){lo[k][0],lo[k][1],lo[k][2],lo[k][3],hi[k][0],hi[k][1],hi[k][2],hi[k][3]}
    o[d0]=__builtin_amdgcn_mfma_f32_32x32x16_bf16(pa0,PK(0),o[d0],0,0,0);
    o[d0]=__builtin_amdgcn_mfma_f32_32x32x16_bf16(pa1,PK(1),o[d0],0,0,0);
    o[d0]=__builtin_amdgcn_mfma_f32_32x32x16_bf16(pa2,PK(2),o[d0],0,0,0);
    o[d0]=__builtin_amdgcn_mfma_f32_32x32x16_bf16(pa3,PK(3),o[d0],0,0,0);
    #undef PK
  }
}

#ifndef ATTN_STORE16
#define ATTN_STORE16(p,v) (*(u32x4*)(p)=(v))
#endif
template<int THRL> __device__ __forceinline__ void attn_unit(const bf16*Qp,int qpitch,const bf16*__restrict__ Kp,int kpitch,const bf16*__restrict__ Vp,int vpitch,bf16*Op,int opitch,const int NT,char*shm){
  const int tid=fresh_tid(),lane=tid&63,r32=lane&31,hi=lane>>5; const int wid=__builtin_amdgcn_readfirstlane(tid>>6);
  const bf16*Qw=Qp+(long)(wid*QBLK)*qpitch;
  const bf16*Kh=Kp,*Vh=Vp;
  const unsigned lds0=(unsigned)(uintptr_t)shm;
  float*wsf=(float*)(shm+LDS_WS)+wid*64;
  const bf16*ksrc=Kh+(long)lane*kpitch+wid*8;
  const bf16*vsrc=Vh+(long)(16*(wid&3)+(lane>>2))*vpitch+(wid>>2)*32+(lane&3)*8;
  const unsigned kdst=lds0+LDS_K+wid*1024, vdst=lds0+LDS_V+wid*1024;
  #define DMA_K(t,slot) glds16(ksrc+(long)(t)*KVBLK*kpitch,(unsigned)__builtin_amdgcn_readfirstlane(kdst+(slot)))
  #define DMA_V(t,slot) glds16(vsrc+(long)(t)*KVBLK*vpitch,(unsigned)__builtin_amdgcn_readfirstlane(vdst+(slot)))
  const int vb0=(int)(lds0+LDS_V)+((lane>>4)&1)*32+(lane&3)*8+(4*hi+((lane&15)>>2))*64;
  const char*Kbase=shm+LDS_K; bf16x8 kf[8];
  const lds_cptr shm3=(lds_cptr)shm; const lds_cptr kp0=shm3+LDS_K+hi*1024+r32*16; const lds_cptr vp0=shm3+LDS_V+((lane>>4)&1)*32+(lane&3)*8+(4*hi+((lane&15)>>2))*64;
  DMA_K(0,0);DMA_V(0,0);DMA_K(1,SLOTB);
  bf16x8 qr[4];
  #pragma unroll
  for(int d0=0;d0<4;++d0)qr[d0]=*reinterpret_cast<const bf16x8*>(&Qw[(long)r32*qpitch+d0*16+hi*8]);
  float mhat=0.f,l_reg=0.f;f32x16 o[2];o[0]=f32x16{};o[1]=f32x16{};f32x16 negm=f32x16{};asm volatile("":"+v"(negm));
  #define CMASK(P0,P1,t) do{}while(0)
  bool resc=false;
  #define START(P0,P1) do{ const float rm=rowmax(P0,P1); resc=false; \
    { const float dl=rm; mhat=fadd_s(mhat,dl); \
      _Pragma("unroll") for(int r=0;r<16;++r){P0[r]=fsub_s(P0[r],dl);P1[r]=fsub_s(P1[r],dl);} \
      _Pragma("unroll") for(int r=0;r<16;++r)negm[r]=-mhat; asm volatile("":"+v"(negm)); } \
    _Pragma("unroll") for(int r=0;r<16;++r)P0[r]=__builtin_amdgcn_exp2f(P0[r]); }while(0)
  #define RESC() do{ if(resc){ asm volatile("s_waitcnt lgkmcnt(0)":::"memory"); \
      _Pragma("unroll") for(int d_=0;d_<2;++d_) _Pragma("unroll") for(int r=0;r<16;++r)o[d_][r]*=wsf[crow(r,hi)]; } }while(0)
  f32x16 pA0,pA1,pB0,pB1;
  int sl_prev=0,sl_cur=0,sl_next=SLOTB;
  #define ROT() do{sl_prev=sl_cur;sl_cur=sl_next;sl_next=(sl_next==(NSLOT-1)*SLOTB)?0:sl_next+SLOTB;}while(0)
  DMA_K(2,2*SLOTB);
  WAIT_BAR(3);
  qkt(pA0,pA1,Kbase,qr,negm,r32,hi);asm volatile("s_nop 15\n\ts_nop 7":"+v"(pA0),"+v"(pA1));CMASK(pA0,pA1,0);
  START(pA0,pA1);
  _Pragma("unroll") for(int r=0;r<16;++r)pA1[r]=__builtin_amdgcn_exp2f(pA1[r]);
  WAIT_BAR(0);
  DMA_K(3,0);DMA_V(1,SLOTB);
  ROT();
  kload8(kf,kp0+sl_cur);
  WAIT_BAR(2);
  s16x4 vlo[8],vhi[8]; u32x4 pw0,pw1,pw2,pw3;
  #define PKW(P,B) cvtpk_s(P[B],P[B+1])
  #define PAF(k) __builtin_bit_cast(bf16x8,pw##k)
  #define VFR(i) (bf16x8){vlo[i][0],vlo[i][1],vlo[i][2],vlo[i][3],vhi[i][0],vhi[i][1],vhi[i][2],vhi[i][3]}
  #define PIN(x) asm volatile("":"+v"(x))
  #define MX3(a,b,c) __builtin_fmaxf(__builtin_fmaxf((a),(b)),(c))
  #define GAPA(MF,A0,A1,A2,A3,W0,W1,PW) do{ MF; sacc+=A0; sacc+=A1; sacc+=A2; sacc+=A3; PIN(sacc); W0; W1; PIN(PW); SBAR(); }while(0)
  #define EX(v) __builtin_amdgcn_exp2f(v)
  #define GAPB(MF,X,B) do{ MF; X[B]=EX(X[B]); X[B+1]=EX(X[B+1]); X[B+2]=EX(X[B+2]); X[B+3]=EX(X[B+3]); PIN(X); SBAR(); }while(0)
  #define VRD(i) do{ vlo[i]=vtr(vp_+(((i)>>2)*4096+((i)&3)*1024)); vhi[i]=vtr(vp_+(((i)>>2)*4096+((i)&3)*1024+512)); }while(0)
  #define KRD(G,j) do{ if(G){ kload2(kf,kp0+sl_next,j); SBAR(); } }while(0)
  #define STEP(C0,C1,P0,P1,t,GK,GV,GL) do{ SBAR(); \
    const lds_cptr vp_=vp0+sl_prev; \
    VRD(0); SBAR(); float sacc=(P0[0]+P0[1]); \
    GAPA(C0=__builtin_amdgcn_mfma_f32_32x32x16_bf16(kf[0],qr[0],negm,0,0,0), P0[2],P0[3],P0[4],P0[5],     pw0[0]=PKW(P0,0), pw0[1]=PKW(P0,2), pw0); \
    VRD(4); SBAR(); GAPA(C1=__builtin_amdgcn_mfma_f32_32x32x16_bf16(kf[1],qr[0],negm,0,0,0), P0[6],P0[7],P0[8],P0[9],     pw0[2]=PKW(P0,4), pw0[3]=PKW(P0,6), pw0); \
    VRD(1); SBAR(); GAPA(C0=__builtin_amdgcn_mfma_f32_32x32x16_bf16(kf[2],qr[1],C0,0,0,0),   P0[10],P0[11],P0[12],P0[13], pw1[0]=PKW(P0,8), pw1[1]=PKW(P0,10), pw1); \
    VRD(5); SBAR(); GAPA(C1=__builtin_amdgcn_mfma_f32_32x32x16_bf16(kf[3],qr[1],C1,0,0,0),   P0[14],P0[15],P1[0],P1[1],   pw1[2]=PKW(P0,12),pw1[3]=PKW(P0,14), pw1); \
    VRD(2); SBAR(); GAPA(C0=__builtin_amdgcn_mfma_f32_32x32x16_bf16(kf[4],qr[2],C0,0,0,0),   P1[2],P1[3],P1[4],P1[5],     pw2[0]=PKW(P1,0), pw2[1]=PKW(P1,2), pw2); \
    VRD(6); SBAR(); GAPA(C1=__builtin_amdgcn_mfma_f32_32x32x16_bf16(kf[5],qr[2],C1,0,0,0),   P1[6],P1[7],P1[8],P1[9],     pw2[2]=PKW(P1,4), pw2[3]=PKW(P1,6), pw2); \
    VRD(3); SBAR(); GAPA(C0=__builtin_amdgcn_mfma_f32_32x32x16_bf16(kf[6],qr[3],C0,0,0,0),   P1[10],P1[11],P1[12],P1[13], pw3[0]=PKW(P1,8), pw3[1]=PKW(P1,10), pw3); \
    VRD(7); SBAR(); GAPA(C1=__builtin_amdgcn_mfma_f32_32x32x16_bf16(kf[7],qr[3],C1,0,0,0),   P1[14],P1[15],0.f,0.f,       pw3[2]=PKW(P1,12),pw3[3]=PKW(P1,14), pw3); \
    l_reg+=sacc; \
    if(GK){DMA_K((t)+3,sl_cur);} if(GV){DMA_V((t)+1,sl_next);} \
    CMASK(C0,C1,t); \
    { float a=MX3(C0[0],C0[1],C1[0]),b=MX3(C0[2],C0[3],C1[1]); a=MX3(a,C1[2],C1[3]); \
      _Pragma("unroll") for(int r=4;r<16;r+=4){a=MX3(a,C0[r],C0[r+1]);b=MX3(b,C0[r+2],C0[r+3]);a=MX3(a,C1[r],C1[r+1]);b=MX3(b,C1[r+2],C1[r+3]);} \
      float rm=__builtin_fmaxf(a,b); { auto rr=__builtin_amdgcn_permlane32_swap(__float_as_uint(rm),__float_as_uint(rm),false,false); rm=__builtin_fmaxf(__uint_as_float(rr[0]),__uint_as_float(rr[1])); } \
      resc=false; \
      if(__builtin_expect(__any(rm>(float)THRL),0)){ const float dl=__builtin_fmaxf(rm,0.f); mhat+=dl; \
        _Pragma("unroll") for(int r=0;r<16;++r){C0[r]-=dl;C1[r]-=dl;} \
        _Pragma("unroll") for(int r=0;r<16;++r)negm[r]=-mhat; asm volatile("":"+v"(negm)); \
        const float f=__builtin_amdgcn_exp2f(-dl); l_reg*=f; if(hi==0)wsf[r32]=f; resc=true; } } \
    SBAR(); \
    GAPB(o[0]=__builtin_amdgcn_mfma_f32_32x32x16_bf16(PAF(0),VFR(0),o[0],0,0,0), C0,0); \
    GAPB(o[1]=__builtin_amdgcn_mfma_f32_32x32x16_bf16(PAF(0),VFR(4),o[1],0,0,0), C0,4); \
    KRD(GL,0); GAPB(o[0]=__builtin_amdgcn_mfma_f32_32x32x16_bf16(PAF(1),VFR(1),o[0],0,0,0), C0,8); \
    KRD(GL,1); GAPB(o[1]=__builtin_amdgcn_mfma_f32_32x32x16_bf16(PAF(1),VFR(5),o[1],0,0,0), C0,12); \
    KRD(GL,2); GAPB(o[0]=__builtin_amdgcn_mfma_f32_32x32x16_bf16(PAF(2),VFR(2),o[0],0,0,0), C1,0); \
    KRD(GL,3); GAPB(o[1]=__builtin_amdgcn_mfma_f32_32x32x16_bf16(PAF(2),VFR(6),o[1],0,0,0), C1,4); \
    GAPB(o[0]=__builtin_amdgcn_mfma_f32_32x32x16_bf16(PAF(3),VFR(3),o[0],0,0,0), C1,8); \
    GAPB(o[1]=__builtin_amdgcn_mfma_f32_32x32x16_bf16(PAF(3),VFR(7),o[1],0,0,0), C1,12); \
    }while(0)
  int t=1;
  for(;t+5<NT;t+=2){
    STEP(pB0,pB1,pA0,pA1,t,true,true,true);     WAIT_BAR(2); RESC(); ROT();
    STEP(pA0,pA1,pB0,pB1,t+1,true,true,true);   WAIT_BAR(2); RESC(); ROT();
  }
  #define ENDW(tt) do{ if((tt)+3<NT){WAIT_BAR(2);} else if((tt)+2<NT){WAIT_BAR(1);} else {WAIT_BAR(0);} }while(0)
  for(;t+1<NT;t+=2){
    STEP(pB0,pB1,pA0,pA1,t,(t+3<NT),(t+1<NT),(t+1<NT));       ENDW(t);   RESC(); ROT();
    STEP(pA0,pA1,pB0,pB1,t+1,(t+4<NT),(t+2<NT),(t+2<NT));     ENDW(t+1); RESC(); ROT();
  }
  STEP(pB0,pB1,pA0,pA1,NT-1,false,false,false); RESC();
  { float sacc=pB0[0]+pB0[1]; _Pragma("unroll") for(int r=2;r<16;++r)sacc+=pB0[r]; _Pragma("unroll") for(int r=0;r<16;++r)sacc+=pB1[r]; l_reg+=sacc;
    pw0=(u32x4){PKW(pB0,0),PKW(pB0,2),PKW(pB0,4),PKW(pB0,6)};pw1=(u32x4){PKW(pB0,8),PKW(pB0,10),PKW(pB0,12),PKW(pB0,14)};pw2=(u32x4){PKW(pB1,0),PKW(pB1,2),PKW(pB1,4),PKW(pB1,6)};pw3=(u32x4){PKW(pB1,8),PKW(pB1,10),PKW(pB1,12),PKW(pB1,14)};
    SBAR(); pv(o,vb0+sl_cur,PAF(0),PAF(1),PAF(2),PAF(3)); }
  #undef PKW
  #undef PAF
  #undef VFR
  #undef PIN
  #undef MX3
  #undef GAPA
  #undef GAPB
  #undef EX
  #undef VRD
  #undef KRD
  #undef STEP
  #undef ENDW
  {auto rr=__builtin_amdgcn_permlane32_swap(__float_as_uint(l_reg),__float_as_uint(l_reg),false,false);l_reg=__uint_as_float(rr[0])+__uint_as_float(rr[1]);}
  if(hi==0)wsf[32+r32]=l_reg;asm volatile("s_waitcnt lgkmcnt(0)":::"memory");
  float rli[16];
  #pragma unroll
  for(int r=0;r<16;++r)rli[r]=__builtin_amdgcn_rcpf(wsf[32+crow(r,hi)]);
  bf16*Ow=Op+(long)(wid*QBLK)*opitch;
  { bf16*stg=(bf16*)(shm+LDS_OST)+wid*2048;
    #pragma unroll
    for(int r=0;r<16;++r){const int orow=crow(r,hi);
      #pragma unroll
      for(int d0=0;d0<2;++d0)stg[orow*64+d0*32+r32]=__float2bfloat16(o[d0][r]*rli[r]);}
    asm volatile("s_waitcnt lgkmcnt(0)":::"memory");
    #pragma unroll
    for(int i=0;i<4;++i){const int row=i*8+(lane>>3),ch=lane&7; const u32x4 v=*(const u32x4*)(stg+row*64+ch*8); ATTN_STORE16(Ow+(long)row*opitch+ch*8,v);} }
  asm volatile("s_waitcnt lgkmcnt(0)\n\ts_barrier":::"memory");
  #undef DMA_K
  #undef DMA_V
  #undef CMASK
  #undef START
  #undef RESC
  #undef ROT
}
constexpr int ATTN_LDS_BYTES=LDS_BYTES;
#undef SBAR
#undef WAIT_BAR
}


#define pMOD ((float*)(ws + WS_MOD))
#define pROPE ((float*)(ws + WS_ROPE))
#define pAFF ((float*)(ws + WS_AFF))
#define pINV ((int*)(ws + WS_INV))
#define pDT ((float*)(ws + WS_DT))
#define pSRC ((int*)(ws + WS_SRC))
#define pGV ((float*)(ws + WS_GV))
#define pSSQ ((float*)(ws + WS_SSQ))
#define pTOT ((float*)(ws + WS_TOT))
#define pX ((float*)(ws + WS_X))
#define pH ((bf16_t*)(ws + WS_H))
#define pYAB ((bf16_t*)(ws + WS_YAB))
#define pPA ((bf16_t*)(ws + WS_PA))
#define pPG ((bf16_t*)(ws + WS_PG))
#define pMRGB ((bf16_t*)(ws + WS_MRGB))
#define pY ((bf16_t*)(ws + WS_Y))
#define pXG ((bf16_t*)(ws + WS_XG))
#define pHID ((bf16_t*)(ws + WS_HID))
#define pYE ((bf16_t*)(ws + WS_YE))
#define pQN ((bf16_t*)(ws + WS_QN))
#define pKN ((bf16_t*)(ws + WS_KN))
#define pHIN ((bf16_t*)(ws + WS_HIN))
#define pXBC ((bf16_t*)(ws + WS_XBC))
#define pAU ((bf16_t*)(ws + WS_AU))
#define pSS ((float*)(ws + WS_S))
#define pYG ((bf16_t*)(ws + WS_YG))
#define pS5S ((float*)(ws + WS_S5S))
#define pYCD ((bf16_t*)(ws + WS_YCD))
constexpr int EW_SPLIT1 = 2688, EW_SPLIT2 = 7168, EW1_SPLIT = 3072;
struct Args { const float* in[38]; float* out; unsigned char* ws; int ph_lo, ph_hi; };
constexpr int PH_PER_LAYER = 15, PH_FINAL = 2 * PH_PER_LAYER, PH_TOTAL = PH_FINAL + 1;

DI LayerIn layer_in(const Args& a, int L) {
    LayerIn P;
    P.norm_mix_g = a.in[6] + (size_t)L * 1024; P.norm_ffn_g = a.in[7] + (size_t)L * 1024;
    P.w_in = a.in[8] + (size_t)L * 1024 * NIN; P.q_norm_g = a.in[9] + L * 64; P.k_norm_g = a.in[10] + L * 64;
    P.ssd_conv_w = a.in[11] + L * 3 * 768; P.ssd_conv_b = a.in[12] + L * 768; P.ssd_dt_bias = a.in[13] + L * 16; P.ssd_a_log = a.in[14] + L * 16;
    P.ssd_d = a.in[15] + L * 8; P.ssd_norm_g = a.in[16] + L * 512;
    P.s5_lre = a.in[17] + L * 2 * 24 * 64; P.s5_lim = a.in[18] + L * 2 * 24 * 64; P.s5_lstep = a.in[19] + L * 48;
    P.s5_bre = a.in[20] + (size_t)L * 24 * 64 * 16; P.s5_bim = a.in[21] + (size_t)L * 24 * 64 * 16; P.s5_cre = a.in[22] + (size_t)L * 24 * 16 * 64; P.s5_cim = a.in[23] + (size_t)L * 24 * 16 * 64;
    P.s5_d = a.in[24] + L * 384; P.s5_wglu = a.in[25] + (size_t)L * 384 * 384; P.s5_bglu = a.in[26] + L * 384; P.sc_conv_w = a.in[27] + L * 3 * 384;
    P.w_br_attn = a.in[28] + (size_t)L * 512 * 1024; P.w_br_ssd = a.in[29] + (size_t)L * 512 * 1024; P.w_br_s5 = a.in[30] + (size_t)L * 384 * 1024; P.w_br_sc = a.in[31] + (size_t)L * 384 * 1024;
    P.w_out = a.in[32] + (size_t)L * 1024 * 1024; P.w_router = a.in[33] + (size_t)L * 1024 * 16;
    P.w_gate = a.in[34] + (size_t)L * 16 * 1024 * 1024; P.w_up = a.in[35] + (size_t)L * 16 * 1024 * 1024; P.w_down = a.in[36] + (size_t)L * 16 * 1024 * 1024;
    return P;
}

__global__ void __launch_bounds__(NWAVES * 64, 2) hybrid_fwd(Args args) {
    extern __shared__ __attribute__((aligned(16))) unsigned char lds_raw[];
    Frame F0;
#define F F0
    F.lds = (LAS unsigned char*)lds_raw;
    F.tid = threadIdx.x; F.lane = F.tid & 63; F.wave = __builtin_amdgcn_readfirstlane(F.tid >> 6);
    F.G = gridDim.x; { const int bx = blockIdx.x; F.vcu = (F.G % 8 == 0) ? (bx % 8) * (F.G / 8) + bx / 8 : bx; }
    F.gw = F.vcu * NWAVES + F.wave; F.NGW = F.G * NWAVES;
    unsigned char* ws = args.ws;
    volatile LAS unsigned* MISC = (volatile LAS unsigned*)(F.lds + LDSCTL_OFF);
    for (int u = F.tid; u < (LDS_BYTES - LDSCTL_OFF) / 4; u += NWAVES * 64) ((LAS unsigned*)(F.lds + LDSCTL_OFF))[u] = 0u;
    __syncthreads();
    XcdBarrier bar = xcd_barrier_post((unsigned*)(ws + WS_CTL) + CW_BAR, MISC + 8);
    const int lo = args.ph_lo, hi = args.ph_hi;
#ifndef PH_MASK
#define PH_MASK 0xFFFF
#endif
#define IN(k) (lo <= (k) && (k) < hi)
#define INL(j) (((PH_MASK >> (j)) & 1) && IN(base + (j)))
#ifndef REPEAT_MASK
#define REPEAT_MASK 0
#endif
#define REP(j) for (int rep_ = 0; rep_ < 1 + ((REPEAT_MASK >> (j)) & 1); ++rep_)
#define SEAM(k) do { if (IN((k) + 1)) xcd_barrier(bar); } while (0)

#undef F
#pragma unroll 1
    for (int L = 0; L < 2; ++L) {
        const int base = L * PH_PER_LAYER;
        if (hi <= base || lo >= base + PH_PER_LAYER) continue;
        const bool lastL = (L == 1);

        if (L == 0 && INL(0)) REP(0) { const LayerIn P = layer_in(args, L); Frame F = F0; F.tid = fresh_tid(); F.lane = F.tid & 63; if (rep_) xcd_barrier(bar);
#ifndef SUBREP_MOD
#define SUBREP_MOD 0
#endif
#ifndef SUBREP_S5
#define SUBREP_S5 0
#endif
#ifndef SUBREP_SW
#define SUBREP_SW 0
#endif
            if (L == 0) { for (int q_ = 0; q_ <= SUBREP_MOD; ++q_) { prep_mod(F, args.in[1], args.in[3], args.in[4], args.in[5], pMOD); prep_rope(F, pROPE); } }
            for (int q_ = 0; q_ <= SUBREP_S5; ++q_) prep_s5(F, P, ws);
            for (int q_ = 0; q_ <= SUBREP_SW; ++q_) prep_small_weights(F, P, ws);
            SEAM(base + 0);
        }
        if (INL(1)) REP(1) { const LayerIn P = layer_in(args, L); Frame F = F0; F.tid = fresh_tid(); F.lane = F.tid & 63; if (rep_) xcd_barrier(bar); phase_norm1(F, L, args.in[0], args.in[2], pX, pH, pMOD, P.norm_mix_g, pINV, pYE, pY); SEAM(base + 1); }
        if (INL(2)) REP(2) { const LayerIn P = layer_in(args, L); Frame F = F0; F.tid = fresh_tid(); F.lane = F.tid & 63; if (rep_) xcd_barrier(bar);
            pg8::Gemm g{pH, (const bf16_t*)(ws + W_WIN), 1024, 1024, 1024};
            RowSkipOrder S; S.init(NPROJ, F.G, (int)blockIdx.x, lastL ? 1 : 0, 2, 10);
            EpiProj E{pPA, PA_W, PA_W / 256, pPG, PG_W};
            pg8::gemm_phase<EpiProj, RowSkipOrder>(F.lds, g, S, E);
            SEAM(base + 2);
        }
        if (INL(3)) REP(3) { const LayerIn P = layer_in(args, L); Frame F = F0; F.tid = fresh_tid(); F.lane = F.tid & 63; if (rep_) xcd_barrier(bar); phase_elem(F, P, pPA, pROPE, pQN, pKN, pXBC, pDT, pAU, pYCD); SEAM(base + 3); }
        if (INL(4)) REP(4) { const LayerIn P = layer_in(args, L); Frame F = F0; F.tid = fresh_tid(); F.lane = F.tid & 63; if (rep_) xcd_barrier(bar);
            using abf = attn_body::bf16;
#ifndef SUBREP_ATTN
#define SUBREP_ATTN 0
#endif
#ifndef SUBREP_E1
#define SUBREP_E1 0
#endif
#ifndef SUBREP_E3
#define SUBREP_E3 0
#endif
#ifndef NO_ATTN
            for (int q_ = 0; q_ <= SUBREP_ATTN; ++q_) {
            for (int u = F.vcu; u < 512; u += F.G) { const int bk = u >> 5, r = u & 31, b = bk >> 1, kvh = bk & 1, h = kvh * 4 + (r >> 3), qb = r & 7;
                const size_t qrow = (size_t)b * PB + CTXL + qb * 256, krow = (size_t)b * PB;
                attn_body::attn_unit<8>((const abf*)(pQN + qrow * 512 + h * 64), 512, (const abf*)(pKN + krow * 128 + kvh * 64), 128, (const abf*)(pPA + krow * PA_W + C_V + kvh * 64), PA_W,
                                        (abf*)(pYAB + qrow * 1024 + h * 64), 1024, 36, (char*)lds_raw); }
            if (!lastL) for (int u = (F.vcu + F.G - 64) % F.G; u < 64; u += F.G) { const int b = u >> 3, h = u & 7, kvh = h >> 2; const size_t krow = (size_t)b * PB;
                attn_body::attn_unit<8>((const abf*)(pQN + krow * 512 + h * 64), 512, (const abf*)(pKN + krow * 128 + kvh * 64), 128, (const abf*)(pPA + krow * PA_W + C_V + kvh * 64), PA_W,
                                        (abf*)(pYAB + krow * 1024 + h * 64), 1024, 4, (char*)lds_raw); }
            }
#endif
            __syncthreads();
#ifndef NO_E1
            for (int q_ = 0; q_ <= SUBREP_E1; ++q_) ssd_chunk_states(F, P, pXBC, pDT, pSS, pTOT);
#endif
#ifndef NO_S5S
            { pg8::Gemm g{pAU, (const bf16_t*)(ws + W_P), 768, 512, 512}; OrderS5S S{F.G, (int)((blockIdx.x + F.G - 184) % F.G)}; EpiS5S E{pS5S};
              pg8::gemm_phase<EpiS5S, OrderS5S>(F.lds, g, S, E); }
#endif
            SEAM(base + 4);
        }
        if (INL(5)) REP(5) { const LayerIn P = layer_in(args, L); Frame F = F0; F.tid = fresh_tid(); F.lane = F.tid & 63; if (rep_) xcd_barrier(bar); ssd_recurrence(F, pSS, pTOT, pHIN); s5_recurrence(F, P, pS5S, pAU); SEAM(base + 5); }
        if (INL(6)) REP(6) { const LayerIn P = layer_in(args, L); Frame F = F0; F.tid = fresh_tid(); F.lane = F.tid & 63; if (rep_) xcd_barrier(bar);
#ifndef NO_E3
            for (int q_ = 0; q_ <= SUBREP_E3; ++q_) ssd_output(F, P, pXBC, pPA, pDT, pHIN, pYAB, pSSQ, lastL);
#endif
#ifndef NO_S5Y
            { pg8::Gemm g{pAU, (const bf16_t*)(ws + W_TQ), 768, 768, 768}; OrderS5Y S{F.G, (int)((blockIdx.x + F.G - 112) % F.G)}; EpiS5Y E{pAU, pYG, P.s5_d};
              pg8::gemm_phase<EpiS5Y, OrderS5Y>(F.lds, g, S, E); }
#endif
            SEAM(base + 6);
        }
        if (INL(7)) REP(7) { const LayerIn P = layer_in(args, L); Frame F = F0; F.tid = fresh_tid(); F.lane = F.tid & 63; if (rep_) xcd_barrier(bar);
            for (int R = F.gw; R < MROWS; R += F.NGW) {
                if (lastL && (R % PB) < CTXL) continue;
                const float rs = 1.0f / sqrtf((pSSQ[2 * R] + pSSQ[2 * R + 1]) * (1.f / 512.f) + RMS_EPS);
                bf16_t* yb = pYAB + (size_t)R * 1024 + 512 + 8 * F.lane; float v[8]; unpack8(*(const u32x4*)yb, v);
#pragma unroll
                for (int k = 0; k < 8; ++k) v[k] *= rs;
                *(u32x4*)yb = pack8(v); }
            pg8::Gemm g{pYG, (const bf16_t*)(ws + W_GLU), 384, 384, 384};
            RowSkipOrder S; S.init(512, F.G, (int)blockIdx.x, lastL ? 1 : 0, 0, 0);
            EpiGlu E{pYG, pYCD, P.s5_bglu};
            pg8::gemm_phase<EpiGlu, RowSkipOrder>(F.lds, g, S, E);
            SEAM(base + 7);
        }
        if (INL(8)) REP(8) { const LayerIn P = layer_in(args, L); Frame F = F0; F.tid = fresh_tid(); F.lane = F.tid & 63; if (rep_) xcd_barrier(bar);
            MergeOrder S; S.init(F.G, (int)blockIdx.x, lastL ? 1 : 0);
            pg8::MergeArgs MA{pYAB, pYCD, (const bf16_t*)(ws + W_BR4), pPG, pMRGB};
            pg8::gemm_merge_phase<MergeOrder>(F.lds, MA, S);
            if (!lastL) { __syncthreads(); const LayerIn P1 = layer_in(args, 1); prep_s5(F, P1, ws, 64); __syncthreads(); prep_expert_weights(F, P, ws, 160, 0, EW_SPLIT1); }
            SEAM(base + 8);
        }
        if (INL(9)) REP(9) { const LayerIn P = layer_in(args, L); Frame F = F0; F.tid = fresh_tid(); F.lane = F.tid & 63; if (rep_) xcd_barrier(bar);
            pg8::Gemm g{pMRGB, (const bf16_t*)(ws + W_OUT), 1024, 1024, 1024};
            RowSkipOrder S; S.init(1024, F.G, (int)blockIdx.x, lastL ? 1 : 0, 0, 0);
            EpiWout E{pY};
            pg8::gemm_phase<EpiWout, RowSkipOrder>(F.lds, g, S, E);
            if (!lastL) { __syncthreads(); const LayerIn P1 = layer_in(args, 1); prep_small_weights(F, P1, ws, 1, 32); prep_expert_weights(F, P, ws, 32, EW_SPLIT1, EW_SPLIT2); }
            SEAM(base + 9);
        }
        if (INL(10)) REP(10) { const LayerIn P = layer_in(args, L); Frame F = F0; F.tid = fresh_tid(); F.lane = F.tid & 63; if (rep_) xcd_barrier(bar); phase_norm2(F, L, lastL, args.in[0], args.in[2], pX, pY, pH, pMOD, P.norm_ffn_g, P.w_router, pAFF); SEAM(base + 10); }
        if (INL(11)) REP(11) { const LayerIn P = layer_in(args, L); Frame F = F0; F.tid = fresh_tid(); F.lane = F.tid & 63; if (rep_) xcd_barrier(bar); phase_topk(F, lastL ? 128 : 256, pAFF, pSRC, pGV, pINV);
            if (L == 0) { const LayerIn P1 = layer_in(args, 1); prep_small_weights(F, P1, ws, 2, 0); }
            prep_expert_weights(F, P, ws, 0, (L == 0) ? EW_SPLIT2 : 2 * 4096, EXPERT_W_ITEMS); SEAM(base + 12); }
        if (INL(13)) REP(13) { const LayerIn P = layer_in(args, L); Frame F = F0; F.tid = fresh_tid(); F.lane = F.tid & 63; if (rep_) xcd_barrier(bar);
            pg8::Gemm g{pH, lastL ? (const bf16_t*)args.out : (const bf16_t*)(ws + WS_WGU), 1024, 1024, 1024}; OrderUp S{F.G, (int)blockIdx.x, lastL ? 8 : 9}; EpiUp E{pHID};
            pg8::gemm_phase_gather<EpiUp, OrderUp>(F.lds, g, pSRC, S, E);
            if (!lastL) { __syncthreads(); const LayerIn P1 = layer_in(args, 1); prep_expert_weights(F, P1, ws, 128, 0, EW1_SPLIT, (bf16_t*)args.out); }
            SEAM(base + 13);
        }
        if (INL(14)) REP(14) { const LayerIn P = layer_in(args, L); Frame F = F0; F.tid = fresh_tid(); F.lane = F.tid & 63; if (rep_) xcd_barrier(bar);
            pg8::Gemm g{pHID, (const bf16_t*)(ws + WS_WD), 1024, 1024, 1024}; OrderDown S{F.G, (int)blockIdx.x, lastL ? 8 : 9}; EpiDown E{pYE, pGV};
            pg8::gemm_phase<EpiDown, OrderDown>(F.lds, g, S, E);
            if (!lastL) { __syncthreads(); const LayerIn P1 = layer_in(args, 1); prep_expert_weights(F, P1, ws, 64, EW1_SPLIT, 2 * 4096, (bf16_t*)args.out); }
            SEAM(base + 14);
        }
    }
#ifdef EXTRA_BARRIERS
    for (int eb = 0; eb < EXTRA_BARRIERS; ++eb) xcd_barrier(bar);
#endif
    if (IN(PH_FINAL)) phase_final(F0, pX, args.out, pMOD, args.in[37], pINV, pYE, pY);
#undef IN
#undef INL
#undef SEAM
}

#ifndef MK_N_LAUNCHES
#define MK_N_LAUNCHES 1
#endif
extern "C" void kernel_launch(void* const* d_in, const int* in_sizes, int n_in, void* d_out, int out_size, void* d_ws, size_t ws_size, hipStream_t stream) {
    static int grid = 0;
    if (grid == 0) {
        if (n_in != 38 || ws_size < WS_END) { fprintf(stderr, "kernel_launch: unexpected inputs (n_in %d, ws %zu)\n", n_in, ws_size); grid = -1; return; }
        int dev = 0, cus = 0;
        if (hipGetDevice(&dev) != hipSuccess || hipDeviceGetAttribute(&cus, hipDeviceAttributeMultiprocessorCount, dev) != hipSuccess) { grid = -1; return; }
        if (hipFuncSetAttribute((const void*)hybrid_fwd, hipFuncAttributeMaxDynamicSharedMemorySize, LDS_BYTES) != hipSuccess) { fprintf(stderr, "kernel_launch: hipFuncSetAttribute failed\n"); grid = -1; return; }
        (void)hipGetLastError();
        grid = (cus / 8) * 8;
        if (grid > 256) grid = 256;
    }
    if (grid < 0) return;
    if (hipMemsetAsync((char*)d_ws + WS_CTL, 0, CTL_ZERO_BYTES, stream) != hipSuccess) return;
    Args a{};
    for (int i = 0; i < 38; ++i) a.in[i] = (const float*)d_in[i];
    a.out = (float*)d_out; a.ws = (unsigned char*)d_ws;
#if MK_N_LAUNCHES == 1
    a.ph_lo = 0; a.ph_hi = PH_TOTAL;
    hipLaunchKernelGGL(hybrid_fwd, dim3(grid), dim3(NWAVES * 64), LDS_BYTES, stream, a);
#else
    for (int p = 0; p < PH_TOTAL; ++p) { a.ph_lo = p; a.ph_hi = p + 1; hipLaunchKernelGGL(hybrid_fwd, dim3(grid), dim3(NWAVES * 64), LDS_BYTES, stream, a); }
#endif
}
```

```cpp
#include <hip/hip_runtime.h>
#include <hip/hip_bf16.h>
#include <cstdio>
#include <cstdint>
#include <cmath>

#define DI __device__ __forceinline__
#define GAS __attribute__((address_space(1)))
#define LAS __attribute__((address_space(3)))
typedef unsigned short bf16_t;
typedef short bf16x8 __attribute__((ext_vector_type(8)));
typedef short s16x4 __attribute__((ext_vector_type(4)));
typedef float f32x2 __attribute__((ext_vector_type(2)));
typedef float f32x4 __attribute__((ext_vector_type(4)));
typedef float f32x16 __attribute__((ext_vector_type(16)));
typedef unsigned u32x2 __attribute__((ext_vector_type(2)));
typedef unsigned u32x4 __attribute__((ext_vector_type(4)));
typedef GAS unsigned gu32;

constexpr int DM = 1024, NB = 8, SEQ = 2048, CTXL = 256, PB = 2304, MROWS = NB * PB;
constexpr int NIN = 7688, NE = 16, EFF = 1024;
constexpr int C_Q = 0, C_K = 512, C_V = 640, C_Z = 768, C_XBC = 1280, C_DT = 2048, C_U = 2056, C_SB = 2440, C_SG = 2824, C_SH = 3208, C_G = 3592;
constexpr int PA_W = 3840, PG_W = 4096, NPROJ = PA_W + PG_W;
constexpr int EROWS = 2304;
constexpr float RMS_EPS = 1e-6f;
constexpr float ATT_C2 = 0.125f * 1.4426950408889634f;

constexpr size_t MiB = 1u << 20;
constexpr size_t WS_CTL = 0, CTL_ZERO_BYTES = 1 * MiB;
constexpr size_t WS_MOD = 1 * MiB;
constexpr size_t WS_ROPE = WS_MOD + 512 * 1024;
constexpr size_t WS_AFF = 2 * MiB;
constexpr size_t WS_INV = WS_AFF + 1280 * 1024;
constexpr size_t WS_DT = WS_INV + 1280 * 1024;
constexpr size_t WS_SRC = WS_DT + 1280 * 1024;
constexpr size_t WS_GV = WS_SRC + 256 * 1024;
constexpr size_t WS_SSQ = WS_GV + 256 * 1024;
constexpr size_t WS_TOT = WS_SSQ + 256 * 1024;
constexpr size_t WS_X = 8 * MiB;
constexpr size_t WS_W = 80 * MiB;
constexpr size_t W_WIN = WS_W;
constexpr size_t W_BR4 = W_WIN + (size_t)NPROJ * 1024 * 2;
constexpr size_t W_OUT = W_BR4 + (size_t)1024 * 1792 * 2;
constexpr size_t W_GLU = W_OUT + 1024 * 1024 * 2;
constexpr size_t W_TQ = W_GLU + 512 * 384 * 2;
constexpr size_t W_P = W_TQ + (size_t)24 * 512 * 768 * 2;
constexpr size_t W_END = W_P + (size_t)24 * 256 * 512 * 2;
constexpr size_t WS_H = 126 * MiB;
constexpr size_t WS_YAB = WS_H;
constexpr size_t WS_PA = 162 * MiB;
constexpr size_t WS_MRGB = WS_PA, WS_XG = WS_PA, WS_Y = WS_PA + 72 * MiB;
constexpr size_t WS_PG = 297 * MiB;
constexpr size_t WS_HID = WS_PG, WS_YE = WS_PG + 72 * MiB;
constexpr size_t WS_R5 = 441 * MiB;
constexpr size_t WS_QN = WS_R5;
constexpr size_t WS_KN = WS_R5 + 18 * MiB;
constexpr size_t WS_HIN = WS_PG + 72 * MiB;
constexpr size_t WS_XBC = WS_R5 + 22 * MiB + 512 * 1024;
constexpr size_t WS_AU = WS_R5 + 49 * MiB + 512 * 1024;
constexpr size_t WS_S = WS_R5 + 70 * MiB;
constexpr size_t WS_YG = WS_S;
constexpr size_t WS_S5S = WS_R5 + 106 * MiB;
constexpr size_t WS_YCD = WS_S5S + 13 * MiB + 512 * 1024;
constexpr size_t WS_WGU = WS_R5;
constexpr size_t WS_WD = WS_PA + 36 * MiB;
constexpr size_t WS_END = WS_YCD + 27 * MiB;
static_assert(W_END <= WS_H, "small weights fit");
static_assert(WS_AU + (size_t)24 * 576 * 768 * 2 <= WS_S && WS_XBC + (size_t)MROWS * 768 * 2 <= WS_AU && WS_S + (size_t)8 * 18 * 16 * 4096 * 4 <= WS_S5S, "R5 map");
static_assert(WS_S5S + (size_t)24 * 576 * 256 * 4 <= WS_YCD && WS_YCD + (size_t)MROWS * 768 * 2 <= WS_END && WS_WD + (size_t)32 * MiB <= WS_Y && WS_MRGB + (size_t)MROWS * 1024 * 2 <= WS_WD && WS_WGU + (size_t)64 * MiB <= WS_S && WS_END <= (size_t)588 * MiB, "R5 map 2");
static_assert(WS_TOT + 16384 <= WS_X && WS_ROPE + 2048 * 64 * 4 <= WS_AFF, "misc map");

constexpr int CW_BAR = 4096;
constexpr int CW_S5CNT = 16384;

constexpr int NWAVES = 8;
constexpr int LDS_SCRATCH = 151552;
constexpr int LDSCTL_OFF = LDS_SCRATCH;
constexpr int LDS_BYTES = 155648;

#define LDS_WAIT() asm volatile("s_waitcnt lgkmcnt(0)" ::: "memory")
#define VM_WAIT() asm volatile("s_waitcnt vmcnt(0)" ::: "memory")
DI int fresh_tid() { int t = threadIdx.x; asm volatile("" : "+v"(t)); return t; }
DI unsigned f2bf(float f) { unsigned u = __builtin_bit_cast(unsigned, f); return (u + 0x7fffu + ((u >> 16) & 1u)) >> 16; }
DI unsigned pk2(float lo, float hi) { typedef __bf16 bf2_t __attribute__((ext_vector_type(2))); f32x2 v = {lo, hi}; bf2_t b = __builtin_convertvector(v, bf2_t); return __builtin_bit_cast(unsigned, b); }
DI float bflo(unsigned w) { return __builtin_bit_cast(float, w << 16); }
DI float bfhi(unsigned w) { return __builtin_bit_cast(float, w & 0xffff0000u); }
DI float bf2f(bf16_t h) { return __builtin_bit_cast(float, (unsigned)h << 16); }
DI float silu_f(float x) { return x * __builtin_amdgcn_rcpf(1.f + __expf(-x)); }
DI float sigmoid_f(float x) { return __builtin_amdgcn_rcpf(1.f + __expf(-x)); }
DI float softplus_f(float x) { const float e = __expf(-fabsf(x)); const float l = (e < 1e-3f) ? e * (1.f - 0.5f * e) : __logf(1.f + e); return fmaxf(x, 0.f) + l; }
DI float gelu_tanh_f(float x) { const float u = 0.7978845608028654f * (x + 0.044715f * x * x * x); const float t = 1.f - 2.f * __builtin_amdgcn_rcpf(__expf(2.f * u) + 1.f); return 0.5f * x * (1.f + t); }
DI int lane_op() { int l = (int)__builtin_amdgcn_mbcnt_hi(~0u, __builtin_amdgcn_mbcnt_lo(~0u, 0u)); asm volatile("" : "+v"(l)); return l; }
DI float shup(float v, int d, int l) { return __builtin_bit_cast(float, __builtin_amdgcn_ds_bpermute(((l >= d) ? l - d : l) << 2, __builtin_bit_cast(int, v))); }
DI int shup(int v, int d, int l) { return __builtin_amdgcn_ds_bpermute(((l >= d) ? l - d : l) << 2, v); }
DI float shidx(float v, int src) { return __builtin_bit_cast(float, __builtin_amdgcn_ds_bpermute(src << 2, __builtin_bit_cast(int, v))); }
DI float wave_sum(float v) {
#pragma unroll
    for (int o = 1; o < 64; o <<= 1) v += __shfl_xor(v, o);
    return v;
}
DI void unpack8(const u32x4 w, float (&f)[8]) {
    f[0] = bflo(w.x); f[1] = bfhi(w.x); f[2] = bflo(w.y); f[3] = bfhi(w.y); f[4] = bflo(w.z); f[5] = bfhi(w.z); f[6] = bflo(w.w); f[7] = bfhi(w.w);
}
DI u32x4 pack8(const float (&f)[8]) { u32x4 w; w.x = pk2(f[0], f[1]); w.y = pk2(f[2], f[3]); w.z = pk2(f[4], f[5]); w.w = pk2(f[6], f[7]); return w; }

#define XB_TMO      128
#define XB_XCNT(j)  (256  + 64 * (j))
#define XB_XSUB(j)  (1280 + 64 * (j))
#define XB_XGEN(j)  (2304 + 64 * (j))
#define XB_TOP      3328
#define XB_TOPGEN   3392
#define XCD_BAR_WORDS 3456
#define XB_SPIN_CAP (1u << 20)
DI unsigned xb_ld(unsigned* p)              { return __hip_atomic_load(p, __ATOMIC_RELAXED, __HIP_MEMORY_SCOPE_AGENT); }
DI unsigned xb_add(unsigned* p, unsigned v) { return __hip_atomic_fetch_add(p, v, __ATOMIC_RELAXED, __HIP_MEMORY_SCOPE_AGENT); }
DI unsigned xb_xcc_id() { return (unsigned)__builtin_amdgcn_s_getreg((3 << 11) | 20) & 0xFu; }
#define XB_SPIN(cond, bar) do { unsigned _sp = 0; while (cond) { __builtin_amdgcn_s_sleep(1); \
    if ((++_sp & 255u) == 0u) { if (xb_ld(&(bar)[XB_TMO])) break; if (_sp > XB_SPIN_CAP) { atomicAdd(&(bar)[XB_TMO], 1u); break; } } } } while (0)
struct XcdBarrier { unsigned* bar; unsigned x; volatile LAS unsigned* st; unsigned G; };
DI XcdBarrier xcd_barrier_post(unsigned* bar, volatile LAS unsigned* st, unsigned G) {
    XcdBarrier b; b.bar = bar; b.x = xb_xcc_id(); b.st = st; b.G = G;
    if (threadIdx.x == 0) (void)xb_add(&bar[XB_XCNT(b.x)], 1u);
    return b;
}
DI void xcd_barrier_complete(unsigned* bar, unsigned x, unsigned& nloc, unsigned& nx, unsigned G) {
    unsigned sum, cnt, mine, sp = 0u;
    for (;;) {
        sum = 0u; cnt = 0u; mine = 0u;
#pragma unroll
        for (unsigned j = 0; j < 16; ++j) { const unsigned c = xb_ld(&bar[XB_XCNT(j)]); sum += c; cnt += (c > 0u) ? 1u : 0u; mine = (j == x) ? c : mine; }
        if (sum == G) break;
        __builtin_amdgcn_s_sleep(1);
        if ((++sp & 255u) == 0u) { if (xb_ld(&bar[XB_TMO])) break; if (sp > XB_SPIN_CAP) { atomicAdd(&bar[XB_TMO], 1u); break; } }
    }
    nloc = mine > 0u ? mine : 1u; nx = cnt > 0u ? cnt : 1u;
}
DI void xcd_barrier(const XcdBarrier& b) {
    asm volatile("s_waitcnt vmcnt(0)" ::: "memory");
    __syncthreads();
    if (threadIdx.x == 0) {
        unsigned* bar = b.bar;
        asm volatile("" : "+s"(bar));
        __builtin_amdgcn_s_waitcnt(0);
        unsigned nloc = b.st[0], nx = b.st[1];
        if (nloc == 0u) { xcd_barrier_complete(bar, b.x, nloc, nx, b.G); b.st[0] = nloc; b.st[1] = nx; }
        const unsigned old = xb_add(&bar[XB_XSUB(b.x)], 1u);
        const unsigned gen = old / nloc;
        if (old + 1u == (gen + 1u) * nloc) {
#ifndef NO_RELEASE_PROBE
            __builtin_amdgcn_fence(__ATOMIC_RELEASE, "agent");
#endif
            asm volatile("s_waitcnt vmcnt(0)" ::: "memory");
            const unsigned og = xb_add(&bar[XB_TOP], 1u);
            const unsigned tg = og / nx;
            if (og + 1u == (tg + 1u) * nx) xb_add(&bar[XB_TOPGEN], 1u);
            else XB_SPIN(xb_ld(&bar[XB_TOPGEN]) == tg, bar);
            __builtin_amdgcn_fence(__ATOMIC_ACQUIRE, "agent");
            asm volatile("s_waitcnt vmcnt(0)" ::: "memory");
        } else {
            XB_SPIN(xb_ld(&bar[XB_TOPGEN]) == gen, bar);
            __builtin_amdgcn_fence(__ATOMIC_ACQUIRE, "agent");
            asm volatile("s_waitcnt vmcnt(0)" ::: "memory");
        }
    }
    __syncthreads();
}

namespace pg8 {
constexpr int BM = 256, BK = 64, HALF = 128, HTB = HALF * BK * 2, STAGE_BYTES = 8 * HTB, NXCD = 8, WGM = 8;
__host__ __device__ __forceinline__ int lds_byte(int r, int c) { const int st = (r >> 4) * 2 + (c >> 5), rr = r & 15, cc = c & 31, ob = rr * 64 + cc * 2; return st * 1024 + (ob ^ (((ob >> 9) & 1) << 5)); }
__host__ __device__ __forceinline__ void stage_rc(int b, int& R, int& C) { const int st = b / 1024, sb = b % 1024, swz = sb ^ (((sb >> 9) & 1) << 5); R = (st >> 1) * 16 + swz / 64; C = (st & 1) * 32 + (swz % 64) / 2; }
__host__ __device__ __forceinline__ int perm32(int rho) { const int n = rho >> 4, i = rho & 15; return 8 * (i >> 2) + 4 * n + (i & 3); }

struct Unit { int arow, brow, pm, pn; };
struct Gemm { const bf16_t* A; const bf16_t* Bt; int lda, ldb, K; };

template <class Epi, class Sched, bool ALIGN_EPI = true>
DI void gemm_phase(LAS unsigned char* lds, const Gemm g, const Sched& S, const Epi& E) {
    const int tid = fresh_tid(), wid = __builtin_amdgcn_readfirstlane(tid >> 6), lane = tid & 63, wr = wid >> 2, wc = wid & 3, fr = lane & 15, fq = lane >> 4;
    const int K = g.K, nt = K / BK;
    unsigned voffA[2], voffB[2];
#pragma unroll
    for (int i = 0; i < 2; ++i) { int R, C; stage_rc(tid * 16 + i * 8192, R, C); const int Rb = Epi::PERM ? ((R & ~31) + perm32(R & 31)) : R;
        voffA[i] = (unsigned)(R * g.lda + C) * 2u; voffB[i] = (unsigned)(Rb * g.ldb + C) * 2u; }
    const size_t kstep = (size_t)(BK * 2);
    const size_t hA = (size_t)HALF * g.lda * 2, hB = (size_t)HALF * g.ldb * 2;
    const unsigned ldsw = (unsigned)wid * 1024u;
    const int aoff = lds_byte(wr * 64 + fr, fq * 8), boff = lds_byte(wc * 32 + fr, fq * 8);
#define PG8_SA(b, h) (((b) * 2 + (h)) * HTB)
#define PG8_SB(b, h) ((4 + (b) * 2 + (h)) * HTB)
#define PG8_STAGE(bufoff, gbase, voff) do { _Pragma("unroll") for (int _i = 0; _i < 2; ++_i) \
        __builtin_amdgcn_global_load_lds((const unsigned*)((const char*)(gbase) + (voff)[_i]), (LAS unsigned*)(lds + (bufoff) + ldsw + _i * 8192), 16, 0, 0); } while (0)
#define PG8_LDA(dst, b, h) do { _Pragma("unroll") for (int m = 0; m < 4; ++m) _Pragma("unroll") for (int k = 0; k < 2; ++k) dst[m][k] = *(const LAS bf16x8*)(lds + PG8_SA(b, h) + aoff + m * 2048 + k * 1024); } while (0)
#define PG8_LDB(dst, b, h) do { _Pragma("unroll") for (int n = 0; n < 2; ++n) _Pragma("unroll") for (int k = 0; k < 2; ++k) dst[n][k] = *(const LAS bf16x8*)(lds + PG8_SB(b, h) + boff + n * 2048 + k * 1024); } while (0)
#define PG8_MMA(ai, bj, At, Bt) do { __builtin_amdgcn_s_setprio(1); _Pragma("unroll") for (int m = 0; m < 4; ++m) _Pragma("unroll") for (int n = 0; n < 2; ++n) _Pragma("unroll") for (int k = 0; k < 2; ++k) \
        acc[ai][bj][m][n] = __builtin_amdgcn_mfma_f32_16x16x32_bf16(Bt[n][k], At[m][k], acc[ai][bj][m][n], 0, 0, 0); __builtin_amdgcn_s_setprio(0); } while (0)
#define PG8_WAIT_V(n) asm volatile("s_waitcnt vmcnt(" #n ")" ::: "memory")
#define PG8_WAIT_L(n) asm volatile("s_waitcnt lgkmcnt(" #n ")" ::: "memory")
#define PG8_BAR __builtin_amdgcn_s_barrier()
#define PG8_SCHED __builtin_amdgcn_sched_barrier(0)
    int ui = 0;
    Unit cur = S.next(0);
    if (cur.arow < 0) return;
    f32x4 acc[2][2][4][2];
#pragma unroll
    for (int a = 0; a < 2; ++a)
#pragma unroll
        for (int b = 0; b < 2; ++b)
#pragma unroll
            for (int m = 0; m < 4; ++m)
#pragma unroll
                for (int n = 0; n < 2; ++n) acc[a][b][m][n] = (f32x4){0.f, 0.f, 0.f, 0.f};
    bf16x8 At[4][2], B0[2][2], B1[2][2];
    const char* cA = (const char*)g.A + (size_t)cur.arow * g.lda * 2; const char* cB = (const char*)g.Bt + (size_t)cur.brow * g.ldb * 2;
    PG8_STAGE(PG8_SB(0, 0), cB, voffB); PG8_STAGE(PG8_SB(0, 1), cB + hB, voffB); PG8_STAGE(PG8_SA(0, 0), cA, voffA); PG8_STAGE(PG8_SA(0, 1), cA + hA, voffA);
    if (wr == 1) PG8_BAR;
    PG8_WAIT_V(2); PG8_BAR;
    PG8_STAGE(PG8_SB(1, 0), cB + kstep, voffB); PG8_STAGE(PG8_SA(1, 0), cA + kstep, voffA); PG8_STAGE(PG8_SB(1, 1), cB + hB + kstep, voffB);
    PG8_WAIT_V(6); PG8_BAR;
    for (;;) {
        const Unit nxt = S.next(ui + 1);
        const bool has_next = nxt.arow >= 0;
        const char* nA = has_next ? (const char*)g.A + (size_t)nxt.arow * g.lda * 2 : cA; const char* nB = has_next ? (const char*)g.Bt + (size_t)nxt.brow * g.ldb * 2 : cB;
#pragma unroll 1
        for (int t = 0; t < nt; t += 2) {
            const bool last = (t == nt - 2);
            const char* a1 = cA + (size_t)(t + 1) * kstep;
            const char* a2 = last ? nA : cA + (size_t)(t + 2) * kstep; const char* b2 = last ? nB : cB + (size_t)(t + 2) * kstep;
            const char* a3 = a2 + kstep; const char* b3 = b2 + kstep;
            PG8_LDB(B0, 0, 0); PG8_LDB(B1, 0, 1); PG8_SCHED; PG8_LDA(At, 0, 0); PG8_STAGE(PG8_SA(1, 1), a1 + hA, voffA);
            PG8_WAIT_V(8); PG8_WAIT_L(0); PG8_BAR; PG8_MMA(0, 0, At, B0); PG8_MMA(0, 1, At, B1); PG8_BAR; PG8_SCHED;
            PG8_LDA(At, 0, 1); PG8_STAGE(PG8_SB(0, 0), b2, voffB); PG8_STAGE(PG8_SB(0, 1), b2 + hB, voffB); PG8_STAGE(PG8_SA(0, 0), a2, voffA);
            PG8_WAIT_V(8); PG8_WAIT_L(0); PG8_BAR; PG8_MMA(1, 0, At, B0); PG8_MMA(1, 1, At, B1); PG8_BAR; PG8_SCHED;
            PG8_LDB(B0, 1, 0); PG8_LDB(B1, 1, 1); PG8_SCHED; PG8_LDA(At, 1, 0); PG8_STAGE(PG8_SA(0, 1), a2 + hA, voffA);
            PG8_WAIT_V(8); PG8_WAIT_L(0); PG8_BAR; PG8_MMA(0, 0, At, B0); PG8_MMA(0, 1, At, B1); PG8_BAR; PG8_SCHED;
            PG8_LDA(At, 1, 1); PG8_STAGE(PG8_SB(1, 0), b3, voffB); PG8_STAGE(PG8_SB(1, 1), b3 + hB, voffB); PG8_STAGE(PG8_SA(1, 0), a3, voffA);
            PG8_WAIT_V(8); PG8_WAIT_L(0); PG8_BAR; PG8_MMA(1, 0, At, B0); PG8_MMA(1, 1, At, B1); PG8_BAR; PG8_SCHED;
        }
        if constexpr (ALIGN_EPI) { if (wr == 0) PG8_BAR; }
        E(acc, cur, wr, wc, fr, fq);
        if (!has_next) break;
#pragma unroll
        for (int a = 0; a < 2; ++a)
#pragma unroll
            for (int b = 0; b < 2; ++b)
#pragma unroll
                for (int m = 0; m < 4; ++m)
#pragma unroll
                    for (int n = 0; n < 2; ++n) acc[a][b][m][n] = (f32x4){0.f, 0.f, 0.f, 0.f};
        cur = nxt; cA = nA; cB = nB; ++ui;
        if constexpr (ALIGN_EPI) { if (wr == 1) PG8_BAR; }
    }
    PG8_WAIT_V(0);
    if constexpr (!ALIGN_EPI) { if (wr == 0) PG8_BAR; }
    PG8_BAR;
#undef PG8_SA
#undef PG8_SB
#undef PG8_STAGE
#undef PG8_LDA
#undef PG8_LDB
#undef PG8_MMA
#undef PG8_WAIT_V
#undef PG8_WAIT_L
#undef PG8_BAR
#undef PG8_SCHED
}

template <class Epi, class Sched, bool ALIGN_EPI = true>
DI void gemm_phase_gather(LAS unsigned char* lds, const Gemm g, const int* __restrict__ grow, const Sched& S, const Epi& E) {
    const int tid = fresh_tid(), wid = __builtin_amdgcn_readfirstlane(tid >> 6), lane = tid & 63, wr = wid >> 2, wc = wid & 3, fr = lane & 15, fq = lane >> 4;
    const int K = g.K, nt = K / BK;
    unsigned voffB[2];
#pragma unroll
    for (int i = 0; i < 2; ++i) { int R, C; stage_rc(tid * 16 + i * 8192, R, C); const int Rb = Epi::PERM ? ((R & ~31) + perm32(R & 31)) : R;
        voffB[i] = (unsigned)(Rb * g.ldb + C) * 2u; }
#define PG8_RA(i_) ([&]{ int R_, C_; stage_rc(tid * 16 + (i_) * 8192, R_, C_); return R_; }())
#define PG8_CA2(i_) ([&]{ int R_, C_; stage_rc(tid * 16 + (i_) * 8192, R_, C_); return (unsigned)C_ * 2u; }())
    unsigned vAc[2][2];
#define PG8_GOFF(dst, arow_) do { _Pragma("unroll") for (int h_ = 0; h_ < 2; ++h_) _Pragma("unroll") for (int i_ = 0; i_ < 2; ++i_) \
        dst[h_][i_] = (unsigned)grow[(arow_) + h_ * HALF + PG8_RA(i_)] * (unsigned)(g.lda * 2) + PG8_CA2(i_); } while (0)
    const size_t kstep = (size_t)(BK * 2);
    const size_t hB = (size_t)HALF * g.ldb * 2;
    const unsigned ldsw = (unsigned)wid * 1024u;
    const int aoff = lds_byte(wr * 64 + fr, fq * 8), boff = lds_byte(wc * 32 + fr, fq * 8);
#define PG8_SA(b, h) (((b) * 2 + (h)) * HTB)
#define PG8_SB(b, h) ((4 + (b) * 2 + (h)) * HTB)
#define PG8_STAGE(bufoff, gbase, voff) do { _Pragma("unroll") for (int _i = 0; _i < 2; ++_i) \
        __builtin_amdgcn_global_load_lds((const unsigned*)((const char*)(gbase) + (voff)[_i]), (LAS unsigned*)(lds + (bufoff) + ldsw + _i * 8192), 16, 0, 0); } while (0)
#define PG8_STAGEA(bufoff, kbyte, vv, hf) do { _Pragma("unroll") for (int _i = 0; _i < 2; ++_i) \
        __builtin_amdgcn_global_load_lds((const unsigned*)((const char*)g.A + (kbyte) + vv[hf][_i]), (LAS unsigned*)(lds + (bufoff) + ldsw + _i * 8192), 16, 0, 0); } while (0)
#define PG8_LDA(dst, b, h) do { _Pragma("unroll") for (int m = 0; m < 4; ++m) _Pragma("unroll") for (int k = 0; k < 2; ++k) dst[m][k] = *(const LAS bf16x8*)(lds + PG8_SA(b, h) + aoff + m * 2048 + k * 1024); } while (0)
#define PG8_LDB(dst, b, h) do { _Pragma("unroll") for (int n = 0; n < 2; ++n) _Pragma("unroll") for (int k = 0; k < 2; ++k) dst[n][k] = *(const LAS bf16x8*)(lds + PG8_SB(b, h) + boff + n * 2048 + k * 1024); } while (0)
#define PG8_MMA(ai, bj, At, Bt) do { __builtin_amdgcn_s_setprio(1); _Pragma("unroll") for (int m = 0; m < 4; ++m) _Pragma("unroll") for (int n = 0; n < 2; ++n) _Pragma("unroll") for (int k = 0; k < 2; ++k) \
        acc[ai][bj][m][n] = __builtin_amdgcn_mfma_f32_16x16x32_bf16(Bt[n][k], At[m][k], acc[ai][bj][m][n], 0, 0, 0); __builtin_amdgcn_s_setprio(0); } while (0)
#define PG8_WAIT_V(n) asm volatile("s_waitcnt vmcnt(" #n ")" ::: "memory")
#define PG8_WAIT_L(n) asm volatile("s_waitcnt lgkmcnt(" #n ")" ::: "memory")
#define PG8_BAR __builtin_amdgcn_s_barrier()
#define PG8_SCHED __builtin_amdgcn_sched_barrier(0)
    int ui = 0;
    Unit cur = S.next(0);
    if (cur.arow < 0) return;
    f32x4 acc[2][2][4][2];
#pragma unroll
    for (int a = 0; a < 2; ++a)
#pragma unroll
        for (int b = 0; b < 2; ++b)
#pragma unroll
            for (int m = 0; m < 4; ++m)
#pragma unroll
                for (int n = 0; n < 2; ++n) acc[a][b][m][n] = (f32x4){0.f, 0.f, 0.f, 0.f};
    bf16x8 At[4][2], B0[2][2], B1[2][2];
    const char* cB = (const char*)g.Bt + (size_t)cur.brow * g.ldb * 2;
    PG8_GOFF(vAc, cur.arow);
    PG8_STAGE(PG8_SB(0, 0), cB, voffB); PG8_STAGE(PG8_SB(0, 1), cB + hB, voffB); PG8_STAGEA(PG8_SA(0, 0), 0, vAc, 0); PG8_STAGEA(PG8_SA(0, 1), 0, vAc, 1);
    if (wr == 1) PG8_BAR;
    PG8_WAIT_V(2); PG8_BAR;
    PG8_STAGE(PG8_SB(1, 0), cB + kstep, voffB); PG8_STAGEA(PG8_SA(1, 0), kstep, vAc, 0); PG8_STAGE(PG8_SB(1, 1), cB + hB + kstep, voffB);
    PG8_WAIT_V(6); PG8_BAR;
    for (;;) {
        const Unit nxt = S.next(ui + 1);
        const bool has_next = nxt.arow >= 0;
        const char* nB = has_next ? (const char*)g.Bt + (size_t)nxt.brow * g.ldb * 2 : cB;
        int rawn[2][2];
#pragma unroll
        for (int h_ = 0; h_ < 2; ++h_)
#pragma unroll
            for (int i_ = 0; i_ < 2; ++i_) rawn[h_][i_] = has_next ? grow[nxt.arow + h_ * HALF + PG8_RA(i_)] : 0;
#pragma unroll 1
        for (int t = 0; t < nt; t += 2) {
            const bool last = (t == nt - 2);
            const size_t k1 = (size_t)(t + 1) * kstep, k2 = last ? 0 : (size_t)(t + 2) * kstep, k3 = k2 + kstep;
            const char* b2 = last ? nB : cB + (size_t)(t + 2) * kstep; const char* b3 = b2 + kstep;
            PG8_LDB(B0, 0, 0); PG8_LDB(B1, 0, 1); PG8_SCHED; PG8_LDA(At, 0, 0); PG8_STAGEA(PG8_SA(1, 1), k1, vAc, 1);
            if (last && has_next) {
#pragma unroll
                for (int h_ = 0; h_ < 2; ++h_)
#pragma unroll
                    for (int i_ = 0; i_ < 2; ++i_) vAc[h_][i_] = (unsigned)rawn[h_][i_] * (unsigned)(g.lda * 2) + PG8_CA2(i_); }
            PG8_WAIT_V(8); PG8_WAIT_L(0); PG8_BAR; PG8_MMA(0, 0, At, B0); PG8_MMA(0, 1, At, B1); PG8_BAR; PG8_SCHED;
            PG8_LDA(At, 0, 1); PG8_STAGE(PG8_SB(0, 0), b2, voffB); PG8_STAGE(PG8_SB(0, 1), b2 + hB, voffB); PG8_STAGEA(PG8_SA(0, 0), k2, vAc, 0);
            PG8_WAIT_V(8); PG8_WAIT_L(0); PG8_BAR; PG8_MMA(1, 0, At, B0); PG8_MMA(1, 1, At, B1); PG8_BAR; PG8_SCHED;
            PG8_LDB(B0, 1, 0); PG8_LDB(B1, 1, 1); PG8_SCHED; PG8_LDA(At, 1, 0); PG8_STAGEA(PG8_SA(0, 1), k2, vAc, 1);
            PG8_WAIT_V(8); PG8_WAIT_L(0); PG8_BAR; PG8_MMA(0, 0, At, B0); PG8_MMA(0, 1, At, B1); PG8_BAR; PG8_SCHED;
            PG8_LDA(At, 1, 1); PG8_STAGE(PG8_SB(1, 0), b3, voffB); PG8_STAGE(PG8_SB(1, 1), b3 + hB, voffB); PG8_STAGEA(PG8_SA(1, 0), k3, vAc, 0);
            PG8_WAIT_V(8); PG8_WAIT_L(0); PG8_BAR; PG8_MMA(1, 0, At, B0); PG8_MMA(1, 1, At, B1); PG8_BAR; PG8_SCHED;
        }
        if constexpr (ALIGN_EPI) { if (wr == 0) PG8_BAR; }
        E(acc, cur, wr, wc, fr, fq);
        if (!has_next) break;
#pragma unroll
        for (int a = 0; a < 2; ++a)
#pragma unroll
            for (int b = 0; b < 2; ++b)
#pragma unroll
                for (int m = 0; m < 4; ++m)
#pragma unroll
                    for (int n = 0; n < 2; ++n) acc[a][b][m][n] = (f32x4){0.f, 0.f, 0.f, 0.f};
        cur = nxt; cB = nB; ++ui;
        if constexpr (ALIGN_EPI) { if (wr == 1) PG8_BAR; }
    }
    PG8_WAIT_V(0);
    if constexpr (!ALIGN_EPI) { if (wr == 0) PG8_BAR; }
    PG8_BAR;
#undef PG8_SA
#undef PG8_SB
#undef PG8_STAGE
#undef PG8_STAGEA
#undef PG8_GOFF
#undef PG8_RA
#undef PG8_CA2
#undef PG8_LDA
#undef PG8_LDB
#undef PG8_MMA
#undef PG8_WAIT_V
#undef PG8_WAIT_L
#undef PG8_BAR
#undef PG8_SCHED
}

struct MergeArgs { const bf16_t* YAB; const bf16_t* YCD; const bf16_t* W4T; const unsigned char* G; const float* ssq; bf16_t* MRGB; };
template <class Sched>
DI void gemm_merge_phase(LAS unsigned char* lds, const MergeArgs M, const Sched& S) {
    const int tid = fresh_tid(), wid = __builtin_amdgcn_readfirstlane(tid >> 6), lane = tid & 63, wr = wid >> 2, wc = wid & 3, fr = lane & 15, fq = lane >> 4;
    constexpr int NT = 28, LDB = 1792;
    unsigned vA0[2], vA1[2], voffB[2];
#pragma unroll
    for (int i = 0; i < 2; ++i) { int R, C; stage_rc(tid * 16 + i * 8192, R, C); const int Rb = (R & ~31) + perm32(R & 31);
        vA0[i] = (unsigned)(R * 1024 + C) * 2u; vA1[i] = (unsigned)(R * 768 + C) * 2u; voffB[i] = (unsigned)(Rb * LDB + C) * 2u; }
    const size_t kstep = (size_t)(BK * 2);
    const unsigned ldsw = (unsigned)wid * 1024u;
    const int aoff = lds_byte(wr * 64 + fr, fq * 8), boff = lds_byte(wc * 32 + fr, fq * 8);
#define PG8_SA(b, h) (((b) * 2 + (h)) * HTB)
#define PG8_SB(b, h) ((4 + (b) * 2 + (h)) * HTB)
#define PG8_STAGEB(bufoff, gbase) do { _Pragma("unroll") for (int _i = 0; _i < 2; ++_i) \
        __builtin_amdgcn_global_load_lds((const unsigned*)((const char*)(gbase) + voffB[_i]), (LAS unsigned*)(lds + (bufoff) + ldsw + _i * 8192), 16, 0, 0); } while (0)
#define PG8_STAGEA(bufoff, arow_, tt, hf) do { const bool ab_ = (tt) < 16; \
        const char* gp_ = ab_ ? (const char*)M.YAB + ((size_t)(arow_) + (hf) * HALF) * 2048 + (size_t)(tt) * 128 : (const char*)M.YCD + ((size_t)(arow_) + (hf) * HALF) * 1536 + (size_t)((tt) - 16) * 128; \
        const unsigned o0_ = ab_ ? vA0[0] : vA1[0], o1_ = ab_ ? vA0[1] : vA1[1]; \
        __builtin_amdgcn_global_load_lds((const unsigned*)(gp_ + o0_), (LAS unsigned*)(lds + (bufoff) + ldsw), 16, 0, 0); \
        __builtin_amdgcn_global_load_lds((const unsigned*)(gp_ + o1_), (LAS unsigned*)(lds + (bufoff) + ldsw + 8192), 16, 0, 0); } while (0)
#define PG8_LDA(dst, b, h) do { _Pragma("unroll") for (int m = 0; m < 4; ++m) _Pragma("unroll") for (int k = 0; k < 2; ++k) dst[m][k] = *(const LAS bf16x8*)(lds + PG8_SA(b, h) + aoff + m * 2048 + k * 1024); } while (0)
#define PG8_LDB(dst, b, h) do { _Pragma("unroll") for (int n = 0; n < 2; ++n) _Pragma("unroll") for (int k = 0; k < 2; ++k) dst[n][k] = *(const LAS bf16x8*)(lds + PG8_SB(b, h) + boff + n * 2048 + k * 1024); } while (0)
#define PG8_MMA(ai, At, Bt) do { __builtin_amdgcn_s_setprio(1); _Pragma("unroll") for (int m = 0; m < 4; ++m) _Pragma("unroll") for (int n = 0; n < 2; ++n) _Pragma("unroll") for (int k = 0; k < 2; ++k) \
        acc[ai][0][m][n] = __builtin_amdgcn_mfma_f32_16x16x32_bf16(Bt[n][k], At[m][k], acc[ai][0][m][n], 0, 0, 0); __builtin_amdgcn_s_setprio(0); } while (0)
#define PG8_WAIT_V(n) asm volatile("s_waitcnt vmcnt(" #n ")" ::: "memory")
#define PG8_WAIT_L(n) asm volatile("s_waitcnt lgkmcnt(" #n ")" ::: "memory")
#define PG8_BAR __builtin_amdgcn_s_barrier()
#define PG8_SCHED __builtin_amdgcn_sched_barrier(0)
    int ui = 0;
    Unit cur = S.next(0);
    if (cur.arow < 0) return;
    f32x4 acc[2][2][4][2];
#pragma unroll
    for (int a = 0; a < 2; ++a)
#pragma unroll
        for (int b = 0; b < 2; ++b)
#pragma unroll
            for (int m = 0; m < 4; ++m)
#pragma unroll
                for (int n = 0; n < 2; ++n) acc[a][b][m][n] = (f32x4){0.f, 0.f, 0.f, 0.f};
    bf16x8 At[4][2], B0[2][2];
    const char* cB = (const char*)M.W4T + (size_t)cur.brow * LDB * 2;
    int carow = cur.arow;
    PG8_STAGEB(PG8_SB(0, 0), cB); PG8_STAGEA(PG8_SA(0, 0), carow, 0, 0); PG8_STAGEA(PG8_SA(0, 1), carow, 0, 1);
    if (wr == 1) PG8_BAR;
    PG8_WAIT_V(2); PG8_BAR;
    PG8_STAGEB(PG8_SB(1, 0), cB + kstep); PG8_STAGEA(PG8_SA(1, 0), carow, 1, 0);
    PG8_WAIT_V(4); PG8_BAR;
    for (;;) {
        const Unit nxt = S.next(ui + 1);
        const bool has_next = nxt.arow >= 0;
        const int narow = has_next ? nxt.arow : carow; const char* nB = has_next ? (const char*)M.W4T + (size_t)nxt.brow * LDB * 2 : cB;
#pragma unroll 1
        for (int t = 0; t < NT; t += 2) {
            const bool last = (t == NT - 2);
            const bool fold_it = (t == 6 || t == 14 || t == 20 || t == 26);
            u32x2 gq[2][4];
            if (fold_it) {
                const int seg = (t == 6) ? 0 : (t == 14) ? 1 : (t == 20) ? 2 : 3;
                int row0 = cur.arow + wr * 64 + fr, col = cur.pn * 128 + wc * 32 + 8 * fq;
                asm volatile("" : "+v"(row0), "+v"(col));
#pragma unroll
                for (int ai = 0; ai < 2; ++ai)
#pragma unroll
                    for (int m = 0; m < 4; ++m) gq[ai][m] = *(const u32x2*)(M.G + (size_t)(row0 + ai * 128 + m * 16) * PG_W + seg * 1024 + col);
            }
            const int t2 = last ? 0 : t + 2, t3 = t2 + 1; const int arow2 = last ? narow : carow;
            const char* b2 = last ? nB : cB + (size_t)(t + 2) * kstep; const char* b3 = b2 + kstep;
            PG8_LDB(B0, 0, 0); PG8_SCHED; PG8_LDA(At, 0, 0); PG8_STAGEA(PG8_SA(1, 1), carow, t + 1, 1);
            PG8_WAIT_V(6); PG8_WAIT_L(0); PG8_BAR; PG8_MMA(0, At, B0); PG8_BAR; PG8_SCHED;
            PG8_LDA(At, 0, 1); PG8_STAGEB(PG8_SB(0, 0), b2); PG8_STAGEA(PG8_SA(0, 0), arow2, t2, 0);
            PG8_WAIT_V(6); PG8_WAIT_L(0); PG8_BAR; PG8_MMA(1, At, B0); PG8_BAR; PG8_SCHED;
            PG8_LDB(B0, 1, 0); PG8_SCHED; PG8_LDA(At, 1, 0); PG8_STAGEA(PG8_SA(0, 1), arow2, t2, 1);
            PG8_WAIT_V(6); PG8_WAIT_L(0); PG8_BAR; PG8_MMA(0, At, B0); PG8_BAR; PG8_SCHED;
            PG8_LDA(At, 1, 1); PG8_STAGEB(PG8_SB(1, 0), b3); PG8_STAGEA(PG8_SA(1, 0), arow2, t3, 0);
            PG8_WAIT_V(6); PG8_WAIT_L(0); PG8_BAR; PG8_MMA(1, At, B0); PG8_BAR; PG8_SCHED;
            if (fold_it) {
                float rs[2][4];
#pragma unroll
                for (int ai = 0; ai < 2; ++ai)
#pragma unroll
                    for (int m = 0; m < 4; ++m) rs[ai][m] = 1.f / 255.f;
                if (t == 14) {
                    int rowq = cur.arow + wr * 64 + fr; asm volatile("" : "+v"(rowq));
                    f32x2 q2[2][4];
#pragma unroll
                    for (int ai = 0; ai < 2; ++ai)
#pragma unroll
                        for (int m = 0; m < 4; ++m) q2[ai][m] = *(const f32x2*)(M.ssq + 2 * (size_t)(rowq + ai * 128 + m * 16));
#pragma unroll
                    for (int ai = 0; ai < 2; ++ai)
#pragma unroll
                        for (int m = 0; m < 4; ++m) rs[ai][m] = __builtin_amdgcn_rsqf((q2[ai][m][0] + q2[ai][m][1]) * (1.f / 512.f) + RMS_EPS) * (1.f / 255.f); }
#pragma unroll
                for (int ai = 0; ai < 2; ++ai)
#pragma unroll
                    for (int m = 0; m < 4; ++m) { const u32x2 q = gq[ai][m]; const float sc = rs[ai][m];
#pragma unroll
                        for (int k = 0; k < 4; ++k) { const float g0 = (float)((q.x >> (8 * k)) & 255u) * sc, g1 = (float)((q.y >> (8 * k)) & 255u) * sc;
                            acc[ai][1][m][0][k] += acc[ai][0][m][0][k] * g0; acc[ai][1][m][1][k] += acc[ai][0][m][1][k] * g1; }
                        acc[ai][0][m][0] = (f32x4){0.f, 0.f, 0.f, 0.f}; acc[ai][0][m][1] = (f32x4){0.f, 0.f, 0.f, 0.f}; }
                if (t == NT - 2) {
                    int row0 = cur.arow + wr * 64 + fr, col = cur.pn * 128 + wc * 32 + 8 * fq;
                    asm volatile("" : "+v"(row0), "+v"(col));
#pragma unroll
                    for (int ai = 0; ai < 2; ++ai)
#pragma unroll
                        for (int m = 0; m < 4; ++m) { const f32x4 v0 = acc[ai][1][m][0], v1 = acc[ai][1][m][1];
                            u32x4 w; w.x = pk2(v0[0], v0[1]); w.y = pk2(v0[2], v0[3]); w.z = pk2(v1[0], v1[1]); w.w = pk2(v1[2], v1[3]);
                            *(u32x4*)(M.MRGB + (size_t)(row0 + ai * 128 + m * 16) * 1024 + col) = w;
                            acc[ai][1][m][0] = (f32x4){0.f, 0.f, 0.f, 0.f}; acc[ai][1][m][1] = (f32x4){0.f, 0.f, 0.f, 0.f}; } }
            }
        }
        if (!has_next) break;
        cur = nxt; carow = narow; cB = nB; ++ui;
    }
    PG8_WAIT_V(0);
    if (wr == 0) PG8_BAR;
    PG8_BAR;
#undef PG8_SA
#undef PG8_SB
#undef PG8_STAGEA
#undef PG8_STAGEB
#undef PG8_LDA
#undef PG8_LDB
#undef PG8_MMA
#undef PG8_WAIT_V
#undef PG8_WAIT_L
#undef PG8_BAR
#undef PG8_SCHED
}
}

using pg8::Unit;

struct EpiProj {
    static constexpr bool PERM = true;
    bf16_t* O0; int ld0; int split_pn; unsigned char* G8;
    DI void operator()(const f32x4 (&acc)[2][2][4][2], const Unit& u, int wr, int wc, int fr, int fq) const {
        const int row0 = u.arow + wr * 64 + fr;
        if (u.pn < split_pn) {
            const int col0 = u.pn * 256 + wc * 32 + 8 * fq;
#pragma unroll
            for (int ai = 0; ai < 2; ++ai)
#pragma unroll
                for (int m = 0; m < 4; ++m) { bf16_t* rowp = O0 + (size_t)(row0 + ai * 128 + m * 16) * ld0 + col0;
#pragma unroll
                    for (int bj = 0; bj < 2; ++bj) { const f32x4 v0 = acc[ai][bj][m][0], v1 = acc[ai][bj][m][1];
                        u32x4 w; w.x = pk2(v0[0], v0[1]); w.y = pk2(v0[2], v0[3]); w.z = pk2(v1[0], v1[1]); w.w = pk2(v1[2], v1[3]);
                        *(u32x4*)(rowp + bj * 128) = w; } }
        } else {
            const int col0 = (u.pn - split_pn) * 256 + wc * 32 + 8 * fq;
#pragma unroll
            for (int ai = 0; ai < 2; ++ai)
#pragma unroll
                for (int m = 0; m < 4; ++m) { unsigned char* rowp = G8 + (size_t)(row0 + ai * 128 + m * 16) * PG_W + col0;
#pragma unroll
                    for (int bj = 0; bj < 2; ++bj) { const f32x4 v0 = acc[ai][bj][m][0], v1 = acc[ai][bj][m][1]; unsigned q[8];
#pragma unroll
                        for (int k = 0; k < 4; ++k) { q[k] = (unsigned)(sigmoid_f(v0[k]) * 255.f + 0.5f); q[4 + k] = (unsigned)(sigmoid_f(v1[k]) * 255.f + 0.5f); }
                        u32x2 w; w.x = q[0] | (q[1] << 8) | (q[2] << 16) | (q[3] << 24); w.y = q[4] | (q[5] << 8) | (q[6] << 16) | (q[7] << 24);
                        *(u32x2*)(rowp + bj * 128) = w; } }
        }
    }
};

struct EpiWout {
    static constexpr bool PERM = true;
    bf16_t* Y;
    DI void operator()(const f32x4 (&acc)[2][2][4][2], const Unit& u, int wr, int wc, int fr, int fq) const {
        const int row0 = u.arow + wr * 64 + fr, col0 = u.pn * 256 + wc * 32 + 8 * fq;
#pragma unroll
        for (int ai = 0; ai < 2; ++ai)
#pragma unroll
            for (int m = 0; m < 4; ++m) { bf16_t* rowp = Y + (size_t)(row0 + ai * 128 + m * 16) * 1024 + col0;
#pragma unroll
                for (int bj = 0; bj < 2; ++bj) { const f32x4 v0 = acc[ai][bj][m][0], v1 = acc[ai][bj][m][1];
                    u32x4 w; w.x = pk2(v0[0], v0[1]); w.y = pk2(v0[2], v0[3]); w.z = pk2(v1[0], v1[1]); w.w = pk2(v1[2], v1[3]);
                    *(u32x4*)(rowp + bj * 128) = w; } }
    }
};

struct EpiGlu {
    static constexpr bool PERM = true;
    const bf16_t* YG; bf16_t* YC; const float* bglu;
    DI void operator()(const f32x4 (&acc)[2][2][4][2], const Unit& u, int wr, int wc, int fr, int fq) const {
        const int row0 = u.arow + wr * 64 + fr, col0 = u.pn * 256 + wc * 32 + 8 * fq;
#pragma unroll
        for (int bj = 0; bj < 2; ++bj) { const int col = col0 + bj * 128; if (u.pn == 1 && bj == 1) continue;
            const f32x4 b0 = *(const f32x4*)(bglu + col), b1 = *(const f32x4*)(bglu + col + 4);
#pragma unroll
            for (int ai = 0; ai < 2; ++ai) { u32x4 yw[4];
#pragma unroll
                for (int m = 0; m < 4; ++m) yw[m] = *(const u32x4*)(YG + (size_t)(row0 + ai * 128 + m * 16) * 384 + col);
#pragma unroll
                for (int m = 0; m < 4; ++m) { float y[8]; unpack8(yw[m], y);
                    const f32x4 a0 = acc[ai][bj][m][0] + b0, a1 = acc[ai][bj][m][1] + b1;
                    float o[8];
#pragma unroll
                    for (int k = 0; k < 4; ++k) { o[k] = y[k] * sigmoid_f(a0[k]); o[4 + k] = y[4 + k] * sigmoid_f(a1[k]); }
                    *(u32x4*)(YC + (size_t)(row0 + ai * 128 + m * 16) * 768 + col) = pack8(o); }
                __builtin_amdgcn_sched_barrier(0); } }
    }
};

struct EpiS5S {
    static constexpr bool PERM = true;
    float* S;
    DI void operator()(const f32x4 (&acc)[2][2][4][2], const Unit& u, int wr, int wc, int fr, int fq) const {
        const int m0 = u.pn * 256 + wr * 64 + fr, col0 = wc * 32 + 8 * fq;
#pragma unroll
        for (int ai = 0; ai < 2; ++ai)
#pragma unroll
            for (int m = 0; m < 4; ++m) { const int mm = m0 + ai * 128 + m * 16; if (u.pn == 2 && (ai == 1 || wr == 1)) continue;
                float* p = S + ((size_t)u.pm * 576 + mm) * 256 + col0;
#pragma unroll
                for (int bj = 0; bj < 2; ++bj) { *(f32x4*)(p + bj * 128) = acc[ai][bj][m][0]; *(f32x4*)(p + bj * 128 + 4) = acc[ai][bj][m][1]; } }
    }
};

struct EpiS5Y {
    static constexpr bool PERM = true;
    const bf16_t* AU; bf16_t* YG; const float* dsk;
    DI void operator()(const f32x4 (&acc)[2][2][4][2], const Unit& u, int wr, int wc, int fr, int fq) const {
        const int g = u.pm / 3, j = u.pm % 3;
        const int m0 = j * 256 + wr * 64 + fr, n0 = u.pn * 256 + wc * 32 + 8 * fq;
#pragma unroll
        for (int bj = 0; bj < 2; ++bj) { const int n = n0 + bj * 128, i = n >> 4, a0 = n & 15;
            const f32x4 d0 = *(const f32x4*)(dsk + g * 16 + a0), d1 = *(const f32x4*)(dsk + g * 16 + a0 + 4);
#pragma unroll
            for (int ai = 0; ai < 2; ++ai) { if (j == 2 && (ai == 1 || wr == 1)) continue;
                u32x4 uw[4];
#pragma unroll
                for (int m = 0; m < 4; ++m) uw[m] = *(const u32x4*)(AU + ((size_t)g * 576 + m0 + ai * 128 + m * 16) * 768 + n);
#pragma unroll
                for (int m = 0; m < 4; ++m) { const int mm = m0 + ai * 128 + m * 16; float uu[8]; unpack8(uw[m], uu);
                    const f32x4 v0 = acc[ai][bj][m][0], v1 = acc[ai][bj][m][1];
                    float o[8];
#pragma unroll
                    for (int k = 0; k < 4; ++k) { o[k] = gelu_tanh_f(v0[k] + d0[k] * uu[k]); o[4 + k] = gelu_tanh_f(v1[k] + d1[k] * uu[4 + k]); }
                    *(u32x4*)(YG + (size_t)(mm * 32 + i) * 384 + g * 16 + a0) = pack8(o); }
                __builtin_amdgcn_sched_barrier(0); } }
    }
};

struct EpiUp {
    static constexpr bool PERM = true;
    bf16_t* HID;
    DI void operator()(const f32x4 (&acc)[2][2][4][2], const Unit& u, int wr, int wc, int fr, int fq) const {
        const int row0 = u.arow + wr * 64 + fr, col0 = u.pn * 128 + wc * 32 + 8 * fq;
#pragma unroll
        for (int ai = 0; ai < 2; ++ai)
#pragma unroll
            for (int m = 0; m < 4; ++m) { const f32x4 g0 = acc[ai][0][m][0], g1 = acc[ai][0][m][1], u0 = acc[ai][1][m][0], u1 = acc[ai][1][m][1];
                float o[8];
#pragma unroll
                for (int k = 0; k < 4; ++k) { o[k] = silu_f(g0[k]) * u0[k]; o[4 + k] = silu_f(g1[k]) * u1[k]; }
                *(u32x4*)(HID + (size_t)(row0 + ai * 128 + m * 16) * 1024 + col0) = pack8(o); }
    }
};

struct EpiDown {
    static constexpr bool PERM = true;
    bf16_t* YE; const float* GV;
    DI void operator()(const f32x4 (&acc)[2][2][4][2], const Unit& u, int wr, int wc, int fr, int fq) const {
        const int row0 = u.arow + wr * 64 + fr, col0 = u.pn * 256 + wc * 32 + 8 * fq;
#pragma unroll
        for (int ai = 0; ai < 2; ++ai)
#pragma unroll
            for (int m = 0; m < 4; ++m) { const int row = row0 + ai * 128 + m * 16; const float gv = GV[row];
#pragma unroll
                for (int bj = 0; bj < 2; ++bj) { const f32x4 v0 = acc[ai][bj][m][0] * gv, v1 = acc[ai][bj][m][1] * gv;
                    u32x4 w; w.x = pk2(v0[0], v0[1]); w.y = pk2(v0[2], v0[3]); w.z = pk2(v1[0], v1[1]); w.w = pk2(v1[2], v1[3]);
                    *(u32x4*)(YE + (size_t)row * 1024 + col0 + bj * 128) = w; } }
    }
};

DI Unit mk_unit(int arow, int brow, int pm, int pn) { Unit u; u.arow = arow; u.brow = brow; u.pm = pm; u.pn = pn; return u; }
struct RowSkipOrder {
    int nN, G, c, skipctx, keep_lo, keep_hi, nmain, total, bstep;
    DI void init(int N, int G_, int c_, int skipctx_, int keep_lo_, int keep_hi_, int bstep_ = 256) { bstep = bstep_; nN = N / bstep_; G = G_; c = c_; skipctx = skipctx_; keep_lo = keep_lo_; keep_hi = keep_hi_;
        nmain = (skipctx ? 64 : 72) * nN; total = nmain + (skipctx ? 8 * (keep_hi - keep_lo) : 0); }
    DI Unit next(int i) const {
        const int L0 = i * G + c; if (L0 >= total) return mk_unit(-1, 0, 0, 0);
        const int q = total / 8, r = total % 8, xcd = L0 % 8, off = L0 / 8;
        const int L = (xcd < r ? xcd * (q + 1) : r * (q + 1) + (xcd - r) * q) + off;
        const int nig = 8 * nN, gid = L / nig, rr = L % nig, lt = gid * 8 + (rr % 8);
        const int pm_main = skipctx ? ((lt / 8) * 9 + 1 + (lt % 8)) : lt, pn_main = rr / 8;
        const int Lc = L - nmain, pm_ctx = (Lc % 8) * 9, pn_ctx = keep_lo + Lc / 8;
        const bool main = L < nmain;
        const int pm = main ? pm_main : pm_ctx, pn = main ? pn_main : pn_ctx;
        return mk_unit(pm * 256, pn * bstep, pm, pn);
    }
};
DI int xcd_remap(int L0, int total) { const int q = total / 8, r = total % 8, xcd = L0 % 8, off = L0 / 8; return (xcd < r ? xcd * (q + 1) : r * (q + 1) + (xcd - r) * q) + off; }
struct MergeOrder {
    int G, c, skipctx, total;
    DI void init(int G_, int c_, int skipctx_) { G = G_; c = c_; skipctx = skipctx_; total = (skipctx ? 64 : 72) * 8; }
    DI Unit next(int i) const {
        const int L0 = i * G + c; if (L0 >= total) return mk_unit(-1, 0, 0, 0);
        const int L = xcd_remap(L0, total), lt = L >> 3, pn = L & 7, pm = skipctx ? ((lt / 8) * 9 + 1 + (lt % 8)) : lt;
        return mk_unit(pm * 256, pn * 128, pm, pn);
    }
};
struct OrderS5S { int G, c; DI Unit next(int i) const { const int L = i * G + c; if (L >= 72) return mk_unit(-1, 0, 0, 0); const int g = L / 3, j = L % 3; return mk_unit(g * 576 + j * 256, g * 256, g, j); } };
struct OrderS5Y { int G, c; DI Unit next(int i) const { const int L = i * G + c; if (L >= 144) return mk_unit(-1, 0, 0, 0); const int g = L / 6, r = L % 6, j = r >> 1, nh = r & 1;
    return mk_unit(g * 576 + j * 256, g * 512 + nh * 256, g * 3 + j, nh); } };
struct OrderUp { int G, c, nJ; DI Unit next(int i) const { const int L0 = i * G + c, total = 16 * nJ * 8; if (L0 >= total) return mk_unit(-1, 0, 0, 0); const int L = xcd_remap(L0, total), n = L & 7, t = L >> 3, jt = t % nJ, e = t / nJ;
    return mk_unit(e * EROWS + jt * 256, e * 2048 + n * 256, e, n); } };
struct OrderDown { int G, c, nJ; DI Unit next(int i) const { const int L0 = i * G + c, total = 16 * nJ * 4; if (L0 >= total) return mk_unit(-1, 0, 0, 0); const int L = xcd_remap(L0, total), n = L & 3, t = L >> 2, jt = t % nJ, e = t / nJ;
    return mk_unit(e * EROWS + jt * 256, e * 1024 + n * 256, e, n); } };

struct Frame {
    LAS unsigned char* lds;
    int tid, lane, wave, G, vcu, gw, NGW, bid;
};

template <class DstRow>
DI void tr_item(const float* __restrict__ W, int ldw, int nvalid, int nstore, int K, bf16_t* __restrict__ WT, int k0, int n0, const DstRow& drow, const float* __restrict__ kscale, LAS float* scr  , int lane, int kofs = 0) {
    const int c4 = (lane & 15) * 4, r0 = lane >> 4;
    f32x4 v[16];
#pragma unroll
    for (int i = 0; i < 16; ++i) { const int kk = 4 * i + r0; v[i] = (n0 + c4 < nvalid) ? *(const f32x4*)(W + (size_t)(k0 + kk) * ldw + n0 + c4) : (f32x4){0.f, 0.f, 0.f, 0.f}; }
#pragma unroll
    for (int i = 0; i < 16; ++i) { const int kk = 4 * i + r0; f32x4 x = v[i]; if (kscale) x = x * kscale[k0 + kk];
        LAS float* d = scr + kk * 65 + c4; d[0] = x[0]; d[1] = x[1]; d[2] = x[2]; d[3] = x[3]; }
    LDS_WAIT(); asm volatile("" ::: "memory");
    const int c = lane & 7;
#pragma unroll
    for (int j = 0; j < 8; ++j) { const int n = (lane >> 3) + 8 * j; const LAS float* s = scr + (8 * c) * 65 + n;
        u32x4 o; o.x = pk2(s[0 * 65], s[1 * 65]); o.y = pk2(s[2 * 65], s[3 * 65]); o.z = pk2(s[4 * 65], s[5 * 65]); o.w = pk2(s[6 * 65], s[7 * 65]);
        if (n0 + n < nstore) *(u32x4*)(WT + (size_t)drow(n0 + n) * K + kofs + k0 + 8 * c) = o; }
    LDS_WAIT(); asm volatile("" ::: "memory");
}
struct DrIdent { int off; DI int operator()(int n) const { return off + n; } };
struct DrWin { DI int operator()(int n) const { return n < C_G ? n : n + (PA_W - C_G); } };
struct DrGU { int base; DI int operator()(int f) const { return base + (f >> 7) * 256 + (f & 127); } };

struct LayerIn {
    const float *w_in, *q_norm_g, *k_norm_g, *ssd_conv_w, *ssd_conv_b, *ssd_dt_bias, *ssd_a_log, *ssd_d, *ssd_norm_g;
    const float *s5_lre, *s5_lim, *s5_lstep, *s5_bre, *s5_bim, *s5_cre, *s5_cim, *s5_d, *s5_wglu, *s5_bglu, *sc_conv_w;
    const float *w_br_attn, *w_br_ssd, *w_br_s5, *w_br_sc, *w_out, *w_router, *w_gate, *w_up, *w_down, *norm_mix_g, *norm_ffn_g;
};

DI void prep_small_weights(const Frame& F, const LayerIn& P, unsigned char* ws, int part = 0, int first_wg = 0) {
    if ((int)blockIdx.x < first_wg) return;
    LAS float* scr = (LAS float*)(F.lds + F.wave * 16896);
    bf16_t* WIN = (bf16_t*)(ws + W_WIN);
    constexpr int NB_WIN = (NIN + 63) / 64;
    constexpr int I_WIN = 16 * NB_WIN, I_PAD = 62, I_BA = 8 * 16, I_BB = 8 * 16, I_BC = 6 * 16, I_BD = 6 * 16, I_OUT = 16 * 16, I_GLU = 6 * 8;
    constexpr int NIT = I_WIN + I_PAD + I_BA + I_BB + I_BC + I_BD + I_OUT + I_GLU;
    for (int it = ((int)blockIdx.x - first_wg) * NWAVES + F.wave; it < NIT; it += (F.G - first_wg) * NWAVES) {
        int r = it;
        { const bool is_out = (it >= NIT - I_GLU - I_OUT) && (it < NIT - I_GLU); if ((part == 1 && is_out) || (part == 2 && !is_out)) continue; }
        if (r < I_WIN) { const int kb = r / NB_WIN, nb = r % NB_WIN; tr_item(P.w_in, NIN, NIN, NIN, 1024, WIN, kb * 64, nb * 64, DrWin{}, nullptr, scr, F.lane); continue; } r -= I_WIN;
        if (r < I_PAD) {
#pragma unroll
            for (int j = 0; j < 8; ++j) { const int idx = j * 64 + F.lane, row = C_G + r * 4 + (idx >> 7), ch = idx & 127; *(u32x4*)(WIN + (size_t)row * 1024 + ch * 8) = (u32x4){0u, 0u, 0u, 0u}; }
            continue; } r -= I_PAD;
        if (r < I_BA) { tr_item(P.w_br_attn, 1024, 1024, 1024, 1792, (bf16_t*)(ws + W_BR4), (r / 16) * 64, (r % 16) * 64, DrIdent{0}, nullptr, scr, F.lane, 0); continue; } r -= I_BA;
        if (r < I_BB) { tr_item(P.w_br_ssd, 1024, 1024, 1024, 1792, (bf16_t*)(ws + W_BR4), (r / 16) * 64, (r % 16) * 64, DrIdent{0}, P.ssd_norm_g, scr, F.lane, 512); continue; } r -= I_BB;
        if (r < I_BC) { tr_item(P.w_br_s5, 1024, 1024, 1024, 1792, (bf16_t*)(ws + W_BR4), (r / 16) * 64, (r % 16) * 64, DrIdent{0}, nullptr, scr, F.lane, 1024); continue; } r -= I_BC;
        if (r < I_BD) { tr_item(P.w_br_sc, 1024, 1024, 1024, 1792, (bf16_t*)(ws + W_BR4), (r / 16) * 64, (r % 16) * 64, DrIdent{0}, nullptr, scr, F.lane, 1408); continue; } r -= I_BD;
        if (r < I_OUT) { tr_item(P.w_out, 1024, 1024, 1024, 1024, (bf16_t*)(ws + W_OUT), (r / 16) * 64, (r % 16) * 64, DrIdent{0}, nullptr, scr, F.lane); continue; } r -= I_OUT;
        tr_item(P.s5_wglu, 384, 384, 512, 384, (bf16_t*)(ws + W_GLU), (r / 8) * 64, (r % 8) * 64, DrIdent{0}, nullptr, scr, F.lane);
    }
}
DI void prep_expert_weights(const Frame& F, const LayerIn& P, unsigned char* ws, int first_wg, int item_lo, int item_hi, bf16_t* wgu = nullptr) {
    if ((int)blockIdx.x < first_wg) return;
    LAS float* scr = (LAS float*)(F.lds + F.wave * 16896);
    if (!wgu) wgu = (bf16_t*)(ws + WS_WGU);
    constexpr int PER = 16 * 16;
    for (int it = item_lo + ((int)blockIdx.x - first_wg) * NWAVES + F.wave; it < item_hi; it += (F.G - first_wg) * NWAVES) {
        const int which = it / (16 * PER), r = it % (16 * PER), e = r / PER, q = r % PER, k0 = (q / 16) * 64, n0 = (q % 16) * 64;
        if (which == 0) tr_item(P.w_gate + (size_t)e * 1024 * 1024, 1024, 1024, 1024, 1024, wgu, k0, n0, DrGU{e * 2048}, nullptr, scr, F.lane);
        else if (which == 1) tr_item(P.w_up + (size_t)e * 1024 * 1024, 1024, 1024, 1024, 1024, wgu, k0, n0, DrGU{e * 2048 + 128}, nullptr, scr, F.lane);
        else tr_item(P.w_down + (size_t)e * 1024 * 1024, 1024, 1024, 1024, 1024, (bf16_t*)(ws + WS_WD), k0, n0, DrIdent{e * 1024}, nullptr, scr, F.lane);
    }
}
constexpr int EXPERT_W_ITEMS = 3 * 16 * 16 * 16;

DI void prep_mod(const Frame& F, const float* __restrict__ c, const float* __restrict__ c_ctx, const float* __restrict__ w_mod, const float* __restrict__ b_mod, float* __restrict__ MOD, int first_wg) {
    const int wgi = (int)blockIdx.x - first_wg, nwg = F.G - first_wg;
    if (wgi < 0 || wgi >= 2 * 96) return;
    LAS float* sc = (LAS float*)F.lds;
    LAS float* red = sc + 9 * 1024;
    for (int o = F.tid; o < 9 * 1024; o += 512) { const float cv = (o < 8 * 1024) ? c[o] : c_ctx[o - 8 * 1024]; sc[o] = silu_f(cv); }
    __syncthreads();
    for (int it = wgi; it < 2 * 96; it += nwg) {
        const int l = it / 96, cb = it % 96, n = cb * 64 + F.lane;
        const float* W = w_mod + (size_t)l * 1024 * 6144;
        float acc[9];
#pragma unroll
        for (int r = 0; r < 9; ++r) acc[r] = 0.f;
        const int kbeg = F.wave * 128;
#pragma unroll 1
        for (int k8 = 0; k8 < 128; k8 += 16) { float w[16];
#pragma unroll
            for (int j = 0; j < 16; ++j) w[j] = W[(size_t)(kbeg + k8 + j) * 6144 + n];
#pragma unroll
            for (int j = 0; j < 16; ++j)
#pragma unroll
                for (int r = 0; r < 9; ++r) acc[r] += sc[r * 1024 + kbeg + k8 + j] * w[j]; }
#pragma unroll
        for (int r = 0; r < 9; ++r) red[(F.wave * 9 + r) * 64 + F.lane] = acc[r];
        __syncthreads();
        for (int o = F.tid; o < 9 * 64; o += 512) { const int r = o >> 6, ln = o & 63; float s = 0.f;
#pragma unroll
            for (int w = 0; w < 8; ++w) s += red[(w * 9 + r) * 64 + ln];
            MOD[((size_t)l * 9 + r) * 6144 + cb * 64 + ln] = s + b_mod[l * 6144 + cb * 64 + ln]; }
        __syncthreads();
    }
    __syncthreads();
}
DI void prep_rope(const Frame& F, float* ROPE, int first_wg) {
    if ((int)blockIdx.x < first_wg) return;
    for (int idx = ((int)blockIdx.x - first_wg) * 512 + F.tid; idx < 2048 * 32; idx += (F.G - first_wg) * 512) {
        const int t = idx >> 5, j = idx & 31, i = j & 15;
        const float inv = powf(10000.f, -(float)(2 * i) / 32.f);
        const float pos = (j < 16) ? (float)(t >> 6) : (float)(t & 63);
        const float a = pos * inv;
        ROPE[t * 64 + j] = cosf(a); ROPE[t * 64 + 32 + j] = sinf(a);
    }
}

DI void prep_s5(const Frame& F, const LayerIn& P, unsigned char* ws, int wg_off = 0) {
    const int wgi = (int)blockIdx.x - wg_off;
    if (wgi < 0 || wgi >= 96) return;
    LAS float* pw = (LAS float*)F.lds;
    LAS float* bb = pw + 8448;
    LAS float* Kt = bb + 4096;
    LAS float* cc = Kt + 16896;
    LAS float* prm = cc + 2048;
    for (int it = wgi; it < 96; it += F.G) {
        const int g = it >> 2, qt = it & 3;
        for (int o = F.tid; o < 2048; o += 512) cc[o] = (o < 1024) ? P.s5_cre[(size_t)g * 1024 + o] : P.s5_cim[(size_t)g * 1024 + o - 1024];
        for (int o = F.tid; o < 2048; o += 512) prm[264 + o] = (o < 1024) ? P.s5_bre[(size_t)g * 1024 + o] : P.s5_bim[(size_t)g * 1024 + o - 1024];
        if (F.tid < 256) { const int d = (F.tid >> 6) & 1, p = F.tid & 63; prm[F.tid] = (F.tid < 128) ? P.s5_lre[(d * 24 + g) * 64 + p] : P.s5_lim[(d * 24 + g) * 64 + p]; }
        if (F.tid < 2) prm[256 + F.tid] = __expf(P.s5_lstep[F.tid * 24 + g]);
        __syncthreads();
        if (F.tid < 128) { const int d = F.tid >> 6, p = F.tid & 63;
            const float step = prm[256 + d], lr = prm[d * 64 + p], li = prm[128 + d * 64 + p];
            const float th = li * step, sh = sinf(0.5f * th);
            const float mag = expf(lr * step), abi = mag * sinf(th);
            const float nr = expm1f(lr * step) - 2.f * mag * sh * sh, ni = abi;
            const float den = lr * lr + li * li;
            const float cr = (nr * lr + ni * li) / den, ci = (ni * lr - nr * li) / den;
#pragma unroll
            for (int j = 0; j < 16; ++j) { const float br = prm[264 + p * 16 + j], bi = prm[264 + 1024 + p * 16 + j];
                bb[((d * 64 + p) * 16 + j) * 2 + 0] = cr * br - ci * bi; bb[((d * 64 + p) * 16 + j) * 2 + 1] = cr * bi + ci * br; } }
        for (int o = F.tid; o < 2 * 64 * 33; o += 512) { const int dp = o / 33, tau = o % 33, d = dp >> 6, p = dp & 63;
            const float step = prm[256 + d], lr = prm[d * 64 + p], li = prm[128 + d * 64 + p];
            const float m = expf(lr * step * (float)tau), a = li * step * (float)tau;
            pw[o * 2 + 0] = m * cosf(a); pw[o * 2 + 1] = m * sinf(a); }
        __syncthreads();
        for (int o = F.tid; o < 1024; o += 512) { const int d = o >> 9, a = (o >> 5) & 15, tau = o & 31; float s[16];
#pragma unroll
            for (int b_ = 0; b_ < 16; ++b_) s[b_] = 0.f;
            for (int p = 0; p < 64; ++p) { const float cre = cc[a * 64 + p], cim = cc[1024 + a * 64 + p];
                const f32x2 lp = *(const LAS f32x2*)(pw + ((d * 64 + p) * 33 + tau) * 2);
                const float wr_ = cre * lp[0] - cim * lp[1], wi_ = cre * lp[1] + cim * lp[0];
                const LAS f32x4* bp = (const LAS f32x4*)(bb + (d * 64 + p) * 32);
#pragma unroll
                for (int q4 = 0; q4 < 8; ++q4) { const f32x4 t = bp[q4]; s[2 * q4] += wr_ * t[0] - wi_ * t[1]; s[2 * q4 + 1] += wr_ * t[2] - wi_ * t[3]; } }
#pragma unroll
            for (int b_ = 0; b_ < 16; ++b_) Kt[((d * 16 + a) * 16 + b_) * 33 + tau] = s[b_]; }
        __syncthreads();
        bf16_t* TQ = (bf16_t*)(ws + W_TQ) + (size_t)g * 512 * 768;
        for (int o = F.tid; o < 128 * 64; o += 512) { const int row = qt * 128 + (o >> 6), ch = o & 63, i = row >> 4, a = row & 15, b0 = (ch >> 5) * 8, j = ch & 31; float v[8];
#pragma unroll
            for (int k = 0; k < 8; ++k) { float s_ = 0.f;
                if (j <= i) s_ += Kt[((0 * 16 + a) * 16 + b0 + k) * 33 + (i - j)];
                if (j >= i) s_ += Kt[((1 * 16 + a) * 16 + b0 + k) * 33 + (j - i)];
                v[k] = s_; }
            *(u32x4*)(TQ + (size_t)row * 768 + j * 16 + b0) = pack8(v); }
        for (int o = F.tid; o < 128 * 128; o += 512) { const int row = qt * 128 + (o >> 7), dp = o & 127, d = dp >> 6, p = dp & 63, i = row >> 4, a = row & 15; const int tau = d == 0 ? (i + 1) : (32 - i);
            const float cre = cc[a * 64 + p], cim = cc[1024 + a * 64 + p];
            const f32x2 lp = *(const LAS f32x2*)(pw + ((d * 64 + p) * 33 + tau) * 2);
            TQ[(size_t)row * 768 + 512 + d * 128 + p] = (bf16_t)f2bf(cre * lp[0] - cim * lp[1]);
            TQ[(size_t)row * 768 + 512 + d * 128 + 64 + p] = (bf16_t)f2bf(-(cre * lp[1] + cim * lp[0])); }
        bf16_t* PP = (bf16_t*)(ws + W_P) + (size_t)g * 256 * 512;
        for (int o = F.tid; o < 2 * 16 * 32; o += 512) { const int d = o >> 9, p = qt * 16 + ((o >> 5) & 15), j = o & 31; const int tau = d == 0 ? (31 - j) : j;
            const f32x2 lp = *(const LAS f32x2*)(pw + ((d * 64 + p) * 33 + tau) * 2);
            const LAS f32x4* bp = (const LAS f32x4*)(bb + (d * 64 + p) * 32);
            float vr[16], vi[16];
#pragma unroll
            for (int q4 = 0; q4 < 8; ++q4) { const f32x4 t = bp[q4];
                vr[2 * q4] = lp[0] * t[0] - lp[1] * t[1]; vi[2 * q4] = lp[0] * t[1] + lp[1] * t[0];
                vr[2 * q4 + 1] = lp[0] * t[2] - lp[1] * t[3]; vi[2 * q4 + 1] = lp[0] * t[3] + lp[1] * t[2]; }
            float h0[8], h1[8];
#pragma unroll
            for (int k = 0; k < 8; ++k) { h0[k] = vr[k]; h1[k] = vr[8 + k]; }
            bf16_t* pr = PP + (size_t)(d * 128 + p) * 512 + j * 16;
            *(u32x4*)pr = pack8(h0); *(u32x4*)(pr + 8) = pack8(h1);
#pragma unroll
            for (int k = 0; k < 8; ++k) { h0[k] = vi[k]; h1[k] = vi[8 + k]; }
            bf16_t* pi = PP + (size_t)(d * 128 + 64 + p) * 512 + j * 16;
            *(u32x4*)pi = pack8(h0); *(u32x4*)(pi + 8) = pack8(h1); }
        __syncthreads();
    }
}

struct RowCtx { int R, b, p, isctx, mrow; };
DI RowCtx row_ctx(int R) { RowCtx r; r.R = R; r.b = R / PB; r.p = R - r.b * PB; r.isctx = r.p < CTXL; r.mrow = r.isctx ? 8 : r.b; return r; }
struct WaveRows { int b, pa, pb; };
DI WaveRows wave_rows(int wg, int nwb, int p0, int np, int wave) {
    const int b = wg / nwb, j = wg - b * nwb;
    const int lo = p0 + (j * np) / nwb, hi = p0 + ((j + 1) * np) / nwb, per = (hi - lo + NWAVES - 1) / NWAVES;
    WaveRows w; w.b = b; w.pa = min(lo + wave * per, hi); w.pb = min(w.pa + per, hi); return w;
}
DI const float* stream_in(const float* x_in, const float* ctx_in, int b, int p) { return (p < CTXL) ? ctx_in + ((size_t)b * CTXL + p) * 1024 : x_in + ((size_t)b * SEQ + (p - CTXL)) * 1024; }
template <int N> DI void wave_sum_n(float (&v)[N]) {
#pragma unroll
    for (int o = 1; o < 64; o <<= 1) {
        float t[N];
#pragma unroll
        for (int k = 0; k < N; ++k) t[k] = __shfl_xor(v[k], o);
#pragma unroll
        for (int k = 0; k < N; ++k) v[k] += t[k]; }
}
DI float row_ssq(const f32x4 (&x)[4]) {
    float ss = 0.f;
#pragma unroll
    for (int j = 0; j < 4; ++j) ss += (x[j][0] * x[j][0] + x[j][1] * x[j][1]) + (x[j][2] * x[j][2] + x[j][3] * x[j][3]);
    return ss;
}
DI void row_store_bf16(int lane, const f32x4 (&h)[4], bf16_t* dst) {
#pragma unroll
    for (int j = 0; j < 4; ++j) { u32x2 w; w.x = pk2(h[j][0], h[j][1]); w.y = pk2(h[j][2], h[j][3]); *(u32x2*)(dst + j * 256 + 4 * lane) = w; }
}
DI void add_gated_bf16(f32x4 (&x)[4], const u32x2 (&y)[4], const LAS float* gate, int lane) {
#pragma unroll
    for (int j = 0; j < 4; ++j) { const f32x4 g = *(const LAS f32x4*)(gate + j * 256 + 4 * lane);
        x[j][0] += g[0] * bflo(y[j].x); x[j][1] += g[1] * bfhi(y[j].x); x[j][2] += g[2] * bflo(y[j].y); x[j][3] += g[3] * bfhi(y[j].y); }
}
DI __amdgpu_buffer_rsrc_t ye_resource(const bf16_t* YE) { return __builtin_amdgcn_make_buffer_rsrc((void*)YE, 0, 16 * EROWS * 2048, 0x00020000); }
DI unsigned combine_issue(const __amdgpu_buffer_rsrc_t rs, const int myinv, const int lane, u32x2 (&ye)[4][4]) {
    unsigned mask = (unsigned)__ballot(myinv >= 0) & 0xFFFFu;
#pragma unroll
    for (int s = 0; s < 4; ++s) { const bool has = mask != 0u; const int e = has ? __builtin_ctz(mask) : 0; mask &= mask - 1u;
        const int er = __builtin_amdgcn_readlane(myinv, e);
        const unsigned off = has ? (unsigned)er * 2048u + (unsigned)lane * 8u : 0x80000000u;
#pragma unroll
        for (int j = 0; j < 4; ++j) ye[s][j] = __builtin_amdgcn_raw_buffer_load_b64(rs, off + j * 512, 0, 0); }
    return mask;
}
DI void combine_add(f32x4 (&x)[4], const u32x2 (&ye)[4][4], unsigned rest, const int myinv, const bf16_t* YE, const LAS float* gate, int lane) {
    f32x4 s[4];
#pragma unroll
    for (int j = 0; j < 4; ++j) { s[j][0] = (bflo(ye[0][j].x) + bflo(ye[1][j].x)) + (bflo(ye[2][j].x) + bflo(ye[3][j].x)); s[j][1] = (bfhi(ye[0][j].x) + bfhi(ye[1][j].x)) + (bfhi(ye[2][j].x) + bfhi(ye[3][j].x));
        s[j][2] = (bflo(ye[0][j].y) + bflo(ye[1][j].y)) + (bflo(ye[2][j].y) + bflo(ye[3][j].y)); s[j][3] = (bfhi(ye[0][j].y) + bfhi(ye[1][j].y)) + (bfhi(ye[2][j].y) + bfhi(ye[3][j].y)); }
    while (rest) { const int e = __builtin_ctz(rest); rest &= rest - 1u; const int er = __builtin_amdgcn_readlane(myinv, e); const bf16_t* yr = YE + (size_t)er * 1024 + 4 * lane;
#pragma unroll
        for (int j = 0; j < 4; ++j) { const u32x2 w = *(const u32x2*)(yr + j * 256); s[j][0] += bflo(w.x); s[j][1] += bfhi(w.x); s[j][2] += bflo(w.y); s[j][3] += bfhi(w.y); } }
#pragma unroll
    for (int j = 0; j < 4; ++j) x[j] += *(const LAS f32x4*)(gate + j * 256 + 4 * lane) * s[j];
}

template <bool COMBINE, int RPW>
DI void phase_norm1(const Frame& F, int layer, const float* x_in, const float* ctx_in, float* X, bf16_t* H1, const float* MOD, const float* gmix, const int* INV, const bf16_t* YE, const bf16_t* Y, int first_wg) {
    if ((int)blockIdx.x < first_wg) return;
    const WaveRows wr = wave_rows((int)blockIdx.x - first_wg, (F.G - first_wg) / NB, 0, PB, F.wave);
    LAS float* ml = (LAS float*)F.lds;
    { const float* modl = MOD + (size_t)layer * 9 * 6144; const float* modp = MOD + (size_t)(COMBINE ? layer - 1 : 0) * 9 * 6144;
      for (int idx = F.tid; idx < 2048; idx += NWAVES * 64) { const int set = idx >> 10, c = idx & 1023; const size_t mo = (size_t)(set ? 8 : wr.b) * 6144;
          if (COMBINE) { ml[(set * 4 + 0) * 1024 + c] = modp[mo + 2 * 1024 + c]; ml[(set * 4 + 1) * 1024 + c] = modp[mo + 5 * 1024 + c]; }
          ml[(set * 4 + 2) * 1024 + c] = gmix[c] * (1.f + modl[mo + 1024 + c]); ml[(set * 4 + 3) * 1024 + c] = modl[mo + c]; } }
    __syncthreads();
    const __amdgpu_buffer_rsrc_t rs = ye_resource(YE);
    for (int p = wr.pa; p < wr.pb; p += RPW) {
        f32x4 x[RPW][4]; u32x2 y[RPW][4]; int inv[RPW]; size_t Rk[RPW]; const LAS float* mk[RPW];
#pragma unroll
        for (int k = 0; k < RPW; ++k) { const int pk = min(p + k, wr.pb - 1); Rk[k] = (size_t)wr.b * PB + pk; mk[k] = ml + (pk < CTXL ? 4096 : 0);
            const float* src = stream_in(x_in, ctx_in, wr.b, pk);
#pragma unroll
            for (int j = 0; j < 4; ++j) x[k][j] = *(const f32x4*)(src + j * 256 + 4 * F.lane);
            if (COMBINE) { inv[k] = (F.lane < 16) ? INV[Rk[k] * 16 + F.lane] : -1;
#pragma unroll
                for (int j = 0; j < 4; ++j) y[k][j] = *(const u32x2*)(Y + Rk[k] * 1024 + j * 256 + 4 * F.lane); } }
        if (COMBINE) {
            u32x2 ye[RPW][4][4]; unsigned rest[RPW];
#pragma unroll
            for (int k = 0; k < RPW; ++k) rest[k] = combine_issue(rs, inv[k], F.lane, ye[k]);
#pragma unroll
            for (int k = 0; k < RPW; ++k) add_gated_bf16(x[k], y[k], mk[k], F.lane);
#pragma unroll
            for (int k = 0; k < RPW; ++k) { combine_add(x[k], ye[k], rest[k], inv[k], YE, mk[k] + 1024, F.lane);
#pragma unroll
                for (int j = 0; j < 4; ++j) *(f32x4*)(X + Rk[k] * 1024 + j * 256 + 4 * F.lane) = x[k][j]; }
        }
        float ss[RPW];
#pragma unroll
        for (int k = 0; k < RPW; ++k) ss[k] = row_ssq(x[k]);
        wave_sum_n<RPW>(ss);
#pragma unroll
        for (int k = 0; k < RPW; ++k) { const float rstd = __builtin_amdgcn_rsqf(ss[k] * (1.f / 1024.f) + RMS_EPS);
#pragma unroll
            for (int j = 0; j < 4; ++j) x[k][j] = x[k][j] * rstd * *(const LAS f32x4*)(mk[k] + 2048 + j * 256 + 4 * F.lane) + *(const LAS f32x4*)(mk[k] + 3072 + j * 256 + 4 * F.lane);
            row_store_bf16(F.lane, x[k], H1 + Rk[k] * 1024); }
    }
    __syncthreads();
}
template <int RPW>
DI void phase_final(const Frame& F, const float* X, float* out, const float* MOD, const float* gfin, const int* INV, const bf16_t* YE, const bf16_t* Y) {
    const WaveRows wr = wave_rows((int)blockIdx.x, F.G / NB, CTXL, SEQ, F.wave);
    LAS float* ml = (LAS float*)F.lds;
    for (int c = F.tid; c < 1024; c += NWAVES * 64) { const float* mr = MOD + (size_t)(9 + wr.b) * 6144; ml[c] = mr[2 * 1024 + c]; ml[1024 + c] = mr[5 * 1024 + c]; ml[2048 + c] = gfin[c]; }
    __syncthreads();
    const __amdgpu_buffer_rsrc_t rs = ye_resource(YE);
    for (int p = wr.pa; p < wr.pb; p += RPW) {
        f32x4 x[RPW][4]; u32x2 y[RPW][4]; int inv[RPW]; size_t Rk[RPW];
#pragma unroll
        for (int k = 0; k < RPW; ++k) { const int pk = min(p + k, wr.pb - 1); Rk[k] = (size_t)wr.b * PB + pk;
#pragma unroll
            for (int j = 0; j < 4; ++j) x[k][j] = *(const f32x4*)(X + Rk[k] * 1024 + j * 256 + 4 * F.lane);
            inv[k] = (F.lane < 16) ? INV[Rk[k] * 16 + F.lane] : -1;
#pragma unroll
            for (int j = 0; j < 4; ++j) y[k][j] = *(const u32x2*)(Y + Rk[k] * 1024 + j * 256 + 4 * F.lane); }
        u32x2 ye[RPW][4][4]; unsigned rest[RPW];
#pragma unroll
        for (int k = 0; k < RPW; ++k) rest[k] = combine_issue(rs, inv[k], F.lane, ye[k]);
#pragma unroll
        for (int k = 0; k < RPW; ++k) add_gated_bf16(x[k], y[k], ml, F.lane);
#pragma unroll
        for (int k = 0; k < RPW; ++k) combine_add(x[k], ye[k], rest[k], inv[k], YE, ml + 1024, F.lane);
        float ss[RPW];
#pragma unroll
        for (int k = 0; k < RPW; ++k) ss[k] = row_ssq(x[k]);
        wave_sum_n<RPW>(ss);
#pragma unroll
        for (int k = 0; k < RPW; ++k) { const float rstd = __builtin_amdgcn_rsqf(ss[k] * (1.f / 1024.f) + RMS_EPS);
            float* o = out + ((size_t)wr.b * SEQ + (min(p + k, wr.pb - 1) - CTXL)) * 1024;
#pragma unroll
            for (int j = 0; j < 4; ++j) *(f32x4*)(o + j * 256 + 4 * F.lane) = x[k][j] * rstd * *(const LAS f32x4*)(ml + 2048 + j * 256 + 4 * F.lane); }
    }
}

DI float router_butterfly(const float (&s16)[16], int lane, int& e_out) {
    const bool b5 = (lane & 32) != 0, b4 = (lane & 16) != 0, b3 = (lane & 8) != 0, b2 = (lane & 4) != 0;
    float t8[8], u4[4], w2[2];
#pragma unroll
    for (int k = 0; k < 8; ++k) { const float keep = b5 ? s16[k + 8] : s16[k], send = b5 ? s16[k] : s16[k + 8]; t8[k] = keep + __shfl_xor(send, 32); }
#pragma unroll
    for (int k = 0; k < 4; ++k) { const float keep = b4 ? t8[k + 4] : t8[k], send = b4 ? t8[k] : t8[k + 4]; u4[k] = keep + __shfl_xor(send, 16); }
#pragma unroll
    for (int k = 0; k < 2; ++k) { const float keep = b3 ? u4[k + 2] : u4[k], send = b3 ? u4[k] : u4[k + 2]; w2[k] = keep + __shfl_xor(send, 8); }
    float z; { const float keep = b2 ? w2[1] : w2[0], send = b2 ? w2[0] : w2[1]; z = keep + __shfl_xor(send, 4); }
    z += __shfl_xor(z, 2); z += __shfl_xor(z, 1);
    e_out = (b5 ? 8 : 0) + (b4 ? 4 : 0) + (b3 ? 2 : 0) + (b2 ? 1 : 0);
    return z;
}
template <int RPW>
DI void phase_norm2(const Frame& F, int layer, bool skipctx, const float* x_in, const float* ctx_in, const float* X, const bf16_t* Y, bf16_t* H2, const float* MOD, const float* gffn, const float* w_router, float* AFF) {
    constexpr int WP = 1028;
    LAS float* wl = (LAS float*)F.lds;
    LAS float* ml = wl + 16 * WP;
    const WaveRows wr = wave_rows((int)blockIdx.x, F.G / NB, skipctx ? CTXL : 0, skipctx ? SEQ : PB, F.wave);
    for (int idx = F.tid; idx < 16384; idx += NWAVES * 64) wl[(idx & 15) * WP + (idx >> 4)] = w_router[idx];
    { const float* modl = MOD + (size_t)layer * 9 * 6144;
      for (int idx = F.tid; idx < 2048; idx += NWAVES * 64) { const int set = idx >> 10, c = idx & 1023; const float* mr = modl + (size_t)(set ? 8 : wr.b) * 6144;
          ml[(set * 3 + 0) * 1024 + c] = mr[2 * 1024 + c]; ml[(set * 3 + 1) * 1024 + c] = gffn[c] * (1.f + mr[4 * 1024 + c]); ml[(set * 3 + 2) * 1024 + c] = mr[3 * 1024 + c]; } }
    __syncthreads();
    for (int p = wr.pa; p < wr.pb; p += RPW) {
        f32x4 x[RPW][4]; int pk[RPW]; size_t Rk[RPW]; const LAS float* mk[RPW];
        { u32x2 y[RPW][4];
#pragma unroll
          for (int k = 0; k < RPW; ++k) { pk[k] = min(p + k, wr.pb - 1); Rk[k] = (size_t)wr.b * PB + pk[k]; mk[k] = ml + (pk[k] < CTXL ? 3072 : 0);
              const float* src = (layer > 0) ? X + Rk[k] * 1024 : stream_in(x_in, ctx_in, wr.b, pk[k]);
#pragma unroll
              for (int j = 0; j < 4; ++j) x[k][j] = *(const f32x4*)(src + j * 256 + 4 * F.lane);
#pragma unroll
              for (int j = 0; j < 4; ++j) y[k][j] = *(const u32x2*)(Y + Rk[k] * 1024 + j * 256 + 4 * F.lane); }
#pragma unroll
          for (int k = 0; k < RPW; ++k) add_gated_bf16(x[k], y[k], mk[k], F.lane); }
        float ss[RPW];
#pragma unroll
        for (int k = 0; k < RPW; ++k) ss[k] = row_ssq(x[k]);
        wave_sum_n<RPW>(ss);
#pragma unroll
        for (int k = 0; k < RPW; ++k) { const float rstd = __builtin_amdgcn_rsqf(ss[k] * (1.f / 1024.f) + RMS_EPS);
#pragma unroll
            for (int j = 0; j < 4; ++j) x[k][j] = x[k][j] * rstd * *(const LAS f32x4*)(mk[k] + 1024 + j * 256 + 4 * F.lane) + *(const LAS f32x4*)(mk[k] + 2048 + j * 256 + 4 * F.lane);
            row_store_bf16(F.lane, x[k], H2 + Rk[k] * 1024); }
        float s16[RPW][16];
        int wofs = 4 * F.lane; asm volatile("" : "+v"(wofs));
#pragma unroll
        for (int e = 0; e < 16; ++e) {
            f32x4 w[4];
#pragma unroll
            for (int j = 0; j < 4; ++j) w[j] = *(const LAS f32x4*)(wl + e * WP + j * 256 + wofs);
#pragma unroll
            for (int k = 0; k < RPW; ++k) { float s = 0.f;
#pragma unroll
                for (int j = 0; j < 4; ++j) s += (x[k][j][0] * w[j][0] + x[k][j][1] * w[j][1]) + (x[k][j][2] * w[j][2] + x[k][j][3] * w[j][3]);
                s16[k][e] = s; }
            if ((e & 3) == 3) __builtin_amdgcn_sched_barrier(0);
        }
        float aff[RPW]; int ek = 0;
#pragma unroll
        for (int k = 0; k < RPW; ++k) { int e; const float z = router_butterfly(s16[k], F.lane, e);
            float mx = z;
            mx = fmaxf(mx, __shfl_xor(mx, 32)); mx = fmaxf(mx, __shfl_xor(mx, 16)); mx = fmaxf(mx, __shfl_xor(mx, 8)); mx = fmaxf(mx, __shfl_xor(mx, 4));
            const float mine = expf(z - mx);
            float den = mine;
            den += __shfl_xor(den, 32); den += __shfl_xor(den, 16); den += __shfl_xor(den, 8); den += __shfl_xor(den, 4);
            aff[k] = mine / den; ek = e; }
        if ((F.lane & 3) == 0) {
#pragma unroll
            for (int k = 0; k < RPW; ++k) AFF[((size_t)wr.b * 16 + ek) * PB + pk[k]] = aff[k]; }
    }
    __syncthreads();
}

DI int block_exscan(const Frame& F, int v, LAS int* wtot, int& total) {
    int incl = v; const int sl = lane_op();
#pragma unroll
    for (int o = 1; o < 64; o <<= 1) { const int t = shup(incl, o, sl); if (sl >= o) incl += t; }
    if (F.lane == 63) wtot[F.wave] = incl;
    __syncthreads();
    int base = 0; total = 0;
#pragma unroll
    for (int w = 0; w < 8; ++w) { const int x = wtot[w]; if (w < F.wave) base += x; total += x; }
    __syncthreads();
    return base + incl - v;
}
DI void phase_topk(const Frame& F, int nitems, const float* AFF, int* SRC, float* GV, int* INV) {
    LAS int* wcnt = (LAS int*)F.lds;
    LAS int* wtot = wcnt + 48;
    for (int it = blockIdx.x; it < nitems; it += F.G) {
        const int isctx = it >= 128, be = it & 127, b = be >> 4, e = be & 15;
        const int n = isctx ? CTXL : SEQ, cap = isctx ? 32 : 256, p0 = isctx ? 0 : CTXL;
        const float* a = AFF + ((size_t)b * 16 + e) * PB + p0;
        unsigned v[4]; float av[4];
#pragma unroll
        for (int k = 0; k < 4; ++k) { const int idx = 4 * F.tid + k; av[k] = idx < n ? a[idx] : 0.f; v[k] = __builtin_bit_cast(unsigned, av[k]); }
        unsigned prefix = 0u;
        for (int b0 = 28; b0 >= 0; b0 -= 2) {
            const unsigned c3 = prefix | (3u << b0), c2 = prefix | (2u << b0), c1 = prefix | (1u << b0);
            int n3 = 0, n2 = 0, n1 = 0;
#pragma unroll
            for (int k = 0; k < 4; ++k) { n3 += __popcll(__ballot(v[k] >= c3)); n2 += __popcll(__ballot(v[k] >= c2)); n1 += __popcll(__ballot(v[k] >= c1)); }
            LAS int* wc = wcnt + ((b0 >> 1) & 1) * 24;
            if (F.lane == 0) { wc[F.wave] = n3; wc[8 + F.wave] = n2; wc[16 + F.wave] = n1; }
            __syncthreads();
            int t3 = 0, t2 = 0, t1 = 0;
#pragma unroll
            for (int w = 0; w < 8; ++w) { t3 += wc[w]; t2 += wc[8 + w]; t1 += wc[16 + w]; }
            prefix = (t3 >= cap) ? c3 : (t2 >= cap) ? c2 : (t1 >= cap) ? c1 : prefix;
        }
        __syncthreads();
        int ngt_t = 0, neq_t = 0;
#pragma unroll
        for (int k = 0; k < 4; ++k) { ngt_t += (v[k] > prefix) ? 1 : 0; neq_t += (v[k] == prefix) ? 1 : 0; }
        int ngt_total, neq_total;
        (void)block_exscan(F, ngt_t, wtot, ngt_total);
        int eq_rank = block_exscan(F, neq_t, wtot, neq_total);
        const int eq_take = cap - ngt_total;
        int sel[4], nsel_t = 0;
#pragma unroll
        for (int k = 0; k < 4; ++k) { int s = 0; if (v[k] > prefix) s = 1; else if (v[k] == prefix) { s = (eq_rank < eq_take) ? 1 : 0; ++eq_rank; } sel[k] = s; nsel_t += s; }
        int nsel_total;
        int slot = block_exscan(F, nsel_t, wtot, nsel_total);
        const int ebase = e * EROWS + (isctx ? 2048 + b * 32 : b * 256);
#pragma unroll
        for (int k = 0; k < 4; ++k) { const int idx = 4 * F.tid + k;
            if (idx < n) { const int R = b * PB + p0 + idx;
                if (sel[k]) { const int er = ebase + slot; ++slot; SRC[er] = R; GV[er] = av[k]; INV[(size_t)R * 16 + e] = er; }
                else INV[(size_t)R * 16 + e] = -1; } }
        __syncthreads();
    }
}
DI void phase_gather(const Frame& F, int rows_per_expert, const int* __restrict__ SRC, const bf16_t* __restrict__ H2, bf16_t* __restrict__ XG) {
    const int total = 16 * rows_per_expert;
    for (int q = F.gw * 4; q < total; q += F.NGW * 4) {
        const int e = q / rows_per_expert, s = q - e * rows_per_expert, er = e * EROWS + s;
        int R[4];
#pragma unroll
        for (int u = 0; u < 4; ++u) R[u] = SRC[er + u];
        u32x4 v0[4], v1[4];
#pragma unroll
        for (int u = 0; u < 4; ++u) { v0[u] = *(const u32x4*)(H2 + (size_t)R[u] * 1024 + 8 * F.lane); v1[u] = *(const u32x4*)(H2 + (size_t)R[u] * 1024 + 512 + 8 * F.lane); }
#pragma unroll
        for (int u = 0; u < 4; ++u) { *(u32x4*)(XG + (size_t)(er + u) * 1024 + 8 * F.lane) = v0[u]; *(u32x4*)(XG + (size_t)(er + u) * 1024 + 512 + 8 * F.lane) = v1[u]; }
    }
}

DI void qk_norm_rope(const float (&vin)[8], int ll, const float (&gn)[8], const float (&c)[8], const float (&sn)[8], float scale, float (&o)[8]) {
    float v[8]; float ss = 0.f;
#pragma unroll
    for (int k = 0; k < 8; ++k) ss += vin[k] * vin[k];
    ss += __shfl_xor(ss, 1); ss += __shfl_xor(ss, 2); ss += __shfl_xor(ss, 4);
    const float rstd = __builtin_amdgcn_rsqf(ss * (1.f / 64.f) + RMS_EPS) * scale;
#pragma unroll
    for (int k = 0; k < 8; ++k) v[k] = vin[k] * rstd * gn[k];
    const bool isx2 = (ll & 2) != 0;
#pragma unroll
    for (int k = 0; k < 8; ++k) { const float pv = __shfl_xor(v[k], 2); o[k] = isx2 ? (v[k] * c[k] + pv * sn[k]) : (v[k] * c[k] - pv * sn[k]); }
}
DI void ld8(const float* p, float (&o)[8]) { const f32x4 a = *(const f32x4*)p, b = *(const f32x4*)(p + 4); o[0] = a[0]; o[1] = a[1]; o[2] = a[2]; o[3] = a[3]; o[4] = b[0]; o[5] = b[1]; o[6] = b[2]; o[7] = b[3]; }
DI void phase_elem(const Frame& F, const LayerIn& P, const bf16_t* __restrict__ PA, const float* __restrict__ ROPE, bf16_t* __restrict__ QN, bf16_t* __restrict__ KN, bf16_t* __restrict__ XBC,
                   float* __restrict__ DT, bf16_t* __restrict__ AU, bf16_t* __restrict__ YCD) {
    const int l = F.lane;
    constexpr int NGRP = MROWS / 4;
    for (int task = F.gw; task < 3 * NGRP; task += F.NGW) {
        const int part = task / NGRP, R0 = (task - part * NGRP) * 4;
        const RowCtx rc = row_ctx(R0);
        const bf16_t* pr = PA + (size_t)R0 * PA_W;
        const bool has_prev = (rc.p != 0) && (rc.p != CTXL), has_next = (rc.p + 3 != CTXL - 1) && (rc.p + 3 != PB - 1);
        const bool rope = !rc.isctx; const int t0 = rope ? rc.p - CTXL : 0;
        if (part == 0) {
            const int hb = (l & 7) >> 2, i0 = (l & 1) * 8, uk = l >> 4, lk = l & 15, hbk = (lk & 7) >> 2, i0k = (lk & 1) * 8;
            u32x4 wq[4]; float cq[4][8], sq[4][8], ck[8], sk[8], gq[8], gk[8];
#pragma unroll
            for (int u = 0; u < 4; ++u) wq[u] = *(const u32x4*)(pr + (size_t)u * PA_W + C_Q + l * 8);
            const u32x4 wk = *(const u32x4*)(pr + (size_t)uk * PA_W + C_K + lk * 8);
            const bf16_t dtr = pr[(size_t)uk * PA_W + C_DT + (l & 7)];
            if (rope) {
#pragma unroll
                for (int u = 0; u < 4; ++u) { const float* cs = ROPE + (size_t)(t0 + u) * 64 + hb * 16 + i0; ld8(cs, cq[u]); ld8(cs + 32, sq[u]); }
                const float* cs = ROPE + (size_t)(t0 + uk) * 64 + hbk * 16 + i0k; ld8(cs, ck); ld8(cs + 32, sk);
            } else {
#pragma unroll
                for (int k = 0; k < 8; ++k) { ck[k] = 1.f; sk[k] = 0.f;
#pragma unroll
                    for (int u = 0; u < 4; ++u) { cq[u][k] = 1.f; sq[u][k] = 0.f; } }
            }
            ld8(P.q_norm_g + (l & 7) * 8, gq); ld8(P.k_norm_g + (lk & 7) * 8, gk);
            const float dtb = P.ssd_dt_bias[((l >> 3) & 1) * 8 + (l & 7)];
#pragma unroll
            for (int u = 0; u < 4; ++u) { float v[8], o[8]; unpack8(wq[u], v); qk_norm_rope(v, l, gq, cq[u], sq[u], ATT_C2, o); *(u32x4*)(QN + (size_t)(R0 + u) * 512 + l * 8) = pack8(o); }
            { float v[8], o[8]; unpack8(wk, v); qk_norm_rope(v, lk, gk, ck, sk, 1.f, o); *(u32x4*)(KN + (size_t)(R0 + uk) * 128 + lk * 8) = pack8(o); }
            { const int d = (l >> 3) & 1, h = l & 7; DT[((size_t)d * MROWS + R0 + uk) * 8 + h] = softplus_f(bf2f(dtr) + dtb); }
        } else if (part == 1) {
            const bool v1 = l < 32;
            u32x4 w[2][6]; float cw[2][4][8];
#pragma unroll
            for (int ps = 0; ps < 2; ++ps) { const int ch = (ps * 64 + l) * 8;
#pragma unroll
                for (int u = 0; u < 6; ++u) { const bool ok = ((u == 0) ? has_prev : (u == 5) ? has_next : true) && (ps == 0 || v1);
                    w[ps][u] = ok ? *(const u32x4*)(pr + (ptrdiff_t)(u - 1) * PA_W + C_XBC + ch) : (u32x4){0u, 0u, 0u, 0u}; } }
#pragma unroll
            for (int ps = 0; ps < 2; ++ps) { const int ch = (ps == 0 || v1) ? (ps * 64 + l) * 8 : 0;
                ld8(P.ssd_conv_w + ch, cw[ps][0]); ld8(P.ssd_conv_w + 768 + ch, cw[ps][1]); ld8(P.ssd_conv_w + 1536 + ch, cw[ps][2]); ld8(P.ssd_conv_b + ch, cw[ps][3]); }
#pragma unroll
            for (int ps = 0; ps < 2; ++ps) { const int ch = (ps * 64 + l) * 8;
                float a[8], b[8], c[8]; unpack8(w[ps][0], a); unpack8(w[ps][1], b);
#pragma unroll
                for (int u = 0; u < 4; ++u) { unpack8(w[ps][u + 2], c); float o[8];
#pragma unroll
                    for (int k = 0; k < 8; ++k) { o[k] = silu_f(cw[ps][0][k] * a[k] + cw[ps][1][k] * b[k] + cw[ps][2][k] * c[k] + cw[ps][3][k]); a[k] = b[k]; b[k] = c[k]; }
                    if (ps == 0 || v1) *(u32x4*)(XBC + (size_t)(R0 + u) * 768 + ch) = pack8(o); } }
        } else if (l < 48) {
            const int g = l >> 1, a0 = (l & 1) * 8, ch = l * 8;
            u32x4 uw[4], sb[4], sg[6], sh[6];
#pragma unroll
            for (int u = 0; u < 4; ++u) { uw[u] = *(const u32x4*)(pr + (size_t)u * PA_W + C_U + ch); sb[u] = *(const u32x4*)(pr + (size_t)u * PA_W + C_SB + ch); }
#pragma unroll
            for (int u = 0; u < 6; ++u) { const bool ok = (u == 0) ? has_prev : (u == 5) ? has_next : true;
                sg[u] = ok ? *(const u32x4*)(pr + (ptrdiff_t)(u - 1) * PA_W + C_SG + ch) : (u32x4){0u, 0u, 0u, 0u};
                sh[u] = ok ? *(const u32x4*)(pr + (ptrdiff_t)(u - 1) * PA_W + C_SH + ch) : (u32x4){0u, 0u, 0u, 0u}; }
            float w0[8], w1[8], w2[8];
            ld8(P.sc_conv_w + ch, w0); ld8(P.sc_conv_w + 384 + ch, w1); ld8(P.sc_conv_w + 768 + ch, w2);
#pragma unroll
            for (int u = 0; u < 4; ++u) *(u32x4*)(AU + ((size_t)g * 576 + ((R0 + u) >> 5)) * 768 + ((R0 + u) & 31) * 16 + a0) = uw[u];
            float a[8], b[8], c[8], x[8], y[8];
            unpack8(sg[0], x); unpack8(sh[0], y);
#pragma unroll
            for (int k = 0; k < 8; ++k) a[k] = x[k] * y[k];
            unpack8(sg[1], x); unpack8(sh[1], y);
#pragma unroll
            for (int k = 0; k < 8; ++k) b[k] = x[k] * y[k];
#pragma unroll
            for (int u = 0; u < 4; ++u) { unpack8(sg[u + 2], x); unpack8(sh[u + 2], y); float s[8], o[8]; unpack8(sb[u], s);
#pragma unroll
                for (int k = 0; k < 8; ++k) { c[k] = x[k] * y[k]; o[k] = s[k] * (w0[k] * a[k] + w1[k] * b[k] + w2[k] * c[k]); a[k] = b[k]; b[k] = c[k]; }
                *(u32x4*)(YCD + (size_t)(R0 + u) * 768 + 384 + ch) = pack8(o); }
        }
    }
}

typedef short v4i16_t __attribute__((ext_vector_type(4)));
DI int img_off(int row, int chunk) { return row * 128 + ((chunk ^ (row & 7)) << 4); }
DI s16x4 tr_read4(const LAS unsigned char* p) { return __builtin_bit_cast(s16x4, __builtin_amdgcn_ds_read_tr16_b64_v4i16((LAS v4i16_t*)p)); }
DI bf16x8 cat8(s16x4 lo, s16x4 hi) { return (bf16x8){lo[0], lo[1], lo[2], lo[3], hi[0], hi[1], hi[2], hi[3]}; }
DI unsigned cvtpk(float lo, float hi) { typedef __bf16 bf2 __attribute__((ext_vector_type(2))); f32x2 v = {lo, hi}; bf2 b = __builtin_convertvector(v, bf2); return __builtin_bit_cast(unsigned, b); }
#define MFMA32(a, b, c) __builtin_amdgcn_mfma_f32_32x32x16_bf16((a), (b), (c), 0, 0, 0)
DI int crow(int r, int hh) { return (r & 3) + 8 * (r >> 2) + 4 * hh; }

constexpr int SSD_XH = 0, SSD_BM = 65536, SSD_CM = 81920, SSD_ARR = 131072;
DI void ssd_load_images(const Frame& F, const bf16_t* XBC, int R0, int g, bool with_c) {
    int tid_l = F.tid; asm volatile("" : "+v"(tid_l));
#pragma unroll
    for (int it = 0; it < 8; ++it) { const int idx = it * 512 + tid_l, h4 = idx >> 10, row = (idx >> 3) & 127, ch = idx & 7;
        *(LAS u32x4*)(F.lds + SSD_XH + h4 * 16384 + img_off(row, ch)) = *(const u32x4*)(XBC + (size_t)(R0 + row) * 768 + g * 256 + h4 * 64 + ch * 8); }
#pragma unroll
    for (int it = 0; it < 2; ++it) { const int idx = it * 512 + tid_l, row = idx >> 3, ch = idx & 7;
        *(LAS u32x4*)(F.lds + SSD_BM + img_off(row, ch)) = *(const u32x4*)(XBC + (size_t)(R0 + row) * 768 + 512 + g * 64 + ch * 8);
        if (with_c) *(LAS u32x4*)(F.lds + SSD_CM + img_off(row, ch)) = *(const u32x4*)(XBC + (size_t)(R0 + row) * 768 + 640 + g * 64 + ch * 8); }
}
struct Series { float dt0, dt1, cs0, cs1, ecs0, ecs1, tot; };
DI Series ssd_series(const Frame& F, const float* DT, const float* a_log, int R0, int h, int d) {
    Series s; const float a = -__expf(a_log[d * 8 + h]);
    s.dt0 = DT[((size_t)d * MROWS + R0 + 2 * F.lane) * 8 + h]; s.dt1 = DT[((size_t)d * MROWS + R0 + 2 * F.lane + 1) * 8 + h];
    const float ad0 = s.dt0 * a, ad1 = s.dt1 * a, pair = ad0 + ad1; float incl = pair; const int sl = lane_op();
#pragma unroll
    for (int o = 1; o < 64; o <<= 1) { const float t = shup(incl, o, sl); if (sl >= o) incl += t; }
    const float excl = incl - pair;
    s.cs0 = excl + ad0; s.cs1 = incl; s.ecs0 = excl; s.ecs1 = excl + ad0; s.tot = shidx(incl, 63);
    return s;
}

DI void ssd_chunk_states(const Frame& F, const LayerIn& P, const bf16_t* XBC, const float* DT, float* S, float* TOT) {
    LAS float* W = (LAS float*)(F.lds + SSD_ARR);
    const int lane = F.lane, hh = lane >> 5, q = (lane & 15) >> 2, pp = lane & 3, blk = (lane >> 4) & 1;
    const int h4 = F.wave & 3, d = F.wave >> 2;
    for (int it = F.bid; it < 288; it += F.G) {
        const int b = it / 36, r = it % 36, c = r >> 1, g = r & 1, R0 = b * PB + c * 128, h = 4 * g + h4;
        ssd_load_images(F, XBC, R0, g, false);
        const Series s = ssd_series(F, DT, P.ssd_a_log, R0, h, d);
        float w0, w1;
        if (d == 0) { w0 = s.dt0 * __expf(s.tot - s.cs0); w1 = s.dt1 * __expf(s.tot - s.cs1); } else { w0 = s.dt0 * __expf(s.ecs0); w1 = s.dt1 * __expf(s.ecs1); }
        *(LAS f32x2*)(W + F.wave * 128 + 2 * lane) = (f32x2){w0, w1};
        if (lane == 0) TOT[(((size_t)b * 18 + c) * 8 + h) * 2 + d] = s.tot;
        __syncthreads();
        f32x16 acc[2][2];
#pragma unroll
        for (int i = 0; i < 2; ++i)
#pragma unroll
            for (int j = 0; j < 2; ++j)
#pragma unroll
                for (int k = 0; k < 16; ++k) acc[i][j][k] = 0.f;
        const LAS unsigned char* xh = F.lds + SSD_XH + h4 * 16384;
        const LAS unsigned char* bm = F.lds + SSD_BM;
#pragma unroll 2
        for (int st = 0; st < 8; ++st) {
            const int row = 16 * st + 8 * hh + q;
            const f32x4 wa = *(const LAS f32x4*)(W + F.wave * 128 + 16 * st + 8 * hh), wb = *(const LAS f32x4*)(W + F.wave * 128 + 16 * st + 8 * hh + 4);
            bf16x8 af[2], bfr[2];
#pragma unroll
            for (int t = 0; t < 2; ++t) { const int chunk = t * 4 + 2 * blk + (pp >> 1), within = 8 * (pp & 1);
                af[t] = cat8(tr_read4(bm + img_off(row, chunk) + within), tr_read4(bm + img_off(row + 4, chunk) + within));
                const s16x4 lo = tr_read4(xh + img_off(row, chunk) + within), hi = tr_read4(xh + img_off(row + 4, chunk) + within);
                u32x4 pw;
                pw.x = cvtpk(bf2f((bf16_t)lo[0]) * wa[0], bf2f((bf16_t)lo[1]) * wa[1]); pw.y = cvtpk(bf2f((bf16_t)lo[2]) * wa[2], bf2f((bf16_t)lo[3]) * wa[3]);
                pw.z = cvtpk(bf2f((bf16_t)hi[0]) * wb[0], bf2f((bf16_t)hi[1]) * wb[1]); pw.w = cvtpk(bf2f((bf16_t)hi[2]) * wb[2], bf2f((bf16_t)hi[3]) * wb[3]);
                bfr[t] = __builtin_bit_cast(bf16x8, pw); }
#pragma unroll
            for (int nt = 0; nt < 2; ++nt)
#pragma unroll
                for (int pt = 0; pt < 2; ++pt) acc[nt][pt] = MFMA32(af[nt], bfr[pt], acc[nt][pt]);
        }
        float* Sb = S + ((((size_t)b * 18 + c) * 8 + h) * 2 + d) * 4096;
#pragma unroll
        for (int nt = 0; nt < 2; ++nt)
#pragma unroll
            for (int pt = 0; pt < 2; ++pt)
#pragma unroll
                for (int q4 = 0; q4 < 4; ++q4) { const int p = pt * 32 + (lane & 31), n0 = nt * 32 + 8 * q4 + 4 * hh;
                    *(f32x4*)(Sb + p * 64 + n0) = (f32x4){acc[nt][pt][4 * q4], acc[nt][pt][4 * q4 + 1], acc[nt][pt][4 * q4 + 2], acc[nt][pt][4 * q4 + 3]}; }
        __syncthreads();
    }
}

DI void ssd_recurrence(const Frame& F, const float* __restrict__ S, const float* __restrict__ TOT, bf16_t* __restrict__ HIN) {
    for (int gi = F.bid * 512 + F.tid; gi < 128 * 1024; gi += F.G * 512) {
        const int bhd = gi >> 10, e4 = (gi & 1023) * 4, b = bhd >> 4, h = (bhd >> 1) & 7, d = bhd & 1;
        f32x4 sv[18]; float dec[18];
#pragma unroll
        for (int k = 0; k < 18; ++k) { const int c = (d == 0) ? k : (k < 2 ? 1 - k : 19 - k);
            const size_t st = (((size_t)b * 18 + c) * 8 + h) * 2 + d;
            sv[k] = *(const f32x4*)(S + st * 4096 + e4); dec[k] = TOT[st]; }
        float z0 = 0.f; asm volatile("" : "+v"(z0));
        f32x4 H = (f32x4){z0, z0, z0, z0};
#pragma unroll
        for (int k = 0; k < 18; ++k) { const int c = (d == 0) ? k : (k < 2 ? 1 - k : 19 - k);
            const size_t st = (((size_t)b * 18 + c) * 8 + h) * 2 + d;
            u32x2 w; w.x = pk2(H[0], H[1]); w.y = pk2(H[2], H[3]);
            *(u32x2*)(HIN + st * 4096 + e4) = w;
            H = H * __expf(dec[k]) + sv[k]; }
    }
}

#ifndef E3_PROBE
#define E3_PROBE 0
#endif
__device__ unsigned long long g_probe_ticks;
#define E3STAMP(k) do { if (E3_PROBE) { const unsigned long long t_ = __builtin_amdgcn_s_memrealtime(); if (E3_PROBE == (k) && blockIdx.x == 0 && threadIdx.x == 0) g_probe_ticks += t_ - tprev_; tprev_ = t_; } } while (0)
DI void ssd_output(const Frame& F, const LayerIn& P, const bf16_t* XBC, const bf16_t* PA, const float* DT, const bf16_t* HIN, bf16_t* YB, float* SSQ, bool skipctx) {
    LAS float* ARR = (LAS float*)(F.lds + SSD_ARR);
    const int lane = F.lane, hh = lane >> 5, q = (lane & 15) >> 2, pp = lane & 3, blk = (lane >> 4) & 1, l31 = lane & 31;
    for (int it = F.bid; it < 288; it += F.G) {
        const int b = it / 36, r_ = it % 36, c = r_ >> 1, g = r_ & 1, R0 = b * PB + c * 128;
        if (skipctx && c < 2) continue;
        unsigned long long tprev_ = E3_PROBE ? __builtin_amdgcn_s_memrealtime() : 0ull;
        ssd_load_images(F, XBC, R0, g, true);
        bf16x8 hb0[2][4];
        { const bf16_t* Hs = HIN + (((((size_t)b * 18 + c) * 8 + 4 * g + (F.wave & 3)) * 2 + 0) * 4096);
#pragma unroll
          for (int pt = 0; pt < 2; ++pt)
#pragma unroll
              for (int ks = 0; ks < 4; ++ks) hb0[pt][ks] = *(const bf16x8*)(Hs + (pt * 32 + l31) * 64 + 16 * ks + 8 * hh); }
        { const int h4 = F.wave & 3, d = F.wave >> 2, h = 4 * g + h4;
          const Series s = ssd_series(F, DT, P.ssd_a_log, R0, h, d);
          LAS float* A = ARR + h4 * 768;
          if (d == 0) { *(LAS f32x2*)(A + 0 * 128 + 2 * lane) = (f32x2){s.cs0, s.cs1}; *(LAS f32x2*)(A + 1 * 128 + 2 * lane) = (f32x2){s.dt0, s.dt1};
                        *(LAS f32x2*)(A + 2 * 128 + 2 * lane) = (f32x2){__expf(s.cs0), __expf(s.cs1)}; }
          else { *(LAS f32x2*)(A + 3 * 128 + 2 * lane) = (f32x2){s.ecs0, s.ecs1}; *(LAS f32x2*)(A + 4 * 128 + 2 * lane) = (f32x2){s.dt0, s.dt1};
                 *(LAS f32x2*)(A + 5 * 128 + 2 * lane) = (f32x2){__expf(s.tot - s.ecs0), __expf(s.tot - s.ecs1)}; } }
        __syncthreads();
        E3STAMP(1);
        const int h4 = F.wave & 3, rh = F.wave >> 2, h = 4 * g + h4;
        const LAS float* A = ARR + h4 * 768;
        const LAS unsigned char* xh = F.lds + SSD_XH + h4 * 16384;
        const LAS unsigned char* bm = F.lds + SSD_BM;
        const LAS unsigned char* cm = F.lds + SSD_CM;
        f32x16 yacc[2][2];
#pragma unroll
        for (int i = 0; i < 2; ++i)
#pragma unroll
            for (int j = 0; j < 2; ++j)
#pragma unroll
                for (int k = 0; k < 16; ++k) yacc[i][j][k] = 0.f;
        bf16x8 hb1[2][4];
        { const bf16_t* Hs = HIN + (((((size_t)b * 18 + c) * 8 + h) * 2 + 1) * 4096);
#pragma unroll
          for (int pt = 0; pt < 2; ++pt)
#pragma unroll
              for (int ks = 0; ks < 4; ++ks) hb1[pt][ks] = *(const bf16x8*)(Hs + (pt * 32 + l31) * 64 + 16 * ks + 8 * hh); }
#pragma unroll
        for (int d = 0; d < 2; ++d)
#pragma unroll
            for (int itl = 0; itl < 2; ++itl) {
                const int itile = 2 * rh + itl, irow = itile * 32 + l31;
                bf16x8 cf[4];
#pragma unroll
                for (int ks = 0; ks < 4; ++ks) cf[ks] = *(const LAS bf16x8*)(cm + img_off(irow, 2 * ks + hh));
#pragma unroll
                for (int pt = 0; pt < 2; ++pt) {
                    f32x16 tmp;
#pragma unroll
                    for (int k = 0; k < 16; ++k) tmp[k] = 0.f;
#pragma unroll
                    for (int ks = 0; ks < 4; ++ks) tmp = MFMA32(cf[ks], d == 0 ? hb0[pt][ks] : hb1[pt][ks], tmp);
#pragma unroll
                    for (int q4 = 0; q4 < 4; ++q4) { const f32x4 ev = *(const LAS f32x4*)(A + (d == 0 ? 2 : 5) * 128 + itile * 32 + 8 * q4 + 4 * hh);
#pragma unroll
                        for (int k = 0; k < 4; ++k) yacc[itl][pt][4 * q4 + k] += tmp[4 * q4 + k] * ev[k]; }
                }
                __builtin_amdgcn_sched_barrier(0);
            }
#pragma unroll
        for (int itl = 0; itl < 2; ++itl) {
            const int itile = 2 * rh + itl, irow = itile * 32 + l31;
            bf16x8 cf[4];
#pragma unroll
            for (int ks = 0; ks < 4; ++ks) cf[ks] = *(const LAS bf16x8*)(cm + img_off(irow, 2 * ks + hh));
            const float csf_i = A[0 * 128 + irow], ecb_i = A[3 * 128 + irow];
#pragma unroll 1
            for (int jt = 0; jt < 4; ++jt) {
                f32x16 Z;
#pragma unroll
                for (int k = 0; k < 16; ++k) Z[k] = 0.f;
#pragma unroll
                for (int ks = 0; ks < 4; ++ks) { const bf16x8 bf_ = *(const LAS bf16x8*)(bm + img_off(jt * 32 + l31, 2 * ks + hh)); Z = MFMA32(bf_, cf[ks], Z); }
#pragma unroll
                for (int q4 = 0; q4 < 4; ++q4) { const int j0 = jt * 32 + 8 * q4 + 4 * hh;
                    f32x4 w = (f32x4){0.f, 0.f, 0.f, 0.f};
                    if (jt <= itile) { const f32x4 cj = *(const LAS f32x4*)(A + 0 * 128 + j0), dj = *(const LAS f32x4*)(A + 1 * 128 + j0);
#pragma unroll
                        for (int k = 0; k < 4; ++k) { const bool ok = (jt < itile) || (j0 + k <= irow); w[k] += ok ? __expf(fminf(csf_i - cj[k], 0.f)) * dj[k] : 0.f; } }
                    if (jt >= itile) { const f32x4 ej = *(const LAS f32x4*)(A + 3 * 128 + j0), dj = *(const LAS f32x4*)(A + 4 * 128 + j0);
#pragma unroll
                        for (int k = 0; k < 4; ++k) { const bool ok = (jt > itile) || (j0 + k >= irow); w[k] += ok ? __expf(fminf(ej[k] - ecb_i, 0.f)) * dj[k] : 0.f; } }
#pragma unroll
                    for (int k = 0; k < 4; ++k) Z[4 * q4 + k] *= w[k]; }
#pragma unroll
                for (int s = 0; s < 2; ++s) {
                    u32x4 zp; zp.x = cvtpk(Z[8 * s], Z[8 * s + 1]); zp.y = cvtpk(Z[8 * s + 2], Z[8 * s + 3]); zp.z = cvtpk(Z[8 * s + 4], Z[8 * s + 5]); zp.w = cvtpk(Z[8 * s + 6], Z[8 * s + 7]);
                    const bf16x8 za = __builtin_bit_cast(bf16x8, zp);
                    const int row = jt * 32 + 16 * s + 4 * hh + q;
#pragma unroll
                    for (int pt = 0; pt < 2; ++pt) { const int chunk = pt * 4 + 2 * blk + (pp >> 1), within = 8 * (pp & 1);
                        const bf16x8 xb = cat8(tr_read4(xh + img_off(row, chunk) + within), tr_read4(xh + img_off(row + 8, chunk) + within));
                        yacc[itl][pt] = MFMA32(za, xb, yacc[itl][pt]); }
                }
                __builtin_amdgcn_sched_barrier(0);
            }
        }
        __syncthreads();
        E3STAMP(2);
        LAS float* Y = (LAS float*)F.lds;
#pragma unroll
        for (int itl = 0; itl < 2; ++itl)
#pragma unroll
            for (int pt = 0; pt < 2; ++pt)
#pragma unroll
                for (int r = 0; r < 16; ++r) Y[((2 * rh + itl) * 32 + crow(r, hh)) * 256 + h4 * 64 + pt * 32 + l31] = yacc[itl][pt][r];
        u32x4 xw[4], zw[4];
        int tid_e = F.tid; asm volatile("" : "+v"(tid_e));
#pragma unroll
        for (int u = 0; u < 4; ++u) { const int idx = u * 512 + tid_e, row = idx >> 5, ch = idx & 31, R = R0 + row;
            xw[u] = *(const u32x4*)(XBC + (size_t)R * 768 + g * 256 + ch * 8); zw[u] = *(const u32x4*)(PA + (size_t)R * PA_W + C_Z + g * 256 + ch * 8); }
        __syncthreads();
#pragma unroll
        for (int it4 = 0; it4 < 8; it4 += 4) {
            u32x4 xn[4], zn[4];
            if (it4 == 0) {
#pragma unroll
                for (int u = 0; u < 4; ++u) { const int idx = (4 + u) * 512 + tid_e, row = idx >> 5, ch = idx & 31, R = R0 + row;
                    xn[u] = *(const u32x4*)(XBC + (size_t)R * 768 + g * 256 + ch * 8); zn[u] = *(const u32x4*)(PA + (size_t)R * PA_W + C_Z + g * 256 + ch * 8); } }
#pragma unroll
            for (int u = 0; u < 4; ++u) { const int idx = (it4 + u) * 512 + tid_e, row = idx >> 5, ch = idx & 31, R = R0 + row;
                const f32x4 y0 = *(const LAS f32x4*)(Y + row * 256 + ch * 8), y1 = *(const LAS f32x4*)(Y + row * 256 + ch * 8 + 4);
                float xv[8], zv[8]; unpack8(xw[u], xv); unpack8(zw[u], zv);
                const float Dh = P.ssd_d[4 * g + (ch >> 3)]; float o[8], ss = 0.f;
#pragma unroll
                for (int k = 0; k < 8; ++k) { const float yv = (k < 4 ? y0[k] : y1[k - 4]) + Dh * xv[k]; o[k] = yv * silu_f(zv[k]); ss += o[k] * o[k]; }
                ss += __shfl_xor(ss, 1); ss += __shfl_xor(ss, 2); ss += __shfl_xor(ss, 4); ss += __shfl_xor(ss, 8); ss += __shfl_xor(ss, 16);
                if (ch == 0) SSQ[(size_t)R * 2 + g] = ss;
                *(u32x4*)(YB + (size_t)R * 1024 + 512 + g * 256 + ch * 8) = pack8(o); }
            if (it4 == 0) {
#pragma unroll
                for (int u = 0; u < 4; ++u) { xw[u] = xn[u]; zw[u] = zn[u]; } }
        }
        __syncthreads();
        E3STAMP(3);
    }
}

DI void s5_recurrence(const Frame& F, const LayerIn& P, const float* __restrict__ S5S, bf16_t* __restrict__ AU) {
    if (F.gw >= 384) return;
    const int g = F.gw >> 4, b = (F.gw >> 1) & 7, d = F.gw & 1, p = F.lane;
    const float step = __expf(P.s5_lstep[d * 24 + g]);
    const float lr = P.s5_lre[(d * 24 + g) * 64 + p], li = P.s5_lim[(d * 24 + g) * 64 + p];
    const float mag = expf(32.f * lr * step), ang = 32.f * li * step, Lr = mag * cosf(ang), Li = mag * sinf(ang);
    float Hr = 0.f, Hi = 0.f;
#pragma unroll 1
    for (int kb = 0; kb < 72; kb += 24) {
        float sr[24], si[24];
#pragma unroll
        for (int k = 0; k < 24; ++k) { const int kk = kb + k, ck = (d == 0) ? kk : (kk < 8 ? 7 - kk : 79 - kk);
            const size_t m = (size_t)g * 576 + b * 72 + ck;
            sr[k] = S5S[m * 256 + d * 128 + p]; si[k] = S5S[m * 256 + d * 128 + 64 + p]; }
#pragma unroll
        for (int k = 0; k < 24; ++k) { const int kk = kb + k, ck = (d == 0) ? kk : (kk < 8 ? 7 - kk : 79 - kk);
            const size_t m = (size_t)g * 576 + b * 72 + ck;
            AU[m * 768 + 512 + d * 128 + p] = (bf16_t)f2bf(Hr); AU[m * 768 + 512 + d * 128 + 64 + p] = (bf16_t)f2bf(Hi);
            const float nr = Lr * Hr - Li * Hi + sr[k], ni = Lr * Hi + Li * Hr + si[k];
            Hr = nr; Hi = ni; }
    }
}

namespace attn_body {
using bf16=__hip_bfloat16;
using bf16x8=__attribute__((ext_vector_type(8)))short;
using s16x4=__attribute__((ext_vector_type(4)))short;
using f32x16=__attribute__((ext_vector_type(16)))float;
using u32x4=__attribute__((ext_vector_type(4)))unsigned;
constexpr int D=64;
constexpr int NW=8,QBLK=32,QB=QBLK*NW,KVBLK=64;
__device__ __forceinline__ int crow(int r,int hi){return (r&3)+8*(r>>2)+4*hi;}
#define SBAR() __builtin_amdgcn_sched_barrier(0)
constexpr int NSLOT=3, SLOTB=8192;
constexpr int LDS_K=0, LDS_V=NSLOT*SLOTB, LDS_WS=2*NSLOT*SLOTB, LDS_OST=LDS_WS+NW*64*4, LDS_BYTES=LDS_OST+NW*4096;
constexpr float C2=0.125f*1.4426950408889634f;
__device__ __forceinline__ void glds16(const void*gsrc,unsigned lds_dst){unsigned keep;
  asm volatile("s_mov_b32 %0, m0\n\ts_mov_b32 m0, %2\n\ts_nop 0\n\tglobal_load_lds_dwordx4 %1, off\n\ts_mov_b32 m0, %0":"=&s"(keep):"v"(gsrc),"s"(lds_dst):"memory");}
__device__ __forceinline__ float max3f(float a,float b,float c){float r;asm("v_max3_f32 %0, %1, %2, %3":"=v"(r):"v"(a),"v"(b),"v"(c));return r;}
__device__ __forceinline__ float max2f(float a,float b){float r;asm("v_max_f32_e32 %0, %1, %2":"=v"(r):"v"(a),"v"(b));return r;}
__device__ __forceinline__ float fadd_s(float a,float b){float r;asm("v_add_f32_e32 %0, %1, %2":"=v"(r):"v"(a),"v"(b));return r;}
__device__ __forceinline__ float fsub_s(float a,float b){float r;asm("v_sub_f32_e32 %0, %1, %2":"=v"(r):"v"(a),"v"(b));return r;}
typedef float f32x2_t __attribute__((ext_vector_type(2))); typedef __bf16 bf16x2_t __attribute__((ext_vector_type(2)));
__device__ __forceinline__ unsigned cvtpk_s(float lo,float hi){f32x2_t v={lo,hi};bf16x2_t b=__builtin_convertvector(v,bf16x2_t);return __builtin_bit_cast(unsigned,b);}
#define WAIT_BAR(N) asm volatile("s_waitcnt vmcnt(" #N ") lgkmcnt(0)\n\ts_barrier":::"memory")

__device__ __forceinline__ void qkt(f32x16&p0,f32x16&p1,const char*Kslot,const bf16x8*qr,const f32x16&negm,int r32,int hi){
  const char*kb=Kslot+hi*1024+r32*16;
  #pragma unroll
  for(int d0=0;d0<4;++d0){
    const bf16x8 b0=*reinterpret_cast<const bf16x8*>(kb+d0*2048);
    const bf16x8 b1=*reinterpret_cast<const bf16x8*>(kb+d0*2048+512);
    if(d0==0){p0=__builtin_amdgcn_mfma_f32_32x32x16_bf16(b0,qr[0],negm,0,0,0);p1=__builtin_amdgcn_mfma_f32_32x32x16_bf16(b1,qr[0],negm,0,0,0);}
    else{p0=__builtin_amdgcn_mfma_f32_32x32x16_bf16(b0,qr[d0],p0,0,0,0);p1=__builtin_amdgcn_mfma_f32_32x32x16_bf16(b1,qr[d0],p1,0,0,0);}}
}
typedef __attribute__((address_space(3))) const char* lds_cptr;
typedef short v4i16_t __attribute__((ext_vector_type(4)));
__device__ __forceinline__ void kload8(bf16x8*kf,lds_cptr kp){
  kf[0]=*(const __attribute__((address_space(3))) bf16x8*)(kp);      kf[1]=*(const __attribute__((address_space(3))) bf16x8*)(kp+512);
  kf[2]=*(const __attribute__((address_space(3))) bf16x8*)(kp+2048); kf[3]=*(const __attribute__((address_space(3))) bf16x8*)(kp+2560);
  kf[4]=*(const __attribute__((address_space(3))) bf16x8*)(kp+4096); kf[5]=*(const __attribute__((address_space(3))) bf16x8*)(kp+4608);
  kf[6]=*(const __attribute__((address_space(3))) bf16x8*)(kp+6144); kf[7]=*(const __attribute__((address_space(3))) bf16x8*)(kp+6656);
}
__device__ __forceinline__ void kload2(bf16x8*kf,lds_cptr kp,int j){ kf[2*j]=*(const __attribute__((address_space(3))) bf16x8*)(kp+j*2048); kf[2*j+1]=*(const __attribute__((address_space(3))) bf16x8*)(kp+j*2048+512); }
__device__ __forceinline__ s16x4 vtr(lds_cptr p){ return __builtin_bit_cast(s16x4,__builtin_amdgcn_ds_read_tr16_b64_v4i16((__attribute__((address_space(3))) v4i16_t*)p)); }
__device__ __forceinline__ float rowmax(const f32x16&p0,const f32x16&p1){
  float a=max3f(p0[0],p0[1],p1[0]),b=max3f(p0[2],p0[3],p1[1]);a=max3f(a,p1[2],p1[3]);
  #pragma unroll
  for(int r=4;r<16;r+=4){a=max3f(a,p0[r],p0[r+1]);b=max3f(b,p0[r+2],p0[r+3]);a=max3f(a,p1[r],p1[r+1]);b=max3f(b,p1[r+2],p1[r+3]);}
  const float m=max2f(a,b);
  auto rr=__builtin_amdgcn_permlane32_swap(__float_as_uint(m),__float_as_uint(m),false,false);
  return max2f(__uint_as_float(rr[0]),__uint_as_float(rr[1]));
}
__device__ __forceinline__ void pv(f32x16*o,int vb,bf16x8 pa0,bf16x8 pa1,bf16x8 pa2,bf16x8 pa3){
  #pragma unroll
  for(int d0=0;d0<2;++d0){s16x4 lo[4],hi[4];
    #pragma unroll
    for(int ks=0;ks<4;++ks){
      asm volatile("ds_read_b64_tr_b16 %0,%1 offset:%c2":"=&v"(lo[ks]):"v"(vb),"i"(d0*4096+ks*1024):"memory");
      asm volatile("ds_read_b64_tr_b16 %0,%1 offset:%c2":"=&v"(hi[ks]):"v"(vb),"i"(d0*4096+ks*1024+512):"memory");}
    asm volatile("s_waitcnt lgkmcnt(0)":::"memory");SBAR();
    #define PK(k) (bf16x8){lo[k][0],lo[k][1],lo[k][2],lo[k][3],hi[k][0],hi[k][1],hi[k][2],hi[k][3]}
    o[d0]=__builtin_amdgcn_mfma_f32_32x32x16_bf16(pa0,PK(0),o[d0],0,0,0);
    o[d0]=__builtin_amdgcn_mfma_f32_32x32x16_bf16(pa1,PK(1),o[d0],0,0,0);
    o[d0]=__builtin_amdgcn_mfma_f32_32x32x16_bf16(pa2,PK(2),o[d0],0,0,0);
    o[d0]=__builtin_amdgcn_mfma_f32_32x32x16_bf16(pa3,PK(3),o[d0],0,0,0);
    #undef PK
  }
}

#ifndef ATTN_STORE16
#define ATTN_STORE16(p,v) (*(u32x4*)(p)=(v))
#endif
template<int THRL> __device__ __forceinline__ void attn_unit(const bf16*Qp,int qpitch,const bf16*__restrict__ Kp,int kpitch,const bf16*__restrict__ Vp,int vpitch,bf16*Op,int opitch,const int NT,char*shm){
  const int tid=fresh_tid(),lane=tid&63,r32=lane&31,hi=lane>>5; const int wid=__builtin_amdgcn_readfirstlane(tid>>6);
  const bf16*Qw=Qp+(long)(wid*QBLK)*qpitch;
  const bf16*Kh=Kp,*Vh=Vp;
  const unsigned lds0=(unsigned)(uintptr_t)shm;
  float*wsf=(float*)(shm+LDS_WS)+wid*64;
  const bf16*ksrc=Kh+(long)lane*kpitch+wid*8;
  const bf16*vsrc=Vh+(long)(16*(wid&3)+(lane>>2))*vpitch+(wid>>2)*32+(lane&3)*8;
  const unsigned kdst=lds0+LDS_K+wid*1024, vdst=lds0+LDS_V+wid*1024;
  #define DMA_K(t,slot) glds16(ksrc+(long)(t)*KVBLK*kpitch,(unsigned)__builtin_amdgcn_readfirstlane(kdst+(slot)))
  #define DMA_V(t,slot) glds16(vsrc+(long)(t)*KVBLK*vpitch,(unsigned)__builtin_amdgcn_readfirstlane(vdst+(slot)))
  const int vb0=(int)(lds0+LDS_V)+((lane>>4)&1)*32+(lane&3)*8+(4*hi+((lane&15)>>2))*64;
  const char*Kbase=shm+LDS_K; bf16x8 kf[8];
  const lds_cptr shm3=(lds_cptr)shm; const lds_cptr kp0=shm3+LDS_K+hi*1024+r32*16; const lds_cptr vp0=shm3+LDS_V+((lane>>4)&1)*32+(lane&3)*8+(4*hi+((lane&15)>>2))*64;
  DMA_K(0,0);DMA_V(0,0);DMA_K(1,SLOTB);
  bf16x8 qr[4];
  #pragma unroll
  for(int d0=0;d0<4;++d0)qr[d0]=*reinterpret_cast<const bf16x8*>(&Qw[(long)r32*qpitch+d0*16+hi*8]);
  float mhat=0.f,l_reg=0.f;f32x16 o[2];o[0]=f32x16{};o[1]=f32x16{};f32x16 negm=f32x16{};asm volatile("":"+v"(negm));
  #define CMASK(P0,P1,t) do{}while(0)
  bool resc=false;
  #define START(P0,P1) do{ const float rm=rowmax(P0,P1); resc=false; \
    { const float dl=rm; mhat=fadd_s(mhat,dl); \
      _Pragma("unroll") for(int r=0;r<16;++r){P0[r]=fsub_s(P0[r],dl);P1[r]=fsub_s(P1[r],dl);} \
      _Pragma("unroll") for(int r=0;r<16;++r)negm[r]=-mhat; asm volatile("":"+v"(negm)); } \
    _Pragma("unroll") for(int r=0;r<16;++r)P0[r]=__builtin_amdgcn_exp2f(P0[r]); }while(0)
  #define RESC() do{ if(resc){ asm volatile("s_waitcnt lgkmcnt(0)":::"memory"); \
      _Pragma("unroll") for(int d_=0;d_<2;++d_) _Pragma("unroll") for(int r=0;r<16;++r)o[d_][r]*=wsf[crow(r,hi)]; } }while(0)
  f32x16 pA0,pA1,pB0,pB1;
  int sl_prev=0,sl_cur=0,sl_next=SLOTB;
  #define ROT() do{sl_prev=sl_cur;sl_cur=sl_next;sl_next=(sl_next==(NSLOT-1)*SLOTB)?0:sl_next+SLOTB;}while(0)
  DMA_K(2,2*SLOTB);
  WAIT_BAR(3);
  qkt(pA0,pA1,Kbase,qr,negm,r32,hi);asm volatile("s_nop 15\n\ts_nop 7":"+v"(pA0),"+v"(pA1));CMASK(pA0,pA1,0);
  START(pA0,pA1);
  _Pragma("unroll") for(int r=0;r<16;++r)pA1[r]=__builtin_amdgcn_exp2f(pA1[r]);
  WAIT_BAR(0);
  DMA_K(3,0);DMA_V(1,SLOTB);
  ROT();
  kload8(kf,kp0+sl_cur);
  WAIT_BAR(2);
  s16x4 vlo[8],vhi[8]; u32x4 pw0,pw1,pw2,pw3;
  #define PKW(P,B) cvtpk_s(P[B],P[B+1])
  #define PAF(k) __builtin_bit_cast(bf16x8,pw##k)
  #define VFR(i) (bf16x8){vlo[i][0],vlo[i][1],vlo[i][2],vlo[i][3],vhi[i][0],vhi[i][1],vhi[i][2],vhi[i][3]}
  #define PIN(x) asm volatile("":"+v"(x))
  #define MX3(a,b,c) __builtin_fmaxf(__builtin_fmaxf((a),(b)),(c))
  #define GAPA(MF,A0,A1,A2,A3,W0,W1,PW) do{ MF; sacc+=A0; sacc+=A1; sacc+=A2; sacc+=A3; PIN(sacc); W0; W1; PIN(PW); SBAR(); }while(0)
  #define EX(v) __builtin_amdgcn_exp2f(v)
  #define GAPB(MF,X,B) do{ MF; X[B]=EX(X[B]); X[B+1]=EX(X[B+1]); X[B+2]=EX(X[B+2]); X[B+3]=EX(X[B+3]); PIN(X); SBAR(); }while(0)
  #define VRD(i) do{ vlo[i]=vtr(vp_+(((i)>>2)*4096+((i)&3)*1024)); vhi[i]=vtr(vp_+(((i)>>2)*4096+((i)&3)*1024+512)); }while(0)
  #define KRD(G,j) do{ if(G){ kload2(kf,kp0+sl_next,j); SBAR(); } }while(0)
  #define STEP(C0,C1,P0,P1,t,GK,GV,GL) do{ SBAR(); \
    const lds_cptr vp_=vp0+sl_prev; \
    VRD(0); SBAR(); float sacc=(P0[0]+P0[1]); \
    GAPA(C0=__builtin_amdgcn_mfma_f32_32x32x16_bf16(kf[0],qr[0],negm,0,0,0), P0[2],P0[3],P0[4],P0[5],     pw0[0]=PKW(P0,0), pw0[1]=PKW(P0,2), pw0); \
    VRD(4); SBAR(); GAPA(C1=__builtin_amdgcn_mfma_f32_32x32x16_bf16(kf[1],qr[0],negm,0,0,0), P0[6],P0[7],P0[8],P0[9],     pw0[2]=PKW(P0,4), pw0[3]=PKW(P0,6), pw0); \
    VRD(1); SBAR(); GAPA(C0=__builtin_amdgcn_mfma_f32_32x32x16_bf16(kf[2],qr[1],C0,0,0,0),   P0[10],P0[11],P0[12],P0[13], pw1[0]=PKW(P0,8), pw1[1]=PKW(P0,10), pw1); \
    VRD(5); SBAR(); GAPA(C1=__builtin_amdgcn_mfma_f32_32x32x16_bf16(kf[3],qr[1],C1,0,0,0),   P0[14],P0[15],P1[0],P1[1],   pw1[2]=PKW(P0,12),pw1[3]=PKW(P0,14), pw1); \
    VRD(2); SBAR(); GAPA(C0=__builtin_amdgcn_mfma_f32_32x32x16_bf16(kf[4],qr[2],C0,0,0,0),   P1[2],P1[3],P1[4],P1[5],     pw2[0]=PKW(P1,0), pw2[1]=PKW(P1,2), pw2); \
    VRD(6); SBAR(); GAPA(C1=__builtin_amdgcn_mfma_f32_32x32x16_bf16(kf[5],qr[2],C1,0,0,0),   P1[6],P1[7],P1[8],P1[9],     pw2[2]=PKW(P1,4), pw2[3]=PKW(P1,6), pw2); \
    VRD(3); SBAR(); GAPA(C0=__builtin_amdgcn_mfma_f32_32x32x16_bf16(kf[6],qr[3],C0,0,0,0),   P1[10],P1[11],P1[12],P1[13], pw3[0]=PKW(P1,8), pw3[1]=PKW(P1,10), pw3); \
    VRD(7); SBAR(); GAPA(C1=__builtin_amdgcn_mfma_f32_32x32x16_bf16(kf[7],qr[3],C1,0,0,0),   P1[14],P1[15],0.f,0.f,       pw3[2]=PKW(P1,12),pw3[3]=PKW(P1,14), pw3); \
    l_reg+=sacc; \
    if(GK){DMA_K((t)+3,sl_cur);} if(GV){DMA_V((t)+1,sl_next);} \
    CMASK(C0,C1,t); \
    { float a=MX3(C0[0],C0[1],C1[0]),b=MX3(C0[2],C0[3],C1[1]); a=MX3(a,C1[2],C1[3]); \
      _Pragma("unroll") for(int r=4;r<16;r+=4){a=MX3(a,C0[r],C0[r+1]);b=MX3(b,C0[r+2],C0[r+3]);a=MX3(a,C1[r],C1[r+1]);b=MX3(b,C1[r+2],C1[r+3]);} \
      float rm=__builtin_fmaxf(a,b); { auto rr=__builtin_amdgcn_permlane32_swap(__float_as_uint(rm),__float_as_uint(rm),false,false); rm=__builtin_fmaxf(__uint_as_float(rr[0]),__uint_as_float(rr[1])); } \
      resc=false; \
      if(__builtin_expect(__any(rm>(float)THRL),0)){ const float dl=__builtin_fmaxf(rm,0.f); mhat+=dl; \
        _Pragma("unroll") for(int r=0;r<16;++r){C0[r]-=dl;C1[r]-=dl;} \
        _Pragma("unroll") for(int r=0;r<16;++r)negm[r]=-mhat; asm volatile("":"+v"(negm)); \
        const float f=__builtin_amdgcn_exp2f(-dl); l_reg*=f; if(hi==0)wsf[r32]=f; resc=true; } } \
    SBAR(); \
    GAPB(o[0]=__builtin_amdgcn_mfma_f32_32x32x16_bf16(PAF(0),VFR(0),o[0],0,0,0), C0,0); \
    GAPB(o[1]=__builtin_amdgcn_mfma_f32_32x32x16_bf16(PAF(0),VFR(4),o[1],0,0,0), C0,4); \
    KRD(GL,0); GAPB(o[0]=__builtin_amdgcn_mfma_f32_32x32x16_bf16(PAF(1),VFR(1),o[0],0,0,0), C0,8); \
    KRD(GL,1); GAPB(o[1]=__builtin_amdgcn_mfma_f32_32x32x16_bf16(PAF(1),VFR(5),o[1],0,0,0), C0,12); \
    KRD(GL,2); GAPB(o[0]=__builtin_amdgcn_mfma_f32_32x32x16_bf16(PAF(2),VFR(2),o[0],0,0,0), C1,0); \
    KRD(GL,3); GAPB(o[1]=__builtin_amdgcn_mfma_f32_32x32x16_bf16(PAF(2),VFR(6),o[1],0,0,0), C1,4); \
    GAPB(o[0]=__builtin_amdgcn_mfma_f32_32x32x16_bf16(PAF(3),VFR(3),o[0],0,0,0), C1,8); \
    GAPB(o[1]=__builtin_amdgcn_mfma_f32_32x32x16_bf16(PAF(3),VFR(7),o[1],0,0,0), C1,12); \
    }while(0)
  int t=1;
  for(;t+5<NT;t+=2){
    STEP(pB0,pB1,pA0,pA1,t,true,true,true);     WAIT_BAR(2); RESC(); ROT();
    STEP(pA0,pA1,pB0,pB1,t+1,true,true,true);   WAIT_BAR(2); RESC(); ROT();
  }
  #define ENDW(tt) do{ if((tt)+3<NT){WAIT_BAR(2);} else if((tt)+2<NT){WAIT_BAR(1);} else {WAIT_BAR(0);} }while(0)
  for(;t+1<NT;t+=2){
    STEP(pB0,pB1,pA0,pA1,t,(t+3<NT),(t+1<NT),(t+1<NT));       ENDW(t);   RESC(); ROT();
    STEP(pA0,pA1,pB0,pB1,t+1,(t+4<NT),(t+2<NT),(t+2<NT));     ENDW(t+1); RESC(); ROT();
  }
  STEP(pB0,pB1,pA0,pA1,NT-1,false,false,false); RESC();
  { float sacc=pB0[0]+pB0[1]; _Pragma("unroll") for(int r=2;r<16;++r)sacc+=pB0[r]; _Pragma("unroll") for(int r=0;r<16;++r)sacc+=pB1[r]; l_reg+=sacc;
    pw0=(u32x4){PKW(pB0,0),PKW(pB0,2),PKW(pB0,4),PKW(pB0,6)};pw1=(u32x4){PKW(pB0,8),PKW(pB0,10),PKW(pB0,12),PKW(pB0,14)};pw2=(u32x4){PKW(pB1,0),PKW(pB1,2),PKW(pB1,4),PKW(pB1,6)};pw3=(u32x4){PKW(pB1,8),PKW(pB1,10),PKW(pB1,12),PKW(pB1,14)};
    SBAR(); pv(o,vb0+sl_cur,PAF(0),PAF(1),PAF(2),PAF(3)); }
  #undef PKW
  #undef PAF
  #undef VFR
  #undef PIN
  #undef MX3
  #undef GAPA
  #undef GAPB
  #undef EX
  #undef VRD
  #undef KRD
  #undef STEP
  #undef ENDW
  {auto rr=__builtin_amdgcn_permlane32_swap(__float_as_uint(l_reg),__float_as_uint(l_reg),false,false);l_reg=__uint_as_float(rr[0])+__uint_as_float(rr[1]);}
  if(hi==0)wsf[32+r32]=l_reg;asm volatile("s_waitcnt lgkmcnt(0)":::"memory");
  float rli[16];
  #pragma unroll
  for(int r=0;r<16;++r)rli[r]=__builtin_amdgcn_rcpf(wsf[32+crow(r,hi)]);
  bf16*Ow=Op+(long)(wid*QBLK)*opitch;
  { bf16*stg=(bf16*)(shm+LDS_OST)+wid*2048;
    #pragma unroll
    for(int r=0;r<16;++r){const int orow=crow(r,hi);
      #pragma unroll
      for(int d0=0;d0<2;++d0)stg[orow*64+d0*32+r32]=__float2bfloat16(o[d0][r]*rli[r]);}
    asm volatile("s_waitcnt lgkmcnt(0)":::"memory");
    #pragma unroll
    for(int i=0;i<4;++i){const int row=i*8+(lane>>3),ch=lane&7; const u32x4 v=*(const u32x4*)(stg+row*64+ch*8); ATTN_STORE16(Ow+(long)row*opitch+ch*8,v);} }
  asm volatile("s_waitcnt lgkmcnt(0)\n\ts_barrier":::"memory");
  #undef DMA_K
  #undef DMA_V
  #undef CMASK
  #undef START
  #undef RESC
  #undef ROT
}
constexpr int ATTN_LDS_BYTES=LDS_BYTES;
#undef SBAR
#undef WAIT_BAR
}


#define pMOD ((float*)(ws + WS_MOD))
#define pROPE ((float*)(ws + WS_ROPE))
#define pAFF ((float*)(ws + WS_AFF))
#define pINV ((int*)(ws + WS_INV))
#define pDT ((float*)(ws + WS_DT))
#define pSRC ((int*)(ws + WS_SRC))
#define pGV ((float*)(ws + WS_GV))
#define pSSQ ((float*)(ws + WS_SSQ))
#define pTOT ((float*)(ws + WS_TOT))
#define pX ((float*)(ws + WS_X))
#define pH ((bf16_t*)(ws + WS_H))
#define pYAB ((bf16_t*)(ws + WS_YAB))
#define pPA ((bf16_t*)(ws + WS_PA))
#define pPG ((unsigned char*)(ws + WS_PG))
#define pMRGB ((bf16_t*)(ws + WS_MRGB))
#define pY ((bf16_t*)(ws + WS_Y))
#define pXG ((bf16_t*)(ws + WS_XG))
#define pHID ((bf16_t*)(ws + WS_HID))
#define pYE ((bf16_t*)(ws + WS_YE))
#define pQN ((bf16_t*)(ws + WS_QN))
#define pKN ((bf16_t*)(ws + WS_KN))
#define pHIN ((bf16_t*)(ws + WS_HIN))
#define pXBC ((bf16_t*)(ws + WS_XBC))
#define pAU ((bf16_t*)(ws + WS_AU))
#define pSS ((float*)(ws + WS_S))
#define pYG ((bf16_t*)(ws + WS_YG))
#define pS5S ((float*)(ws + WS_S5S))
#define pYCD ((bf16_t*)(ws + WS_YCD))
constexpr int EW7_L0 = 1792, EW7_L1 = 2048, EW_SPLIT1 = EW7_L0 + 2688, EW_SPLIT2 = EW_SPLIT1 + 4480, EW1_SPLIT = 3072;
struct Args { const float* in[38]; float* out; unsigned char* ws; int ph_lo, ph_hi; };
constexpr int PH_PER_LAYER = 15, PH_FINAL = 2 * PH_PER_LAYER, PH_TOTAL = PH_FINAL + 1;

DI LayerIn layer_in(const Args& a, int L) {
    LayerIn P;
    P.norm_mix_g = a.in[6] + (size_t)L * 1024; P.norm_ffn_g = a.in[7] + (size_t)L * 1024;
    P.w_in = a.in[8] + (size_t)L * 1024 * NIN; P.q_norm_g = a.in[9] + L * 64; P.k_norm_g = a.in[10] + L * 64;
    P.ssd_conv_w = a.in[11] + L * 3 * 768; P.ssd_conv_b = a.in[12] + L * 768; P.ssd_dt_bias = a.in[13] + L * 16; P.ssd_a_log = a.in[14] + L * 16;
    P.ssd_d = a.in[15] + L * 8; P.ssd_norm_g = a.in[16] + L * 512;
    P.s5_lre = a.in[17] + L * 2 * 24 * 64; P.s5_lim = a.in[18] + L * 2 * 24 * 64; P.s5_lstep = a.in[19] + L * 48;
    P.s5_bre = a.in[20] + (size_t)L * 24 * 64 * 16; P.s5_bim = a.in[21] + (size_t)L * 24 * 64 * 16; P.s5_cre = a.in[22] + (size_t)L * 24 * 16 * 64; P.s5_cim = a.in[23] + (size_t)L * 24 * 16 * 64;
    P.s5_d = a.in[24] + L * 384; P.s5_wglu = a.in[25] + (size_t)L * 384 * 384; P.s5_bglu = a.in[26] + L * 384; P.sc_conv_w = a.in[27] + L * 3 * 384;
    P.w_br_attn = a.in[28] + (size_t)L * 512 * 1024; P.w_br_ssd = a.in[29] + (size_t)L * 512 * 1024; P.w_br_s5 = a.in[30] + (size_t)L * 384 * 1024; P.w_br_sc = a.in[31] + (size_t)L * 384 * 1024;
    P.w_out = a.in[32] + (size_t)L * 1024 * 1024; P.w_router = a.in[33] + (size_t)L * 1024 * 16;
    P.w_gate = a.in[34] + (size_t)L * 16 * 1024 * 1024; P.w_up = a.in[35] + (size_t)L * 16 * 1024 * 1024; P.w_down = a.in[36] + (size_t)L * 16 * 1024 * 1024;
    return P;
}

__global__ void __launch_bounds__(NWAVES * 64, 2) hybrid_fwd(Args args) {
    extern __shared__ __attribute__((aligned(16))) unsigned char lds_raw[];
    Frame F0;
#define F F0
    F.lds = (LAS unsigned char*)lds_raw;
    F.tid = threadIdx.x; F.lane = F.tid & 63; F.wave = __builtin_amdgcn_readfirstlane(F.tid >> 6);
    F.G = gridDim.x; { const int bx = blockIdx.x; F.vcu = (F.G % 8 == 0) ? (bx % 8) * (F.G / 8) + bx / 8 : bx; }
    F.gw = F.vcu * NWAVES + F.wave; F.NGW = F.G * NWAVES; F.bid = (int)blockIdx.x;
    unsigned char* ws = args.ws;
    volatile LAS unsigned* MISC = (volatile LAS unsigned*)(F.lds + LDSCTL_OFF);
    for (int u = F.tid; u < (LDS_BYTES - LDSCTL_OFF) / 4; u += NWAVES * 64) ((LAS unsigned*)(F.lds + LDSCTL_OFF))[u] = 0u;
    __syncthreads();
    XcdBarrier bar = xcd_barrier_post((unsigned*)(ws + WS_CTL) + CW_BAR, MISC + 8, (unsigned)gridDim.x);
    const int GH = (int)gridDim.x / 2; const bool chain = (int)blockIdx.x >= GH;
    XcdBarrier bar2 = bar; if (chain) bar2 = xcd_barrier_post((unsigned*)(ws + WS_CTL) + CW_BAR + XCD_BAR_WORDS, MISC + 10, (unsigned)((int)gridDim.x - GH));
    const int lo = args.ph_lo, hi = args.ph_hi;
#ifndef PH_MASK
#define PH_MASK 0xFFFF
#endif
#define IN(k) (lo <= (k) && (k) < hi)
#define INL(j) (((PH_MASK >> (j)) & 1) && IN(base + (j)))
#ifndef REPEAT_MASK
#define REPEAT_MASK 0
#endif
#define REP(j) for (int rep_ = 0; rep_ < 1 + ((REPEAT_MASK >> (j)) & 1); ++rep_)
#ifndef SP_AMP
#define SP_AMP 0
#endif
#ifndef SP_WG
#define SP_WG 0
#endif
#ifndef SP_MAXLO
#define SP_MAXLO 0
#define SP_MAXHI 0
#endif
#define PRESTAMP(k) do { if (SP_AMP && threadIdx.x == 0) { const unsigned t_ = (unsigned)__builtin_amdgcn_s_memrealtime(); if (blockIdx.x == SP_WG) MISC[128 + (k)] = t_; \
    if ((int)blockIdx.x >= SP_MAXLO && (int)blockIdx.x < SP_MAXHI) atomicMax((unsigned*)(ws + WS_CTL) + 32768 + (k), t_); } } while (0)
#define SEAM(k) do { if (IN((k) + 1)) xcd_barrier(bar); if (SP_AMP && blockIdx.x == SP_WG && threadIdx.x == 0) MISC[64 + (k)] = (unsigned)__builtin_amdgcn_s_memrealtime(); } while (0)
    if (SP_AMP && blockIdx.x == SP_WG && threadIdx.x == 0) MISC[63] = (unsigned)__builtin_amdgcn_s_memrealtime();

#undef F
#pragma unroll 1
    for (int L = 0; L < 2; ++L) {
        const int base = L * PH_PER_LAYER;
        if (hi <= base || lo >= base + PH_PER_LAYER) continue;
        const bool lastL = (L == 1);

        if (L == 0 && INL(0)) REP(0) { const LayerIn P = layer_in(args, L); Frame F = F0; F.tid = fresh_tid(); F.lane = F.tid & 63; if (rep_) xcd_barrier(bar);
#ifndef SUBREP_MOD
#define SUBREP_MOD 0
#endif
#ifndef SUBREP_S5
#define SUBREP_S5 0
#endif
#ifndef SUBREP_SW
#define SUBREP_SW 0
#endif
            prep_s5(F, P, ws);
            for (int q_ = 0; q_ <= SUBREP_MOD; ++q_) { prep_mod(F, args.in[1], args.in[3], args.in[4], args.in[5], pMOD, 96); prep_rope(F, pROPE, 96); }
            for (int q_ = 0; q_ <= SUBREP_SW; ++q_) prep_small_weights(F, P, ws, 0, 96);
            SEAM(base + 0);
        }
        if (INL(1)) REP(1) { const LayerIn P = layer_in(args, L); Frame F = F0; F.tid = fresh_tid(); F.lane = F.tid & 63; if (rep_) xcd_barrier(bar);
            if (L == 0) phase_norm1<false, 3>(F, L, args.in[0], args.in[2], pX, pH, pMOD, P.norm_mix_g, pINV, pYE, pY, 0); else phase_norm1<true, 2>(F, L, args.in[0], args.in[2], pX, pH, pMOD, P.norm_mix_g, pINV, pYE, pY, 0); SEAM(base + 1); }
        if (INL(2)) REP(2) { const LayerIn P = layer_in(args, L); Frame F = F0; F.tid = fresh_tid(); F.lane = F.tid & 63; if (rep_) xcd_barrier(bar);
            pg8::Gemm g{pH, (const bf16_t*)(ws + W_WIN), 1024, 1024, 1024};
            RowSkipOrder S; S.init(NPROJ, F.G, (int)blockIdx.x, lastL ? 1 : 0, 2, 10);
            EpiProj E{pPA, PA_W, PA_W / 256, pPG};
            pg8::gemm_phase<EpiProj, RowSkipOrder>(F.lds, g, S, E);
            SEAM(base + 2);
        }
        if (INL(3)) REP(3) { const LayerIn P = layer_in(args, L); Frame F = F0; F.tid = fresh_tid(); F.lane = F.tid & 63; if (rep_) xcd_barrier(bar); phase_elem(F, P, pPA, pROPE, pQN, pKN, pXBC, pDT, pAU, pYCD); SEAM(base + 3); }
        if (INL(4)) { const LayerIn P = layer_in(args, L); Frame F = F0; F.tid = fresh_tid(); F.lane = F.tid & 63;
            if (!chain) {
                using abf = attn_body::bf16;
                const int a = (int)blockIdx.x, av = (GH % 8 == 0) ? (a % 8) * (GH / 8) + a / 8 : a;
                { pg8::Gemm g{pAU, (const bf16_t*)(ws + W_P), 768, 512, 512}; OrderS5S S{GH, (a + GH - 56) % GH}; EpiS5S E{pS5S};
                  pg8::gemm_phase<EpiS5S, OrderS5S>(F.lds, g, S, E);
                  if (((a + GH - 56) % GH) < 72) { asm volatile("s_waitcnt vmcnt(0)" ::: "memory"); __syncthreads();
                      if (F.tid == 0) { __builtin_amdgcn_fence(__ATOMIC_RELEASE, "agent"); asm volatile("s_waitcnt vmcnt(0)" ::: "memory"); (void)xb_add((unsigned*)(ws + WS_CTL) + CW_S5CNT + 64 * L, 1u); } } }
                for (int u = av; u < 512; u += GH) { const int bk = u >> 5, r = u & 31, b = bk >> 1, kvh = bk & 1, h = kvh * 4 + (r >> 3), qb = r & 7;
                    const size_t qrow = (size_t)b * PB + CTXL + qb * 256, krow = (size_t)b * PB;
                    attn_body::attn_unit<8>((const abf*)(pQN + qrow * 512 + h * 64), 512, (const abf*)(pKN + krow * 128 + kvh * 64), 128, (const abf*)(pPA + krow * PA_W + C_V + kvh * 64), PA_W,
                                            (abf*)(pYAB + qrow * 1024 + h * 64), 1024, 36, (char*)lds_raw); }
                if (!lastL) for (int u = av; u < 64; u += GH) { const int b = u >> 3, h = u & 7, kvh = h >> 2; const size_t krow = (size_t)b * PB;
                    attn_body::attn_unit<8>((const abf*)(pQN + krow * 512 + h * 64), 512, (const abf*)(pKN + krow * 128 + kvh * 64), 128, (const abf*)(pPA + krow * PA_W + C_V + kvh * 64), PA_W,
                                            (abf*)(pYAB + krow * 1024 + h * 64), 1024, 4, (char*)lds_raw); }
            } else {
                const int GC = F.G - GH, rk = (int)blockIdx.x - GH;
                Frame Fc = F; Fc.G = GC; Fc.bid = rk; Fc.vcu = (GC % 8 == 0) ? (rk % 8) * (GC / 8) + rk / 8 : rk; Fc.gw = Fc.vcu * NWAVES + F.wave; Fc.NGW = GC * NWAVES;
                ssd_chunk_states(Fc, P, pXBC, pDT, pSS, pTOT);
                xcd_barrier(bar2);
                ssd_recurrence(Fc, pSS, pTOT, pHIN);
                { if (F.tid == 0) { unsigned* cw = (unsigned*)(ws + WS_CTL) + CW_S5CNT + 64 * L; unsigned sp = 0;
                      while (xb_ld(cw) < 72u) { __builtin_amdgcn_s_sleep(1); if (++sp > (1u << 22)) break; }
                      __builtin_amdgcn_fence(__ATOMIC_ACQUIRE, "agent"); asm volatile("s_waitcnt vmcnt(0)" ::: "memory"); }
                  __syncthreads(); }
                s5_recurrence(Fc, P, pS5S, pAU);
                xcd_barrier(bar2);
                ssd_output(Fc, P, pXBC, pPA, pDT, pHIN, pYAB, pSSQ, lastL);
                { pg8::Gemm g{pAU, (const bf16_t*)(ws + W_TQ), 768, 768, 768}; OrderS5Y S{GC, (rk + GC - 32) % GC}; EpiS5Y E{pAU, pYG, P.s5_d};
                  pg8::gemm_phase<EpiS5Y, OrderS5Y>(F.lds, g, S, E); }
            }
            PRESTAMP(base + 6); SEAM(base + 6);
        }
        if (INL(7)) REP(7) { const LayerIn P = layer_in(args, L); Frame F = F0; F.tid = fresh_tid(); F.lane = F.tid & 63; if (rep_) xcd_barrier(bar);
            pg8::Gemm g{pYG, (const bf16_t*)(ws + W_GLU), 384, 384, 384};
            RowSkipOrder S; S.init(512, F.G, (int)blockIdx.x, lastL ? 1 : 0, 0, 0);
            EpiGlu E{pYG, pYCD, P.s5_bglu};
            pg8::gemm_phase<EpiGlu, RowSkipOrder>(F.lds, g, S, E);
            if (!lastL) prep_expert_weights(F, P, ws, 144, 0, EW7_L0); else prep_expert_weights(F, P, ws, 128, 2 * 4096, 2 * 4096 + EW7_L1);
            SEAM(base + 7);
        }
        if (INL(8)) REP(8) { const LayerIn P = layer_in(args, L); Frame F = F0; F.tid = fresh_tid(); F.lane = F.tid & 63; if (rep_) xcd_barrier(bar);
            MergeOrder S; S.init(F.G, (int)blockIdx.x, lastL ? 1 : 0);
            pg8::MergeArgs MA{pYAB, pYCD, (const bf16_t*)(ws + W_BR4), pPG, pSSQ, pMRGB};
            pg8::gemm_merge_phase<MergeOrder>(F.lds, MA, S);
            if (!lastL) { __syncthreads(); const LayerIn P1 = layer_in(args, 1); prep_s5(F, P1, ws, 64); __syncthreads(); prep_expert_weights(F, P, ws, 160, EW7_L0, EW_SPLIT1); }
            SEAM(base + 8);
        }
        if (INL(9)) REP(9) { const LayerIn P = layer_in(args, L); Frame F = F0; F.tid = fresh_tid(); F.lane = F.tid & 63; if (rep_) xcd_barrier(bar);
            pg8::Gemm g{pMRGB, (const bf16_t*)(ws + W_OUT), 1024, 1024, 1024};
            RowSkipOrder S; S.init(1024, F.G, (int)blockIdx.x, lastL ? 1 : 0, 0, 0);
            EpiWout E{pY};
            pg8::gemm_phase<EpiWout, RowSkipOrder>(F.lds, g, S, E);
            if (!lastL) { __syncthreads(); const LayerIn P1 = layer_in(args, 1); prep_small_weights(F, P1, ws, 1, 32); prep_expert_weights(F, P, ws, 32, EW_SPLIT1, EW_SPLIT2); }
            SEAM(base + 9);
        }
        if (INL(10)) REP(10) { const LayerIn P = layer_in(args, L); Frame F = F0; F.tid = fresh_tid(); F.lane = F.tid & 63; if (rep_) xcd_barrier(bar); phase_norm2<3>(F, L, lastL, args.in[0], args.in[2], pX, pY, pH, pMOD, P.norm_ffn_g, P.w_router, pAFF); SEAM(base + 10); }
        if (INL(11)) REP(11) { const LayerIn P = layer_in(args, L); Frame F = F0; F.tid = fresh_tid(); F.lane = F.tid & 63; if (rep_) xcd_barrier(bar); phase_topk(F, lastL ? 128 : 256, pAFF, pSRC, pGV, pINV);
            if (L == 0) { const LayerIn P1 = layer_in(args, 1); prep_small_weights(F, P1, ws, 2, 0); }
            prep_expert_weights(F, P, ws, (L == 0) ? 0 : 128, (L == 0) ? EW_SPLIT2 : 2 * 4096 + EW7_L1, EXPERT_W_ITEMS); SEAM(base + 12); }
        if (INL(13)) REP(13) { const LayerIn P = layer_in(args, L); Frame F = F0; F.tid = fresh_tid(); F.lane = F.tid & 63; if (rep_) xcd_barrier(bar);
            pg8::Gemm g{pH, lastL ? (const bf16_t*)args.out : (const bf16_t*)(ws + WS_WGU), 1024, 1024, 1024}; OrderUp S{F.G, (int)blockIdx.x, lastL ? 8 : 9}; EpiUp E{pHID};
            pg8::gemm_phase_gather<EpiUp, OrderUp>(F.lds, g, pSRC, S, E);
            if (!lastL) { __syncthreads(); const LayerIn P1 = layer_in(args, 1); prep_expert_weights(F, P1, ws, 128, 0, EW1_SPLIT, (bf16_t*)args.out); }
            SEAM(base + 13);
        }
        if (INL(14)) REP(14) { const LayerIn P = layer_in(args, L); Frame F = F0; F.tid = fresh_tid(); F.lane = F.tid & 63; if (rep_) xcd_barrier(bar);
            pg8::Gemm g{pHID, (const bf16_t*)(ws + WS_WD), 1024, 1024, 1024}; OrderDown S{F.G, (int)blockIdx.x, lastL ? 8 : 9}; EpiDown E{pYE, pGV};
            pg8::gemm_phase<EpiDown, OrderDown>(F.lds, g, S, E);
            if (!lastL) { __syncthreads(); const LayerIn P1 = layer_in(args, 1); prep_expert_weights(F, P1, ws, 64, EW1_SPLIT, 2 * 4096, (bf16_t*)args.out); }
            SEAM(base + 14);
        }
    }
#if E3_PROBE
    if (blockIdx.x == 0 && threadIdx.x == 0) { const unsigned long long t0_ = __builtin_amdgcn_s_memrealtime(), w_ = 20ull * g_probe_ticks; while (__builtin_amdgcn_s_memrealtime() - t0_ < w_) __builtin_amdgcn_s_sleep(8); g_probe_ticks = 0; }
    __syncthreads();
#endif
#if SP_AMP
    if (blockIdx.x == SP_WG && threadIdx.x == 0) {
#ifdef SP_MAXK
        unsigned w_ = __hip_atomic_load((unsigned*)(ws + WS_CTL) + 32768 + SP_MAXK, __ATOMIC_RELAXED, __HIP_MEMORY_SCOPE_AGENT) - MISC[64 + SP_A];
#else
        unsigned w_ = MISC[64 + SP_B] - MISC[64 + SP_A];
#endif
#ifdef SP_B2
        w_ += MISC[64 + SP_B2] - MISC[64 + SP_A2];
#endif
        const unsigned long long t0_ = __builtin_amdgcn_s_memrealtime(), ww_ = (unsigned long long)SP_AMP * w_; while (__builtin_amdgcn_s_memrealtime() - t0_ < ww_) __builtin_amdgcn_s_sleep(8); }
    __syncthreads();
#endif
#ifdef EXTRA_BARRIERS
    for (int eb = 0; eb < EXTRA_BARRIERS; ++eb) xcd_barrier(bar);
#endif
    if (IN(PH_FINAL)) { Frame F = F0; F.tid = fresh_tid(); F.lane = F.tid & 63; phase_final<2>(F, pX, args.out, pMOD, args.in[37], pINV, pYE, pY); }
#undef IN
#undef INL
#undef SEAM
}

#ifndef MK_N_LAUNCHES
#define MK_N_LAUNCHES 1
#endif
extern "C" void kernel_launch(void* const* d_in, const int* in_sizes, int n_in, void* d_out, int out_size, void* d_ws, size_t ws_size, hipStream_t stream) {
    static int grid = 0;
    if (grid == 0) {
        if (n_in != 38 || ws_size < WS_END) { fprintf(stderr, "kernel_launch: unexpected inputs (n_in %d, ws %zu)\n", n_in, ws_size); grid = -1; return; }
        int dev = 0, cus = 0;
        if (hipGetDevice(&dev) != hipSuccess || hipDeviceGetAttribute(&cus, hipDeviceAttributeMultiprocessorCount, dev) != hipSuccess) { grid = -1; return; }
        if (hipFuncSetAttribute((const void*)hybrid_fwd, hipFuncAttributeMaxDynamicSharedMemorySize, LDS_BYTES) != hipSuccess) { fprintf(stderr, "kernel_launch: hipFuncSetAttribute failed\n"); grid = -1; return; }
        (void)hipGetLastError();
        grid = (cus / 8) * 8;
        if (grid > 256) grid = 256;
    }
    if (grid < 0) return;
    if (hipMemsetAsync((char*)d_ws + WS_CTL, 0, CTL_ZERO_BYTES, stream) != hipSuccess) return;
    Args a{};
    for (int i = 0; i < 38; ++i) a.in[i] = (const float*)d_in[i];
    a.out = (float*)d_out; a.ws = (unsigned char*)d_ws;
#if MK_N_LAUNCHES == 1
    a.ph_lo = 0; a.ph_hi = PH_TOTAL;
    hipLaunchKernelGGL(hybrid_fwd, dim3(grid), dim3(NWAVES * 64), LDS_BYTES, stream, a);
#else
    for (int p = 0; p < PH_TOTAL; ++p) { a.ph_lo = p; a.ph_hi = p + 1; hipLaunchKernelGGL(hybrid_fwd, dim3(grid), dim3(NWAVES * 64), LDS_BYTES, stream, a); }
#endif
}
```

```cpp
#include <hip/hip_runtime.h>
#include <hip/hip_bf16.h>
#include <cstdio>
#include <cstdint>
#include <cmath>

#define DI __device__ __forceinline__
#define GAS __attribute__((address_space(1)))
#define LAS __attribute__((address_space(3)))
typedef unsigned short bf16_t;
typedef short bf16x8 __attribute__((ext_vector_type(8)));
typedef short s16x4 __attribute__((ext_vector_type(4)));
typedef float f32x2 __attribute__((ext_vector_type(2)));
typedef float f32x4 __attribute__((ext_vector_type(4)));
typedef float f32x16 __attribute__((ext_vector_type(16)));
typedef unsigned u32x2 __attribute__((ext_vector_type(2)));
typedef unsigned u32x4 __attribute__((ext_vector_type(4)));
typedef GAS unsigned gu32;

constexpr int DM = 1024, NB = 8, SEQ = 2048, CTXL = 256, PB = 2304, MROWS = NB * PB;
constexpr int NIN = 7688, NE = 16, EFF = 1024;
constexpr int C_Q = 0, C_K = 512, C_V = 640, C_Z = 768, C_XBC = 1280, C_DT = 2048, C_U = 2056, C_SB = 2440, C_SG = 2824, C_SH = 3208, C_G = 3592;
constexpr int PA_W = 3840, PG_W = 4096, NPROJ = PA_W + PG_W;
constexpr int EROWS = 2304;
constexpr float RMS_EPS = 1e-6f;
constexpr float ATT_C2 = 0.125f * 1.4426950408889634f;

constexpr size_t MiB = 1u << 20;
constexpr size_t WS_CTL = 0, CTL_ZERO_BYTES = 1 * MiB;
constexpr size_t WS_MOD = 1 * MiB;
constexpr size_t WS_ROPE = WS_MOD + 512 * 1024;
constexpr size_t WS_AFF = 2 * MiB;
constexpr size_t WS_INV = WS_AFF + 1280 * 1024;
constexpr size_t WS_DT = WS_INV + 1280 * 1024;
constexpr size_t WS_SRC = WS_DT + 1280 * 1024;
constexpr size_t WS_GV = WS_SRC + 256 * 1024;
constexpr size_t WS_SSQ = WS_GV + 256 * 1024;
constexpr size_t WS_TOT = WS_SSQ + 256 * 1024;
constexpr size_t WS_X = 8 * MiB;
constexpr size_t WS_W = 80 * MiB;
constexpr size_t W_WIN = WS_W;
constexpr size_t W_BR4 = W_WIN + (size_t)NPROJ * 1024 * 2;
constexpr size_t W_OUT = W_BR4 + (size_t)1024 * 1792 * 2;
constexpr size_t W_GLU = W_OUT + 1024 * 1024 * 2;
constexpr size_t W_TQ = W_GLU + 512 * 384 * 2;
constexpr size_t W_P = W_TQ + (size_t)24 * 512 * 768 * 2;
constexpr size_t W_END = W_P + (size_t)24 * 256 * 512 * 2;
constexpr size_t WS_H = 126 * MiB;
constexpr size_t WS_YAB = WS_H;
constexpr size_t WS_PA = 162 * MiB;
constexpr size_t WS_MRGB = WS_PA, WS_XG = WS_PA, WS_Y = WS_PA + 72 * MiB;
constexpr size_t WS_PG = 297 * MiB;
constexpr size_t WS_HID = WS_PG, WS_YE = WS_PG + 72 * MiB;
constexpr size_t WS_R5 = 441 * MiB;
constexpr size_t WS_QN = WS_R5;
constexpr size_t WS_KN = WS_R5 + 18 * MiB;
constexpr size_t WS_HIN = WS_PG + 72 * MiB;
constexpr size_t WS_XBC = WS_R5 + 22 * MiB + 512 * 1024;
constexpr size_t WS_AU = WS_R5 + 49 * MiB + 512 * 1024;
constexpr size_t WS_S = WS_R5 + 70 * MiB;
constexpr size_t WS_YG = WS_S;
constexpr size_t WS_S5S = WS_R5 + 106 * MiB;
constexpr size_t WS_YCD = WS_S5S + 13 * MiB + 512 * 1024;
constexpr size_t WS_WGU = WS_R5;
constexpr size_t WS_WD = WS_PA + 36 * MiB;
constexpr size_t WS_END = WS_YCD + 27 * MiB;
static_assert(W_END <= WS_H, "small weights fit");
static_assert(WS_AU + (size_t)24 * 576 * 768 * 2 <= WS_S && WS_XBC + (size_t)MROWS * 768 * 2 <= WS_AU && WS_S + (size_t)8 * 18 * 16 * 4096 * 4 <= WS_S5S, "R5 map");
static_assert(WS_S5S + (size_t)24 * 576 * 256 * 4 <= WS_YCD && WS_YCD + (size_t)MROWS * 768 * 2 <= WS_END && WS_WD + (size_t)32 * MiB <= WS_Y && WS_MRGB + (size_t)MROWS * 1024 * 2 <= WS_WD && WS_WGU + (size_t)64 * MiB <= WS_S && WS_END <= (size_t)588 * MiB, "R5 map 2");
static_assert(WS_TOT + 16384 <= WS_X && WS_ROPE + 2048 * 64 * 4 <= WS_AFF, "misc map");

constexpr int CW_BAR = 4096;
constexpr int CW_S5CNT = 16384;

constexpr int NWAVES = 8;
constexpr int LDS_SCRATCH = 151552;
constexpr int LDSCTL_OFF = LDS_SCRATCH;
constexpr int LDS_BYTES = 155648;

#define LDS_WAIT() asm volatile("s_waitcnt lgkmcnt(0)" ::: "memory")
#define VM_WAIT() asm volatile("s_waitcnt vmcnt(0)" ::: "memory")
DI int fresh_tid() { int t = threadIdx.x; asm volatile("" : "+v"(t)); return t; }
DI unsigned f2bf(float f) { unsigned u = __builtin_bit_cast(unsigned, f); return (u + 0x7fffu + ((u >> 16) & 1u)) >> 16; }
DI unsigned pk2(float lo, float hi) { typedef __bf16 bf2_t __attribute__((ext_vector_type(2))); f32x2 v = {lo, hi}; bf2_t b = __builtin_convertvector(v, bf2_t); return __builtin_bit_cast(unsigned, b); }
DI float bflo(unsigned w) { return __builtin_bit_cast(float, w << 16); }
DI float bfhi(unsigned w) { return __builtin_bit_cast(float, w & 0xffff0000u); }
DI float bf2f(bf16_t h) { return __builtin_bit_cast(float, (unsigned)h << 16); }
DI float silu_f(float x) { return x * __builtin_amdgcn_rcpf(1.f + __expf(-x)); }
DI float sigmoid_f(float x) { return __builtin_amdgcn_rcpf(1.f + __expf(-x)); }
DI float softplus_f(float x) { const float e = __expf(-fabsf(x)); const float l = (e < 1e-3f) ? e * (1.f - 0.5f * e) : __logf(1.f + e); return fmaxf(x, 0.f) + l; }
DI float gelu_tanh_f(float x) { const float u = 0.7978845608028654f * (x + 0.044715f * x * x * x); const float t = 1.f - 2.f * __builtin_amdgcn_rcpf(__expf(2.f * u) + 1.f); return 0.5f * x * (1.f + t); }
DI int lane_op() { int l = (int)__builtin_amdgcn_mbcnt_hi(~0u, __builtin_amdgcn_mbcnt_lo(~0u, 0u)); asm volatile("" : "+v"(l)); return l; }
DI float shup(float v, int d, int l) { return __builtin_bit_cast(float, __builtin_amdgcn_ds_bpermute(((l >= d) ? l - d : l) << 2, __builtin_bit_cast(int, v))); }
DI int shup(int v, int d, int l) { return __builtin_amdgcn_ds_bpermute(((l >= d) ? l - d : l) << 2, v); }
DI float shidx(float v, int src) { return __builtin_bit_cast(float, __builtin_amdgcn_ds_bpermute(src << 2, __builtin_bit_cast(int, v))); }
DI float wave_sum(float v) {
#pragma unroll
    for (int o = 1; o < 64; o <<= 1) v += __shfl_xor(v, o);
    return v;
}
DI void unpack8(const u32x4 w, float (&f)[8]) {
    f[0] = bflo(w.x); f[1] = bfhi(w.x); f[2] = bflo(w.y); f[3] = bfhi(w.y); f[4] = bflo(w.z); f[5] = bfhi(w.z); f[6] = bflo(w.w); f[7] = bfhi(w.w);
}
DI u32x4 pack8(const float (&f)[8]) { u32x4 w; w.x = pk2(f[0], f[1]); w.y = pk2(f[2], f[3]); w.z = pk2(f[4], f[5]); w.w = pk2(f[6], f[7]); return w; }

#define XB_TMO      128
#define XB_XCNT(j)  (256  + 64 * (j))
#define XB_XSUB(j)  (1280 + 64 * (j))
#define XB_XGEN(j)  (2304 + 64 * (j))
#define XB_TOP      3328
#define XB_TOPGEN   3392
#define XCD_BAR_WORDS 3456
#define XB_SPIN_CAP (1u << 20)
DI unsigned xb_ld(unsigned* p)              { return __hip_atomic_load(p, __ATOMIC_RELAXED, __HIP_MEMORY_SCOPE_AGENT); }
DI unsigned xb_add(unsigned* p, unsigned v) { return __hip_atomic_fetch_add(p, v, __ATOMIC_RELAXED, __HIP_MEMORY_SCOPE_AGENT); }
DI unsigned xb_xcc_id() { return (unsigned)__builtin_amdgcn_s_getreg((3 << 11) | 20) & 0xFu; }
#define XB_SPIN(cond, bar) do { unsigned _sp = 0; while (cond) { __builtin_amdgcn_s_sleep(1); \
    if ((++_sp & 255u) == 0u) { if (xb_ld(&(bar)[XB_TMO])) break; if (_sp > XB_SPIN_CAP) { atomicAdd(&(bar)[XB_TMO], 1u); break; } } } } while (0)
struct XcdBarrier { unsigned* bar; unsigned x; volatile LAS unsigned* st; unsigned G; };
DI XcdBarrier xcd_barrier_post(unsigned* bar, volatile LAS unsigned* st, unsigned G) {
    XcdBarrier b; b.bar = bar; b.x = xb_xcc_id(); b.st = st; b.G = G;
    if (threadIdx.x == 0) (void)xb_add(&bar[XB_XCNT(b.x)], 1u);
    return b;
}
DI void xcd_barrier_complete(unsigned* bar, unsigned x, unsigned& nloc, unsigned& nx, unsigned G) {
    unsigned sum, cnt, mine, sp = 0u;
    for (;;) {
        sum = 0u; cnt = 0u; mine = 0u;
#pragma unroll
        for (unsigned j = 0; j < 16; ++j) { const unsigned c = xb_ld(&bar[XB_XCNT(j)]); sum += c; cnt += (c > 0u) ? 1u : 0u; mine = (j == x) ? c : mine; }
        if (sum == G) break;
        __builtin_amdgcn_s_sleep(1);
        if ((++sp & 255u) == 0u) { if (xb_ld(&bar[XB_TMO])) break; if (sp > XB_SPIN_CAP) { atomicAdd(&bar[XB_TMO], 1u); break; } }
    }
    nloc = mine > 0u ? mine : 1u; nx = cnt > 0u ? cnt : 1u;
}
DI void xcd_barrier(const XcdBarrier& b) {
    asm volatile("s_waitcnt vmcnt(0)" ::: "memory");
    __syncthreads();
    if (threadIdx.x == 0) {
        unsigned* bar = b.bar;
        asm volatile("" : "+s"(bar));
        __builtin_amdgcn_s_waitcnt(0);
        unsigned nloc = b.st[0], nx = b.st[1];
        if (nloc == 0u) { xcd_barrier_complete(bar, b.x, nloc, nx, b.G); b.st[0] = nloc; b.st[1] = nx; }
        const unsigned old = xb_add(&bar[XB_XSUB(b.x)], 1u);
        const unsigned gen = old / nloc;
        if (old + 1u == (gen + 1u) * nloc) {
#ifndef NO_RELEASE_PROBE
            __builtin_amdgcn_fence(__ATOMIC_RELEASE, "agent");
#endif
            asm volatile("s_waitcnt vmcnt(0)" ::: "memory");
            const unsigned og = xb_add(&bar[XB_TOP], 1u);
            const unsigned tg = og / nx;
            if (og + 1u == (tg + 1u) * nx) xb_add(&bar[XB_TOPGEN], 1u);
            else XB_SPIN(xb_ld(&bar[XB_TOPGEN]) == tg, bar);
            __builtin_amdgcn_fence(__ATOMIC_ACQUIRE, "agent");
            asm volatile("s_waitcnt vmcnt(0)" ::: "memory");
        } else {
            XB_SPIN(xb_ld(&bar[XB_TOPGEN]) == gen, bar);
            __builtin_amdgcn_fence(__ATOMIC_ACQUIRE, "agent");
            asm volatile("s_waitcnt vmcnt(0)" ::: "memory");
        }
    }
    __syncthreads();
}

namespace pg8 {
constexpr int BM = 256, BK = 64, HALF = 128, HTB = HALF * BK * 2, STAGE_BYTES = 8 * HTB, NXCD = 8, WGM = 8;
__host__ __device__ __forceinline__ int lds_byte(int r, int c) { const int st = (r >> 4) * 2 + (c >> 5), rr = r & 15, cc = c & 31, ob = rr * 64 + cc * 2; return st * 1024 + (ob ^ (((ob >> 9) & 1) << 5)); }
__host__ __device__ __forceinline__ void stage_rc(int b, int& R, int& C) { const int st = b / 1024, sb = b % 1024, swz = sb ^ (((sb >> 9) & 1) << 5); R = (st >> 1) * 16 + swz / 64; C = (st & 1) * 32 + (swz % 64) / 2; }
__host__ __device__ __forceinline__ int perm32(int rho) { const int n = rho >> 4, i = rho & 15; return 8 * (i >> 2) + 4 * n + (i & 3); }

struct Unit { int arow, brow, pm, pn; };
struct Gemm { const bf16_t* A; const bf16_t* Bt; int lda, ldb, K; };

template <class Epi, class Sched, bool ALIGN_EPI = true>
DI void gemm_phase(LAS unsigned char* lds, const Gemm g, const Sched& S, const Epi& E) {
    const int tid = fresh_tid(), wid = __builtin_amdgcn_readfirstlane(tid >> 6), lane = tid & 63, wr = wid >> 2, wc = wid & 3, fr = lane & 15, fq = lane >> 4;
    const int K = g.K, nt = K / BK;
    unsigned voffA[2], voffB[2];
#pragma unroll
    for (int i = 0; i < 2; ++i) { int R, C; stage_rc(tid * 16 + i * 8192, R, C); const int Rb = Epi::PERM ? ((R & ~31) + perm32(R & 31)) : R;
        voffA[i] = (unsigned)(R * g.lda + C) * 2u; voffB[i] = (unsigned)(Rb * g.ldb + C) * 2u; }
    const size_t kstep = (size_t)(BK * 2);
    const size_t hA = (size_t)HALF * g.lda * 2, hB = (size_t)HALF * g.ldb * 2;
    const unsigned ldsw = (unsigned)wid * 1024u;
    const int aoff = lds_byte(wr * 64 + fr, fq * 8), boff = lds_byte(wc * 32 + fr, fq * 8);
#define PG8_SA(b, h) (((b) * 2 + (h)) * HTB)
#define PG8_SB(b, h) ((4 + (b) * 2 + (h)) * HTB)
#define PG8_STAGE(bufoff, gbase, voff) do { _Pragma("unroll") for (int _i = 0; _i < 2; ++_i) \
        __builtin_amdgcn_global_load_lds((const unsigned*)((const char*)(gbase) + (voff)[_i]), (LAS unsigned*)(lds + (bufoff) + ldsw + _i * 8192), 16, 0, 0); } while (0)
#define PG8_LDA(dst, b, h) do { _Pragma("unroll") for (int m = 0; m < 4; ++m) _Pragma("unroll") for (int k = 0; k < 2; ++k) dst[m][k] = *(const LAS bf16x8*)(lds + PG8_SA(b, h) + aoff + m * 2048 + k * 1024); } while (0)
#define PG8_LDB(dst, b, h) do { _Pragma("unroll") for (int n = 0; n < 2; ++n) _Pragma("unroll") for (int k = 0; k < 2; ++k) dst[n][k] = *(const LAS bf16x8*)(lds + PG8_SB(b, h) + boff + n * 2048 + k * 1024); } while (0)
#define PG8_MMA(ai, bj, At, Bt) do { __builtin_amdgcn_s_setprio(1); _Pragma("unroll") for (int m = 0; m < 4; ++m) _Pragma("unroll") for (int n = 0; n < 2; ++n) _Pragma("unroll") for (int k = 0; k < 2; ++k) \
        acc[ai][bj][m][n] = __builtin_amdgcn_mfma_f32_16x16x32_bf16(Bt[n][k], At[m][k], acc[ai][bj][m][n], 0, 0, 0); __builtin_amdgcn_s_setprio(0); } while (0)
#define PG8_WAIT_V(n) asm volatile("s_waitcnt vmcnt(" #n ")" ::: "memory")
#define PG8_WAIT_L(n) asm volatile("s_waitcnt lgkmcnt(" #n ")" ::: "memory")
#define PG8_BAR __builtin_amdgcn_s_barrier()
#define PG8_SCHED __builtin_amdgcn_sched_barrier(0)
    int ui = 0;
    Unit cur = S.next(0);
    if (cur.arow < 0) return;
    f32x4 acc[2][2][4][2];
#pragma unroll
    for (int a = 0; a < 2; ++a)
#pragma unroll
        for (int b = 0; b < 2; ++b)
#pragma unroll
            for (int m = 0; m < 4; ++m)
#pragma unroll
                for (int n = 0; n < 2; ++n) acc[a][b][m][n] = (f32x4){0.f, 0.f, 0.f, 0.f};
    bf16x8 At[4][2], B0[2][2], B1[2][2];
    const char* cA = (const char*)g.A + (size_t)cur.arow * g.lda * 2; const char* cB = (const char*)g.Bt + (size_t)cur.brow * g.ldb * 2;
    PG8_STAGE(PG8_SB(0, 0), cB, voffB); PG8_STAGE(PG8_SB(0, 1), cB + hB, voffB); PG8_STAGE(PG8_SA(0, 0), cA, voffA); PG8_STAGE(PG8_SA(0, 1), cA + hA, voffA);
    if (wr == 1) PG8_BAR;
    PG8_WAIT_V(2); PG8_BAR;
    PG8_STAGE(PG8_SB(1, 0), cB + kstep, voffB); PG8_STAGE(PG8_SA(1, 0), cA + kstep, voffA); PG8_STAGE(PG8_SB(1, 1), cB + hB + kstep, voffB);
    PG8_WAIT_V(6); PG8_BAR;
    for (;;) {
        const Unit nxt = S.next(ui + 1);
        const bool has_next = nxt.arow >= 0;
        const char* nA = has_next ? (const char*)g.A + (size_t)nxt.arow * g.lda * 2 : cA; const char* nB = has_next ? (const char*)g.Bt + (size_t)nxt.brow * g.ldb * 2 : cB;
#pragma unroll 1
        for (int t = 0; t < nt; t += 2) {
            const bool last = (t == nt - 2);
            const char* a1 = cA + (size_t)(t + 1) * kstep;
            const char* a2 = last ? nA : cA + (size_t)(t + 2) * kstep; const char* b2 = last ? nB : cB + (size_t)(t + 2) * kstep;
            const char* a3 = a2 + kstep; const char* b3 = b2 + kstep;
            PG8_LDB(B0, 0, 0); PG8_LDB(B1, 0, 1); PG8_SCHED; PG8_LDA(At, 0, 0); PG8_STAGE(PG8_SA(1, 1), a1 + hA, voffA);
            PG8_WAIT_V(8); PG8_WAIT_L(0); PG8_BAR; PG8_MMA(0, 0, At, B0); PG8_MMA(0, 1, At, B1); PG8_BAR; PG8_SCHED;
            PG8_LDA(At, 0, 1); PG8_STAGE(PG8_SB(0, 0), b2, voffB); PG8_STAGE(PG8_SB(0, 1), b2 + hB, voffB); PG8_STAGE(PG8_SA(0, 0), a2, voffA);
            PG8_WAIT_V(8); PG8_WAIT_L(0); PG8_BAR; PG8_MMA(1, 0, At, B0); PG8_MMA(1, 1, At, B1); PG8_BAR; PG8_SCHED;
            PG8_LDB(B0, 1, 0); PG8_LDB(B1, 1, 1); PG8_SCHED; PG8_LDA(At, 1, 0); PG8_STAGE(PG8_SA(0, 1), a2 + hA, voffA);
            PG8_WAIT_V(8); PG8_WAIT_L(0); PG8_BAR; PG8_MMA(0, 0, At, B0); PG8_MMA(0, 1, At, B1); PG8_BAR; PG8_SCHED;
            PG8_LDA(At, 1, 1); PG8_STAGE(PG8_SB(1, 0), b3, voffB); PG8_STAGE(PG8_SB(1, 1), b3 + hB, voffB); PG8_STAGE(PG8_SA(1, 0), a3, voffA);
            PG8_WAIT_V(8); PG8_WAIT_L(0); PG8_BAR; PG8_MMA(1, 0, At, B0); PG8_MMA(1, 1, At, B1); PG8_BAR; PG8_SCHED;
        }
        if constexpr (ALIGN_EPI) { if (wr == 0) PG8_BAR; }
        E(acc, cur, wr, wc, fr, fq);
        if (!has_next) break;
#pragma unroll
        for (int a = 0; a < 2; ++a)
#pragma unroll
            for (int b = 0; b < 2; ++b)
#pragma unroll
                for (int m = 0; m < 4; ++m)
#pragma unroll
                    for (int n = 0; n < 2; ++n) acc[a][b][m][n] = (f32x4){0.f, 0.f, 0.f, 0.f};
        cur = nxt; cA = nA; cB = nB; ++ui;
        if constexpr (ALIGN_EPI) { if (wr == 1) PG8_BAR; }
    }
    PG8_WAIT_V(0);
    if constexpr (!ALIGN_EPI) { if (wr == 0) PG8_BAR; }
    PG8_BAR;
#undef PG8_SA
#undef PG8_SB
#undef PG8_STAGE
#undef PG8_LDA
#undef PG8_LDB
#undef PG8_MMA
#undef PG8_WAIT_V
#undef PG8_WAIT_L
#undef PG8_BAR
#undef PG8_SCHED
}

template <class Epi, class Sched, bool ALIGN_EPI = true>
DI void gemm_phase_gather(LAS unsigned char* lds, const Gemm g, const int* __restrict__ grow, const Sched& S, const Epi& E) {
    const int tid = fresh_tid(), wid = __builtin_amdgcn_readfirstlane(tid >> 6), lane = tid & 63, wr = wid >> 2, wc = wid & 3, fr = lane & 15, fq = lane >> 4;
    const int K = g.K, nt = K / BK;
    unsigned voffB[2];
#pragma unroll
    for (int i = 0; i < 2; ++i) { int R, C; stage_rc(tid * 16 + i * 8192, R, C); const int Rb = Epi::PERM ? ((R & ~31) + perm32(R & 31)) : R;
        voffB[i] = (unsigned)(Rb * g.ldb + C) * 2u; }
#define PG8_RA(i_) ([&]{ int R_, C_; stage_rc(tid * 16 + (i_) * 8192, R_, C_); return R_; }())
#define PG8_CA2(i_) ([&]{ int R_, C_; stage_rc(tid * 16 + (i_) * 8192, R_, C_); return (unsigned)C_ * 2u; }())
    unsigned vAc[2][2];
#define PG8_GOFF(dst, arow_) do { _Pragma("unroll") for (int h_ = 0; h_ < 2; ++h_) _Pragma("unroll") for (int i_ = 0; i_ < 2; ++i_) \
        dst[h_][i_] = (unsigned)grow[(arow_) + h_ * HALF + PG8_RA(i_)] * (unsigned)(g.lda * 2) + PG8_CA2(i_); } while (0)
    const size_t kstep = (size_t)(BK * 2);
    const size_t hB = (size_t)HALF * g.ldb * 2;
    const unsigned ldsw = (unsigned)wid * 1024u;
    const int aoff = lds_byte(wr * 64 + fr, fq * 8), boff = lds_byte(wc * 32 + fr, fq * 8);
#define PG8_SA(b, h) (((b) * 2 + (h)) * HTB)
#define PG8_SB(b, h) ((4 + (b) * 2 + (h)) * HTB)
#define PG8_STAGE(bufoff, gbase, voff) do { _Pragma("unroll") for (int _i = 0; _i < 2; ++_i) \
        __builtin_amdgcn_global_load_lds((const unsigned*)((const char*)(gbase) + (voff)[_i]), (LAS unsigned*)(lds + (bufoff) + ldsw + _i * 8192), 16, 0, 0); } while (0)
#define PG8_STAGEA(bufoff, kbyte, vv, hf) do { _Pragma("unroll") for (int _i = 0; _i < 2; ++_i) \
        __builtin_amdgcn_global_load_lds((const unsigned*)((const char*)g.A + (kbyte) + vv[hf][_i]), (LAS unsigned*)(lds + (bufoff) + ldsw + _i * 8192), 16, 0, 0); } while (0)
#define PG8_LDA(dst, b, h) do { _Pragma("unroll") for (int m = 0; m < 4; ++m) _Pragma("unroll") for (int k = 0; k < 2; ++k) dst[m][k] = *(const LAS bf16x8*)(lds + PG8_SA(b, h) + aoff + m * 2048 + k * 1024); } while (0)
#define PG8_LDB(dst, b, h) do { _Pragma("unroll") for (int n = 0; n < 2; ++n) _Pragma("unroll") for (int k = 0; k < 2; ++k) dst[n][k] = *(const LAS bf16x8*)(lds + PG8_SB(b, h) + boff + n * 2048 + k * 1024); } while (0)
#define PG8_MMA(ai, bj, At, Bt) do { __builtin_amdgcn_s_setprio(1); _Pragma("unroll") for (int m = 0; m < 4; ++m) _Pragma("unroll") for (int n = 0; n < 2; ++n) _Pragma("unroll") for (int k = 0; k < 2; ++k) \
        acc[ai][bj][m][n] = __builtin_amdgcn_mfma_f32_16x16x32_bf16(Bt[n][k], At[m][k], acc[ai][bj][m][n], 0, 0, 0); __builtin_amdgcn_s_setprio(0); } while (0)
#define PG8_WAIT_V(n) asm volatile("s_waitcnt vmcnt(" #n ")" ::: "memory")
#define PG8_WAIT_L(n) asm volatile("s_waitcnt lgkmcnt(" #n ")" ::: "memory")
#define PG8_BAR __builtin_amdgcn_s_barrier()
#define PG8_SCHED __builtin_amdgcn_sched_barrier(0)
    int ui = 0;
    Unit cur = S.next(0);
    if (cur.arow < 0) return;
    f32x4 acc[2][2][4][2];
#pragma unroll
    for (int a = 0; a < 2; ++a)
#pragma unroll
        for (int b = 0; b < 2; ++b)
#pragma unroll
            for (int m = 0; m < 4; ++m)
#pragma unroll
                for (int n = 0; n < 2; ++n) acc[a][b][m][n] = (f32x4){0.f, 0.f, 0.f, 0.f};
    bf16x8 At[4][2], B0[2][2], B1[2][2];
    const char* cB = (const char*)g.Bt + (size_t)cur.brow * g.ldb * 2;
    PG8_GOFF(vAc, cur.arow);
    PG8_STAGE(PG8_SB(0, 0), cB, voffB); PG8_STAGE(PG8_SB(0, 1), cB + hB, voffB); PG8_STAGEA(PG8_SA(0, 0), 0, vAc, 0); PG8_STAGEA(PG8_SA(0, 1), 0, vAc, 1);
    if (wr == 1) PG8_BAR;
    PG8_WAIT_V(2); PG8_BAR;
    PG8_STAGE(PG8_SB(1, 0), cB + kstep, voffB); PG8_STAGEA(PG8_SA(1, 0), kstep, vAc, 0); PG8_STAGE(PG8_SB(1, 1), cB + hB + kstep, voffB);
    PG8_WAIT_V(6); PG8_BAR;
    for (;;) {
        const Unit nxt = S.next(ui + 1);
        const bool has_next = nxt.arow >= 0;
        const char* nB = has_next ? (const char*)g.Bt + (size_t)nxt.brow * g.ldb * 2 : cB;
        int rawn[2][2];
#pragma unroll
        for (int h_ = 0; h_ < 2; ++h_)
#pragma unroll
            for (int i_ = 0; i_ < 2; ++i_) rawn[h_][i_] = has_next ? grow[nxt.arow + h_ * HALF + PG8_RA(i_)] : 0;
#pragma unroll 1
        for (int t = 0; t < nt; t += 2) {
            const bool last = (t == nt - 2);
            const size_t k1 = (size_t)(t + 1) * kstep, k2 = last ? 0 : (size_t)(t + 2) * kstep, k3 = k2 + kstep;
            const char* b2 = last ? nB : cB + (size_t)(t + 2) * kstep; const char* b3 = b2 + kstep;
            PG8_LDB(B0, 0, 0); PG8_LDB(B1, 0, 1); PG8_SCHED; PG8_LDA(At, 0, 0); PG8_STAGEA(PG8_SA(1, 1), k1, vAc, 1);
            if (last && has_next) {
#pragma unroll
                for (int h_ = 0; h_ < 2; ++h_)
#pragma unroll
                    for (int i_ = 0; i_ < 2; ++i_) vAc[h_][i_] = (unsigned)rawn[h_][i_] * (unsigned)(g.lda * 2) + PG8_CA2(i_); }
            PG8_WAIT_V(8); PG8_WAIT_L(0); PG8_BAR; PG8_MMA(0, 0, At, B0); PG8_MMA(0, 1, At, B1); PG8_BAR; PG8_SCHED;
            PG8_LDA(At, 0, 1); PG8_STAGE(PG8_SB(0, 0), b2, voffB); PG8_STAGE(PG8_SB(0, 1), b2 + hB, voffB); PG8_STAGEA(PG8_SA(0, 0), k2, vAc, 0);
            PG8_WAIT_V(8); PG8_WAIT_L(0); PG8_BAR; PG8_MMA(1, 0, At, B0); PG8_MMA(1, 1, At, B1); PG8_BAR; PG8_SCHED;
            PG8_LDB(B0, 1, 0); PG8_LDB(B1, 1, 1); PG8_SCHED; PG8_LDA(At, 1, 0); PG8_STAGEA(PG8_SA(0, 1), k2, vAc, 1);
            PG8_WAIT_V(8); PG8_WAIT_L(0); PG8_BAR; PG8_MMA(0, 0, At, B0); PG8_MMA(0, 1, At, B1); PG8_BAR; PG8_SCHED;
            PG8_LDA(At, 1, 1); PG8_STAGE(PG8_SB(1, 0), b3, voffB); PG8_STAGE(PG8_SB(1, 1), b3 + hB, voffB); PG8_STAGEA(PG8_SA(1, 0), k3, vAc, 0);
            PG8_WAIT_V(8); PG8_WAIT_L(0); PG8_BAR; PG8_MMA(1, 0, At, B0); PG8_MMA(1, 1, At, B1); PG8_BAR; PG8_SCHED;
        }
        if constexpr (ALIGN_EPI) { if (wr == 0) PG8_BAR; }
        E(acc, cur, wr, wc, fr, fq);
        if (!has_next) break;
#pragma unroll
        for (int a = 0; a < 2; ++a)
#pragma unroll
            for (int b = 0; b < 2; ++b)
#pragma unroll
                for (int m = 0; m < 4; ++m)
#pragma unroll
                    for (int n = 0; n < 2; ++n) acc[a][b][m][n] = (f32x4){0.f, 0.f, 0.f, 0.f};
        cur = nxt; cB = nB; ++ui;
        if constexpr (ALIGN_EPI) { if (wr == 1) PG8_BAR; }
    }
    PG8_WAIT_V(0);
    if constexpr (!ALIGN_EPI) { if (wr == 0) PG8_BAR; }
    PG8_BAR;
#undef PG8_SA
#undef PG8_SB
#undef PG8_STAGE
#undef PG8_STAGEA
#undef PG8_GOFF
#undef PG8_RA
#undef PG8_CA2
#undef PG8_LDA
#undef PG8_LDB
#undef PG8_MMA
#undef PG8_WAIT_V
#undef PG8_WAIT_L
#undef PG8_BAR
#undef PG8_SCHED
}

struct MergeArgs { const bf16_t* YAB; const bf16_t* YCD; const bf16_t* W4T; const unsigned char* G; const float* ssq; bf16_t* MRGB; };
template <class Sched>
DI void gemm_merge_phase(LAS unsigned char* lds, const MergeArgs M, const Sched& S) {
    const int tid = fresh_tid(), wid = __builtin_amdgcn_readfirstlane(tid >> 6), lane = tid & 63, wr = wid >> 2, wc = wid & 3, fr = lane & 15, fq = lane >> 4;
    constexpr int NT = 28, LDB = 1792;
    unsigned vA0[2], vA1[2], voffB[2];
#pragma unroll
    for (int i = 0; i < 2; ++i) { int R, C; stage_rc(tid * 16 + i * 8192, R, C); const int Rb = (R & ~31) + perm32(R & 31);
        vA0[i] = (unsigned)(R * 1024 + C) * 2u; vA1[i] = (unsigned)(R * 768 + C) * 2u; voffB[i] = (unsigned)(Rb * LDB + C) * 2u; }
    const size_t kstep = (size_t)(BK * 2);
    const unsigned ldsw = (unsigned)wid * 1024u;
    const int aoff = lds_byte(wr * 64 + fr, fq * 8), boff = lds_byte(wc * 32 + fr, fq * 8);
#define PG8_SA(b, h) (((b) * 2 + (h)) * HTB)
#define PG8_SB(b, h) ((4 + (b) * 2 + (h)) * HTB)
#define PG8_STAGEB(bufoff, gbase) do { _Pragma("unroll") for (int _i = 0; _i < 2; ++_i) \
        __builtin_amdgcn_global_load_lds((const unsigned*)((const char*)(gbase) + voffB[_i]), (LAS unsigned*)(lds + (bufoff) + ldsw + _i * 8192), 16, 0, 0); } while (0)
#define PG8_STAGEA(bufoff, arow_, tt, hf) do { const bool ab_ = (tt) < 16; \
        const char* gp_ = ab_ ? (const char*)M.YAB + ((size_t)(arow_) + (hf) * HALF) * 2048 + (size_t)(tt) * 128 : (const char*)M.YCD + ((size_t)(arow_) + (hf) * HALF) * 1536 + (size_t)((tt) - 16) * 128; \
        const unsigned o0_ = ab_ ? vA0[0] : vA1[0], o1_ = ab_ ? vA0[1] : vA1[1]; \
        __builtin_amdgcn_global_load_lds((const unsigned*)(gp_ + o0_), (LAS unsigned*)(lds + (bufoff) + ldsw), 16, 0, 0); \
        __builtin_amdgcn_global_load_lds((const unsigned*)(gp_ + o1_), (LAS unsigned*)(lds + (bufoff) + ldsw + 8192), 16, 0, 0); } while (0)
#define PG8_LDA(dst, b, h) do { _Pragma("unroll") for (int m = 0; m < 4; ++m) _Pragma("unroll") for (int k = 0; k < 2; ++k) dst[m][k] = *(const LAS bf16x8*)(lds + PG8_SA(b, h) + aoff + m * 2048 + k * 1024); } while (0)
#define PG8_LDB(dst, b, h) do { _Pragma("unroll") for (int n = 0; n < 2; ++n) _Pragma("unroll") for (int k = 0; k < 2; ++k) dst[n][k] = *(const LAS bf16x8*)(lds + PG8_SB(b, h) + boff + n * 2048 + k * 1024); } while (0)
#define PG8_MMA(ai, At, Bt) do { __builtin_amdgcn_s_setprio(1); _Pragma("unroll") for (int m = 0; m < 4; ++m) _Pragma("unroll") for (int n = 0; n < 2; ++n) _Pragma("unroll") for (int k = 0; k < 2; ++k) \
        acc[ai][0][m][n] = __builtin_amdgcn_mfma_f32_16x16x32_bf16(Bt[n][k], At[m][k], acc[ai][0][m][n], 0, 0, 0); __builtin_amdgcn_s_setprio(0); } while (0)
#define PG8_WAIT_V(n) asm volatile("s_waitcnt vmcnt(" #n ")" ::: "memory")
#define PG8_WAIT_L(n) asm volatile("s_waitcnt lgkmcnt(" #n ")" ::: "memory")
#define PG8_BAR __builtin_amdgcn_s_barrier()
#define PG8_SCHED __builtin_amdgcn_sched_barrier(0)
    int ui = 0;
    Unit cur = S.next(0);
    if (cur.arow < 0) return;
    f32x4 acc[2][2][4][2];
#pragma unroll
    for (int a = 0; a < 2; ++a)
#pragma unroll
        for (int b = 0; b < 2; ++b)
#pragma unroll
            for (int m = 0; m < 4; ++m)
#pragma unroll
                for (int n = 0; n < 2; ++n) acc[a][b][m][n] = (f32x4){0.f, 0.f, 0.f, 0.f};
    bf16x8 At[4][2], B0[2][2];
    const char* cB = (const char*)M.W4T + (size_t)cur.brow * LDB * 2;
    int carow = cur.arow;
    PG8_STAGEB(PG8_SB(0, 0), cB); PG8_STAGEA(PG8_SA(0, 0), carow, 0, 0); PG8_STAGEA(PG8_SA(0, 1), carow, 0, 1);
    if (wr == 1) PG8_BAR;
    PG8_WAIT_V(2); PG8_BAR;
    PG8_STAGEB(PG8_SB(1, 0), cB + kstep); PG8_STAGEA(PG8_SA(1, 0), carow, 1, 0);
    PG8_WAIT_V(4); PG8_BAR;
    for (;;) {
        const Unit nxt = S.next(ui + 1);
        const bool has_next = nxt.arow >= 0;
        const int narow = has_next ? nxt.arow : carow; const char* nB = has_next ? (const char*)M.W4T + (size_t)nxt.brow * LDB * 2 : cB;
#pragma unroll 1
        for (int t = 0; t < NT; t += 2) {
            const bool last = (t == NT - 2);
            const bool fold_it = (t == 6 || t == 14 || t == 20 || t == 26);
            u32x2 gq[2][4];
            if (fold_it) {
                const int seg = (t == 6) ? 0 : (t == 14) ? 1 : (t == 20) ? 2 : 3;
                int row0 = cur.arow + wr * 64 + fr, col = cur.pn * 128 + wc * 32 + 8 * fq;
                asm volatile("" : "+v"(row0), "+v"(col));
#pragma unroll
                for (int ai = 0; ai < 2; ++ai)
#pragma unroll
                    for (int m = 0; m < 4; ++m) gq[ai][m] = *(const u32x2*)(M.G + (size_t)(row0 + ai * 128 + m * 16) * PG_W + seg * 1024 + col);
            }
            const int t2 = last ? 0 : t + 2, t3 = t2 + 1; const int arow2 = last ? narow : carow;
            const char* b2 = last ? nB : cB + (size_t)(t + 2) * kstep; const char* b3 = b2 + kstep;
            PG8_LDB(B0, 0, 0); PG8_SCHED; PG8_LDA(At, 0, 0); PG8_STAGEA(PG8_SA(1, 1), carow, t + 1, 1);
            PG8_WAIT_V(6); PG8_WAIT_L(0); PG8_BAR; PG8_MMA(0, At, B0); PG8_BAR; PG8_SCHED;
            PG8_LDA(At, 0, 1); PG8_STAGEB(PG8_SB(0, 0), b2); PG8_STAGEA(PG8_SA(0, 0), arow2, t2, 0);
            PG8_WAIT_V(6); PG8_WAIT_L(0); PG8_BAR; PG8_MMA(1, At, B0); PG8_BAR; PG8_SCHED;
            PG8_LDB(B0, 1, 0); PG8_SCHED; PG8_LDA(At, 1, 0); PG8_STAGEA(PG8_SA(0, 1), arow2, t2, 1);
            PG8_WAIT_V(6); PG8_WAIT_L(0); PG8_BAR; PG8_MMA(0, At, B0); PG8_BAR; PG8_SCHED;
            PG8_LDA(At, 1, 1); PG8_STAGEB(PG8_SB(1, 0), b3); PG8_STAGEA(PG8_SA(1, 0), arow2, t3, 0);
            PG8_WAIT_V(6); PG8_WAIT_L(0); PG8_BAR; PG8_MMA(1, At, B0); PG8_BAR; PG8_SCHED;
            if (fold_it) {
                float rs[2][4];
#pragma unroll
                for (int ai = 0; ai < 2; ++ai)
#pragma unroll
                    for (int m = 0; m < 4; ++m) rs[ai][m] = 1.f / 255.f;
                if (t == 14) {
                    int rowq = cur.arow + wr * 64 + fr; asm volatile("" : "+v"(rowq));
                    f32x2 q2[2][4];
#pragma unroll
                    for (int ai = 0; ai < 2; ++ai)
#pragma unroll
                        for (int m = 0; m < 4; ++m) q2[ai][m] = *(const f32x2*)(M.ssq + 2 * (size_t)(rowq + ai * 128 + m * 16));
#pragma unroll
                    for (int ai = 0; ai < 2; ++ai)
#pragma unroll
                        for (int m = 0; m < 4; ++m) rs[ai][m] = __builtin_amdgcn_rsqf((q2[ai][m][0] + q2[ai][m][1]) * (1.f / 512.f) + RMS_EPS) * (1.f / 255.f); }
#pragma unroll
                for (int ai = 0; ai < 2; ++ai)
#pragma unroll
                    for (int m = 0; m < 4; ++m) { const u32x2 q = gq[ai][m]; const float sc = rs[ai][m];
#pragma unroll
                        for (int k = 0; k < 4; ++k) { const float g0 = (float)((q.x >> (8 * k)) & 255u) * sc, g1 = (float)((q.y >> (8 * k)) & 255u) * sc;
                            acc[ai][1][m][0][k] += acc[ai][0][m][0][k] * g0; acc[ai][1][m][1][k] += acc[ai][0][m][1][k] * g1; }
                        acc[ai][0][m][0] = (f32x4){0.f, 0.f, 0.f, 0.f}; acc[ai][0][m][1] = (f32x4){0.f, 0.f, 0.f, 0.f}; }
                if (t == NT - 2) {
                    int row0 = cur.arow + wr * 64 + fr, col = cur.pn * 128 + wc * 32 + 8 * fq;
                    asm volatile("" : "+v"(row0), "+v"(col));
#pragma unroll
                    for (int ai = 0; ai < 2; ++ai)
#pragma unroll
                        for (int m = 0; m < 4; ++m) { const f32x4 v0 = acc[ai][1][m][0], v1 = acc[ai][1][m][1];
                            u32x4 w; w.x = pk2(v0[0], v0[1]); w.y = pk2(v0[2], v0[3]); w.z = pk2(v1[0], v1[1]); w.w = pk2(v1[2], v1[3]);
                            *(u32x4*)(M.MRGB + (size_t)(row0 + ai * 128 + m * 16) * 1024 + col) = w;
                            acc[ai][1][m][0] = (f32x4){0.f, 0.f, 0.f, 0.f}; acc[ai][1][m][1] = (f32x4){0.f, 0.f, 0.f, 0.f}; } }
            }
        }
        if (!has_next) break;
        cur = nxt; carow = narow; cB = nB; ++ui;
    }
    PG8_WAIT_V(0);
    if (wr == 0) PG8_BAR;
    PG8_BAR;
#undef PG8_SA
#undef PG8_SB
#undef PG8_STAGEA
#undef PG8_STAGEB
#undef PG8_LDA
#undef PG8_LDB
#undef PG8_MMA
#undef PG8_WAIT_V
#undef PG8_WAIT_L
#undef PG8_BAR
#undef PG8_SCHED
}
}

using pg8::Unit;

struct EpiProj {
    static constexpr bool PERM = true;
    bf16_t* O0; int ld0; int split_pn; unsigned char* G8;
    DI void operator()(const f32x4 (&acc)[2][2][4][2], const Unit& u, int wr, int wc, int fr, int fq) const {
        const int row0 = u.arow + wr * 64 + fr;
        if (u.pn < split_pn) {
            const int col0 = u.pn * 256 + wc * 32 + 8 * fq;
#pragma unroll
            for (int ai = 0; ai < 2; ++ai)
#pragma unroll
                for (int m = 0; m < 4; ++m) { bf16_t* rowp = O0 + (size_t)(row0 + ai * 128 + m * 16) * ld0 + col0;
#pragma unroll
                    for (int bj = 0; bj < 2; ++bj) { const f32x4 v0 = acc[ai][bj][m][0], v1 = acc[ai][bj][m][1];
                        u32x4 w; w.x = pk2(v0[0], v0[1]); w.y = pk2(v0[2], v0[3]); w.z = pk2(v1[0], v1[1]); w.w = pk2(v1[2], v1[3]);
                        *(u32x4*)(rowp + bj * 128) = w; } }
        } else {
            const int col0 = (u.pn - split_pn) * 256 + wc * 32 + 8 * fq;
#pragma unroll
            for (int ai = 0; ai < 2; ++ai)
#pragma unroll
                for (int m = 0; m < 4; ++m) { unsigned char* rowp = G8 + (size_t)(row0 + ai * 128 + m * 16) * PG_W + col0;
#pragma unroll
                    for (int bj = 0; bj < 2; ++bj) { const f32x4 v0 = acc[ai][bj][m][0], v1 = acc[ai][bj][m][1]; unsigned q[8];
#pragma unroll
                        for (int k = 0; k < 4; ++k) { q[k] = (unsigned)(sigmoid_f(v0[k]) * 255.f + 0.5f); q[4 + k] = (unsigned)(sigmoid_f(v1[k]) * 255.f + 0.5f); }
                        u32x2 w; w.x = q[0] | (q[1] << 8) | (q[2] << 16) | (q[3] << 24); w.y = q[4] | (q[5] << 8) | (q[6] << 16) | (q[7] << 24);
                        *(u32x2*)(rowp + bj * 128) = w; } }
        }
    }
};

struct EpiWout {
    static constexpr bool PERM = true;
    bf16_t* Y;
    DI void operator()(const f32x4 (&acc)[2][2][4][2], const Unit& u, int wr, int wc, int fr, int fq) const {
        const int row0 = u.arow + wr * 64 + fr, col0 = u.pn * 256 + wc * 32 + 8 * fq;
#pragma unroll
        for (int ai = 0; ai < 2; ++ai)
#pragma unroll
            for (int m = 0; m < 4; ++m) { bf16_t* rowp = Y + (size_t)(row0 + ai * 128 + m * 16) * 1024 + col0;
#pragma unroll
                for (int bj = 0; bj < 2; ++bj) { const f32x4 v0 = acc[ai][bj][m][0], v1 = acc[ai][bj][m][1];
                    u32x4 w; w.x = pk2(v0[0], v0[1]); w.y = pk2(v0[2], v0[3]); w.z = pk2(v1[0], v1[1]); w.w = pk2(v1[2], v1[3]);
                    *(u32x4*)(rowp + bj * 128) = w; } }
    }
};

struct EpiGlu {
    static constexpr bool PERM = true;
    const bf16_t* YG; bf16_t* YC; const float* bglu;
    DI void operator()(const f32x4 (&acc)[2][2][4][2], const Unit& u, int wr, int wc, int fr, int fq) const {
        const int row0 = u.arow + wr * 64 + fr, col0 = u.pn * 256 + wc * 32 + 8 * fq;
#pragma unroll
        for (int bj = 0; bj < 2; ++bj) { const int col = col0 + bj * 128; if (u.pn == 1 && bj == 1) continue;
            const f32x4 b0 = *(const f32x4*)(bglu + col), b1 = *(const f32x4*)(bglu + col + 4);
#pragma unroll
            for (int ai = 0; ai < 2; ++ai) { u32x4 yw[4];
#pragma unroll
                for (int m = 0; m < 4; ++m) yw[m] = *(const u32x4*)(YG + (size_t)(row0 + ai * 128 + m * 16) * 384 + col);
#pragma unroll
                for (int m = 0; m < 4; ++m) { float y[8]; unpack8(yw[m], y);
                    const f32x4 a0 = acc[ai][bj][m][0] + b0, a1 = acc[ai][bj][m][1] + b1;
                    float o[8];
#pragma unroll
                    for (int k = 0; k < 4; ++k) { o[k] = y[k] * sigmoid_f(a0[k]); o[4 + k] = y[4 + k] * sigmoid_f(a1[k]); }
                    *(u32x4*)(YC + (size_t)(row0 + ai * 128 + m * 16) * 768 + col) = pack8(o); }
                __builtin_amdgcn_sched_barrier(0); } }
    }
};

struct EpiS5S {
    static constexpr bool PERM = true;
    float* S;
    DI void operator()(const f32x4 (&acc)[2][2][4][2], const Unit& u, int wr, int wc, int fr, int fq) const {
        const int m0 = u.pn * 256 + wr * 64 + fr, col0 = wc * 32 + 8 * fq;
#pragma unroll
        for (int ai = 0; ai < 2; ++ai)
#pragma unroll
            for (int m = 0; m < 4; ++m) { const int mm = m0 + ai * 128 + m * 16; if (u.pn == 2 && (ai == 1 || wr == 1)) continue;
                float* p = S + ((size_t)u.pm * 576 + mm) * 256 + col0;
#pragma unroll
                for (int bj = 0; bj < 2; ++bj) { *(f32x4*)(p + bj * 128) = acc[ai][bj][m][0]; *(f32x4*)(p + bj * 128 + 4) = acc[ai][bj][m][1]; } }
    }
};

struct EpiS5Y {
    static constexpr bool PERM = true;
    const bf16_t* AU; bf16_t* YG; const float* dsk;
    DI void operator()(const f32x4 (&acc)[2][2][4][2], const Unit& u, int wr, int wc, int fr, int fq) const {
        const int g = u.pm / 3, j = u.pm % 3;
        const int m0 = j * 256 + wr * 64 + fr, n0 = u.pn * 256 + wc * 32 + 8 * fq;
#pragma unroll
        for (int bj = 0; bj < 2; ++bj) { const int n = n0 + bj * 128, i = n >> 4, a0 = n & 15;
            const f32x4 d0 = *(const f32x4*)(dsk + g * 16 + a0), d1 = *(const f32x4*)(dsk + g * 16 + a0 + 4);
#pragma unroll
            for (int ai = 0; ai < 2; ++ai) { if (j == 2 && (ai == 1 || wr == 1)) continue;
                u32x4 uw[4];
#pragma unroll
                for (int m = 0; m < 4; ++m) uw[m] = *(const u32x4*)(AU + ((size_t)g * 576 + m0 + ai * 128 + m * 16) * 768 + n);
#pragma unroll
                for (int m = 0; m < 4; ++m) { const int mm = m0 + ai * 128 + m * 16; float uu[8]; unpack8(uw[m], uu);
                    const f32x4 v0 = acc[ai][bj][m][0], v1 = acc[ai][bj][m][1];
                    float o[8];
#pragma unroll
                    for (int k = 0; k < 4; ++k) { o[k] = gelu_tanh_f(v0[k] + d0[k] * uu[k]); o[4 + k] = gelu_tanh_f(v1[k] + d1[k] * uu[4 + k]); }
                    *(u32x4*)(YG + (size_t)(mm * 32 + i) * 384 + g * 16 + a0) = pack8(o); }
                __builtin_amdgcn_sched_barrier(0); } }
    }
};

struct EpiUp {
    static constexpr bool PERM = true;
    bf16_t* HID;
    DI void operator()(const f32x4 (&acc)[2][2][4][2], const Unit& u, int wr, int wc, int fr, int fq) const {
        const int row0 = u.arow + wr * 64 + fr, col0 = u.pn * 128 + wc * 32 + 8 * fq;
#pragma unroll
        for (int ai = 0; ai < 2; ++ai)
#pragma unroll
            for (int m = 0; m < 4; ++m) { const f32x4 g0 = acc[ai][0][m][0], g1 = acc[ai][0][m][1], u0 = acc[ai][1][m][0], u1 = acc[ai][1][m][1];
                float o[8];
#pragma unroll
                for (int k = 0; k < 4; ++k) { o[k] = silu_f(g0[k]) * u0[k]; o[4 + k] = silu_f(g1[k]) * u1[k]; }
                *(u32x4*)(HID + (size_t)(row0 + ai * 128 + m * 16) * 1024 + col0) = pack8(o); }
    }
};

struct EpiDown {
    static constexpr bool PERM = true;
    bf16_t* YE; const float* GV;
    DI void operator()(const f32x4 (&acc)[2][2][4][2], const Unit& u, int wr, int wc, int fr, int fq) const {
        const int row0 = u.arow + wr * 64 + fr, col0 = u.pn * 256 + wc * 32 + 8 * fq;
#pragma unroll
        for (int ai = 0; ai < 2; ++ai)
#pragma unroll
            for (int m = 0; m < 4; ++m) { const int row = row0 + ai * 128 + m * 16; const float gv = GV[row];
#pragma unroll
                for (int bj = 0; bj < 2; ++bj) { const f32x4 v0 = acc[ai][bj][m][0] * gv, v1 = acc[ai][bj][m][1] * gv;
                    u32x4 w; w.x = pk2(v0[0], v0[1]); w.y = pk2(v0[2], v0[3]); w.z = pk2(v1[0], v1[1]); w.w = pk2(v1[2], v1[3]);
                    *(u32x4*)(YE + (size_t)row * 1024 + col0 + bj * 128) = w; } }
    }
};

DI Unit mk_unit(int arow, int brow, int pm, int pn) { Unit u; u.arow = arow; u.brow = brow; u.pm = pm; u.pn = pn; return u; }
struct RowSkipOrder {
    int nN, G, c, skipctx, keep_lo, keep_hi, nmain, total, bstep;
    DI void init(int N, int G_, int c_, int skipctx_, int keep_lo_, int keep_hi_, int bstep_ = 256) { bstep = bstep_; nN = N / bstep_; G = G_; c = c_; skipctx = skipctx_; keep_lo = keep_lo_; keep_hi = keep_hi_;
        nmain = (skipctx ? 64 : 72) * nN; total = nmain + (skipctx ? 8 * (keep_hi - keep_lo) : 0); }
    DI Unit next(int i) const {
        const int L0 = i * G + c; if (L0 >= total) return mk_unit(-1, 0, 0, 0);
        const int q = total / 8, r = total % 8, xcd = L0 % 8, off = L0 / 8;
        const int L = (xcd < r ? xcd * (q + 1) : r * (q + 1) + (xcd - r) * q) + off;
        const int nig = 8 * nN, gid = L / nig, rr = L % nig, lt = gid * 8 + (rr % 8);
        const int pm_main = skipctx ? ((lt / 8) * 9 + 1 + (lt % 8)) : lt, pn_main = rr / 8;
        const int Lc = L - nmain, pm_ctx = (Lc % 8) * 9, pn_ctx = keep_lo + Lc / 8;
        const bool main = L < nmain;
        const int pm = main ? pm_main : pm_ctx, pn = main ? pn_main : pn_ctx;
        return mk_unit(pm * 256, pn * bstep, pm, pn);
    }
};
DI int xcd_remap(int L0, int total) { const int q = total / 8, r = total % 8, xcd = L0 % 8, off = L0 / 8; return (xcd < r ? xcd * (q + 1) : r * (q + 1) + (xcd - r) * q) + off; }
struct MergeOrder {
    int G, c, skipctx, total;
    DI void init(int G_, int c_, int skipctx_) { G = G_; c = c_; skipctx = skipctx_; total = (skipctx ? 64 : 72) * 8; }
    DI Unit next(int i) const {
        const int L0 = i * G + c; if (L0 >= total) return mk_unit(-1, 0, 0, 0);
        const int L = xcd_remap(L0, total), lt = L >> 3, pn = L & 7, pm = skipctx ? ((lt / 8) * 9 + 1 + (lt % 8)) : lt;
        return mk_unit(pm * 256, pn * 128, pm, pn);
    }
};
struct OrderS5S { int G, c; DI Unit next(int i) const { const int L = i * G + c; if (L >= 72) return mk_unit(-1, 0, 0, 0); const int g = L / 3, j = L % 3; return mk_unit(g * 576 + j * 256, g * 256, g, j); } };
struct OrderS5Y { int G, c; DI Unit next(int i) const { const int L = i * G + c; if (L >= 144) return mk_unit(-1, 0, 0, 0); const int g = L / 6, r = L % 6, j = r >> 1, nh = r & 1;
    return mk_unit(g * 576 + j * 256, g * 512 + nh * 256, g * 3 + j, nh); } };
struct OrderUp { int G, c, nJ; DI Unit next(int i) const { const int L0 = i * G + c, total = 16 * nJ * 8; if (L0 >= total) return mk_unit(-1, 0, 0, 0); const int L = xcd_remap(L0, total), n = L & 7, t = L >> 3, jt = t % nJ, e = t / nJ;
    return mk_unit(e * EROWS + jt * 256, e * 2048 + n * 256, e, n); } };
struct OrderDown { int G, c, nJ; DI Unit next(int i) const { const int L0 = i * G + c, total = 16 * nJ * 4; if (L0 >= total) return mk_unit(-1, 0, 0, 0); const int L = xcd_remap(L0, total), n = L & 3, t = L >> 2, jt = t % nJ, e = t / nJ;
    return mk_unit(e * EROWS + jt * 256, e * 1024 + n * 256, e, n); } };

struct Frame {
    LAS unsigned char* lds;
    int tid, lane, wave, G, vcu, gw, NGW, bid;
};

template <class DstRow>
DI void tr_item(const float* __restrict__ W, int ldw, int nvalid, int nstore, int K, bf16_t* __restrict__ WT, int k0, int n0, const DstRow& drow, const float* __restrict__ kscale, LAS float* scr  , int lane, int kofs = 0) {
    const int c4 = (lane & 15) * 4, r0 = lane >> 4;
    f32x4 v[16];
#pragma unroll
    for (int i = 0; i < 16; ++i) { const int kk = 4 * i + r0; v[i] = (n0 + c4 < nvalid) ? *(const f32x4*)(W + (size_t)(k0 + kk) * ldw + n0 + c4) : (f32x4){0.f, 0.f, 0.f, 0.f}; }
#pragma unroll
    for (int i = 0; i < 16; ++i) { const int kk = 4 * i + r0; f32x4 x = v[i]; if (kscale) x = x * kscale[k0 + kk];
        LAS float* d = scr + kk * 65 + c4; d[0] = x[0]; d[1] = x[1]; d[2] = x[2]; d[3] = x[3]; }
    LDS_WAIT(); asm volatile("" ::: "memory");
    const int c = lane & 7;
#pragma unroll
    for (int j = 0; j < 8; ++j) { const int n = (lane >> 3) + 8 * j; const LAS float* s = scr + (8 * c) * 65 + n;
        u32x4 o; o.x = pk2(s[0 * 65], s[1 * 65]); o.y = pk2(s[2 * 65], s[3 * 65]); o.z = pk2(s[4 * 65], s[5 * 65]); o.w = pk2(s[6 * 65], s[7 * 65]);
        if (n0 + n < nstore) *(u32x4*)(WT + (size_t)drow(n0 + n) * K + kofs + k0 + 8 * c) = o; }
    LDS_WAIT(); asm volatile("" ::: "memory");
}
struct DrIdent { int off; DI int operator()(int n) const { return off + n; } };
struct DrWin { DI int operator()(int n) const { return n < C_G ? n : n + (PA_W - C_G); } };
struct DrGU { int base; DI int operator()(int f) const { return base + (f >> 7) * 256 + (f & 127); } };

struct LayerIn {
    const float *w_in, *q_norm_g, *k_norm_g, *ssd_conv_w, *ssd_conv_b, *ssd_dt_bias, *ssd_a_log, *ssd_d, *ssd_norm_g;
    const float *s5_lre, *s5_lim, *s5_lstep, *s5_bre, *s5_bim, *s5_cre, *s5_cim, *s5_d, *s5_wglu, *s5_bglu, *sc_conv_w;
    const float *w_br_attn, *w_br_ssd, *w_br_s5, *w_br_sc, *w_out, *w_router, *w_gate, *w_up, *w_down, *norm_mix_g, *norm_ffn_g;
};

DI void prep_small_weights(const Frame& F, const LayerIn& P, unsigned char* ws, int part = 0, int first_wg = 0) {
    if ((int)blockIdx.x < first_wg) return;
    LAS float* scr = (LAS float*)(F.lds + F.wave * 16896);
    bf16_t* WIN = (bf16_t*)(ws + W_WIN);
    constexpr int NB_WIN = (NIN + 63) / 64;
    constexpr int I_WIN = 16 * NB_WIN, I_PAD = 62, I_BA = 8 * 16, I_BB = 8 * 16, I_BC = 6 * 16, I_BD = 6 * 16, I_OUT = 16 * 16, I_GLU = 6 * 8;
    constexpr int NIT = I_WIN + I_PAD + I_BA + I_BB + I_BC + I_BD + I_OUT + I_GLU;
    for (int it = ((int)blockIdx.x - first_wg) * NWAVES + F.wave; it < NIT; it += (F.G - first_wg) * NWAVES) {
        int r = it;
        { const bool is_out = (it >= NIT - I_GLU - I_OUT) && (it < NIT - I_GLU); if ((part == 1 && is_out) || (part == 2 && !is_out)) continue; }
        if (r < I_WIN) { const int kb = r / NB_WIN, nb = r % NB_WIN; tr_item(P.w_in, NIN, NIN, NIN, 1024, WIN, kb * 64, nb * 64, DrWin{}, nullptr, scr, F.lane); continue; } r -= I_WIN;
        if (r < I_PAD) {
#pragma unroll
            for (int j = 0; j < 8; ++j) { const int idx = j * 64 + F.lane, row = C_G + r * 4 + (idx >> 7), ch = idx & 127; *(u32x4*)(WIN + (size_t)row * 1024 + ch * 8) = (u32x4){0u, 0u, 0u, 0u}; }
            continue; } r -= I_PAD;
        if (r < I_BA) { tr_item(P.w_br_attn, 1024, 1024, 1024, 1792, (bf16_t*)(ws + W_BR4), (r / 16) * 64, (r % 16) * 64, DrIdent{0}, nullptr, scr, F.lane, 0); continue; } r -= I_BA;
        if (r < I_BB) { tr_item(P.w_br_ssd, 1024, 1024, 1024, 1792, (bf16_t*)(ws + W_BR4), (r / 16) * 64, (r % 16) * 64, DrIdent{0}, P.ssd_norm_g, scr, F.lane, 512); continue; } r -= I_BB;
        if (r < I_BC) { tr_item(P.w_br_s5, 1024, 1024, 1024, 1792, (bf16_t*)(ws + W_BR4), (r / 16) * 64, (r % 16) * 64, DrIdent{0}, nullptr, scr, F.lane, 1024); continue; } r -= I_BC;
        if (r < I_BD) { tr_item(P.w_br_sc, 1024, 1024, 1024, 1792, (bf16_t*)(ws + W_BR4), (r / 16) * 64, (r % 16) * 64, DrIdent{0}, nullptr, scr, F.lane, 1408); continue; } r -= I_BD;
        if (r < I_OUT) { tr_item(P.w_out, 1024, 1024, 1024, 1024, (bf16_t*)(ws + W_OUT), (r / 16) * 64, (r % 16) * 64, DrIdent{0}, nullptr, scr, F.lane); continue; } r -= I_OUT;
        tr_item(P.s5_wglu, 384, 384, 512, 384, (bf16_t*)(ws + W_GLU), (r / 8) * 64, (r % 8) * 64, DrIdent{0}, nullptr, scr, F.lane);
    }
}
DI void prep_expert_weights(const Frame& F, const LayerIn& P, unsigned char* ws, int first_wg, int item_lo, int item_hi, bf16_t* wgu = nullptr) {
    if ((int)blockIdx.x < first_wg) return;
    LAS float* scr = (LAS float*)(F.lds + F.wave * 16896);
    if (!wgu) wgu = (bf16_t*)(ws + WS_WGU);
    constexpr int PER = 16 * 16;
    for (int it = item_lo + ((int)blockIdx.x - first_wg) * NWAVES + F.wave; it < item_hi; it += (F.G - first_wg) * NWAVES) {
        const int which = it / (16 * PER), r = it % (16 * PER), e = r / PER, q = r % PER, k0 = (q / 16) * 64, n0 = (q % 16) * 64;
        if (which == 0) tr_item(P.w_gate + (size_t)e * 1024 * 1024, 1024, 1024, 1024, 1024, wgu, k0, n0, DrGU{e * 2048}, nullptr, scr, F.lane);
        else if (which == 1) tr_item(P.w_up + (size_t)e * 1024 * 1024, 1024, 1024, 1024, 1024, wgu, k0, n0, DrGU{e * 2048 + 128}, nullptr, scr, F.lane);
        else tr_item(P.w_down + (size_t)e * 1024 * 1024, 1024, 1024, 1024, 1024, (bf16_t*)(ws + WS_WD), k0, n0, DrIdent{e * 1024}, nullptr, scr, F.lane);
    }
}
constexpr int EXPERT_W_ITEMS = 3 * 16 * 16 * 16;

DI void prep_mod(const Frame& F, const float* __restrict__ c, const float* __restrict__ c_ctx, const float* __restrict__ w_mod, const float* __restrict__ b_mod, float* __restrict__ MOD, int first_wg) {
    const int wgi = (int)blockIdx.x - first_wg, nwg = F.G - first_wg;
    if (wgi < 0 || wgi >= 2 * 96) return;
    LAS float* sc = (LAS float*)F.lds;
    LAS float* red = sc + 9 * 1024;
    for (int o = F.tid; o < 9 * 1024; o += 512) { const float cv = (o < 8 * 1024) ? c[o] : c_ctx[o - 8 * 1024]; sc[o] = silu_f(cv); }
    __syncthreads();
    for (int it = wgi; it < 2 * 96; it += nwg) {
        const int l = it / 96, cb = it % 96, n = cb * 64 + F.lane;
        const float* W = w_mod + (size_t)l * 1024 * 6144;
        float acc[9];
#pragma unroll
        for (int r = 0; r < 9; ++r) acc[r] = 0.f;
        const int kbeg = F.wave * 128;
#pragma unroll 1
        for (int k8 = 0; k8 < 128; k8 += 16) { float w[16];
#pragma unroll
            for (int j = 0; j < 16; ++j) w[j] = W[(size_t)(kbeg + k8 + j) * 6144 + n];
#pragma unroll
            for (int j = 0; j < 16; ++j)
#pragma unroll
                for (int r = 0; r < 9; ++r) acc[r] += sc[r * 1024 + kbeg + k8 + j] * w[j]; }
#pragma unroll
        for (int r = 0; r < 9; ++r) red[(F.wave * 9 + r) * 64 + F.lane] = acc[r];
        __syncthreads();
        for (int o = F.tid; o < 9 * 64; o += 512) { const int r = o >> 6, ln = o & 63; float s = 0.f;
#pragma unroll
            for (int w = 0; w < 8; ++w) s += red[(w * 9 + r) * 64 + ln];
            MOD[((size_t)l * 9 + r) * 6144 + cb * 64 + ln] = s + b_mod[l * 6144 + cb * 64 + ln]; }
        __syncthreads();
    }
    __syncthreads();
}
DI void prep_rope(const Frame& F, float* ROPE, int first_wg) {
    if ((int)blockIdx.x < first_wg) return;
    for (int idx = ((int)blockIdx.x - first_wg) * 512 + F.tid; idx < 2048 * 32; idx += (F.G - first_wg) * 512) {
        const int t = idx >> 5, j = idx & 31, i = j & 15;
        const float inv = powf(10000.f, -(float)(2 * i) / 32.f);
        const float pos = (j < 16) ? (float)(t >> 6) : (float)(t & 63);
        const float a = pos * inv;
        ROPE[t * 64 + j] = cosf(a); ROPE[t * 64 + 32 + j] = sinf(a);
    }
}

DI void prep_s5(const Frame& F, const LayerIn& P, unsigned char* ws, int wg_off = 0) {
    const int wgi = (int)blockIdx.x - wg_off;
    if (wgi < 0 || wgi >= 96) return;
    LAS float* pw = (LAS float*)F.lds;
    LAS float* bb = pw + 8448;
    LAS float* Kt = bb + 4096;
    LAS float* cc = Kt + 16896;
    LAS float* prm = cc + 2048;
    for (int it = wgi; it < 96; it += F.G) {
        const int g = it >> 2, qt = it & 3;
        for (int o = F.tid; o < 2048; o += 512) cc[o] = (o < 1024) ? P.s5_cre[(size_t)g * 1024 + o] : P.s5_cim[(size_t)g * 1024 + o - 1024];
        for (int o = F.tid; o < 2048; o += 512) prm[264 + o] = (o < 1024) ? P.s5_bre[(size_t)g * 1024 + o] : P.s5_bim[(size_t)g * 1024 + o - 1024];
        if (F.tid < 256) { const int d = (F.tid >> 6) & 1, p = F.tid & 63; prm[F.tid] = (F.tid < 128) ? P.s5_lre[(d * 24 + g) * 64 + p] : P.s5_lim[(d * 24 + g) * 64 + p]; }
        if (F.tid < 2) prm[256 + F.tid] = __expf(P.s5_lstep[F.tid * 24 + g]);
        __syncthreads();
        if (F.tid < 128) { const int d = F.tid >> 6, p = F.tid & 63;
            const float step = prm[256 + d], lr = prm[d * 64 + p], li = prm[128 + d * 64 + p];
            const float th = li * step, sh = sinf(0.5f * th);
            const float mag = expf(lr * step), abi = mag * sinf(th);
            const float nr = expm1f(lr * step) - 2.f * mag * sh * sh, ni = abi;
            const float den = lr * lr + li * li;
            const float cr = (nr * lr + ni * li) / den, ci = (ni * lr - nr * li) / den;
#pragma unroll
            for (int j = 0; j < 16; ++j) { const float br = prm[264 + p * 16 + j], bi = prm[264 + 1024 + p * 16 + j];
                bb[((d * 64 + p) * 16 + j) * 2 + 0] = cr * br - ci * bi; bb[((d * 64 + p) * 16 + j) * 2 + 1] = cr * bi + ci * br; } }
        for (int o = F.tid; o < 2 * 64 * 33; o += 512) { const int dp = o / 33, tau = o % 33, d = dp >> 6, p = dp & 63;
            const float step = prm[256 + d], lr = prm[d * 64 + p], li = prm[128 + d * 64 + p];
            const float m = expf(lr * step * (float)tau), a = li * step * (float)tau;
            pw[o * 2 + 0] = m * cosf(a); pw[o * 2 + 1] = m * sinf(a); }
        __syncthreads();
        for (int o = F.tid; o < 1024; o += 512) { const int d = o >> 9, a = (o >> 5) & 15, tau = o & 31; float s[16];
#pragma unroll
            for (int b_ = 0; b_ < 16; ++b_) s[b_] = 0.f;
            for (int p = 0; p < 64; ++p) { const float cre = cc[a * 64 + p], cim = cc[1024 + a * 64 + p];
                const f32x2 lp = *(const LAS f32x2*)(pw + ((d * 64 + p) * 33 + tau) * 2);
                const float wr_ = cre * lp[0] - cim * lp[1], wi_ = cre * lp[1] + cim * lp[0];
                const LAS f32x4* bp = (const LAS f32x4*)(bb + (d * 64 + p) * 32);
#pragma unroll
                for (int q4 = 0; q4 < 8; ++q4) { const f32x4 t = bp[q4]; s[2 * q4] += wr_ * t[0] - wi_ * t[1]; s[2 * q4 + 1] += wr_ * t[2] - wi_ * t[3]; } }
#pragma unroll
            for (int b_ = 0; b_ < 16; ++b_) Kt[((d * 16 + a) * 16 + b_) * 33 + tau] = s[b_]; }
        __syncthreads();
        bf16_t* TQ = (bf16_t*)(ws + W_TQ) + (size_t)g * 512 * 768;
        for (int o = F.tid; o < 128 * 64; o += 512) { const int row = qt * 128 + (o >> 6), ch = o & 63, i = row >> 4, a = row & 15, b0 = (ch >> 5) * 8, j = ch & 31; float v[8];
#pragma unroll
            for (int k = 0; k < 8; ++k) { float s_ = 0.f;
                if (j <= i) s_ += Kt[((0 * 16 + a) * 16 + b0 + k) * 33 + (i - j)];
                if (j >= i) s_ += Kt[((1 * 16 + a) * 16 + b0 + k) * 33 + (j - i)];
                v[k] = s_; }
            *(u32x4*)(TQ + (size_t)row * 768 + j * 16 + b0) = pack8(v); }
        for (int o = F.tid; o < 128 * 128; o += 512) { const int row = qt * 128 + (o >> 7), dp = o & 127, d = dp >> 6, p = dp & 63, i = row >> 4, a = row & 15; const int tau = d == 0 ? (i + 1) : (32 - i);
            const float cre = cc[a * 64 + p], cim = cc[1024 + a * 64 + p];
            const f32x2 lp = *(const LAS f32x2*)(pw + ((d * 64 + p) * 33 + tau) * 2);
            TQ[(size_t)row * 768 + 512 + d * 128 + p] = (bf16_t)f2bf(cre * lp[0] - cim * lp[1]);
            TQ[(size_t)row * 768 + 512 + d * 128 + 64 + p] = (bf16_t)f2bf(-(cre * lp[1] + cim * lp[0])); }
        bf16_t* PP = (bf16_t*)(ws + W_P) + (size_t)g * 256 * 512;
        for (int o = F.tid; o < 2 * 16 * 32; o += 512) { const int d = o >> 9, p = qt * 16 + ((o >> 5) & 15), j = o & 31; const int tau = d == 0 ? (31 - j) : j;
            const f32x2 lp = *(const LAS f32x2*)(pw + ((d * 64 + p) * 33 + tau) * 2);
            const LAS f32x4* bp = (const LAS f32x4*)(bb + (d * 64 + p) * 32);
            float vr[16], vi[16];
#pragma unroll
            for (int q4 = 0; q4 < 8; ++q4) { const f32x4 t = bp[q4];
                vr[2 * q4] = lp[0] * t[0] - lp[1] * t[1]; vi[2 * q4] = lp[0] * t[1] + lp[1] * t[0];
                vr[2 * q4 + 1] = lp[0] * t[2] - lp[1] * t[3]; vi[2 * q4 + 1] = lp[0] * t[3] + lp[1] * t[2]; }
            float h0[8], h1[8];
#pragma unroll
            for (int k = 0; k < 8; ++k) { h0[k] = vr[k]; h1[k] = vr[8 + k]; }
            bf16_t* pr = PP + (size_t)(d * 128 + p) * 512 + j * 16;
            *(u32x4*)pr = pack8(h0); *(u32x4*)(pr + 8) = pack8(h1);
#pragma unroll
            for (int k = 0; k < 8; ++k) { h0[k] = vi[k]; h1[k] = vi[8 + k]; }
            bf16_t* pi = PP + (size_t)(d * 128 + 64 + p) * 512 + j * 16;
            *(u32x4*)pi = pack8(h0); *(u32x4*)(pi + 8) = pack8(h1); }
        __syncthreads();
    }
}

struct RowCtx { int R, b, p, isctx, mrow; };
DI RowCtx row_ctx(int R) { RowCtx r; r.R = R; r.b = R / PB; r.p = R - r.b * PB; r.isctx = r.p < CTXL; r.mrow = r.isctx ? 8 : r.b; return r; }
struct WaveRows { int b, pa, pb; };
DI WaveRows wave_rows(int wg, int nwb, int p0, int np, int wave) {
    const int b = wg / nwb, j = wg - b * nwb;
    const int lo = p0 + (j * np) / nwb, hi = p0 + ((j + 1) * np) / nwb, per = (hi - lo + NWAVES - 1) / NWAVES;
    WaveRows w; w.b = b; w.pa = min(lo + wave * per, hi); w.pb = min(w.pa + per, hi); return w;
}
DI const float* stream_in(const float* x_in, const float* ctx_in, int b, int p) { return (p < CTXL) ? ctx_in + ((size_t)b * CTXL + p) * 1024 : x_in + ((size_t)b * SEQ + (p - CTXL)) * 1024; }
template <int N> DI void wave_sum_n(float (&v)[N]) {
#pragma unroll
    for (int o = 1; o < 64; o <<= 1) {
        float t[N];
#pragma unroll
        for (int k = 0; k < N; ++k) t[k] = __shfl_xor(v[k], o);
#pragma unroll
        for (int k = 0; k < N; ++k) v[k] += t[k]; }
}
DI float row_ssq(const f32x4 (&x)[4]) {
    float ss = 0.f;
#pragma unroll
    for (int j = 0; j < 4; ++j) ss += (x[j][0] * x[j][0] + x[j][1] * x[j][1]) + (x[j][2] * x[j][2] + x[j][3] * x[j][3]);
    return ss;
}
DI void row_store_bf16(int lane, const f32x4 (&h)[4], bf16_t* dst) {
#pragma unroll
    for (int j = 0; j < 4; ++j) { u32x2 w; w.x = pk2(h[j][0], h[j][1]); w.y = pk2(h[j][2], h[j][3]); *(u32x2*)(dst + j * 256 + 4 * lane) = w; }
}
DI void add_gated_bf16(f32x4 (&x)[4], const u32x2 (&y)[4], const LAS float* gate, int lane) {
#pragma unroll
    for (int j = 0; j < 4; ++j) { const f32x4 g = *(const LAS f32x4*)(gate + j * 256 + 4 * lane);
        x[j][0] += g[0] * bflo(y[j].x); x[j][1] += g[1] * bfhi(y[j].x); x[j][2] += g[2] * bflo(y[j].y); x[j][3] += g[3] * bfhi(y[j].y); }
}
DI __amdgpu_buffer_rsrc_t ye_resource(const bf16_t* YE) { return __builtin_amdgcn_make_buffer_rsrc((void*)YE, 0, 16 * EROWS * 2048, 0x00020000); }
DI unsigned combine_issue(const __amdgpu_buffer_rsrc_t rs, const int myinv, const int lane, u32x2 (&ye)[4][4]) {
    unsigned mask = (unsigned)__ballot(myinv >= 0) & 0xFFFFu;
#pragma unroll
    for (int s = 0; s < 4; ++s) { const bool has = mask != 0u; const int e = has ? __builtin_ctz(mask) : 0; mask &= mask - 1u;
        const int er = __builtin_amdgcn_readlane(myinv, e);
        const unsigned off = has ? (unsigned)er * 2048u + (unsigned)lane * 8u : 0x80000000u;
#pragma unroll
        for (int j = 0; j < 4; ++j) ye[s][j] = __builtin_amdgcn_raw_buffer_load_b64(rs, off + j * 512, 0, 0); }
    return mask;
}
DI void combine_add(f32x4 (&x)[4], const u32x2 (&ye)[4][4], unsigned rest, const int myinv, const bf16_t* YE, const LAS float* gate, int lane) {
    f32x4 s[4];
#pragma unroll
    for (int j = 0; j < 4; ++j) { s[j][0] = (bflo(ye[0][j].x) + bflo(ye[1][j].x)) + (bflo(ye[2][j].x) + bflo(ye[3][j].x)); s[j][1] = (bfhi(ye[0][j].x) + bfhi(ye[1][j].x)) + (bfhi(ye[2][j].x) + bfhi(ye[3][j].x));
        s[j][2] = (bflo(ye[0][j].y) + bflo(ye[1][j].y)) + (bflo(ye[2][j].y) + bflo(ye[3][j].y)); s[j][3] = (bfhi(ye[0][j].y) + bfhi(ye[1][j].y)) + (bfhi(ye[2][j].y) + bfhi(ye[3][j].y)); }
    while (rest) { const int e = __builtin_ctz(rest); rest &= rest - 1u; const int er = __builtin_amdgcn_readlane(myinv, e); const bf16_t* yr = YE + (size_t)er * 1024 + 4 * lane;
#pragma unroll
        for (int j = 0; j < 4; ++j) { const u32x2 w = *(const u32x2*)(yr + j * 256); s[j][0] += bflo(w.x); s[j][1] += bfhi(w.x); s[j][2] += bflo(w.y); s[j][3] += bfhi(w.y); } }
#pragma unroll
    for (int j = 0; j < 4; ++j) x[j] += *(const LAS f32x4*)(gate + j * 256 + 4 * lane) * s[j];
}

template <bool COMBINE, int RPW>
DI void phase_norm1(const Frame& F, int layer, const float* x_in, const float* ctx_in, bf16_t* X, bf16_t* H1, const float* MOD, const float* gmix, const int* INV, const bf16_t* YE, const bf16_t* Y, int first_wg) {
    if ((int)blockIdx.x < first_wg) return;
    const WaveRows wr = wave_rows((int)blockIdx.x - first_wg, (F.G - first_wg) / NB, 0, PB, F.wave);
    LAS float* ml = (LAS float*)F.lds;
    { const float* modl = MOD + (size_t)layer * 9 * 6144; const float* modp = MOD + (size_t)(COMBINE ? layer - 1 : 0) * 9 * 6144;
      for (int idx = F.tid; idx < 2048; idx += NWAVES * 64) { const int set = idx >> 10, c = idx & 1023; const size_t mo = (size_t)(set ? 8 : wr.b) * 6144;
          if (COMBINE) { ml[(set * 4 + 0) * 1024 + c] = modp[mo + 2 * 1024 + c]; ml[(set * 4 + 1) * 1024 + c] = modp[mo + 5 * 1024 + c]; }
          ml[(set * 4 + 2) * 1024 + c] = gmix[c] * (1.f + modl[mo + 1024 + c]); ml[(set * 4 + 3) * 1024 + c] = modl[mo + c]; } }
    __syncthreads();
    const __amdgpu_buffer_rsrc_t rs = ye_resource(YE);
    for (int p = wr.pa; p < wr.pb; p += RPW) {
        f32x4 x[RPW][4]; u32x2 y[RPW][4]; int inv[RPW]; size_t Rk[RPW]; const LAS float* mk[RPW];
#pragma unroll
        for (int k = 0; k < RPW; ++k) { const int pk = min(p + k, wr.pb - 1); Rk[k] = (size_t)wr.b * PB + pk; mk[k] = ml + (pk < CTXL ? 4096 : 0);
            const float* src = stream_in(x_in, ctx_in, wr.b, pk);
#pragma unroll
            for (int j = 0; j < 4; ++j) x[k][j] = *(const f32x4*)(src + j * 256 + 4 * F.lane);
            if (COMBINE) { inv[k] = (F.lane < 16) ? INV[Rk[k] * 16 + F.lane] : -1;
#pragma unroll
                for (int j = 0; j < 4; ++j) y[k][j] = *(const u32x2*)(Y + Rk[k] * 1024 + j * 256 + 4 * F.lane); } }
        if (COMBINE) {
            u32x2 ye[RPW][4][4]; unsigned rest[RPW];
#pragma unroll
            for (int k = 0; k < RPW; ++k) rest[k] = combine_issue(rs, inv[k], F.lane, ye[k]);
#pragma unroll
            for (int k = 0; k < RPW; ++k) add_gated_bf16(x[k], y[k], mk[k], F.lane);
#pragma unroll
            for (int k = 0; k < RPW; ++k) { combine_add(x[k], ye[k], rest[k], inv[k], YE, mk[k] + 1024, F.lane);
#pragma unroll
                for (int j = 0; j < 4; ++j) { u32x2 w; w.x = pk2(x[k][j][0], x[k][j][1]); w.y = pk2(x[k][j][2], x[k][j][3]); *(u32x2*)(X + Rk[k] * 1024 + j * 256 + 4 * F.lane) = w; } }
        }
        float ss[RPW];
#pragma unroll
        for (int k = 0; k < RPW; ++k) ss[k] = row_ssq(x[k]);
        wave_sum_n<RPW>(ss);
#pragma unroll
        for (int k = 0; k < RPW; ++k) { const float rstd = __builtin_amdgcn_rsqf(ss[k] * (1.f / 1024.f) + RMS_EPS);
#pragma unroll
            for (int j = 0; j < 4; ++j) x[k][j] = x[k][j] * rstd * *(const LAS f32x4*)(mk[k] + 2048 + j * 256 + 4 * F.lane) + *(const LAS f32x4*)(mk[k] + 3072 + j * 256 + 4 * F.lane);
            row_store_bf16(F.lane, x[k], H1 + Rk[k] * 1024); }
    }
    __syncthreads();
}
template <int RPW>
DI void phase_final(const Frame& F, const bf16_t* X, float* out, const float* MOD, const float* gfin, const int* INV, const bf16_t* YE, const bf16_t* Y) {
    const WaveRows wr = wave_rows((int)blockIdx.x, F.G / NB, CTXL, SEQ, F.wave);
    LAS float* ml = (LAS float*)F.lds;
    for (int c = F.tid; c < 1024; c += NWAVES * 64) { const float* mr = MOD + (size_t)(9 + wr.b) * 6144; ml[c] = mr[2 * 1024 + c]; ml[1024 + c] = mr[5 * 1024 + c]; ml[2048 + c] = gfin[c]; }
    __syncthreads();
    const __amdgpu_buffer_rsrc_t rs = ye_resource(YE);
    for (int p = wr.pa; p < wr.pb; p += RPW) {
        f32x4 x[RPW][4]; u32x2 y[RPW][4]; int inv[RPW]; size_t Rk[RPW];
#pragma unroll
        for (int k = 0; k < RPW; ++k) { const int pk = min(p + k, wr.pb - 1); Rk[k] = (size_t)wr.b * PB + pk;
#pragma unroll
            for (int j = 0; j < 4; ++j) { const u32x2 w = *(const u32x2*)(X + Rk[k] * 1024 + j * 256 + 4 * F.lane); x[k][j] = (f32x4){bflo(w.x), bfhi(w.x), bflo(w.y), bfhi(w.y)}; }
            inv[k] = (F.lane < 16) ? INV[Rk[k] * 16 + F.lane] : -1;
#pragma unroll
            for (int j = 0; j < 4; ++j) y[k][j] = *(const u32x2*)(Y + Rk[k] * 1024 + j * 256 + 4 * F.lane); }
        u32x2 ye[RPW][4][4]; unsigned rest[RPW];
#pragma unroll
        for (int k = 0; k < RPW; ++k) rest[k] = combine_issue(rs, inv[k], F.lane, ye[k]);
#pragma unroll
        for (int k = 0; k < RPW; ++k) add_gated_bf16(x[k], y[k], ml, F.lane);
#pragma unroll
        for (int k = 0; k < RPW; ++k) combine_add(x[k], ye[k], rest[k], inv[k], YE, ml + 1024, F.lane);
        float ss[RPW];
#pragma unroll
        for (int k = 0; k < RPW; ++k) ss[k] = row_ssq(x[k]);
        wave_sum_n<RPW>(ss);
#pragma unroll
        for (int k = 0; k < RPW; ++k) { const float rstd = __builtin_amdgcn_rsqf(ss[k] * (1.f / 1024.f) + RMS_EPS);
            float* o = out + ((size_t)wr.b * SEQ + (min(p + k, wr.pb - 1) - CTXL)) * 1024;
#pragma unroll
            for (int j = 0; j < 4; ++j) *(f32x4*)(o + j * 256 + 4 * F.lane) = x[k][j] * rstd * *(const LAS f32x4*)(ml + 2048 + j * 256 + 4 * F.lane); }
    }
}

DI float router_butterfly(const float (&s16)[16], int lane, int& e_out) {
    const bool b5 = (lane & 32) != 0, b4 = (lane & 16) != 0, b3 = (lane & 8) != 0, b2 = (lane & 4) != 0;
    float t8[8], u4[4], w2[2];
#pragma unroll
    for (int k = 0; k < 8; ++k) { const float keep = b5 ? s16[k + 8] : s16[k], send = b5 ? s16[k] : s16[k + 8]; t8[k] = keep + __shfl_xor(send, 32); }
#pragma unroll
    for (int k = 0; k < 4; ++k) { const float keep = b4 ? t8[k + 4] : t8[k], send = b4 ? t8[k] : t8[k + 4]; u4[k] = keep + __shfl_xor(send, 16); }
#pragma unroll
    for (int k = 0; k < 2; ++k) { const float keep = b3 ? u4[k + 2] : u4[k], send = b3 ? u4[k] : u4[k + 2]; w2[k] = keep + __shfl_xor(send, 8); }
    float z; { const float keep = b2 ? w2[1] : w2[0], send = b2 ? w2[0] : w2[1]; z = keep + __shfl_xor(send, 4); }
    z += __shfl_xor(z, 2); z += __shfl_xor(z, 1);
    e_out = (b5 ? 8 : 0) + (b4 ? 4 : 0) + (b3 ? 2 : 0) + (b2 ? 1 : 0);
    return z;
}
template <int RPW>
DI void phase_norm2(const Frame& F, int layer, bool skipctx, const float* x_in, const float* ctx_in, const bf16_t* X, const bf16_t* Y, bf16_t* H2, const float* MOD, const float* gffn, const float* w_router, float* AFF) {
    constexpr int WP = 1028;
    LAS float* wl = (LAS float*)F.lds;
    LAS float* ml = wl + 16 * WP;
    const WaveRows wr = wave_rows((int)blockIdx.x, F.G / NB, skipctx ? CTXL : 0, skipctx ? SEQ : PB, F.wave);
    for (int idx = F.tid; idx < 16384; idx += NWAVES * 64) wl[(idx & 15) * WP + (idx >> 4)] = w_router[idx];
    { const float* modl = MOD + (size_t)layer * 9 * 6144;
      for (int idx = F.tid; idx < 2048; idx += NWAVES * 64) { const int set = idx >> 10, c = idx & 1023; const float* mr = modl + (size_t)(set ? 8 : wr.b) * 6144;
          ml[(set * 3 + 0) * 1024 + c] = mr[2 * 1024 + c]; ml[(set * 3 + 1) * 1024 + c] = gffn[c] * (1.f + mr[4 * 1024 + c]); ml[(set * 3 + 2) * 1024 + c] = mr[3 * 1024 + c]; } }
    __syncthreads();
    for (int p = wr.pa; p < wr.pb; p += RPW) {
        f32x4 x[RPW][4]; int pk[RPW]; size_t Rk[RPW]; const LAS float* mk[RPW];
        { u32x2 y[RPW][4];
#pragma unroll
          for (int k = 0; k < RPW; ++k) { pk[k] = min(p + k, wr.pb - 1); Rk[k] = (size_t)wr.b * PB + pk[k]; mk[k] = ml + (pk[k] < CTXL ? 3072 : 0);
              if (layer > 0) {
#pragma unroll
                  for (int j = 0; j < 4; ++j) { const u32x2 w = *(const u32x2*)(X + Rk[k] * 1024 + j * 256 + 4 * F.lane); x[k][j] = (f32x4){bflo(w.x), bfhi(w.x), bflo(w.y), bfhi(w.y)}; }
              } else { const float* src = stream_in(x_in, ctx_in, wr.b, pk[k]);
#pragma unroll
                  for (int j = 0; j < 4; ++j) x[k][j] = *(const f32x4*)(src + j * 256 + 4 * F.lane); }
#pragma unroll
              for (int j = 0; j < 4; ++j) y[k][j] = *(const u32x2*)(Y + Rk[k] * 1024 + j * 256 + 4 * F.lane); }
#pragma unroll
          for (int k = 0; k < RPW; ++k) add_gated_bf16(x[k], y[k], mk[k], F.lane); }
        float ss[RPW];
#pragma unroll
        for (int k = 0; k < RPW; ++k) ss[k] = row_ssq(x[k]);
        wave_sum_n<RPW>(ss);
#pragma unroll
        for (int k = 0; k < RPW; ++k) { const float rstd = __builtin_amdgcn_rsqf(ss[k] * (1.f / 1024.f) + RMS_EPS);
#pragma unroll
            for (int j = 0; j < 4; ++j) x[k][j] = x[k][j] * rstd * *(const LAS f32x4*)(mk[k] + 1024 + j * 256 + 4 * F.lane) + *(const LAS f32x4*)(mk[k] + 2048 + j * 256 + 4 * F.lane);
            row_store_bf16(F.lane, x[k], H2 + Rk[k] * 1024); }
        float s16[RPW][16];
        int wofs = 4 * F.lane; asm volatile("" : "+v"(wofs));
#pragma unroll
        for (int e = 0; e < 16; ++e) {
            f32x4 w[4];
#pragma unroll
            for (int j = 0; j < 4; ++j) w[j] = *(const LAS f32x4*)(wl + e * WP + j * 256 + wofs);
#pragma unroll
            for (int k = 0; k < RPW; ++k) { float s = 0.f;
#pragma unroll
                for (int j = 0; j < 4; ++j) s += (x[k][j][0] * w[j][0] + x[k][j][1] * w[j][1]) + (x[k][j][2] * w[j][2] + x[k][j][3] * w[j][3]);
                s16[k][e] = s; }
            if ((e & 3) == 3) __builtin_amdgcn_sched_barrier(0);
        }
        float aff[RPW]; int ek = 0;
#pragma unroll
        for (int k = 0; k < RPW; ++k) { int e; const float z = router_butterfly(s16[k], F.lane, e);
            float mx = z;
            mx = fmaxf(mx, __shfl_xor(mx, 32)); mx = fmaxf(mx, __shfl_xor(mx, 16)); mx = fmaxf(mx, __shfl_xor(mx, 8)); mx = fmaxf(mx, __shfl_xor(mx, 4));
            const float mine = expf(z - mx);
            float den = mine;
            den += __shfl_xor(den, 32); den += __shfl_xor(den, 16); den += __shfl_xor(den, 8); den += __shfl_xor(den, 4);
            aff[k] = mine / den; ek = e; }
        if ((F.lane & 3) == 0) {
#pragma unroll
            for (int k = 0; k < RPW; ++k) AFF[((size_t)wr.b * 16 + ek) * PB + pk[k]] = aff[k]; }
    }
    __syncthreads();
}

DI int block_exscan(const Frame& F, int v, LAS int* wtot, int& total) {
    int incl = v; const int sl = lane_op();
#pragma unroll
    for (int o = 1; o < 64; o <<= 1) { const int t = shup(incl, o, sl); if (sl >= o) incl += t; }
    if (F.lane == 63) wtot[F.wave] = incl;
    __syncthreads();
    int base = 0; total = 0;
#pragma unroll
    for (int w = 0; w < 8; ++w) { const int x = wtot[w]; if (w < F.wave) base += x; total += x; }
    __syncthreads();
    return base + incl - v;
}
DI void phase_topk(const Frame& F, int nitems, const float* AFF, int* SRC, float* GV, int* INV) {
    LAS int* wcnt = (LAS int*)F.lds;
    LAS int* wtot = wcnt + 48;
    for (int it = blockIdx.x; it < nitems; it += F.G) {
        const int isctx = it >= 128, be = it & 127, b = be >> 4, e = be & 15;
        const int n = isctx ? CTXL : SEQ, cap = isctx ? 32 : 256, p0 = isctx ? 0 : CTXL;
        const float* a = AFF + ((size_t)b * 16 + e) * PB + p0;
        unsigned v[4]; float av[4];
#pragma unroll
        for (int k = 0; k < 4; ++k) { const int idx = 4 * F.tid + k; av[k] = idx < n ? a[idx] : 0.f; v[k] = __builtin_bit_cast(unsigned, av[k]); }
        unsigned prefix = 0u;
        for (int b0 = 28; b0 >= 0; b0 -= 2) {
            const unsigned c3 = prefix | (3u << b0), c2 = prefix | (2u << b0), c1 = prefix | (1u << b0);
            int n3 = 0, n2 = 0, n1 = 0;
#pragma unroll
            for (int k = 0; k < 4; ++k) { n3 += __popcll(__ballot(v[k] >= c3)); n2 += __popcll(__ballot(v[k] >= c2)); n1 += __popcll(__ballot(v[k] >= c1)); }
            LAS int* wc = wcnt + ((b0 >> 1) & 1) * 24;
            if (F.lane == 0) { wc[F.wave] = n3; wc[8 + F.wave] = n2; wc[16 + F.wave] = n1; }
            __syncthreads();
            int t3 = 0, t2 = 0, t1 = 0;
#pragma unroll
            for (int w = 0; w < 8; ++w) { t3 += wc[w]; t2 += wc[8 + w]; t1 += wc[16 + w]; }
            prefix = (t3 >= cap) ? c3 : (t2 >= cap) ? c2 : (t1 >= cap) ? c1 : prefix;
        }
        __syncthreads();
        int ngt_t = 0, neq_t = 0;
#pragma unroll
        for (int k = 0; k < 4; ++k) { ngt_t += (v[k] > prefix) ? 1 : 0; neq_t += (v[k] == prefix) ? 1 : 0; }
        int ngt_total, neq_total;
        (void)block_exscan(F, ngt_t, wtot, ngt_total);
        int eq_rank = block_exscan(F, neq_t, wtot, neq_total);
        const int eq_take = cap - ngt_total;
        int sel[4], nsel_t = 0;
#pragma unroll
        for (int k = 0; k < 4; ++k) { int s = 0; if (v[k] > prefix) s = 1; else if (v[k] == prefix) { s = (eq_rank < eq_take) ? 1 : 0; ++eq_rank; } sel[k] = s; nsel_t += s; }
        int nsel_total;
        int slot = block_exscan(F, nsel_t, wtot, nsel_total);
        const int ebase = e * EROWS + (isctx ? 2048 + b * 32 : b * 256);
#pragma unroll
        for (int k = 0; k < 4; ++k) { const int idx = 4 * F.tid + k;
            if (idx < n) { const int R = b * PB + p0 + idx;
                if (sel[k]) { const int er = ebase + slot; ++slot; SRC[er] = R; GV[er] = av[k]; INV[(size_t)R * 16 + e] = er; }
                else INV[(size_t)R * 16 + e] = -1; } }
        __syncthreads();
    }
}
DI void phase_gather(const Frame& F, int rows_per_expert, const int* __restrict__ SRC, const bf16_t* __restrict__ H2, bf16_t* __restrict__ XG) {
    const int total = 16 * rows_per_expert;
    for (int q = F.gw * 4; q < total; q += F.NGW * 4) {
        const int e = q / rows_per_expert, s = q - e * rows_per_expert, er = e * EROWS + s;
        int R[4];
#pragma unroll
        for (int u = 0; u < 4; ++u) R[u] = SRC[er + u];
        u32x4 v0[4], v1[4];
#pragma unroll
        for (int u = 0; u < 4; ++u) { v0[u] = *(const u32x4*)(H2 + (size_t)R[u] * 1024 + 8 * F.lane); v1[u] = *(const u32x4*)(H2 + (size_t)R[u] * 1024 + 512 + 8 * F.lane); }
#pragma unroll
        for (int u = 0; u < 4; ++u) { *(u32x4*)(XG + (size_t)(er + u) * 1024 + 8 * F.lane) = v0[u]; *(u32x4*)(XG + (size_t)(er + u) * 1024 + 512 + 8 * F.lane) = v1[u]; }
    }
}

DI void qk_norm_rope(const float (&vin)[8], int ll, const float (&gn)[8], const float (&c)[8], const float (&sn)[8], float scale, float (&o)[8]) {
    float v[8]; float ss = 0.f;
#pragma unroll
    for (int k = 0; k < 8; ++k) ss += vin[k] * vin[k];
    ss += __shfl_xor(ss, 1); ss += __shfl_xor(ss, 2); ss += __shfl_xor(ss, 4);
    const float rstd = __builtin_amdgcn_rsqf(ss * (1.f / 64.f) + RMS_EPS) * scale;
#pragma unroll
    for (int k = 0; k < 8; ++k) v[k] = vin[k] * rstd * gn[k];
    const bool isx2 = (ll & 2) != 0;
#pragma unroll
    for (int k = 0; k < 8; ++k) { const float pv = __shfl_xor(v[k], 2); o[k] = isx2 ? (v[k] * c[k] + pv * sn[k]) : (v[k] * c[k] - pv * sn[k]); }
}
DI void ld8(const float* p, float (&o)[8]) { const f32x4 a = *(const f32x4*)p, b = *(const f32x4*)(p + 4); o[0] = a[0]; o[1] = a[1]; o[2] = a[2]; o[3] = a[3]; o[4] = b[0]; o[5] = b[1]; o[6] = b[2]; o[7] = b[3]; }
DI void phase_elem(const Frame& F, const LayerIn& P, const bf16_t* __restrict__ PA, const float* __restrict__ ROPE, bf16_t* __restrict__ QN, bf16_t* __restrict__ KN, bf16_t* __restrict__ XBC,
                   float* __restrict__ DT, bf16_t* __restrict__ AU, bf16_t* __restrict__ YCD) {
    const int l = F.lane;
    constexpr int NGRP = MROWS / 4;
    for (int task = F.gw; task < 3 * NGRP; task += F.NGW) {
        const int part = task / NGRP, R0 = (task - part * NGRP) * 4;
        const RowCtx rc = row_ctx(R0);
        const bf16_t* pr = PA + (size_t)R0 * PA_W;
        const bool has_prev = (rc.p != 0) && (rc.p != CTXL), has_next = (rc.p + 3 != CTXL - 1) && (rc.p + 3 != PB - 1);
        const bool rope = !rc.isctx; const int t0 = rope ? rc.p - CTXL : 0;
        if (part == 0) {
            const int hb = (l & 7) >> 2, i0 = (l & 1) * 8, uk = l >> 4, lk = l & 15, hbk = (lk & 7) >> 2, i0k = (lk & 1) * 8;
            u32x4 wq[4]; float cq[4][8], sq[4][8], ck[8], sk[8], gq[8], gk[8];
#pragma unroll
            for (int u = 0; u < 4; ++u) wq[u] = *(const u32x4*)(pr + (size_t)u * PA_W + C_Q + l * 8);
            const u32x4 wk = *(const u32x4*)(pr + (size_t)uk * PA_W + C_K + lk * 8);
            const bf16_t dtr = pr[(size_t)uk * PA_W + C_DT + (l & 7)];
            if (rope) {
#pragma unroll
                for (int u = 0; u < 4; ++u) { const float* cs = ROPE + (size_t)(t0 + u) * 64 + hb * 16 + i0; ld8(cs, cq[u]); ld8(cs + 32, sq[u]); }
                const float* cs = ROPE + (size_t)(t0 + uk) * 64 + hbk * 16 + i0k; ld8(cs, ck); ld8(cs + 32, sk);
            } else {
#pragma unroll
                for (int k = 0; k < 8; ++k) { ck[k] = 1.f; sk[k] = 0.f;
#pragma unroll
                    for (int u = 0; u < 4; ++u) { cq[u][k] = 1.f; sq[u][k] = 0.f; } }
            }
            ld8(P.q_norm_g + (l & 7) * 8, gq); ld8(P.k_norm_g + (lk & 7) * 8, gk);
            const float dtb = P.ssd_dt_bias[((l >> 3) & 1) * 8 + (l & 7)];
#pragma unroll
            for (int u = 0; u < 4; ++u) { float v[8], o[8]; unpack8(wq[u], v); qk_norm_rope(v, l, gq, cq[u], sq[u], ATT_C2, o); *(u32x4*)(QN + (size_t)(R0 + u) * 512 + l * 8) = pack8(o); }
            { float v[8], o[8]; unpack8(wk, v); qk_norm_rope(v, lk, gk, ck, sk, 1.f, o); *(u32x4*)(KN + (size_t)(R0 + uk) * 128 + lk * 8) = pack8(o); }
            { const int d = (l >> 3) & 1, h = l & 7; DT[((size_t)d * MROWS + R0 + uk) * 8 + h] = softplus_f(bf2f(dtr) + dtb); }
        } else if (part == 1) {
            const bool v1 = l < 32;
            u32x4 w[2][6]; float cw[2][4][8];
#pragma unroll
            for (int ps = 0; ps < 2; ++ps) { const int ch = (ps * 64 + l) * 8;
#pragma unroll
                for (int u = 0; u < 6; ++u) { const bool ok = ((u == 0) ? has_prev : (u == 5) ? has_next : true) && (ps == 0 || v1);
                    w[ps][u] = ok ? *(const u32x4*)(pr + (ptrdiff_t)(u - 1) * PA_W + C_XBC + ch) : (u32x4){0u, 0u, 0u, 0u}; } }
#pragma unroll
            for (int ps = 0; ps < 2; ++ps) { const int ch = (ps == 0 || v1) ? (ps * 64 + l) * 8 : 0;
                ld8(P.ssd_conv_w + ch, cw[ps][0]); ld8(P.ssd_conv_w + 768 + ch, cw[ps][1]); ld8(P.ssd_conv_w + 1536 + ch, cw[ps][2]); ld8(P.ssd_conv_b + ch, cw[ps][3]); }
#pragma unroll
            for (int ps = 0; ps < 2; ++ps) { const int ch = (ps * 64 + l) * 8;
                float a[8], b[8], c[8]; unpack8(w[ps][0], a); unpack8(w[ps][1], b);
#pragma unroll
                for (int u = 0; u < 4; ++u) { unpack8(w[ps][u + 2], c); float o[8];
#pragma unroll
                    for (int k = 0; k < 8; ++k) { o[k] = silu_f(cw[ps][0][k] * a[k] + cw[ps][1][k] * b[k] + cw[ps][2][k] * c[k] + cw[ps][3][k]); a[k] = b[k]; b[k] = c[k]; }
                    if (ps == 0 || v1) *(u32x4*)(XBC + (size_t)(R0 + u) * 768 + ch) = pack8(o); } }
        } else if (l < 48) {
            const int g = l >> 1, a0 = (l & 1) * 8, ch = l * 8;
            u32x4 uw[4], sb[4], sg[6], sh[6];
#pragma unroll
            for (int u = 0; u < 4; ++u) { uw[u] = *(const u32x4*)(pr + (size_t)u * PA_W + C_U + ch); sb[u] = *(const u32x4*)(pr + (size_t)u * PA_W + C_SB + ch); }
#pragma unroll
            for (int u = 0; u < 6; ++u) { const bool ok = (u == 0) ? has_prev : (u == 5) ? has_next : true;
                sg[u] = ok ? *(const u32x4*)(pr + (ptrdiff_t)(u - 1) * PA_W + C_SG + ch) : (u32x4){0u, 0u, 0u, 0u};
                sh[u] = ok ? *(const u32x4*)(pr + (ptrdiff_t)(u - 1) * PA_W + C_SH + ch) : (u32x4){0u, 0u, 0u, 0u}; }
            float w0[8], w1[8], w2[8];
            ld8(P.sc_conv_w + ch, w0); ld8(P.sc_conv_w + 384 + ch, w1); ld8(P.sc_conv_w + 768 + ch, w2);
#pragma unroll
            for (int u = 0; u < 4; ++u) *(u32x4*)(AU + ((size_t)g * 576 + ((R0 + u) >> 5)) * 768 + ((R0 + u) & 31) * 16 + a0) = uw[u];
            float a[8], b[8], c[8], x[8], y[8];
            unpack8(sg[0], x); unpack8(sh[0], y);
#pragma unroll
            for (int k = 0; k < 8; ++k) a[k] = x[k] * y[k];
            unpack8(sg[1], x); unpack8(sh[1], y);
#pragma unroll
            for (int k = 0; k < 8; ++k) b[k] = x[k] * y[k];
#pragma unroll
            for (int u = 0; u < 4; ++u) { unpack8(sg[u + 2], x); unpack8(sh[u + 2], y); float s[8], o[8]; unpack8(sb[u], s);
#pragma unroll
                for (int k = 0; k < 8; ++k) { c[k] = x[k] * y[k]; o[k] = s[k] * (w0[k] * a[k] + w1[k] * b[k] + w2[k] * c[k]); a[k] = b[k]; b[k] = c[k]; }
                *(u32x4*)(YCD + (size_t)(R0 + u) * 768 + 384 + ch) = pack8(o); }
        }
    }
}

typedef short v4i16_t __attribute__((ext_vector_type(4)));
DI int img_off(int row, int chunk) { return row * 128 + ((chunk ^ (row & 7)) << 4); }
DI s16x4 tr_read4(const LAS unsigned char* p) { return __builtin_bit_cast(s16x4, __builtin_amdgcn_ds_read_tr16_b64_v4i16((LAS v4i16_t*)p)); }
DI bf16x8 cat8(s16x4 lo, s16x4 hi) { return (bf16x8){lo[0], lo[1], lo[2], lo[3], hi[0], hi[1], hi[2], hi[3]}; }
DI unsigned cvtpk(float lo, float hi) { typedef __bf16 bf2 __attribute__((ext_vector_type(2))); f32x2 v = {lo, hi}; bf2 b = __builtin_convertvector(v, bf2); return __builtin_bit_cast(unsigned, b); }
#define MFMA32(a, b, c) __builtin_amdgcn_mfma_f32_32x32x16_bf16((a), (b), (c), 0, 0, 0)
DI int crow(int r, int hh) { return (r & 3) + 8 * (r >> 2) + 4 * hh; }

constexpr int SSD_XH = 0, SSD_BM = 65536, SSD_CM = 81920, SSD_ARR = 131072;
DI void ssd_load_images(const Frame& F, const bf16_t* XBC, int R0, int g, bool with_c) {
    int tid_l = F.tid; asm volatile("" : "+v"(tid_l));
#pragma unroll
    for (int it = 0; it < 8; ++it) { const int idx = it * 512 + tid_l, h4 = idx >> 10, row = (idx >> 3) & 127, ch = idx & 7;
        *(LAS u32x4*)(F.lds + SSD_XH + h4 * 16384 + img_off(row, ch)) = *(const u32x4*)(XBC + (size_t)(R0 + row) * 768 + g * 256 + h4 * 64 + ch * 8); }
#pragma unroll
    for (int it = 0; it < 2; ++it) { const int idx = it * 512 + tid_l, row = idx >> 3, ch = idx & 7;
        *(LAS u32x4*)(F.lds + SSD_BM + img_off(row, ch)) = *(const u32x4*)(XBC + (size_t)(R0 + row) * 768 + 512 + g * 64 + ch * 8);
        if (with_c) *(LAS u32x4*)(F.lds + SSD_CM + img_off(row, ch)) = *(const u32x4*)(XBC + (size_t)(R0 + row) * 768 + 640 + g * 64 + ch * 8); }
}
struct Series { float dt0, dt1, cs0, cs1, ecs0, ecs1, tot; };
DI Series ssd_series(const Frame& F, const float* DT, const float* a_log, int R0, int h, int d) {
    Series s; const float a = -__expf(a_log[d * 8 + h]);
    s.dt0 = DT[((size_t)d * MROWS + R0 + 2 * F.lane) * 8 + h]; s.dt1 = DT[((size_t)d * MROWS + R0 + 2 * F.lane + 1) * 8 + h];
    const float ad0 = s.dt0 * a, ad1 = s.dt1 * a, pair = ad0 + ad1; float incl = pair; const int sl = lane_op();
#pragma unroll
    for (int o = 1; o < 64; o <<= 1) { const float t = shup(incl, o, sl); if (sl >= o) incl += t; }
    const float excl = incl - pair;
    s.cs0 = excl + ad0; s.cs1 = incl; s.ecs0 = excl; s.ecs1 = excl + ad0; s.tot = shidx(incl, 63);
    return s;
}

DI void ssd_chunk_states(const Frame& F, const LayerIn& P, const bf16_t* XBC, const float* DT, float* S, float* TOT) {
    LAS float* W = (LAS float*)(F.lds + SSD_ARR);
    const int lane = F.lane, hh = lane >> 5, q = (lane & 15) >> 2, pp = lane & 3, blk = (lane >> 4) & 1;
    const int h4 = F.wave & 3, d = F.wave >> 2;
    for (int it = F.bid; it < 288; it += F.G) {
        const int b = it / 36, r = it % 36, c = r >> 1, g = r & 1, R0 = b * PB + c * 128, h = 4 * g + h4;
        ssd_load_images(F, XBC, R0, g, false);
        const Series s = ssd_series(F, DT, P.ssd_a_log, R0, h, d);
        float w0, w1;
        if (d == 0) { w0 = s.dt0 * __expf(s.tot - s.cs0); w1 = s.dt1 * __expf(s.tot - s.cs1); } else { w0 = s.dt0 * __expf(s.ecs0); w1 = s.dt1 * __expf(s.ecs1); }
        *(LAS f32x2*)(W + F.wave * 128 + 2 * lane) = (f32x2){w0, w1};
        if (lane == 0) TOT[(((size_t)b * 18 + c) * 8 + h) * 2 + d] = s.tot;
        __syncthreads();
        f32x16 acc[2][2];
#pragma unroll
        for (int i = 0; i < 2; ++i)
#pragma unroll
            for (int j = 0; j < 2; ++j)
#pragma unroll
                for (int k = 0; k < 16; ++k) acc[i][j][k] = 0.f;
        const LAS unsigned char* xh = F.lds + SSD_XH + h4 * 16384;
        const LAS unsigned char* bm = F.lds + SSD_BM;
#pragma unroll 2
        for (int st = 0; st < 8; ++st) {
            const int row = 16 * st + 8 * hh + q;
            const f32x4 wa = *(const LAS f32x4*)(W + F.wave * 128 + 16 * st + 8 * hh), wb = *(const LAS f32x4*)(W + F.wave * 128 + 16 * st + 8 * hh + 4);
            bf16x8 af[2], bfr[2];
#pragma unroll
            for (int t = 0; t < 2; ++t) { const int chunk = t * 4 + 2 * blk + (pp >> 1), within = 8 * (pp & 1);
                af[t] = cat8(tr_read4(bm + img_off(row, chunk) + within), tr_read4(bm + img_off(row + 4, chunk) + within));
                const s16x4 lo = tr_read4(xh + img_off(row, chunk) + within), hi = tr_read4(xh + img_off(row + 4, chunk) + within);
                u32x4 pw;
                pw.x = cvtpk(bf2f((bf16_t)lo[0]) * wa[0], bf2f((bf16_t)lo[1]) * wa[1]); pw.y = cvtpk(bf2f((bf16_t)lo[2]) * wa[2], bf2f((bf16_t)lo[3]) * wa[3]);
                pw.z = cvtpk(bf2f((bf16_t)hi[0]) * wb[0], bf2f((bf16_t)hi[1]) * wb[1]); pw.w = cvtpk(bf2f((bf16_t)hi[2]) * wb[2], bf2f((bf16_t)hi[3]) * wb[3]);
                bfr[t] = __builtin_bit_cast(bf16x8, pw); }
#pragma unroll
            for (int nt = 0; nt < 2; ++nt)
#pragma unroll
                for (int pt = 0; pt < 2; ++pt) acc[nt][pt] = MFMA32(af[nt], bfr[pt], acc[nt][pt]);
        }
        float* Sb = S + ((((size_t)b * 18 + c) * 8 + h) * 2 + d) * 4096;
#pragma unroll
        for (int nt = 0; nt < 2; ++nt)
#pragma unroll
            for (int pt = 0; pt < 2; ++pt)
#pragma unroll
                for (int q4 = 0; q4 < 4; ++q4) { const int p = pt * 32 + (lane & 31), n0 = nt * 32 + 8 * q4 + 4 * hh;
                    *(f32x4*)(Sb + p * 64 + n0) = (f32x4){acc[nt][pt][4 * q4], acc[nt][pt][4 * q4 + 1], acc[nt][pt][4 * q4 + 2], acc[nt][pt][4 * q4 + 3]}; }
        __syncthreads();
    }
}

DI void ssd_recurrence(const Frame& F, const float* __restrict__ S, const float* __restrict__ TOT, bf16_t* __restrict__ HIN) {
    for (int gi = F.bid * 512 + F.tid; gi < 128 * 1024; gi += F.G * 512) {
        const int bhd = gi >> 10, e4 = (gi & 1023) * 4, b = bhd >> 4, h = (bhd >> 1) & 7, d = bhd & 1;
        f32x4 sv[18]; float dec[18];
#pragma unroll
        for (int k = 0; k < 18; ++k) { const int c = (d == 0) ? k : (k < 2 ? 1 - k : 19 - k);
            const size_t st = (((size_t)b * 18 + c) * 8 + h) * 2 + d;
            sv[k] = *(const f32x4*)(S + st * 4096 + e4); dec[k] = TOT[st]; }
        float z0 = 0.f; asm volatile("" : "+v"(z0));
        f32x4 H = (f32x4){z0, z0, z0, z0};
#pragma unroll
        for (int k = 0; k < 18; ++k) { const int c = (d == 0) ? k : (k < 2 ? 1 - k : 19 - k);
            const size_t st = (((size_t)b * 18 + c) * 8 + h) * 2 + d;
            u32x2 w; w.x = pk2(H[0], H[1]); w.y = pk2(H[2], H[3]);
            *(u32x2*)(HIN + st * 4096 + e4) = w;
            H = H * __expf(dec[k]) + sv[k]; }
    }
}

#ifndef E3_PROBE
#define E3_PROBE 0
#endif
__device__ unsigned long long g_probe_ticks;
#define E3STAMP(k) do { if (E3_PROBE) { const unsigned long long t_ = __builtin_amdgcn_s_memrealtime(); if (E3_PROBE == (k) && blockIdx.x == 0 && threadIdx.x == 0) g_probe_ticks += t_ - tprev_; tprev_ = t_; } } while (0)
DI void ssd_output(const Frame& F, const LayerIn& P, const bf16_t* XBC, const bf16_t* PA, const float* DT, const bf16_t* HIN, bf16_t* YB, float* SSQ, bool skipctx) {
    LAS float* ARR = (LAS float*)(F.lds + SSD_ARR);
    const int lane = F.lane, hh = lane >> 5, q = (lane & 15) >> 2, pp = lane & 3, blk = (lane >> 4) & 1, l31 = lane & 31;
    for (int it = F.bid; it < 288; it += F.G) {
        const int b = it / 36, r_ = it % 36, c = r_ >> 1, g = r_ & 1, R0 = b * PB + c * 128;
        if (skipctx && c < 2) continue;
        unsigned long long tprev_ = E3_PROBE ? __builtin_amdgcn_s_memrealtime() : 0ull;
        ssd_load_images(F, XBC, R0, g, true);
        bf16x8 hb0[2][4];
        { const bf16_t* Hs = HIN + (((((size_t)b * 18 + c) * 8 + 4 * g + (F.wave & 3)) * 2 + 0) * 4096);
#pragma unroll
          for (int pt = 0; pt < 2; ++pt)
#pragma unroll
              for (int ks = 0; ks < 4; ++ks) hb0[pt][ks] = *(const bf16x8*)(Hs + (pt * 32 + l31) * 64 + 16 * ks + 8 * hh); }
        { const int h4 = F.wave & 3, d = F.wave >> 2, h = 4 * g + h4;
          const Series s = ssd_series(F, DT, P.ssd_a_log, R0, h, d);
          LAS float* A = ARR + h4 * 768;
          if (d == 0) { *(LAS f32x2*)(A + 0 * 128 + 2 * lane) = (f32x2){s.cs0, s.cs1}; *(LAS f32x2*)(A + 1 * 128 + 2 * lane) = (f32x2){s.dt0, s.dt1};
                        *(LAS f32x2*)(A + 2 * 128 + 2 * lane) = (f32x2){__expf(s.cs0), __expf(s.cs1)}; }
          else { *(LAS f32x2*)(A + 3 * 128 + 2 * lane) = (f32x2){s.ecs0, s.ecs1}; *(LAS f32x2*)(A + 4 * 128 + 2 * lane) = (f32x2){s.dt0, s.dt1};
                 *(LAS f32x2*)(A + 5 * 128 + 2 * lane) = (f32x2){__expf(s.tot - s.ecs0), __expf(s.tot - s.ecs1)}; } }
        __syncthreads();
        E3STAMP(1);
        const int h4 = F.wave & 3, rh = F.wave >> 2, h = 4 * g + h4;
        const LAS float* A = ARR + h4 * 768;
        const LAS unsigned char* xh = F.lds + SSD_XH + h4 * 16384;
        const LAS unsigned char* bm = F.lds + SSD_BM;
        const LAS unsigned char* cm = F.lds + SSD_CM;
        f32x16 yacc[2][2];
#pragma unroll
        for (int i = 0; i < 2; ++i)
#pragma unroll
            for (int j = 0; j < 2; ++j)
#pragma unroll
                for (int k = 0; k < 16; ++k) yacc[i][j][k] = 0.f;
        bf16x8 hb1[2][4];
        { const bf16_t* Hs = HIN + (((((size_t)b * 18 + c) * 8 + h) * 2 + 1) * 4096);
#pragma unroll
          for (int pt = 0; pt < 2; ++pt)
#pragma unroll
              for (int ks = 0; ks < 4; ++ks) hb1[pt][ks] = *(const bf16x8*)(Hs + (pt * 32 + l31) * 64 + 16 * ks + 8 * hh); }
#pragma unroll
        for (int d = 0; d < 2; ++d)
#pragma unroll
            for (int itl = 0; itl < 2; ++itl) {
                const int itile = 2 * rh + itl, irow = itile * 32 + l31;
                bf16x8 cf[4];
#pragma unroll
                for (int ks = 0; ks < 4; ++ks) cf[ks] = *(const LAS bf16x8*)(cm + img_off(irow, 2 * ks + hh));
#pragma unroll
                for (int pt = 0; pt < 2; ++pt) {
                    f32x16 tmp;
#pragma unroll
                    for (int k = 0; k < 16; ++k) tmp[k] = 0.f;
#pragma unroll
                    for (int ks = 0; ks < 4; ++ks) tmp = MFMA32(cf[ks], d == 0 ? hb0[pt][ks] : hb1[pt][ks], tmp);
#pragma unroll
                    for (int q4 = 0; q4 < 4; ++q4) { const f32x4 ev = *(const LAS f32x4*)(A + (d == 0 ? 2 : 5) * 128 + itile * 32 + 8 * q4 + 4 * hh);
#pragma unroll
                        for (int k = 0; k < 4; ++k) yacc[itl][pt][4 * q4 + k] += tmp[4 * q4 + k] * ev[k]; }
                }
                __builtin_amdgcn_sched_barrier(0);
            }
#pragma unroll
        for (int itl = 0; itl < 2; ++itl) {
            const int itile = 2 * rh + itl, irow = itile * 32 + l31;
            bf16x8 cf[4];
#pragma unroll
            for (int ks = 0; ks < 4; ++ks) cf[ks] = *(const LAS bf16x8*)(cm + img_off(irow, 2 * ks + hh));
            const float csf_i = A[0 * 128 + irow], ecb_i = A[3 * 128 + irow];
#pragma unroll 1
            for (int jt = 0; jt < 4; ++jt) {
                f32x16 Z;
#pragma unroll
                for (int k = 0; k < 16; ++k) Z[k] = 0.f;
#pragma unroll
                for (int ks = 0; ks < 4; ++ks) { const bf16x8 bf_ = *(const LAS bf16x8*)(bm + img_off(jt * 32 + l31, 2 * ks + hh)); Z = MFMA32(bf_, cf[ks], Z); }
#pragma unroll
                for (int q4 = 0; q4 < 4; ++q4) { const int j0 = jt * 32 + 8 * q4 + 4 * hh;
                    f32x4 w = (f32x4){0.f, 0.f, 0.f, 0.f};
                    if (jt <= itile) { const f32x4 cj = *(const LAS f32x4*)(A + 0 * 128 + j0), dj = *(const LAS f32x4*)(A + 1 * 128 + j0);
#pragma unroll
                        for (int k = 0; k < 4; ++k) { const bool ok = (jt < itile) || (j0 + k <= irow); w[k] += ok ? __expf(fminf(csf_i - cj[k], 0.f)) * dj[k] : 0.f; } }
                    if (jt >= itile) { const f32x4 ej = *(const LAS f32x4*)(A + 3 * 128 + j0), dj = *(const LAS f32x4*)(A + 4 * 128 + j0);
#pragma unroll
                        for (int k = 0; k < 4; ++k) { const bool ok = (jt > itile) || (j0 + k >= irow); w[k] += ok ? __expf(fminf(ej[k] - ecb_i, 0.f)) * dj[k] : 0.f; } }
#pragma unroll
                    for (int k = 0; k < 4; ++k) Z[4 * q4 + k] *= w[k]; }
#pragma unroll
                for (int s = 0; s < 2; ++s) {
                    u32x4 zp; zp.x = cvtpk(Z[8 * s], Z[8 * s + 1]); zp.y = cvtpk(Z[8 * s + 2], Z[8 * s + 3]); zp.z = cvtpk(Z[8 * s + 4], Z[8 * s + 5]); zp.w = cvtpk(Z[8 * s + 6], Z[8 * s + 7]);
                    const bf16x8 za = __builtin_bit_cast(bf16x8, zp);
                    const int row = jt * 32 + 16 * s + 4 * hh + q;
#pragma unroll
                    for (int pt = 0; pt < 2; ++pt) { const int chunk = pt * 4 + 2 * blk + (pp >> 1), within = 8 * (pp & 1);
                        const bf16x8 xb = cat8(tr_read4(xh + img_off(row, chunk) + within), tr_read4(xh + img_off(row + 8, chunk) + within));
                        yacc[itl][pt] = MFMA32(za, xb, yacc[itl][pt]); }
                }
                __builtin_amdgcn_sched_barrier(0);
            }
        }
        __syncthreads();
        E3STAMP(2);
        LAS float* Y = (LAS float*)F.lds;
#pragma unroll
        for (int itl = 0; itl < 2; ++itl)
#pragma unroll
            for (int pt = 0; pt < 2; ++pt)
#pragma unroll
                for (int r = 0; r < 16; ++r) Y[((2 * rh + itl) * 32 + crow(r, hh)) * 256 + h4 * 64 + pt * 32 + l31] = yacc[itl][pt][r];
        u32x4 xw[4], zw[4];
        int tid_e = F.tid; asm volatile("" : "+v"(tid_e));
#pragma unroll
        for (int u = 0; u < 4; ++u) { const int idx = u * 512 + tid_e, row = idx >> 5, ch = idx & 31, R = R0 + row;
            xw[u] = *(const u32x4*)(XBC + (size_t)R * 768 + g * 256 + ch * 8); zw[u] = *(const u32x4*)(PA + (size_t)R * PA_W + C_Z + g * 256 + ch * 8); }
        __syncthreads();
#pragma unroll
        for (int it4 = 0; it4 < 8; it4 += 4) {
            u32x4 xn[4], zn[4];
            if (it4 == 0) {
#pragma unroll
                for (int u = 0; u < 4; ++u) { const int idx = (4 + u) * 512 + tid_e, row = idx >> 5, ch = idx & 31, R = R0 + row;
                    xn[u] = *(const u32x4*)(XBC + (size_t)R * 768 + g * 256 + ch * 8); zn[u] = *(const u32x4*)(PA + (size_t)R * PA_W + C_Z + g * 256 + ch * 8); } }
#pragma unroll
            for (int u = 0; u < 4; ++u) { const int idx = (it4 + u) * 512 + tid_e, row = idx >> 5, ch = idx & 31, R = R0 + row;
                const f32x4 y0 = *(const LAS f32x4*)(Y + row * 256 + ch * 8), y1 = *(const LAS f32x4*)(Y + row * 256 + ch * 8 + 4);
                float xv[8], zv[8]; unpack8(xw[u], xv); unpack8(zw[u], zv);
                const float Dh = P.ssd_d[4 * g + (ch >> 3)]; float o[8], ss = 0.f;
#pragma unroll
                for (int k = 0; k < 8; ++k) { const float yv = (k < 4 ? y0[k] : y1[k - 4]) + Dh * xv[k]; o[k] = yv * silu_f(zv[k]); ss += o[k] * o[k]; }
                ss += __shfl_xor(ss, 1); ss += __shfl_xor(ss, 2); ss += __shfl_xor(ss, 4); ss += __shfl_xor(ss, 8); ss += __shfl_xor(ss, 16);
                if (ch == 0) SSQ[(size_t)R * 2 + g] = ss;
                *(u32x4*)(YB + (size_t)R * 1024 + 512 + g * 256 + ch * 8) = pack8(o); }
            if (it4 == 0) {
#pragma unroll
                for (int u = 0; u < 4; ++u) { xw[u] = xn[u]; zw[u] = zn[u]; } }
        }
        __syncthreads();
        E3STAMP(3);
    }
}

DI void s5_recurrence(const Frame& F, const LayerIn& P, const float* __restrict__ S5S, bf16_t* __restrict__ AU) {
    if (F.gw >= 384) return;
    const int g = F.gw >> 4, b = (F.gw >> 1) & 7, d = F.gw & 1, p = F.lane;
    const float step = __expf(P.s5_lstep[d * 24 + g]);
    const float lr = P.s5_lre[(d * 24 + g) * 64 + p], li = P.s5_lim[(d * 24 + g) * 64 + p];
    const float mag = expf(32.f * lr * step), ang = 32.f * li * step, Lr = mag * cosf(ang), Li = mag * sinf(ang);
    float Hr = 0.f, Hi = 0.f;
#pragma unroll 1
    for (int kb = 0; kb < 72; kb += 24) {
        float sr[24], si[24];
#pragma unroll
        for (int k = 0; k < 24; ++k) { const int kk = kb + k, ck = (d == 0) ? kk : (kk < 8 ? 7 - kk : 79 - kk);
            const size_t m = (size_t)g * 576 + b * 72 + ck;
            sr[k] = S5S[m * 256 + d * 128 + p]; si[k] = S5S[m * 256 + d * 128 + 64 + p]; }
#pragma unroll
        for (int k = 0; k < 24; ++k) { const int kk = kb + k, ck = (d == 0) ? kk : (kk < 8 ? 7 - kk : 79 - kk);
            const size_t m = (size_t)g * 576 + b * 72 + ck;
            AU[m * 768 + 512 + d * 128 + p] = (bf16_t)f2bf(Hr); AU[m * 768 + 512 + d * 128 + 64 + p] = (bf16_t)f2bf(Hi);
            const float nr = Lr * Hr - Li * Hi + sr[k], ni = Lr * Hi + Li * Hr + si[k];
            Hr = nr; Hi = ni; }
    }
}

namespace attn_body {
using bf16=__hip_bfloat16;
using bf16x8=__attribute__((ext_vector_type(8)))short;
using s16x4=__attribute__((ext_vector_type(4)))short;
using f32x16=__attribute__((ext_vector_type(16)))float;
using u32x4=__attribute__((ext_vector_type(4)))unsigned;
constexpr int D=64;
constexpr int NW=8,QBLK=32,QB=QBLK*NW,KVBLK=64;
__device__ __forceinline__ int crow(int r,int hi){return (r&3)+8*(r>>2)+4*hi;}
#define SBAR() __builtin_amdgcn_sched_barrier(0)
constexpr int NSLOT=3, SLOTB=8192;
constexpr int LDS_K=0, LDS_V=NSLOT*SLOTB, LDS_WS=2*NSLOT*SLOTB, LDS_OST=LDS_WS+NW*64*4, LDS_BYTES=LDS_OST+NW*4096;
constexpr float C2=0.125f*1.4426950408889634f;
__device__ __forceinline__ void glds16(const void*gsrc,unsigned lds_dst){unsigned keep;
  asm volatile("s_mov_b32 %0, m0\n\ts_mov_b32 m0, %2\n\ts_nop 0\n\tglobal_load_lds_dwordx4 %1, off\n\ts_mov_b32 m0, %0":"=&s"(keep):"v"(gsrc),"s"(lds_dst):"memory");}
__device__ __forceinline__ float max3f(float a,float b,float c){float r;asm("v_max3_f32 %0, %1, %2, %3":"=v"(r):"v"(a),"v"(b),"v"(c));return r;}
__device__ __forceinline__ float max2f(float a,float b){float r;asm("v_max_f32_e32 %0, %1, %2":"=v"(r):"v"(a),"v"(b));return r;}
__device__ __forceinline__ float fadd_s(float a,float b){float r;asm("v_add_f32_e32 %0, %1, %2":"=v"(r):"v"(a),"v"(b));return r;}
__device__ __forceinline__ float fsub_s(float a,float b){float r;asm("v_sub_f32_e32 %0, %1, %2":"=v"(r):"v"(a),"v"(b));return r;}
typedef float f32x2_t __attribute__((ext_vector_type(2))); typedef __bf16 bf16x2_t __attribute__((ext_vector_type(2)));
__device__ __forceinline__ unsigned cvtpk_s(float lo,float hi){f32x2_t v={lo,hi};bf16x2_t b=__builtin_convertvector(v,bf16x2_t);return __builtin_bit_cast(unsigned,b);}
#define WAIT_BAR(N) asm volatile("s_waitcnt vmcnt(" #N ") lgkmcnt(0)\n\ts_barrier":::"memory")

__device__ __forceinline__ void qkt(f32x16&p0,f32x16&p1,const char*Kslot,const bf16x8*qr,const f32x16&negm,int r32,int hi){
  const char*kb=Kslot+hi*1024+r32*16;
  #pragma unroll
  for(int d0=0;d0<4;++d0){
    const bf16x8 b0=*reinterpret_cast<const bf16x8*>(kb+d0*2048);
    const bf16x8 b1=*reinterpret_cast<const bf16x8*>(kb+d0*2048+512);
    if(d0==0){p0=__builtin_amdgcn_mfma_f32_32x32x16_bf16(b0,qr[0],negm,0,0,0);p1=__builtin_amdgcn_mfma_f32_32x32x16_bf16(b1,qr[0],negm,0,0,0);}
    else{p0=__builtin_amdgcn_mfma_f32_32x32x16_bf16(b0,qr[d0],p0,0,0,0);p1=__builtin_amdgcn_mfma_f32_32x32x16_bf16(b1,qr[d0],p1,0,0,0);}}
}
typedef __attribute__((address_space(3))) const char* lds_cptr;
typedef short v4i16_t __attribute__((ext_vector_type(4)));
__device__ __forceinline__ void kload8(bf16x8*kf,lds_cptr kp){
  kf[0]=*(const __attribute__((address_space(3))) bf16x8*)(kp);      kf[1]=*(const __attribute__((address_space(3))) bf16x8*)(kp+512);
  kf[2]=*(const __attribute__((address_space(3))) bf16x8*)(kp+2048); kf[3]=*(const __attribute__((address_space(3))) bf16x8*)(kp+2560);
  kf[4]=*(const __attribute__((address_space(3))) bf16x8*)(kp+4096); kf[5]=*(const __attribute__((address_space(3))) bf16x8*)(kp+4608);
  kf[6]=*(const __attribute__((address_space(3))) bf16x8*)(kp+6144); kf[7]=*(const __attribute__((address_space(3))) bf16x8*)(kp+6656);
}
__device__ __forceinline__ void kload2(bf16x8*kf,lds_cptr kp,int j){ kf[2*j]=*(const __attribute__((address_space(3))) bf16x8*)(kp+j*2048); kf[2*j+1]=*(const __attribute__((address_space(3))) bf16x8*)(kp+j*2048+512); }
__device__ __forceinline__ s16x4 vtr(lds_cptr p){ return __builtin_bit_cast(s16x4,__builtin_amdgcn_ds_read_tr16_b64_v4i16((__attribute__((address_space(3))) v4i16_t*)p)); }
__device__ __forceinline__ float rowmax(const f32x16&p0,const f32x16&p1){
  float a=max3f(p0[0],p0[1],p1[0]),b=max3f(p0[2],p0[3],p1[1]);a=max3f(a,p1[2],p1[3]);
  #pragma unroll
  for(int r=4;r<16;r+=4){a=max3f(a,p0[r],p0[r+1]);b=max3f(b,p0[r+2],p0[r+3]);a=max3f(a,p1[r],p1[r+1]);b=max3f(b,p1[r+2],p1[r+3]);}
  const float m=max2f(a,b);
  auto rr=__builtin_amdgcn_permlane32_swap(__float_as_uint(m),__float_as_uint(m),false,false);
  return max2f(__uint_as_float(rr[0]),__uint_as_float(rr[1]));
}
__device__ __forceinline__ void pv(f32x16*o,int vb,bf16x8 pa0,bf16x8 pa1,bf16x8 pa2,bf16x8 pa3){
  #pragma unroll
  for(int d0=0;d0<2;++d0){s16x4 lo[4],hi[4];
    #pragma unroll
    for(int ks=0;ks<4;++ks){
      asm volatile("ds_read_b64_tr_b16 %0,%1 offset:%c2":"=&v"(lo[ks]):"v"(vb),"i"(d0*4096+ks*1024):"memory");
      asm volatile("ds_read_b64_tr_b16 %0,%1 offset:%c2":"=&v"(hi[ks]):"v"(vb),"i"(d0*4096+ks*1024+512):"memory");}
    asm volatile("s_waitcnt lgkmcnt(0)":::"memory");SBAR();
    #define PK(k) (bf16x8){lo[k][0],lo[k][1],lo[k][2],lo[k][3],hi[k][0],hi[k][1],hi[k][2],hi[k][3]}
    o[d0]=__builtin_amdgcn_mfma_f32_32x32x16_bf16(pa0,PK(0),o[d0],0,0,0);
    o[d0]=__builtin_amdgcn_mfma_f32_32x32x16_bf16(pa1,PK(1),o[d0],0,0,0);
    o[d0]=__builtin_amdgcn_mfma_f32_32x32x16_bf16(pa2,PK(2),o[d0],0,0,0);
    o[d0]=__builtin_amdgcn_mfma_f32_32x32x16_bf16(pa3,PK(3),o[d0],0,0,0);
    #undef PK
  }
}

#ifndef ATTN_STORE16
#define ATTN_STORE16(p,v) (*(u32x4*)(p)=(v))
#endif
template<int THRL> __device__ __forceinline__ void attn_unit(const bf16*Qp,int qpitch,const bf16*__restrict__ Kp,int kpitch,const bf16*__restrict__ Vp,int vpitch,bf16*Op,int opitch,const int NT,char*shm){
  const int tid=fresh_tid(),lane=tid&63,r32=lane&31,hi=lane>>5; const int wid=__builtin_amdgcn_readfirstlane(tid>>6);
  const bf16*Qw=Qp+(long)(wid*QBLK)*qpitch;
  const bf16*Kh=Kp,*Vh=Vp;
  const unsigned lds0=(unsigned)(uintptr_t)shm;
  float*wsf=(float*)(shm+LDS_WS)+wid*64;
  const bf16*ksrc=Kh+(long)lane*kpitch+wid*8;
  const bf16*vsrc=Vh+(long)(16*(wid&3)+(lane>>2))*vpitch+(wid>>2)*32+(lane&3)*8;
  const unsigned kdst=lds0+LDS_K+wid*1024, vdst=lds0+LDS_V+wid*1024;
  #define DMA_K(t,slot) glds16(ksrc+(long)(t)*KVBLK*kpitch,(unsigned)__builtin_amdgcn_readfirstlane(kdst+(slot)))
  #define DMA_V(t,slot) glds16(vsrc+(long)(t)*KVBLK*vpitch,(unsigned)__builtin_amdgcn_readfirstlane(vdst+(slot)))
  const int vb0=(int)(lds0+LDS_V)+((lane>>4)&1)*32+(lane&3)*8+(4*hi+((lane&15)>>2))*64;
  const char*Kbase=shm+LDS_K; bf16x8 kf[8];
  const lds_cptr shm3=(lds_cptr)shm; const lds_cptr kp0=shm3+LDS_K+hi*1024+r32*16; const lds_cptr vp0=shm3+LDS_V+((lane>>4)&1)*32+(lane&3)*8+(4*hi+((lane&15)>>2))*64;
  DMA_K(0,0);DMA_V(0,0);DMA_K(1,SLOTB);
  bf16x8 qr[4];
  #pragma unroll
  for(int d0=0;d0<4;++d0)qr[d0]=*reinterpret_cast<const bf16x8*>(&Qw[(long)r32*qpitch+d0*16+hi*8]);
  float mhat=0.f,l_reg=0.f;f32x16 o[2];o[0]=f32x16{};o[1]=f32x16{};f32x16 negm=f32x16{};asm volatile("":"+v"(negm));
  #define CMASK(P0,P1,t) do{}while(0)
  bool resc=false;
  #define START(P0,P1) do{ const float rm=rowmax(P0,P1); resc=false; \
    { const float dl=rm; mhat=fadd_s(mhat,dl); \
      _Pragma("unroll") for(int r=0;r<16;++r){P0[r]=fsub_s(P0[r],dl);P1[r]=fsub_s(P1[r],dl);} \
      _Pragma("unroll") for(int r=0;r<16;++r)negm[r]=-mhat; asm volatile("":"+v"(negm)); } \
    _Pragma("unroll") for(int r=0;r<16;++r)P0[r]=__builtin_amdgcn_exp2f(P0[r]); }while(0)
  #define RESC() do{ if(resc){ asm volatile("s_waitcnt lgkmcnt(0)":::"memory"); \
      _Pragma("unroll") for(int d_=0;d_<2;++d_) _Pragma("unroll") for(int r=0;r<16;++r)o[d_][r]*=wsf[crow(r,hi)]; } }while(0)
  f32x16 pA0,pA1,pB0,pB1;
  int sl_prev=0,sl_cur=0,sl_next=SLOTB;
  #define ROT() do{sl_prev=sl_cur;sl_cur=sl_next;sl_next=(sl_next==(NSLOT-1)*SLOTB)?0:sl_next+SLOTB;}while(0)
  DMA_K(2,2*SLOTB);
  WAIT_BAR(3);
  qkt(pA0,pA1,Kbase,qr,negm,r32,hi);asm volatile("s_nop 15\n\ts_nop 7":"+v"(pA0),"+v"(pA1));CMASK(pA0,pA1,0);
  START(pA0,pA1);
  _Pragma("unroll") for(int r=0;r<16;++r)pA1[r]=__builtin_amdgcn_exp2f(pA1[r]);
  WAIT_BAR(0);
  DMA_K(3,0);DMA_V(1,SLOTB);
  ROT();
  kload8(kf,kp0+sl_cur);
  WAIT_BAR(2);
  s16x4 vlo[8],vhi[8]; u32x4 pw0,pw1,pw2,pw3;
  #define PKW(P,B) cvtpk_s(P[B],P[B+1])
  #define PAF(k) __builtin_bit_cast(bf16x8,pw##k)
  #define VFR(i) (bf16x8){vlo[i][0],vlo[i][1],vlo[i][2],vlo[i][3],vhi[i][0],vhi[i][1],vhi[i][2],vhi[i][3]}
  #define PIN(x) asm volatile("":"+v"(x))
  #define MX3(a,b,c) __builtin_fmaxf(__builtin_fmaxf((a),(b)),(c))
  #define GAPA(MF,A0,A1,A2,A3,W0,W1,PW) do{ MF; sacc+=A0; sacc+=A1; sacc+=A2; sacc+=A3; PIN(sacc); W0; W1; PIN(PW); SBAR(); }while(0)
  #define EX(v) __builtin_amdgcn_exp2f(v)
  #define GAPB(MF,X,B) do{ MF; X[B]=EX(X[B]); X[B+1]=EX(X[B+1]); X[B+2]=EX(X[B+2]); X[B+3]=EX(X[B+3]); PIN(X); SBAR(); }while(0)
  #define VRD(i) do{ vlo[i]=vtr(vp_+(((i)>>2)*4096+((i)&3)*1024)); vhi[i]=vtr(vp_+(((i)>>2)*4096+((i)&3)*1024+512)); }while(0)
  #define KRD(G,j) do{ if(G){ kload2(kf,kp0+sl_next,j); SBAR(); } }while(0)
  #define STEP(C0,C1,P0,P1,t,GK,GV,GL) do{ SBAR(); \
    const lds_cptr vp_=vp0+sl_prev; \
    VRD(0); SBAR(); float sacc=(P0[0]+P0[1]); \
    GAPA(C0=__builtin_amdgcn_mfma_f32_32x32x16_bf16(kf[0],qr[0],negm,0,0,0), P0[2],P0[3],P0[4],P0[5],     pw0[0]=PKW(P0,0), pw0[1]=PKW(P0,2), pw0); \
    VRD(4); SBAR(); GAPA(C1=__builtin_amdgcn_mfma_f32_32x32x16_bf16(kf[1],qr[0],negm,0,0,0), P0[6],P0[7],P0[8],P0[9],     pw0[2]=PKW(P0,4), pw0[3]=PKW(P0,6), pw0); \
    VRD(1); SBAR(); GAPA(C0=__builtin_amdgcn_mfma_f32_32x32x16_bf16(kf[2],qr[1],C0,0,0,0),   P0[10],P0[11],P0[12],P0[13], pw1[0]=PKW(P0,8), pw1[1]=PKW(P0,10), pw1); \
    VRD(5); SBAR(); GAPA(C1=__builtin_amdgcn_mfma_f32_32x32x16_bf16(kf[3],qr[1],C1,0,0,0),   P0[14],P0[15],P1[0],P1[1],   pw1[2]=PKW(P0,12),pw1[3]=PKW(P0,14), pw1); \
    VRD(2); SBAR(); GAPA(C0=__builtin_amdgcn_mfma_f32_32x32x16_bf16(kf[4],qr[2],C0,0,0,0),   P1[2],P1[3],P1[4],P1[5],     pw2[0]=PKW(P1,0), pw2[1]=PKW(P1,2), pw2); \
    VRD(6); SBAR(); GAPA(C1=__builtin_amdgcn_mfma_f32_32x32x16_bf16(kf[5],qr[2],C1,0,0,0),   P1[6],P1[7],P1[8],P1[9],     pw2[2]=PKW(P1,4), pw2[3]=PKW(P1,6), pw2); \
    VRD(3); SBAR(); GAPA(C0=__builtin_amdgcn_mfma_f32_32x32x16_bf16(kf[6],qr[3],C0,0,0,0),   P1[10],P1[11],P1[12],P1[13], pw3[0]=PKW(P1,8), pw3[1]=PKW(P1,10), pw3); \
    VRD(7); SBAR(); GAPA(C1=__builtin_amdgcn_mfma_f32_32x32x16_bf16(kf[7],qr[3],C1,0,0,0),   P1[14],P1[15],0.f,0.f,       pw3[2]=PKW(P1,12),pw3[3]=PKW(P1,14), pw3); \
    l_reg+=sacc; \
    if(GK){DMA_K((t)+3,sl_cur);} if(GV){DMA_V((t)+1,sl_next);} \
    CMASK(C0,C1,t); \
    { float a=MX3(C0[0],C0[1],C1[0]),b=MX3(C0[2],C0[3],C1[1]); a=MX3(a,C1[2],C1[3]); \
      _Pragma("unroll") for(int r=4;r<16;r+=4){a=MX3(a,C0[r],C0[r+1]);b=MX3(b,C0[r+2],C0[r+3]);a=MX3(a,C1[r],C1[r+1]);b=MX3(b,C1[r+2],C1[r+3]);} \
      float rm=__builtin_fmaxf(a,b); { auto rr=__builtin_amdgcn_permlane32_swap(__float_as_uint(rm),__float_as_uint(rm),false,false); rm=__builtin_fmaxf(__uint_as_float(rr[0]),__uint_as_float(rr[1])); } \
      resc=false; \
      if(__builtin_expect(__any(rm>(float)THRL),0)){ const float dl=__builtin_fmaxf(rm,0.f); mhat+=dl; \
        _Pragma("unroll") for(int r=0;r<16;++r){C0[r]-=dl;C1[r]-=dl;} \
        _Pragma("unroll") for(int r=0;r<16;++r)negm[r]=-mhat; asm volatile("":"+v"(negm)); \
        const float f=__builtin_amdgcn_exp2f(-dl); l_reg*=f; if(hi==0)wsf[r32]=f; resc=true; } } \
    SBAR(); \
    GAPB(o[0]=__builtin_amdgcn_mfma_f32_32x32x16_bf16(PAF(0),VFR(0),o[0],0,0,0), C0,0); \
    GAPB(o[1]=__builtin_amdgcn_mfma_f32_32x32x16_bf16(PAF(0),VFR(4),o[1],0,0,0), C0,4); \
    KRD(GL,0); GAPB(o[0]=__builtin_amdgcn_mfma_f32_32x32x16_bf16(PAF(1),VFR(1),o[0],0,0,0), C0,8); \
    KRD(GL,1); GAPB(o[1]=__builtin_amdgcn_mfma_f32_32x32x16_bf16(PAF(1),VFR(5),o[1],0,0,0), C0,12); \
    KRD(GL,2); GAPB(o[0]=__builtin_amdgcn_mfma_f32_32x32x16_bf16(PAF(2),VFR(2),o[0],0,0,0), C1,0); \
    KRD(GL,3); GAPB(o[1]=__builtin_amdgcn_mfma_f32_32x32x16_bf16(PAF(2),VFR(6),o[1],0,0,0), C1,4); \
    GAPB(o[0]=__builtin_amdgcn_mfma_f32_32x32x16_bf16(PAF(3),VFR(3),o[0],0,0,0), C1,8); \
    GAPB(o[1]=__builtin_amdgcn_mfma_f32_32x32x16_bf16(PAF(3),VFR(7),o[1],0,0,0), C1,12); \
    }while(0)
  int t=1;
  for(;t+5<NT;t+=2){
    STEP(pB0,pB1,pA0,pA1,t,true,true,true);     WAIT_BAR(2); RESC(); ROT();
    STEP(pA0,pA1,pB0,pB1,t+1,true,true,true);   WAIT_BAR(2); RESC(); ROT();
  }
  #define ENDW(tt) do{ if((tt)+3<NT){WAIT_BAR(2);} else if((tt)+2<NT){WAIT_BAR(1);} else {WAIT_BAR(0);} }while(0)
  for(;t+1<NT;t+=2){
    STEP(pB0,pB1,pA0,pA1,t,(t+3<NT),(t+1<NT),(t+1<NT));       ENDW(t);   RESC(); ROT();
    STEP(pA0,pA1,pB0,pB1,t+1,(t+4<NT),(t+2<NT),(t+2<NT));     ENDW(t+1); RESC(); ROT();
  }
  STEP(pB0,pB1,pA0,pA1,NT-1,false,false,false); RESC();
  { float sacc=pB0[0]+pB0[1]; _Pragma("unroll") for(int r=2;r<16;++r)sacc+=pB0[r]; _Pragma("unroll") for(int r=0;r<16;++r)sacc+=pB1[r]; l_reg+=sacc;
    pw0=(u32x4){PKW(pB0,0),PKW(pB0,2),PKW(pB0,4),PKW(pB0,6)};pw1=(u32x4){PKW(pB0,8),PKW(pB0,10),PKW(pB0,12),PKW(pB0,14)};pw2=(u32x4){PKW(pB1,0),PKW(pB1,2),PKW(pB1,4),PKW(pB1,6)};pw3=(u32x4){PKW(pB1,8),PKW(pB1,10),PKW(pB1,12),PKW(pB1,14)};
    SBAR(); pv(o,vb0+sl_cur,PAF(0),PAF(1),PAF(2),PAF(3)); }
  #undef PKW
  #undef PAF
  #undef VFR
  #undef PIN
  #undef MX3
  #undef GAPA
  #undef GAPB
  #undef EX
  #undef VRD
  #undef KRD
  #undef STEP
  #undef ENDW
  {auto rr=__builtin_amdgcn_permlane32_swap(__float_as_uint(l_reg),__float_as_uint(l_reg),false,false);l_reg=__uint_as_float(rr[0])+__uint_as_float(rr[1]);}
  if(hi==0)wsf[32+r32]=l_reg;asm volatile("s_waitcnt lgkmcnt(0)":::"memory");
  float rli[16];
  #pragma unroll
  for(int r=0;r<16;++r)rli[r]=__builtin_amdgcn_rcpf(wsf[32+crow(r,hi)]);
  bf16*Ow=Op+(long)(wid*QBLK)*opitch;
  { bf16*stg=(bf16*)(shm+LDS_OST)+wid*2048;
    #pragma unroll
    for(int r=0;r<16;++r){const int orow=crow(r,hi);
      #pragma unroll
      for(int d0=0;d0<2;++d0)stg[orow*64+d0*32+r32]=__float2bfloat16(o[d0][r]*rli[r]);}
    asm volatile("s_waitcnt lgkmcnt(0)":::"memory");
    #pragma unroll
    for(int i=0;i<4;++i){const int row=i*8+(lane>>3),ch=lane&7; const u32x4 v=*(const u32x4*)(stg+row*64+ch*8); ATTN_STORE16(Ow+(long)row*opitch+ch*8,v);} }
  asm volatile("s_waitcnt lgkmcnt(0)\n\ts_barrier":::"memory");
  #undef DMA_K
  #undef DMA_V
  #undef CMASK
  #undef START
  #undef RESC
  #undef ROT
}
constexpr int ATTN_LDS_BYTES=LDS_BYTES;
#undef SBAR
#undef WAIT_BAR
}


#define pMOD ((float*)(ws + WS_MOD))
#define pROPE ((float*)(ws + WS_ROPE))
#define pAFF ((float*)(ws + WS_AFF))
#define pINV ((int*)(ws + WS_INV))
#define pDT ((float*)(ws + WS_DT))
#define pSRC ((int*)(ws + WS_SRC))
#define pGV ((float*)(ws + WS_GV))
#define pSSQ ((float*)(ws + WS_SSQ))
#define pTOT ((float*)(ws + WS_TOT))
#define pX ((bf16_t*)(ws + WS_X))
#define pH ((bf16_t*)(ws + WS_H))
#define pYAB ((bf16_t*)(ws + WS_YAB))
#define pPA ((bf16_t*)(ws + WS_PA))
#define pPG ((unsigned char*)(ws + WS_PG))
#define pMRGB ((bf16_t*)(ws + WS_MRGB))
#define pY ((bf16_t*)(ws + WS_Y))
#define pXG ((bf16_t*)(ws + WS_XG))
#define pHID ((bf16_t*)(ws + WS_HID))
#define pYE ((bf16_t*)(ws + WS_YE))
#define pQN ((bf16_t*)(ws + WS_QN))
#define pKN ((bf16_t*)(ws + WS_KN))
#define pHIN ((bf16_t*)(ws + WS_HIN))
#define pXBC ((bf16_t*)(ws + WS_XBC))
#define pAU ((bf16_t*)(ws + WS_AU))
#define pSS ((float*)(ws + WS_S))
#define pYG ((bf16_t*)(ws + WS_YG))
#define pS5S ((float*)(ws + WS_S5S))
#define pYCD ((bf16_t*)(ws + WS_YCD))
constexpr int EW7_L0 = 1792, EW7_L1 = 2048, EW_SPLIT1 = EW7_L0 + 2688, EW_SPLIT2 = EW_SPLIT1 + 4480, EW1_SPLIT = 3072;
struct Args { const float* in[38]; float* out; unsigned char* ws; int ph_lo, ph_hi; };
constexpr int PH_PER_LAYER = 15, PH_FINAL = 2 * PH_PER_LAYER, PH_TOTAL = PH_FINAL + 1;

DI LayerIn layer_in(const Args& a, int L) {
    LayerIn P;
    P.norm_mix_g = a.in[6] + (size_t)L * 1024; P.norm_ffn_g = a.in[7] + (size_t)L * 1024;
    P.w_in = a.in[8] + (size_t)L * 1024 * NIN; P.q_norm_g = a.in[9] + L * 64; P.k_norm_g = a.in[10] + L * 64;
    P.ssd_conv_w = a.in[11] + L * 3 * 768; P.ssd_conv_b = a.in[12] + L * 768; P.ssd_dt_bias = a.in[13] + L * 16; P.ssd_a_log = a.in[14] + L * 16;
    P.ssd_d = a.in[15] + L * 8; P.ssd_norm_g = a.in[16] + L * 512;
    P.s5_lre = a.in[17] + L * 2 * 24 * 64; P.s5_lim = a.in[18] + L * 2 * 24 * 64; P.s5_lstep = a.in[19] + L * 48;
    P.s5_bre = a.in[20] + (size_t)L * 24 * 64 * 16; P.s5_bim = a.in[21] + (size_t)L * 24 * 64 * 16; P.s5_cre = a.in[22] + (size_t)L * 24 * 16 * 64; P.s5_cim = a.in[23] + (size_t)L * 24 * 16 * 64;
    P.s5_d = a.in[24] + L * 384; P.s5_wglu = a.in[25] + (size_t)L * 384 * 384; P.s5_bglu = a.in[26] + L * 384; P.sc_conv_w = a.in[27] + L * 3 * 384;
    P.w_br_attn = a.in[28] + (size_t)L * 512 * 1024; P.w_br_ssd = a.in[29] + (size_t)L * 512 * 1024; P.w_br_s5 = a.in[30] + (size_t)L * 384 * 1024; P.w_br_sc = a.in[31] + (size_t)L * 384 * 1024;
    P.w_out = a.in[32] + (size_t)L * 1024 * 1024; P.w_router = a.in[33] + (size_t)L * 1024 * 16;
    P.w_gate = a.in[34] + (size_t)L * 16 * 1024 * 1024; P.w_up = a.in[35] + (size_t)L * 16 * 1024 * 1024; P.w_down = a.in[36] + (size_t)L * 16 * 1024 * 1024;
    return P;
}

__global__ void __launch_bounds__(NWAVES * 64, 2) hybrid_fwd(Args args) {
    extern __shared__ __attribute__((aligned(16))) unsigned char lds_raw[];
    Frame F0;
#define F F0
    F.lds = (LAS unsigned char*)lds_raw;
    F.tid = threadIdx.x; F.lane = F.tid & 63; F.wave = __builtin_amdgcn_readfirstlane(F.tid >> 6);
    F.G = gridDim.x; { const int bx = blockIdx.x; F.vcu = (F.G % 8 == 0) ? (bx % 8) * (F.G / 8) + bx / 8 : bx; }
    F.gw = F.vcu * NWAVES + F.wave; F.NGW = F.G * NWAVES; F.bid = (int)blockIdx.x;
    unsigned char* ws = args.ws;
    volatile LAS unsigned* MISC = (volatile LAS unsigned*)(F.lds + LDSCTL_OFF);
    for (int u = F.tid; u < (LDS_BYTES - LDSCTL_OFF) / 4; u += NWAVES * 64) ((LAS unsigned*)(F.lds + LDSCTL_OFF))[u] = 0u;
    __syncthreads();
    XcdBarrier bar = xcd_barrier_post((unsigned*)(ws + WS_CTL) + CW_BAR, MISC + 8, (unsigned)gridDim.x);
    const int GH = (int)gridDim.x / 2; const bool chain = (int)blockIdx.x >= GH;
    XcdBarrier bar2 = bar; if (chain) bar2 = xcd_barrier_post((unsigned*)(ws + WS_CTL) + CW_BAR + XCD_BAR_WORDS, MISC + 10, (unsigned)((int)gridDim.x - GH));
    const int lo = args.ph_lo, hi = args.ph_hi;
#ifndef PH_MASK
#define PH_MASK 0xFFFF
#endif
#define IN(k) (lo <= (k) && (k) < hi)
#define INL(j) (((PH_MASK >> (j)) & 1) && IN(base + (j)))
#ifndef REPEAT_MASK
#define REPEAT_MASK 0
#endif
#define REP(j) for (int rep_ = 0; rep_ < 1 + ((REPEAT_MASK >> (j)) & 1); ++rep_)
#ifndef SP_AMP
#define SP_AMP 0
#endif
#ifndef SP_WG
#define SP_WG 0
#endif
#ifndef SP_MAXLO
#define SP_MAXLO 0
#define SP_MAXHI 0
#endif
#define PRESTAMP(k) do { if (SP_AMP && threadIdx.x == 0) { const unsigned t_ = (unsigned)__builtin_amdgcn_s_memrealtime(); if (blockIdx.x == SP_WG) MISC[128 + (k)] = t_; \
    if ((int)blockIdx.x >= SP_MAXLO && (int)blockIdx.x < SP_MAXHI) atomicMax((unsigned*)(ws + WS_CTL) + 32768 + (k), t_); } } while (0)
#define SEAM(k) do { if (IN((k) + 1)) xcd_barrier(bar); if (SP_AMP && blockIdx.x == SP_WG && threadIdx.x == 0) MISC[64 + (k)] = (unsigned)__builtin_amdgcn_s_memrealtime(); } while (0)
    if (SP_AMP && blockIdx.x == SP_WG && threadIdx.x == 0) MISC[63] = (unsigned)__builtin_amdgcn_s_memrealtime();

#undef F
#pragma unroll 1
    for (int L = 0; L < 2; ++L) {
        const int base = L * PH_PER_LAYER;
        if (hi <= base || lo >= base + PH_PER_LAYER) continue;
        const bool lastL = (L == 1);

        if (L == 0 && INL(0)) REP(0) { const LayerIn P = layer_in(args, L); Frame F = F0; F.tid = fresh_tid(); F.lane = F.tid & 63; if (rep_) xcd_barrier(bar);
#ifndef SUBREP_MOD
#define SUBREP_MOD 0
#endif
#ifndef SUBREP_S5
#define SUBREP_S5 0
#endif
#ifndef SUBREP_SW
#define SUBREP_SW 0
#endif
            prep_s5(F, P, ws);
            for (int q_ = 0; q_ <= SUBREP_MOD; ++q_) { prep_mod(F, args.in[1], args.in[3], args.in[4], args.in[5], pMOD, 96); prep_rope(F, pROPE, 96); }
            for (int q_ = 0; q_ <= SUBREP_SW; ++q_) prep_small_weights(F, P, ws, 0, 96);
            SEAM(base + 0);
        }
        if (INL(1)) REP(1) { const LayerIn P = layer_in(args, L); Frame F = F0; F.tid = fresh_tid(); F.lane = F.tid & 63; if (rep_) xcd_barrier(bar);
            if (L == 0) phase_norm1<false, 3>(F, L, args.in[0], args.in[2], pX, pH, pMOD, P.norm_mix_g, pINV, pYE, pY, 0); else phase_norm1<true, 2>(F, L, args.in[0], args.in[2], pX, pH, pMOD, P.norm_mix_g, pINV, pYE, pY, 0); SEAM(base + 1); }
        if (INL(2)) REP(2) { const LayerIn P = layer_in(args, L); Frame F = F0; F.tid = fresh_tid(); F.lane = F.tid & 63; if (rep_) xcd_barrier(bar);
            pg8::Gemm g{pH, (const bf16_t*)(ws + W_WIN), 1024, 1024, 1024};
            RowSkipOrder S; S.init(NPROJ, F.G, (int)blockIdx.x, lastL ? 1 : 0, 2, 10);
            EpiProj E{pPA, PA_W, PA_W / 256, pPG};
            pg8::gemm_phase<EpiProj, RowSkipOrder>(F.lds, g, S, E);
            SEAM(base + 2);
        }
        if (INL(3)) REP(3) { const LayerIn P = layer_in(args, L); Frame F = F0; F.tid = fresh_tid(); F.lane = F.tid & 63; if (rep_) xcd_barrier(bar); phase_elem(F, P, pPA, pROPE, pQN, pKN, pXBC, pDT, pAU, pYCD); SEAM(base + 3); }
        if (INL(4)) { const LayerIn P = layer_in(args, L); Frame F = F0; F.tid = fresh_tid(); F.lane = F.tid & 63;
            if (!chain) {
                using abf = attn_body::bf16;
                const int a = (int)blockIdx.x, av = (GH % 8 == 0) ? (a % 8) * (GH / 8) + a / 8 : a;
                { pg8::Gemm g{pAU, (const bf16_t*)(ws + W_P), 768, 512, 512}; OrderS5S S{GH, (a + GH - 56) % GH}; EpiS5S E{pS5S};
                  pg8::gemm_phase<EpiS5S, OrderS5S>(F.lds, g, S, E);
                  if (((a + GH - 56) % GH) < 72) { asm volatile("s_waitcnt vmcnt(0)" ::: "memory"); __syncthreads();
                      if (F.tid == 0) { __builtin_amdgcn_fence(__ATOMIC_RELEASE, "agent"); asm volatile("s_waitcnt vmcnt(0)" ::: "memory"); (void)xb_add((unsigned*)(ws + WS_CTL) + CW_S5CNT + 64 * L, 1u); } } }
                for (int u = av; u < 512; u += GH) { const int bk = u >> 5, r = u & 31, b = bk >> 1, kvh = bk & 1, h = kvh * 4 + (r >> 3), qb = r & 7;
                    const size_t qrow = (size_t)b * PB + CTXL + qb * 256, krow = (size_t)b * PB;
                    attn_body::attn_unit<8>((const abf*)(pQN + qrow * 512 + h * 64), 512, (const abf*)(pKN + krow * 128 + kvh * 64), 128, (const abf*)(pPA + krow * PA_W + C_V + kvh * 64), PA_W,
                                            (abf*)(pYAB + qrow * 1024 + h * 64), 1024, 36, (char*)lds_raw); }
                if (!lastL) for (int u = av; u < 64; u += GH) { const int b = u >> 3, h = u & 7, kvh = h >> 2; const size_t krow = (size_t)b * PB;
                    attn_body::attn_unit<8>((const abf*)(pQN + krow * 512 + h * 64), 512, (const abf*)(pKN + krow * 128 + kvh * 64), 128, (const abf*)(pPA + krow * PA_W + C_V + kvh * 64), PA_W,
                                            (abf*)(pYAB + krow * 1024 + h * 64), 1024, 4, (char*)lds_raw); }
            } else {
                const int GC = F.G - GH, rk = (int)blockIdx.x - GH;
                Frame Fc = F; Fc.G = GC; Fc.bid = rk; Fc.vcu = (GC % 8 == 0) ? (rk % 8) * (GC / 8) + rk / 8 : rk; Fc.gw = Fc.vcu * NWAVES + F.wave; Fc.NGW = GC * NWAVES;
                ssd_chunk_states(Fc, P, pXBC, pDT, pSS, pTOT);
                xcd_barrier(bar2);
                ssd_recurrence(Fc, pSS, pTOT, pHIN);
                { if (F.tid == 0) { unsigned* cw = (unsigned*)(ws + WS_CTL) + CW_S5CNT + 64 * L; unsigned sp = 0;
                      while (xb_ld(cw) < 72u) { __builtin_amdgcn_s_sleep(1); if (++sp > (1u << 22)) break; }
                      __builtin_amdgcn_fence(__ATOMIC_ACQUIRE, "agent"); asm volatile("s_waitcnt vmcnt(0)" ::: "memory"); }
                  __syncthreads(); }
                s5_recurrence(Fc, P, pS5S, pAU);
                xcd_barrier(bar2);
                ssd_output(Fc, P, pXBC, pPA, pDT, pHIN, pYAB, pSSQ, lastL);
                { pg8::Gemm g{pAU, (const bf16_t*)(ws + W_TQ), 768, 768, 768}; OrderS5Y S{GC, (rk + GC - 32) % GC}; EpiS5Y E{pAU, pYG, P.s5_d};
                  pg8::gemm_phase<EpiS5Y, OrderS5Y>(F.lds, g, S, E); }
            }
            PRESTAMP(base + 6); SEAM(base + 6);
        }
        if (INL(7)) REP(7) { const LayerIn P = layer_in(args, L); Frame F = F0; F.tid = fresh_tid(); F.lane = F.tid & 63; if (rep_) xcd_barrier(bar);
            pg8::Gemm g{pYG, (const bf16_t*)(ws + W_GLU), 384, 384, 384};
            RowSkipOrder S; S.init(512, F.G, (int)blockIdx.x, lastL ? 1 : 0, 0, 0);
            EpiGlu E{pYG, pYCD, P.s5_bglu};
            pg8::gemm_phase<EpiGlu, RowSkipOrder>(F.lds, g, S, E);
            if (!lastL) prep_expert_weights(F, P, ws, 144, 0, EW7_L0); else prep_expert_weights(F, P, ws, 128, 2 * 4096, 2 * 4096 + EW7_L1);
            SEAM(base + 7);
        }
        if (INL(8)) REP(8) { const LayerIn P = layer_in(args, L); Frame F = F0; F.tid = fresh_tid(); F.lane = F.tid & 63; if (rep_) xcd_barrier(bar);
            MergeOrder S; S.init(F.G, (int)blockIdx.x, lastL ? 1 : 0);
            pg8::MergeArgs MA{pYAB, pYCD, (const bf16_t*)(ws + W_BR4), pPG, pSSQ, pMRGB};
            pg8::gemm_merge_phase<MergeOrder>(F.lds, MA, S);
            if (!lastL) { __syncthreads(); const LayerIn P1 = layer_in(args, 1); prep_s5(F, P1, ws, 64); __syncthreads(); prep_expert_weights(F, P, ws, 160, EW7_L0, EW_SPLIT1); }
            SEAM(base + 8);
        }
        if (INL(9)) REP(9) { const LayerIn P = layer_in(args, L); Frame F = F0; F.tid = fresh_tid(); F.lane = F.tid & 63; if (rep_) xcd_barrier(bar);
            pg8::Gemm g{pMRGB, (const bf16_t*)(ws + W_OUT), 1024, 1024, 1024};
            RowSkipOrder S; S.init(1024, F.G, (int)blockIdx.x, lastL ? 1 : 0, 0, 0);
            EpiWout E{pY};
            pg8::gemm_phase<EpiWout, RowSkipOrder>(F.lds, g, S, E);
            if (!lastL) { __syncthreads(); const LayerIn P1 = layer_in(args, 1); prep_small_weights(F, P1, ws, 1, 32); prep_expert_weights(F, P, ws, 32, EW_SPLIT1, EW_SPLIT2); }
            SEAM(base + 9);
        }
        if (INL(10)) REP(10) { const LayerIn P = layer_in(args, L); Frame F = F0; F.tid = fresh_tid(); F.lane = F.tid & 63; if (rep_) xcd_barrier(bar); phase_norm2<3>(F, L, lastL, args.in[0], args.in[2], pX, pY, pH, pMOD, P.norm_ffn_g, P.w_router, pAFF); SEAM(base + 10); }
        if (INL(11)) REP(11) { const LayerIn P = layer_in(args, L); Frame F = F0; F.tid = fresh_tid(); F.lane = F.tid & 63; if (rep_) xcd_barrier(bar); phase_topk(F, lastL ? 128 : 256, pAFF, pSRC, pGV, pINV);
            if (L == 0) { const LayerIn P1 = layer_in(args, 1); prep_small_weights(F, P1, ws, 2, 0); }
            prep_expert_weights(F, P, ws, (L == 0) ? 0 : 128, (L == 0) ? EW_SPLIT2 : 2 * 4096 + EW7_L1, EXPERT_W_ITEMS); SEAM(base + 12); }
        if (INL(13)) REP(13) { const LayerIn P = layer_in(args, L); Frame F = F0; F.tid = fresh_tid(); F.lane = F.tid & 63; if (rep_) xcd_barrier(bar);
            pg8::Gemm g{pH, lastL ? (const bf16_t*)args.out : (const bf16_t*)(ws + WS_WGU), 1024, 1024, 1024}; OrderUp S{F.G, (int)blockIdx.x, lastL ? 8 : 9}; EpiUp E{pHID};
            pg8::gemm_phase_gather<EpiUp, OrderUp>(F.lds, g, pSRC, S, E);
            if (!lastL) { __syncthreads(); const LayerIn P1 = layer_in(args, 1); prep_expert_weights(F, P1, ws, 128, 0, EW1_SPLIT, (bf16_t*)args.out); }
            SEAM(base + 13);
        }
        if (INL(14)) REP(14) { const LayerIn P = layer_in(args, L); Frame F = F0; F.tid = fresh_tid(); F.lane = F.tid & 63; if (rep_) xcd_barrier(bar);
            pg8::Gemm g{pHID, (const bf16_t*)(ws + WS_WD), 1024, 1024, 1024}; OrderDown S{F.G, (int)blockIdx.x, lastL ? 8 : 9}; EpiDown E{pYE, pGV};
            pg8::gemm_phase<EpiDown, OrderDown>(F.lds, g, S, E);
            if (!lastL) { __syncthreads(); const LayerIn P1 = layer_in(args, 1); prep_expert_weights(F, P1, ws, 64, EW1_SPLIT, 2 * 4096, (bf16_t*)args.out); }
            SEAM(base + 14);
        }
    }
#if E3_PROBE
    if (blockIdx.x == 0 && threadIdx.x == 0) { const unsigned long long t0_ = __builtin_amdgcn_s_memrealtime(), w_ = 20ull * g_probe_ticks; while (__builtin_amdgcn_s_memrealtime() - t0_ < w_) __builtin_amdgcn_s_sleep(8); g_probe_ticks = 0; }
    __syncthreads();
#endif
#if SP_AMP
    if (blockIdx.x == SP_WG && threadIdx.x == 0) {
#ifdef SP_MAXK
        unsigned w_ = __hip_atomic_load((unsigned*)(ws + WS_CTL) + 32768 + SP_MAXK, __ATOMIC_RELAXED, __HIP_MEMORY_SCOPE_AGENT) - MISC[64 + SP_A];
#else
        unsigned w_ = MISC[64 + SP_B] - MISC[64 + SP_A];
#endif
#ifdef SP_B2
        w_ += MISC[64 + SP_B2] - MISC[64 + SP_A2];
#endif
        const unsigned long long t0_ = __builtin_amdgcn_s_memrealtime(), ww_ = (unsigned long long)SP_AMP * w_; while (__builtin_amdgcn_s_memrealtime() - t0_ < ww_) __builtin_amdgcn_s_sleep(8); }
    __syncthreads();
#endif
#ifdef EXTRA_BARRIERS
    for (int eb = 0; eb < EXTRA_BARRIERS; ++eb) xcd_barrier(bar);
#endif
    if (IN(PH_FINAL)) { Frame F = F0; F.tid = fresh_tid(); F.lane = F.tid & 63; phase_final<2>(F, pX, args.out, pMOD, args.in[37], pINV, pYE, pY); }
#undef IN
#undef INL
#undef SEAM
}

#ifndef MK_N_LAUNCHES
#define MK_N_LAUNCHES 1
#endif
extern "C" void kernel_launch(void* const* d_in, const int* in_sizes, int n_in, void* d_out, int out_size, void* d_ws, size_t ws_size, hipStream_t stream) {
    static int grid = 0;
    if (grid == 0) {
        if (n_in != 38 || ws_size < WS_END) { fprintf(stderr, "kernel_launch: unexpected inputs (n_in %d, ws %zu)\n", n_in, ws_size); grid = -1; return; }
        int dev = 0, cus = 0;
        if (hipGetDevice(&dev) != hipSuccess || hipDeviceGetAttribute(&cus, hipDeviceAttributeMultiprocessorCount, dev) != hipSuccess) { grid = -1; return; }
        if (hipFuncSetAttribute((const void*)hybrid_fwd, hipFuncAttributeMaxDynamicSharedMemorySize, LDS_BYTES) != hipSuccess) { fprintf(stderr, "kernel_launch: hipFuncSetAttribute failed\n"); grid = -1; return; }
        (void)hipGetLastError();
        grid = (cus / 8) * 8;
        if (grid > 256) grid = 256;
    }
    if (grid < 0) return;
    if (hipMemsetAsync((char*)d_ws + WS_CTL, 0, CTL_ZERO_BYTES, stream) != hipSuccess) return;
    Args a{};
    for (int i = 0; i < 38; ++i) a.in[i] = (const float*)d_in[i];
    a.out = (float*)d_out; a.ws = (unsigned char*)d_ws;
#if MK_N_LAUNCHES == 1
    a.ph_lo = 0; a.ph_hi = PH_TOTAL;
    hipLaunchKernelGGL(hybrid_fwd, dim3(grid), dim3(NWAVES * 64), LDS_BYTES, stream, a);
#else
    for (int p = 0; p < PH_TOTAL; ++p) { a.ph_lo = p; a.ph_hi = p + 1; hipLaunchKernelGGL(hybrid_fwd, dim3(grid), dim3(NWAVES * 64), LDS_BYTES, stream, a); }
#endif
}
```

```cpp
#include <hip/hip_runtime.h>
#include <hip/hip_bf16.h>
#include <cstdio>
#include <cstdint>
#include <cmath>

#define DI __device__ __forceinline__
#define GAS __attribute__((address_space(1)))
#define LAS __attribute__((address_space(3)))
typedef unsigned short bf16_t;
typedef short bf16x8 __attribute__((ext_vector_type(8)));
typedef short s16x4 __attribute__((ext_vector_type(4)));
typedef float f32x2 __attribute__((ext_vector_type(2)));
typedef float f32x4 __attribute__((ext_vector_type(4)));
typedef float f32x16 __attribute__((ext_vector_type(16)));
typedef unsigned u32x2 __attribute__((ext_vector_type(2)));
typedef unsigned u32x4 __attribute__((ext_vector_type(4)));
typedef GAS unsigned gu32;

constexpr int DM = 1024, NB = 8, SEQ = 2048, CTXL = 256, PB = 2304, MROWS = NB * PB;
constexpr int NIN = 7688, NE = 16, EFF = 1024;
constexpr int C_Q = 0, C_K = 512, C_V = 640, C_Z = 768, C_XBC = 1280, C_DT = 2048, C_U = 2056, C_SB = 2440, C_SG = 2824, C_SH = 3208, C_G = 3592;
constexpr int PA_W = 3840, PG_W = 4096, NPROJ = PA_W + PG_W;
constexpr int EROWS = 2304;
constexpr float RMS_EPS = 1e-6f;
constexpr float ATT_C2 = 0.125f * 1.4426950408889634f;

constexpr size_t MiB = 1u << 20;
constexpr size_t WS_CTL = 0, CTL_ZERO_BYTES = 1 * MiB;
constexpr size_t WS_MOD = 1 * MiB;
constexpr size_t WS_ROPE = WS_MOD + 512 * 1024;
constexpr size_t WS_AFF = 2 * MiB;
constexpr size_t WS_INV = WS_AFF + 1280 * 1024;
constexpr size_t WS_DT = WS_INV + 1280 * 1024;
constexpr size_t WS_SRC = WS_DT + 1280 * 1024;
constexpr size_t WS_GV = WS_SRC + 256 * 1024;
constexpr size_t WS_SSQ = WS_GV + 256 * 1024;
constexpr size_t WS_TOT = WS_SSQ + 256 * 1024;
constexpr size_t WS_X = 8 * MiB;
constexpr size_t WS_W = 80 * MiB;
constexpr size_t W_WIN = WS_W;
constexpr size_t W_BR4 = W_WIN + (size_t)NPROJ * 1024 * 2;
constexpr size_t W_OUT = W_BR4 + (size_t)1024 * 1792 * 2;
constexpr size_t W_GLU = W_OUT + 1024 * 1024 * 2;
constexpr size_t W_TQ = W_GLU + 512 * 384 * 2;
constexpr size_t W_P = W_TQ + (size_t)24 * 512 * 768 * 2;
constexpr size_t W_END = W_P + (size_t)24 * 256 * 512 * 2;
constexpr size_t WS_H = 126 * MiB;
constexpr size_t WS_YAB = WS_H;
constexpr size_t WS_PA = 162 * MiB;
constexpr size_t WS_MRGB = WS_PA, WS_XG = WS_PA, WS_Y = WS_PA + 72 * MiB;
constexpr size_t WS_PG = 297 * MiB;
constexpr size_t WS_HID = WS_PG, WS_YE = WS_PG + 72 * MiB;
constexpr size_t WS_R5 = 441 * MiB;
constexpr size_t WS_QN = WS_R5;
constexpr size_t WS_KN = WS_R5 + 18 * MiB;
constexpr size_t WS_HIN = WS_PG + 72 * MiB;
constexpr size_t WS_XBC = WS_R5 + 22 * MiB + 512 * 1024;
constexpr size_t WS_AU = WS_R5 + 49 * MiB + 512 * 1024;
constexpr size_t WS_S = WS_R5 + 70 * MiB;
constexpr size_t WS_YG = WS_S;
constexpr size_t WS_S5S = WS_R5 + 106 * MiB;
constexpr size_t WS_YCD = WS_S5S + 13 * MiB + 512 * 1024;
constexpr size_t WS_WGU = WS_R5;
constexpr size_t WS_WD = WS_PA + 36 * MiB;
constexpr size_t WS_END = WS_YCD + 27 * MiB;
static_assert(W_END <= WS_H, "small weights fit");
static_assert(WS_AU + (size_t)24 * 576 * 768 * 2 <= WS_S && WS_XBC + (size_t)MROWS * 768 * 2 <= WS_AU && WS_S + (size_t)8 * 18 * 16 * 4096 * 4 <= WS_S5S, "R5 map");
static_assert(WS_S5S + (size_t)24 * 576 * 256 * 4 <= WS_YCD && WS_YCD + (size_t)MROWS * 768 * 2 <= WS_END && WS_WD + (size_t)32 * MiB <= WS_Y && WS_MRGB + (size_t)MROWS * 1024 * 2 <= WS_WD && WS_WGU + (size_t)64 * MiB <= WS_S && WS_END <= (size_t)588 * MiB, "R5 map 2");
static_assert(WS_TOT + 16384 <= WS_X && WS_ROPE + 2048 * 64 * 4 <= WS_AFF, "misc map");

constexpr int CW_BAR = 4096;
constexpr int CW_S5CNT = 16384;

constexpr int NWAVES = 8;
constexpr int LDS_SCRATCH = 151552;
constexpr int LDSCTL_OFF = LDS_SCRATCH;
constexpr int LDS_BYTES = 155648;

#define LDS_WAIT() asm volatile("s_waitcnt lgkmcnt(0)" ::: "memory")
#define VM_WAIT() asm volatile("s_waitcnt vmcnt(0)" ::: "memory")
DI int fresh_tid() { int t = threadIdx.x; asm volatile("" : "+v"(t)); return t; }
DI unsigned f2bf(float f) { unsigned u = __builtin_bit_cast(unsigned, f); return (u + 0x7fffu + ((u >> 16) & 1u)) >> 16; }
DI unsigned pk2(float lo, float hi) { typedef __bf16 bf2_t __attribute__((ext_vector_type(2))); f32x2 v = {lo, hi}; bf2_t b = __builtin_convertvector(v, bf2_t); return __builtin_bit_cast(unsigned, b); }
DI float bflo(unsigned w) { return __builtin_bit_cast(float, w << 16); }
DI float bfhi(unsigned w) { return __builtin_bit_cast(float, w & 0xffff0000u); }
DI float bf2f(bf16_t h) { return __builtin_bit_cast(float, (unsigned)h << 16); }
DI float silu_f(float x) { return x * __builtin_amdgcn_rcpf(1.f + __expf(-x)); }
DI float sigmoid_f(float x) { return __builtin_amdgcn_rcpf(1.f + __expf(-x)); }
DI float softplus_f(float x) { const float e = __expf(-fabsf(x)); const float l = (e < 1e-3f) ? e * (1.f - 0.5f * e) : __logf(1.f + e); return fmaxf(x, 0.f) + l; }
DI float gelu_tanh_f(float x) { const float u = 0.7978845608028654f * (x + 0.044715f * x * x * x); const float t = 1.f - 2.f * __builtin_amdgcn_rcpf(__expf(2.f * u) + 1.f); return 0.5f * x * (1.f + t); }
DI int lane_op() { int l = (int)__builtin_amdgcn_mbcnt_hi(~0u, __builtin_amdgcn_mbcnt_lo(~0u, 0u)); asm volatile("" : "+v"(l)); return l; }
DI float shup(float v, int d, int l) { return __builtin_bit_cast(float, __builtin_amdgcn_ds_bpermute(((l >= d) ? l - d : l) << 2, __builtin_bit_cast(int, v))); }
DI int shup(int v, int d, int l) { return __builtin_amdgcn_ds_bpermute(((l >= d) ? l - d : l) << 2, v); }
DI float shidx(float v, int src) { return __builtin_bit_cast(float, __builtin_amdgcn_ds_bpermute(src << 2, __builtin_bit_cast(int, v))); }
DI float wave_sum(float v) {
#pragma unroll
    for (int o = 1; o < 64; o <<= 1) v += __shfl_xor(v, o);
    return v;
}
DI void unpack8(const u32x4 w, float (&f)[8]) {
    f[0] = bflo(w.x); f[1] = bfhi(w.x); f[2] = bflo(w.y); f[3] = bfhi(w.y); f[4] = bflo(w.z); f[5] = bfhi(w.z); f[6] = bflo(w.w); f[7] = bfhi(w.w);
}
DI u32x4 pack8(const float (&f)[8]) { u32x4 w; w.x = pk2(f[0], f[1]); w.y = pk2(f[2], f[3]); w.z = pk2(f[4], f[5]); w.w = pk2(f[6], f[7]); return w; }

#define XB_TMO      128
#define XB_XCNT(j)  (256  + 64 * (j))
#define XB_XSUB(j)  (1280 + 64 * (j))
#define XB_XGEN(j)  (2304 + 64 * (j))
#define XB_TOP      3328
#define XB_TOPGEN   3392
#define XCD_BAR_WORDS 3456
#define XB_SPIN_CAP (1u << 20)
DI unsigned xb_ld(unsigned* p)              { return __hip_atomic_load(p, __ATOMIC_RELAXED, __HIP_MEMORY_SCOPE_AGENT); }
DI unsigned xb_add(unsigned* p, unsigned v) { return __hip_atomic_fetch_add(p, v, __ATOMIC_RELAXED, __HIP_MEMORY_SCOPE_AGENT); }
DI unsigned xb_xcc_id() { return (unsigned)__builtin_amdgcn_s_getreg((3 << 11) | 20) & 0xFu; }
#define XB_SPIN(cond, bar) do { unsigned _sp = 0; while (cond) { __builtin_amdgcn_s_sleep(1); \
    if ((++_sp & 255u) == 0u) { if (xb_ld(&(bar)[XB_TMO])) break; if (_sp > XB_SPIN_CAP) { atomicAdd(&(bar)[XB_TMO], 1u); break; } } } } while (0)
struct XcdBarrier { unsigned* bar; unsigned x; volatile LAS unsigned* st; unsigned G; };
DI XcdBarrier xcd_barrier_post(unsigned* bar, volatile LAS unsigned* st, unsigned G) {
    XcdBarrier b; b.bar = bar; b.x = xb_xcc_id(); b.st = st; b.G = G;
    if (threadIdx.x == 0) (void)xb_add(&bar[XB_XCNT(b.x)], 1u);
    return b;
}
DI void xcd_barrier_complete(unsigned* bar, unsigned x, unsigned& nloc, unsigned& nx, unsigned G) {
    unsigned sum, cnt, mine, sp = 0u;
    for (;;) {
        sum = 0u; cnt = 0u; mine = 0u;
#pragma unroll
        for (unsigned j = 0; j < 16; ++j) { const unsigned c = xb_ld(&bar[XB_XCNT(j)]); sum += c; cnt += (c > 0u) ? 1u : 0u; mine = (j == x) ? c : mine; }
        if (sum == G) break;
        __builtin_amdgcn_s_sleep(1);
        if ((++sp & 255u) == 0u) { if (xb_ld(&bar[XB_TMO])) break; if (sp > XB_SPIN_CAP) { atomicAdd(&bar[XB_TMO], 1u); break; } }
    }
    nloc = mine > 0u ? mine : 1u; nx = cnt > 0u ? cnt : 1u;
}
DI void xcd_barrier(const XcdBarrier& b) {
    asm volatile("s_waitcnt vmcnt(0)" ::: "memory");
    __syncthreads();
    if (threadIdx.x == 0) {
        unsigned* bar = b.bar;
        asm volatile("" : "+s"(bar));
        __builtin_amdgcn_s_waitcnt(0);
        unsigned nloc = b.st[0], nx = b.st[1];
        if (nloc == 0u) { xcd_barrier_complete(bar, b.x, nloc, nx, b.G); b.st[0] = nloc; b.st[1] = nx; }
        const unsigned old = xb_add(&bar[XB_XSUB(b.x)], 1u);
        const unsigned gen = old / nloc;
        if (old + 1u == (gen + 1u) * nloc) {
#ifndef NO_RELEASE_PROBE
            __builtin_amdgcn_fence(__ATOMIC_RELEASE, "agent");
#endif
            asm volatile("s_waitcnt vmcnt(0)" ::: "memory");
            const unsigned og = xb_add(&bar[XB_TOP], 1u);
            const unsigned tg = og / nx;
            if (og + 1u == (tg + 1u) * nx) xb_add(&bar[XB_TOPGEN], 1u);
            else XB_SPIN(xb_ld(&bar[XB_TOPGEN]) == tg, bar);
            __builtin_amdgcn_fence(__ATOMIC_ACQUIRE, "agent");
            asm volatile("s_waitcnt vmcnt(0)" ::: "memory");
        } else {
            XB_SPIN(xb_ld(&bar[XB_TOPGEN]) == gen, bar);
            __builtin_amdgcn_fence(__ATOMIC_ACQUIRE, "agent");
            asm volatile("s_waitcnt vmcnt(0)" ::: "memory");
        }
    }
    __syncthreads();
}

namespace pg8 {
constexpr int BM = 256, BK = 64, HALF = 128, HTB = HALF * BK * 2, STAGE_BYTES = 8 * HTB, NXCD = 8, WGM = 8;
__host__ __device__ __forceinline__ int lds_byte(int r, int c) { const int st = (r >> 4) * 2 + (c >> 5), rr = r & 15, cc = c & 31, ob = rr * 64 + cc * 2; return st * 1024 + (ob ^ (((ob >> 9) & 1) << 5)); }
__host__ __device__ __forceinline__ void stage_rc(int b, int& R, int& C) { const int st = b / 1024, sb = b % 1024, swz = sb ^ (((sb >> 9) & 1) << 5); R = (st >> 1) * 16 + swz / 64; C = (st & 1) * 32 + (swz % 64) / 2; }
__host__ __device__ __forceinline__ int perm32(int rho) { const int n = rho >> 4, i = rho & 15; return 8 * (i >> 2) + 4 * n + (i & 3); }

struct Unit { int arow, brow, pm, pn; };
struct Gemm { const bf16_t* A; const bf16_t* Bt; int lda, ldb, K; };

template <class Epi, class Sched, bool ALIGN_EPI = true>
DI void gemm_phase(LAS unsigned char* lds, const Gemm g, const Sched& S, const Epi& E) {
    const int tid = fresh_tid(), wid = __builtin_amdgcn_readfirstlane(tid >> 6), lane = tid & 63, wr = wid >> 2, wc = wid & 3, fr = lane & 15, fq = lane >> 4;
    const int K = g.K, nt = K / BK;
    unsigned voffA[2], voffB[2];
#pragma unroll
    for (int i = 0; i < 2; ++i) { int R, C; stage_rc(tid * 16 + i * 8192, R, C); const int Rb = Epi::PERM ? ((R & ~31) + perm32(R & 31)) : R;
        voffA[i] = (unsigned)(R * g.lda + C) * 2u; voffB[i] = (unsigned)(Rb * g.ldb + C) * 2u; }
    const size_t kstep = (size_t)(BK * 2);
    const size_t hA = (size_t)HALF * g.lda * 2, hB = (size_t)HALF * g.ldb * 2;
    const unsigned ldsw = (unsigned)wid * 1024u;
    const int aoff = lds_byte(wr * 64 + fr, fq * 8), boff = lds_byte(wc * 32 + fr, fq * 8);
#define PG8_SA(b, h) (((b) * 2 + (h)) * HTB)
#define PG8_SB(b, h) ((4 + (b) * 2 + (h)) * HTB)
#define PG8_STAGE(bufoff, gbase, voff) do { _Pragma("unroll") for (int _i = 0; _i < 2; ++_i) \
        __builtin_amdgcn_global_load_lds((const unsigned*)((const char*)(gbase) + (voff)[_i]), (LAS unsigned*)(lds + (bufoff) + ldsw + _i * 8192), 16, 0, 0); } while (0)
#define PG8_LDA(dst, b, h) do { _Pragma("unroll") for (int m = 0; m < 4; ++m) _Pragma("unroll") for (int k = 0; k < 2; ++k) dst[m][k] = *(const LAS bf16x8*)(lds + PG8_SA(b, h) + aoff + m * 2048 + k * 1024); } while (0)
#define PG8_LDB(dst, b, h) do { _Pragma("unroll") for (int n = 0; n < 2; ++n) _Pragma("unroll") for (int k = 0; k < 2; ++k) dst[n][k] = *(const LAS bf16x8*)(lds + PG8_SB(b, h) + boff + n * 2048 + k * 1024); } while (0)
#define PG8_MMA(ai, bj, At, Bt) do { __builtin_amdgcn_s_setprio(1); _Pragma("unroll") for (int m = 0; m < 4; ++m) _Pragma("unroll") for (int n = 0; n < 2; ++n) _Pragma("unroll") for (int k = 0; k < 2; ++k) \
        acc[ai][bj][m][n] = __builtin_amdgcn_mfma_f32_16x16x32_bf16(Bt[n][k], At[m][k], acc[ai][bj][m][n], 0, 0, 0); __builtin_amdgcn_s_setprio(0); } while (0)
#define PG8_WAIT_V(n) asm volatile("s_waitcnt vmcnt(" #n ")" ::: "memory")
#define PG8_WAIT_L(n) asm volatile("s_waitcnt lgkmcnt(" #n ")" ::: "memory")
#define PG8_BAR __builtin_amdgcn_s_barrier()
#define PG8_SCHED __builtin_amdgcn_sched_barrier(0)
    int ui = 0;
    Unit cur = S.next(0);
    if (cur.arow < 0) return;
    f32x4 acc[2][2][4][2];
#pragma unroll
    for (int a = 0; a < 2; ++a)
#pragma unroll
        for (int b = 0; b < 2; ++b)
#pragma unroll
            for (int m = 0; m < 4; ++m)
#pragma unroll
                for (int n = 0; n < 2; ++n) acc[a][b][m][n] = (f32x4){0.f, 0.f, 0.f, 0.f};
    bf16x8 At[4][2], B0[2][2], B1[2][2];
    const char* cA = (const char*)g.A + (size_t)cur.arow * g.lda * 2; const char* cB = (const char*)g.Bt + (size_t)cur.brow * g.ldb * 2;
    PG8_STAGE(PG8_SB(0, 0), cB, voffB); PG8_STAGE(PG8_SB(0, 1), cB + hB, voffB); PG8_STAGE(PG8_SA(0, 0), cA, voffA); PG8_STAGE(PG8_SA(0, 1), cA + hA, voffA);
    if (wr == 1) PG8_BAR;
    PG8_WAIT_V(2); PG8_BAR;
    PG8_STAGE(PG8_SB(1, 0), cB + kstep, voffB); PG8_STAGE(PG8_SA(1, 0), cA + kstep, voffA); PG8_STAGE(PG8_SB(1, 1), cB + hB + kstep, voffB);
    PG8_WAIT_V(6); PG8_BAR;
    for (;;) {
        const Unit nxt = S.next(ui + 1);
        const bool has_next = nxt.arow >= 0;
        const char* nA = has_next ? (const char*)g.A + (size_t)nxt.arow * g.lda * 2 : cA; const char* nB = has_next ? (const char*)g.Bt + (size_t)nxt.brow * g.ldb * 2 : cB;
#pragma unroll 1
        for (int t = 0; t < nt; t += 2) {
            const bool last = (t == nt - 2);
            const char* a1 = cA + (size_t)(t + 1) * kstep;
            const char* a2 = last ? nA : cA + (size_t)(t + 2) * kstep; const char* b2 = last ? nB : cB + (size_t)(t + 2) * kstep;
            const char* a3 = a2 + kstep; const char* b3 = b2 + kstep;
            PG8_LDB(B0, 0, 0); PG8_LDB(B1, 0, 1); PG8_SCHED; PG8_LDA(At, 0, 0); PG8_STAGE(PG8_SA(1, 1), a1 + hA, voffA);
            PG8_WAIT_V(8); PG8_WAIT_L(0); PG8_BAR; PG8_MMA(0, 0, At, B0); PG8_MMA(0, 1, At, B1); PG8_BAR; PG8_SCHED;
            PG8_LDA(At, 0, 1); PG8_STAGE(PG8_SB(0, 0), b2, voffB); PG8_STAGE(PG8_SB(0, 1), b2 + hB, voffB); PG8_STAGE(PG8_SA(0, 0), a2, voffA);
            PG8_WAIT_V(8); PG8_WAIT_L(0); PG8_BAR; PG8_MMA(1, 0, At, B0); PG8_MMA(1, 1, At, B1); PG8_BAR; PG8_SCHED;
            PG8_LDB(B0, 1, 0); PG8_LDB(B1, 1, 1); PG8_SCHED; PG8_LDA(At, 1, 0); PG8_STAGE(PG8_SA(0, 1), a2 + hA, voffA);
            PG8_WAIT_V(8); PG8_WAIT_L(0); PG8_BAR; PG8_MMA(0, 0, At, B0); PG8_MMA(0, 1, At, B1); PG8_BAR; PG8_SCHED;
            PG8_LDA(At, 1, 1); PG8_STAGE(PG8_SB(1, 0), b3, voffB); PG8_STAGE(PG8_SB(1, 1), b3 + hB, voffB); PG8_STAGE(PG8_SA(1, 0), a3, voffA);
            PG8_WAIT_V(8); PG8_WAIT_L(0); PG8_BAR; PG8_MMA(1, 0, At, B0); PG8_MMA(1, 1, At, B1); PG8_BAR; PG8_SCHED;
        }
        if constexpr (ALIGN_EPI) { if (wr == 0) PG8_BAR; }
        E(acc, cur, wr, wc, fr, fq);
        if (!has_next) break;
#pragma unroll
        for (int a = 0; a < 2; ++a)
#pragma unroll
            for (int b = 0; b < 2; ++b)
#pragma unroll
                for (int m = 0; m < 4; ++m)
#pragma unroll
                    for (int n = 0; n < 2; ++n) acc[a][b][m][n] = (f32x4){0.f, 0.f, 0.f, 0.f};
        cur = nxt; cA = nA; cB = nB; ++ui;
        if constexpr (ALIGN_EPI) { if (wr == 1) PG8_BAR; }
    }
    PG8_WAIT_V(0);
    if constexpr (!ALIGN_EPI) { if (wr == 0) PG8_BAR; }
    PG8_BAR;
#undef PG8_SA
#undef PG8_SB
#undef PG8_STAGE
#undef PG8_LDA
#undef PG8_LDB
#undef PG8_MMA
#undef PG8_WAIT_V
#undef PG8_WAIT_L
#undef PG8_BAR
#undef PG8_SCHED
}

template <class Epi, class Sched, bool ALIGN_EPI = true>
DI void gemm_phase_gather(LAS unsigned char* lds, const Gemm g, const int* __restrict__ grow, const Sched& S, const Epi& E) {
    const int tid = fresh_tid(), wid = __builtin_amdgcn_readfirstlane(tid >> 6), lane = tid & 63, wr = wid >> 2, wc = wid & 3, fr = lane & 15, fq = lane >> 4;
    const int K = g.K, nt = K / BK;
    unsigned voffB[2];
#pragma unroll
    for (int i = 0; i < 2; ++i) { int R, C; stage_rc(tid * 16 + i * 8192, R, C); const int Rb = Epi::PERM ? ((R & ~31) + perm32(R & 31)) : R;
        voffB[i] = (unsigned)(Rb * g.ldb + C) * 2u; }
#define PG8_RA(i_) ([&]{ int R_, C_; stage_rc(tid * 16 + (i_) * 8192, R_, C_); return R_; }())
#define PG8_CA2(i_) ([&]{ int R_, C_; stage_rc(tid * 16 + (i_) * 8192, R_, C_); return (unsigned)C_ * 2u; }())
    unsigned vAc[2][2];
#define PG8_GOFF(dst, arow_) do { _Pragma("unroll") for (int h_ = 0; h_ < 2; ++h_) _Pragma("unroll") for (int i_ = 0; i_ < 2; ++i_) \
        dst[h_][i_] = (unsigned)grow[(arow_) + h_ * HALF + PG8_RA(i_)] * (unsigned)(g.lda * 2) + PG8_CA2(i_); } while (0)
    const size_t kstep = (size_t)(BK * 2);
    const size_t hB = (size_t)HALF * g.ldb * 2;
    const unsigned ldsw = (unsigned)wid * 1024u;
    const int aoff = lds_byte(wr * 64 + fr, fq * 8), boff = lds_byte(wc * 32 + fr, fq * 8);
#define PG8_SA(b, h) (((b) * 2 + (h)) * HTB)
#define PG8_SB(b, h) ((4 + (b) * 2 + (h)) * HTB)
#define PG8_STAGE(bufoff, gbase, voff) do { _Pragma("unroll") for (int _i = 0; _i < 2; ++_i) \
        __builtin_amdgcn_global_load_lds((const unsigned*)((const char*)(gbase) + (voff)[_i]), (LAS unsigned*)(lds + (bufoff) + ldsw + _i * 8192), 16, 0, 0); } while (0)
#define PG8_STAGEA(bufoff, kbyte, vv, hf) do { _Pragma("unroll") for (int _i = 0; _i < 2; ++_i) \
        __builtin_amdgcn_global_load_lds((const unsigned*)((const char*)g.A + (kbyte) + vv[hf][_i]), (LAS unsigned*)(lds + (bufoff) + ldsw + _i * 8192), 16, 0, 0); } while (0)
#define PG8_LDA(dst, b, h) do { _Pragma("unroll") for (int m = 0; m < 4; ++m) _Pragma("unroll") for (int k = 0; k < 2; ++k) dst[m][k] = *(const LAS bf16x8*)(lds + PG8_SA(b, h) + aoff + m * 2048 + k * 1024); } while (0)
#define PG8_LDB(dst, b, h) do { _Pragma("unroll") for (int n = 0; n < 2; ++n) _Pragma("unroll") for (int k = 0; k < 2; ++k) dst[n][k] = *(const LAS bf16x8*)(lds + PG8_SB(b, h) + boff + n * 2048 + k * 1024); } while (0)
#define PG8_MMA(ai, bj, At, Bt) do { __builtin_amdgcn_s_setprio(1); _Pragma("unroll") for (int m = 0; m < 4; ++m) _Pragma("unroll") for (int n = 0; n < 2; ++n) _Pragma("unroll") for (int k = 0; k < 2; ++k) \
        acc[ai][bj][m][n] = __builtin_amdgcn_mfma_f32_16x16x32_bf16(Bt[n][k], At[m][k], acc[ai][bj][m][n], 0, 0, 0); __builtin_amdgcn_s_setprio(0); } while (0)
#define PG8_WAIT_V(n) asm volatile("s_waitcnt vmcnt(" #n ")" ::: "memory")
#define PG8_WAIT_L(n) asm volatile("s_waitcnt lgkmcnt(" #n ")" ::: "memory")
#define PG8_BAR __builtin_amdgcn_s_barrier()
#define PG8_SCHED __builtin_amdgcn_sched_barrier(0)
    int ui = 0;
    Unit cur = S.next(0);
    if (cur.arow < 0) return;
    f32x4 acc[2][2][4][2];
#pragma unroll
    for (int a = 0; a < 2; ++a)
#pragma unroll
        for (int b = 0; b < 2; ++b)
#pragma unroll
            for (int m = 0; m < 4; ++m)
#pragma unroll
                for (int n = 0; n < 2; ++n) acc[a][b][m][n] = (f32x4){0.f, 0.f, 0.f, 0.f};
    bf16x8 At[4][2], B0[2][2], B1[2][2];
    const char* cB = (const char*)g.Bt + (size_t)cur.brow * g.ldb * 2;
    PG8_GOFF(vAc, cur.arow);
    PG8_STAGE(PG8_SB(0, 0), cB, voffB); PG8_STAGE(PG8_SB(0, 1), cB + hB, voffB); PG8_STAGEA(PG8_SA(0, 0), 0, vAc, 0); PG8_STAGEA(PG8_SA(0, 1), 0, vAc, 1);
    if (wr == 1) PG8_BAR;
    PG8_WAIT_V(2); PG8_BAR;
    PG8_STAGE(PG8_SB(1, 0), cB + kstep, voffB); PG8_STAGEA(PG8_SA(1, 0), kstep, vAc, 0); PG8_STAGE(PG8_SB(1, 1), cB + hB + kstep, voffB);
    PG8_WAIT_V(6); PG8_BAR;
    for (;;) {
        const Unit nxt = S.next(ui + 1);
        const bool has_next = nxt.arow >= 0;
        const char* nB = has_next ? (const char*)g.Bt + (size_t)nxt.brow * g.ldb * 2 : cB;
        int rawn[2][2];
#pragma unroll
        for (int h_ = 0; h_ < 2; ++h_)
#pragma unroll
            for (int i_ = 0; i_ < 2; ++i_) rawn[h_][i_] = has_next ? grow[nxt.arow + h_ * HALF + PG8_RA(i_)] : 0;
#pragma unroll 1
        for (int t = 0; t < nt; t += 2) {
            const bool last = (t == nt - 2);
            const size_t k1 = (size_t)(t + 1) * kstep, k2 = last ? 0 : (size_t)(t + 2) * kstep, k3 = k2 + kstep;
            const char* b2 = last ? nB : cB + (size_t)(t + 2) * kstep; const char* b3 = b2 + kstep;
            PG8_LDB(B0, 0, 0); PG8_LDB(B1, 0, 1); PG8_SCHED; PG8_LDA(At, 0, 0); PG8_STAGEA(PG8_SA(1, 1), k1, vAc, 1);
            if (last && has_next) {
#pragma unroll
                for (int h_ = 0; h_ < 2; ++h_)
#pragma unroll
                    for (int i_ = 0; i_ < 2; ++i_) vAc[h_][i_] = (unsigned)rawn[h_][i_] * (unsigned)(g.lda * 2) + PG8_CA2(i_); }
            PG8_WAIT_V(8); PG8_WAIT_L(0); PG8_BAR; PG8_MMA(0, 0, At, B0); PG8_MMA(0, 1, At, B1); PG8_BAR; PG8_SCHED;
            PG8_LDA(At, 0, 1); PG8_STAGE(PG8_SB(0, 0), b2, voffB); PG8_STAGE(PG8_SB(0, 1), b2 + hB, voffB); PG8_STAGEA(PG8_SA(0, 0), k2, vAc, 0);
            PG8_WAIT_V(8); PG8_WAIT_L(0); PG8_BAR; PG8_MMA(1, 0, At, B0); PG8_MMA(1, 1, At, B1); PG8_BAR; PG8_SCHED;
            PG8_LDB(B0, 1, 0); PG8_LDB(B1, 1, 1); PG8_SCHED; PG8_LDA(At, 1, 0); PG8_STAGEA(PG8_SA(0, 1), k2, vAc, 1);
            PG8_WAIT_V(8); PG8_WAIT_L(0); PG8_BAR; PG8_MMA(0, 0, At, B0); PG8_MMA(0, 1, At, B1); PG8_BAR; PG8_SCHED;
            PG8_LDA(At, 1, 1); PG8_STAGE(PG8_SB(1, 0), b3, voffB); PG8_STAGE(PG8_SB(1, 1), b3 + hB, voffB); PG8_STAGEA(PG8_SA(1, 0), k3, vAc, 0);
            PG8_WAIT_V(8); PG8_WAIT_L(0); PG8_BAR; PG8_MMA(1, 0, At, B0); PG8_MMA(1, 1, At, B1); PG8_BAR; PG8_SCHED;
        }
        if constexpr (ALIGN_EPI) { if (wr == 0) PG8_BAR; }
        E(acc, cur, wr, wc, fr, fq);
        if (!has_next) break;
#pragma unroll
        for (int a = 0; a < 2; ++a)
#pragma unroll
            for (int b = 0; b < 2; ++b)
#pragma unroll
                for (int m = 0; m < 4; ++m)
#pragma unroll
                    for (int n = 0; n < 2; ++n) acc[a][b][m][n] = (f32x4){0.f, 0.f, 0.f, 0.f};
        cur = nxt; cB = nB; ++ui;
        if constexpr (ALIGN_EPI) { if (wr == 1) PG8_BAR; }
    }
    PG8_WAIT_V(0);
    if constexpr (!ALIGN_EPI) { if (wr == 0) PG8_BAR; }
    PG8_BAR;
#undef PG8_SA
#undef PG8_SB
#undef PG8_STAGE
#undef PG8_STAGEA
#undef PG8_GOFF
#undef PG8_RA
#undef PG8_CA2
#undef PG8_LDA
#undef PG8_LDB
#undef PG8_MMA
#undef PG8_WAIT_V
#undef PG8_WAIT_L
#undef PG8_BAR
#undef PG8_SCHED
}

struct MergeArgs { const bf16_t* YAB; const bf16_t* YCD; const bf16_t* W4T; const unsigned char* G; const float* ssq; bf16_t* MRGB; };
template <class Sched>
DI void gemm_merge_phase(LAS unsigned char* lds, const MergeArgs M, const Sched& S) {
    const int tid = fresh_tid(), wid = __builtin_amdgcn_readfirstlane(tid >> 6), lane = tid & 63, wr = wid >> 2, wc = wid & 3, fr = lane & 15, fq = lane >> 4;
    constexpr int NT = 28, LDB = 1792;
    unsigned vA0[2], vA1[2], voffB[2];
#pragma unroll
    for (int i = 0; i < 2; ++i) { int R, C; stage_rc(tid * 16 + i * 8192, R, C); const int Rb = (R & ~31) + perm32(R & 31);
        vA0[i] = (unsigned)(R * 1024 + C) * 2u; vA1[i] = (unsigned)(R * 768 + C) * 2u; voffB[i] = (unsigned)(Rb * LDB + C) * 2u; }
    const size_t kstep = (size_t)(BK * 2);
    const unsigned ldsw = (unsigned)wid * 1024u;
    const int aoff = lds_byte(wr * 64 + fr, fq * 8), boff = lds_byte(wc * 32 + fr, fq * 8);
#define PG8_SA(b, h) (((b) * 2 + (h)) * HTB)
#define PG8_SB(b, h) ((4 + (b) * 2 + (h)) * HTB)
#define PG8_STAGEB(bufoff, gbase) do { _Pragma("unroll") for (int _i = 0; _i < 2; ++_i) \
        __builtin_amdgcn_global_load_lds((const unsigned*)((const char*)(gbase) + voffB[_i]), (LAS unsigned*)(lds + (bufoff) + ldsw + _i * 8192), 16, 0, 0); } while (0)
#define PG8_STAGEA(bufoff, arow_, tt, hf) do { const bool ab_ = (tt) < 16; \
        const char* gp_ = ab_ ? (const char*)M.YAB + ((size_t)(arow_) + (hf) * HALF) * 2048 + (size_t)(tt) * 128 : (const char*)M.YCD + ((size_t)(arow_) + (hf) * HALF) * 1536 + (size_t)((tt) - 16) * 128; \
        const unsigned o0_ = ab_ ? vA0[0] : vA1[0], o1_ = ab_ ? vA0[1] : vA1[1]; \
        __builtin_amdgcn_global_load_lds((const unsigned*)(gp_ + o0_), (LAS unsigned*)(lds + (bufoff) + ldsw), 16, 0, 0); \
        __builtin_amdgcn_global_load_lds((const unsigned*)(gp_ + o1_), (LAS unsigned*)(lds + (bufoff) + ldsw + 8192), 16, 0, 0); } while (0)
#define PG8_LDA(dst, b, h) do { _Pragma("unroll") for (int m = 0; m < 4; ++m) _Pragma("unroll") for (int k = 0; k < 2; ++k) dst[m][k] = *(const LAS bf16x8*)(lds + PG8_SA(b, h) + aoff + m * 2048 + k * 1024); } while (0)
#define PG8_LDB(dst, b, h) do { _Pragma("unroll") for (int n = 0; n < 2; ++n) _Pragma("unroll") for (int k = 0; k < 2; ++k) dst[n][k] = *(const LAS bf16x8*)(lds + PG8_SB(b, h) + boff + n * 2048 + k * 1024); } while (0)
#define PG8_MMA(ai, At, Bt) do { __builtin_amdgcn_s_setprio(1); _Pragma("unroll") for (int m = 0; m < 4; ++m) _Pragma("unroll") for (int n = 0; n < 2; ++n) _Pragma("unroll") for (int k = 0; k < 2; ++k) \
        acc[ai][0][m][n] = __builtin_amdgcn_mfma_f32_16x16x32_bf16(Bt[n][k], At[m][k], acc[ai][0][m][n], 0, 0, 0); __builtin_amdgcn_s_setprio(0); } while (0)
#define PG8_WAIT_V(n) asm volatile("s_waitcnt vmcnt(" #n ")" ::: "memory")
#define PG8_WAIT_L(n) asm volatile("s_waitcnt lgkmcnt(" #n ")" ::: "memory")
#define PG8_BAR __builtin_amdgcn_s_barrier()
#define PG8_SCHED __builtin_amdgcn_sched_barrier(0)
    int ui = 0;
    Unit cur = S.next(0);
    if (cur.arow < 0) return;
    f32x4 acc[2][2][4][2];
#pragma unroll
    for (int a = 0; a < 2; ++a)
#pragma unroll
        for (int b = 0; b < 2; ++b)
#pragma unroll
            for (int m = 0; m < 4; ++m)
#pragma unroll
                for (int n = 0; n < 2; ++n) acc[a][b][m][n] = (f32x4){0.f, 0.f, 0.f, 0.f};
    bf16x8 At[4][2], B0[2][2];
    const char* cB = (const char*)M.W4T + (size_t)cur.brow * LDB * 2;
    int carow = cur.arow;
    PG8_STAGEB(PG8_SB(0, 0), cB); PG8_STAGEA(PG8_SA(0, 0), carow, 0, 0); PG8_STAGEA(PG8_SA(0, 1), carow, 0, 1);
    if (wr == 1) PG8_BAR;
    PG8_WAIT_V(2); PG8_BAR;
    PG8_STAGEB(PG8_SB(1, 0), cB + kstep); PG8_STAGEA(PG8_SA(1, 0), carow, 1, 0);
    PG8_WAIT_V(4); PG8_BAR;
    for (;;) {
        const Unit nxt = S.next(ui + 1);
        const bool has_next = nxt.arow >= 0;
        const int narow = has_next ? nxt.arow : carow; const char* nB = has_next ? (const char*)M.W4T + (size_t)nxt.brow * LDB * 2 : cB;
#pragma unroll 1
        for (int t = 0; t < NT; t += 2) {
            const bool last = (t == NT - 2);
            const bool fold_it = (t == 6 || t == 14 || t == 20 || t == 26);
            u32x2 gq[2][4];
            if (fold_it) {
                const int seg = (t == 6) ? 0 : (t == 14) ? 1 : (t == 20) ? 2 : 3;
                int row0 = cur.arow + wr * 64 + fr, col = cur.pn * 128 + wc * 32 + 8 * fq;
                asm volatile("" : "+v"(row0), "+v"(col));
#pragma unroll
                for (int ai = 0; ai < 2; ++ai)
#pragma unroll
                    for (int m = 0; m < 4; ++m) gq[ai][m] = *(const u32x2*)(M.G + (size_t)(row0 + ai * 128 + m * 16) * PG_W + seg * 1024 + col);
            }
            const int t2 = last ? 0 : t + 2, t3 = t2 + 1; const int arow2 = last ? narow : carow;
            const char* b2 = last ? nB : cB + (size_t)(t + 2) * kstep; const char* b3 = b2 + kstep;
            PG8_LDB(B0, 0, 0); PG8_SCHED; PG8_LDA(At, 0, 0); PG8_STAGEA(PG8_SA(1, 1), carow, t + 1, 1);
            PG8_WAIT_V(6); PG8_WAIT_L(0); PG8_BAR; PG8_MMA(0, At, B0); PG8_BAR; PG8_SCHED;
            PG8_LDA(At, 0, 1); PG8_STAGEB(PG8_SB(0, 0), b2); PG8_STAGEA(PG8_SA(0, 0), arow2, t2, 0);
            PG8_WAIT_V(6); PG8_WAIT_L(0); PG8_BAR; PG8_MMA(1, At, B0); PG8_BAR; PG8_SCHED;
            PG8_LDB(B0, 1, 0); PG8_SCHED; PG8_LDA(At, 1, 0); PG8_STAGEA(PG8_SA(0, 1), arow2, t2, 1);
            PG8_WAIT_V(6); PG8_WAIT_L(0); PG8_BAR; PG8_MMA(0, At, B0); PG8_BAR; PG8_SCHED;
            PG8_LDA(At, 1, 1); PG8_STAGEB(PG8_SB(1, 0), b3); PG8_STAGEA(PG8_SA(1, 0), arow2, t3, 0);
            PG8_WAIT_V(6); PG8_WAIT_L(0); PG8_BAR; PG8_MMA(1, At, B0); PG8_BAR; PG8_SCHED;
            if (fold_it) {
                float rs[2][4];
#pragma unroll
                for (int ai = 0; ai < 2; ++ai)
#pragma unroll
                    for (int m = 0; m < 4; ++m) rs[ai][m] = 1.f / 255.f;
                if (t == 14) {
                    int rowq = cur.arow + wr * 64 + fr; asm volatile("" : "+v"(rowq));
                    f32x2 q2[2][4];
#pragma unroll
                    for (int ai = 0; ai < 2; ++ai)
#pragma unroll
                        for (int m = 0; m < 4; ++m) q2[ai][m] = *(const f32x2*)(M.ssq + 2 * (size_t)(rowq + ai * 128 + m * 16));
#pragma unroll
                    for (int ai = 0; ai < 2; ++ai)
#pragma unroll
                        for (int m = 0; m < 4; ++m) rs[ai][m] = __builtin_amdgcn_rsqf((q2[ai][m][0] + q2[ai][m][1]) * (1.f / 512.f) + RMS_EPS) * (1.f / 255.f); }
#pragma unroll
                for (int ai = 0; ai < 2; ++ai)
#pragma unroll
                    for (int m = 0; m < 4; ++m) { const u32x2 q = gq[ai][m]; const float sc = rs[ai][m];
#pragma unroll
                        for (int k = 0; k < 4; ++k) { const float g0 = (float)((q.x >> (8 * k)) & 255u) * sc, g1 = (float)((q.y >> (8 * k)) & 255u) * sc;
                            acc[ai][1][m][0][k] += acc[ai][0][m][0][k] * g0; acc[ai][1][m][1][k] += acc[ai][0][m][1][k] * g1; }
                        acc[ai][0][m][0] = (f32x4){0.f, 0.f, 0.f, 0.f}; acc[ai][0][m][1] = (f32x4){0.f, 0.f, 0.f, 0.f}; }
                if (t == NT - 2) {
                    int row0 = cur.arow + wr * 64 + fr, col = cur.pn * 128 + wc * 32 + 8 * fq;
                    asm volatile("" : "+v"(row0), "+v"(col));
#pragma unroll
                    for (int ai = 0; ai < 2; ++ai)
#pragma unroll
                        for (int m = 0; m < 4; ++m) { const f32x4 v0 = acc[ai][1][m][0], v1 = acc[ai][1][m][1];
                            u32x4 w; w.x = pk2(v0[0], v0[1]); w.y = pk2(v0[2], v0[3]); w.z = pk2(v1[0], v1[1]); w.w = pk2(v1[2], v1[3]);
                            *(u32x4*)(M.MRGB + (size_t)(row0 + ai * 128 + m * 16) * 1024 + col) = w;
                            acc[ai][1][m][0] = (f32x4){0.f, 0.f, 0.f, 0.f}; acc[ai][1][m][1] = (f32x4){0.f, 0.f, 0.f, 0.f}; } }
            }
        }
        if (!has_next) break;
        cur = nxt; carow = narow; cB = nB; ++ui;
    }
    PG8_WAIT_V(0);
    if (wr == 0) PG8_BAR;
    PG8_BAR;
#undef PG8_SA
#undef PG8_SB
#undef PG8_STAGEA
#undef PG8_STAGEB
#undef PG8_LDA
#undef PG8_LDB
#undef PG8_MMA
#undef PG8_WAIT_V
#undef PG8_WAIT_L
#undef PG8_BAR
#undef PG8_SCHED
}
}

using pg8::Unit;

struct EpiProj {
    static constexpr bool PERM = true;
    bf16_t* O0; int ld0; int split_pn; unsigned char* G8; bf16_t* AU;
    DI void operator()(const f32x4 (&acc)[2][2][4][2], const Unit& u, int wr, int wc, int fr, int fq) const {
        const int row0 = u.arow + wr * 64 + fr;
        if (u.pn == 8 || u.pn == 9) {
            const int col0 = u.pn * 256 + wc * 32 + 8 * fq;
#pragma unroll
            for (int ai = 0; ai < 2; ++ai)
#pragma unroll
                for (int m = 0; m < 4; ++m) { const int R = row0 + ai * 128 + m * 16; bf16_t* rowp = O0 + (size_t)R * ld0 + col0;
#pragma unroll
                    for (int bj = 0; bj < 2; ++bj) { const f32x4 v0 = acc[ai][bj][m][0], v1 = acc[ai][bj][m][1];
                        u32x4 w; w.x = pk2(v0[0], v0[1]); w.y = pk2(v0[2], v0[3]); w.z = pk2(v1[0], v1[1]); w.w = pk2(v1[2], v1[3]);
                        const int c8 = col0 + bj * 128, ch = c8 - C_U;
                        if (c8 >= C_U && c8 < C_SB) *(u32x4*)(AU + ((size_t)(ch >> 4) * 576 + (R >> 5)) * 768 + (R & 31) * 16 + (ch & 15)) = w;
                        else *(u32x4*)(rowp + bj * 128) = w; } }
        } else if (u.pn < split_pn) {
            const int col0 = u.pn * 256 + wc * 32 + 8 * fq;
#pragma unroll
            for (int ai = 0; ai < 2; ++ai)
#pragma unroll
                for (int m = 0; m < 4; ++m) { bf16_t* rowp = O0 + (size_t)(row0 + ai * 128 + m * 16) * ld0 + col0;
#pragma unroll
                    for (int bj = 0; bj < 2; ++bj) { const f32x4 v0 = acc[ai][bj][m][0], v1 = acc[ai][bj][m][1];
                        u32x4 w; w.x = pk2(v0[0], v0[1]); w.y = pk2(v0[2], v0[3]); w.z = pk2(v1[0], v1[1]); w.w = pk2(v1[2], v1[3]);
                        *(u32x4*)(rowp + bj * 128) = w; } }
        } else {
            const int col0 = (u.pn - split_pn) * 256 + wc * 32 + 8 * fq;
#pragma unroll
            for (int ai = 0; ai < 2; ++ai)
#pragma unroll
                for (int m = 0; m < 4; ++m) { unsigned char* rowp = G8 + (size_t)(row0 + ai * 128 + m * 16) * PG_W + col0;
#pragma unroll
                    for (int bj = 0; bj < 2; ++bj) { const f32x4 v0 = acc[ai][bj][m][0], v1 = acc[ai][bj][m][1]; unsigned q[8];
#pragma unroll
                        for (int k = 0; k < 4; ++k) { q[k] = (unsigned)(sigmoid_f(v0[k]) * 255.f + 0.5f); q[4 + k] = (unsigned)(sigmoid_f(v1[k]) * 255.f + 0.5f); }
                        u32x2 w; w.x = q[0] | (q[1] << 8) | (q[2] << 16) | (q[3] << 24); w.y = q[4] | (q[5] << 8) | (q[6] << 16) | (q[7] << 24);
                        *(u32x2*)(rowp + bj * 128) = w; } }
        }
    }
};

struct EpiWout {
    static constexpr bool PERM = true;
    bf16_t* Y;
    DI void operator()(const f32x4 (&acc)[2][2][4][2], const Unit& u, int wr, int wc, int fr, int fq) const {
        const int row0 = u.arow + wr * 64 + fr, col0 = u.pn * 256 + wc * 32 + 8 * fq;
#pragma unroll
        for (int ai = 0; ai < 2; ++ai)
#pragma unroll
            for (int m = 0; m < 4; ++m) { bf16_t* rowp = Y + (size_t)(row0 + ai * 128 + m * 16) * 1024 + col0;
#pragma unroll
                for (int bj = 0; bj < 2; ++bj) { const f32x4 v0 = acc[ai][bj][m][0], v1 = acc[ai][bj][m][1];
                    u32x4 w; w.x = pk2(v0[0], v0[1]); w.y = pk2(v0[2], v0[3]); w.z = pk2(v1[0], v1[1]); w.w = pk2(v1[2], v1[3]);
                    *(u32x4*)(rowp + bj * 128) = w; } }
    }
};

struct EpiGlu {
    static constexpr bool PERM = true;
    const bf16_t* YG; bf16_t* YC; const float* bglu;
    DI void operator()(const f32x4 (&acc)[2][2][4][2], const Unit& u, int wr, int wc, int fr, int fq) const {
        const int row0 = u.arow + wr * 64 + fr, col0 = u.pn * 256 + wc * 32 + 8 * fq;
#pragma unroll
        for (int bj = 0; bj < 2; ++bj) { const int col = col0 + bj * 128; if (u.pn == 1 && bj == 1) continue;
            const f32x4 b0 = *(const f32x4*)(bglu + col), b1 = *(const f32x4*)(bglu + col + 4);
#pragma unroll
            for (int ai = 0; ai < 2; ++ai) { u32x4 yw[4];
#pragma unroll
                for (int m = 0; m < 4; ++m) yw[m] = *(const u32x4*)(YG + (size_t)(row0 + ai * 128 + m * 16) * 384 + col);
#pragma unroll
                for (int m = 0; m < 4; ++m) { float y[8]; unpack8(yw[m], y);
                    const f32x4 a0 = acc[ai][bj][m][0] + b0, a1 = acc[ai][bj][m][1] + b1;
                    float o[8];
#pragma unroll
                    for (int k = 0; k < 4; ++k) { o[k] = y[k] * sigmoid_f(a0[k]); o[4 + k] = y[4 + k] * sigmoid_f(a1[k]); }
                    *(u32x4*)(YC + (size_t)(row0 + ai * 128 + m * 16) * 768 + col) = pack8(o); }
                __builtin_amdgcn_sched_barrier(0); } }
    }
};

struct EpiS5S {
    static constexpr bool PERM = true;
    float* S;
    DI void operator()(const f32x4 (&acc)[2][2][4][2], const Unit& u, int wr, int wc, int fr, int fq) const {
        const int m0 = u.pn * 256 + wr * 64 + fr, col0 = wc * 32 + 8 * fq;
#pragma unroll
        for (int ai = 0; ai < 2; ++ai)
#pragma unroll
            for (int m = 0; m < 4; ++m) { const int mm = m0 + ai * 128 + m * 16; if (u.pn == 2 && (ai == 1 || wr == 1)) continue;
                float* p = S + ((size_t)u.pm * 576 + mm) * 256 + col0;
#pragma unroll
                for (int bj = 0; bj < 2; ++bj) { *(f32x4*)(p + bj * 128) = acc[ai][bj][m][0]; *(f32x4*)(p + bj * 128 + 4) = acc[ai][bj][m][1]; } }
    }
};

struct EpiS5Y {
    static constexpr bool PERM = true;
    const bf16_t* AU; bf16_t* YG; const float* dsk;
    DI void operator()(const f32x4 (&acc)[2][2][4][2], const Unit& u, int wr, int wc, int fr, int fq) const {
        const int g = u.pm / 3, j = u.pm % 3;
        const int m0 = j * 256 + wr * 64 + fr, n0 = u.pn * 256 + wc * 32 + 8 * fq;
#pragma unroll
        for (int bj = 0; bj < 2; ++bj) { const int n = n0 + bj * 128, i = n >> 4, a0 = n & 15;
            const f32x4 d0 = *(const f32x4*)(dsk + g * 16 + a0), d1 = *(const f32x4*)(dsk + g * 16 + a0 + 4);
#pragma unroll
            for (int ai = 0; ai < 2; ++ai) { if (j == 2 && (ai == 1 || wr == 1)) continue;
                u32x4 uw[4];
#pragma unroll
                for (int m = 0; m < 4; ++m) uw[m] = *(const u32x4*)(AU + ((size_t)g * 576 + m0 + ai * 128 + m * 16) * 768 + n);
#pragma unroll
                for (int m = 0; m < 4; ++m) { const int mm = m0 + ai * 128 + m * 16; float uu[8]; unpack8(uw[m], uu);
                    const f32x4 v0 = acc[ai][bj][m][0], v1 = acc[ai][bj][m][1];
                    float o[8];
#pragma unroll
                    for (int k = 0; k < 4; ++k) { o[k] = gelu_tanh_f(v0[k] + d0[k] * uu[k]); o[4 + k] = gelu_tanh_f(v1[k] + d1[k] * uu[4 + k]); }
                    *(u32x4*)(YG + (size_t)(mm * 32 + i) * 384 + g * 16 + a0) = pack8(o); }
                __builtin_amdgcn_sched_barrier(0); } }
    }
};

struct EpiUp {
    static constexpr bool PERM = true;
    bf16_t* HID;
    DI void operator()(const f32x4 (&acc)[2][2][4][2], const Unit& u, int wr, int wc, int fr, int fq) const {
        const int row0 = u.arow + wr * 64 + fr, col0 = u.pn * 128 + wc * 32 + 8 * fq;
#pragma unroll
        for (int ai = 0; ai < 2; ++ai)
#pragma unroll
            for (int m = 0; m < 4; ++m) { const f32x4 g0 = acc[ai][0][m][0], g1 = acc[ai][0][m][1], u0 = acc[ai][1][m][0], u1 = acc[ai][1][m][1];
                float o[8];
#pragma unroll
                for (int k = 0; k < 4; ++k) { o[k] = silu_f(g0[k]) * u0[k]; o[4 + k] = silu_f(g1[k]) * u1[k]; }
                *(u32x4*)(HID + (size_t)(row0 + ai * 128 + m * 16) * 1024 + col0) = pack8(o); }
    }
};

struct EpiDown {
    static constexpr bool PERM = true;
    bf16_t* YE; const float* GV;
    DI void operator()(const f32x4 (&acc)[2][2][4][2], const Unit& u, int wr, int wc, int fr, int fq) const {
        const int row0 = u.arow + wr * 64 + fr, col0 = u.pn * 256 + wc * 32 + 8 * fq;
#pragma unroll
        for (int ai = 0; ai < 2; ++ai)
#pragma unroll
            for (int m = 0; m < 4; ++m) { const int row = row0 + ai * 128 + m * 16; const float gv = GV[row];
#pragma unroll
                for (int bj = 0; bj < 2; ++bj) { const f32x4 v0 = acc[ai][bj][m][0] * gv, v1 = acc[ai][bj][m][1] * gv;
                    u32x4 w; w.x = pk2(v0[0], v0[1]); w.y = pk2(v0[2], v0[3]); w.z = pk2(v1[0], v1[1]); w.w = pk2(v1[2], v1[3]);
                    *(u32x4*)(YE + (size_t)row * 1024 + col0 + bj * 128) = w; } }
    }
};

DI Unit mk_unit(int arow, int brow, int pm, int pn) { Unit u; u.arow = arow; u.brow = brow; u.pm = pm; u.pn = pn; return u; }
struct RowSkipOrder {
    int nN, G, c, skipctx, keep_lo, keep_hi, nmain, total, bstep;
    DI void init(int N, int G_, int c_, int skipctx_, int keep_lo_, int keep_hi_, int bstep_ = 256) { bstep = bstep_; nN = N / bstep_; G = G_; c = c_; skipctx = skipctx_; keep_lo = keep_lo_; keep_hi = keep_hi_;
        nmain = (skipctx ? 64 : 72) * nN; total = nmain + (skipctx ? 8 * (keep_hi - keep_lo) : 0); }
    DI Unit next(int i) const {
        const int L0 = i * G + c; if (L0 >= total) return mk_unit(-1, 0, 0, 0);
        const int q = total / 8, r = total % 8, xcd = L0 % 8, off = L0 / 8;
        const int L = (xcd < r ? xcd * (q + 1) : r * (q + 1) + (xcd - r) * q) + off;
        const int nig = 8 * nN, gid = L / nig, rr = L % nig, lt = gid * 8 + (rr % 8);
        const int pm_main = skipctx ? ((lt / 8) * 9 + 1 + (lt % 8)) : lt, pn_main = rr / 8;
        const int Lc = L - nmain, pm_ctx = (Lc % 8) * 9, pn_ctx = keep_lo + Lc / 8;
        const bool main = L < nmain;
        const int pm = main ? pm_main : pm_ctx, pn = main ? pn_main : pn_ctx;
        return mk_unit(pm * 256, pn * bstep, pm, pn);
    }
};
DI int xcd_remap(int L0, int total) { const int q = total / 8, r = total % 8, xcd = L0 % 8, off = L0 / 8; return (xcd < r ? xcd * (q + 1) : r * (q + 1) + (xcd - r) * q) + off; }
struct MergeOrder {
    int G, c, skipctx, total;
    DI void init(int G_, int c_, int skipctx_) { G = G_; c = c_; skipctx = skipctx_; total = (skipctx ? 64 : 72) * 8; }
    DI Unit next(int i) const {
        const int L0 = i * G + c; if (L0 >= total) return mk_unit(-1, 0, 0, 0);
        const int L = xcd_remap(L0, total), lt = L >> 3, pn = L & 7, pm = skipctx ? ((lt / 8) * 9 + 1 + (lt % 8)) : lt;
        return mk_unit(pm * 256, pn * 128, pm, pn);
    }
};
struct OrderS5S { int G, c; DI Unit next(int i) const { const int L = i * G + c; if (L >= 72) return mk_unit(-1, 0, 0, 0); const int g = L / 3, j = L % 3; return mk_unit(g * 576 + j * 256, g * 256, g, j); } };
struct OrderS5Y { int G, c; DI Unit next(int i) const { const int L = i * G + c; if (L >= 144) return mk_unit(-1, 0, 0, 0); const int g = L / 6, r = L % 6, j = r >> 1, nh = r & 1;
    return mk_unit(g * 576 + j * 256, g * 512 + nh * 256, g * 3 + j, nh); } };
struct OrderUp { int G, c, nJ; DI Unit next(int i) const { const int L0 = i * G + c, total = 16 * nJ * 8; if (L0 >= total) return mk_unit(-1, 0, 0, 0); const int L = xcd_remap(L0, total), n = L & 7, t = L >> 3, jt = t % nJ, e = t / nJ;
    return mk_unit(e * EROWS + jt * 256, e * 2048 + n * 256, e, n); } };
struct OrderDown { int G, c, nJ; DI Unit next(int i) const { const int L0 = i * G + c, total = 16 * nJ * 4; if (L0 >= total) return mk_unit(-1, 0, 0, 0); const int L = xcd_remap(L0, total), n = L & 3, t = L >> 2, jt = t % nJ, e = t / nJ;
    return mk_unit(e * EROWS + jt * 256, e * 1024 + n * 256, e, n); } };

struct Frame {
    LAS unsigned char* lds;
    int tid, lane, wave, G, vcu, gw, NGW, bid;
};

template <class DstRow>
DI void tr_item(const float* __restrict__ W, int ldw, int nvalid, int nstore, int K, bf16_t* __restrict__ WT, int k0, int n0, const DstRow& drow, const float* __restrict__ kscale, LAS float* scr  , int lane, int kofs = 0) {
    const int c4 = (lane & 15) * 4, r0 = lane >> 4;
    f32x4 v[16];
#pragma unroll
    for (int i = 0; i < 16; ++i) { const int kk = 4 * i + r0; v[i] = (n0 + c4 < nvalid) ? *(const f32x4*)(W + (size_t)(k0 + kk) * ldw + n0 + c4) : (f32x4){0.f, 0.f, 0.f, 0.f}; }
#pragma unroll
    for (int i = 0; i < 16; ++i) { const int kk = 4 * i + r0; f32x4 x = v[i]; if (kscale) x = x * kscale[k0 + kk];
        LAS float* d = scr + kk * 65 + c4; d[0] = x[0]; d[1] = x[1]; d[2] = x[2]; d[3] = x[3]; }
    LDS_WAIT(); asm volatile("" ::: "memory");
    const int c = lane & 7;
#pragma unroll
    for (int j = 0; j < 8; ++j) { const int n = (lane >> 3) + 8 * j; const LAS float* s = scr + (8 * c) * 65 + n;
        u32x4 o; o.x = pk2(s[0 * 65], s[1 * 65]); o.y = pk2(s[2 * 65], s[3 * 65]); o.z = pk2(s[4 * 65], s[5 * 65]); o.w = pk2(s[6 * 65], s[7 * 65]);
        if (n0 + n < nstore) *(u32x4*)(WT + (size_t)drow(n0 + n) * K + kofs + k0 + 8 * c) = o; }
    LDS_WAIT(); asm volatile("" ::: "memory");
}
struct DrIdent { int off; DI int operator()(int n) const { return off + n; } };
struct DrWin { DI int operator()(int n) const { return n < C_G ? n : n + (PA_W - C_G); } };
struct DrGU { int base; DI int operator()(int f) const { return base + (f >> 7) * 256 + (f & 127); } };

struct LayerIn {
    const float *w_in, *q_norm_g, *k_norm_g, *ssd_conv_w, *ssd_conv_b, *ssd_dt_bias, *ssd_a_log, *ssd_d, *ssd_norm_g;
    const float *s5_lre, *s5_lim, *s5_lstep, *s5_bre, *s5_bim, *s5_cre, *s5_cim, *s5_d, *s5_wglu, *s5_bglu, *sc_conv_w;
    const float *w_br_attn, *w_br_ssd, *w_br_s5, *w_br_sc, *w_out, *w_router, *w_gate, *w_up, *w_down, *norm_mix_g, *norm_ffn_g;
};

DI void prep_small_weights(const Frame& F, const LayerIn& P, unsigned char* ws, int part = 0, int first_wg = 0) {
    if ((int)blockIdx.x < first_wg) return;
    LAS float* scr = (LAS float*)(F.lds + F.wave * 16896);
    bf16_t* WIN = (bf16_t*)(ws + W_WIN);
    constexpr int NB_WIN = (NIN + 63) / 64;
    constexpr int I_WIN = 16 * NB_WIN, I_PAD = 62, I_BA = 8 * 16, I_BB = 8 * 16, I_BC = 6 * 16, I_BD = 6 * 16, I_OUT = 16 * 16, I_GLU = 6 * 8;
    constexpr int NIT = I_WIN + I_PAD + I_BA + I_BB + I_BC + I_BD + I_OUT + I_GLU;
    for (int it = ((int)blockIdx.x - first_wg) * NWAVES + F.wave; it < NIT; it += (F.G - first_wg) * NWAVES) {
        int r = it;
        { const bool is_out = (it >= NIT - I_GLU - I_OUT) && (it < NIT - I_GLU); if ((part == 1 && is_out) || (part == 2 && !is_out)) continue; }
        if (r < I_WIN) { const int kb = r / NB_WIN, nb = r % NB_WIN; tr_item(P.w_in, NIN, NIN, NIN, 1024, WIN, kb * 64, nb * 64, DrWin{}, nullptr, scr, F.lane); continue; } r -= I_WIN;
        if (r < I_PAD) {
#pragma unroll
            for (int j = 0; j < 8; ++j) { const int idx = j * 64 + F.lane, row = C_G + r * 4 + (idx >> 7), ch = idx & 127; *(u32x4*)(WIN + (size_t)row * 1024 + ch * 8) = (u32x4){0u, 0u, 0u, 0u}; }
            continue; } r -= I_PAD;
        if (r < I_BA) { tr_item(P.w_br_attn, 1024, 1024, 1024, 1792, (bf16_t*)(ws + W_BR4), (r / 16) * 64, (r % 16) * 64, DrIdent{0}, nullptr, scr, F.lane, 0); continue; } r -= I_BA;
        if (r < I_BB) { tr_item(P.w_br_ssd, 1024, 1024, 1024, 1792, (bf16_t*)(ws + W_BR4), (r / 16) * 64, (r % 16) * 64, DrIdent{0}, P.ssd_norm_g, scr, F.lane, 512); continue; } r -= I_BB;
        if (r < I_BC) { tr_item(P.w_br_s5, 1024, 1024, 1024, 1792, (bf16_t*)(ws + W_BR4), (r / 16) * 64, (r % 16) * 64, DrIdent{0}, nullptr, scr, F.lane, 1024); continue; } r -= I_BC;
        if (r < I_BD) { tr_item(P.w_br_sc, 1024, 1024, 1024, 1792, (bf16_t*)(ws + W_BR4), (r / 16) * 64, (r % 16) * 64, DrIdent{0}, nullptr, scr, F.lane, 1408); continue; } r -= I_BD;
        if (r < I_OUT) { tr_item(P.w_out, 1024, 1024, 1024, 1024, (bf16_t*)(ws + W_OUT), (r / 16) * 64, (r % 16) * 64, DrIdent{0}, nullptr, scr, F.lane); continue; } r -= I_OUT;
        tr_item(P.s5_wglu, 384, 384, 512, 384, (bf16_t*)(ws + W_GLU), (r / 8) * 64, (r % 8) * 64, DrIdent{0}, nullptr, scr, F.lane);
    }
}
DI void prep_expert_weights(const Frame& F, const LayerIn& P, unsigned char* ws, int first_wg, int item_lo, int item_hi, bf16_t* wgu = nullptr) {
    if ((int)blockIdx.x < first_wg) return;
    LAS float* scr = (LAS float*)(F.lds + F.wave * 16896);
    if (!wgu) wgu = (bf16_t*)(ws + WS_WGU);
    constexpr int PER = 16 * 16;
    for (int it = item_lo + ((int)blockIdx.x - first_wg) * NWAVES + F.wave; it < item_hi; it += (F.G - first_wg) * NWAVES) {
        const int which = it / (16 * PER), r = it % (16 * PER), e = r / PER, q = r % PER, k0 = (q / 16) * 64, n0 = (q % 16) * 64;
        if (which == 0) tr_item(P.w_gate + (size_t)e * 1024 * 1024, 1024, 1024, 1024, 1024, wgu, k0, n0, DrGU{e * 2048}, nullptr, scr, F.lane);
        else if (which == 1) tr_item(P.w_up + (size_t)e * 1024 * 1024, 1024, 1024, 1024, 1024, wgu, k0, n0, DrGU{e * 2048 + 128}, nullptr, scr, F.lane);
        else tr_item(P.w_down + (size_t)e * 1024 * 1024, 1024, 1024, 1024, 1024, (bf16_t*)(ws + WS_WD), k0, n0, DrIdent{e * 1024}, nullptr, scr, F.lane);
    }
}
constexpr int EXPERT_W_ITEMS = 3 * 16 * 16 * 16;

DI void prep_mod(const Frame& F, const float* __restrict__ c, const float* __restrict__ c_ctx, const float* __restrict__ w_mod, const float* __restrict__ b_mod, float* __restrict__ MOD, int first_wg) {
    const int wgi = (int)blockIdx.x - first_wg, nwg = F.G - first_wg;
    if (wgi < 0 || wgi >= 2 * 96) return;
    LAS float* sc = (LAS float*)F.lds;
    LAS float* red = sc + 9 * 1024;
    for (int o = F.tid; o < 9 * 1024; o += 512) { const float cv = (o < 8 * 1024) ? c[o] : c_ctx[o - 8 * 1024]; sc[o] = silu_f(cv); }
    __syncthreads();
    for (int it = wgi; it < 2 * 96; it += nwg) {
        const int l = it / 96, cb = it % 96, n = cb * 64 + F.lane;
        const float* W = w_mod + (size_t)l * 1024 * 6144;
        float acc[9];
#pragma unroll
        for (int r = 0; r < 9; ++r) acc[r] = 0.f;
        const int kbeg = F.wave * 128;
#pragma unroll 1
        for (int k8 = 0; k8 < 128; k8 += 16) { float w[16];
#pragma unroll
            for (int j = 0; j < 16; ++j) w[j] = W[(size_t)(kbeg + k8 + j) * 6144 + n];
#pragma unroll
            for (int j = 0; j < 16; ++j)
#pragma unroll
                for (int r = 0; r < 9; ++r) acc[r] += sc[r * 1024 + kbeg + k8 + j] * w[j]; }
#pragma unroll
        for (int r = 0; r < 9; ++r) red[(F.wave * 9 + r) * 64 + F.lane] = acc[r];
        __syncthreads();
        for (int o = F.tid; o < 9 * 64; o += 512) { const int r = o >> 6, ln = o & 63; float s = 0.f;
#pragma unroll
            for (int w = 0; w < 8; ++w) s += red[(w * 9 + r) * 64 + ln];
            MOD[((size_t)l * 9 + r) * 6144 + cb * 64 + ln] = s + b_mod[l * 6144 + cb * 64 + ln]; }
        __syncthreads();
    }
    __syncthreads();
}
DI void prep_rope(const Frame& F, float* ROPE, int first_wg) {
    if ((int)blockIdx.x < first_wg) return;
    for (int idx = ((int)blockIdx.x - first_wg) * 512 + F.tid; idx < 2048 * 32; idx += (F.G - first_wg) * 512) {
        const int t = idx >> 5, j = idx & 31, i = j & 15;
        const float inv = powf(10000.f, -(float)(2 * i) / 32.f);
        const float pos = (j < 16) ? (float)(t >> 6) : (float)(t & 63);
        const float a = pos * inv;
        ROPE[t * 64 + j] = cosf(a); ROPE[t * 64 + 32 + j] = sinf(a);
    }
}

DI void prep_s5(const Frame& F, const LayerIn& P, unsigned char* ws, int wg_off = 0) {
    const int wgi = (int)blockIdx.x - wg_off;
    if (wgi < 0 || wgi >= 96) return;
    LAS float* pw = (LAS float*)F.lds;
    LAS float* bb = pw + 8448;
    LAS float* Kt = bb + 4096;
    LAS float* cc = Kt + 16896;
    LAS float* prm = cc + 2048;
    for (int it = wgi; it < 96; it += F.G) {
        const int g = it >> 2, qt = it & 3;
        for (int o = F.tid; o < 2048; o += 512) cc[o] = (o < 1024) ? P.s5_cre[(size_t)g * 1024 + o] : P.s5_cim[(size_t)g * 1024 + o - 1024];
        for (int o = F.tid; o < 2048; o += 512) prm[264 + o] = (o < 1024) ? P.s5_bre[(size_t)g * 1024 + o] : P.s5_bim[(size_t)g * 1024 + o - 1024];
        if (F.tid < 256) { const int d = (F.tid >> 6) & 1, p = F.tid & 63; prm[F.tid] = (F.tid < 128) ? P.s5_lre[(d * 24 + g) * 64 + p] : P.s5_lim[(d * 24 + g) * 64 + p]; }
        if (F.tid < 2) prm[256 + F.tid] = __expf(P.s5_lstep[F.tid * 24 + g]);
        __syncthreads();
        if (F.tid < 128) { const int d = F.tid >> 6, p = F.tid & 63;
            const float step = prm[256 + d], lr = prm[d * 64 + p], li = prm[128 + d * 64 + p];
            const float th = li * step, sh = sinf(0.5f * th);
            const float mag = expf(lr * step), abi = mag * sinf(th);
            const float nr = expm1f(lr * step) - 2.f * mag * sh * sh, ni = abi;
            const float den = lr * lr + li * li;
            const float cr = (nr * lr + ni * li) / den, ci = (ni * lr - nr * li) / den;
#pragma unroll
            for (int j = 0; j < 16; ++j) { const float br = prm[264 + p * 16 + j], bi = prm[264 + 1024 + p * 16 + j];
                bb[((d * 64 + p) * 16 + j) * 2 + 0] = cr * br - ci * bi; bb[((d * 64 + p) * 16 + j) * 2 + 1] = cr * bi + ci * br; } }
        for (int o = F.tid; o < 2 * 64 * 33; o += 512) { const int dp = o / 33, tau = o % 33, d = dp >> 6, p = dp & 63;
            const float step = prm[256 + d], lr = prm[d * 64 + p], li = prm[128 + d * 64 + p];
            const float m = expf(lr * step * (float)tau), a = li * step * (float)tau;
            pw[o * 2 + 0] = m * cosf(a); pw[o * 2 + 1] = m * sinf(a); }
        __syncthreads();
        for (int o = F.tid; o < 1024; o += 512) { const int d = o >> 9, a = (o >> 5) & 15, tau = o & 31; float s[16];
#pragma unroll
            for (int b_ = 0; b_ < 16; ++b_) s[b_] = 0.f;
            for (int p = 0; p < 64; ++p) { const float cre = cc[a * 64 + p], cim = cc[1024 + a * 64 + p];
                const f32x2 lp = *(const LAS f32x2*)(pw + ((d * 64 + p) * 33 + tau) * 2);
                const float wr_ = cre * lp[0] - cim * lp[1], wi_ = cre * lp[1] + cim * lp[0];
                const LAS f32x4* bp = (const LAS f32x4*)(bb + (d * 64 + p) * 32);
#pragma unroll
                for (int q4 = 0; q4 < 8; ++q4) { const f32x4 t = bp[q4]; s[2 * q4] += wr_ * t[0] - wi_ * t[1]; s[2 * q4 + 1] += wr_ * t[2] - wi_ * t[3]; } }
#pragma unroll
            for (int b_ = 0; b_ < 16; ++b_) Kt[((d * 16 + a) * 16 + b_) * 33 + tau] = s[b_]; }
        __syncthreads();
        bf16_t* TQ = (bf16_t*)(ws + W_TQ) + (size_t)g * 512 * 768;
        for (int o = F.tid; o < 128 * 64; o += 512) { const int row = qt * 128 + (o >> 6), ch = o & 63, i = row >> 4, a = row & 15, b0 = (ch >> 5) * 8, j = ch & 31; float v[8];
#pragma unroll
            for (int k = 0; k < 8; ++k) { float s_ = 0.f;
                if (j <= i) s_ += Kt[((0 * 16 + a) * 16 + b0 + k) * 33 + (i - j)];
                if (j >= i) s_ += Kt[((1 * 16 + a) * 16 + b0 + k) * 33 + (j - i)];
                v[k] = s_; }
            *(u32x4*)(TQ + (size_t)row * 768 + j * 16 + b0) = pack8(v); }
        for (int o = F.tid; o < 128 * 128; o += 512) { const int row = qt * 128 + (o >> 7), dp = o & 127, d = dp >> 6, p = dp & 63, i = row >> 4, a = row & 15; const int tau = d == 0 ? (i + 1) : (32 - i);
            const float cre = cc[a * 64 + p], cim = cc[1024 + a * 64 + p];
            const f32x2 lp = *(const LAS f32x2*)(pw + ((d * 64 + p) * 33 + tau) * 2);
            TQ[(size_t)row * 768 + 512 + d * 128 + p] = (bf16_t)f2bf(cre * lp[0] - cim * lp[1]);
            TQ[(size_t)row * 768 + 512 + d * 128 + 64 + p] = (bf16_t)f2bf(-(cre * lp[1] + cim * lp[0])); }
        bf16_t* PP = (bf16_t*)(ws + W_P) + (size_t)g * 256 * 512;
        for (int o = F.tid; o < 2 * 16 * 32; o += 512) { const int d = o >> 9, p = qt * 16 + ((o >> 5) & 15), j = o & 31; const int tau = d == 0 ? (31 - j) : j;
            const f32x2 lp = *(const LAS f32x2*)(pw + ((d * 64 + p) * 33 + tau) * 2);
            const LAS f32x4* bp = (const LAS f32x4*)(bb + (d * 64 + p) * 32);
            float vr[16], vi[16];
#pragma unroll
            for (int q4 = 0; q4 < 8; ++q4) { const f32x4 t = bp[q4];
                vr[2 * q4] = lp[0] * t[0] - lp[1] * t[1]; vi[2 * q4] = lp[0] * t[1] + lp[1] * t[0];
                vr[2 * q4 + 1] = lp[0] * t[2] - lp[1] * t[3]; vi[2 * q4 + 1] = lp[0] * t[3] + lp[1] * t[2]; }
            float h0[8], h1[8];
#pragma unroll
            for (int k = 0; k < 8; ++k) { h0[k] = vr[k]; h1[k] = vr[8 + k]; }
            bf16_t* pr = PP + (size_t)(d * 128 + p) * 512 + j * 16;
            *(u32x4*)pr = pack8(h0); *(u32x4*)(pr + 8) = pack8(h1);
#pragma unroll
            for (int k = 0; k < 8; ++k) { h0[k] = vi[k]; h1[k] = vi[8 + k]; }
            bf16_t* pi = PP + (size_t)(d * 128 + 64 + p) * 512 + j * 16;
            *(u32x4*)pi = pack8(h0); *(u32x4*)(pi + 8) = pack8(h1); }
        __syncthreads();
    }
}

struct RowCtx { int R, b, p, isctx, mrow; };
DI RowCtx row_ctx(int R) { RowCtx r; r.R = R; r.b = R / PB; r.p = R - r.b * PB; r.isctx = r.p < CTXL; r.mrow = r.isctx ? 8 : r.b; return r; }
struct WaveRows { int b, pa, pb; };
DI WaveRows wave_rows(int wg, int nwb, int p0, int np, int wave) {
    const int b = wg / nwb, j = wg - b * nwb;
    const int lo = p0 + (j * np) / nwb, hi = p0 + ((j + 1) * np) / nwb, per = (hi - lo + NWAVES - 1) / NWAVES;
    WaveRows w; w.b = b; w.pa = min(lo + wave * per, hi); w.pb = min(w.pa + per, hi); return w;
}
DI const float* stream_in(const float* x_in, const float* ctx_in, int b, int p) { return (p < CTXL) ? ctx_in + ((size_t)b * CTXL + p) * 1024 : x_in + ((size_t)b * SEQ + (p - CTXL)) * 1024; }
template <int N> DI void wave_sum_n(float (&v)[N]) {
#pragma unroll
    for (int o = 1; o < 64; o <<= 1) {
        float t[N];
#pragma unroll
        for (int k = 0; k < N; ++k) t[k] = __shfl_xor(v[k], o);
#pragma unroll
        for (int k = 0; k < N; ++k) v[k] += t[k]; }
}
DI float row_ssq(const f32x4 (&x)[4]) {
    float ss = 0.f;
#pragma unroll
    for (int j = 0; j < 4; ++j) ss += (x[j][0] * x[j][0] + x[j][1] * x[j][1]) + (x[j][2] * x[j][2] + x[j][3] * x[j][3]);
    return ss;
}
DI void row_store_bf16(int lane, const f32x4 (&h)[4], bf16_t* dst) {
#pragma unroll
    for (int j = 0; j < 4; ++j) { u32x2 w; w.x = pk2(h[j][0], h[j][1]); w.y = pk2(h[j][2], h[j][3]); *(u32x2*)(dst + j * 256 + 4 * lane) = w; }
}
DI void add_gated_bf16(f32x4 (&x)[4], const u32x2 (&y)[4], const LAS float* gate, int lane) {
#pragma unroll
    for (int j = 0; j < 4; ++j) { const f32x4 g = *(const LAS f32x4*)(gate + j * 256 + 4 * lane);
        x[j][0] += g[0] * bflo(y[j].x); x[j][1] += g[1] * bfhi(y[j].x); x[j][2] += g[2] * bflo(y[j].y); x[j][3] += g[3] * bfhi(y[j].y); }
}
DI __amdgpu_buffer_rsrc_t ye_resource(const bf16_t* YE) { return __builtin_amdgcn_make_buffer_rsrc((void*)YE, 0, 16 * EROWS * 2048, 0x00020000); }
DI unsigned combine_issue(const __amdgpu_buffer_rsrc_t rs, const int myinv, const int lane, u32x2 (&ye)[4][4]) {
    unsigned mask = (unsigned)__ballot(myinv >= 0) & 0xFFFFu;
#pragma unroll
    for (int s = 0; s < 4; ++s) { const bool has = mask != 0u; const int e = has ? __builtin_ctz(mask) : 0; mask &= mask - 1u;
        const int er = __builtin_amdgcn_readlane(myinv, e);
        const unsigned off = has ? (unsigned)er * 2048u + (unsigned)lane * 8u : 0x80000000u;
#pragma unroll
        for (int j = 0; j < 4; ++j) ye[s][j] = __builtin_amdgcn_raw_buffer_load_b64(rs, off + j * 512, 0, 0); }
    return mask;
}
DI void combine_add(f32x4 (&x)[4], const u32x2 (&ye)[4][4], unsigned rest, const int myinv, const bf16_t* YE, const LAS float* gate, int lane) {
    f32x4 s[4];
#pragma unroll
    for (int j = 0; j < 4; ++j) { s[j][0] = (bflo(ye[0][j].x) + bflo(ye[1][j].x)) + (bflo(ye[2][j].x) + bflo(ye[3][j].x)); s[j][1] = (bfhi(ye[0][j].x) + bfhi(ye[1][j].x)) + (bfhi(ye[2][j].x) + bfhi(ye[3][j].x));
        s[j][2] = (bflo(ye[0][j].y) + bflo(ye[1][j].y)) + (bflo(ye[2][j].y) + bflo(ye[3][j].y)); s[j][3] = (bfhi(ye[0][j].y) + bfhi(ye[1][j].y)) + (bfhi(ye[2][j].y) + bfhi(ye[3][j].y)); }
    while (rest) { const int e = __builtin_ctz(rest); rest &= rest - 1u; const int er = __builtin_amdgcn_readlane(myinv, e); const bf16_t* yr = YE + (size_t)er * 1024 + 4 * lane;
#pragma unroll
        for (int j = 0; j < 4; ++j) { const u32x2 w = *(const u32x2*)(yr + j * 256); s[j][0] += bflo(w.x); s[j][1] += bfhi(w.x); s[j][2] += bflo(w.y); s[j][3] += bfhi(w.y); } }
#pragma unroll
    for (int j = 0; j < 4; ++j) x[j] += *(const LAS f32x4*)(gate + j * 256 + 4 * lane) * s[j];
}

template <bool COMBINE, int RPW>
DI void phase_norm1(const Frame& F, int layer, const float* x_in, const float* ctx_in, bf16_t* X, bf16_t* H1, const float* MOD, const float* gmix, const int* INV, const bf16_t* YE, const bf16_t* Y, int first_wg) {
    if ((int)blockIdx.x < first_wg) return;
    const WaveRows wr = wave_rows((int)blockIdx.x - first_wg, (F.G - first_wg) / NB, 0, PB, F.wave);
    LAS float* ml = (LAS float*)F.lds;
    { const float* modl = MOD + (size_t)layer * 9 * 6144; const float* modp = MOD + (size_t)(COMBINE ? layer - 1 : 0) * 9 * 6144;
      for (int idx = F.tid; idx < 2048; idx += NWAVES * 64) { const int set = idx >> 10, c = idx & 1023; const size_t mo = (size_t)(set ? 8 : wr.b) * 6144;
          if (COMBINE) { ml[(set * 4 + 0) * 1024 + c] = modp[mo + 2 * 1024 + c]; ml[(set * 4 + 1) * 1024 + c] = modp[mo + 5 * 1024 + c]; }
          ml[(set * 4 + 2) * 1024 + c] = gmix[c] * (1.f + modl[mo + 1024 + c]); ml[(set * 4 + 3) * 1024 + c] = modl[mo + c]; } }
    __syncthreads();
    const __amdgpu_buffer_rsrc_t rs = ye_resource(YE);
    for (int p = wr.pa; p < wr.pb; p += RPW) {
        f32x4 x[RPW][4]; u32x2 y[RPW][4]; int inv[RPW]; size_t Rk[RPW]; const LAS float* mk[RPW];
#pragma unroll
        for (int k = 0; k < RPW; ++k) { const int pk = min(p + k, wr.pb - 1); Rk[k] = (size_t)wr.b * PB + pk; mk[k] = ml + (pk < CTXL ? 4096 : 0);
            const float* src = stream_in(x_in, ctx_in, wr.b, pk);
#pragma unroll
            for (int j = 0; j < 4; ++j) x[k][j] = *(const f32x4*)(src + j * 256 + 4 * F.lane);
            if (COMBINE) { inv[k] = (F.lane < 16) ? INV[Rk[k] * 16 + F.lane] : -1;
#pragma unroll
                for (int j = 0; j < 4; ++j) y[k][j] = *(const u32x2*)(Y + Rk[k] * 1024 + j * 256 + 4 * F.lane); } }
        if (COMBINE) {
            u32x2 ye[RPW][4][4]; unsigned rest[RPW];
#pragma unroll
            for (int k = 0; k < RPW; ++k) rest[k] = combine_issue(rs, inv[k], F.lane, ye[k]);
#pragma unroll
            for (int k = 0; k < RPW; ++k) add_gated_bf16(x[k], y[k], mk[k], F.lane);
#pragma unroll
            for (int k = 0; k < RPW; ++k) { combine_add(x[k], ye[k], rest[k], inv[k], YE, mk[k] + 1024, F.lane);
#pragma unroll
                for (int j = 0; j < 4; ++j) { u32x2 w; w.x = pk2(x[k][j][0], x[k][j][1]); w.y = pk2(x[k][j][2], x[k][j][3]); *(u32x2*)(X + Rk[k] * 1024 + j * 256 + 4 * F.lane) = w; } }
        }
        float ss[RPW];
#pragma unroll
        for (int k = 0; k < RPW; ++k) ss[k] = row_ssq(x[k]);
        wave_sum_n<RPW>(ss);
#pragma unroll
        for (int k = 0; k < RPW; ++k) { const float rstd = __builtin_amdgcn_rsqf(ss[k] * (1.f / 1024.f) + RMS_EPS);
#pragma unroll
            for (int j = 0; j < 4; ++j) x[k][j] = x[k][j] * rstd * *(const LAS f32x4*)(mk[k] + 2048 + j * 256 + 4 * F.lane) + *(const LAS f32x4*)(mk[k] + 3072 + j * 256 + 4 * F.lane);
            row_store_bf16(F.lane, x[k], H1 + Rk[k] * 1024); }
    }
    __syncthreads();
}
template <int RPW>
DI void phase_final(const Frame& F, const bf16_t* X, float* out, const float* MOD, const float* gfin, const int* INV, const bf16_t* YE, const bf16_t* Y) {
    const WaveRows wr = wave_rows((int)blockIdx.x, F.G / NB, CTXL, SEQ, F.wave);
    LAS float* ml = (LAS float*)F.lds;
    for (int c = F.tid; c < 1024; c += NWAVES * 64) { const float* mr = MOD + (size_t)(9 + wr.b) * 6144; ml[c] = mr[2 * 1024 + c]; ml[1024 + c] = mr[5 * 1024 + c]; ml[2048 + c] = gfin[c]; }
    __syncthreads();
    const __amdgpu_buffer_rsrc_t rs = ye_resource(YE);
    for (int p = wr.pa; p < wr.pb; p += RPW) {
        f32x4 x[RPW][4]; u32x2 y[RPW][4]; int inv[RPW]; size_t Rk[RPW];
#pragma unroll
        for (int k = 0; k < RPW; ++k) { const int pk = min(p + k, wr.pb - 1); Rk[k] = (size_t)wr.b * PB + pk;
#pragma unroll
            for (int j = 0; j < 4; ++j) { const u32x2 w = *(const u32x2*)(X + Rk[k] * 1024 + j * 256 + 4 * F.lane); x[k][j] = (f32x4){bflo(w.x), bfhi(w.x), bflo(w.y), bfhi(w.y)}; }
            inv[k] = (F.lane < 16) ? INV[Rk[k] * 16 + F.lane] : -1;
#pragma unroll
            for (int j = 0; j < 4; ++j) y[k][j] = *(const u32x2*)(Y + Rk[k] * 1024 + j * 256 + 4 * F.lane); }
        u32x2 ye[RPW][4][4]; unsigned rest[RPW];
#pragma unroll
        for (int k = 0; k < RPW; ++k) rest[k] = combine_issue(rs, inv[k], F.lane, ye[k]);
#pragma unroll
        for (int k = 0; k < RPW; ++k) add_gated_bf16(x[k], y[k], ml, F.lane);
#pragma unroll
        for (int k = 0; k < RPW; ++k) combine_add(x[k], ye[k], rest[k], inv[k], YE, ml + 1024, F.lane);
        float ss[RPW];
#pragma unroll
        for (int k = 0; k < RPW; ++k) ss[k] = row_ssq(x[k]);
        wave_sum_n<RPW>(ss);
#pragma unroll
        for (int k = 0; k < RPW; ++k) { const float rstd = __builtin_amdgcn_rsqf(ss[k] * (1.f / 1024.f) + RMS_EPS);
            float* o = out + ((size_t)wr.b * SEQ + (min(p + k, wr.pb - 1) - CTXL)) * 1024;
#pragma unroll
            for (int j = 0; j < 4; ++j) *(f32x4*)(o + j * 256 + 4 * F.lane) = x[k][j] * rstd * *(const LAS f32x4*)(ml + 2048 + j * 256 + 4 * F.lane); }
    }
}

DI float router_butterfly(const float (&s16)[16], int lane, int& e_out) {
    const bool b5 = (lane & 32) != 0, b4 = (lane & 16) != 0, b3 = (lane & 8) != 0, b2 = (lane & 4) != 0;
    float t8[8], u4[4], w2[2];
#pragma unroll
    for (int k = 0; k < 8; ++k) { const float keep = b5 ? s16[k + 8] : s16[k], send = b5 ? s16[k] : s16[k + 8]; t8[k] = keep + __shfl_xor(send, 32); }
#pragma unroll
    for (int k = 0; k < 4; ++k) { const float keep = b4 ? t8[k + 4] : t8[k], send = b4 ? t8[k] : t8[k + 4]; u4[k] = keep + __shfl_xor(send, 16); }
#pragma unroll
    for (int k = 0; k < 2; ++k) { const float keep = b3 ? u4[k + 2] : u4[k], send = b3 ? u4[k] : u4[k + 2]; w2[k] = keep + __shfl_xor(send, 8); }
    float z; { const float keep = b2 ? w2[1] : w2[0], send = b2 ? w2[0] : w2[1]; z = keep + __shfl_xor(send, 4); }
    z += __shfl_xor(z, 2); z += __shfl_xor(z, 1);
    e_out = (b5 ? 8 : 0) + (b4 ? 4 : 0) + (b3 ? 2 : 0) + (b2 ? 1 : 0);
    return z;
}
template <int RPW>
DI void phase_norm2(const Frame& F, int layer, bool skipctx, const float* x_in, const float* ctx_in, const bf16_t* X, const bf16_t* Y, bf16_t* H2, const float* MOD, const float* gffn, const float* w_router, float* AFF) {
    constexpr int WP = 1028;
    LAS float* wl = (LAS float*)F.lds;
    LAS float* ml = wl + 16 * WP;
    const WaveRows wr = wave_rows((int)blockIdx.x, F.G / NB, skipctx ? CTXL : 0, skipctx ? SEQ : PB, F.wave);
    for (int idx = F.tid; idx < 16384; idx += NWAVES * 64) wl[(idx & 15) * WP + (idx >> 4)] = w_router[idx];
    { const float* modl = MOD + (size_t)layer * 9 * 6144;
      for (int idx = F.tid; idx < 2048; idx += NWAVES * 64) { const int set = idx >> 10, c = idx & 1023; const float* mr = modl + (size_t)(set ? 8 : wr.b) * 6144;
          ml[(set * 3 + 0) * 1024 + c] = mr[2 * 1024 + c]; ml[(set * 3 + 1) * 1024 + c] = gffn[c] * (1.f + mr[4 * 1024 + c]); ml[(set * 3 + 2) * 1024 + c] = mr[3 * 1024 + c]; } }
    __syncthreads();
    for (int p = wr.pa; p < wr.pb; p += RPW) {
        f32x4 x[RPW][4]; int pk[RPW]; size_t Rk[RPW]; const LAS float* mk[RPW];
        { u32x2 y[RPW][4];
#pragma unroll
          for (int k = 0; k < RPW; ++k) { pk[k] = min(p + k, wr.pb - 1); Rk[k] = (size_t)wr.b * PB + pk[k]; mk[k] = ml + (pk[k] < CTXL ? 3072 : 0);
              if (layer > 0) {
#pragma unroll
                  for (int j = 0; j < 4; ++j) { const u32x2 w = *(const u32x2*)(X + Rk[k] * 1024 + j * 256 + 4 * F.lane); x[k][j] = (f32x4){bflo(w.x), bfhi(w.x), bflo(w.y), bfhi(w.y)}; }
              } else { const float* src = stream_in(x_in, ctx_in, wr.b, pk[k]);
#pragma unroll
                  for (int j = 0; j < 4; ++j) x[k][j] = *(const f32x4*)(src + j * 256 + 4 * F.lane); }
#pragma unroll
              for (int j = 0; j < 4; ++j) y[k][j] = *(const u32x2*)(Y + Rk[k] * 1024 + j * 256 + 4 * F.lane); }
#pragma unroll
          for (int k = 0; k < RPW; ++k) add_gated_bf16(x[k], y[k], mk[k], F.lane); }
        float ss[RPW];
#pragma unroll
        for (int k = 0; k < RPW; ++k) ss[k] = row_ssq(x[k]);
        wave_sum_n<RPW>(ss);
#pragma unroll
        for (int k = 0; k < RPW; ++k) { const float rstd = __builtin_amdgcn_rsqf(ss[k] * (1.f / 1024.f) + RMS_EPS);
#pragma unroll
            for (int j = 0; j < 4; ++j) x[k][j] = x[k][j] * rstd * *(const LAS f32x4*)(mk[k] + 1024 + j * 256 + 4 * F.lane) + *(const LAS f32x4*)(mk[k] + 2048 + j * 256 + 4 * F.lane);
            row_store_bf16(F.lane, x[k], H2 + Rk[k] * 1024); }
        float s16[RPW][16];
        int wofs = 4 * F.lane; asm volatile("" : "+v"(wofs));
#pragma unroll
        for (int e = 0; e < 16; ++e) {
            f32x4 w[4];
#pragma unroll
            for (int j = 0; j < 4; ++j) w[j] = *(const LAS f32x4*)(wl + e * WP + j * 256 + wofs);
#pragma unroll
            for (int k = 0; k < RPW; ++k) { float s = 0.f;
#pragma unroll
                for (int j = 0; j < 4; ++j) s += (x[k][j][0] * w[j][0] + x[k][j][1] * w[j][1]) + (x[k][j][2] * w[j][2] + x[k][j][3] * w[j][3]);
                s16[k][e] = s; }
            if ((e & 3) == 3) __builtin_amdgcn_sched_barrier(0);
        }
        float aff[RPW]; int ek = 0;
#pragma unroll
        for (int k = 0; k < RPW; ++k) { int e; const float z = router_butterfly(s16[k], F.lane, e);
            float mx = z;
            mx = fmaxf(mx, __shfl_xor(mx, 32)); mx = fmaxf(mx, __shfl_xor(mx, 16)); mx = fmaxf(mx, __shfl_xor(mx, 8)); mx = fmaxf(mx, __shfl_xor(mx, 4));
            const float mine = expf(z - mx);
            float den = mine;
            den += __shfl_xor(den, 32); den += __shfl_xor(den, 16); den += __shfl_xor(den, 8); den += __shfl_xor(den, 4);
            aff[k] = mine / den; ek = e; }
        if ((F.lane & 3) == 0) {
#pragma unroll
            for (int k = 0; k < RPW; ++k) AFF[((size_t)wr.b * 16 + ek) * PB + pk[k]] = aff[k]; }
    }
    __syncthreads();
}

DI int block_exscan(const Frame& F, int v, LAS int* wtot, int& total) {
    int incl = v; const int sl = lane_op();
#pragma unroll
    for (int o = 1; o < 64; o <<= 1) { const int t = shup(incl, o, sl); if (sl >= o) incl += t; }
    if (F.lane == 63) wtot[F.wave] = incl;
    __syncthreads();
    int base = 0; total = 0;
#pragma unroll
    for (int w = 0; w < 8; ++w) { const int x = wtot[w]; if (w < F.wave) base += x; total += x; }
    __syncthreads();
    return base + incl - v;
}
DI void phase_topk(const Frame& F, int nitems, const float* AFF, int* SRC, float* GV, int* INV) {
    LAS int* wcnt = (LAS int*)F.lds;
    LAS int* wtot = wcnt + 48;
    for (int it = blockIdx.x; it < nitems; it += F.G) {
        const int isctx = it >= 128, be = it & 127, b = be >> 4, e = be & 15;
        const int n = isctx ? CTXL : SEQ, cap = isctx ? 32 : 256, p0 = isctx ? 0 : CTXL;
        const float* a = AFF + ((size_t)b * 16 + e) * PB + p0;
        unsigned v[4]; float av[4];
#pragma unroll
        for (int k = 0; k < 4; ++k) { const int idx = 4 * F.tid + k; av[k] = idx < n ? a[idx] : 0.f; v[k] = __builtin_bit_cast(unsigned, av[k]); }
        unsigned prefix = 0u;
        for (int b0 = 28; b0 >= 0; b0 -= 2) {
            const unsigned c3 = prefix | (3u << b0), c2 = prefix | (2u << b0), c1 = prefix | (1u << b0);
            int n3 = 0, n2 = 0, n1 = 0;
#pragma unroll
            for (int k = 0; k < 4; ++k) { n3 += __popcll(__ballot(v[k] >= c3)); n2 += __popcll(__ballot(v[k] >= c2)); n1 += __popcll(__ballot(v[k] >= c1)); }
            LAS int* wc = wcnt + ((b0 >> 1) & 1) * 24;
            if (F.lane == 0) { wc[F.wave] = n3; wc[8 + F.wave] = n2; wc[16 + F.wave] = n1; }
            __syncthreads();
            int t3 = 0, t2 = 0, t1 = 0;
#pragma unroll
            for (int w = 0; w < 8; ++w) { t3 += wc[w]; t2 += wc[8 + w]; t1 += wc[16 + w]; }
            prefix = (t3 >= cap) ? c3 : (t2 >= cap) ? c2 : (t1 >= cap) ? c1 : prefix;
        }
        __syncthreads();
        int ngt_t = 0, neq_t = 0;
#pragma unroll
        for (int k = 0; k < 4; ++k) { ngt_t += (v[k] > prefix) ? 1 : 0; neq_t += (v[k] == prefix) ? 1 : 0; }
        int ngt_total, neq_total;
        (void)block_exscan(F, ngt_t, wtot, ngt_total);
        int eq_rank = block_exscan(F, neq_t, wtot, neq_total);
        const int eq_take = cap - ngt_total;
        int sel[4], nsel_t = 0;
#pragma unroll
        for (int k = 0; k < 4; ++k) { int s = 0; if (v[k] > prefix) s = 1; else if (v[k] == prefix) { s = (eq_rank < eq_take) ? 1 : 0; ++eq_rank; } sel[k] = s; nsel_t += s; }
        int nsel_total;
        int slot = block_exscan(F, nsel_t, wtot, nsel_total);
        const int ebase = e * EROWS + (isctx ? 2048 + b * 32 : b * 256);
#pragma unroll
        for (int k = 0; k < 4; ++k) { const int idx = 4 * F.tid + k;
            if (idx < n) { const int R = b * PB + p0 + idx;
                if (sel[k]) { const int er = ebase + slot; ++slot; SRC[er] = R; GV[er] = av[k]; INV[(size_t)R * 16 + e] = er; }
                else INV[(size_t)R * 16 + e] = -1; } }
        __syncthreads();
    }
}
DI void phase_gather(const Frame& F, int rows_per_expert, const int* __restrict__ SRC, const bf16_t* __restrict__ H2, bf16_t* __restrict__ XG) {
    const int total = 16 * rows_per_expert;
    for (int q = F.gw * 4; q < total; q += F.NGW * 4) {
        const int e = q / rows_per_expert, s = q - e * rows_per_expert, er = e * EROWS + s;
        int R[4];
#pragma unroll
        for (int u = 0; u < 4; ++u) R[u] = SRC[er + u];
        u32x4 v0[4], v1[4];
#pragma unroll
        for (int u = 0; u < 4; ++u) { v0[u] = *(const u32x4*)(H2 + (size_t)R[u] * 1024 + 8 * F.lane); v1[u] = *(const u32x4*)(H2 + (size_t)R[u] * 1024 + 512 + 8 * F.lane); }
#pragma unroll
        for (int u = 0; u < 4; ++u) { *(u32x4*)(XG + (size_t)(er + u) * 1024 + 8 * F.lane) = v0[u]; *(u32x4*)(XG + (size_t)(er + u) * 1024 + 512 + 8 * F.lane) = v1[u]; }
    }
}

DI void qk_norm_rope(const float (&vin)[8], int ll, const float (&gn)[8], const float (&c)[8], const float (&sn)[8], float scale, float (&o)[8]) {
    float v[8]; float ss = 0.f;
#pragma unroll
    for (int k = 0; k < 8; ++k) ss += vin[k] * vin[k];
    ss += __shfl_xor(ss, 1); ss += __shfl_xor(ss, 2); ss += __shfl_xor(ss, 4);
    const float rstd = __builtin_amdgcn_rsqf(ss * (1.f / 64.f) + RMS_EPS) * scale;
#pragma unroll
    for (int k = 0; k < 8; ++k) v[k] = vin[k] * rstd * gn[k];
    const bool isx2 = (ll & 2) != 0;
#pragma unroll
    for (int k = 0; k < 8; ++k) { const float pv = __shfl_xor(v[k], 2); o[k] = isx2 ? (v[k] * c[k] + pv * sn[k]) : (v[k] * c[k] - pv * sn[k]); }
}
DI void ld8(const float* p, float (&o)[8]) { const f32x4 a = *(const f32x4*)p, b = *(const f32x4*)(p + 4); o[0] = a[0]; o[1] = a[1]; o[2] = a[2]; o[3] = a[3]; o[4] = b[0]; o[5] = b[1]; o[6] = b[2]; o[7] = b[3]; }
DI void phase_elem(const Frame& F, const LayerIn& P, const bf16_t* __restrict__ PA, const float* __restrict__ ROPE, bf16_t* __restrict__ QN, bf16_t* __restrict__ KN, bf16_t* __restrict__ XBC,
                   float* __restrict__ DT, bf16_t* __restrict__ AU, bf16_t* __restrict__ YCD) {
    const int l = F.lane;
    constexpr int NGRP = MROWS / 4;
    for (int task = F.gw; task < 3 * NGRP; task += F.NGW) {
        const int part = task / NGRP, R0 = (task - part * NGRP) * 4;
        const RowCtx rc = row_ctx(R0);
        const bf16_t* pr = PA + (size_t)R0 * PA_W;
        const bool has_prev = (rc.p != 0) && (rc.p != CTXL), has_next = (rc.p + 3 != CTXL - 1) && (rc.p + 3 != PB - 1);
        const bool rope = !rc.isctx; const int t0 = rope ? rc.p - CTXL : 0;
        if (part == 0) {
            const int hb = (l & 7) >> 2, i0 = (l & 1) * 8, uk = l >> 4, lk = l & 15, hbk = (lk & 7) >> 2, i0k = (lk & 1) * 8;
            u32x4 wq[4]; float cq[4][8], sq[4][8], ck[8], sk[8], gq[8], gk[8];
#pragma unroll
            for (int u = 0; u < 4; ++u) wq[u] = *(const u32x4*)(pr + (size_t)u * PA_W + C_Q + l * 8);
            const u32x4 wk = *(const u32x4*)(pr + (size_t)uk * PA_W + C_K + lk * 8);
            const bf16_t dtr = pr[(size_t)uk * PA_W + C_DT + (l & 7)];
            if (rope) {
#pragma unroll
                for (int u = 0; u < 4; ++u) { const float* cs = ROPE + (size_t)(t0 + u) * 64 + hb * 16 + i0; ld8(cs, cq[u]); ld8(cs + 32, sq[u]); }
                const float* cs = ROPE + (size_t)(t0 + uk) * 64 + hbk * 16 + i0k; ld8(cs, ck); ld8(cs + 32, sk);
            } else {
#pragma unroll
                for (int k = 0; k < 8; ++k) { ck[k] = 1.f; sk[k] = 0.f;
#pragma unroll
                    for (int u = 0; u < 4; ++u) { cq[u][k] = 1.f; sq[u][k] = 0.f; } }
            }
            ld8(P.q_norm_g + (l & 7) * 8, gq); ld8(P.k_norm_g + (lk & 7) * 8, gk);
            const float dtb = P.ssd_dt_bias[((l >> 3) & 1) * 8 + (l & 7)];
#pragma unroll
            for (int u = 0; u < 4; ++u) { float v[8], o[8]; unpack8(wq[u], v); qk_norm_rope(v, l, gq, cq[u], sq[u], ATT_C2, o); *(u32x4*)(QN + (size_t)(R0 + u) * 512 + l * 8) = pack8(o); }
            { float v[8], o[8]; unpack8(wk, v); qk_norm_rope(v, lk, gk, ck, sk, 1.f, o); *(u32x4*)(KN + (size_t)(R0 + uk) * 128 + lk * 8) = pack8(o); }
            { const int d = (l >> 3) & 1, h = l & 7; DT[((size_t)d * MROWS + R0 + uk) * 8 + h] = softplus_f(bf2f(dtr) + dtb); }
        } else if (part == 1) {
            const bool v1 = l < 32;
            u32x4 w[2][6]; float cw[2][4][8];
#pragma unroll
            for (int ps = 0; ps < 2; ++ps) { const int ch = (ps * 64 + l) * 8;
#pragma unroll
                for (int u = 0; u < 6; ++u) { const bool ok = ((u == 0) ? has_prev : (u == 5) ? has_next : true) && (ps == 0 || v1);
                    w[ps][u] = ok ? *(const u32x4*)(pr + (ptrdiff_t)(u - 1) * PA_W + C_XBC + ch) : (u32x4){0u, 0u, 0u, 0u}; } }
#pragma unroll
            for (int ps = 0; ps < 2; ++ps) { const int ch = (ps == 0 || v1) ? (ps * 64 + l) * 8 : 0;
                ld8(P.ssd_conv_w + ch, cw[ps][0]); ld8(P.ssd_conv_w + 768 + ch, cw[ps][1]); ld8(P.ssd_conv_w + 1536 + ch, cw[ps][2]); ld8(P.ssd_conv_b + ch, cw[ps][3]); }
#pragma unroll
            for (int ps = 0; ps < 2; ++ps) { const int ch = (ps * 64 + l) * 8;
                float a[8], b[8], c[8]; unpack8(w[ps][0], a); unpack8(w[ps][1], b);
#pragma unroll
                for (int u = 0; u < 4; ++u) { unpack8(w[ps][u + 2], c); float o[8];
#pragma unroll
                    for (int k = 0; k < 8; ++k) { o[k] = silu_f(cw[ps][0][k] * a[k] + cw[ps][1][k] * b[k] + cw[ps][2][k] * c[k] + cw[ps][3][k]); a[k] = b[k]; b[k] = c[k]; }
                    if (ps == 0 || v1) *(u32x4*)(XBC + (size_t)(R0 + u) * 768 + ch) = pack8(o); } }
        } else if (l < 48) {
            const int g = l >> 1, a0 = (l & 1) * 8, ch = l * 8;
            u32x4 sb[4], sg[6], sh[6];
#pragma unroll
            for (int u = 0; u < 4; ++u) sb[u] = *(const u32x4*)(pr + (size_t)u * PA_W + C_SB + ch);
#pragma unroll
            for (int u = 0; u < 6; ++u) { const bool ok = (u == 0) ? has_prev : (u == 5) ? has_next : true;
                sg[u] = ok ? *(const u32x4*)(pr + (ptrdiff_t)(u - 1) * PA_W + C_SG + ch) : (u32x4){0u, 0u, 0u, 0u};
                sh[u] = ok ? *(const u32x4*)(pr + (ptrdiff_t)(u - 1) * PA_W + C_SH + ch) : (u32x4){0u, 0u, 0u, 0u}; }
            float w0[8], w1[8], w2[8];
            ld8(P.sc_conv_w + ch, w0); ld8(P.sc_conv_w + 384 + ch, w1); ld8(P.sc_conv_w + 768 + ch, w2);
            float a[8], b[8], c[8], x[8], y[8];
            unpack8(sg[0], x); unpack8(sh[0], y);
#pragma unroll
            for (int k = 0; k < 8; ++k) a[k] = x[k] * y[k];
            unpack8(sg[1], x); unpack8(sh[1], y);
#pragma unroll
            for (int k = 0; k < 8; ++k) b[k] = x[k] * y[k];
#pragma unroll
            for (int u = 0; u < 4; ++u) { unpack8(sg[u + 2], x); unpack8(sh[u + 2], y); float s[8], o[8]; unpack8(sb[u], s);
#pragma unroll
                for (int k = 0; k < 8; ++k) { c[k] = x[k] * y[k]; o[k] = s[k] * (w0[k] * a[k] + w1[k] * b[k] + w2[k] * c[k]); a[k] = b[k]; b[k] = c[k]; }
                *(u32x4*)(YCD + (size_t)(R0 + u) * 768 + 384 + ch) = pack8(o); }
        }
    }
}

typedef short v4i16_t __attribute__((ext_vector_type(4)));
DI int img_off(int row, int chunk) { return row * 128 + ((chunk ^ (row & 7)) << 4); }
DI s16x4 tr_read4(const LAS unsigned char* p) { return __builtin_bit_cast(s16x4, __builtin_amdgcn_ds_read_tr16_b64_v4i16((LAS v4i16_t*)p)); }
DI bf16x8 cat8(s16x4 lo, s16x4 hi) { return (bf16x8){lo[0], lo[1], lo[2], lo[3], hi[0], hi[1], hi[2], hi[3]}; }
DI unsigned cvtpk(float lo, float hi) { typedef __bf16 bf2 __attribute__((ext_vector_type(2))); f32x2 v = {lo, hi}; bf2 b = __builtin_convertvector(v, bf2); return __builtin_bit_cast(unsigned, b); }
#define MFMA32(a, b, c) __builtin_amdgcn_mfma_f32_32x32x16_bf16((a), (b), (c), 0, 0, 0)
DI int crow(int r, int hh) { return (r & 3) + 8 * (r >> 2) + 4 * hh; }

constexpr int SSD_XH = 0, SSD_BM = 65536, SSD_CM = 81920, SSD_ARR = 131072;
DI void ssd_load_images(const Frame& F, const bf16_t* XBC, int R0, int g, bool with_c) {
    int tid_l = F.tid; asm volatile("" : "+v"(tid_l));
#pragma unroll
    for (int it = 0; it < 8; ++it) { const int idx = it * 512 + tid_l, h4 = idx >> 10, row = (idx >> 3) & 127, ch = idx & 7;
        *(LAS u32x4*)(F.lds + SSD_XH + h4 * 16384 + img_off(row, ch)) = *(const u32x4*)(XBC + (size_t)(R0 + row) * 768 + g * 256 + h4 * 64 + ch * 8); }
#pragma unroll
    for (int it = 0; it < 2; ++it) { const int idx = it * 512 + tid_l, row = idx >> 3, ch = idx & 7;
        *(LAS u32x4*)(F.lds + SSD_BM + img_off(row, ch)) = *(const u32x4*)(XBC + (size_t)(R0 + row) * 768 + 512 + g * 64 + ch * 8);
        if (with_c) *(LAS u32x4*)(F.lds + SSD_CM + img_off(row, ch)) = *(const u32x4*)(XBC + (size_t)(R0 + row) * 768 + 640 + g * 64 + ch * 8); }
}
struct Series { float dt0, dt1, cs0, cs1, ecs0, ecs1, tot; };
DI Series ssd_series(const Frame& F, const float* DT, const float* a_log, int R0, int h, int d) {
    Series s; const float a = -__expf(a_log[d * 8 + h]);
    s.dt0 = DT[((size_t)d * MROWS + R0 + 2 * F.lane) * 8 + h]; s.dt1 = DT[((size_t)d * MROWS + R0 + 2 * F.lane + 1) * 8 + h];
    const float ad0 = s.dt0 * a, ad1 = s.dt1 * a, pair = ad0 + ad1; float incl = pair; const int sl = lane_op();
#pragma unroll
    for (int o = 1; o < 64; o <<= 1) { const float t = shup(incl, o, sl); if (sl >= o) incl += t; }
    const float excl = incl - pair;
    s.cs0 = excl + ad0; s.cs1 = incl; s.ecs0 = excl; s.ecs1 = excl + ad0; s.tot = shidx(incl, 63);
    return s;
}

DI void ssd_chunk_states(const Frame& F, const LayerIn& P, const bf16_t* XBC, const float* DT, float* S, float* TOT) {
    LAS float* W = (LAS float*)(F.lds + SSD_ARR);
    const int lane = F.lane, hh = lane >> 5, q = (lane & 15) >> 2, pp = lane & 3, blk = (lane >> 4) & 1;
    const int h4 = F.wave & 3, d = F.wave >> 2;
    for (int it = F.bid; it < 288; it += F.G) {
        const int b = it / 36, r = it % 36, c = r >> 1, g = r & 1, R0 = b * PB + c * 128, h = 4 * g + h4;
        ssd_load_images(F, XBC, R0, g, false);
        const Series s = ssd_series(F, DT, P.ssd_a_log, R0, h, d);
        float w0, w1;
        if (d == 0) { w0 = s.dt0 * __expf(s.tot - s.cs0); w1 = s.dt1 * __expf(s.tot - s.cs1); } else { w0 = s.dt0 * __expf(s.ecs0); w1 = s.dt1 * __expf(s.ecs1); }
        *(LAS f32x2*)(W + F.wave * 128 + 2 * lane) = (f32x2){w0, w1};
        if (lane == 0) TOT[(((size_t)b * 18 + c) * 8 + h) * 2 + d] = s.tot;
        __syncthreads();
        f32x16 acc[2][2];
#pragma unroll
        for (int i = 0; i < 2; ++i)
#pragma unroll
            for (int j = 0; j < 2; ++j)
#pragma unroll
                for (int k = 0; k < 16; ++k) acc[i][j][k] = 0.f;
        const LAS unsigned char* xh = F.lds + SSD_XH + h4 * 16384;
        const LAS unsigned char* bm = F.lds + SSD_BM;
#pragma unroll 2
        for (int st = 0; st < 8; ++st) {
            const int row = 16 * st + 8 * hh + q;
            const f32x4 wa = *(const LAS f32x4*)(W + F.wave * 128 + 16 * st + 8 * hh), wb = *(const LAS f32x4*)(W + F.wave * 128 + 16 * st + 8 * hh + 4);
            bf16x8 af[2], bfr[2];
#pragma unroll
            for (int t = 0; t < 2; ++t) { const int chunk = t * 4 + 2 * blk + (pp >> 1), within = 8 * (pp & 1);
                af[t] = cat8(tr_read4(bm + img_off(row, chunk) + within), tr_read4(bm + img_off(row + 4, chunk) + within));
                const s16x4 lo = tr_read4(xh + img_off(row, chunk) + within), hi = tr_read4(xh + img_off(row + 4, chunk) + within);
                u32x4 pw;
                pw.x = cvtpk(bf2f((bf16_t)lo[0]) * wa[0], bf2f((bf16_t)lo[1]) * wa[1]); pw.y = cvtpk(bf2f((bf16_t)lo[2]) * wa[2], bf2f((bf16_t)lo[3]) * wa[3]);
                pw.z = cvtpk(bf2f((bf16_t)hi[0]) * wb[0], bf2f((bf16_t)hi[1]) * wb[1]); pw.w = cvtpk(bf2f((bf16_t)hi[2]) * wb[2], bf2f((bf16_t)hi[3]) * wb[3]);
                bfr[t] = __builtin_bit_cast(bf16x8, pw); }
#pragma unroll
            for (int nt = 0; nt < 2; ++nt)
#pragma unroll
                for (int pt = 0; pt < 2; ++pt) acc[nt][pt] = MFMA32(af[nt], bfr[pt], acc[nt][pt]);
        }
        float* Sb = S + ((((size_t)b * 18 + c) * 8 + h) * 2 + d) * 4096;
#pragma unroll
        for (int nt = 0; nt < 2; ++nt)
#pragma unroll
            for (int pt = 0; pt < 2; ++pt)
#pragma unroll
                for (int q4 = 0; q4 < 4; ++q4) { const int p = pt * 32 + (lane & 31), n0 = nt * 32 + 8 * q4 + 4 * hh;
                    *(f32x4*)(Sb + p * 64 + n0) = (f32x4){acc[nt][pt][4 * q4], acc[nt][pt][4 * q4 + 1], acc[nt][pt][4 * q4 + 2], acc[nt][pt][4 * q4 + 3]}; }
        __syncthreads();
    }
}

DI void ssd_recurrence(const Frame& F, const float* __restrict__ S, const float* __restrict__ TOT, bf16_t* __restrict__ HIN) {
    for (int gi = F.bid * 512 + F.tid; gi < 128 * 1024; gi += F.G * 512) {
        const int bhd = gi >> 10, e4 = (gi & 1023) * 4, b = bhd >> 4, h = (bhd >> 1) & 7, d = bhd & 1;
        f32x4 sv[18]; float dec[18];
#pragma unroll
        for (int k = 0; k < 18; ++k) { const int c = (d == 0) ? k : (k < 2 ? 1 - k : 19 - k);
            const size_t st = (((size_t)b * 18 + c) * 8 + h) * 2 + d;
            sv[k] = *(const f32x4*)(S + st * 4096 + e4); dec[k] = TOT[st]; }
        float z0 = 0.f; asm volatile("" : "+v"(z0));
        f32x4 H = (f32x4){z0, z0, z0, z0};
#pragma unroll
        for (int k = 0; k < 18; ++k) { const int c = (d == 0) ? k : (k < 2 ? 1 - k : 19 - k);
            const size_t st = (((size_t)b * 18 + c) * 8 + h) * 2 + d;
            u32x2 w; w.x = pk2(H[0], H[1]); w.y = pk2(H[2], H[3]);
            *(u32x2*)(HIN + st * 4096 + e4) = w;
            H = H * __expf(dec[k]) + sv[k]; }
    }
}

#ifndef E3_PROBE
#define E3_PROBE 0
#endif
__device__ unsigned long long g_probe_ticks;
#define E3STAMP(k) do { if (E3_PROBE) { const unsigned long long t_ = __builtin_amdgcn_s_memrealtime(); if (E3_PROBE == (k) && blockIdx.x == 0 && threadIdx.x == 0) g_probe_ticks += t_ - tprev_; tprev_ = t_; } } while (0)
DI void ssd_output(const Frame& F, const LayerIn& P, const bf16_t* XBC, const bf16_t* PA, const float* DT, const bf16_t* HIN, bf16_t* YB, float* SSQ, bool skipctx) {
    LAS float* ARR = (LAS float*)(F.lds + SSD_ARR);
    const int lane = F.lane, hh = lane >> 5, q = (lane & 15) >> 2, pp = lane & 3, blk = (lane >> 4) & 1, l31 = lane & 31;
    for (int it = F.bid; it < 288; it += F.G) {
        const int b = it / 36, r_ = it % 36, c = r_ >> 1, g = r_ & 1, R0 = b * PB + c * 128;
        if (skipctx && c < 2) continue;
        unsigned long long tprev_ = E3_PROBE ? __builtin_amdgcn_s_memrealtime() : 0ull;
        ssd_load_images(F, XBC, R0, g, true);
        bf16x8 hb0[2][4];
        { const bf16_t* Hs = HIN + (((((size_t)b * 18 + c) * 8 + 4 * g + (F.wave & 3)) * 2 + 0) * 4096);
#pragma unroll
          for (int pt = 0; pt < 2; ++pt)
#pragma unroll
              for (int ks = 0; ks < 4; ++ks) hb0[pt][ks] = *(const bf16x8*)(Hs + (pt * 32 + l31) * 64 + 16 * ks + 8 * hh); }
        { const int h4 = F.wave & 3, d = F.wave >> 2, h = 4 * g + h4;
          const Series s = ssd_series(F, DT, P.ssd_a_log, R0, h, d);
          LAS float* A = ARR + h4 * 768;
          if (d == 0) { *(LAS f32x2*)(A + 0 * 128 + 2 * lane) = (f32x2){s.cs0, s.cs1}; *(LAS f32x2*)(A + 1 * 128 + 2 * lane) = (f32x2){s.dt0, s.dt1};
                        *(LAS f32x2*)(A + 2 * 128 + 2 * lane) = (f32x2){__expf(s.cs0), __expf(s.cs1)}; }
          else { *(LAS f32x2*)(A + 3 * 128 + 2 * lane) = (f32x2){s.ecs0, s.ecs1}; *(LAS f32x2*)(A + 4 * 128 + 2 * lane) = (f32x2){s.dt0, s.dt1};
                 *(LAS f32x2*)(A + 5 * 128 + 2 * lane) = (f32x2){__expf(s.tot - s.ecs0), __expf(s.tot - s.ecs1)}; } }
        __syncthreads();
        E3STAMP(1);
        const int h4 = F.wave & 3, rh = F.wave >> 2, h = 4 * g + h4;
        const LAS float* A = ARR + h4 * 768;
        const LAS unsigned char* xh = F.lds + SSD_XH + h4 * 16384;
        const LAS unsigned char* bm = F.lds + SSD_BM;
        const LAS unsigned char* cm = F.lds + SSD_CM;
        f32x16 yacc[2][2];
#pragma unroll
        for (int i = 0; i < 2; ++i)
#pragma unroll
            for (int j = 0; j < 2; ++j)
#pragma unroll
                for (int k = 0; k < 16; ++k) yacc[i][j][k] = 0.f;
        bf16x8 hb1[2][4];
        { const bf16_t* Hs = HIN + (((((size_t)b * 18 + c) * 8 + h) * 2 + 1) * 4096);
#pragma unroll
          for (int pt = 0; pt < 2; ++pt)
#pragma unroll
              for (int ks = 0; ks < 4; ++ks) hb1[pt][ks] = *(const bf16x8*)(Hs + (pt * 32 + l31) * 64 + 16 * ks + 8 * hh); }
#pragma unroll
        for (int d = 0; d < 2; ++d)
#pragma unroll
            for (int itl = 0; itl < 2; ++itl) {
                const int itile = 2 * rh + itl, irow = itile * 32 + l31;
                bf16x8 cf[4];
#pragma unroll
                for (int ks = 0; ks < 4; ++ks) cf[ks] = *(const LAS bf16x8*)(cm + img_off(irow, 2 * ks + hh));
#pragma unroll
                for (int pt = 0; pt < 2; ++pt) {
                    f32x16 tmp;
#pragma unroll
                    for (int k = 0; k < 16; ++k) tmp[k] = 0.f;
#pragma unroll
                    for (int ks = 0; ks < 4; ++ks) tmp = MFMA32(cf[ks], d == 0 ? hb0[pt][ks] : hb1[pt][ks], tmp);
#pragma unroll
                    for (int q4 = 0; q4 < 4; ++q4) { const f32x4 ev = *(const LAS f32x4*)(A + (d == 0 ? 2 : 5) * 128 + itile * 32 + 8 * q4 + 4 * hh);
#pragma unroll
                        for (int k = 0; k < 4; ++k) yacc[itl][pt][4 * q4 + k] += tmp[4 * q4 + k] * ev[k]; }
                }
                __builtin_amdgcn_sched_barrier(0);
            }
#pragma unroll
        for (int itl = 0; itl < 2; ++itl) {
            const int itile = 2 * rh + itl, irow = itile * 32 + l31;
            bf16x8 cf[4];
#pragma unroll
            for (int ks = 0; ks < 4; ++ks) cf[ks] = *(const LAS bf16x8*)(cm + img_off(irow, 2 * ks + hh));
            const float csf_i = A[0 * 128 + irow], ecb_i = A[3 * 128 + irow];
#pragma unroll 1
            for (int jt = 0; jt < 4; ++jt) {
                f32x16 Z;
#pragma unroll
                for (int k = 0; k < 16; ++k) Z[k] = 0.f;
#pragma unroll
                for (int ks = 0; ks < 4; ++ks) { const bf16x8 bf_ = *(const LAS bf16x8*)(bm + img_off(jt * 32 + l31, 2 * ks + hh)); Z = MFMA32(bf_, cf[ks], Z); }
#pragma unroll
                for (int q4 = 0; q4 < 4; ++q4) { const int j0 = jt * 32 + 8 * q4 + 4 * hh;
                    f32x4 w = (f32x4){0.f, 0.f, 0.f, 0.f};
                    if (jt <= itile) { const f32x4 cj = *(const LAS f32x4*)(A + 0 * 128 + j0), dj = *(const LAS f32x4*)(A + 1 * 128 + j0);
#pragma unroll
                        for (int k = 0; k < 4; ++k) { const bool ok = (jt < itile) || (j0 + k <= irow); w[k] += ok ? __expf(fminf(csf_i - cj[k], 0.f)) * dj[k] : 0.f; } }
                    if (jt >= itile) { const f32x4 ej = *(const LAS f32x4*)(A + 3 * 128 + j0), dj = *(const LAS f32x4*)(A + 4 * 128 + j0);
#pragma unroll
                        for (int k = 0; k < 4; ++k) { const bool ok = (jt > itile) || (j0 + k >= irow); w[k] += ok ? __expf(fminf(ej[k] - ecb_i, 0.f)) * dj[k] : 0.f; } }
#pragma unroll
                    for (int k = 0; k < 4; ++k) Z[4 * q4 + k] *= w[k]; }
#pragma unroll
                for (int s = 0; s < 2; ++s) {
                    u32x4 zp; zp.x = cvtpk(Z[8 * s], Z[8 * s + 1]); zp.y = cvtpk(Z[8 * s + 2], Z[8 * s + 3]); zp.z = cvtpk(Z[8 * s + 4], Z[8 * s + 5]); zp.w = cvtpk(Z[8 * s + 6], Z[8 * s + 7]);
                    const bf16x8 za = __builtin_bit_cast(bf16x8, zp);
                    const int row = jt * 32 + 16 * s + 4 * hh + q;
#pragma unroll
                    for (int pt = 0; pt < 2; ++pt) { const int chunk = pt * 4 + 2 * blk + (pp >> 1), within = 8 * (pp & 1);
                        const bf16x8 xb = cat8(tr_read4(xh + img_off(row, chunk) + within), tr_read4(xh + img_off(row + 8, chunk) + within));
                        yacc[itl][pt] = MFMA32(za, xb, yacc[itl][pt]); }
                }
                __builtin_amdgcn_sched_barrier(0);
            }
        }
        __syncthreads();
        E3STAMP(2);
        LAS float* Y = (LAS float*)F.lds;
#pragma unroll
        for (int itl = 0; itl < 2; ++itl)
#pragma unroll
            for (int pt = 0; pt < 2; ++pt)
#pragma unroll
                for (int r = 0; r < 16; ++r) Y[((2 * rh + itl) * 32 + crow(r, hh)) * 256 + h4 * 64 + pt * 32 + l31] = yacc[itl][pt][r];
        u32x4 xw[4], zw[4];
        int tid_e = F.tid; asm volatile("" : "+v"(tid_e));
#pragma unroll
        for (int u = 0; u < 4; ++u) { const int idx = u * 512 + tid_e, row = idx >> 5, ch = idx & 31, R = R0 + row;
            xw[u] = *(const u32x4*)(XBC + (size_t)R * 768 + g * 256 + ch * 8); zw[u] = *(const u32x4*)(PA + (size_t)R * PA_W + C_Z + g * 256 + ch * 8); }
        __syncthreads();
#pragma unroll
        for (int it4 = 0; it4 < 8; it4 += 4) {
            u32x4 xn[4], zn[4];
            if (it4 == 0) {
#pragma unroll
                for (int u = 0; u < 4; ++u) { const int idx = (4 + u) * 512 + tid_e, row = idx >> 5, ch = idx & 31, R = R0 + row;
                    xn[u] = *(const u32x4*)(XBC + (size_t)R * 768 + g * 256 + ch * 8); zn[u] = *(const u32x4*)(PA + (size_t)R * PA_W + C_Z + g * 256 + ch * 8); } }
#pragma unroll
            for (int u = 0; u < 4; ++u) { const int idx = (it4 + u) * 512 + tid_e, row = idx >> 5, ch = idx & 31, R = R0 + row;
                const f32x4 y0 = *(const LAS f32x4*)(Y + row * 256 + ch * 8), y1 = *(const LAS f32x4*)(Y + row * 256 + ch * 8 + 4);
                float xv[8], zv[8]; unpack8(xw[u], xv); unpack8(zw[u], zv);
                const float Dh = P.ssd_d[4 * g + (ch >> 3)]; float o[8], ss = 0.f;
#pragma unroll
                for (int k = 0; k < 8; ++k) { const float yv = (k < 4 ? y0[k] : y1[k - 4]) + Dh * xv[k]; o[k] = yv * silu_f(zv[k]); ss += o[k] * o[k]; }
                ss += __shfl_xor(ss, 1); ss += __shfl_xor(ss, 2); ss += __shfl_xor(ss, 4); ss += __shfl_xor(ss, 8); ss += __shfl_xor(ss, 16);
                if (ch == 0) SSQ[(size_t)R * 2 + g] = ss;
                *(u32x4*)(YB + (size_t)R * 1024 + 512 + g * 256 + ch * 8) = pack8(o); }
            if (it4 == 0) {
#pragma unroll
                for (int u = 0; u < 4; ++u) { xw[u] = xn[u]; zw[u] = zn[u]; } }
        }
        __syncthreads();
        E3STAMP(3);
    }
}

DI void s5_recurrence(const Frame& F, const LayerIn& P, const float* __restrict__ S5S, bf16_t* __restrict__ AU) {
    if (F.gw >= 384) return;
    const int g = F.gw >> 4, b = (F.gw >> 1) & 7, d = F.gw & 1, p = F.lane;
    const float step = __expf(P.s5_lstep[d * 24 + g]);
    const float lr = P.s5_lre[(d * 24 + g) * 64 + p], li = P.s5_lim[(d * 24 + g) * 64 + p];
    const float mag = expf(32.f * lr * step), ang = 32.f * li * step, Lr = mag * cosf(ang), Li = mag * sinf(ang);
    float Hr = 0.f, Hi = 0.f;
#pragma unroll 1
    for (int kb = 0; kb < 72; kb += 24) {
        float sr[24], si[24];
#pragma unroll
        for (int k = 0; k < 24; ++k) { const int kk = kb + k, ck = (d == 0) ? kk : (kk < 8 ? 7 - kk : 79 - kk);
            const size_t m = (size_t)g * 576 + b * 72 + ck;
            sr[k] = S5S[m * 256 + d * 128 + p]; si[k] = S5S[m * 256 + d * 128 + 64 + p]; }
#pragma unroll
        for (int k = 0; k < 24; ++k) { const int kk = kb + k, ck = (d == 0) ? kk : (kk < 8 ? 7 - kk : 79 - kk);
            const size_t m = (size_t)g * 576 + b * 72 + ck;
            AU[m * 768 + 512 + d * 128 + p] = (bf16_t)f2bf(Hr); AU[m * 768 + 512 + d * 128 + 64 + p] = (bf16_t)f2bf(Hi);
            const float nr = Lr * Hr - Li * Hi + sr[k], ni = Lr * Hi + Li * Hr + si[k];
            Hr = nr; Hi = ni; }
    }
}

namespace attn_body {
using bf16=__hip_bfloat16;
using bf16x8=__attribute__((ext_vector_type(8)))short;
using s16x4=__attribute__((ext_vector_type(4)))short;
using f32x16=__attribute__((ext_vector_type(16)))float;
using u32x4=__attribute__((ext_vector_type(4)))unsigned;
constexpr int D=64;
constexpr int NW=8,QBLK=32,QB=QBLK*NW,KVBLK=64;
__device__ __forceinline__ int crow(int r,int hi){return (r&3)+8*(r>>2)+4*hi;}
#define SBAR() __builtin_amdgcn_sched_barrier(0)
constexpr int NSLOT=3, SLOTB=8192;
constexpr int LDS_K=0, LDS_V=NSLOT*SLOTB, LDS_WS=2*NSLOT*SLOTB, LDS_OST=LDS_WS+NW*64*4, LDS_BYTES=LDS_OST+NW*4096;
constexpr float C2=0.125f*1.4426950408889634f;
__device__ __forceinline__ void glds16(const void*gsrc,unsigned lds_dst){unsigned keep;
  asm volatile("s_mov_b32 %0, m0\n\ts_mov_b32 m0, %2\n\ts_nop 0\n\tglobal_load_lds_dwordx4 %1, off\n\ts_mov_b32 m0, %0":"=&s"(keep):"v"(gsrc),"s"(lds_dst):"memory");}
__device__ __forceinline__ float max3f(float a,float b,float c){float r;asm("v_max3_f32 %0, %1, %2, %3":"=v"(r):"v"(a),"v"(b),"v"(c));return r;}
__device__ __forceinline__ float max2f(float a,float b){float r;asm("v_max_f32_e32 %0, %1, %2":"=v"(r):"v"(a),"v"(b));return r;}
__device__ __forceinline__ float fadd_s(float a,float b){float r;asm("v_add_f32_e32 %0, %1, %2":"=v"(r):"v"(a),"v"(b));return r;}
__device__ __forceinline__ float fsub_s(float a,float b){float r;asm("v_sub_f32_e32 %0, %1, %2":"=v"(r):"v"(a),"v"(b));return r;}
typedef float f32x2_t __attribute__((ext_vector_type(2))); typedef __bf16 bf16x2_t __attribute__((ext_vector_type(2)));
__device__ __forceinline__ unsigned cvtpk_s(float lo,float hi){f32x2_t v={lo,hi};bf16x2_t b=__builtin_convertvector(v,bf16x2_t);return __builtin_bit_cast(unsigned,b);}
#define WAIT_BAR(N) asm volatile("s_waitcnt vmcnt(" #N ") lgkmcnt(0)\n\ts_barrier":::"memory")

__device__ __forceinline__ void qkt(f32x16&p0,f32x16&p1,const char*Kslot,const bf16x8*qr,const f32x16&negm,int r32,int hi){
  const char*kb=Kslot+hi*1024+r32*16;
  #pragma unroll
  for(int d0=0;d0<4;++d0){
    const bf16x8 b0=*reinterpret_cast<const bf16x8*>(kb+d0*2048);
    const bf16x8 b1=*reinterpret_cast<const bf16x8*>(kb+d0*2048+512);
    if(d0==0){p0=__builtin_amdgcn_mfma_f32_32x32x16_bf16(b0,qr[0],negm,0,0,0);p1=__builtin_amdgcn_mfma_f32_32x32x16_bf16(b1,qr[0],negm,0,0,0);}
    else{p0=__builtin_amdgcn_mfma_f32_32x32x16_bf16(b0,qr[d0],p0,0,0,0);p1=__builtin_amdgcn_mfma_f32_32x32x16_bf16(b1,qr[d0],p1,0,0,0);}}
}
typedef __attribute__((address_space(3))) const char* lds_cptr;
typedef short v4i16_t __attribute__((ext_vector_type(4)));
__device__ __forceinline__ void kload8(bf16x8*kf,lds_cptr kp){
  kf[0]=*(const __attribute__((address_space(3))) bf16x8*)(kp);      kf[1]=*(const __attribute__((address_space(3))) bf16x8*)(kp+512);
  kf[2]=*(const __attribute__((address_space(3))) bf16x8*)(kp+2048); kf[3]=*(const __attribute__((address_space(3))) bf16x8*)(kp+2560);
  kf[4]=*(const __attribute__((address_space(3))) bf16x8*)(kp+4096); kf[5]=*(const __attribute__((address_space(3))) bf16x8*)(kp+4608);
  kf[6]=*(const __attribute__((address_space(3))) bf16x8*)(kp+6144); kf[7]=*(const __attribute__((address_space(3))) bf16x8*)(kp+6656);
}
__device__ __forceinline__ void kload2(bf16x8*kf,lds_cptr kp,int j){ kf[2*j]=*(const __attribute__((address_space(3))) bf16x8*)(kp+j*2048); kf[2*j+1]=*(const __attribute__((address_space(3))) bf16x8*)(kp+j*2048+512); }
__device__ __forceinline__ s16x4 vtr(lds_cptr p){ return __builtin_bit_cast(s16x4,__builtin_amdgcn_ds_read_tr16_b64_v4i16((__attribute__((address_space(3))) v4i16_t*)p)); }
__device__ __forceinline__ float rowmax(const f32x16&p0,const f32x16&p1){
  float a=max3f(p0[0],p0[1],p1[0]),b=max3f(p0[2],p0[3],p1[1]);a=max3f(a,p1[2],p1[3]);
  #pragma unroll
  for(int r=4;r<16;r+=4){a=max3f(a,p0[r],p0[r+1]);b=max3f(b,p0[r+2],p0[r+3]);a=max3f(a,p1[r],p1[r+1]);b=max3f(b,p1[r+2],p1[r+3]);}
  const float m=max2f(a,b);
  auto rr=__builtin_amdgcn_permlane32_swap(__float_as_uint(m),__float_as_uint(m),false,false);
  return max2f(__uint_as_float(rr[0]),__uint_as_float(rr[1]));
}
__device__ __forceinline__ void pv(f32x16*o,int vb,bf16x8 pa0,bf16x8 pa1,bf16x8 pa2,bf16x8 pa3){
  #pragma unroll
  for(int d0=0;d0<2;++d0){s16x4 lo[4],hi[4];
    #pragma unroll
    for(int ks=0;ks<4;++ks){
      asm volatile("ds_read_b64_tr_b16 %0,%1 offset:%c2":"=&v"(lo[ks]):"v"(vb),"i"(d0*4096+ks*1024):"memory");
      asm volatile("ds_read_b64_tr_b16 %0,%1 offset:%c2":"=&v"(hi[ks]):"v"(vb),"i"(d0*4096+ks*1024+512):"memory");}
    asm volatile("s_waitcnt lgkmcnt(0)":::"memory");SBAR();
    #define PK(k) (bf16x8){lo[k][0],lo[k][1],lo[k][2],lo[k][3],hi[k][0],hi[k][1],hi[k][2],hi[k][3]}
    o[d0]=__builtin_amdgcn_mfma_f32_32x32x16_bf16(pa0,PK(0),o[d0],0,0,0);
    o[d0]=__builtin_amdgcn_mfma_f32_32x32x16_bf16(pa1,PK(1),o[d0],0,0,0);
    o[d0]=__builtin_amdgcn_mfma_f32_32x32x16_bf16(pa2,PK(2),o[d0],0,0,0);
    o[d0]=__builtin_amdgcn_mfma_f32_32x32x16_bf16(pa3,PK(3),o[d0],0,0,0);
    #undef PK
  }
}

#ifndef ATTN_STORE16
#define ATTN_STORE16(p,v) (*(u32x4*)(p)=(v))
#endif
template<int THRL> __device__ __forceinline__ void attn_unit(const bf16*Qp,int qpitch,const bf16*__restrict__ Kp,int kpitch,const bf16*__restrict__ Vp,int vpitch,bf16*Op,int opitch,const int NT,char*shm){
  const int tid=fresh_tid(),lane=tid&63,r32=lane&31,hi=lane>>5; const int wid=__builtin_amdgcn_readfirstlane(tid>>6);
  const bf16*Qw=Qp+(long)(wid*QBLK)*qpitch;
  const bf16*Kh=Kp,*Vh=Vp;
  const unsigned lds0=(unsigned)(uintptr_t)shm;
  float*wsf=(float*)(shm+LDS_WS)+wid*64;
  const bf16*ksrc=Kh+(long)lane*kpitch+wid*8;
  const bf16*vsrc=Vh+(long)(16*(wid&3)+(lane>>2))*vpitch+(wid>>2)*32+(lane&3)*8;
  const unsigned kdst=lds0+LDS_K+wid*1024, vdst=lds0+LDS_V+wid*1024;
  #define DMA_K(t,slot) glds16(ksrc+(long)(t)*KVBLK*kpitch,(unsigned)__builtin_amdgcn_readfirstlane(kdst+(slot)))
  #define DMA_V(t,slot) glds16(vsrc+(long)(t)*KVBLK*vpitch,(unsigned)__builtin_amdgcn_readfirstlane(vdst+(slot)))
  const int vb0=(int)(lds0+LDS_V)+((lane>>4)&1)*32+(lane&3)*8+(4*hi+((lane&15)>>2))*64;
  const char*Kbase=shm+LDS_K; bf16x8 kf[8];
  const lds_cptr shm3=(lds_cptr)shm; const lds_cptr kp0=shm3+LDS_K+hi*1024+r32*16; const lds_cptr vp0=shm3+LDS_V+((lane>>4)&1)*32+(lane&3)*8+(4*hi+((lane&15)>>2))*64;
  DMA_K(0,0);DMA_V(0,0);DMA_K(1,SLOTB);
  bf16x8 qr[4];
  #pragma unroll
  for(int d0=0;d0<4;++d0)qr[d0]=*reinterpret_cast<const bf16x8*>(&Qw[(long)r32*qpitch+d0*16+hi*8]);
  float mhat=0.f,l_reg=0.f;f32x16 o[2];o[0]=f32x16{};o[1]=f32x16{};f32x16 negm=f32x16{};asm volatile("":"+v"(negm));
  #define CMASK(P0,P1,t) do{}while(0)
  bool resc=false;
  #define START(P0,P1) do{ const float rm=rowmax(P0,P1); resc=false; \
    { const float dl=rm; mhat=fadd_s(mhat,dl); \
      _Pragma("unroll") for(int r=0;r<16;++r){P0[r]=fsub_s(P0[r],dl);P1[r]=fsub_s(P1[r],dl);} \
      _Pragma("unroll") for(int r=0;r<16;++r)negm[r]=-mhat; asm volatile("":"+v"(negm)); } \
    _Pragma("unroll") for(int r=0;r<16;++r)P0[r]=__builtin_amdgcn_exp2f(P0[r]); }while(0)
  #define RESC() do{ if(resc){ asm volatile("s_waitcnt lgkmcnt(0)":::"memory"); \
      _Pragma("unroll") for(int d_=0;d_<2;++d_) _Pragma("unroll") for(int r=0;r<16;++r)o[d_][r]*=wsf[crow(r,hi)]; } }while(0)
  f32x16 pA0,pA1,pB0,pB1;
  int sl_prev=0,sl_cur=0,sl_next=SLOTB;
  #define ROT() do{sl_prev=sl_cur;sl_cur=sl_next;sl_next=(sl_next==(NSLOT-1)*SLOTB)?0:sl_next+SLOTB;}while(0)
  DMA_K(2,2*SLOTB);
  WAIT_BAR(3);
  qkt(pA0,pA1,Kbase,qr,negm,r32,hi);asm volatile("s_nop 15\n\ts_nop 7":"+v"(pA0),"+v"(pA1));CMASK(pA0,pA1,0);
  START(pA0,pA1);
  _Pragma("unroll") for(int r=0;r<16;++r)pA1[r]=__builtin_amdgcn_exp2f(pA1[r]);
  WAIT_BAR(0);
  DMA_K(3,0);DMA_V(1,SLOTB);
  ROT();
  kload8(kf,kp0+sl_cur);
  WAIT_BAR(2);
  s16x4 vlo[8],vhi[8]; u32x4 pw0,pw1,pw2,pw3;
  #define PKW(P,B) cvtpk_s(P[B],P[B+1])
  #define PAF(k) __builtin_bit_cast(bf16x8,pw##k)
  #define VFR(i) (bf16x8){vlo[i][0],vlo[i][1],vlo[i][2],vlo[i][3],vhi[i][0],vhi[i][1],vhi[i][2],vhi[i][3]}
  #define PIN(x) asm volatile("":"+v"(x))
  #define MX3(a,b,c) __builtin_fmaxf(__builtin_fmaxf((a),(b)),(c))
  #define GAPA(MF,A0,A1,A2,A3,W0,W1,PW) do{ MF; sacc+=A0; sacc+=A1; sacc+=A2; sacc+=A3; PIN(sacc); W0; W1; PIN(PW); SBAR(); }while(0)
  #define EX(v) __builtin_amdgcn_exp2f(v)
  #define GAPB(MF,X,B) do{ MF; X[B]=EX(X[B]); X[B+1]=EX(X[B+1]); X[B+2]=EX(X[B+2]); X[B+3]=EX(X[B+3]); PIN(X); SBAR(); }while(0)
  #define VRD(i) do{ vlo[i]=vtr(vp_+(((i)>>2)*4096+((i)&3)*1024)); vhi[i]=vtr(vp_+(((i)>>2)*4096+((i)&3)*1024+512)); }while(0)
  #define KRD(G,j) do{ if(G){ kload2(kf,kp0+sl_next,j); SBAR(); } }while(0)
  #define STEP(C0,C1,P0,P1,t,GK,GV,GL) do{ SBAR(); \
    const lds_cptr vp_=vp0+sl_prev; \
    VRD(0); SBAR(); float sacc=(P0[0]+P0[1]); \
    GAPA(C0=__builtin_amdgcn_mfma_f32_32x32x16_bf16(kf[0],qr[0],negm,0,0,0), P0[2],P0[3],P0[4],P0[5],     pw0[0]=PKW(P0,0), pw0[1]=PKW(P0,2), pw0); \
    VRD(4); SBAR(); GAPA(C1=__builtin_amdgcn_mfma_f32_32x32x16_bf16(kf[1],qr[0],negm,0,0,0), P0[6],P0[7],P0[8],P0[9],     pw0[2]=PKW(P0,4), pw0[3]=PKW(P0,6), pw0); \
    VRD(1); SBAR(); GAPA(C0=__builtin_amdgcn_mfma_f32_32x32x16_bf16(kf[2],qr[1],C0,0,0,0),   P0[10],P0[11],P0[12],P0[13], pw1[0]=PKW(P0,8), pw1[1]=PKW(P0,10), pw1); \
    VRD(5); SBAR(); GAPA(C1=__builtin_amdgcn_mfma_f32_32x32x16_bf16(kf[3],qr[1],C1,0,0,0),   P0[14],P0[15],P1[0],P1[1],   pw1[2]=PKW(P0,12),pw1[3]=PKW(P0,14), pw1); \
    VRD(2); SBAR(); GAPA(C0=__builtin_amdgcn_mfma_f32_32x32x16_bf16(kf[4],qr[2],C0,0,0,0),   P1[2],P1[3],P1[4],P1[5],     pw2[0]=PKW(P1,0), pw2[1]=PKW(P1,2), pw2); \
    VRD(6); SBAR(); GAPA(C1=__builtin_amdgcn_mfma_f32_32x32x16_bf16(kf[5],qr[2],C1,0,0,0),   P1[6],P1[7],P1[8],P1[9],     pw2[2]=PKW(P1,4), pw2[3]=PKW(P1,6), pw2); \
    VRD(3); SBAR(); GAPA(C0=__builtin_amdgcn_mfma_f32_32x32x16_bf16(kf[6],qr[3],C0,0,0,0),   P1[10],P1[11],P1[12],P1[13], pw3[0]=PKW(P1,8), pw3[1]=PKW(P1,10), pw3); \
    VRD(7); SBAR(); GAPA(C1=__builtin_amdgcn_mfma_f32_32x32x16_bf16(kf[7],qr[3],C1,0,0,0),   P1[14],P1[15],0.f,0.f,       pw3[2]=PKW(P1,12),pw3[3]=PKW(P1,14), pw3); \
    l_reg+=sacc; \
    if(GK){DMA_K((t)+3,sl_cur);} if(GV){DMA_V((t)+1,sl_next);} \
    CMASK(C0,C1,t); \
    { float a=MX3(C0[0],C0[1],C1[0]),b=MX3(C0[2],C0[3],C1[1]); a=MX3(a,C1[2],C1[3]); \
      _Pragma("unroll") for(int r=4;r<16;r+=4){a=MX3(a,C0[r],C0[r+1]);b=MX3(b,C0[r+2],C0[r+3]);a=MX3(a,C1[r],C1[r+1]);b=MX3(b,C1[r+2],C1[r+3]);} \
      float rm=__builtin_fmaxf(a,b); { auto rr=__builtin_amdgcn_permlane32_swap(__float_as_uint(rm),__float_as_uint(rm),false,false); rm=__builtin_fmaxf(__uint_as_float(rr[0]),__uint_as_float(rr[1])); } \
      resc=false; \
      if(__builtin_expect(__any(rm>(float)THRL),0)){ const float dl=__builtin_fmaxf(rm,0.f); mhat+=dl; \
        _Pragma("unroll") for(int r=0;r<16;++r){C0[r]-=dl;C1[r]-=dl;} \
        _Pragma("unroll") for(int r=0;r<16;++r)negm[r]=-mhat; asm volatile("":"+v"(negm)); \
        const float f=__builtin_amdgcn_exp2f(-dl); l_reg*=f; if(hi==0)wsf[r32]=f; resc=true; } } \
    SBAR(); \
    GAPB(o[0]=__builtin_amdgcn_mfma_f32_32x32x16_bf16(PAF(0),VFR(0),o[0],0,0,0), C0,0); \
    GAPB(o[1]=__builtin_amdgcn_mfma_f32_32x32x16_bf16(PAF(0),VFR(4),o[1],0,0,0), C0,4); \
    KRD(GL,0); GAPB(o[0]=__builtin_amdgcn_mfma_f32_32x32x16_bf16(PAF(1),VFR(1),o[0],0,0,0), C0,8); \
    KRD(GL,1); GAPB(o[1]=__builtin_amdgcn_mfma_f32_32x32x16_bf16(PAF(1),VFR(5),o[1],0,0,0), C0,12); \
    KRD(GL,2); GAPB(o[0]=__builtin_amdgcn_mfma_f32_32x32x16_bf16(PAF(2),VFR(2),o[0],0,0,0), C1,0); \
    KRD(GL,3); GAPB(o[1]=__builtin_amdgcn_mfma_f32_32x32x16_bf16(PAF(2),VFR(6),o[1],0,0,0), C1,4); \
    GAPB(o[0]=__builtin_amdgcn_mfma_f32_32x32x16_bf16(PAF(3),VFR(3),o[0],0,0,0), C1,8); \
    GAPB(o[1]=__builtin_amdgcn_mfma_f32_32x32x16_bf16(PAF(3),VFR(7),o[1],0,0,0), C1,12); \
    }while(0)
  int t=1;
  for(;t+5<NT;t+=2){
    STEP(pB0,pB1,pA0,pA1,t,true,true,true);     WAIT_BAR(2); RESC(); ROT();
    STEP(pA0,pA1,pB0,pB1,t+1,true,true,true);   WAIT_BAR(2); RESC(); ROT();
  }
  #define ENDW(tt) do{ if((tt)+3<NT){WAIT_BAR(2);} else if((tt)+2<NT){WAIT_BAR(1);} else {WAIT_BAR(0);} }while(0)
  for(;t+1<NT;t+=2){
    STEP(pB0,pB1,pA0,pA1,t,(t+3<NT),(t+1<NT),(t+1<NT));       ENDW(t);   RESC(); ROT();
    STEP(pA0,pA1,pB0,pB1,t+1,(t+4<NT),(t+2<NT),(t+2<NT));     ENDW(t+1); RESC(); ROT();
  }
  STEP(pB0,pB1,pA0,pA1,NT-1,false,false,false); RESC();
  { float sacc=pB0[0]+pB0[1]; _Pragma("unroll") for(int r=2;r<16;++r)sacc+=pB0[r]; _Pragma("unroll") for(int r=0;r<16;++r)sacc+=pB1[r]; l_reg+=sacc;
    pw0=(u32x4){PKW(pB0,0),PKW(pB0,2),PKW(pB0,4),PKW(pB0,6)};pw1=(u32x4){PKW(pB0,8),PKW(pB0,10),PKW(pB0,12),PKW(pB0,14)};pw2=(u32x4){PKW(pB1,0),PKW(pB1,2),PKW(pB1,4),PKW(pB1,6)};pw3=(u32x4){PKW(pB1,8),PKW(pB1,10),PKW(pB1,12),PKW(pB1,14)};
    SBAR(); pv(o,vb0+sl_cur,PAF(0),PAF(1),PAF(2),PAF(3)); }
  #undef PKW
  #undef PAF
  #undef VFR
  #undef PIN
  #undef MX3
  #undef GAPA
  #undef GAPB
  #undef EX
  #undef VRD
  #undef KRD
  #undef STEP
  #undef ENDW
  {auto rr=__builtin_amdgcn_permlane32_swap(__float_as_uint(l_reg),__float_as_uint(l_reg),false,false);l_reg=__uint_as_float(rr[0])+__uint_as_float(rr[1]);}
  if(hi==0)wsf[32+r32]=l_reg;asm volatile("s_waitcnt lgkmcnt(0)":::"memory");
  float rli[16];
  #pragma unroll
  for(int r=0;r<16;++r)rli[r]=__builtin_amdgcn_rcpf(wsf[32+crow(r,hi)]);
  bf16*Ow=Op+(long)(wid*QBLK)*opitch;
  { bf16*stg=(bf16*)(shm+LDS_OST)+wid*2048;
    #pragma unroll
    for(int r=0;r<16;++r){const int orow=crow(r,hi);
      #pragma unroll
      for(int d0=0;d0<2;++d0)stg[orow*64+d0*32+r32]=__float2bfloat16(o[d0][r]*rli[r]);}
    asm volatile("s_waitcnt lgkmcnt(0)":::"memory");
    #pragma unroll
    for(int i=0;i<4;++i){const int row=i*8+(lane>>3),ch=lane&7; const u32x4 v=*(const u32x4*)(stg+row*64+ch*8); ATTN_STORE16(Ow+(long)row*opitch+ch*8,v);} }
  asm volatile("s_waitcnt lgkmcnt(0)\n\ts_barrier":::"memory");
  #undef DMA_K
  #undef DMA_V
  #undef CMASK
  #undef START
  #undef RESC
  #undef ROT
}
constexpr int ATTN_LDS_BYTES=LDS_BYTES;
#undef SBAR
#undef WAIT_BAR
}


#define pMOD ((float*)(ws + WS_MOD))
#define pROPE ((float*)(ws + WS_ROPE))
#define pAFF ((float*)(ws + WS_AFF))
#define pINV ((int*)(ws + WS_INV))
#define pDT ((float*)(ws + WS_DT))
#define pSRC ((int*)(ws + WS_SRC))
#define pGV ((float*)(ws + WS_GV))
#define pSSQ ((float*)(ws + WS_SSQ))
#define pTOT ((float*)(ws + WS_TOT))
#define pX ((bf16_t*)(ws + WS_X))
#define pH ((bf16_t*)(ws + WS_H))
#define pYAB ((bf16_t*)(ws + WS_YAB))
#define pPA ((bf16_t*)(ws + WS_PA))
#define pPG ((unsigned char*)(ws + WS_PG))
#define pMRGB ((bf16_t*)(ws + WS_MRGB))
#define pY ((bf16_t*)(ws + WS_Y))
#define pXG ((bf16_t*)(ws + WS_XG))
#define pHID ((bf16_t*)(ws + WS_HID))
#define pYE ((bf16_t*)(ws + WS_YE))
#define pQN ((bf16_t*)(ws + WS_QN))
#define pKN ((bf16_t*)(ws + WS_KN))
#define pHIN ((bf16_t*)(ws + WS_HIN))
#define pXBC ((bf16_t*)(ws + WS_XBC))
#define pAU ((bf16_t*)(ws + WS_AU))
#define pSS ((float*)(ws + WS_S))
#define pYG ((bf16_t*)(ws + WS_YG))
#define pS5S ((float*)(ws + WS_S5S))
#define pYCD ((bf16_t*)(ws + WS_YCD))
constexpr int EW7_L0 = 1792, EW7_L1 = 2048, EW_SPLIT1 = EW7_L0 + 2688, EW_SPLIT2 = EW_SPLIT1 + 4480, EW1_SPLIT = 3072;
struct Args { const float* in[38]; float* out; unsigned char* ws; int ph_lo, ph_hi; };
constexpr int PH_PER_LAYER = 15, PH_FINAL = 2 * PH_PER_LAYER, PH_TOTAL = PH_FINAL + 1;

DI LayerIn layer_in(const Args& a, int L) {
    LayerIn P;
    P.norm_mix_g = a.in[6] + (size_t)L * 1024; P.norm_ffn_g = a.in[7] + (size_t)L * 1024;
    P.w_in = a.in[8] + (size_t)L * 1024 * NIN; P.q_norm_g = a.in[9] + L * 64; P.k_norm_g = a.in[10] + L * 64;
    P.ssd_conv_w = a.in[11] + L * 3 * 768; P.ssd_conv_b = a.in[12] + L * 768; P.ssd_dt_bias = a.in[13] + L * 16; P.ssd_a_log = a.in[14] + L * 16;
    P.ssd_d = a.in[15] + L * 8; P.ssd_norm_g = a.in[16] + L * 512;
    P.s5_lre = a.in[17] + L * 2 * 24 * 64; P.s5_lim = a.in[18] + L * 2 * 24 * 64; P.s5_lstep = a.in[19] + L * 48;
    P.s5_bre = a.in[20] + (size_t)L * 24 * 64 * 16; P.s5_bim = a.in[21] + (size_t)L * 24 * 64 * 16; P.s5_cre = a.in[22] + (size_t)L * 24 * 16 * 64; P.s5_cim = a.in[23] + (size_t)L * 24 * 16 * 64;
    P.s5_d = a.in[24] + L * 384; P.s5_wglu = a.in[25] + (size_t)L * 384 * 384; P.s5_bglu = a.in[26] + L * 384; P.sc_conv_w = a.in[27] + L * 3 * 384;
    P.w_br_attn = a.in[28] + (size_t)L * 512 * 1024; P.w_br_ssd = a.in[29] + (size_t)L * 512 * 1024; P.w_br_s5 = a.in[30] + (size_t)L * 384 * 1024; P.w_br_sc = a.in[31] + (size_t)L * 384 * 1024;
    P.w_out = a.in[32] + (size_t)L * 1024 * 1024; P.w_router = a.in[33] + (size_t)L * 1024 * 16;
    P.w_gate = a.in[34] + (size_t)L * 16 * 1024 * 1024; P.w_up = a.in[35] + (size_t)L * 16 * 1024 * 1024; P.w_down = a.in[36] + (size_t)L * 16 * 1024 * 1024;
    return P;
}

__global__ void __launch_bounds__(NWAVES * 64, 2) hybrid_fwd(Args args) {
    extern __shared__ __attribute__((aligned(16))) unsigned char lds_raw[];
    Frame F0;
#define F F0
    F.lds = (LAS unsigned char*)lds_raw;
    F.tid = threadIdx.x; F.lane = F.tid & 63; F.wave = __builtin_amdgcn_readfirstlane(F.tid >> 6);
    F.G = gridDim.x; { const int bx = blockIdx.x; F.vcu = (F.G % 8 == 0) ? (bx % 8) * (F.G / 8) + bx / 8 : bx; }
    F.gw = F.vcu * NWAVES + F.wave; F.NGW = F.G * NWAVES; F.bid = (int)blockIdx.x;
    unsigned char* ws = args.ws;
    volatile LAS unsigned* MISC = (volatile LAS unsigned*)(F.lds + LDSCTL_OFF);
    for (int u = F.tid; u < (LDS_BYTES - LDSCTL_OFF) / 4; u += NWAVES * 64) ((LAS unsigned*)(F.lds + LDSCTL_OFF))[u] = 0u;
    __syncthreads();
    XcdBarrier bar = xcd_barrier_post((unsigned*)(ws + WS_CTL) + CW_BAR, MISC + 8, (unsigned)gridDim.x);
    const int GH = (int)gridDim.x / 2; const bool chain = (int)blockIdx.x >= GH;
    XcdBarrier bar2 = bar; if (chain) bar2 = xcd_barrier_post((unsigned*)(ws + WS_CTL) + CW_BAR + XCD_BAR_WORDS, MISC + 10, (unsigned)((int)gridDim.x - GH));
    const int lo = args.ph_lo, hi = args.ph_hi;
#ifndef PH_MASK
#define PH_MASK 0xFFFF
#endif
#define IN(k) (lo <= (k) && (k) < hi)
#define INL(j) (((PH_MASK >> (j)) & 1) && IN(base + (j)))
#ifndef REPEAT_MASK
#define REPEAT_MASK 0
#endif
#define REP(j) for (int rep_ = 0; rep_ < 1 + ((REPEAT_MASK >> (j)) & 1); ++rep_)
#ifndef SP_AMP
#define SP_AMP 0
#endif
#ifndef SP_WG
#define SP_WG 0
#endif
#ifndef SP_MAXLO
#define SP_MAXLO 0
#define SP_MAXHI 0
#endif
#define PRESTAMP(k) do { if (SP_AMP && threadIdx.x == 0) { const unsigned t_ = (unsigned)__builtin_amdgcn_s_memrealtime(); if (blockIdx.x == SP_WG) MISC[128 + (k)] = t_; \
    if ((int)blockIdx.x >= SP_MAXLO && (int)blockIdx.x < SP_MAXHI) atomicMax((unsigned*)(ws + WS_CTL) + 32768 + (k), t_); } } while (0)
#define SEAM(k) do { if (IN((k) + 1)) xcd_barrier(bar); if (SP_AMP && blockIdx.x == SP_WG && threadIdx.x == 0) MISC[64 + (k)] = (unsigned)__builtin_amdgcn_s_memrealtime(); } while (0)
    if (SP_AMP && blockIdx.x == SP_WG && threadIdx.x == 0) MISC[63] = (unsigned)__builtin_amdgcn_s_memrealtime();

#undef F
#pragma unroll 1
    for (int L = 0; L < 2; ++L) {
        const int base = L * PH_PER_LAYER;
        if (hi <= base || lo >= base + PH_PER_LAYER) continue;
        const bool lastL = (L == 1);

        if (L == 0 && INL(0)) REP(0) { const LayerIn P = layer_in(args, L); Frame F = F0; F.tid = fresh_tid(); F.lane = F.tid & 63; if (rep_) xcd_barrier(bar);
#ifndef SUBREP_MOD
#define SUBREP_MOD 0
#endif
#ifndef SUBREP_S5
#define SUBREP_S5 0
#endif
#ifndef SUBREP_SW
#define SUBREP_SW 0
#endif
            prep_s5(F, P, ws);
            for (int q_ = 0; q_ <= SUBREP_MOD; ++q_) { prep_mod(F, args.in[1], args.in[3], args.in[4], args.in[5], pMOD, 96); prep_rope(F, pROPE, 96); }
            for (int q_ = 0; q_ <= SUBREP_SW; ++q_) prep_small_weights(F, P, ws, 0, 96);
            SEAM(base + 0);
        }
        if (INL(1)) REP(1) { const LayerIn P = layer_in(args, L); Frame F = F0; F.tid = fresh_tid(); F.lane = F.tid & 63; if (rep_) xcd_barrier(bar);
            if (L == 0) phase_norm1<false, 3>(F, L, args.in[0], args.in[2], pX, pH, pMOD, P.norm_mix_g, pINV, pYE, pY, 0); else phase_norm1<true, 2>(F, L, args.in[0], args.in[2], pX, pH, pMOD, P.norm_mix_g, pINV, pYE, pY, 0); SEAM(base + 1); }
        if (INL(2)) REP(2) { const LayerIn P = layer_in(args, L); Frame F = F0; F.tid = fresh_tid(); F.lane = F.tid & 63; if (rep_) xcd_barrier(bar);
            pg8::Gemm g{pH, (const bf16_t*)(ws + W_WIN), 1024, 1024, 1024};
            RowSkipOrder S; S.init(NPROJ, F.G, (int)blockIdx.x, lastL ? 1 : 0, 2, 10);
            EpiProj E{pPA, PA_W, PA_W / 256, pPG, pAU};
            pg8::gemm_phase<EpiProj, RowSkipOrder>(F.lds, g, S, E);
            SEAM(base + 2);
        }
        if (INL(3)) REP(3) { const LayerIn P = layer_in(args, L); Frame F = F0; F.tid = fresh_tid(); F.lane = F.tid & 63; if (rep_) xcd_barrier(bar); phase_elem(F, P, pPA, pROPE, pQN, pKN, pXBC, pDT, pAU, pYCD); SEAM(base + 3); }
        if (INL(4)) { const LayerIn P = layer_in(args, L); Frame F = F0; F.tid = fresh_tid(); F.lane = F.tid & 63;
            if (!chain) {
                using abf = attn_body::bf16;
                const int a = (int)blockIdx.x, av = (GH % 8 == 0) ? (a % 8) * (GH / 8) + a / 8 : a;
                { pg8::Gemm g{pAU, (const bf16_t*)(ws + W_P), 768, 512, 512}; OrderS5S S{GH, (a + GH - 56) % GH}; EpiS5S E{pS5S};
                  pg8::gemm_phase<EpiS5S, OrderS5S>(F.lds, g, S, E);
                  if (((a + GH - 56) % GH) < 72) { asm volatile("s_waitcnt vmcnt(0)" ::: "memory"); __syncthreads();
                      if (F.tid == 0) { __builtin_amdgcn_fence(__ATOMIC_RELEASE, "agent"); asm volatile("s_waitcnt vmcnt(0)" ::: "memory"); (void)xb_add((unsigned*)(ws + WS_CTL) + CW_S5CNT + 64 * L, 1u); } } }
                for (int u = av; u < 512; u += GH) { const int bk = u >> 5, r = u & 31, b = bk >> 1, kvh = bk & 1, h = kvh * 4 + (r >> 3), qb = r & 7;
                    const size_t qrow = (size_t)b * PB + CTXL + qb * 256, krow = (size_t)b * PB;
                    attn_body::attn_unit<8>((const abf*)(pQN + qrow * 512 + h * 64), 512, (const abf*)(pKN + krow * 128 + kvh * 64), 128, (const abf*)(pPA + krow * PA_W + C_V + kvh * 64), PA_W,
                                            (abf*)(pYAB + qrow * 1024 + h * 64), 1024, 36, (char*)lds_raw); }
                if (!lastL) for (int u = av; u < 64; u += GH) { const int b = u >> 3, h = u & 7, kvh = h >> 2; const size_t krow = (size_t)b * PB;
                    attn_body::attn_unit<8>((const abf*)(pQN + krow * 512 + h * 64), 512, (const abf*)(pKN + krow * 128 + kvh * 64), 128, (const abf*)(pPA + krow * PA_W + C_V + kvh * 64), PA_W,
                                            (abf*)(pYAB + krow * 1024 + h * 64), 1024, 4, (char*)lds_raw); }
            } else {
                const int GC = F.G - GH, rk = (int)blockIdx.x - GH;
                Frame Fc = F; Fc.G = GC; Fc.bid = rk; Fc.vcu = (GC % 8 == 0) ? (rk % 8) * (GC / 8) + rk / 8 : rk; Fc.gw = Fc.vcu * NWAVES + F.wave; Fc.NGW = GC * NWAVES;
                ssd_chunk_states(Fc, P, pXBC, pDT, pSS, pTOT);
                xcd_barrier(bar2);
                ssd_recurrence(Fc, pSS, pTOT, pHIN);
                { if (F.tid == 0) { unsigned* cw = (unsigned*)(ws + WS_CTL) + CW_S5CNT + 64 * L; unsigned sp = 0;
                      while (xb_ld(cw) < 72u) { __builtin_amdgcn_s_sleep(1); if (++sp > (1u << 22)) break; }
                      __builtin_amdgcn_fence(__ATOMIC_ACQUIRE, "agent"); asm volatile("s_waitcnt vmcnt(0)" ::: "memory"); }
                  __syncthreads(); }
                s5_recurrence(Fc, P, pS5S, pAU);
                xcd_barrier(bar2);
                ssd_output(Fc, P, pXBC, pPA, pDT, pHIN, pYAB, pSSQ, lastL);
                { pg8::Gemm g{pAU, (const bf16_t*)(ws + W_TQ), 768, 768, 768}; OrderS5Y S{GC, (rk + GC - 32) % GC}; EpiS5Y E{pAU, pYG, P.s5_d};
                  pg8::gemm_phase<EpiS5Y, OrderS5Y>(F.lds, g, S, E); }
            }
            PRESTAMP(base + 6); SEAM(base + 6);
        }
        if (INL(7)) REP(7) { const LayerIn P = layer_in(args, L); Frame F = F0; F.tid = fresh_tid(); F.lane = F.tid & 63; if (rep_) xcd_barrier(bar);
            pg8::Gemm g{pYG, (const bf16_t*)(ws + W_GLU), 384, 384, 384};
            RowSkipOrder S; S.init(512, F.G, (int)blockIdx.x, lastL ? 1 : 0, 0, 0);
            EpiGlu E{pYG, pYCD, P.s5_bglu};
            pg8::gemm_phase<EpiGlu, RowSkipOrder>(F.lds, g, S, E);
            if (!lastL) prep_expert_weights(F, P, ws, 144, 0, EW7_L0); else prep_expert_weights(F, P, ws, 128, 2 * 4096, 2 * 4096 + EW7_L1);
            SEAM(base + 7);
        }
        if (INL(8)) REP(8) { const LayerIn P = layer_in(args, L); Frame F = F0; F.tid = fresh_tid(); F.lane = F.tid & 63; if (rep_) xcd_barrier(bar);
            MergeOrder S; S.init(F.G, (int)blockIdx.x, lastL ? 1 : 0);
            pg8::MergeArgs MA{pYAB, pYCD, (const bf16_t*)(ws + W_BR4), pPG, pSSQ, pMRGB};
            pg8::gemm_merge_phase<MergeOrder>(F.lds, MA, S);
            if (!lastL) { __syncthreads(); const LayerIn P1 = layer_in(args, 1); prep_s5(F, P1, ws, 64); __syncthreads(); prep_expert_weights(F, P, ws, 160, EW7_L0, EW_SPLIT1); }
            SEAM(base + 8);
        }
        if (INL(9)) REP(9) { const LayerIn P = layer_in(args, L); Frame F = F0; F.tid = fresh_tid(); F.lane = F.tid & 63; if (rep_) xcd_barrier(bar);
            pg8::Gemm g{pMRGB, (const bf16_t*)(ws + W_OUT), 1024, 1024, 1024};
            RowSkipOrder S; S.init(1024, F.G, (int)blockIdx.x, lastL ? 1 : 0, 0, 0);
            EpiWout E{pY};
            pg8::gemm_phase<EpiWout, RowSkipOrder>(F.lds, g, S, E);
            if (!lastL) { __syncthreads(); const LayerIn P1 = layer_in(args, 1); prep_small_weights(F, P1, ws, 1, 32); prep_expert_weights(F, P, ws, 32, EW_SPLIT1, EW_SPLIT2); }
            SEAM(base + 9);
        }
        if (INL(10)) REP(10) { const LayerIn P = layer_in(args, L); Frame F = F0; F.tid = fresh_tid(); F.lane = F.tid & 63; if (rep_) xcd_barrier(bar); phase_norm2<3>(F, L, lastL, args.in[0], args.in[2], pX, pY, pH, pMOD, P.norm_ffn_g, P.w_router, pAFF); SEAM(base + 10); }
        if (INL(11)) REP(11) { const LayerIn P = layer_in(args, L); Frame F = F0; F.tid = fresh_tid(); F.lane = F.tid & 63; if (rep_) xcd_barrier(bar); phase_topk(F, lastL ? 128 : 256, pAFF, pSRC, pGV, pINV);
            if (L == 0) { const LayerIn P1 = layer_in(args, 1); prep_small_weights(F, P1, ws, 2, 0); }
            prep_expert_weights(F, P, ws, (L == 0) ? 0 : 128, (L == 0) ? EW_SPLIT2 : 2 * 4096 + EW7_L1, EXPERT_W_ITEMS); SEAM(base + 12); }
        if (INL(13)) REP(13) { const LayerIn P = layer_in(args, L); Frame F = F0; F.tid = fresh_tid(); F.lane = F.tid & 63; if (rep_) xcd_barrier(bar);
            pg8::Gemm g{pH, lastL ? (const bf16_t*)args.out : (const bf16_t*)(ws + WS_WGU), 1024, 1024, 1024}; OrderUp S{F.G, (int)blockIdx.x, lastL ? 8 : 9}; EpiUp E{pHID};
            pg8::gemm_phase_gather<EpiUp, OrderUp>(F.lds, g, pSRC, S, E);
            if (!lastL) { __syncthreads(); const LayerIn P1 = layer_in(args, 1); prep_expert_weights(F, P1, ws, 128, 0, EW1_SPLIT, (bf16_t*)args.out); }
            SEAM(base + 13);
        }
        if (INL(14)) REP(14) { const LayerIn P = layer_in(args, L); Frame F = F0; F.tid = fresh_tid(); F.lane = F.tid & 63; if (rep_) xcd_barrier(bar);
            pg8::Gemm g{pHID, (const bf16_t*)(ws + WS_WD), 1024, 1024, 1024}; OrderDown S{F.G, (int)blockIdx.x, lastL ? 8 : 9}; EpiDown E{pYE, pGV};
            pg8::gemm_phase<EpiDown, OrderDown>(F.lds, g, S, E);
            if (!lastL) { __syncthreads(); const LayerIn P1 = layer_in(args, 1); prep_expert_weights(F, P1, ws, 64, EW1_SPLIT, 2 * 4096, (bf16_t*)args.out); }
            SEAM(base + 14);
        }
    }
#if E3_PROBE
    if (blockIdx.x == 0 && threadIdx.x == 0) { const unsigned long long t0_ = __builtin_amdgcn_s_memrealtime(), w_ = 20ull * g_probe_ticks; while (__builtin_amdgcn_s_memrealtime() - t0_ < w_) __builtin_amdgcn_s_sleep(8); g_probe_ticks = 0; }
    __syncthreads();
#endif
#if SP_AMP
    if (blockIdx.x == SP_WG && threadIdx.x == 0) {
#ifdef SP_MAXK
        unsigned w_ = __hip_atomic_load((unsigned*)(ws + WS_CTL) + 32768 + SP_MAXK, __ATOMIC_RELAXED, __HIP_MEMORY_SCOPE_AGENT) - MISC[64 + SP_A];
#else
        unsigned w_ = MISC[64 + SP_B] - MISC[64 + SP_A];
#endif
#ifdef SP_B2
        w_ += MISC[64 + SP_B2] - MISC[64 + SP_A2];
#endif
        const unsigned long long t0_ = __builtin_amdgcn_s_memrealtime(), ww_ = (unsigned long long)SP_AMP * w_; while (__builtin_amdgcn_s_memrealtime() - t0_ < ww_) __builtin_amdgcn_s_sleep(8); }
    __syncthreads();
#endif
#ifdef EXTRA_BARRIERS
    for (int eb = 0; eb < EXTRA_BARRIERS; ++eb) xcd_barrier(bar);
#endif
    if (IN(PH_FINAL)) { Frame F = F0; F.tid = fresh_tid(); F.lane = F.tid & 63; phase_final<2>(F, pX, args.out, pMOD, args.in[37], pINV, pYE, pY); }
#undef IN
#undef INL
#undef SEAM
}

#ifndef MK_N_LAUNCHES
#define MK_N_LAUNCHES 1
#endif
extern "C" void kernel_launch(void* const* d_in, const int* in_sizes, int n_in, void* d_out, int out_size, void* d_ws, size_t ws_size, hipStream_t stream) {
    static int grid = 0;
    if (grid == 0) {
        if (n_in != 38 || ws_size < WS_END) { fprintf(stderr, "kernel_launch: unexpected inputs (n_in %d, ws %zu)\n", n_in, ws_size); grid = -1; return; }
        int dev = 0, cus = 0;
        if (hipGetDevice(&dev) != hipSuccess || hipDeviceGetAttribute(&cus, hipDeviceAttributeMultiprocessorCount, dev) != hipSuccess) { grid = -1; return; }
        if (hipFuncSetAttribute((const void*)hybrid_fwd, hipFuncAttributeMaxDynamicSharedMemorySize, LDS_BYTES) != hipSuccess) { fprintf(stderr, "kernel_launch: hipFuncSetAttribute failed\n"); grid = -1; return; }
        (void)hipGetLastError();
        grid = (cus / 8) * 8;
        if (grid > 256) grid = 256;
    }
    if (grid < 0) return;
    if (hipMemsetAsync((char*)d_ws + WS_CTL, 0, CTL_ZERO_BYTES, stream) != hipSuccess) return;
    Args a{};
    for (int i = 0; i < 38; ++i) a.in[i] = (const float*)d_in[i];
    a.out = (float*)d_out; a.ws = (unsigned char*)d_ws;
#if MK_N_LAUNCHES == 1
    a.ph_lo = 0; a.ph_hi = PH_TOTAL;
    hipLaunchKernelGGL(hybrid_fwd, dim3(grid), dim3(NWAVES * 64), LDS_BYTES, stream, a);
#else
    for (int p = 0; p < PH_TOTAL; ++p) { a.ph_lo = p; a.ph_hi = p + 1; hipLaunchKernelGGL(hybrid_fwd, dim3(grid), dim3(NWAVES * 64), LDS_BYTES, stream, a); }
#endif
}
```

```cpp
#include <hip/hip_runtime.h>
#include <hip/hip_bf16.h>
#include <cstdio>
#include <cstdint>
#include <cmath>

#define DI __device__ __forceinline__
#define GAS __attribute__((address_space(1)))
#define LAS __attribute__((address_space(3)))
typedef unsigned short bf16_t;
typedef short bf16x8 __attribute__((ext_vector_type(8)));
typedef short s16x4 __attribute__((ext_vector_type(4)));
typedef float f32x2 __attribute__((ext_vector_type(2)));
typedef float f32x4 __attribute__((ext_vector_type(4)));
typedef float f32x16 __attribute__((ext_vector_type(16)));
typedef unsigned u32x2 __attribute__((ext_vector_type(2)));
typedef unsigned u32x4 __attribute__((ext_vector_type(4)));
typedef GAS unsigned gu32;

constexpr int DM = 1024, NB = 8, SEQ = 2048, CTXL = 256, PB = 2304, MROWS = NB * PB;
constexpr int NIN = 7688, NE = 16, EFF = 1024;
constexpr int C_Q = 0, C_K = 512, C_V = 640, C_Z = 768, C_XBC = 1280, C_DT = 2048, C_U = 2056, C_SB = 2440, C_SG = 2824, C_SH = 3208, C_G = 3592;
constexpr int PA_W = 3840, PG_W = 4096, NPROJ = PA_W + PG_W;
constexpr int EROWS = 2304;
constexpr float RMS_EPS = 1e-6f;
constexpr float ATT_C2 = 0.125f * 1.4426950408889634f;

constexpr size_t MiB = 1u << 20;
constexpr size_t WS_CTL = 0, CTL_ZERO_BYTES = 1 * MiB;
constexpr size_t WS_MOD = 1 * MiB;
constexpr size_t WS_ROPE = WS_MOD + 512 * 1024;
constexpr size_t WS_AFF = 2 * MiB;
constexpr size_t WS_INV = WS_AFF + 1280 * 1024;
constexpr size_t WS_DT = WS_INV + 1280 * 1024;
constexpr size_t WS_SRC = WS_DT + 1280 * 1024;
constexpr size_t WS_GV = WS_SRC + 256 * 1024;
constexpr size_t WS_SSQ = WS_GV + 256 * 1024;
constexpr size_t WS_TOT = WS_SSQ + 256 * 1024;
constexpr size_t WS_X = 8 * MiB;
constexpr size_t WS_W = 80 * MiB;
constexpr size_t W_WIN = WS_W;
constexpr size_t W_BR4 = W_WIN + (size_t)NPROJ * 1024 * 2;
constexpr size_t W_OUT = W_BR4 + (size_t)1024 * 1792 * 2;
constexpr size_t W_GLU = W_OUT + 1024 * 1024 * 2;
constexpr size_t W_TQ = W_GLU + 512 * 384 * 2;
constexpr size_t W_P = W_TQ + (size_t)24 * 512 * 768 * 2;
constexpr size_t W_END = W_P + (size_t)24 * 256 * 512 * 2;
constexpr size_t WS_H = 126 * MiB;
constexpr size_t WS_YAB = WS_H;
constexpr size_t WS_PA = 162 * MiB;
constexpr size_t WS_MRGB = WS_PA, WS_XG = WS_PA, WS_Y = WS_PA + 72 * MiB;
constexpr size_t WS_PG = 297 * MiB;
constexpr size_t WS_HID = WS_PG, WS_YE = WS_PG + 72 * MiB;
constexpr size_t WS_R5 = 441 * MiB;
constexpr size_t WS_QN = WS_R5;
constexpr size_t WS_KN = WS_R5 + 18 * MiB;
constexpr size_t WS_HIN = WS_PG + 72 * MiB;
constexpr size_t WS_XBC = WS_R5 + 22 * MiB + 512 * 1024;
constexpr size_t WS_AU = WS_R5 + 49 * MiB + 512 * 1024;
constexpr size_t WS_S = WS_R5 + 70 * MiB;
constexpr size_t WS_YG = WS_S;
constexpr size_t WS_S5S = WS_R5 + 106 * MiB;
constexpr size_t WS_YCD = WS_S5S + 13 * MiB + 512 * 1024;
constexpr size_t WS_WGU = WS_R5;
constexpr size_t WS_WD1 = WS_X + 36 * MiB;
constexpr size_t WS_WD = WS_PA + 36 * MiB;
constexpr size_t WS_END = WS_YCD + 27 * MiB;
static_assert(W_END <= WS_H, "small weights fit");
static_assert(WS_AU + (size_t)24 * 576 * 768 * 2 <= WS_S && WS_XBC + (size_t)MROWS * 768 * 2 <= WS_AU && WS_S + (size_t)8 * 18 * 16 * 4096 * 4 <= WS_S5S, "R5 map");
static_assert(WS_X + (size_t)MROWS * 1024 * 2 <= WS_WD1 && WS_WD1 + (size_t)32 * MiB <= WS_W, "stream / layer-1 down weights");
static_assert(WS_S5S + (size_t)24 * 576 * 256 * 4 <= WS_YCD && WS_YCD + (size_t)MROWS * 768 * 2 <= WS_END && WS_WD + (size_t)32 * MiB <= WS_Y && WS_MRGB + (size_t)MROWS * 1024 * 2 <= WS_WD && WS_WGU + (size_t)64 * MiB <= WS_S && WS_END <= (size_t)588 * MiB, "R5 map 2");
static_assert(WS_TOT + 16384 <= WS_X && WS_ROPE + 2048 * 64 * 4 <= WS_AFF, "misc map");

constexpr int CW_BAR = 4096;
constexpr int CW_S5CNT = 16384;

constexpr int NWAVES = 8;
constexpr int LDS_SCRATCH = 151552;
constexpr int LDSCTL_OFF = LDS_SCRATCH;
constexpr int LDS_BYTES = 155648;

#define LDS_WAIT() asm volatile("s_waitcnt lgkmcnt(0)" ::: "memory")
#define VM_WAIT() asm volatile("s_waitcnt vmcnt(0)" ::: "memory")
DI int fresh_tid() { int t = threadIdx.x; asm volatile("" : "+v"(t)); return t; }
DI unsigned f2bf(float f) { unsigned u = __builtin_bit_cast(unsigned, f); return (u + 0x7fffu + ((u >> 16) & 1u)) >> 16; }
DI unsigned pk2(float lo, float hi) { typedef __bf16 bf2_t __attribute__((ext_vector_type(2))); f32x2 v = {lo, hi}; bf2_t b = __builtin_convertvector(v, bf2_t); return __builtin_bit_cast(unsigned, b); }
DI float bflo(unsigned w) { return __builtin_bit_cast(float, w << 16); }
DI float bfhi(unsigned w) { return __builtin_bit_cast(float, w & 0xffff0000u); }
DI float bf2f(bf16_t h) { return __builtin_bit_cast(float, (unsigned)h << 16); }
DI float silu_f(float x) { return x * __builtin_amdgcn_rcpf(1.f + __expf(-x)); }
DI float sigmoid_f(float x) { return __builtin_amdgcn_rcpf(1.f + __expf(-x)); }
DI float softplus_f(float x) { const float e = __expf(-fabsf(x)); const float l = (e < 1e-3f) ? e * (1.f - 0.5f * e) : __logf(1.f + e); return fmaxf(x, 0.f) + l; }
DI float gelu_tanh_f(float x) { const float u = 0.7978845608028654f * (x + 0.044715f * x * x * x); const float t = 1.f - 2.f * __builtin_amdgcn_rcpf(__expf(2.f * u) + 1.f); return 0.5f * x * (1.f + t); }
DI int lane_op() { int l = (int)__builtin_amdgcn_mbcnt_hi(~0u, __builtin_amdgcn_mbcnt_lo(~0u, 0u)); asm volatile("" : "+v"(l)); return l; }
DI float shx(float v, int m, int l) { return __builtin_bit_cast(float, __builtin_amdgcn_ds_bpermute((l ^ m) << 2, __builtin_bit_cast(int, v))); }
DI float shup(float v, int d, int l) { return __builtin_bit_cast(float, __builtin_amdgcn_ds_bpermute(((l >= d) ? l - d : l) << 2, __builtin_bit_cast(int, v))); }
DI int shup(int v, int d, int l) { return __builtin_amdgcn_ds_bpermute(((l >= d) ? l - d : l) << 2, v); }
DI float shidx(float v, int src) { return __builtin_bit_cast(float, __builtin_amdgcn_ds_bpermute(src << 2, __builtin_bit_cast(int, v))); }
DI float wave_sum(float v) {
#pragma unroll
    for (int o = 1; o < 64; o <<= 1) v += __shfl_xor(v, o);
    return v;
}
DI void unpack8(const u32x4 w, float (&f)[8]) {
    f[0] = bflo(w.x); f[1] = bfhi(w.x); f[2] = bflo(w.y); f[3] = bfhi(w.y); f[4] = bflo(w.z); f[5] = bfhi(w.z); f[6] = bflo(w.w); f[7] = bfhi(w.w);
}
DI u32x4 pack8(const float (&f)[8]) { u32x4 w; w.x = pk2(f[0], f[1]); w.y = pk2(f[2], f[3]); w.z = pk2(f[4], f[5]); w.w = pk2(f[6], f[7]); return w; }

#define XB_TMO      128
#define XB_XCNT(j)  (256  + 64 * (j))
#define XB_XSUB(j)  (1280 + 64 * (j))
#define XB_XGEN(j)  (2304 + 64 * (j))
#define XB_TOP      3328
#define XB_TOPGEN   3392
#define XCD_BAR_WORDS 3456
#define XB_SPIN_CAP (1u << 20)
DI unsigned xb_ld(unsigned* p)              { return __hip_atomic_load(p, __ATOMIC_RELAXED, __HIP_MEMORY_SCOPE_AGENT); }
DI unsigned xb_add(unsigned* p, unsigned v) { return __hip_atomic_fetch_add(p, v, __ATOMIC_RELAXED, __HIP_MEMORY_SCOPE_AGENT); }
DI unsigned xb_xcc_id() { return (unsigned)__builtin_amdgcn_s_getreg((3 << 11) | 20) & 0xFu; }
#define XB_SPIN(cond, bar) do { unsigned _sp = 0; while (cond) { __builtin_amdgcn_s_sleep(1); \
    if ((++_sp & 255u) == 0u) { if (xb_ld(&(bar)[XB_TMO])) break; if (_sp > XB_SPIN_CAP) { atomicAdd(&(bar)[XB_TMO], 1u); break; } } } } while (0)
struct XcdBarrier { unsigned* bar; unsigned x; volatile LAS unsigned* st; unsigned G; };
DI XcdBarrier xcd_barrier_post(unsigned* bar, volatile LAS unsigned* st, unsigned G) {
    XcdBarrier b; b.bar = bar; b.x = xb_xcc_id(); b.st = st; b.G = G;
    if (threadIdx.x == 0) (void)xb_add(&bar[XB_XCNT(b.x)], 1u);
    return b;
}
DI void xcd_barrier_complete(unsigned* bar, unsigned x, unsigned& nloc, unsigned& nx, unsigned G) {
    unsigned sum, cnt, mine, sp = 0u;
    for (;;) {
        sum = 0u; cnt = 0u; mine = 0u;
#pragma unroll
        for (unsigned j = 0; j < 16; ++j) { const unsigned c = xb_ld(&bar[XB_XCNT(j)]); sum += c; cnt += (c > 0u) ? 1u : 0u; mine = (j == x) ? c : mine; }
        if (sum == G) break;
        __builtin_amdgcn_s_sleep(1);
        if ((++sp & 255u) == 0u) { if (xb_ld(&bar[XB_TMO])) break; if (sp > XB_SPIN_CAP) { atomicAdd(&bar[XB_TMO], 1u); break; } }
    }
    nloc = mine > 0u ? mine : 1u; nx = cnt > 0u ? cnt : 1u;
}
DI void xcd_barrier(const XcdBarrier& b) {
    asm volatile("s_waitcnt vmcnt(0)" ::: "memory");
    __syncthreads();
    if (threadIdx.x == 0) {
        unsigned* bar = b.bar;
        asm volatile("" : "+s"(bar));
        __builtin_amdgcn_s_waitcnt(0);
        unsigned nloc = b.st[0], nx = b.st[1];
        if (nloc == 0u) { xcd_barrier_complete(bar, b.x, nloc, nx, b.G); b.st[0] = nloc; b.st[1] = nx; }
        const unsigned old = xb_add(&bar[XB_XSUB(b.x)], 1u);
        const unsigned gen = old / nloc;
        if (old + 1u == (gen + 1u) * nloc) {
#ifndef NO_RELEASE_PROBE
            __builtin_amdgcn_fence(__ATOMIC_RELEASE, "agent");
#endif
            asm volatile("s_waitcnt vmcnt(0)" ::: "memory");
            const unsigned og = xb_add(&bar[XB_TOP], 1u);
            const unsigned tg = og / nx;
            if (og + 1u == (tg + 1u) * nx) xb_add(&bar[XB_TOPGEN], 1u);
            else XB_SPIN(xb_ld(&bar[XB_TOPGEN]) == tg, bar);
            __builtin_amdgcn_fence(__ATOMIC_ACQUIRE, "agent");
            asm volatile("s_waitcnt vmcnt(0)" ::: "memory");
        } else {
            XB_SPIN(xb_ld(&bar[XB_TOPGEN]) == gen, bar);
            __builtin_amdgcn_fence(__ATOMIC_ACQUIRE, "agent");
            asm volatile("s_waitcnt vmcnt(0)" ::: "memory");
        }
    }
    __syncthreads();
}

namespace pg8 {
constexpr int BM = 256, BK = 64, HALF = 128, HTB = HALF * BK * 2, STAGE_BYTES = 8 * HTB, NXCD = 8, WGM = 8;
__host__ __device__ __forceinline__ int lds_byte(int r, int c) { const int st = (r >> 4) * 2 + (c >> 5), rr = r & 15, cc = c & 31, ob = rr * 64 + cc * 2; return st * 1024 + (ob ^ (((ob >> 9) & 1) << 5)); }
__host__ __device__ __forceinline__ void stage_rc(int b, int& R, int& C) { const int st = b / 1024, sb = b % 1024, swz = sb ^ (((sb >> 9) & 1) << 5); R = (st >> 1) * 16 + swz / 64; C = (st & 1) * 32 + (swz % 64) / 2; }
__host__ __device__ __forceinline__ int perm32(int rho) { const int n = rho >> 4, i = rho & 15; return 8 * (i >> 2) + 4 * n + (i & 3); }

struct Unit { int arow, brow, pm, pn; };
struct Gemm { const bf16_t* A; const bf16_t* Bt; int lda, ldb, K; };

template <class Epi, class Sched, bool ALIGN_EPI = true>
DI void gemm_phase(LAS unsigned char* lds, const Gemm g, const Sched& S, const Epi& E) {
    const int tid = fresh_tid(), wid = __builtin_amdgcn_readfirstlane(tid >> 6), lane = tid & 63, wr = wid >> 2, wc = wid & 3, fr = lane & 15, fq = lane >> 4;
    const int K = g.K, nt = K / BK;
    unsigned voffA[2], voffB[2];
#pragma unroll
    for (int i = 0; i < 2; ++i) { int R, C; stage_rc(tid * 16 + i * 8192, R, C); const int Rb = Epi::PERM ? ((R & ~31) + perm32(R & 31)) : R;
        voffA[i] = (unsigned)(R * g.lda + C) * 2u; voffB[i] = (unsigned)(Rb * g.ldb + C) * 2u; }
    const size_t kstep = (size_t)(BK * 2);
    const size_t hA = (size_t)HALF * g.lda * 2, hB = (size_t)HALF * g.ldb * 2;
    const unsigned ldsw = (unsigned)wid * 1024u;
    const int aoff = lds_byte(wr * 64 + fr, fq * 8), boff = lds_byte(wc * 32 + fr, fq * 8);
#define PG8_SA(b, h) (((b) * 2 + (h)) * HTB)
#define PG8_SB(b, h) ((4 + (b) * 2 + (h)) * HTB)
#define PG8_STAGE(bufoff, gbase, voff) do { _Pragma("unroll") for (int _i = 0; _i < 2; ++_i) \
        __builtin_amdgcn_global_load_lds((const unsigned*)((const char*)(gbase) + (voff)[_i]), (LAS unsigned*)(lds + (bufoff) + ldsw + _i * 8192), 16, 0, 0); } while (0)
#define PG8_LDA(dst, b, h) do { _Pragma("unroll") for (int m = 0; m < 4; ++m) _Pragma("unroll") for (int k = 0; k < 2; ++k) dst[m][k] = *(const LAS bf16x8*)(lds + PG8_SA(b, h) + aoff + m * 2048 + k * 1024); } while (0)
#define PG8_LDB(dst, b, h) do { _Pragma("unroll") for (int n = 0; n < 2; ++n) _Pragma("unroll") for (int k = 0; k < 2; ++k) dst[n][k] = *(const LAS bf16x8*)(lds + PG8_SB(b, h) + boff + n * 2048 + k * 1024); } while (0)
#define PG8_MMA(ai, bj, At, Bt) do { __builtin_amdgcn_s_setprio(1); _Pragma("unroll") for (int m = 0; m < 4; ++m) _Pragma("unroll") for (int n = 0; n < 2; ++n) _Pragma("unroll") for (int k = 0; k < 2; ++k) \
        acc[ai][bj][m][n] = __builtin_amdgcn_mfma_f32_16x16x32_bf16(Bt[n][k], At[m][k], acc[ai][bj][m][n], 0, 0, 0); __builtin_amdgcn_s_setprio(0); } while (0)
#define PG8_WAIT_V(n) asm volatile("s_waitcnt vmcnt(" #n ")" ::: "memory")
#define PG8_WAIT_L(n) asm volatile("s_waitcnt lgkmcnt(" #n ")" ::: "memory")
#define PG8_BAR __builtin_amdgcn_s_barrier()
#define PG8_SCHED __builtin_amdgcn_sched_barrier(0)
    int ui = 0;
    Unit cur = S.next(0);
    if (cur.arow < 0) return;
    f32x4 acc[2][2][4][2];
#pragma unroll
    for (int a = 0; a < 2; ++a)
#pragma unroll
        for (int b = 0; b < 2; ++b)
#pragma unroll
            for (int m = 0; m < 4; ++m)
#pragma unroll
                for (int n = 0; n < 2; ++n) acc[a][b][m][n] = (f32x4){0.f, 0.f, 0.f, 0.f};
    bf16x8 At[4][2], B0[2][2], B1[2][2];
    const char* cA = (const char*)g.A + (size_t)cur.arow * g.lda * 2; const char* cB = (const char*)g.Bt + (size_t)cur.brow * g.ldb * 2;
    PG8_STAGE(PG8_SB(0, 0), cB, voffB); PG8_STAGE(PG8_SB(0, 1), cB + hB, voffB); PG8_STAGE(PG8_SA(0, 0), cA, voffA); PG8_STAGE(PG8_SA(0, 1), cA + hA, voffA);
    if (wr == 1) PG8_BAR;
    PG8_WAIT_V(2); PG8_BAR;
    PG8_STAGE(PG8_SB(1, 0), cB + kstep, voffB); PG8_STAGE(PG8_SA(1, 0), cA + kstep, voffA); PG8_STAGE(PG8_SB(1, 1), cB + hB + kstep, voffB);
    PG8_WAIT_V(6); PG8_BAR;
    for (;;) {
        const Unit nxt = S.next(ui + 1);
        const bool has_next = nxt.arow >= 0;
        const char* nA = has_next ? (const char*)g.A + (size_t)nxt.arow * g.lda * 2 : cA; const char* nB = has_next ? (const char*)g.Bt + (size_t)nxt.brow * g.ldb * 2 : cB;
#pragma unroll 1
        for (int t = 0; t < nt; t += 2) {
            const bool last = (t == nt - 2);
            const char* a1 = cA + (size_t)(t + 1) * kstep;
            const char* a2 = last ? nA : cA + (size_t)(t + 2) * kstep; const char* b2 = last ? nB : cB + (size_t)(t + 2) * kstep;
            const char* a3 = a2 + kstep; const char* b3 = b2 + kstep;
            PG8_LDB(B0, 0, 0); PG8_LDB(B1, 0, 1); PG8_SCHED; PG8_LDA(At, 0, 0); PG8_STAGE(PG8_SA(1, 1), a1 + hA, voffA);
            PG8_WAIT_V(8); PG8_WAIT_L(0); PG8_BAR; PG8_MMA(0, 0, At, B0); PG8_MMA(0, 1, At, B1); PG8_BAR; PG8_SCHED;
            PG8_LDA(At, 0, 1); PG8_STAGE(PG8_SB(0, 0), b2, voffB); PG8_STAGE(PG8_SB(0, 1), b2 + hB, voffB); PG8_STAGE(PG8_SA(0, 0), a2, voffA);
            PG8_WAIT_V(8); PG8_WAIT_L(0); PG8_BAR; PG8_MMA(1, 0, At, B0); PG8_MMA(1, 1, At, B1); PG8_BAR; PG8_SCHED;
            PG8_LDB(B0, 1, 0); PG8_LDB(B1, 1, 1); PG8_SCHED; PG8_LDA(At, 1, 0); PG8_STAGE(PG8_SA(0, 1), a2 + hA, voffA);
            PG8_WAIT_V(8); PG8_WAIT_L(0); PG8_BAR; PG8_MMA(0, 0, At, B0); PG8_MMA(0, 1, At, B1); PG8_BAR; PG8_SCHED;
            PG8_LDA(At, 1, 1); PG8_STAGE(PG8_SB(1, 0), b3, voffB); PG8_STAGE(PG8_SB(1, 1), b3 + hB, voffB); PG8_STAGE(PG8_SA(1, 0), a3, voffA);
            PG8_WAIT_V(8); PG8_WAIT_L(0); PG8_BAR; PG8_MMA(1, 0, At, B0); PG8_MMA(1, 1, At, B1); PG8_BAR; PG8_SCHED;
        }
        if constexpr (ALIGN_EPI) { if (wr == 0) PG8_BAR; }
        E(acc, cur, wr, wc, fr, fq);
        if (!has_next) break;
#pragma unroll
        for (int a = 0; a < 2; ++a)
#pragma unroll
            for (int b = 0; b < 2; ++b)
#pragma unroll
                for (int m = 0; m < 4; ++m)
#pragma unroll
                    for (int n = 0; n < 2; ++n) acc[a][b][m][n] = (f32x4){0.f, 0.f, 0.f, 0.f};
        cur = nxt; cA = nA; cB = nB; ++ui;
        if constexpr (ALIGN_EPI) { if (wr == 1) PG8_BAR; }
    }
    PG8_WAIT_V(0);
    if constexpr (!ALIGN_EPI) { if (wr == 0) PG8_BAR; }
    PG8_BAR;
#undef PG8_SA
#undef PG8_SB
#undef PG8_STAGE
#undef PG8_LDA
#undef PG8_LDB
#undef PG8_MMA
#undef PG8_WAIT_V
#undef PG8_WAIT_L
#undef PG8_BAR
#undef PG8_SCHED
}

template <class Epi, class Sched, bool ALIGN_EPI = true>
DI void gemm_phase_gather(LAS unsigned char* lds, const Gemm g, const int* __restrict__ grow, const Sched& S, const Epi& E) {
    const int tid = fresh_tid(), wid = __builtin_amdgcn_readfirstlane(tid >> 6), lane = tid & 63, wr = wid >> 2, wc = wid & 3, fr = lane & 15, fq = lane >> 4;
    const int K = g.K, nt = K / BK;
    unsigned voffB[2];
#pragma unroll
    for (int i = 0; i < 2; ++i) { int R, C; stage_rc(tid * 16 + i * 8192, R, C); const int Rb = Epi::PERM ? ((R & ~31) + perm32(R & 31)) : R;
        voffB[i] = (unsigned)(Rb * g.ldb + C) * 2u; }
#define PG8_RA(i_) ([&]{ int R_, C_; stage_rc(tid * 16 + (i_) * 8192, R_, C_); return R_; }())
#define PG8_CA2(i_) ([&]{ int R_, C_; stage_rc(tid * 16 + (i_) * 8192, R_, C_); return (unsigned)C_ * 2u; }())
    unsigned vAc[2][2];
#define PG8_GOFF(dst, arow_) do { _Pragma("unroll") for (int h_ = 0; h_ < 2; ++h_) _Pragma("unroll") for (int i_ = 0; i_ < 2; ++i_) \
        dst[h_][i_] = (unsigned)grow[(arow_) + h_ * HALF + PG8_RA(i_)] * (unsigned)(g.lda * 2) + PG8_CA2(i_); } while (0)
    const size_t kstep = (size_t)(BK * 2);
    const size_t hB = (size_t)HALF * g.ldb * 2;
    const unsigned ldsw = (unsigned)wid * 1024u;
    const int aoff = lds_byte(wr * 64 + fr, fq * 8), boff = lds_byte(wc * 32 + fr, fq * 8);
#define PG8_SA(b, h) (((b) * 2 + (h)) * HTB)
#define PG8_SB(b, h) ((4 + (b) * 2 + (h)) * HTB)
#define PG8_STAGE(bufoff, gbase, voff) do { _Pragma("unroll") for (int _i = 0; _i < 2; ++_i) \
        __builtin_amdgcn_global_load_lds((const unsigned*)((const char*)(gbase) + (voff)[_i]), (LAS unsigned*)(lds + (bufoff) + ldsw + _i * 8192), 16, 0, 0); } while (0)
#define PG8_STAGEA(bufoff, kbyte, vv, hf) do { _Pragma("unroll") for (int _i = 0; _i < 2; ++_i) \
        __builtin_amdgcn_global_load_lds((const unsigned*)((const char*)g.A + (kbyte) + vv[hf][_i]), (LAS unsigned*)(lds + (bufoff) + ldsw + _i * 8192), 16, 0, 0); } while (0)
#define PG8_LDA(dst, b, h) do { _Pragma("unroll") for (int m = 0; m < 4; ++m) _Pragma("unroll") for (int k = 0; k < 2; ++k) dst[m][k] = *(const LAS bf16x8*)(lds + PG8_SA(b, h) + aoff + m * 2048 + k * 1024); } while (0)
#define PG8_LDB(dst, b, h) do { _Pragma("unroll") for (int n = 0; n < 2; ++n) _Pragma("unroll") for (int k = 0; k < 2; ++k) dst[n][k] = *(const LAS bf16x8*)(lds + PG8_SB(b, h) + boff + n * 2048 + k * 1024); } while (0)
#define PG8_MMA(ai, bj, At, Bt) do { __builtin_amdgcn_s_setprio(1); _Pragma("unroll") for (int m = 0; m < 4; ++m) _Pragma("unroll") for (int n = 0; n < 2; ++n) _Pragma("unroll") for (int k = 0; k < 2; ++k) \
        acc[ai][bj][m][n] = __builtin_amdgcn_mfma_f32_16x16x32_bf16(Bt[n][k], At[m][k], acc[ai][bj][m][n], 0, 0, 0); __builtin_amdgcn_s_setprio(0); } while (0)
#define PG8_WAIT_V(n) asm volatile("s_waitcnt vmcnt(" #n ")" ::: "memory")
#define PG8_WAIT_L(n) asm volatile("s_waitcnt lgkmcnt(" #n ")" ::: "memory")
#define PG8_BAR __builtin_amdgcn_s_barrier()
#define PG8_SCHED __builtin_amdgcn_sched_barrier(0)
    int ui = 0;
    Unit cur = S.next(0);
    if (cur.arow < 0) return;
    f32x4 acc[2][2][4][2];
#pragma unroll
    for (int a = 0; a < 2; ++a)
#pragma unroll
        for (int b = 0; b < 2; ++b)
#pragma unroll
            for (int m = 0; m < 4; ++m)
#pragma unroll
                for (int n = 0; n < 2; ++n) acc[a][b][m][n] = (f32x4){0.f, 0.f, 0.f, 0.f};
    bf16x8 At[4][2], B0[2][2], B1[2][2];
    const char* cB = (const char*)g.Bt + (size_t)cur.brow * g.ldb * 2;
    PG8_GOFF(vAc, cur.arow);
    PG8_STAGE(PG8_SB(0, 0), cB, voffB); PG8_STAGE(PG8_SB(0, 1), cB + hB, voffB); PG8_STAGEA(PG8_SA(0, 0), 0, vAc, 0); PG8_STAGEA(PG8_SA(0, 1), 0, vAc, 1);
    if (wr == 1) PG8_BAR;
    PG8_WAIT_V(2); PG8_BAR;
    PG8_STAGE(PG8_SB(1, 0), cB + kstep, voffB); PG8_STAGEA(PG8_SA(1, 0), kstep, vAc, 0); PG8_STAGE(PG8_SB(1, 1), cB + hB + kstep, voffB);
    PG8_WAIT_V(6); PG8_BAR;
    for (;;) {
        const Unit nxt = S.next(ui + 1);
        const bool has_next = nxt.arow >= 0;
        const char* nB = has_next ? (const char*)g.Bt + (size_t)nxt.brow * g.ldb * 2 : cB;
        int rawn[2][2];
#pragma unroll
        for (int h_ = 0; h_ < 2; ++h_)
#pragma unroll
            for (int i_ = 0; i_ < 2; ++i_) rawn[h_][i_] = has_next ? grow[nxt.arow + h_ * HALF + PG8_RA(i_)] : 0;
#pragma unroll 1
        for (int t = 0; t < nt; t += 2) {
            const bool last = (t == nt - 2);
            const size_t k1 = (size_t)(t + 1) * kstep, k2 = last ? 0 : (size_t)(t + 2) * kstep, k3 = k2 + kstep;
            const char* b2 = last ? nB : cB + (size_t)(t + 2) * kstep; const char* b3 = b2 + kstep;
            PG8_LDB(B0, 0, 0); PG8_LDB(B1, 0, 1); PG8_SCHED; PG8_LDA(At, 0, 0); PG8_STAGEA(PG8_SA(1, 1), k1, vAc, 1);
            if (last && has_next) {
#pragma unroll
                for (int h_ = 0; h_ < 2; ++h_)
#pragma unroll
                    for (int i_ = 0; i_ < 2; ++i_) vAc[h_][i_] = (unsigned)rawn[h_][i_] * (unsigned)(g.lda * 2) + PG8_CA2(i_); }
            PG8_WAIT_V(8); PG8_WAIT_L(0); PG8_BAR; PG8_MMA(0, 0, At, B0); PG8_MMA(0, 1, At, B1); PG8_BAR; PG8_SCHED;
            PG8_LDA(At, 0, 1); PG8_STAGE(PG8_SB(0, 0), b2, voffB); PG8_STAGE(PG8_SB(0, 1), b2 + hB, voffB); PG8_STAGEA(PG8_SA(0, 0), k2, vAc, 0);
            PG8_WAIT_V(8); PG8_WAIT_L(0); PG8_BAR; PG8_MMA(1, 0, At, B0); PG8_MMA(1, 1, At, B1); PG8_BAR; PG8_SCHED;
            PG8_LDB(B0, 1, 0); PG8_LDB(B1, 1, 1); PG8_SCHED; PG8_LDA(At, 1, 0); PG8_STAGEA(PG8_SA(0, 1), k2, vAc, 1);
            PG8_WAIT_V(8); PG8_WAIT_L(0); PG8_BAR; PG8_MMA(0, 0, At, B0); PG8_MMA(0, 1, At, B1); PG8_BAR; PG8_SCHED;
            PG8_LDA(At, 1, 1); PG8_STAGE(PG8_SB(1, 0), b3, voffB); PG8_STAGE(PG8_SB(1, 1), b3 + hB, voffB); PG8_STAGEA(PG8_SA(1, 0), k3, vAc, 0);
            PG8_WAIT_V(8); PG8_WAIT_L(0); PG8_BAR; PG8_MMA(1, 0, At, B0); PG8_MMA(1, 1, At, B1); PG8_BAR; PG8_SCHED;
        }
        if constexpr (ALIGN_EPI) { if (wr == 0) PG8_BAR; }
        E(acc, cur, wr, wc, fr, fq);
        if (!has_next) break;
#pragma unroll
        for (int a = 0; a < 2; ++a)
#pragma unroll
            for (int b = 0; b < 2; ++b)
#pragma unroll
                for (int m = 0; m < 4; ++m)
#pragma unroll
                    for (int n = 0; n < 2; ++n) acc[a][b][m][n] = (f32x4){0.f, 0.f, 0.f, 0.f};
        cur = nxt; cB = nB; ++ui;
        if constexpr (ALIGN_EPI) { if (wr == 1) PG8_BAR; }
    }
    PG8_WAIT_V(0);
    if constexpr (!ALIGN_EPI) { if (wr == 0) PG8_BAR; }
    PG8_BAR;
#undef PG8_SA
#undef PG8_SB
#undef PG8_STAGE
#undef PG8_STAGEA
#undef PG8_GOFF
#undef PG8_RA
#undef PG8_CA2
#undef PG8_LDA
#undef PG8_LDB
#undef PG8_MMA
#undef PG8_WAIT_V
#undef PG8_WAIT_L
#undef PG8_BAR
#undef PG8_SCHED
}

struct MergeArgs { const bf16_t* YAB; const bf16_t* YCD; const bf16_t* W4T; const unsigned char* G; const float* ssq; bf16_t* MRGB; };
template <class Sched>
DI void gemm_merge_phase(LAS unsigned char* lds, const MergeArgs M, const Sched& S) {
    const int tid = fresh_tid(), wid = __builtin_amdgcn_readfirstlane(tid >> 6), lane = tid & 63, wr = wid >> 2, wc = wid & 3, fr = lane & 15, fq = lane >> 4;
    constexpr int NT = 28, LDB = 1792;
    unsigned vA0[2], vA1[2], voffB[2];
#pragma unroll
    for (int i = 0; i < 2; ++i) { int R, C; stage_rc(tid * 16 + i * 8192, R, C); const int Rb = (R & ~31) + perm32(R & 31);
        vA0[i] = (unsigned)(R * 1024 + C) * 2u; vA1[i] = (unsigned)(R * 768 + C) * 2u; voffB[i] = (unsigned)(Rb * LDB + C) * 2u; }
    const size_t kstep = (size_t)(BK * 2);
    const unsigned ldsw = (unsigned)wid * 1024u;
    const int aoff = lds_byte(wr * 64 + fr, fq * 8), boff = lds_byte(wc * 32 + fr, fq * 8);
#define PG8_SA(b, h) (((b) * 2 + (h)) * HTB)
#define PG8_SB(b, h) ((4 + (b) * 2 + (h)) * HTB)
#define PG8_STAGEB(bufoff, gbase) do { _Pragma("unroll") for (int _i = 0; _i < 2; ++_i) \
        __builtin_amdgcn_global_load_lds((const unsigned*)((const char*)(gbase) + voffB[_i]), (LAS unsigned*)(lds + (bufoff) + ldsw + _i * 8192), 16, 0, 0); } while (0)
#define PG8_STAGEA(bufoff, arow_, tt, hf) do { const bool ab_ = (tt) < 16; \
        const char* gp_ = ab_ ? (const char*)M.YAB + ((size_t)(arow_) + (hf) * HALF) * 2048 + (size_t)(tt) * 128 : (const char*)M.YCD + ((size_t)(arow_) + (hf) * HALF) * 1536 + (size_t)((tt) - 16) * 128; \
        const unsigned o0_ = ab_ ? vA0[0] : vA1[0], o1_ = ab_ ? vA0[1] : vA1[1]; \
        __builtin_amdgcn_global_load_lds((const unsigned*)(gp_ + o0_), (LAS unsigned*)(lds + (bufoff) + ldsw), 16, 0, 0); \
        __builtin_amdgcn_global_load_lds((const unsigned*)(gp_ + o1_), (LAS unsigned*)(lds + (bufoff) + ldsw + 8192), 16, 0, 0); } while (0)
#define PG8_LDA(dst, b, h) do { _Pragma("unroll") for (int m = 0; m < 4; ++m) _Pragma("unroll") for (int k = 0; k < 2; ++k) dst[m][k] = *(const LAS bf16x8*)(lds + PG8_SA(b, h) + aoff + m * 2048 + k * 1024); } while (0)
#define PG8_LDB(dst, b, h) do { _Pragma("unroll") for (int n = 0; n < 2; ++n) _Pragma("unroll") for (int k = 0; k < 2; ++k) dst[n][k] = *(const LAS bf16x8*)(lds + PG8_SB(b, h) + boff + n * 2048 + k * 1024); } while (0)
#define PG8_MMA(ai, At, Bt) do { __builtin_amdgcn_s_setprio(1); _Pragma("unroll") for (int m = 0; m < 4; ++m) _Pragma("unroll") for (int n = 0; n < 2; ++n) _Pragma("unroll") for (int k = 0; k < 2; ++k) \
        acc[ai][0][m][n] = __builtin_amdgcn_mfma_f32_16x16x32_bf16(Bt[n][k], At[m][k], acc[ai][0][m][n], 0, 0, 0); __builtin_amdgcn_s_setprio(0); } while (0)
#define PG8_WAIT_V(n) asm volatile("s_waitcnt vmcnt(" #n ")" ::: "memory")
#define PG8_WAIT_L(n) asm volatile("s_waitcnt lgkmcnt(" #n ")" ::: "memory")
#define PG8_BAR __builtin_amdgcn_s_barrier()
#define PG8_SCHED __builtin_amdgcn_sched_barrier(0)
    int ui = 0;
    Unit cur = S.next(0);
    if (cur.arow < 0) return;
    f32x4 acc[2][2][4][2];
#pragma unroll
    for (int a = 0; a < 2; ++a)
#pragma unroll
        for (int b = 0; b < 2; ++b)
#pragma unroll
            for (int m = 0; m < 4; ++m)
#pragma unroll
                for (int n = 0; n < 2; ++n) acc[a][b][m][n] = (f32x4){0.f, 0.f, 0.f, 0.f};
    bf16x8 At[4][2], B0[2][2];
    const char* cB = (const char*)M.W4T + (size_t)cur.brow * LDB * 2;
    int carow = cur.arow;
    PG8_STAGEB(PG8_SB(0, 0), cB); PG8_STAGEA(PG8_SA(0, 0), carow, 0, 0); PG8_STAGEA(PG8_SA(0, 1), carow, 0, 1);
    if (wr == 1) PG8_BAR;
    PG8_WAIT_V(2); PG8_BAR;
    PG8_STAGEB(PG8_SB(1, 0), cB + kstep); PG8_STAGEA(PG8_SA(1, 0), carow, 1, 0);
    PG8_WAIT_V(4); PG8_BAR;
    for (;;) {
        const Unit nxt = S.next(ui + 1);
        const bool has_next = nxt.arow >= 0;
        const int narow = has_next ? nxt.arow : carow; const char* nB = has_next ? (const char*)M.W4T + (size_t)nxt.brow * LDB * 2 : cB;
#pragma unroll 1
        for (int t = 0; t < NT; t += 2) {
            const bool last = (t == NT - 2);
            const bool fold_it = (t == 6 || t == 14 || t == 20 || t == 26);
            u32x2 gq[2][4];
            if (fold_it) {
                const int seg = (t == 6) ? 0 : (t == 14) ? 1 : (t == 20) ? 2 : 3;
                int row0 = cur.arow + wr * 64 + fr, col = cur.pn * 128 + wc * 32 + 8 * fq;
                asm volatile("" : "+v"(row0), "+v"(col));
#pragma unroll
                for (int ai = 0; ai < 2; ++ai)
#pragma unroll
                    for (int m = 0; m < 4; ++m) gq[ai][m] = *(const u32x2*)(M.G + (size_t)(row0 + ai * 128 + m * 16) * PG_W + seg * 1024 + col);
            }
            const int t2 = last ? 0 : t + 2, t3 = t2 + 1; const int arow2 = last ? narow : carow;
            const char* b2 = last ? nB : cB + (size_t)(t + 2) * kstep; const char* b3 = b2 + kstep;
            PG8_LDB(B0, 0, 0); PG8_SCHED; PG8_LDA(At, 0, 0); PG8_STAGEA(PG8_SA(1, 1), carow, t + 1, 1);
            PG8_WAIT_V(6); PG8_WAIT_L(0); PG8_BAR; PG8_MMA(0, At, B0); PG8_BAR; PG8_SCHED;
            PG8_LDA(At, 0, 1); PG8_STAGEB(PG8_SB(0, 0), b2); PG8_STAGEA(PG8_SA(0, 0), arow2, t2, 0);
            PG8_WAIT_V(6); PG8_WAIT_L(0); PG8_BAR; PG8_MMA(1, At, B0); PG8_BAR; PG8_SCHED;
            PG8_LDB(B0, 1, 0); PG8_SCHED; PG8_LDA(At, 1, 0); PG8_STAGEA(PG8_SA(0, 1), arow2, t2, 1);
            PG8_WAIT_V(6); PG8_WAIT_L(0); PG8_BAR; PG8_MMA(0, At, B0); PG8_BAR; PG8_SCHED;
            PG8_LDA(At, 1, 1); PG8_STAGEB(PG8_SB(1, 0), b3); PG8_STAGEA(PG8_SA(1, 0), arow2, t3, 0);
            PG8_WAIT_V(6); PG8_WAIT_L(0); PG8_BAR; PG8_MMA(1, At, B0); PG8_BAR; PG8_SCHED;
            if (fold_it) {
                float rs[2][4];
#pragma unroll
                for (int ai = 0; ai < 2; ++ai)
#pragma unroll
                    for (int m = 0; m < 4; ++m) rs[ai][m] = 1.f / 255.f;
                if (t == 14) {
                    int rowq = cur.arow + wr * 64 + fr; asm volatile("" : "+v"(rowq));
                    f32x2 q2[2][4];
#pragma unroll
                    for (int ai = 0; ai < 2; ++ai)
#pragma unroll
                        for (int m = 0; m < 4; ++m) q2[ai][m] = *(const f32x2*)(M.ssq + 2 * (size_t)(rowq + ai * 128 + m * 16));
#pragma unroll
                    for (int ai = 0; ai < 2; ++ai)
#pragma unroll
                        for (int m = 0; m < 4; ++m) rs[ai][m] = __builtin_amdgcn_rsqf((q2[ai][m][0] + q2[ai][m][1]) * (1.f / 512.f) + RMS_EPS) * (1.f / 255.f); }
#pragma unroll
                for (int ai = 0; ai < 2; ++ai)
#pragma unroll
                    for (int m = 0; m < 4; ++m) { const u32x2 q = gq[ai][m]; const float sc = rs[ai][m];
#pragma unroll
                        for (int k = 0; k < 4; ++k) { const float g0 = (float)((q.x >> (8 * k)) & 255u) * sc, g1 = (float)((q.y >> (8 * k)) & 255u) * sc;
                            acc[ai][1][m][0][k] += acc[ai][0][m][0][k] * g0; acc[ai][1][m][1][k] += acc[ai][0][m][1][k] * g1; }
                        acc[ai][0][m][0] = (f32x4){0.f, 0.f, 0.f, 0.f}; acc[ai][0][m][1] = (f32x4){0.f, 0.f, 0.f, 0.f}; }
                if (t == NT - 2) {
                    int row0 = cur.arow + wr * 64 + fr, col = cur.pn * 128 + wc * 32 + 8 * fq;
                    asm volatile("" : "+v"(row0), "+v"(col));
#pragma unroll
                    for (int ai = 0; ai < 2; ++ai)
#pragma unroll
                        for (int m = 0; m < 4; ++m) { const f32x4 v0 = acc[ai][1][m][0], v1 = acc[ai][1][m][1];
                            u32x4 w; w.x = pk2(v0[0], v0[1]); w.y = pk2(v0[2], v0[3]); w.z = pk2(v1[0], v1[1]); w.w = pk2(v1[2], v1[3]);
                            *(u32x4*)(M.MRGB + (size_t)(row0 + ai * 128 + m * 16) * 1024 + col) = w;
                            acc[ai][1][m][0] = (f32x4){0.f, 0.f, 0.f, 0.f}; acc[ai][1][m][1] = (f32x4){0.f, 0.f, 0.f, 0.f}; } }
            }
        }
        if (!has_next) break;
        cur = nxt; carow = narow; cB = nB; ++ui;
    }
    PG8_WAIT_V(0);
    if (wr == 0) PG8_BAR;
    PG8_BAR;
#undef PG8_SA
#undef PG8_SB
#undef PG8_STAGEA
#undef PG8_STAGEB
#undef PG8_LDA
#undef PG8_LDB
#undef PG8_MMA
#undef PG8_WAIT_V
#undef PG8_WAIT_L
#undef PG8_BAR
#undef PG8_SCHED
}
}

using pg8::Unit;

struct EpiProj {
    static constexpr bool PERM = true;
    bf16_t* O0; int ld0; int split_pn; unsigned char* G8; bf16_t* AU;
    bf16_t* QN; bf16_t* KN; const float* ROPE; const float* qg; const float* kg; LAS float* xch;
    DI void operator()(const f32x4 (&acc)[2][2][4][2], const Unit& u, int wr, int wc, int fr, int fq) const {
        const int row0 = u.arow + wr * 64 + fr;
        if (u.pn <= 2) {
            const int nb = (u.pn == 2) ? 1 : 2;
            int frl = fr, fql = fq; asm volatile("" : "+v"(frl), "+v"(fql));
            const int lane = fql * 16 + frl, hb = wc & 1, tile9 = u.pm % 9; const bool rope = tile9 != 0;
            LAS float* xw = xch + (((wr * 64 + frl) << 2) + wc); const LAS float* xr = xch + (((wr * 64 + frl) << 2) + (wc & 2));
#pragma unroll
            for (int bj = 0; bj < 2; ++bj) { if (bj >= nb) continue;
#pragma unroll
                for (int ai = 0; ai < 2; ++ai)
#pragma unroll
                    for (int m = 0; m < 4; ++m) { const f32x4 a0 = acc[ai][bj][m][0], a1 = acc[ai][bj][m][1];
                        float s = (a0[0] * a0[0] + a0[1] * a0[1]) + (a0[2] * a0[2] + a0[3] * a0[3]) + (a1[0] * a1[0] + a1[1] * a1[1]) + (a1[2] * a1[2] + a1[3] * a1[3]);
                        s += shx(s, 16, lane); s += shx(s, 32, lane);
                        if (fql == 0) xw[(bj * 256 + ai * 128 + m * 16) << 2] = s; } }
            LDS_WAIT(); __builtin_amdgcn_s_barrier();
            const float* kgl = kg; const float* qgl = qg; bf16_t* knl = KN; bf16_t* qnl = QN;
            asm volatile("" : "+s"(kgl), "+s"(qgl), "+s"(knl), "+s"(qnl));
            const float* gsrc = (u.pn == 2) ? kgl : qgl; const float sc = (u.pn == 2) ? 1.f : ATT_C2;
            float gn[8]; { const f32x4 g0 = *(const f32x4*)(gsrc + hb * 32 + 8 * fql), g1 = *(const f32x4*)(gsrc + hb * 32 + 8 * fql + 4);
                gn[0] = g0[0]; gn[1] = g0[1]; gn[2] = g0[2]; gn[3] = g0[3]; gn[4] = g1[0]; gn[5] = g1[1]; gn[6] = g1[2]; gn[7] = g1[3]; }
#pragma unroll
            for (int ai = 0; ai < 2; ++ai)
#pragma unroll
                for (int m = 0; m < 4; ++m) { const int rl = ai * 128 + wr * 64 + m * 16 + frl, R = u.arow + rl;
                    float cs[8], sn[8];
                    if (rope) { const float* cp = ROPE + (size_t)((tile9 - 1) * 256 + rl) * 64 + hb * 16 + 8 * (fql & 1);
                        const f32x4 c0 = *(const f32x4*)cp, c1 = *(const f32x4*)(cp + 4), s0 = *(const f32x4*)(cp + 32), s1 = *(const f32x4*)(cp + 36);
#pragma unroll
                        for (int k = 0; k < 4; ++k) { cs[k] = c0[k]; cs[4 + k] = c1[k]; sn[k] = s0[k]; sn[4 + k] = s1[k]; }
                    } else {
#pragma unroll
                        for (int k = 0; k < 8; ++k) { cs[k] = 1.f; sn[k] = 0.f; } }
#pragma unroll
                    for (int bj = 0; bj < 2; ++bj) {
                        if (bj >= nb) {
                            const f32x4 v0 = acc[ai][bj][m][0], v1 = acc[ai][bj][m][1];
                            u32x4 w; w.x = pk2(v0[0], v0[1]); w.y = pk2(v0[2], v0[3]); w.z = pk2(v1[0], v1[1]); w.w = pk2(v1[2], v1[3]);
                            *(u32x4*)(O0 + (size_t)R * ld0 + u.pn * 256 + bj * 128 + wc * 32 + 8 * fql) = w; continue; }
                        const f32x2 pr2 = *(const LAS f32x2*)(xr + ((bj * 256 + ai * 128 + m * 16) << 2)); const float tot = pr2[0] + pr2[1];
                        const float rstd = __builtin_amdgcn_rsqf(tot * (1.f / 64.f) + RMS_EPS) * sc;
                        float v[8], o[8];
#pragma unroll
                        for (int k = 0; k < 4; ++k) { v[k] = acc[ai][bj][m][0][k] * rstd * gn[k]; v[4 + k] = acc[ai][bj][m][1][k] * rstd * gn[4 + k]; }
#pragma unroll
                        for (int k = 0; k < 8; ++k) { const float pv = shx(v[k], 32, lane); o[k] = (fql >= 2) ? (v[k] * cs[k] + pv * sn[k]) : (v[k] * cs[k] - pv * sn[k]); }
                        const int head = (u.pn == 2) ? (wc >> 1) : (u.pn * 4 + bj * 2 + (wc >> 1));
                        bf16_t* dst = (u.pn == 2) ? knl + (size_t)R * 128 + head * 64 : qnl + (size_t)R * 512 + head * 64;
                        *(u32x4*)(dst + hb * 32 + 8 * fql) = pack8(o); } }
            return;
        }
        if (u.pn == 8 || u.pn == 9) {
            const int col0 = u.pn * 256 + wc * 32 + 8 * fq;
#pragma unroll
            for (int ai = 0; ai < 2; ++ai)
#pragma unroll
                for (int m = 0; m < 4; ++m) { const int R = row0 + ai * 128 + m * 16; bf16_t* rowp = O0 + (size_t)R * ld0 + col0;
#pragma unroll
                    for (int bj = 0; bj < 2; ++bj) { const f32x4 v0 = acc[ai][bj][m][0], v1 = acc[ai][bj][m][1];
                        u32x4 w; w.x = pk2(v0[0], v0[1]); w.y = pk2(v0[2], v0[3]); w.z = pk2(v1[0], v1[1]); w.w = pk2(v1[2], v1[3]);
                        const int c8 = col0 + bj * 128, ch = c8 - C_U;
                        if (c8 >= C_U && c8 < C_SB) *(u32x4*)(AU + ((size_t)(ch >> 4) * 576 + (R >> 5)) * 768 + (R & 31) * 16 + (ch & 15)) = w;
                        else *(u32x4*)(rowp + bj * 128) = w; } }
        } else if (u.pn < split_pn) {
            const int col0 = u.pn * 256 + wc * 32 + 8 * fq;
            if (u.pn == 3 || u.pn == 4) {
#pragma unroll
                for (int ai = 0; ai < 2; ++ai)
#pragma unroll
                    for (int m = 0; m < 4; ++m) { bf16_t* rowp = O0 + (size_t)(row0 + ai * 128 + m * 16) * ld0 + col0;
#pragma unroll
                        for (int bj = 0; bj < 2; ++bj) { f32x4 v0 = acc[ai][bj][m][0], v1 = acc[ai][bj][m][1];
#pragma unroll
                            for (int k = 0; k < 4; ++k) { v0[k] = silu_f(v0[k]); v1[k] = silu_f(v1[k]); }
                            u32x4 w; w.x = pk2(v0[0], v0[1]); w.y = pk2(v0[2], v0[3]); w.z = pk2(v1[0], v1[1]); w.w = pk2(v1[2], v1[3]);
                            *(u32x4*)(rowp + bj * 128) = w; } }
            } else {
#pragma unroll
                for (int ai = 0; ai < 2; ++ai)
#pragma unroll
                    for (int m = 0; m < 4; ++m) { bf16_t* rowp = O0 + (size_t)(row0 + ai * 128 + m * 16) * ld0 + col0;
#pragma unroll
                        for (int bj = 0; bj < 2; ++bj) { const f32x4 v0 = acc[ai][bj][m][0], v1 = acc[ai][bj][m][1];
                            u32x4 w; w.x = pk2(v0[0], v0[1]); w.y = pk2(v0[2], v0[3]); w.z = pk2(v1[0], v1[1]); w.w = pk2(v1[2], v1[3]);
                            *(u32x4*)(rowp + bj * 128) = w; } }
            }
        } else {
            const int col0 = (u.pn - split_pn) * 256 + wc * 32 + 8 * fq;
#pragma unroll
            for (int ai = 0; ai < 2; ++ai)
#pragma unroll
                for (int m = 0; m < 4; ++m) { unsigned char* rowp = G8 + (size_t)(row0 + ai * 128 + m * 16) * PG_W + col0;
#pragma unroll
                    for (int bj = 0; bj < 2; ++bj) { const f32x4 v0 = acc[ai][bj][m][0], v1 = acc[ai][bj][m][1]; unsigned q[8];
#pragma unroll
                        for (int k = 0; k < 4; ++k) { q[k] = (unsigned)(sigmoid_f(v0[k]) * 255.f + 0.5f); q[4 + k] = (unsigned)(sigmoid_f(v1[k]) * 255.f + 0.5f); }
                        u32x2 w; w.x = q[0] | (q[1] << 8) | (q[2] << 16) | (q[3] << 24); w.y = q[4] | (q[5] << 8) | (q[6] << 16) | (q[7] << 24);
                        *(u32x2*)(rowp + bj * 128) = w; } }
        }
    }
};

struct EpiWout {
    static constexpr bool PERM = true;
    bf16_t* Y;
    DI void operator()(const f32x4 (&acc)[2][2][4][2], const Unit& u, int wr, int wc, int fr, int fq) const {
        const int row0 = u.arow + wr * 64 + fr, col0 = u.pn * 256 + wc * 32 + 8 * fq;
#pragma unroll
        for (int ai = 0; ai < 2; ++ai)
#pragma unroll
            for (int m = 0; m < 4; ++m) { bf16_t* rowp = Y + (size_t)(row0 + ai * 128 + m * 16) * 1024 + col0;
#pragma unroll
                for (int bj = 0; bj < 2; ++bj) { const f32x4 v0 = acc[ai][bj][m][0], v1 = acc[ai][bj][m][1];
                    u32x4 w; w.x = pk2(v0[0], v0[1]); w.y = pk2(v0[2], v0[3]); w.z = pk2(v1[0], v1[1]); w.w = pk2(v1[2], v1[3]);
                    *(u32x4*)(rowp + bj * 128) = w; } }
    }
};

struct EpiGlu {
    static constexpr bool PERM = true;
    const bf16_t* YG; bf16_t* YC; const float* bglu;
    DI void operator()(const f32x4 (&acc)[2][2][4][2], const Unit& u, int wr, int wc, int fr, int fq) const {
        const int row0 = u.arow + wr * 64 + fr, col0 = u.pn * 256 + wc * 32 + 8 * fq;
#pragma unroll
        for (int bj = 0; bj < 2; ++bj) { const int col = col0 + bj * 128; if (u.pn == 1 && bj == 1) continue;
            const f32x4 b0 = *(const f32x4*)(bglu + col), b1 = *(const f32x4*)(bglu + col + 4);
#pragma unroll
            for (int ai = 0; ai < 2; ++ai) { u32x4 yw[4];
#pragma unroll
                for (int m = 0; m < 4; ++m) yw[m] = *(const u32x4*)(YG + (size_t)(row0 + ai * 128 + m * 16) * 384 + col);
#pragma unroll
                for (int m = 0; m < 4; ++m) { float y[8]; unpack8(yw[m], y);
                    const f32x4 a0 = acc[ai][bj][m][0] + b0, a1 = acc[ai][bj][m][1] + b1;
                    float o[8];
#pragma unroll
                    for (int k = 0; k < 4; ++k) { o[k] = y[k] * sigmoid_f(a0[k]); o[4 + k] = y[4 + k] * sigmoid_f(a1[k]); }
                    *(u32x4*)(YC + (size_t)(row0 + ai * 128 + m * 16) * 768 + col) = pack8(o); }
                __builtin_amdgcn_sched_barrier(0); } }
    }
};

struct EpiS5S {
    static constexpr bool PERM = true;
    float* S;
    DI void operator()(const f32x4 (&acc)[2][2][4][2], const Unit& u, int wr, int wc, int fr, int fq) const {
        const int m0 = u.pn * 256 + wr * 64 + fr, col0 = wc * 32 + 8 * fq;
#pragma unroll
        for (int ai = 0; ai < 2; ++ai)
#pragma unroll
            for (int m = 0; m < 4; ++m) { const int mm = m0 + ai * 128 + m * 16; if (u.pn == 2 && (ai == 1 || wr == 1)) continue;
                float* p = S + ((size_t)u.pm * 576 + mm) * 256 + col0;
#pragma unroll
                for (int bj = 0; bj < 2; ++bj) { *(f32x4*)(p + bj * 128) = acc[ai][bj][m][0]; *(f32x4*)(p + bj * 128 + 4) = acc[ai][bj][m][1]; } }
    }
};

struct EpiS5Y {
    static constexpr bool PERM = true;
    const bf16_t* AU; bf16_t* YG; const float* dsk;
    DI void operator()(const f32x4 (&acc)[2][2][4][2], const Unit& u, int wr, int wc, int fr, int fq) const {
        const int g = u.pm / 3, j = u.pm % 3;
        if (j == 2 && wr == 1) return;
        const int nai = (j == 2) ? 1 : 2;
        const int m0 = j * 256 + wr * 64 + fr, n0 = u.pn * 256 + wc * 32 + 8 * fq;
#pragma unroll
        for (int bj = 0; bj < 2; ++bj) { const int n = n0 + bj * 128, i = n >> 4, a0 = n & 15;
            const f32x4 d0 = *(const f32x4*)(dsk + g * 16 + a0), d1 = *(const f32x4*)(dsk + g * 16 + a0 + 4);
#pragma unroll
            for (int ai = 0; ai < nai; ++ai) {
                u32x4 uw[4];
#pragma unroll
                for (int m = 0; m < 4; ++m) uw[m] = *(const u32x4*)(AU + ((size_t)g * 576 + m0 + ai * 128 + m * 16) * 768 + n);
#pragma unroll
                for (int m = 0; m < 4; ++m) { const int mm = m0 + ai * 128 + m * 16; float uu[8]; unpack8(uw[m], uu);
                    const f32x4 v0 = acc[ai][bj][m][0], v1 = acc[ai][bj][m][1];
                    float o[8];
#pragma unroll
                    for (int k = 0; k < 4; ++k) { o[k] = gelu_tanh_f(v0[k] + d0[k] * uu[k]); o[4 + k] = gelu_tanh_f(v1[k] + d1[k] * uu[4 + k]); }
                    *(u32x4*)(YG + (size_t)(mm * 32 + i) * 384 + g * 16 + a0) = pack8(o); }
                __builtin_amdgcn_sched_barrier(0); } }
    }
};

struct EpiUp {
    static constexpr bool PERM = true;
    bf16_t* HID;
    DI void operator()(const f32x4 (&acc)[2][2][4][2], const Unit& u, int wr, int wc, int fr, int fq) const {
        const int row0 = u.arow + wr * 64 + fr, col0 = u.pn * 128 + wc * 32 + 8 * fq;
#pragma unroll
        for (int ai = 0; ai < 2; ++ai)
#pragma unroll
            for (int m = 0; m < 4; ++m) { const f32x4 g0 = acc[ai][0][m][0], g1 = acc[ai][0][m][1], u0 = acc[ai][1][m][0], u1 = acc[ai][1][m][1];
                float o[8];
#pragma unroll
                for (int k = 0; k < 4; ++k) { o[k] = silu_f(g0[k]) * u0[k]; o[4 + k] = silu_f(g1[k]) * u1[k]; }
                *(u32x4*)(HID + (size_t)(row0 + ai * 128 + m * 16) * 1024 + col0) = pack8(o); }
    }
};

struct EpiDown {
    static constexpr bool PERM = true;
    bf16_t* YE; const float* GV;
    DI void operator()(const f32x4 (&acc)[2][2][4][2], const Unit& u, int wr, int wc, int fr, int fq) const {
        const int row0 = u.arow + wr * 64 + fr, col0 = u.pn * 256 + wc * 32 + 8 * fq;
#pragma unroll
        for (int ai = 0; ai < 2; ++ai)
#pragma unroll
            for (int m = 0; m < 4; ++m) { const int row = row0 + ai * 128 + m * 16; const float gv = GV[row];
#pragma unroll
                for (int bj = 0; bj < 2; ++bj) { const f32x4 v0 = acc[ai][bj][m][0] * gv, v1 = acc[ai][bj][m][1] * gv;
                    u32x4 w; w.x = pk2(v0[0], v0[1]); w.y = pk2(v0[2], v0[3]); w.z = pk2(v1[0], v1[1]); w.w = pk2(v1[2], v1[3]);
                    *(u32x4*)(YE + (size_t)row * 1024 + col0 + bj * 128) = w; } }
    }
};

DI Unit mk_unit(int arow, int brow, int pm, int pn) { Unit u; u.arow = arow; u.brow = brow; u.pm = pm; u.pn = pn; return u; }
struct RowSkipOrder {
    int nN, G, c, skipctx, keep_lo, keep_hi, nmain, total, bstep;
    DI void init(int N, int G_, int c_, int skipctx_, int keep_lo_, int keep_hi_, int bstep_ = 256) { bstep = bstep_; nN = N / bstep_; G = G_; c = c_; skipctx = skipctx_; keep_lo = keep_lo_; keep_hi = keep_hi_;
        nmain = (skipctx ? 64 : 72) * nN; total = nmain + (skipctx ? 8 * (keep_hi - keep_lo) : 0); }
    DI Unit next(int i) const {
        const int L0 = i * G + c; if (L0 >= total) return mk_unit(-1, 0, 0, 0);
        const int q = total / 8, r = total % 8, xcd = L0 % 8, off = L0 / 8;
        const int L = (xcd < r ? xcd * (q + 1) : r * (q + 1) + (xcd - r) * q) + off;
        const int nig = 8 * nN, gid = L / nig, rr = L % nig, lt = gid * 8 + (rr % 8);
        const int pm_main = skipctx ? ((lt / 8) * 9 + 1 + (lt % 8)) : lt, pn_main = rr / 8;
        const int Lc = L - nmain, pm_ctx = (Lc % 8) * 9, pn_ctx = keep_lo + Lc / 8;
        const bool main = L < nmain;
        const int pm = main ? pm_main : pm_ctx, pn = main ? pn_main : pn_ctx;
        return mk_unit(pm * 256, pn * bstep, pm, pn);
    }
};
DI int xcd_remap(int L0, int total) { const int q = total / 8, r = total % 8, xcd = L0 % 8, off = L0 / 8; return (xcd < r ? xcd * (q + 1) : r * (q + 1) + (xcd - r) * q) + off; }
struct MergeOrder {
    int G, c, skipctx, total;
    DI void init(int G_, int c_, int skipctx_) { G = G_; c = c_; skipctx = skipctx_; total = (skipctx ? 64 : 72) * 8; }
    DI Unit next(int i) const {
        const int L0 = i * G + c; if (L0 >= total) return mk_unit(-1, 0, 0, 0);
        const int L = xcd_remap(L0, total), lt = L >> 3, pn = L & 7, pm = skipctx ? ((lt / 8) * 9 + 1 + (lt % 8)) : lt;
        return mk_unit(pm * 256, pn * 128, pm, pn);
    }
};
struct OrderS5S { int G, c; DI Unit next(int i) const { const int L = i * G + c; if (L >= 72) return mk_unit(-1, 0, 0, 0); const int g = L / 3, j = L % 3; return mk_unit(g * 576 + j * 256, g * 256, g, j); } };
struct OrderS5Y { int G, c; DI Unit next(int i) const { const int L = i * G + c; if (L >= 144) return mk_unit(-1, 0, 0, 0); const int g = L / 6, r = L % 6, j = r >> 1, nh = r & 1;
    return mk_unit(g * 576 + j * 256, g * 512 + nh * 256, g * 3 + j, nh); } };
struct OrderUp { int G, c, nJ; DI Unit next(int i) const { const int L0 = i * G + c, total = 16 * nJ * 8; if (L0 >= total) return mk_unit(-1, 0, 0, 0); const int L = xcd_remap(L0, total), n = L & 7, t = L >> 3, jt = t % nJ, e = t / nJ;
    return mk_unit(e * EROWS + jt * 256, e * 2048 + n * 256, e, n); } };
struct OrderDown { int G, c, nJ; DI Unit next(int i) const { const int L0 = i * G + c, total = 16 * nJ * 4; if (L0 >= total) return mk_unit(-1, 0, 0, 0); const int L = xcd_remap(L0, total), n = L & 3, t = L >> 2, jt = t % nJ, e = t / nJ;
    return mk_unit(e * EROWS + jt * 256, e * 1024 + n * 256, e, n); } };

struct Frame {
    LAS unsigned char* lds;
    int tid, lane, wave, G, vcu, gw, NGW, bid;
};

template <class DstRow>
DI void tr_item(const float* __restrict__ W, int ldw, int nvalid, int nstore, int K, bf16_t* __restrict__ WT, int k0, int n0, const DstRow& drow, const float* __restrict__ kscale, LAS float* scr  , int lane, int kofs = 0) {
    const int c4 = (lane & 15) * 4, r0 = lane >> 4;
    f32x4 v[16];
#pragma unroll
    for (int i = 0; i < 16; ++i) { const int kk = 4 * i + r0; v[i] = (n0 + c4 < nvalid) ? *(const f32x4*)(W + (size_t)(k0 + kk) * ldw + n0 + c4) : (f32x4){0.f, 0.f, 0.f, 0.f}; }
#pragma unroll
    for (int i = 0; i < 16; ++i) { const int kk = 4 * i + r0; f32x4 x = v[i]; if (kscale) x = x * kscale[k0 + kk];
        LAS float* d = scr + kk * 65 + c4; d[0] = x[0]; d[1] = x[1]; d[2] = x[2]; d[3] = x[3]; }
    LDS_WAIT(); asm volatile("" ::: "memory");
    const int c = lane & 7;
#pragma unroll
    for (int j = 0; j < 8; ++j) { const int n = (lane >> 3) + 8 * j; const LAS float* s = scr + (8 * c) * 65 + n;
        u32x4 o; o.x = pk2(s[0 * 65], s[1 * 65]); o.y = pk2(s[2 * 65], s[3 * 65]); o.z = pk2(s[4 * 65], s[5 * 65]); o.w = pk2(s[6 * 65], s[7 * 65]);
        if (n0 + n < nstore) *(u32x4*)(WT + (size_t)drow(n0 + n) * K + kofs + k0 + 8 * c) = o; }
    LDS_WAIT(); asm volatile("" ::: "memory");
}
struct DrIdent { int off; DI int operator()(int n) const { return off + n; } };
struct DrWin { DI int operator()(int n) const { return n < C_G ? n : n + (PA_W - C_G); } };
struct DrGU { int base; DI int operator()(int f) const { return base + (f >> 7) * 256 + (f & 127); } };

struct LayerIn {
    const float *w_in, *q_norm_g, *k_norm_g, *ssd_conv_w, *ssd_conv_b, *ssd_dt_bias, *ssd_a_log, *ssd_d, *ssd_norm_g;
    const float *s5_lre, *s5_lim, *s5_lstep, *s5_bre, *s5_bim, *s5_cre, *s5_cim, *s5_d, *s5_wglu, *s5_bglu, *sc_conv_w;
    const float *w_br_attn, *w_br_ssd, *w_br_s5, *w_br_sc, *w_out, *w_router, *w_gate, *w_up, *w_down, *norm_mix_g, *norm_ffn_g;
};

DI void prep_small_weights(const Frame& F, const LayerIn& P, unsigned char* ws, int part = 0, int first_wg = 0) {
    if ((int)blockIdx.x < first_wg) return;
    LAS float* scr = (LAS float*)(F.lds + F.wave * 16896);
    bf16_t* WIN = (bf16_t*)(ws + W_WIN);
    constexpr int NB_WIN = (NIN + 63) / 64;
    constexpr int I_WIN = 16 * NB_WIN, I_PAD = 62, I_BA = 8 * 16, I_BB = 8 * 16, I_BC = 6 * 16, I_BD = 6 * 16, I_OUT = 16 * 16, I_GLU = 6 * 8;
    constexpr int NIT = I_WIN + I_PAD + I_BA + I_BB + I_BC + I_BD + I_OUT + I_GLU;
    for (int it = ((int)blockIdx.x - first_wg) * NWAVES + F.wave; it < NIT; it += (F.G - first_wg) * NWAVES) {
        int r = it;
        { const bool is_out = (it >= NIT - I_GLU - I_OUT) && (it < NIT - I_GLU), is_win = it < I_WIN + I_PAD; if ((part == 1 && is_out) || (part == 2 && !is_out) || (part == 3 && is_win) || (part == 4 && !is_win)) continue; }
        if (r < I_WIN) { const int kb = r / NB_WIN, nb = r % NB_WIN; tr_item(P.w_in, NIN, NIN, NIN, 1024, WIN, kb * 64, nb * 64, DrWin{}, nullptr, scr, F.lane); continue; } r -= I_WIN;
        if (r < I_PAD) {
#pragma unroll
            for (int j = 0; j < 8; ++j) { const int idx = j * 64 + F.lane, row = C_G + r * 4 + (idx >> 7), ch = idx & 127; *(u32x4*)(WIN + (size_t)row * 1024 + ch * 8) = (u32x4){0u, 0u, 0u, 0u}; }
            continue; } r -= I_PAD;
        if (r < I_BA) { tr_item(P.w_br_attn, 1024, 1024, 1024, 1792, (bf16_t*)(ws + W_BR4), (r / 16) * 64, (r % 16) * 64, DrIdent{0}, nullptr, scr, F.lane, 0); continue; } r -= I_BA;
        if (r < I_BB) { tr_item(P.w_br_ssd, 1024, 1024, 1024, 1792, (bf16_t*)(ws + W_BR4), (r / 16) * 64, (r % 16) * 64, DrIdent{0}, P.ssd_norm_g, scr, F.lane, 512); continue; } r -= I_BB;
        if (r < I_BC) { tr_item(P.w_br_s5, 1024, 1024, 1024, 1792, (bf16_t*)(ws + W_BR4), (r / 16) * 64, (r % 16) * 64, DrIdent{0}, nullptr, scr, F.lane, 1024); continue; } r -= I_BC;
        if (r < I_BD) { tr_item(P.w_br_sc, 1024, 1024, 1024, 1792, (bf16_t*)(ws + W_BR4), (r / 16) * 64, (r % 16) * 64, DrIdent{0}, nullptr, scr, F.lane, 1408); continue; } r -= I_BD;
        if (r < I_OUT) { tr_item(P.w_out, 1024, 1024, 1024, 1024, (bf16_t*)(ws + W_OUT), (r / 16) * 64, (r % 16) * 64, DrIdent{0}, nullptr, scr, F.lane); continue; } r -= I_OUT;
        tr_item(P.s5_wglu, 384, 384, 512, 384, (bf16_t*)(ws + W_GLU), (r / 8) * 64, (r % 8) * 64, DrIdent{0}, nullptr, scr, F.lane);
    }
}
DI void prep_expert_weights(const Frame& F, const LayerIn& P, unsigned char* ws, int first_wg, int item_lo, int item_hi, bf16_t* wgu = nullptr, bf16_t* wd = nullptr) {
    if ((int)blockIdx.x < first_wg) return;
    LAS float* scr = (LAS float*)(F.lds + F.wave * 16896);
    if (!wgu) wgu = (bf16_t*)(ws + WS_WGU);
    if (!wd) wd = (bf16_t*)(ws + WS_WD);
    constexpr int PER = 16 * 16;
    for (int it = item_lo + ((int)blockIdx.x - first_wg) * NWAVES + F.wave; it < item_hi; it += (F.G - first_wg) * NWAVES) {
        const int which = it / (16 * PER), r = it % (16 * PER), e = r / PER, q = r % PER, k0 = (q / 16) * 64, n0 = (q % 16) * 64;
        if (which == 0) tr_item(P.w_gate + (size_t)e * 1024 * 1024, 1024, 1024, 1024, 1024, wgu, k0, n0, DrGU{e * 2048}, nullptr, scr, F.lane);
        else if (which == 1) tr_item(P.w_up + (size_t)e * 1024 * 1024, 1024, 1024, 1024, 1024, wgu, k0, n0, DrGU{e * 2048 + 128}, nullptr, scr, F.lane);
        else tr_item(P.w_down + (size_t)e * 1024 * 1024, 1024, 1024, 1024, 1024, wd, k0, n0, DrIdent{e * 1024}, nullptr, scr, F.lane);
    }
}
constexpr int EXPERT_W_ITEMS = 3 * 16 * 16 * 16;

DI void prep_mod(const Frame& F, const float* __restrict__ c, const float* __restrict__ c_ctx, const float* __restrict__ w_mod, const float* __restrict__ b_mod, float* __restrict__ MOD, int first_wg) {
    const int wgi = (int)blockIdx.x - first_wg, nwg = F.G - first_wg;
    if (wgi < 0 || wgi >= 2 * 96) return;
    LAS float* sc = (LAS float*)F.lds;
    LAS float* red = sc + 9 * 1024;
    for (int o = F.tid; o < 9 * 1024; o += 512) { const float cv = (o < 8 * 1024) ? c[o] : c_ctx[o - 8 * 1024]; sc[o] = silu_f(cv); }
    __syncthreads();
    for (int it = wgi; it < 2 * 96; it += nwg) {
        const int l = it / 96, cb = it % 96, n = cb * 64 + F.lane;
        const float* W = w_mod + (size_t)l * 1024 * 6144;
        float acc[9];
#pragma unroll
        for (int r = 0; r < 9; ++r) acc[r] = 0.f;
        const int kbeg = F.wave * 128;
#pragma unroll 1
        for (int k8 = 0; k8 < 128; k8 += 16) { float w[16];
#pragma unroll
            for (int j = 0; j < 16; ++j) w[j] = W[(size_t)(kbeg + k8 + j) * 6144 + n];
#pragma unroll
            for (int j = 0; j < 16; ++j)
#pragma unroll
                for (int r = 0; r < 9; ++r) acc[r] += sc[r * 1024 + kbeg + k8 + j] * w[j]; }
#pragma unroll
        for (int r = 0; r < 9; ++r) red[(F.wave * 9 + r) * 64 + F.lane] = acc[r];
        __syncthreads();
        for (int o = F.tid; o < 9 * 64; o += 512) { const int r = o >> 6, ln = o & 63; float s = 0.f;
#pragma unroll
            for (int w = 0; w < 8; ++w) s += red[(w * 9 + r) * 64 + ln];
            MOD[((size_t)l * 9 + r) * 6144 + cb * 64 + ln] = s + b_mod[l * 6144 + cb * 64 + ln]; }
        __syncthreads();
    }
    __syncthreads();
}
DI void prep_rope(const Frame& F, float* ROPE, int first_wg) {
    if ((int)blockIdx.x < first_wg) return;
    for (int idx = ((int)blockIdx.x - first_wg) * 512 + F.tid; idx < 2048 * 32; idx += (F.G - first_wg) * 512) {
        const int t = idx >> 5, j = idx & 31, i = j & 15;
        const float inv = powf(10000.f, -(float)(2 * i) / 32.f);
        const float pos = (j < 16) ? (float)(t >> 6) : (float)(t & 63);
        const float a = pos * inv;
        ROPE[t * 64 + j] = cosf(a); ROPE[t * 64 + 32 + j] = sinf(a);
    }
}

DI void prep_s5(const Frame& F, const LayerIn& P, unsigned char* ws, int wg_off = 0) {
    const int wgi = (int)blockIdx.x - wg_off;
    if (wgi < 0 || wgi >= 96) return;
    LAS float* pw = (LAS float*)F.lds;
    LAS float* bb = pw + 8448;
    LAS float* Kt = bb + 4096;
    LAS float* cc = Kt + 16896;
    LAS float* prm = cc + 2048;
    for (int it = wgi; it < 96; it += F.G) {
        const int g = it >> 2, qt = it & 3;
        for (int o = F.tid; o < 2048; o += 512) cc[o] = (o < 1024) ? P.s5_cre[(size_t)g * 1024 + o] : P.s5_cim[(size_t)g * 1024 + o - 1024];
        for (int o = F.tid; o < 2048; o += 512) prm[264 + o] = (o < 1024) ? P.s5_bre[(size_t)g * 1024 + o] : P.s5_bim[(size_t)g * 1024 + o - 1024];
        if (F.tid < 256) { const int d = (F.tid >> 6) & 1, p = F.tid & 63; prm[F.tid] = (F.tid < 128) ? P.s5_lre[(d * 24 + g) * 64 + p] : P.s5_lim[(d * 24 + g) * 64 + p]; }
        if (F.tid < 2) prm[256 + F.tid] = __expf(P.s5_lstep[F.tid * 24 + g]);
        __syncthreads();
        if (F.tid < 128) { const int d = F.tid >> 6, p = F.tid & 63;
            const float step = prm[256 + d], lr = prm[d * 64 + p], li = prm[128 + d * 64 + p];
            const float th = li * step, sh = sinf(0.5f * th);
            const float mag = expf(lr * step), abi = mag * sinf(th);
            const float nr = expm1f(lr * step) - 2.f * mag * sh * sh, ni = abi;
            const float den = lr * lr + li * li;
            const float cr = (nr * lr + ni * li) / den, ci = (ni * lr - nr * li) / den;
#pragma unroll
            for (int j = 0; j < 16; ++j) { const float br = prm[264 + p * 16 + j], bi = prm[264 + 1024 + p * 16 + j];
                bb[((d * 64 + p) * 16 + j) * 2 + 0] = cr * br - ci * bi; bb[((d * 64 + p) * 16 + j) * 2 + 1] = cr * bi + ci * br; } }
        for (int o = F.tid; o < 2 * 64 * 33; o += 512) { const int dp = o / 33, tau = o % 33, d = dp >> 6, p = dp & 63;
            const float step = prm[256 + d], lr = prm[d * 64 + p], li = prm[128 + d * 64 + p];
            const float m = __expf(lr * step * (float)tau), a = li * step * (float)tau;
            pw[o * 2 + 0] = m * __cosf(a); pw[o * 2 + 1] = m * __sinf(a); }
        __syncthreads();
        for (int o = F.tid; o < 1024; o += 512) { const int d = o >> 9, a = (o >> 5) & 15, tau = o & 31; float s[16];
#pragma unroll
            for (int b_ = 0; b_ < 16; ++b_) s[b_] = 0.f;
            for (int p = 0; p < 64; ++p) { const float cre = cc[a * 64 + p], cim = cc[1024 + a * 64 + p];
                const f32x2 lp = *(const LAS f32x2*)(pw + ((d * 64 + p) * 33 + tau) * 2);
                const float wr_ = cre * lp[0] - cim * lp[1], wi_ = cre * lp[1] + cim * lp[0];
                const LAS f32x4* bp = (const LAS f32x4*)(bb + (d * 64 + p) * 32);
#pragma unroll
                for (int q4 = 0; q4 < 8; ++q4) { const f32x4 t = bp[q4]; s[2 * q4] += wr_ * t[0] - wi_ * t[1]; s[2 * q4 + 1] += wr_ * t[2] - wi_ * t[3]; } }
#pragma unroll
            for (int b_ = 0; b_ < 16; ++b_) Kt[((d * 16 + a) * 16 + b_) * 33 + tau] = s[b_]; }
        __syncthreads();
        bf16_t* TQ = (bf16_t*)(ws + W_TQ) + (size_t)g * 512 * 768;
        for (int o = F.tid; o < 128 * 64; o += 512) { const int row = qt * 128 + (o >> 6), ch = o & 63, i = row >> 4, a = row & 15, b0 = (ch >> 5) * 8, j = ch & 31; float v[8];
#pragma unroll
            for (int k = 0; k < 8; ++k) { float s_ = 0.f;
                if (j <= i) s_ += Kt[((0 * 16 + a) * 16 + b0 + k) * 33 + (i - j)];
                if (j >= i) s_ += Kt[((1 * 16 + a) * 16 + b0 + k) * 33 + (j - i)];
                v[k] = s_; }
            *(u32x4*)(TQ + (size_t)row * 768 + j * 16 + b0) = pack8(v); }
        for (int o = F.tid; o < 128 * 128; o += 512) { const int row = qt * 128 + (o >> 7), dp = o & 127, d = dp >> 6, p = dp & 63, i = row >> 4, a = row & 15; const int tau = d == 0 ? (i + 1) : (32 - i);
            const float cre = cc[a * 64 + p], cim = cc[1024 + a * 64 + p];
            const f32x2 lp = *(const LAS f32x2*)(pw + ((d * 64 + p) * 33 + tau) * 2);
            TQ[(size_t)row * 768 + 512 + d * 128 + p] = (bf16_t)f2bf(cre * lp[0] - cim * lp[1]);
            TQ[(size_t)row * 768 + 512 + d * 128 + 64 + p] = (bf16_t)f2bf(-(cre * lp[1] + cim * lp[0])); }
        bf16_t* PP = (bf16_t*)(ws + W_P) + (size_t)g * 256 * 512;
        for (int o = F.tid; o < 2 * 16 * 32; o += 512) { const int d = o >> 9, p = qt * 16 + ((o >> 5) & 15), j = o & 31; const int tau = d == 0 ? (31 - j) : j;
            const f32x2 lp = *(const LAS f32x2*)(pw + ((d * 64 + p) * 33 + tau) * 2);
            const LAS f32x4* bp = (const LAS f32x4*)(bb + (d * 64 + p) * 32);
            float vr[16], vi[16];
#pragma unroll
            for (int q4 = 0; q4 < 8; ++q4) { const f32x4 t = bp[q4];
                vr[2 * q4] = lp[0] * t[0] - lp[1] * t[1]; vi[2 * q4] = lp[0] * t[1] + lp[1] * t[0];
                vr[2 * q4 + 1] = lp[0] * t[2] - lp[1] * t[3]; vi[2 * q4 + 1] = lp[0] * t[3] + lp[1] * t[2]; }
            float h0[8], h1[8];
#pragma unroll
            for (int k = 0; k < 8; ++k) { h0[k] = vr[k]; h1[k] = vr[8 + k]; }
            bf16_t* pr = PP + (size_t)(d * 128 + p) * 512 + j * 16;
            *(u32x4*)pr = pack8(h0); *(u32x4*)(pr + 8) = pack8(h1);
#pragma unroll
            for (int k = 0; k < 8; ++k) { h0[k] = vi[k]; h1[k] = vi[8 + k]; }
            bf16_t* pi = PP + (size_t)(d * 128 + 64 + p) * 512 + j * 16;
            *(u32x4*)pi = pack8(h0); *(u32x4*)(pi + 8) = pack8(h1); }
        __syncthreads();
    }
}

struct RowCtx { int R, b, p, isctx, mrow; };
DI RowCtx row_ctx(int R) { RowCtx r; r.R = R; r.b = R / PB; r.p = R - r.b * PB; r.isctx = r.p < CTXL; r.mrow = r.isctx ? 8 : r.b; return r; }
struct WaveRows { int b, pa, pb; };
DI WaveRows wave_rows(int wg, int nwb, int p0, int np, int wave) {
    const int b = wg / nwb, j = wg - b * nwb;
    const int lo = p0 + (j * np) / nwb, hi = p0 + ((j + 1) * np) / nwb, per = (hi - lo + NWAVES - 1) / NWAVES;
    WaveRows w; w.b = b; w.pa = min(lo + wave * per, hi); w.pb = min(w.pa + per, hi); return w;
}
DI const float* stream_in(const float* x_in, const float* ctx_in, int b, int p) { return (p < CTXL) ? ctx_in + ((size_t)b * CTXL + p) * 1024 : x_in + ((size_t)b * SEQ + (p - CTXL)) * 1024; }
template <int N> DI void wave_sum_n(float (&v)[N]) {
#pragma unroll
    for (int o = 1; o < 64; o <<= 1) {
        float t[N];
#pragma unroll
        for (int k = 0; k < N; ++k) t[k] = __shfl_xor(v[k], o);
#pragma unroll
        for (int k = 0; k < N; ++k) v[k] += t[k]; }
}
DI float row_ssq(const f32x4 (&x)[4]) {
    float ss = 0.f;
#pragma unroll
    for (int j = 0; j < 4; ++j) ss += (x[j][0] * x[j][0] + x[j][1] * x[j][1]) + (x[j][2] * x[j][2] + x[j][3] * x[j][3]);
    return ss;
}
DI void row_store_bf16(int lane, const f32x4 (&h)[4], bf16_t* dst) {
#pragma unroll
    for (int j = 0; j < 4; ++j) { u32x2 w; w.x = pk2(h[j][0], h[j][1]); w.y = pk2(h[j][2], h[j][3]); *(u32x2*)(dst + j * 256 + 4 * lane) = w; }
}
DI void add_gated_bf16(f32x4 (&x)[4], const u32x2 (&y)[4], const LAS float* gate, int lane) {
#pragma unroll
    for (int j = 0; j < 4; ++j) { const f32x4 g = *(const LAS f32x4*)(gate + j * 256 + 4 * lane);
        x[j][0] += g[0] * bflo(y[j].x); x[j][1] += g[1] * bfhi(y[j].x); x[j][2] += g[2] * bflo(y[j].y); x[j][3] += g[3] * bfhi(y[j].y); }
}
DI __amdgpu_buffer_rsrc_t ye_resource(const bf16_t* YE) { return __builtin_amdgcn_make_buffer_rsrc((void*)YE, 0, 16 * EROWS * 2048, 0x00020000); }
DI unsigned combine_issue(const __amdgpu_buffer_rsrc_t rs, const int myinv, const int lane, u32x2 (&ye)[4][4]) {
    unsigned mask = (unsigned)__ballot(myinv >= 0) & 0xFFFFu;
#pragma unroll
    for (int s = 0; s < 4; ++s) { const bool has = mask != 0u; const int e = has ? __builtin_ctz(mask) : 0; mask &= mask - 1u;
        const int er = __builtin_amdgcn_readlane(myinv, e);
        const unsigned off = has ? (unsigned)er * 2048u + (unsigned)lane * 8u : 0x80000000u;
#pragma unroll
        for (int j = 0; j < 4; ++j) ye[s][j] = __builtin_amdgcn_raw_buffer_load_b64(rs, off + j * 512, 0, 0); }
    return mask;
}
DI void combine_add(f32x4 (&x)[4], const u32x2 (&ye)[4][4], unsigned rest, const int myinv, const bf16_t* YE, const LAS float* gate, int lane) {
    f32x4 s[4];
#pragma unroll
    for (int j = 0; j < 4; ++j) { s[j][0] = (bflo(ye[0][j].x) + bflo(ye[1][j].x)) + (bflo(ye[2][j].x) + bflo(ye[3][j].x)); s[j][1] = (bfhi(ye[0][j].x) + bfhi(ye[1][j].x)) + (bfhi(ye[2][j].x) + bfhi(ye[3][j].x));
        s[j][2] = (bflo(ye[0][j].y) + bflo(ye[1][j].y)) + (bflo(ye[2][j].y) + bflo(ye[3][j].y)); s[j][3] = (bfhi(ye[0][j].y) + bfhi(ye[1][j].y)) + (bfhi(ye[2][j].y) + bfhi(ye[3][j].y)); }
    while (rest) { const int e = __builtin_ctz(rest); rest &= rest - 1u; const int er = __builtin_amdgcn_readlane(myinv, e); const bf16_t* yr = YE + (size_t)er * 1024 + 4 * lane;
#pragma unroll
        for (int j = 0; j < 4; ++j) { const u32x2 w = *(const u32x2*)(yr + j * 256); s[j][0] += bflo(w.x); s[j][1] += bfhi(w.x); s[j][2] += bflo(w.y); s[j][3] += bfhi(w.y); } }
#pragma unroll
    for (int j = 0; j < 4; ++j) x[j] += *(const LAS f32x4*)(gate + j * 256 + 4 * lane) * s[j];
}

template <bool COMBINE, int RPW>
DI void phase_norm1(const Frame& F, int layer, const float* x_in, const float* ctx_in, bf16_t* X, bf16_t* H1, const float* MOD, const float* gmix, const int* INV, const bf16_t* YE, const bf16_t* Y, int first_wg) {
    if ((int)blockIdx.x < first_wg) return;
    const WaveRows wr = wave_rows((int)blockIdx.x - first_wg, (F.G - first_wg) / NB, 0, PB, F.wave);
    LAS float* ml = (LAS float*)F.lds;
    { const float* modl = MOD + (size_t)layer * 9 * 6144; const float* modp = MOD + (size_t)(COMBINE ? layer - 1 : 0) * 9 * 6144;
      for (int idx = F.tid; idx < 2048; idx += NWAVES * 64) { const int set = idx >> 10, c = idx & 1023; const size_t mo = (size_t)(set ? 8 : wr.b) * 6144;
          if (COMBINE) { ml[(set * 4 + 0) * 1024 + c] = modp[mo + 2 * 1024 + c]; ml[(set * 4 + 1) * 1024 + c] = modp[mo + 5 * 1024 + c]; }
          ml[(set * 4 + 2) * 1024 + c] = gmix[c] * (1.f + modl[mo + 1024 + c]); ml[(set * 4 + 3) * 1024 + c] = modl[mo + c]; } }
    __syncthreads();
    const __amdgpu_buffer_rsrc_t rs = ye_resource(YE);
    for (int p = wr.pa; p < wr.pb; p += RPW) {
        f32x4 x[RPW][4]; u32x2 y[RPW][4]; int inv[RPW]; size_t Rk[RPW]; const LAS float* mk[RPW];
#pragma unroll
        for (int k = 0; k < RPW; ++k) { const int pk = min(p + k, wr.pb - 1); Rk[k] = (size_t)wr.b * PB + pk; mk[k] = ml + (pk < CTXL ? 4096 : 0);
            const float* src = stream_in(x_in, ctx_in, wr.b, pk);
#pragma unroll
            for (int j = 0; j < 4; ++j) x[k][j] = *(const f32x4*)(src + j * 256 + 4 * F.lane);
            if (COMBINE) { inv[k] = (F.lane < 16) ? INV[Rk[k] * 16 + F.lane] : -1;
#pragma unroll
                for (int j = 0; j < 4; ++j) y[k][j] = *(const u32x2*)(Y + Rk[k] * 1024 + j * 256 + 4 * F.lane); } }
        if (COMBINE) {
            u32x2 ye[RPW][4][4]; unsigned rest[RPW];
#pragma unroll
            for (int k = 0; k < RPW; ++k) rest[k] = combine_issue(rs, inv[k], F.lane, ye[k]);
#pragma unroll
            for (int k = 0; k < RPW; ++k) add_gated_bf16(x[k], y[k], mk[k], F.lane);
#pragma unroll
            for (int k = 0; k < RPW; ++k) { combine_add(x[k], ye[k], rest[k], inv[k], YE, mk[k] + 1024, F.lane);
#pragma unroll
                for (int j = 0; j < 4; ++j) { u32x2 w; w.x = pk2(x[k][j][0], x[k][j][1]); w.y = pk2(x[k][j][2], x[k][j][3]); *(u32x2*)(X + Rk[k] * 1024 + j * 256 + 4 * F.lane) = w; } }
        }
        float ss[RPW];
#pragma unroll
        for (int k = 0; k < RPW; ++k) ss[k] = row_ssq(x[k]);
        wave_sum_n<RPW>(ss);
#pragma unroll
        for (int k = 0; k < RPW; ++k) { const float rstd = __builtin_amdgcn_rsqf(ss[k] * (1.f / 1024.f) + RMS_EPS);
#pragma unroll
            for (int j = 0; j < 4; ++j) x[k][j] = x[k][j] * rstd * *(const LAS f32x4*)(mk[k] + 2048 + j * 256 + 4 * F.lane) + *(const LAS f32x4*)(mk[k] + 3072 + j * 256 + 4 * F.lane);
            row_store_bf16(F.lane, x[k], H1 + Rk[k] * 1024); }
    }
    __syncthreads();
}
template <int RPW>
DI void phase_final(const Frame& F, const bf16_t* X, float* out, const float* MOD, const float* gfin, const int* INV, const bf16_t* YE, const bf16_t* Y) {
    const WaveRows wr = wave_rows((int)blockIdx.x, F.G / NB, CTXL, SEQ, F.wave);
    LAS float* ml = (LAS float*)F.lds;
    for (int c = F.tid; c < 1024; c += NWAVES * 64) { const float* mr = MOD + (size_t)(9 + wr.b) * 6144; ml[c] = mr[2 * 1024 + c]; ml[1024 + c] = mr[5 * 1024 + c]; ml[2048 + c] = gfin[c]; }
    __syncthreads();
    const __amdgpu_buffer_rsrc_t rs = ye_resource(YE);
    for (int p = wr.pa; p < wr.pb; p += RPW) {
        f32x4 x[RPW][4]; u32x2 y[RPW][4]; int inv[RPW]; size_t Rk[RPW];
#pragma unroll
        for (int k = 0; k < RPW; ++k) { const int pk = min(p + k, wr.pb - 1); Rk[k] = (size_t)wr.b * PB + pk;
#pragma unroll
            for (int j = 0; j < 4; ++j) { const u32x2 w = *(const u32x2*)(X + Rk[k] * 1024 + j * 256 + 4 * F.lane); x[k][j] = (f32x4){bflo(w.x), bfhi(w.x), bflo(w.y), bfhi(w.y)}; }
            inv[k] = (F.lane < 16) ? INV[Rk[k] * 16 + F.lane] : -1;
#pragma unroll
            for (int j = 0; j < 4; ++j) y[k][j] = *(const u32x2*)(Y + Rk[k] * 1024 + j * 256 + 4 * F.lane); }
        u32x2 ye[RPW][4][4]; unsigned rest[RPW];
#pragma unroll
        for (int k = 0; k < RPW; ++k) rest[k] = combine_issue(rs, inv[k], F.lane, ye[k]);
#pragma unroll
        for (int k = 0; k < RPW; ++k) add_gated_bf16(x[k], y[k], ml, F.lane);
#pragma unroll
        for (int k = 0; k < RPW; ++k) combine_add(x[k], ye[k], rest[k], inv[k], YE, ml + 1024, F.lane);
        float ss[RPW];
#pragma unroll
        for (int k = 0; k < RPW; ++k) ss[k] = row_ssq(x[k]);
        wave_sum_n<RPW>(ss);
#pragma unroll
        for (int k = 0; k < RPW; ++k) { const float rstd = __builtin_amdgcn_rsqf(ss[k] * (1.f / 1024.f) + RMS_EPS);
            float* o = out + ((size_t)wr.b * SEQ + (min(p + k, wr.pb - 1) - CTXL)) * 1024;
#pragma unroll
            for (int j = 0; j < 4; ++j) *(f32x4*)(o + j * 256 + 4 * F.lane) = x[k][j] * rstd * *(const LAS f32x4*)(ml + 2048 + j * 256 + 4 * F.lane); }
    }
}

DI float router_butterfly(const float (&s16)[16], int lane, int& e_out) {
    const bool b5 = (lane & 32) != 0, b4 = (lane & 16) != 0, b3 = (lane & 8) != 0, b2 = (lane & 4) != 0;
    float t8[8], u4[4], w2[2];
#pragma unroll
    for (int k = 0; k < 8; ++k) { const float keep = b5 ? s16[k + 8] : s16[k], send = b5 ? s16[k] : s16[k + 8]; t8[k] = keep + __shfl_xor(send, 32); }
#pragma unroll
    for (int k = 0; k < 4; ++k) { const float keep = b4 ? t8[k + 4] : t8[k], send = b4 ? t8[k] : t8[k + 4]; u4[k] = keep + __shfl_xor(send, 16); }
#pragma unroll
    for (int k = 0; k < 2; ++k) { const float keep = b3 ? u4[k + 2] : u4[k], send = b3 ? u4[k] : u4[k + 2]; w2[k] = keep + __shfl_xor(send, 8); }
    float z; { const float keep = b2 ? w2[1] : w2[0], send = b2 ? w2[0] : w2[1]; z = keep + __shfl_xor(send, 4); }
    z += __shfl_xor(z, 2); z += __shfl_xor(z, 1);
    e_out = (b5 ? 8 : 0) + (b4 ? 4 : 0) + (b3 ? 2 : 0) + (b2 ? 1 : 0);
    return z;
}
template <int RPW>
DI void phase_norm2(const Frame& F, int layer, bool skipctx, const float* x_in, const float* ctx_in, const bf16_t* X, const bf16_t* Y, bf16_t* H2, const float* MOD, const float* gffn, const float* w_router, float* AFF) {
    constexpr int WP = 1028;
    LAS float* wl = (LAS float*)F.lds;
    LAS float* ml = wl + 16 * WP;
    const WaveRows wr = wave_rows((int)blockIdx.x, F.G / NB, skipctx ? CTXL : 0, skipctx ? SEQ : PB, F.wave);
    for (int idx = F.tid; idx < 16384; idx += NWAVES * 64) wl[(idx & 15) * WP + (idx >> 4)] = w_router[idx];
    { const float* modl = MOD + (size_t)layer * 9 * 6144;
      for (int idx = F.tid; idx < 2048; idx += NWAVES * 64) { const int set = idx >> 10, c = idx & 1023; const float* mr = modl + (size_t)(set ? 8 : wr.b) * 6144;
          ml[(set * 3 + 0) * 1024 + c] = mr[2 * 1024 + c]; ml[(set * 3 + 1) * 1024 + c] = gffn[c] * (1.f + mr[4 * 1024 + c]); ml[(set * 3 + 2) * 1024 + c] = mr[3 * 1024 + c]; } }
    __syncthreads();
    for (int p = wr.pa; p < wr.pb; p += RPW) {
        f32x4 x[RPW][4]; int pk[RPW]; size_t Rk[RPW]; const LAS float* mk[RPW];
        { u32x2 y[RPW][4];
#pragma unroll
          for (int k = 0; k < RPW; ++k) { pk[k] = min(p + k, wr.pb - 1); Rk[k] = (size_t)wr.b * PB + pk[k]; mk[k] = ml + (pk[k] < CTXL ? 3072 : 0);
              if (layer > 0) {
#pragma unroll
                  for (int j = 0; j < 4; ++j) { const u32x2 w = *(const u32x2*)(X + Rk[k] * 1024 + j * 256 + 4 * F.lane); x[k][j] = (f32x4){bflo(w.x), bfhi(w.x), bflo(w.y), bfhi(w.y)}; }
              } else { const float* src = stream_in(x_in, ctx_in, wr.b, pk[k]);
#pragma unroll
                  for (int j = 0; j < 4; ++j) x[k][j] = *(const f32x4*)(src + j * 256 + 4 * F.lane); }
#pragma unroll
              for (int j = 0; j < 4; ++j) y[k][j] = *(const u32x2*)(Y + Rk[k] * 1024 + j * 256 + 4 * F.lane); }
#pragma unroll
          for (int k = 0; k < RPW; ++k) add_gated_bf16(x[k], y[k], mk[k], F.lane); }
        float ss[RPW];
#pragma unroll
        for (int k = 0; k < RPW; ++k) ss[k] = row_ssq(x[k]);
        wave_sum_n<RPW>(ss);
#pragma unroll
        for (int k = 0; k < RPW; ++k) { const float rstd = __builtin_amdgcn_rsqf(ss[k] * (1.f / 1024.f) + RMS_EPS);
#pragma unroll
            for (int j = 0; j < 4; ++j) x[k][j] = x[k][j] * rstd * *(const LAS f32x4*)(mk[k] + 1024 + j * 256 + 4 * F.lane) + *(const LAS f32x4*)(mk[k] + 2048 + j * 256 + 4 * F.lane);
            row_store_bf16(F.lane, x[k], H2 + Rk[k] * 1024); }
        float s16[RPW][16];
        int wofs = 4 * F.lane; asm volatile("" : "+v"(wofs));
#pragma unroll
        for (int e = 0; e < 16; ++e) {
            f32x4 w[4];
#pragma unroll
            for (int j = 0; j < 4; ++j) w[j] = *(const LAS f32x4*)(wl + e * WP + j * 256 + wofs);
#pragma unroll
            for (int k = 0; k < RPW; ++k) { float s = 0.f;
#pragma unroll
                for (int j = 0; j < 4; ++j) s += (x[k][j][0] * w[j][0] + x[k][j][1] * w[j][1]) + (x[k][j][2] * w[j][2] + x[k][j][3] * w[j][3]);
                s16[k][e] = s; }
            if ((e & 3) == 3) __builtin_amdgcn_sched_barrier(0);
        }
        float aff[RPW]; int ek = 0;
#pragma unroll
        for (int k = 0; k < RPW; ++k) { int e; const float z = router_butterfly(s16[k], F.lane, e);
            float mx = z;
            mx = fmaxf(mx, __shfl_xor(mx, 32)); mx = fmaxf(mx, __shfl_xor(mx, 16)); mx = fmaxf(mx, __shfl_xor(mx, 8)); mx = fmaxf(mx, __shfl_xor(mx, 4));
            const float mine = expf(z - mx);
            float den = mine;
            den += __shfl_xor(den, 32); den += __shfl_xor(den, 16); den += __shfl_xor(den, 8); den += __shfl_xor(den, 4);
            aff[k] = mine / den; ek = e; }
        if ((F.lane & 3) == 0) {
#pragma unroll
            for (int k = 0; k < RPW; ++k) AFF[((size_t)wr.b * 16 + ek) * PB + pk[k]] = aff[k]; }
    }
    __syncthreads();
}

DI int block_exscan(const Frame& F, int v, LAS int* wtot, int& total) {
    int incl = v; const int sl = lane_op();
#pragma unroll
    for (int o = 1; o < 64; o <<= 1) { const int t = shup(incl, o, sl); if (sl >= o) incl += t; }
    if (F.lane == 63) wtot[F.wave] = incl;
    __syncthreads();
    int base = 0; total = 0;
#pragma unroll
    for (int w = 0; w < 8; ++w) { const int x = wtot[w]; if (w < F.wave) base += x; total += x; }
    __syncthreads();
    return base + incl - v;
}
DI void phase_topk(const Frame& F, int nitems, const float* AFF, int* SRC, float* GV, int* INV) {
    LAS int* wcnt = (LAS int*)F.lds;
    LAS int* wtot = wcnt + 48;
    for (int it = blockIdx.x; it < nitems; it += F.G) {
        const int isctx = it >= 128, be = it & 127, b = be >> 4, e = be & 15;
        const int n = isctx ? CTXL : SEQ, cap = isctx ? 32 : 256, p0 = isctx ? 0 : CTXL;
        const float* a = AFF + ((size_t)b * 16 + e) * PB + p0;
        unsigned v[4]; float av[4];
#pragma unroll
        for (int k = 0; k < 4; ++k) { const int idx = 4 * F.tid + k; av[k] = idx < n ? a[idx] : 0.f; v[k] = __builtin_bit_cast(unsigned, av[k]); }
        unsigned prefix = 0u;
        for (int b0 = 28; b0 >= 0; b0 -= 2) {
            const unsigned c3 = prefix | (3u << b0), c2 = prefix | (2u << b0), c1 = prefix | (1u << b0);
            int n3 = 0, n2 = 0, n1 = 0;
#pragma unroll
            for (int k = 0; k < 4; ++k) { n3 += __popcll(__ballot(v[k] >= c3)); n2 += __popcll(__ballot(v[k] >= c2)); n1 += __popcll(__ballot(v[k] >= c1)); }
            LAS int* wc = wcnt + ((b0 >> 1) & 1) * 24;
            if (F.lane == 0) { wc[F.wave] = n3; wc[8 + F.wave] = n2; wc[16 + F.wave] = n1; }
            __syncthreads();
            int t3 = 0, t2 = 0, t1 = 0;
#pragma unroll
            for (int w = 0; w < 8; ++w) { t3 += wc[w]; t2 += wc[8 + w]; t1 += wc[16 + w]; }
            prefix = (t3 >= cap) ? c3 : (t2 >= cap) ? c2 : (t1 >= cap) ? c1 : prefix;
        }
        __syncthreads();
        int ngt_t = 0, neq_t = 0;
#pragma unroll
        for (int k = 0; k < 4; ++k) { ngt_t += (v[k] > prefix) ? 1 : 0; neq_t += (v[k] == prefix) ? 1 : 0; }
        int ngt_total, neq_total;
        (void)block_exscan(F, ngt_t, wtot, ngt_total);
        int eq_rank = block_exscan(F, neq_t, wtot, neq_total);
        const int eq_take = cap - ngt_total;
        int sel[4], nsel_t = 0;
#pragma unroll
        for (int k = 0; k < 4; ++k) { int s = 0; if (v[k] > prefix) s = 1; else if (v[k] == prefix) { s = (eq_rank < eq_take) ? 1 : 0; ++eq_rank; } sel[k] = s; nsel_t += s; }
        int nsel_total;
        int slot = block_exscan(F, nsel_t, wtot, nsel_total);
        const int ebase = e * EROWS + (isctx ? 2048 + b * 32 : b * 256);
#pragma unroll
        for (int k = 0; k < 4; ++k) { const int idx = 4 * F.tid + k;
            if (idx < n) { const int R = b * PB + p0 + idx;
                if (sel[k]) { const int er = ebase + slot; ++slot; SRC[er] = R; GV[er] = av[k]; INV[(size_t)R * 16 + e] = er; }
                else INV[(size_t)R * 16 + e] = -1; } }
        __syncthreads();
    }
}
DI void phase_gather(const Frame& F, int rows_per_expert, const int* __restrict__ SRC, const bf16_t* __restrict__ H2, bf16_t* __restrict__ XG) {
    const int total = 16 * rows_per_expert;
    for (int q = F.gw * 4; q < total; q += F.NGW * 4) {
        const int e = q / rows_per_expert, s = q - e * rows_per_expert, er = e * EROWS + s;
        int R[4];
#pragma unroll
        for (int u = 0; u < 4; ++u) R[u] = SRC[er + u];
        u32x4 v0[4], v1[4];
#pragma unroll
        for (int u = 0; u < 4; ++u) { v0[u] = *(const u32x4*)(H2 + (size_t)R[u] * 1024 + 8 * F.lane); v1[u] = *(const u32x4*)(H2 + (size_t)R[u] * 1024 + 512 + 8 * F.lane); }
#pragma unroll
        for (int u = 0; u < 4; ++u) { *(u32x4*)(XG + (size_t)(er + u) * 1024 + 8 * F.lane) = v0[u]; *(u32x4*)(XG + (size_t)(er + u) * 1024 + 512 + 8 * F.lane) = v1[u]; }
    }
}

DI void qk_norm_rope(const float (&vin)[8], int ll, const float (&gn)[8], const float (&c)[8], const float (&sn)[8], float scale, float (&o)[8]) {
    float v[8]; float ss = 0.f;
#pragma unroll
    for (int k = 0; k < 8; ++k) ss += vin[k] * vin[k];
    ss += __shfl_xor(ss, 1); ss += __shfl_xor(ss, 2); ss += __shfl_xor(ss, 4);
    const float rstd = __builtin_amdgcn_rsqf(ss * (1.f / 64.f) + RMS_EPS) * scale;
#pragma unroll
    for (int k = 0; k < 8; ++k) v[k] = vin[k] * rstd * gn[k];
    const bool isx2 = (ll & 2) != 0;
#pragma unroll
    for (int k = 0; k < 8; ++k) { const float pv = __shfl_xor(v[k], 2); o[k] = isx2 ? (v[k] * c[k] + pv * sn[k]) : (v[k] * c[k] - pv * sn[k]); }
}
DI void ld8(const float* p, float (&o)[8]) { const f32x4 a = *(const f32x4*)p, b = *(const f32x4*)(p + 4); o[0] = a[0]; o[1] = a[1]; o[2] = a[2]; o[3] = a[3]; o[4] = b[0]; o[5] = b[1]; o[6] = b[2]; o[7] = b[3]; }
DI void phase_elem(const Frame& F, const LayerIn& P, const bf16_t* __restrict__ PA, const float* __restrict__ ROPE, bf16_t* __restrict__ QN, bf16_t* __restrict__ KN, bf16_t* __restrict__ XBC,
                   float* __restrict__ DT, bf16_t* __restrict__ AU, bf16_t* __restrict__ YCD) {
    const int l = F.lane;
    constexpr int NGRP = MROWS / 4;
    for (int task = F.gw; task < 2 * NGRP; task += F.NGW) {
        const int part = task / NGRP, R0 = (task - part * NGRP) * 4;
        const RowCtx rc = row_ctx(R0);
        const bf16_t* pr = PA + (size_t)R0 * PA_W;
        const bool has_prev = (rc.p != 0) && (rc.p != CTXL), has_next = (rc.p + 3 != CTXL - 1) && (rc.p + 3 != PB - 1);
        const bool rope = !rc.isctx; const int t0 = rope ? rc.p - CTXL : 0;
        if (part == 0) {
            const bool v1 = l < 32;
            u32x4 w[2][6]; float cw[2][4][8];
            const int uk = l >> 4; const bf16_t dtr = pr[(size_t)uk * PA_W + C_DT + (l & 7)]; const float dtb = P.ssd_dt_bias[((l >> 3) & 1) * 8 + (l & 7)];
#pragma unroll
            for (int ps = 0; ps < 2; ++ps) { const int ch = (ps * 64 + l) * 8;
#pragma unroll
                for (int u = 0; u < 6; ++u) { const bool ok = ((u == 0) ? has_prev : (u == 5) ? has_next : true) && (ps == 0 || v1);
                    w[ps][u] = ok ? *(const u32x4*)(pr + (ptrdiff_t)(u - 1) * PA_W + C_XBC + ch) : (u32x4){0u, 0u, 0u, 0u}; } }
#pragma unroll
            for (int ps = 0; ps < 2; ++ps) { const int ch = (ps == 0 || v1) ? (ps * 64 + l) * 8 : 0;
                ld8(P.ssd_conv_w + ch, cw[ps][0]); ld8(P.ssd_conv_w + 768 + ch, cw[ps][1]); ld8(P.ssd_conv_w + 1536 + ch, cw[ps][2]); ld8(P.ssd_conv_b + ch, cw[ps][3]); }
            { const int d = (l >> 3) & 1, h = l & 7; DT[((size_t)d * MROWS + R0 + uk) * 8 + h] = softplus_f(bf2f(dtr) + dtb); }
#pragma unroll
            for (int ps = 0; ps < 2; ++ps) { const int ch = (ps * 64 + l) * 8;
                float a[8], b[8], c[8]; unpack8(w[ps][0], a); unpack8(w[ps][1], b);
#pragma unroll
                for (int u = 0; u < 4; ++u) { unpack8(w[ps][u + 2], c); float o[8];
#pragma unroll
                    for (int k = 0; k < 8; ++k) { o[k] = silu_f(cw[ps][0][k] * a[k] + cw[ps][1][k] * b[k] + cw[ps][2][k] * c[k] + cw[ps][3][k]); a[k] = b[k]; b[k] = c[k]; }
                    if (ps == 0 || v1) *(u32x4*)(XBC + (size_t)(R0 + u) * 768 + ch) = pack8(o); } }
        } else if (l < 48) {
            const int g = l >> 1, a0 = (l & 1) * 8, ch = l * 8;
            u32x4 sb[4], sg[6], sh[6];
#pragma unroll
            for (int u = 0; u < 4; ++u) sb[u] = *(const u32x4*)(pr + (size_t)u * PA_W + C_SB + ch);
#pragma unroll
            for (int u = 0; u < 6; ++u) { const bool ok = (u == 0) ? has_prev : (u == 5) ? has_next : true;
                sg[u] = ok ? *(const u32x4*)(pr + (ptrdiff_t)(u - 1) * PA_W + C_SG + ch) : (u32x4){0u, 0u, 0u, 0u};
                sh[u] = ok ? *(const u32x4*)(pr + (ptrdiff_t)(u - 1) * PA_W + C_SH + ch) : (u32x4){0u, 0u, 0u, 0u}; }
            float w0[8], w1[8], w2[8];
            ld8(P.sc_conv_w + ch, w0); ld8(P.sc_conv_w + 384 + ch, w1); ld8(P.sc_conv_w + 768 + ch, w2);
            float a[8], b[8], c[8], x[8], y[8];
            unpack8(sg[0], x); unpack8(sh[0], y);
#pragma unroll
            for (int k = 0; k < 8; ++k) a[k] = x[k] * y[k];
            unpack8(sg[1], x); unpack8(sh[1], y);
#pragma unroll
            for (int k = 0; k < 8; ++k) b[k] = x[k] * y[k];
#pragma unroll
            for (int u = 0; u < 4; ++u) { unpack8(sg[u + 2], x); unpack8(sh[u + 2], y); float s[8], o[8]; unpack8(sb[u], s);
#pragma unroll
                for (int k = 0; k < 8; ++k) { c[k] = x[k] * y[k]; o[k] = s[k] * (w0[k] * a[k] + w1[k] * b[k] + w2[k] * c[k]); a[k] = b[k]; b[k] = c[k]; }
                *(u32x4*)(YCD + (size_t)(R0 + u) * 768 + 384 + ch) = pack8(o); }
        }
    }
}

typedef short v4i16_t __attribute__((ext_vector_type(4)));
DI int img_off(int row, int chunk) { return row * 128 + ((chunk ^ (row & 7)) << 4); }
DI s16x4 tr_read4(const LAS unsigned char* p) { return __builtin_bit_cast(s16x4, __builtin_amdgcn_ds_read_tr16_b64_v4i16((LAS v4i16_t*)p)); }
DI bf16x8 cat8(s16x4 lo, s16x4 hi) { return (bf16x8){lo[0], lo[1], lo[2], lo[3], hi[0], hi[1], hi[2], hi[3]}; }
DI unsigned cvtpk(float lo, float hi) { typedef __bf16 bf2 __attribute__((ext_vector_type(2))); f32x2 v = {lo, hi}; bf2 b = __builtin_convertvector(v, bf2); return __builtin_bit_cast(unsigned, b); }
#define MFMA32(a, b, c) __builtin_amdgcn_mfma_f32_32x32x16_bf16((a), (b), (c), 0, 0, 0)
DI int crow(int r, int hh) { return (r & 3) + 8 * (r >> 2) + 4 * hh; }

constexpr int SSD_XH = 0, SSD_BM = 65536, SSD_CM = 81920, SSD_ARR = 131072;
DI void ssd_load_images(const Frame& F, const bf16_t* XBC, int R0, int g, bool with_c) {
    int tid_l = F.tid; asm volatile("" : "+v"(tid_l));
#pragma unroll
    for (int it = 0; it < 8; ++it) { const int idx = it * 512 + tid_l, h4 = idx >> 10, row = (idx >> 3) & 127, ch = idx & 7;
        *(LAS u32x4*)(F.lds + SSD_XH + h4 * 16384 + img_off(row, ch)) = *(const u32x4*)(XBC + (size_t)(R0 + row) * 768 + g * 256 + h4 * 64 + ch * 8); }
#pragma unroll
    for (int it = 0; it < 2; ++it) { const int idx = it * 512 + tid_l, row = idx >> 3, ch = idx & 7;
        *(LAS u32x4*)(F.lds + SSD_BM + img_off(row, ch)) = *(const u32x4*)(XBC + (size_t)(R0 + row) * 768 + 512 + g * 64 + ch * 8);
        if (with_c) *(LAS u32x4*)(F.lds + SSD_CM + img_off(row, ch)) = *(const u32x4*)(XBC + (size_t)(R0 + row) * 768 + 640 + g * 64 + ch * 8); }
}
struct Series { float dt0, dt1, cs0, cs1, ecs0, ecs1, tot; };
DI Series ssd_series(const Frame& F, const float* DT, const float* a_log, int R0, int h, int d) {
    Series s; const float a = -__expf(a_log[d * 8 + h]);
    s.dt0 = DT[((size_t)d * MROWS + R0 + 2 * F.lane) * 8 + h]; s.dt1 = DT[((size_t)d * MROWS + R0 + 2 * F.lane + 1) * 8 + h];
    const float ad0 = s.dt0 * a, ad1 = s.dt1 * a, pair = ad0 + ad1; float incl = pair; const int sl = lane_op();
#pragma unroll
    for (int o = 1; o < 64; o <<= 1) { const float t = shup(incl, o, sl); if (sl >= o) incl += t; }
    const float excl = incl - pair;
    s.cs0 = excl + ad0; s.cs1 = incl; s.ecs0 = excl; s.ecs1 = excl + ad0; s.tot = shidx(incl, 63);
    return s;
}

DI void ssd_chunk_states(const Frame& F, const LayerIn& P, const bf16_t* XBC, const float* DT, float* S, float* TOT) {
    LAS float* W = (LAS float*)(F.lds + SSD_ARR);
    const int lane = F.lane, hh = lane >> 5, q = (lane & 15) >> 2, pp = lane & 3, blk = (lane >> 4) & 1;
    const int h4 = F.wave & 3, d = F.wave >> 2;
    for (int it = F.bid; it < 288; it += F.G) {
        const int b = it / 36, r = it % 36, c = r >> 1, g = r & 1, R0 = b * PB + c * 128, h = 4 * g + h4;
        ssd_load_images(F, XBC, R0, g, false);
        const Series s = ssd_series(F, DT, P.ssd_a_log, R0, h, d);
        float w0, w1;
        if (d == 0) { w0 = s.dt0 * __expf(s.tot - s.cs0); w1 = s.dt1 * __expf(s.tot - s.cs1); } else { w0 = s.dt0 * __expf(s.ecs0); w1 = s.dt1 * __expf(s.ecs1); }
        *(LAS f32x2*)(W + F.wave * 128 + 2 * lane) = (f32x2){w0, w1};
        if (lane == 0) TOT[(((size_t)b * 18 + c) * 8 + h) * 2 + d] = s.tot;
        __syncthreads();
        f32x16 acc[2][2];
#pragma unroll
        for (int i = 0; i < 2; ++i)
#pragma unroll
            for (int j = 0; j < 2; ++j)
#pragma unroll
                for (int k = 0; k < 16; ++k) acc[i][j][k] = 0.f;
        const LAS unsigned char* xh = F.lds + SSD_XH + h4 * 16384;
        const LAS unsigned char* bm = F.lds + SSD_BM;
#pragma unroll 2
        for (int st = 0; st < 8; ++st) {
            const int row = 16 * st + 8 * hh + q;
            const f32x4 wa = *(const LAS f32x4*)(W + F.wave * 128 + 16 * st + 8 * hh), wb = *(const LAS f32x4*)(W + F.wave * 128 + 16 * st + 8 * hh + 4);
            bf16x8 af[2], bfr[2];
#pragma unroll
            for (int t = 0; t < 2; ++t) { const int chunk = t * 4 + 2 * blk + (pp >> 1), within = 8 * (pp & 1);
                af[t] = cat8(tr_read4(bm + img_off(row, chunk) + within), tr_read4(bm + img_off(row + 4, chunk) + within));
                const s16x4 lo = tr_read4(xh + img_off(row, chunk) + within), hi = tr_read4(xh + img_off(row + 4, chunk) + within);
                u32x4 pw;
                pw.x = cvtpk(bf2f((bf16_t)lo[0]) * wa[0], bf2f((bf16_t)lo[1]) * wa[1]); pw.y = cvtpk(bf2f((bf16_t)lo[2]) * wa[2], bf2f((bf16_t)lo[3]) * wa[3]);
                pw.z = cvtpk(bf2f((bf16_t)hi[0]) * wb[0], bf2f((bf16_t)hi[1]) * wb[1]); pw.w = cvtpk(bf2f((bf16_t)hi[2]) * wb[2], bf2f((bf16_t)hi[3]) * wb[3]);
                bfr[t] = __builtin_bit_cast(bf16x8, pw); }
#pragma unroll
            for (int nt = 0; nt < 2; ++nt)
#pragma unroll
                for (int pt = 0; pt < 2; ++pt) acc[nt][pt] = MFMA32(af[nt], bfr[pt], acc[nt][pt]);
        }
        float* Sb = S + ((((size_t)b * 18 + c) * 8 + h) * 2 + d) * 4096;
#pragma unroll
        for (int nt = 0; nt < 2; ++nt)
#pragma unroll
            for (int pt = 0; pt < 2; ++pt)
#pragma unroll
                for (int q4 = 0; q4 < 4; ++q4) { const int p = pt * 32 + (lane & 31), n0 = nt * 32 + 8 * q4 + 4 * hh;
                    *(f32x4*)(Sb + p * 64 + n0) = (f32x4){acc[nt][pt][4 * q4], acc[nt][pt][4 * q4 + 1], acc[nt][pt][4 * q4 + 2], acc[nt][pt][4 * q4 + 3]}; }
        __syncthreads();
    }
}

DI void ssd_recurrence(const Frame& F, const float* __restrict__ S, const float* __restrict__ TOT, bf16_t* __restrict__ HIN) {
    for (int gi = F.bid * 512 + F.tid; gi < 128 * 1024; gi += F.G * 512) {
        const int bhd = gi >> 10, e4 = (gi & 1023) * 4, b = bhd >> 4, h = (bhd >> 1) & 7, d = bhd & 1;
        f32x4 sv[18]; float dec[18];
#pragma unroll
        for (int k = 0; k < 18; ++k) { const int c = (d == 0) ? k : (k < 2 ? 1 - k : 19 - k);
            const size_t st = (((size_t)b * 18 + c) * 8 + h) * 2 + d;
            sv[k] = *(const f32x4*)(S + st * 4096 + e4); dec[k] = TOT[st]; }
        float z0 = 0.f; asm volatile("" : "+v"(z0));
        f32x4 H = (f32x4){z0, z0, z0, z0};
#pragma unroll
        for (int k = 0; k < 18; ++k) { const int c = (d == 0) ? k : (k < 2 ? 1 - k : 19 - k);
            const size_t st = (((size_t)b * 18 + c) * 8 + h) * 2 + d;
            u32x2 w; w.x = pk2(H[0], H[1]); w.y = pk2(H[2], H[3]);
            *(u32x2*)(HIN + st * 4096 + e4) = w;
            H = H * __expf(dec[k]) + sv[k]; }
    }
}

#ifndef E3_PROBE
#define E3_PROBE 0
#endif
__device__ unsigned long long g_probe_ticks;
#define E3STAMP(k) do { if (E3_PROBE) { const unsigned long long t_ = __builtin_amdgcn_s_memrealtime(); if (E3_PROBE == (k) && blockIdx.x == 0 && threadIdx.x == 0) g_probe_ticks += t_ - tprev_; tprev_ = t_; } } while (0)
DI void ssd_output(const Frame& F, const LayerIn& P, const bf16_t* XBC, const bf16_t* PA, const float* DT, const bf16_t* HIN, bf16_t* YB, float* SSQ, bool skipctx) {
    LAS float* ARR = (LAS float*)(F.lds + SSD_ARR);
    const int lane = F.lane, hh = lane >> 5, q = (lane & 15) >> 2, pp = lane & 3, blk = (lane >> 4) & 1, l31 = lane & 31;
    for (int it = F.bid; it < 288; it += F.G) {
        const int b = it / 36, r_ = it % 36, c = r_ >> 1, g = r_ & 1, R0 = b * PB + c * 128;
        if (skipctx && c < 2) continue;
        unsigned long long tprev_ = E3_PROBE ? __builtin_amdgcn_s_memrealtime() : 0ull;
        ssd_load_images(F, XBC, R0, g, true);
        bf16x8 hb0[2][4];
        { const bf16_t* Hs = HIN + (((((size_t)b * 18 + c) * 8 + 4 * g + (F.wave & 3)) * 2 + 0) * 4096);
#pragma unroll
          for (int pt = 0; pt < 2; ++pt)
#pragma unroll
              for (int ks = 0; ks < 4; ++ks) hb0[pt][ks] = *(const bf16x8*)(Hs + (pt * 32 + l31) * 64 + 16 * ks + 8 * hh); }
        { const int h4 = F.wave & 3, d = F.wave >> 2, h = 4 * g + h4;
          const Series s = ssd_series(F, DT, P.ssd_a_log, R0, h, d);
          LAS float* A = ARR + h4 * 768;
          if (d == 0) { *(LAS f32x2*)(A + 0 * 128 + 2 * lane) = (f32x2){s.cs0, s.cs1}; *(LAS f32x2*)(A + 1 * 128 + 2 * lane) = (f32x2){s.dt0, s.dt1};
                        *(LAS f32x2*)(A + 2 * 128 + 2 * lane) = (f32x2){__expf(s.cs0), __expf(s.cs1)}; }
          else { *(LAS f32x2*)(A + 3 * 128 + 2 * lane) = (f32x2){s.ecs0, s.ecs1}; *(LAS f32x2*)(A + 4 * 128 + 2 * lane) = (f32x2){s.dt0, s.dt1};
                 *(LAS f32x2*)(A + 5 * 128 + 2 * lane) = (f32x2){__expf(s.tot - s.ecs0), __expf(s.tot - s.ecs1)}; } }
        __syncthreads();
        E3STAMP(1);
        const int h4 = F.wave & 3, rh = F.wave >> 2, h = 4 * g + h4;
        const LAS float* A = ARR + h4 * 768;
        const LAS unsigned char* xh = F.lds + SSD_XH + h4 * 16384;
        const LAS unsigned char* bm = F.lds + SSD_BM;
        const LAS unsigned char* cm = F.lds + SSD_CM;
        f32x16 yacc[2][2];
#pragma unroll
        for (int i = 0; i < 2; ++i)
#pragma unroll
            for (int j = 0; j < 2; ++j)
#pragma unroll
                for (int k = 0; k < 16; ++k) yacc[i][j][k] = 0.f;
        bf16x8 hb1[2][4];
        { const bf16_t* Hs = HIN + (((((size_t)b * 18 + c) * 8 + h) * 2 + 1) * 4096);
#pragma unroll
          for (int pt = 0; pt < 2; ++pt)
#pragma unroll
              for (int ks = 0; ks < 4; ++ks) hb1[pt][ks] = *(const bf16x8*)(Hs + (pt * 32 + l31) * 64 + 16 * ks + 8 * hh); }
#pragma unroll
        for (int d = 0; d < 2; ++d)
#pragma unroll
            for (int itl = 0; itl < 2; ++itl) {
                const int itile = 2 * rh + itl, irow = itile * 32 + l31;
                bf16x8 cf[4];
#pragma unroll
                for (int ks = 0; ks < 4; ++ks) cf[ks] = *(const LAS bf16x8*)(cm + img_off(irow, 2 * ks + hh));
#pragma unroll
                for (int pt = 0; pt < 2; ++pt) {
                    f32x16 tmp;
#pragma unroll
                    for (int k = 0; k < 16; ++k) tmp[k] = 0.f;
#pragma unroll
                    for (int ks = 0; ks < 4; ++ks) tmp = MFMA32(cf[ks], d == 0 ? hb0[pt][ks] : hb1[pt][ks], tmp);
#pragma unroll
                    for (int q4 = 0; q4 < 4; ++q4) { const f32x4 ev = *(const LAS f32x4*)(A + (d == 0 ? 2 : 5) * 128 + itile * 32 + 8 * q4 + 4 * hh);
#pragma unroll
                        for (int k = 0; k < 4; ++k) yacc[itl][pt][4 * q4 + k] += tmp[4 * q4 + k] * ev[k]; }
                }
                __builtin_amdgcn_sched_barrier(0);
            }
#pragma unroll
        for (int itl = 0; itl < 2; ++itl) {
            const int itile = 2 * rh + itl, irow = itile * 32 + l31;
            bf16x8 cf[4];
#pragma unroll
            for (int ks = 0; ks < 4; ++ks) cf[ks] = *(const LAS bf16x8*)(cm + img_off(irow, 2 * ks + hh));
            const float csf_i = A[0 * 128 + irow], ecb_i = A[3 * 128 + irow];
#pragma unroll 1
            for (int jt = 0; jt < 4; ++jt) {
                f32x16 Z;
#pragma unroll
                for (int k = 0; k < 16; ++k) Z[k] = 0.f;
#pragma unroll
                for (int ks = 0; ks < 4; ++ks) { const bf16x8 bf_ = *(const LAS bf16x8*)(bm + img_off(jt * 32 + l31, 2 * ks + hh)); Z = MFMA32(bf_, cf[ks], Z); }
#pragma unroll
                for (int q4 = 0; q4 < 4; ++q4) { const int j0 = jt * 32 + 8 * q4 + 4 * hh;
                    f32x4 w = (f32x4){0.f, 0.f, 0.f, 0.f};
                    if (jt <= itile) { const f32x4 cj = *(const LAS f32x4*)(A + 0 * 128 + j0), dj = *(const LAS f32x4*)(A + 1 * 128 + j0);
#pragma unroll
                        for (int k = 0; k < 4; ++k) { const bool ok = (jt < itile) || (j0 + k <= irow); w[k] += ok ? __expf(fminf(csf_i - cj[k], 0.f)) * dj[k] : 0.f; } }
                    if (jt >= itile) { const f32x4 ej = *(const LAS f32x4*)(A + 3 * 128 + j0), dj = *(const LAS f32x4*)(A + 4 * 128 + j0);
#pragma unroll
                        for (int k = 0; k < 4; ++k) { const bool ok = (jt > itile) || (j0 + k >= irow); w[k] += ok ? __expf(fminf(ej[k] - ecb_i, 0.f)) * dj[k] : 0.f; } }
#pragma unroll
                    for (int k = 0; k < 4; ++k) Z[4 * q4 + k] *= w[k]; }
#pragma unroll
                for (int s = 0; s < 2; ++s) {
                    u32x4 zp; zp.x = cvtpk(Z[8 * s], Z[8 * s + 1]); zp.y = cvtpk(Z[8 * s + 2], Z[8 * s + 3]); zp.z = cvtpk(Z[8 * s + 4], Z[8 * s + 5]); zp.w = cvtpk(Z[8 * s + 6], Z[8 * s + 7]);
                    const bf16x8 za = __builtin_bit_cast(bf16x8, zp);
                    const int row = jt * 32 + 16 * s + 4 * hh + q;
#pragma unroll
                    for (int pt = 0; pt < 2; ++pt) { const int chunk = pt * 4 + 2 * blk + (pp >> 1), within = 8 * (pp & 1);
                        const bf16x8 xb = cat8(tr_read4(xh + img_off(row, chunk) + within), tr_read4(xh + img_off(row + 8, chunk) + within));
                        yacc[itl][pt] = MFMA32(za, xb, yacc[itl][pt]); }
                }
                __builtin_amdgcn_sched_barrier(0);
            }
        }
        __syncthreads();
        E3STAMP(2);
        LAS float* Y = (LAS float*)F.lds;
#pragma unroll
        for (int itl = 0; itl < 2; ++itl)
#pragma unroll
            for (int pt = 0; pt < 2; ++pt)
#pragma unroll
                for (int r = 0; r < 16; ++r) Y[((2 * rh + itl) * 32 + crow(r, hh)) * 256 + h4 * 64 + pt * 32 + l31] = yacc[itl][pt][r];
        u32x4 xw[4], zw[4];
        int tid_e = F.tid; asm volatile("" : "+v"(tid_e));
#pragma unroll
        for (int u = 0; u < 4; ++u) { const int idx = u * 512 + tid_e, row = idx >> 5, ch = idx & 31, R = R0 + row;
            xw[u] = *(const u32x4*)(XBC + (size_t)R * 768 + g * 256 + ch * 8); zw[u] = *(const u32x4*)(PA + (size_t)R * PA_W + C_Z + g * 256 + ch * 8); }
        __syncthreads();
#pragma unroll
        for (int it4 = 0; it4 < 8; it4 += 4) {
            u32x4 xn[4], zn[4];
            if (it4 == 0) {
#pragma unroll
                for (int u = 0; u < 4; ++u) { const int idx = (4 + u) * 512 + tid_e, row = idx >> 5, ch = idx & 31, R = R0 + row;
                    xn[u] = *(const u32x4*)(XBC + (size_t)R * 768 + g * 256 + ch * 8); zn[u] = *(const u32x4*)(PA + (size_t)R * PA_W + C_Z + g * 256 + ch * 8); } }
#pragma unroll
            for (int u = 0; u < 4; ++u) { const int idx = (it4 + u) * 512 + tid_e, row = idx >> 5, ch = idx & 31, R = R0 + row;
                const f32x4 y0 = *(const LAS f32x4*)(Y + row * 256 + ch * 8), y1 = *(const LAS f32x4*)(Y + row * 256 + ch * 8 + 4);
                float xv[8], zv[8]; unpack8(xw[u], xv); unpack8(zw[u], zv);
                const float Dh = P.ssd_d[4 * g + (ch >> 3)]; float o[8], ss = 0.f;
#pragma unroll
                for (int k = 0; k < 8; ++k) { const float yv = (k < 4 ? y0[k] : y1[k - 4]) + Dh * xv[k]; o[k] = yv * zv[k]; ss += o[k] * o[k]; }
                ss += __shfl_xor(ss, 1); ss += __shfl_xor(ss, 2); ss += __shfl_xor(ss, 4); ss += __shfl_xor(ss, 8); ss += __shfl_xor(ss, 16);
                if (ch == 0) SSQ[(size_t)R * 2 + g] = ss;
                *(u32x4*)(YB + (size_t)R * 1024 + 512 + g * 256 + ch * 8) = pack8(o); }
            if (it4 == 0) {
#pragma unroll
                for (int u = 0; u < 4; ++u) { xw[u] = xn[u]; zw[u] = zn[u]; } }
        }
        __syncthreads();
        E3STAMP(3);
    }
}

DI void s5_recurrence(const Frame& F, const LayerIn& P, const float* __restrict__ S5S, bf16_t* __restrict__ AU) {
    if (F.gw >= 384) return;
    const int g = F.gw >> 4, b = (F.gw >> 1) & 7, d = F.gw & 1, p = F.lane;
    const float step = __expf(P.s5_lstep[d * 24 + g]);
    const float lr = P.s5_lre[(d * 24 + g) * 64 + p], li = P.s5_lim[(d * 24 + g) * 64 + p];
    const float mag = expf(32.f * lr * step), ang = 32.f * li * step, Lr = mag * cosf(ang), Li = mag * sinf(ang);
    float Hr = 0.f, Hi = 0.f;
#pragma unroll 1
    for (int kb = 0; kb < 72; kb += 24) {
        float sr[24], si[24];
#pragma unroll
        for (int k = 0; k < 24; ++k) { const int kk = kb + k, ck = (d == 0) ? kk : (kk < 8 ? 7 - kk : 79 - kk);
            const size_t m = (size_t)g * 576 + b * 72 + ck;
            sr[k] = S5S[m * 256 + d * 128 + p]; si[k] = S5S[m * 256 + d * 128 + 64 + p]; }
#pragma unroll
        for (int k = 0; k < 24; ++k) { const int kk = kb + k, ck = (d == 0) ? kk : (kk < 8 ? 7 - kk : 79 - kk);
            const size_t m = (size_t)g * 576 + b * 72 + ck;
            AU[m * 768 + 512 + d * 128 + p] = (bf16_t)f2bf(Hr); AU[m * 768 + 512 + d * 128 + 64 + p] = (bf16_t)f2bf(Hi);
            const float nr = Lr * Hr - Li * Hi + sr[k], ni = Lr * Hi + Li * Hr + si[k];
            Hr = nr; Hi = ni; }
    }
}

namespace attn_body {
using bf16=__hip_bfloat16;
using bf16x8=__attribute__((ext_vector_type(8)))short;
using s16x4=__attribute__((ext_vector_type(4)))short;
using f32x16=__attribute__((ext_vector_type(16)))float;
using u32x4=__attribute__((ext_vector_type(4)))unsigned;
constexpr int D=64;
constexpr int NW=8,QBLK=32,QB=QBLK*NW,KVBLK=64;
__device__ __forceinline__ int crow(int r,int hi){return (r&3)+8*(r>>2)+4*hi;}
#define SBAR() __builtin_amdgcn_sched_barrier(0)
constexpr int NSLOT=3, SLOTB=8192;
constexpr int LDS_K=0, LDS_V=NSLOT*SLOTB, LDS_WS=2*NSLOT*SLOTB, LDS_OST=LDS_WS+NW*64*4, LDS_BYTES=LDS_OST+NW*4096;
constexpr float C2=0.125f*1.4426950408889634f;
__device__ __forceinline__ void glds16(const void*gsrc,unsigned lds_dst){unsigned keep;
  asm volatile("s_mov_b32 %0, m0\n\ts_mov_b32 m0, %2\n\ts_nop 0\n\tglobal_load_lds_dwordx4 %1, off\n\ts_mov_b32 m0, %0":"=&s"(keep):"v"(gsrc),"s"(lds_dst):"memory");}
__device__ __forceinline__ float max3f(float a,float b,float c){float r;asm("v_max3_f32 %0, %1, %2, %3":"=v"(r):"v"(a),"v"(b),"v"(c));return r;}
__device__ __forceinline__ float max2f(float a,float b){float r;asm("v_max_f32_e32 %0, %1, %2":"=v"(r):"v"(a),"v"(b));return r;}
__device__ __forceinline__ float fadd_s(float a,float b){float r;asm("v_add_f32_e32 %0, %1, %2":"=v"(r):"v"(a),"v"(b));return r;}
__device__ __forceinline__ float fsub_s(float a,float b){float r;asm("v_sub_f32_e32 %0, %1, %2":"=v"(r):"v"(a),"v"(b));return r;}
typedef float f32x2_t __attribute__((ext_vector_type(2))); typedef __bf16 bf16x2_t __attribute__((ext_vector_type(2)));
__device__ __forceinline__ unsigned cvtpk_s(float lo,float hi){f32x2_t v={lo,hi};bf16x2_t b=__builtin_convertvector(v,bf16x2_t);return __builtin_bit_cast(unsigned,b);}
#define WAIT_BAR(N) asm volatile("s_waitcnt vmcnt(" #N ") lgkmcnt(0)\n\ts_barrier":::"memory")

__device__ __forceinline__ void qkt(f32x16&p0,f32x16&p1,const char*Kslot,const bf16x8*qr,const f32x16&negm,int r32,int hi){
  const char*kb=Kslot+hi*1024+r32*16;
  #pragma unroll
  for(int d0=0;d0<4;++d0){
    const bf16x8 b0=*reinterpret_cast<const bf16x8*>(kb+d0*2048);
    const bf16x8 b1=*reinterpret_cast<const bf16x8*>(kb+d0*2048+512);
    if(d0==0){p0=__builtin_amdgcn_mfma_f32_32x32x16_bf16(b0,qr[0],negm,0,0,0);p1=__builtin_amdgcn_mfma_f32_32x32x16_bf16(b1,qr[0],negm,0,0,0);}
    else{p0=__builtin_amdgcn_mfma_f32_32x32x16_bf16(b0,qr[d0],p0,0,0,0);p1=__builtin_amdgcn_mfma_f32_32x32x16_bf16(b1,qr[d0],p1,0,0,0);}}
}
typedef __attribute__((address_space(3))) const char* lds_cptr;
typedef short v4i16_t __attribute__((ext_vector_type(4)));
__device__ __forceinline__ void kload8(bf16x8*kf,lds_cptr kp){
  kf[0]=*(const __attribute__((address_space(3))) bf16x8*)(kp);      kf[1]=*(const __attribute__((address_space(3))) bf16x8*)(kp+512);
  kf[2]=*(const __attribute__((address_space(3))) bf16x8*)(kp+2048); kf[3]=*(const __attribute__((address_space(3))) bf16x8*)(kp+2560);
  kf[4]=*(const __attribute__((address_space(3))) bf16x8*)(kp+4096); kf[5]=*(const __attribute__((address_space(3))) bf16x8*)(kp+4608);
  kf[6]=*(const __attribute__((address_space(3))) bf16x8*)(kp+6144); kf[7]=*(const __attribute__((address_space(3))) bf16x8*)(kp+6656);
}
__device__ __forceinline__ void kload2(bf16x8*kf,lds_cptr kp,int j){ kf[2*j]=*(const __attribute__((address_space(3))) bf16x8*)(kp+j*2048); kf[2*j+1]=*(const __attribute__((address_space(3))) bf16x8*)(kp+j*2048+512); }
__device__ __forceinline__ s16x4 vtr(lds_cptr p){ return __builtin_bit_cast(s16x4,__builtin_amdgcn_ds_read_tr16_b64_v4i16((__attribute__((address_space(3))) v4i16_t*)p)); }
__device__ __forceinline__ float rowmax(const f32x16&p0,const f32x16&p1){
  float a=max3f(p0[0],p0[1],p1[0]),b=max3f(p0[2],p0[3],p1[1]);a=max3f(a,p1[2],p1[3]);
  #pragma unroll
  for(int r=4;r<16;r+=4){a=max3f(a,p0[r],p0[r+1]);b=max3f(b,p0[r+2],p0[r+3]);a=max3f(a,p1[r],p1[r+1]);b=max3f(b,p1[r+2],p1[r+3]);}
  const float m=max2f(a,b);
  auto rr=__builtin_amdgcn_permlane32_swap(__float_as_uint(m),__float_as_uint(m),false,false);
  return max2f(__uint_as_float(rr[0]),__uint_as_float(rr[1]));
}
__device__ __forceinline__ void pv(f32x16*o,int vb,bf16x8 pa0,bf16x8 pa1,bf16x8 pa2,bf16x8 pa3){
  #pragma unroll
  for(int d0=0;d0<2;++d0){s16x4 lo[4],hi[4];
    #pragma unroll
    for(int ks=0;ks<4;++ks){
      asm volatile("ds_read_b64_tr_b16 %0,%1 offset:%c2":"=&v"(lo[ks]):"v"(vb),"i"(d0*4096+ks*1024):"memory");
      asm volatile("ds_read_b64_tr_b16 %0,%1 offset:%c2":"=&v"(hi[ks]):"v"(vb),"i"(d0*4096+ks*1024+512):"memory");}
    asm volatile("s_waitcnt lgkmcnt(0)":::"memory");SBAR();
    #define PK(k) (bf16x8){lo[k][0],lo[k][1],lo[k][2],lo[k][3],hi[k][0],hi[k][1],hi[k][2],hi[k][3]}
    o[d0]=__builtin_amdgcn_mfma_f32_32x32x16_bf16(pa0,PK(0),o[d0],0,0,0);
    o[d0]=__builtin_amdgcn_mfma_f32_32x32x16_bf16(pa1,PK(1),o[d0],0,0,0);
    o[d0]=__builtin_amdgcn_mfma_f32_32x32x16_bf16(pa2,PK(2),o[d0],0,0,0);
    o[d0]=__builtin_amdgcn_mfma_f32_32x32x16_bf16(pa3,PK(3),o[d0],0,0,0);
    #undef PK
  }
}

#ifndef ATTN_STORE16
#define ATTN_STORE16(p,v) (*(u32x4*)(p)=(v))
#endif
template<int THRL> __device__ __forceinline__ void attn_unit(const bf16*Qp,int qpitch,const bf16*__restrict__ Kp,int kpitch,const bf16*__restrict__ Vp,int vpitch,bf16*Op,int opitch,const int NT,char*shm){
  const int tid=fresh_tid(),lane=tid&63,r32=lane&31,hi=lane>>5; const int wid=__builtin_amdgcn_readfirstlane(tid>>6);
  const bf16*Qw=Qp+(long)(wid*QBLK)*qpitch;
  const bf16*Kh=Kp,*Vh=Vp;
  const unsigned lds0=(unsigned)(uintptr_t)shm;
  float*wsf=(float*)(shm+LDS_WS)+wid*64;
  const bf16*ksrc=Kh+(long)lane*kpitch+wid*8;
  const bf16*vsrc=Vh+(long)(16*(wid&3)+(lane>>2))*vpitch+(wid>>2)*32+(lane&3)*8;
  const unsigned kdst=lds0+LDS_K+wid*1024, vdst=lds0+LDS_V+wid*1024;
  #define DMA_K(t,slot) glds16(ksrc+(long)(t)*KVBLK*kpitch,(unsigned)__builtin_amdgcn_readfirstlane(kdst+(slot)))
  #define DMA_V(t,slot) glds16(vsrc+(long)(t)*KVBLK*vpitch,(unsigned)__builtin_amdgcn_readfirstlane(vdst+(slot)))
  const int vb0=(int)(lds0+LDS_V)+((lane>>4)&1)*32+(lane&3)*8+(4*hi+((lane&15)>>2))*64;
  const char*Kbase=shm+LDS_K; bf16x8 kf[8];
  const lds_cptr shm3=(lds_cptr)shm; const lds_cptr kp0=shm3+LDS_K+hi*1024+r32*16; const lds_cptr vp0=shm3+LDS_V+((lane>>4)&1)*32+(lane&3)*8+(4*hi+((lane&15)>>2))*64;
  DMA_K(0,0);DMA_V(0,0);DMA_K(1,SLOTB);
  bf16x8 qr[4];
  #pragma unroll
  for(int d0=0;d0<4;++d0)qr[d0]=*reinterpret_cast<const bf16x8*>(&Qw[(long)r32*qpitch+d0*16+hi*8]);
  float mhat=0.f,l_reg=0.f;f32x16 o[2];o[0]=f32x16{};o[1]=f32x16{};f32x16 negm=f32x16{};asm volatile("":"+v"(negm));
  #define CMASK(P0,P1,t) do{}while(0)
  bool resc=false;
  #define START(P0,P1) do{ const float rm=rowmax(P0,P1); resc=false; \
    { const float dl=rm; mhat=fadd_s(mhat,dl); \
      _Pragma("unroll") for(int r=0;r<16;++r){P0[r]=fsub_s(P0[r],dl);P1[r]=fsub_s(P1[r],dl);} \
      _Pragma("unroll") for(int r=0;r<16;++r)negm[r]=-mhat; asm volatile("":"+v"(negm)); } \
    _Pragma("unroll") for(int r=0;r<16;++r)P0[r]=__builtin_amdgcn_exp2f(P0[r]); }while(0)
  #define RESC() do{ if(resc){ asm volatile("s_waitcnt lgkmcnt(0)":::"memory"); \
      _Pragma("unroll") for(int d_=0;d_<2;++d_) _Pragma("unroll") for(int r=0;r<16;++r)o[d_][r]*=wsf[crow(r,hi)]; } }while(0)
  f32x16 pA0,pA1,pB0,pB1;
  int sl_prev=0,sl_cur=0,sl_next=SLOTB;
  #define ROT() do{sl_prev=sl_cur;sl_cur=sl_next;sl_next=(sl_next==(NSLOT-1)*SLOTB)?0:sl_next+SLOTB;}while(0)
  DMA_K(2,2*SLOTB);
  WAIT_BAR(3);
  qkt(pA0,pA1,Kbase,qr,negm,r32,hi);asm volatile("s_nop 15\n\ts_nop 7":"+v"(pA0),"+v"(pA1));CMASK(pA0,pA1,0);
  START(pA0,pA1);
  _Pragma("unroll") for(int r=0;r<16;++r)pA1[r]=__builtin_amdgcn_exp2f(pA1[r]);
  WAIT_BAR(0);
  DMA_K(3,0);DMA_V(1,SLOTB);
  ROT();
  kload8(kf,kp0+sl_cur);
  WAIT_BAR(2);
  s16x4 vlo[8],vhi[8]; u32x4 pw0,pw1,pw2,pw3;
  #define PKW(P,B) cvtpk_s(P[B],P[B+1])
  #define PAF(k) __builtin_bit_cast(bf16x8,pw##k)
  #define VFR(i) (bf16x8){vlo[i][0],vlo[i][1],vlo[i][2],vlo[i][3],vhi[i][0],vhi[i][1],vhi[i][2],vhi[i][3]}
  #define PIN(x) asm volatile("":"+v"(x))
  #define MX3(a,b,c) __builtin_fmaxf(__builtin_fmaxf((a),(b)),(c))
  #define GAPA(MF,A0,A1,A2,A3,W0,W1,PW) do{ MF; sacc+=A0; sacc+=A1; sacc+=A2; sacc+=A3; PIN(sacc); W0; W1; PIN(PW); SBAR(); }while(0)
  #define EX(v) __builtin_amdgcn_exp2f(v)
  #define GAPB(MF,X,B) do{ MF; X[B]=EX(X[B]); X[B+1]=EX(X[B+1]); X[B+2]=EX(X[B+2]); X[B+3]=EX(X[B+3]); PIN(X); SBAR(); }while(0)
  #define VRD(i) do{ vlo[i]=vtr(vp_+(((i)>>2)*4096+((i)&3)*1024)); vhi[i]=vtr(vp_+(((i)>>2)*4096+((i)&3)*1024+512)); }while(0)
  #define KRD(G,j) do{ if(G){ kload2(kf,kp0+sl_next,j); SBAR(); } }while(0)
  #define STEP(C0,C1,P0,P1,t,GK,GV,GL) do{ SBAR(); \
    const lds_cptr vp_=vp0+sl_prev; \
    VRD(0); SBAR(); float sacc=(P0[0]+P0[1]); \
    GAPA(C0=__builtin_amdgcn_mfma_f32_32x32x16_bf16(kf[0],qr[0],negm,0,0,0), P0[2],P0[3],P0[4],P0[5],     pw0[0]=PKW(P0,0), pw0[1]=PKW(P0,2), pw0); \
    VRD(4); SBAR(); GAPA(C1=__builtin_amdgcn_mfma_f32_32x32x16_bf16(kf[1],qr[0],negm,0,0,0), P0[6],P0[7],P0[8],P0[9],     pw0[2]=PKW(P0,4), pw0[3]=PKW(P0,6), pw0); \
    VRD(1); SBAR(); GAPA(C0=__builtin_amdgcn_mfma_f32_32x32x16_bf16(kf[2],qr[1],C0,0,0,0),   P0[10],P0[11],P0[12],P0[13], pw1[0]=PKW(P0,8), pw1[1]=PKW(P0,10), pw1); \
    VRD(5); SBAR(); GAPA(C1=__builtin_amdgcn_mfma_f32_32x32x16_bf16(kf[3],qr[1],C1,0,0,0),   P0[14],P0[15],P1[0],P1[1],   pw1[2]=PKW(P0,12),pw1[3]=PKW(P0,14), pw1); \
    VRD(2); SBAR(); GAPA(C0=__builtin_amdgcn_mfma_f32_32x32x16_bf16(kf[4],qr[2],C0,0,0,0),   P1[2],P1[3],P1[4],P1[5],     pw2[0]=PKW(P1,0), pw2[1]=PKW(P1,2), pw2); \
    VRD(6); SBAR(); GAPA(C1=__builtin_amdgcn_mfma_f32_32x32x16_bf16(kf[5],qr[2],C1,0,0,0),   P1[6],P1[7],P1[8],P1[9],     pw2[2]=PKW(P1,4), pw2[3]=PKW(P1,6), pw2); \
    VRD(3); SBAR(); GAPA(C0=__builtin_amdgcn_mfma_f32_32x32x16_bf16(kf[6],qr[3],C0,0,0,0),   P1[10],P1[11],P1[12],P1[13], pw3[0]=PKW(P1,8), pw3[1]=PKW(P1,10), pw3); \
    VRD(7); SBAR(); GAPA(C1=__builtin_amdgcn_mfma_f32_32x32x16_bf16(kf[7],qr[3],C1,0,0,0),   P1[14],P1[15],0.f,0.f,       pw3[2]=PKW(P1,12),pw3[3]=PKW(P1,14), pw3); \
    l_reg+=sacc; \
    if(GK){DMA_K((t)+3,sl_cur);} if(GV){DMA_V((t)+1,sl_next);} \
    CMASK(C0,C1,t); \
    { float a=MX3(C0[0],C0[1],C1[0]),b=MX3(C0[2],C0[3],C1[1]); a=MX3(a,C1[2],C1[3]); \
      _Pragma("unroll") for(int r=4;r<16;r+=4){a=MX3(a,C0[r],C0[r+1]);b=MX3(b,C0[r+2],C0[r+3]);a=MX3(a,C1[r],C1[r+1]);b=MX3(b,C1[r+2],C1[r+3]);} \
      float rm=__builtin_fmaxf(a,b); { auto rr=__builtin_amdgcn_permlane32_swap(__float_as_uint(rm),__float_as_uint(rm),false,false); rm=__builtin_fmaxf(__uint_as_float(rr[0]),__uint_as_float(rr[1])); } \
      resc=false; \
      if(__builtin_expect(__any(rm>(float)THRL),0)){ const float dl=__builtin_fmaxf(rm,0.f); mhat+=dl; \
        _Pragma("unroll") for(int r=0;r<16;++r){C0[r]-=dl;C1[r]-=dl;} \
        _Pragma("unroll") for(int r=0;r<16;++r)negm[r]=-mhat; asm volatile("":"+v"(negm)); \
        const float f=__builtin_amdgcn_exp2f(-dl); l_reg*=f; if(hi==0)wsf[r32]=f; resc=true; } } \
    SBAR(); \
    GAPB(o[0]=__builtin_amdgcn_mfma_f32_32x32x16_bf16(PAF(0),VFR(0),o[0],0,0,0), C0,0); \
    GAPB(o[1]=__builtin_amdgcn_mfma_f32_32x32x16_bf16(PAF(0),VFR(4),o[1],0,0,0), C0,4); \
    KRD(GL,0); GAPB(o[0]=__builtin_amdgcn_mfma_f32_32x32x16_bf16(PAF(1),VFR(1),o[0],0,0,0), C0,8); \
    KRD(GL,1); GAPB(o[1]=__builtin_amdgcn_mfma_f32_32x32x16_bf16(PAF(1),VFR(5),o[1],0,0,0), C0,12); \
    KRD(GL,2); GAPB(o[0]=__builtin_amdgcn_mfma_f32_32x32x16_bf16(PAF(2),VFR(2),o[0],0,0,0), C1,0); \
    KRD(GL,3); GAPB(o[1]=__builtin_amdgcn_mfma_f32_32x32x16_bf16(PAF(2),VFR(6),o[1],0,0,0), C1,4); \
    GAPB(o[0]=__builtin_amdgcn_mfma_f32_32x32x16_bf16(PAF(3),VFR(3),o[0],0,0,0), C1,8); \
    GAPB(o[1]=__builtin_amdgcn_mfma_f32_32x32x16_bf16(PAF(3),VFR(7),o[1],0,0,0), C1,12); \
    }while(0)
  int t=1;
  for(;t+5<NT;t+=2){
    STEP(pB0,pB1,pA0,pA1,t,true,true,true);     WAIT_BAR(2); RESC(); ROT();
    STEP(pA0,pA1,pB0,pB1,t+1,true,true,true);   WAIT_BAR(2); RESC(); ROT();
  }
  #define ENDW(tt) do{ if((tt)+3<NT){WAIT_BAR(2);} else if((tt)+2<NT){WAIT_BAR(1);} else {WAIT_BAR(0);} }while(0)
  for(;t+1<NT;t+=2){
    STEP(pB0,pB1,pA0,pA1,t,(t+3<NT),(t+1<NT),(t+1<NT));       ENDW(t);   RESC(); ROT();
    STEP(pA0,pA1,pB0,pB1,t+1,(t+4<NT),(t+2<NT),(t+2<NT));     ENDW(t+1); RESC(); ROT();
  }
  STEP(pB0,pB1,pA0,pA1,NT-1,false,false,false); RESC();
  { float sacc=pB0[0]+pB0[1]; _Pragma("unroll") for(int r=2;r<16;++r)sacc+=pB0[r]; _Pragma("unroll") for(int r=0;r<16;++r)sacc+=pB1[r]; l_reg+=sacc;
    pw0=(u32x4){PKW(pB0,0),PKW(pB0,2),PKW(pB0,4),PKW(pB0,6)};pw1=(u32x4){PKW(pB0,8),PKW(pB0,10),PKW(pB0,12),PKW(pB0,14)};pw2=(u32x4){PKW(pB1,0),PKW(pB1,2),PKW(pB1,4),PKW(pB1,6)};pw3=(u32x4){PKW(pB1,8),PKW(pB1,10),PKW(pB1,12),PKW(pB1,14)};
    SBAR(); pv(o,vb0+sl_cur,PAF(0),PAF(1),PAF(2),PAF(3)); }
  #undef PKW
  #undef PAF
  #undef VFR
  #undef PIN
  #undef MX3
  #undef GAPA
  #undef GAPB
  #undef EX
  #undef VRD
  #undef KRD
  #undef STEP
  #undef ENDW
  {auto rr=__builtin_amdgcn_permlane32_swap(__float_as_uint(l_reg),__float_as_uint(l_reg),false,false);l_reg=__uint_as_float(rr[0])+__uint_as_float(rr[1]);}
  if(hi==0)wsf[32+r32]=l_reg;asm volatile("s_waitcnt lgkmcnt(0)":::"memory");
  float rli[16];
  #pragma unroll
  for(int r=0;r<16;++r)rli[r]=__builtin_amdgcn_rcpf(wsf[32+crow(r,hi)]);
  bf16*Ow=Op+(long)(wid*QBLK)*opitch;
  { bf16*stg=(bf16*)(shm+LDS_OST)+wid*2048;
    #pragma unroll
    for(int r=0;r<16;++r){const int orow=crow(r,hi);
      #pragma unroll
      for(int d0=0;d0<2;++d0)stg[orow*64+d0*32+r32]=__float2bfloat16(o[d0][r]*rli[r]);}
    asm volatile("s_waitcnt lgkmcnt(0)":::"memory");
    #pragma unroll
    for(int i=0;i<4;++i){const int row=i*8+(lane>>3),ch=lane&7; const u32x4 v=*(const u32x4*)(stg+row*64+ch*8); ATTN_STORE16(Ow+(long)row*opitch+ch*8,v);} }
  asm volatile("s_waitcnt lgkmcnt(0)\n\ts_barrier":::"memory");
  #undef DMA_K
  #undef DMA_V
  #undef CMASK
  #undef START
  #undef RESC
  #undef ROT
}
constexpr int ATTN_LDS_BYTES=LDS_BYTES;
#undef SBAR
#undef WAIT_BAR
}


#define pMOD ((float*)(ws + WS_MOD))
#define pROPE ((float*)(ws + WS_ROPE))
#define pAFF ((float*)(ws + WS_AFF))
#define pINV ((int*)(ws + WS_INV))
#define pDT ((float*)(ws + WS_DT))
#define pSRC ((int*)(ws + WS_SRC))
#define pGV ((float*)(ws + WS_GV))
#define pSSQ ((float*)(ws + WS_SSQ))
#define pTOT ((float*)(ws + WS_TOT))
#define pX ((bf16_t*)(ws + WS_X))
#define pH ((bf16_t*)(ws + WS_H))
#define pYAB ((bf16_t*)(ws + WS_YAB))
#define pPA ((bf16_t*)(ws + WS_PA))
#define pPG ((unsigned char*)(ws + WS_PG))
#define pMRGB ((bf16_t*)(ws + WS_MRGB))
#define pY ((bf16_t*)(ws + WS_Y))
#define pXG ((bf16_t*)(ws + WS_XG))
#define pHID ((bf16_t*)(ws + WS_HID))
#define pYE ((bf16_t*)(ws + WS_YE))
#define pQN ((bf16_t*)(ws + WS_QN))
#define pKN ((bf16_t*)(ws + WS_KN))
#define pHIN ((bf16_t*)(ws + WS_HIN))
#define pXBC ((bf16_t*)(ws + WS_XBC))
#define pAU ((bf16_t*)(ws + WS_AU))
#define pSS ((float*)(ws + WS_S))
#define pYG ((bf16_t*)(ws + WS_YG))
#define pS5S ((float*)(ws + WS_S5S))
#define pYCD ((bf16_t*)(ws + WS_YCD))
constexpr int EW7_L0 = 1792, EW7_L1 = 2048, EW_SPLIT1 = EW7_L0 + 7326, EW_SPLIT2 = EW_SPLIT1 + 3170, EW1_SPLIT = 4096, EW1_END = 2 * 4096 + EW7_L1;
struct Args { const float* in[38]; float* out; unsigned char* ws; int ph_lo, ph_hi; };
constexpr int PH_PER_LAYER = 15, PH_FINAL = 2 * PH_PER_LAYER, PH_TOTAL = PH_FINAL + 1;

DI LayerIn layer_in(const Args& a, int L) {
    LayerIn P;
    P.norm_mix_g = a.in[6] + (size_t)L * 1024; P.norm_ffn_g = a.in[7] + (size_t)L * 1024;
    P.w_in = a.in[8] + (size_t)L * 1024 * NIN; P.q_norm_g = a.in[9] + L * 64; P.k_norm_g = a.in[10] + L * 64;
    P.ssd_conv_w = a.in[11] + L * 3 * 768; P.ssd_conv_b = a.in[12] + L * 768; P.ssd_dt_bias = a.in[13] + L * 16; P.ssd_a_log = a.in[14] + L * 16;
    P.ssd_d = a.in[15] + L * 8; P.ssd_norm_g = a.in[16] + L * 512;
    P.s5_lre = a.in[17] + L * 2 * 24 * 64; P.s5_lim = a.in[18] + L * 2 * 24 * 64; P.s5_lstep = a.in[19] + L * 48;
    P.s5_bre = a.in[20] + (size_t)L * 24 * 64 * 16; P.s5_bim = a.in[21] + (size_t)L * 24 * 64 * 16; P.s5_cre = a.in[22] + (size_t)L * 24 * 16 * 64; P.s5_cim = a.in[23] + (size_t)L * 24 * 16 * 64;
    P.s5_d = a.in[24] + L * 384; P.s5_wglu = a.in[25] + (size_t)L * 384 * 384; P.s5_bglu = a.in[26] + L * 384; P.sc_conv_w = a.in[27] + L * 3 * 384;
    P.w_br_attn = a.in[28] + (size_t)L * 512 * 1024; P.w_br_ssd = a.in[29] + (size_t)L * 512 * 1024; P.w_br_s5 = a.in[30] + (size_t)L * 384 * 1024; P.w_br_sc = a.in[31] + (size_t)L * 384 * 1024;
    P.w_out = a.in[32] + (size_t)L * 1024 * 1024; P.w_router = a.in[33] + (size_t)L * 1024 * 16;
    P.w_gate = a.in[34] + (size_t)L * 16 * 1024 * 1024; P.w_up = a.in[35] + (size_t)L * 16 * 1024 * 1024; P.w_down = a.in[36] + (size_t)L * 16 * 1024 * 1024;
    return P;
}

__global__ void __launch_bounds__(NWAVES * 64, 2) hybrid_fwd(Args args) {
    extern __shared__ __attribute__((aligned(16))) unsigned char lds_raw[];
    Frame F0;
#define F F0
    F.lds = (LAS unsigned char*)lds_raw;
    F.tid = threadIdx.x; F.lane = F.tid & 63; F.wave = __builtin_amdgcn_readfirstlane(F.tid >> 6);
    F.G = gridDim.x; { const int bx = blockIdx.x; F.vcu = (F.G % 8 == 0) ? (bx % 8) * (F.G / 8) + bx / 8 : bx; }
    F.gw = F.vcu * NWAVES + F.wave; F.NGW = F.G * NWAVES; F.bid = (int)blockIdx.x;
    unsigned char* ws = args.ws;
    volatile LAS unsigned* MISC = (volatile LAS unsigned*)(F.lds + LDSCTL_OFF);
    for (int u = F.tid; u < (LDS_BYTES - LDSCTL_OFF) / 4; u += NWAVES * 64) ((LAS unsigned*)(F.lds + LDSCTL_OFF))[u] = 0u;
    __syncthreads();
    XcdBarrier bar = xcd_barrier_post((unsigned*)(ws + WS_CTL) + CW_BAR, MISC + 8, (unsigned)gridDim.x);
    const int GH = (int)gridDim.x / 2; const bool chain = (int)blockIdx.x >= GH;
    XcdBarrier bar2 = bar; if (chain) bar2 = xcd_barrier_post((unsigned*)(ws + WS_CTL) + CW_BAR + XCD_BAR_WORDS, MISC + 10, (unsigned)((int)gridDim.x - GH));
    const int lo = args.ph_lo, hi = args.ph_hi;
#ifndef PH_MASK
#define PH_MASK 0xFFFF
#endif
#define IN(k) (lo <= (k) && (k) < hi)
#define INL(j) (((PH_MASK >> (j)) & 1) && IN(base + (j)))
#ifndef REPEAT_MASK
#define REPEAT_MASK 0
#endif
#define REP(j) for (int rep_ = 0; rep_ < 1 + ((REPEAT_MASK >> (j)) & 1); ++rep_)
#ifndef SP_AMP
#define SP_AMP 0
#endif
#ifndef SP_WG
#define SP_WG 0
#endif
#ifndef SP_MAXLO
#define SP_MAXLO 0
#define SP_MAXHI 0
#endif
#define PRESTAMP(k) do { if (SP_AMP && threadIdx.x == 0) { const unsigned t_ = (unsigned)__builtin_amdgcn_s_memrealtime(); if (blockIdx.x == SP_WG) MISC[128 + (k)] = t_; \
    if ((int)blockIdx.x >= SP_MAXLO && (int)blockIdx.x < SP_MAXHI) atomicMax((unsigned*)(ws + WS_CTL) + 32768 + (k), t_); } } while (0)
#define SEAM(k) do { if (IN((k) + 1)) xcd_barrier(bar); if (SP_AMP && blockIdx.x == SP_WG && threadIdx.x == 0) MISC[64 + (k)] = (unsigned)__builtin_amdgcn_s_memrealtime(); } while (0)
    if (SP_AMP && blockIdx.x == SP_WG && threadIdx.x == 0) MISC[63] = (unsigned)__builtin_amdgcn_s_memrealtime();

#undef F
#pragma unroll 1
    for (int L = 0; L < 2; ++L) {
        const int base = L * PH_PER_LAYER;
        if (hi <= base || lo >= base + PH_PER_LAYER) continue;
        const bool lastL = (L == 1);

        if (L == 0 && INL(0)) REP(0) { const LayerIn P = layer_in(args, L); Frame F = F0; F.tid = fresh_tid(); F.lane = F.tid & 63; if (rep_) xcd_barrier(bar);
#ifndef SUBREP_MOD
#define SUBREP_MOD 0
#endif
#ifndef SUBREP_S5
#define SUBREP_S5 0
#endif
#ifndef SUBREP_SW
#define SUBREP_SW 0
#endif
            prep_s5(F, P, ws);
            for (int q_ = 0; q_ <= SUBREP_MOD; ++q_) { prep_mod(F, args.in[1], args.in[3], args.in[4], args.in[5], pMOD, 96); prep_rope(F, pROPE, 96); }
            for (int q_ = 0; q_ <= SUBREP_SW; ++q_) prep_small_weights(F, P, ws, 4, 96);
            SEAM(base + 0);
        }
        if (INL(1)) REP(1) { const LayerIn P = layer_in(args, L); Frame F = F0; F.tid = fresh_tid(); F.lane = F.tid & 63; if (rep_) xcd_barrier(bar);
            if (L == 0) phase_norm1<false, 3>(F, L, args.in[0], args.in[2], pX, pH, pMOD, P.norm_mix_g, pINV, pYE, pY, 0); else phase_norm1<true, 2>(F, L, args.in[0], args.in[2], pX, pH, pMOD, P.norm_mix_g, pINV, pYE, pY, 0); SEAM(base + 1); }
        if (INL(2)) REP(2) { const LayerIn P = layer_in(args, L); Frame F = F0; F.tid = fresh_tid(); F.lane = F.tid & 63; if (rep_) xcd_barrier(bar);
            pg8::Gemm g{pH, (const bf16_t*)(ws + W_WIN), 1024, 1024, 1024};
            RowSkipOrder S; S.init(NPROJ, F.G, (int)blockIdx.x, lastL ? 1 : 0, 2, 10);
            EpiProj E{pPA, PA_W, PA_W / 256, pPG, pAU, pQN, pKN, pROPE, P.q_norm_g, P.k_norm_g, (LAS float*)(F.lds + 8 * pg8::HTB)};
            pg8::gemm_phase<EpiProj, RowSkipOrder>(F.lds, g, S, E);
            if (L == 0) { __syncthreads(); prep_small_weights(F, P, ws, 3, 184); }
            SEAM(base + 2);
        }
        if (INL(3)) REP(3) { const LayerIn P = layer_in(args, L); Frame F = F0; F.tid = fresh_tid(); F.lane = F.tid & 63; if (rep_) xcd_barrier(bar); phase_elem(F, P, pPA, pROPE, pQN, pKN, pXBC, pDT, pAU, pYCD); SEAM(base + 3); }
        if (INL(4)) { const LayerIn P = layer_in(args, L); Frame F = F0; F.tid = fresh_tid(); F.lane = F.tid & 63;
            if (!chain) {
                using abf = attn_body::bf16;
                const int a = (int)blockIdx.x, av = (GH % 8 == 0) ? (a % 8) * (GH / 8) + a / 8 : a;
                { pg8::Gemm g{pAU, (const bf16_t*)(ws + W_P), 768, 512, 512}; OrderS5S S{GH, (a + GH - 56) % GH}; EpiS5S E{pS5S};
                  pg8::gemm_phase<EpiS5S, OrderS5S>(F.lds, g, S, E);
                  if (((a + GH - 56) % GH) < 72) { asm volatile("s_waitcnt vmcnt(0)" ::: "memory"); __syncthreads();
                      if (F.tid == 0) { __builtin_amdgcn_fence(__ATOMIC_RELEASE, "agent"); asm volatile("s_waitcnt vmcnt(0)" ::: "memory"); (void)xb_add((unsigned*)(ws + WS_CTL) + CW_S5CNT + 64 * L, 1u); } } }
                for (int u = av; u < 512; u += GH) { const int bk = u >> 5, r = u & 31, b = bk >> 1, kvh = bk & 1, h = kvh * 4 + (r >> 3), qb = r & 7;
                    const size_t qrow = (size_t)b * PB + CTXL + qb * 256, krow = (size_t)b * PB;
                    attn_body::attn_unit<8>((const abf*)(pQN + qrow * 512 + h * 64), 512, (const abf*)(pKN + krow * 128 + kvh * 64), 128, (const abf*)(pPA + krow * PA_W + C_V + kvh * 64), PA_W,
                                            (abf*)(pYAB + qrow * 1024 + h * 64), 1024, 36, (char*)lds_raw); }
                if (!lastL) for (int u = av; u < 64; u += GH) { const int b = u >> 3, h = u & 7, kvh = h >> 2; const size_t krow = (size_t)b * PB;
                    attn_body::attn_unit<8>((const abf*)(pQN + krow * 512 + h * 64), 512, (const abf*)(pKN + krow * 128 + kvh * 64), 128, (const abf*)(pPA + krow * PA_W + C_V + kvh * 64), PA_W,
                                            (abf*)(pYAB + krow * 1024 + h * 64), 1024, 4, (char*)lds_raw); }
            } else {
                const int GC = F.G - GH, rk = (int)blockIdx.x - GH;
                Frame Fc = F; Fc.G = GC; Fc.bid = rk; Fc.vcu = (GC % 8 == 0) ? (rk % 8) * (GC / 8) + rk / 8 : rk; Fc.gw = Fc.vcu * NWAVES + F.wave; Fc.NGW = GC * NWAVES;
                ssd_chunk_states(Fc, P, pXBC, pDT, pSS, pTOT);
                xcd_barrier(bar2);
                ssd_recurrence(Fc, pSS, pTOT, pHIN);
                { if (F.tid == 0) { unsigned* cw = (unsigned*)(ws + WS_CTL) + CW_S5CNT + 64 * L; unsigned sp = 0;
                      while (xb_ld(cw) < 72u) { __builtin_amdgcn_s_sleep(1); if (++sp > (1u << 22)) break; }
                      __builtin_amdgcn_fence(__ATOMIC_ACQUIRE, "agent"); asm volatile("s_waitcnt vmcnt(0)" ::: "memory"); }
                  __syncthreads(); }
                s5_recurrence(Fc, P, pS5S, pAU);
                xcd_barrier(bar2);
                ssd_output(Fc, P, pXBC, pPA, pDT, pHIN, pYAB, pSSQ, lastL);
                { pg8::Gemm g{pAU, (const bf16_t*)(ws + W_TQ), 768, 768, 768}; OrderS5Y S{GC, (rk + GC - 32) % GC}; EpiS5Y E{pAU, pYG, P.s5_d};
                  pg8::gemm_phase<EpiS5Y, OrderS5Y>(F.lds, g, S, E); }
            }
            PRESTAMP(base + 6); SEAM(base + 6);
        }
        if (INL(7)) REP(7) { const LayerIn P = layer_in(args, L); Frame F = F0; F.tid = fresh_tid(); F.lane = F.tid & 63; if (rep_) xcd_barrier(bar);
            pg8::Gemm g{pYG, (const bf16_t*)(ws + W_GLU), 384, 384, 384};
            RowSkipOrder S; S.init(512, F.G, (int)blockIdx.x, lastL ? 1 : 0, 0, 0);
            EpiGlu E{pYG, pYCD, P.s5_bglu};
            pg8::gemm_phase<EpiGlu, RowSkipOrder>(F.lds, g, S, E);
            if (!lastL) prep_expert_weights(F, P, ws, 144, 0, EW7_L0);
            SEAM(base + 7);
        }
        if (INL(8)) REP(8) { const LayerIn P = layer_in(args, L); Frame F = F0; F.tid = fresh_tid(); F.lane = F.tid & 63; if (rep_) xcd_barrier(bar);
            MergeOrder S; S.init(F.G, (int)blockIdx.x, lastL ? 1 : 0);
            pg8::MergeArgs MA{pYAB, pYCD, (const bf16_t*)(ws + W_BR4), pPG, pSSQ, pMRGB};
            pg8::gemm_merge_phase<MergeOrder>(F.lds, MA, S);
            if (!lastL) { __syncthreads(); const LayerIn P1 = layer_in(args, 1); prep_s5(F, P1, ws, 64); __syncthreads(); prep_expert_weights(F, P, ws, 160, EW7_L0, EW_SPLIT1); }
            SEAM(base + 8);
        }
        if (INL(9)) REP(9) { const LayerIn P = layer_in(args, L); Frame F = F0; F.tid = fresh_tid(); F.lane = F.tid & 63; if (rep_) xcd_barrier(bar);
            pg8::Gemm g{pMRGB, (const bf16_t*)(ws + W_OUT), 1024, 1024, 1024};
            RowSkipOrder S; S.init(1024, F.G, (int)blockIdx.x, lastL ? 1 : 0, 0, 0);
            EpiWout E{pY};
            pg8::gemm_phase<EpiWout, RowSkipOrder>(F.lds, g, S, E);
            if (!lastL) { __syncthreads(); const LayerIn P1 = layer_in(args, 1); prep_small_weights(F, P1, ws, 1, 32); prep_expert_weights(F, P, ws, 32, EW_SPLIT1, EW_SPLIT2); }
            SEAM(base + 9);
        }
        if (INL(10)) REP(10) { const LayerIn P = layer_in(args, L); Frame F = F0; F.tid = fresh_tid(); F.lane = F.tid & 63; if (rep_) xcd_barrier(bar); phase_norm2<3>(F, L, lastL, args.in[0], args.in[2], pX, pY, pH, pMOD, P.norm_ffn_g, P.w_router, pAFF); SEAM(base + 10); }
        if (INL(11)) REP(11) { const LayerIn P = layer_in(args, L); Frame F = F0; F.tid = fresh_tid(); F.lane = F.tid & 63; if (rep_) xcd_barrier(bar); phase_topk(F, lastL ? 128 : 256, pAFF, pSRC, pGV, pINV);
            if (L == 0) { const LayerIn P1 = layer_in(args, 1); prep_small_weights(F, P1, ws, 2, 0); }
            prep_expert_weights(F, P, ws, (L == 0) ? 0 : 128, (L == 0) ? EW_SPLIT2 : EW1_END, EXPERT_W_ITEMS, nullptr, (L == 0) ? nullptr : (bf16_t*)(ws + WS_WD1)); SEAM(base + 12); }
        if (INL(13)) REP(13) { const LayerIn P = layer_in(args, L); Frame F = F0; F.tid = fresh_tid(); F.lane = F.tid & 63; if (rep_) xcd_barrier(bar);
            pg8::Gemm g{pH, lastL ? (const bf16_t*)args.out : (const bf16_t*)(ws + WS_WGU), 1024, 1024, 1024}; OrderUp S{F.G, (int)blockIdx.x, lastL ? 8 : 9}; EpiUp E{pHID};
            pg8::gemm_phase_gather<EpiUp, OrderUp>(F.lds, g, pSRC, S, E);
            if (!lastL) { __syncthreads(); const LayerIn P1 = layer_in(args, 1); prep_expert_weights(F, P1, ws, 128, 0, EW1_SPLIT, (bf16_t*)args.out, (bf16_t*)(ws + WS_WD1)); }
            SEAM(base + 13);
        }
        if (INL(14)) REP(14) { const LayerIn P = layer_in(args, L); Frame F = F0; F.tid = fresh_tid(); F.lane = F.tid & 63; if (rep_) xcd_barrier(bar);
            pg8::Gemm g{pHID, (const bf16_t*)(ws + (lastL ? WS_WD1 : WS_WD)), 1024, 1024, 1024}; OrderDown S{F.G, (int)blockIdx.x, lastL ? 8 : 9}; EpiDown E{pYE, pGV};
            pg8::gemm_phase<EpiDown, OrderDown>(F.lds, g, S, E);
            if (!lastL) { __syncthreads(); const LayerIn P1 = layer_in(args, 1); prep_expert_weights(F, P1, ws, 64, EW1_SPLIT, EW1_END, (bf16_t*)args.out, (bf16_t*)(ws + WS_WD1)); }
            SEAM(base + 14);
        }
    }
#if E3_PROBE
    if (blockIdx.x == 0 && threadIdx.x == 0) { const unsigned long long t0_ = __builtin_amdgcn_s_memrealtime(), w_ = 20ull * g_probe_ticks; while (__builtin_amdgcn_s_memrealtime() - t0_ < w_) __builtin_amdgcn_s_sleep(8); g_probe_ticks = 0; }
    __syncthreads();
#endif
#if SP_AMP
    if (blockIdx.x == SP_WG && threadIdx.x == 0) {
#ifdef SP_MAXK
        unsigned w_ = __hip_atomic_load((unsigned*)(ws + WS_CTL) + 32768 + SP_MAXK, __ATOMIC_RELAXED, __HIP_MEMORY_SCOPE_AGENT) - MISC[64 + SP_A];
#else
        unsigned w_ = MISC[64 + SP_B] - MISC[64 + SP_A];
#endif
#ifdef SP_B2
        w_ += MISC[64 + SP_B2] - MISC[64 + SP_A2];
#endif
        const unsigned long long t0_ = __builtin_amdgcn_s_memrealtime(), ww_ = (unsigned long long)SP_AMP * w_; while (__builtin_amdgcn_s_memrealtime() - t0_ < ww_) __builtin_amdgcn_s_sleep(8); }
    __syncthreads();
#endif
#ifdef EXTRA_BARRIERS
    for (int eb = 0; eb < EXTRA_BARRIERS; ++eb) xcd_barrier(bar);
#endif
    if (IN(PH_FINAL)) { Frame F = F0; F.tid = fresh_tid(); F.lane = F.tid & 63; phase_final<2>(F, pX, args.out, pMOD, args.in[37], pINV, pYE, pY); }
#undef IN
#undef INL
#undef SEAM
}

#ifndef MK_N_LAUNCHES
#define MK_N_LAUNCHES 1
#endif
extern "C" void kernel_launch(void* const* d_in, const int* in_sizes, int n_in, void* d_out, int out_size, void* d_ws, size_t ws_size, hipStream_t stream) {
    static int grid = 0;
    if (grid == 0) {
        if (n_in != 38 || ws_size < WS_END) { fprintf(stderr, "kernel_launch: unexpected inputs (n_in %d, ws %zu)\n", n_in, ws_size); grid = -1; return; }
        int dev = 0, cus = 0;
        if (hipGetDevice(&dev) != hipSuccess || hipDeviceGetAttribute(&cus, hipDeviceAttributeMultiprocessorCount, dev) != hipSuccess) { grid = -1; return; }
        if (hipFuncSetAttribute((const void*)hybrid_fwd, hipFuncAttributeMaxDynamicSharedMemorySize, LDS_BYTES) != hipSuccess) { fprintf(stderr, "kernel_launch: hipFuncSetAttribute failed\n"); grid = -1; return; }
        (void)hipGetLastError();
        grid = (cus / 8) * 8;
        if (grid > 256) grid = 256;
    }
    if (grid < 0) return;
    if (hipMemsetAsync((char*)d_ws + WS_CTL, 0, CTL_ZERO_BYTES, stream) != hipSuccess) return;
    Args a{};
    for (int i = 0; i < 38; ++i) a.in[i] = (const float*)d_in[i];
    a.out = (float*)d_out; a.ws = (unsigned char*)d_ws;
#if MK_N_LAUNCHES == 1
    a.ph_lo = 0; a.ph_hi = PH_TOTAL;
    hipLaunchKernelGGL(hybrid_fwd, dim3(grid), dim3(NWAVES * 64), LDS_BYTES, stream, a);
#else
    for (int p = 0; p < PH_TOTAL; ++p) { a.ph_lo = p; a.ph_hi = p + 1; hipLaunchKernelGGL(hybrid_fwd, dim3(grid), dim3(NWAVES * 64), LDS_BYTES, stream, a); }
#endif
}
```
